# Optimizing an MI355X kernel written in HIP

```python
import math
import jax, jax.numpy as jnp
from jax import lax
import numpy as np

D_MODEL = 1024
BATCH = 4
SEQ = 4096
DEPTH = 2

N_META = 16
CHUNK = 64
PAD_FRONT = (-N_META) % CHUNK
CONV_W = 4
RMS_EPS = 1e-6
L2_EPS = 1e-6
LB_FLOOR = 1e-30

A_HEADS = 4
A_DK = 128
A_DV = 128
B_HEADS = 4
B_DK = 128
B_DV = 128
C_HEADS = 4
C_DK = 64
C_DV = 128
C_GK_RANK = 16
C_GK_NORM = 16.0

BRANCH_W = 512
N_BRANCH = 3

N_GROUPS = 4
EXP_PER_GROUP = 8
EXPERT_HIDDEN = 256
TOP_K = 2

IN_SPLITS = (
    A_HEADS * A_DK,
    A_HEADS * A_DK,
    A_HEADS * A_DV,
    A_HEADS * A_DV,
    B_HEADS * (2 * B_DK + B_DV),
    B_HEADS,
    B_HEADS,
    B_HEADS * B_DV,
    C_HEADS * C_DK,
    C_HEADS * C_DK,
    C_HEADS * C_DV,
    C_GK_RANK,
    C_HEADS * C_DV,
    N_BRANCH * D_MODEL,
)
IN_COLS = sum(IN_SPLITS)

kernel_name = "hybrid_hgrn2_gdn_gla_hmoe"


def _rmsnorm(x, w):
    xf = x.astype(jnp.float32)
    y = xf * lax.rsqrt(jnp.mean(xf * xf, axis=-1, keepdims=True) + RMS_EPS)
    return (y * w.astype(jnp.float32)).astype(x.dtype)


def _l2norm(x):
    return x * lax.rsqrt(jnp.sum(x * x, axis=-1, keepdims=True) + L2_EPS)


def _split_heads(x, n):
    b, l, c = x.shape
    return jnp.transpose(x.reshape(b, l, n, c // n), (0, 2, 1, 3))


def _to_chunks(x):
    b, h, l, d = x.shape
    return jnp.moveaxis(x.reshape(b, h, l // CHUNK, CHUNK, d), 2, 0)


def _from_chunks(x):
    n, b, h, c, d = x.shape
    return jnp.moveaxis(x, 0, 2).reshape(b, h, n * c, d)


def _masked_exp(diff, mask):
    return jnp.where(mask, jnp.exp(jnp.where(mask, diff, 0.0)), 0.0)


def _gated_head_norm(o, gate, w):
    b, h, l, dv = o.shape
    o = jnp.transpose(o, (0, 2, 1, 3))
    o = _rmsnorm(o, w) * jax.nn.silu(gate.reshape(b, l, h, dv))
    return o.reshape(b, l, h * dv)


def _causal_conv(x, w):
    return lax.conv_general_dilated(
        x, w[:, None, :].astype(x.dtype), window_strides=(1,), padding=((CONV_W - 1, 0),),
        dimension_numbers=("NWC", "WIO", "NWC"), feature_group_count=x.shape[-1])


def _chunk_gla(q, k, v, log_f):
    b_, h_, _, dk = q.shape
    dv = v.shape[-1]
    causal = jnp.tril(jnp.ones((CHUNK, CHUNK), dtype=bool))[:, :, None]

    def step(S, xs):
        qc, kc, vc, gc = xs
        bcum = jnp.cumsum(gc, axis=-2)
        b_last = bcum[..., -1:, :]
        pair = _masked_exp(bcum[..., :, None, :] - bcum[..., None, :, :], causal)
        scores = jnp.einsum('bhtsd,bhsd->bhts', qc[..., :, None, :] * pair, kc)
        o = (jnp.einsum('bhts,bhse->bhte', scores, vc)
             + jnp.einsum('bhtd,bhde->bhte', qc * jnp.exp(bcum), S))
        S = (jnp.exp(b_last[..., 0, :])[..., None] * S
             + jnp.einsum('bhsd,bhse->bhde', kc * jnp.exp(b_last - bcum), vc))
        return S, o

    S0 = jnp.zeros((b_, h_, dk, dv), q.dtype)
    _, o = lax.scan(step, S0, (_to_chunks(q), _to_chunks(k), _to_chunks(v), _to_chunks(log_f)))
    return _from_chunks(o)


def _chunk_gated_delta(q, k, v, log_a, beta):
    dvv = v.shape[-1]
    qc, kc, vc = _to_chunks(q), _to_chunks(k), _to_chunks(v)
    g = jnp.cumsum(_to_chunks(log_a[..., None])[..., 0], axis=-1)
    bc = _to_chunks(beta[..., None])[..., 0]
    causal = jnp.tril(jnp.ones((CHUNK, CHUNK), dtype=bool))
    strict = jnp.tril(jnp.ones((CHUNK, CHUNK), dtype=bool), -1)
    decay = _masked_exp(g[..., :, None] - g[..., None, :], causal)
    a_mat = jnp.where(strict, bc[..., :, None] * jnp.einsum('nbhtd,nbhsd->nbhts', kc, kc) * decay, 0.0)
    eye = jnp.eye(CHUNK, dtype=q.dtype)
    rhs = jnp.concatenate([vc * bc[..., None], kc * (bc * jnp.exp(g))[..., None]], axis=-1)
    sol = lax.linalg.triangular_solve(a_mat + eye, rhs, left_side=True, lower=True, unit_diagonal=True)
    u, w = sol[..., :dvv], sol[..., dvv:]
    qk = jnp.einsum('nbhtd,nbhsd->nbhts', qc, kc) * decay

    def step(S, xs):
        q_, k_, u_, w_, g_, qk_ = xs
        v_new = u_ - jnp.einsum('bhcd,bhde->bhce', w_, S)
        o = (jnp.einsum('bhcd,bhde->bhce', q_ * jnp.exp(g_)[..., None], S)
             + jnp.einsum('bhts,bhse->bhte', qk_, v_new))
        g_last = g_[..., -1:]
        S = (jnp.exp(g_last)[..., None] * S
             + jnp.einsum('bhsd,bhse->bhde', k_ * jnp.exp(g_last - g_)[..., None], v_new))
        return S, o

    S0 = jnp.zeros((q.shape[0], q.shape[1], q.shape[-1], dvv), q.dtype)
    _, o = lax.scan(step, S0, (qc, kc, u, w, g, qk))
    return _from_chunks(o)


def _hgrn2(q_in, f_in, i_in, g_in, lb, norm_w, valid):
    q = jax.nn.silu(q_in) * (A_DK ** -0.5)
    log_f = jnp.logaddexp(jnp.log(jnp.maximum(lb, LB_FLOOR)), jnp.log1p(-lb) + jax.nn.log_sigmoid(f_in))
    k = (1.0 - lb) * jax.nn.sigmoid(-f_in) * valid
    o = _chunk_gla(_split_heads(q, A_HEADS), _split_heads(k, A_HEADS),
                   _split_heads(i_in, A_HEADS), _split_heads(log_f, A_HEADS))
    return _gated_head_norm(o, g_in, norm_w)


def _gated_deltanet(qkv_in, beta_in, decay_in, g_in, conv_w, a_log, dt_bias, norm_w, valid):
    qkv = jax.nn.silu(_causal_conv(qkv_in, conv_w))
    q, k, v = jnp.split(qkv, [B_HEADS * B_DK, 2 * B_HEADS * B_DK], axis=-1)
    q = _l2norm(_split_heads(q, B_HEADS)) * (B_DK ** -0.5)
    k = _l2norm(_split_heads(k * valid, B_HEADS))
    v = _split_heads(v, B_HEADS)
    beta = jnp.transpose(jax.nn.sigmoid(beta_in) * valid, (0, 2, 1))
    log_a = jnp.transpose(-jnp.exp(a_log) * jax.nn.softplus(decay_in + dt_bias), (0, 2, 1))
    o = _chunk_gated_delta(q, k, v, log_a, beta)
    return _gated_head_norm(o, g_in, norm_w)


def _gla(q_in, k_in, v_in, gk_low, g_in, gk_w2, gk_b, norm_w, valid):
    q = _split_heads(q_in, C_HEADS) * (C_DK ** -0.5)
    k = _split_heads(k_in * valid, C_HEADS)
    v = _split_heads(v_in, C_HEADS)
    log_f = _split_heads(jax.nn.log_sigmoid(gk_low @ gk_w2 + gk_b) / C_GK_NORM, C_HEADS)
    o = _chunk_gla(q, k, v, log_f)
    return _gated_head_norm(o, g_in, norm_w)


def _hier_moe(x, wg, bg, we, be, w_gate, w_up, w_down):
    xf = x.astype(jnp.float32)
    b, l, _ = xf.shape
    p_group = jax.nn.softmax(xf @ wg + bg, axis=-1)
    g_val, g_idx = lax.top_k(p_group, 1)
    e_logits = (xf @ we + be).reshape(b, l, N_GROUPS, EXP_PER_GROUP)
    e_logits = jnp.take_along_axis(e_logits, g_idx[..., None], axis=2)[:, :, 0, :]
    p_exp = jax.nn.softmax(e_logits, axis=-1)
    e_val, e_idx = lax.top_k(p_exp, TOP_K)
    e_w = e_val / jnp.sum(e_val, axis=-1, keepdims=True)
    within = jnp.einsum('blk,blke->ble', e_w, jax.nn.one_hot(e_idx, EXP_PER_GROUP, dtype=jnp.float32))
    combine = (jax.nn.one_hot(g_idx[..., 0], N_GROUPS, dtype=jnp.float32)[..., None]
               * (g_val * within)[:, :, None, :])
    y = jnp.zeros_like(xf)
    for grp in range(N_GROUPS):
        hid = (jax.nn.silu(jnp.einsum('bld,edh->bleh', xf, w_gate[grp]))
               * jnp.einsum('bld,edh->bleh', xf, w_up[grp]))
        y = y + jnp.einsum('bleh,ble,ehd->bld', hid, combine[:, :, grp], w_down[grp])
    return y


def setup_inputs(seed: int = 0) -> dict:
    key = jax.random.key(seed)
    ks = jax.random.split(key, 24)
    f32 = jnp.float32

    def nrm(k, shape, scale):
        return jax.random.normal(k, shape, f32) * scale

    dt = jnp.exp(jax.random.uniform(ks[8], (DEPTH, B_HEADS), f32, math.log(1e-3), math.log(1e-1)))
    return {
        "x": nrm(ks[0], (BATCH, SEQ, D_MODEL), 1.0),
        "meta_tokens": nrm(ks[1], (N_META, D_MODEL), 1.0),
        "norm_mix": 1.0 + nrm(ks[2], (DEPTH, D_MODEL), 0.02),
        "w_in": nrm(ks[3], (DEPTH, D_MODEL, IN_COLS), D_MODEL ** -0.5),
        "hgrn_lb_logits": nrm(ks[4], (DEPTH, A_HEADS * A_DK), 0.5),
        "hgrn_norm": 1.0 + nrm(ks[5], (DEPTH, A_DV), 0.02),
        "gdn_conv": nrm(ks[6], (DEPTH, CONV_W, B_HEADS * (2 * B_DK + B_DV)), CONV_W ** -0.5),
        "gdn_a_log": jnp.log(jax.random.uniform(ks[7], (DEPTH, B_HEADS), f32, 1.0, 16.0)),
        "gdn_dt_bias": dt + jnp.log(-jnp.expm1(-dt)),
        "gdn_norm": 1.0 + nrm(ks[9], (DEPTH, B_DV), 0.02),
        "gla_gk_w2": nrm(ks[10], (DEPTH, C_GK_RANK, C_HEADS * C_DK), C_GK_RANK ** -0.5),
        "gla_gk_b": nrm(ks[11], (DEPTH, C_HEADS * C_DK), 0.1),
        "gla_norm": 1.0 + nrm(ks[12], (DEPTH, C_DV), 0.02),
        "w_branch": nrm(ks[13], (DEPTH, N_BRANCH, BRANCH_W, D_MODEL), BRANCH_W ** -0.5),
        "w_out": nrm(ks[14], (DEPTH, D_MODEL, D_MODEL), D_MODEL ** -0.5),
        "norm_ffn": 1.0 + nrm(ks[15], (DEPTH, D_MODEL), 0.02),
        "router_group_w": nrm(ks[16], (DEPTH, D_MODEL, N_GROUPS), D_MODEL ** -0.5),
        "router_group_b": nrm(ks[17], (DEPTH, N_GROUPS), 0.01),
        "router_expert_w": nrm(ks[18], (DEPTH, D_MODEL, N_GROUPS * EXP_PER_GROUP), D_MODEL ** -0.5),
        "router_expert_b": nrm(ks[19], (DEPTH, N_GROUPS * EXP_PER_GROUP), 0.01),
        "expert_w_gate": nrm(ks[20], (DEPTH, N_GROUPS, EXP_PER_GROUP, D_MODEL, EXPERT_HIDDEN), D_MODEL ** -0.5),
        "expert_w_up": nrm(ks[21], (DEPTH, N_GROUPS, EXP_PER_GROUP, D_MODEL, EXPERT_HIDDEN), D_MODEL ** -0.5),
        "expert_w_down": nrm(ks[22], (DEPTH, N_GROUPS, EXP_PER_GROUP, EXPERT_HIDDEN, D_MODEL), EXPERT_HIDDEN ** -0.5),
        "norm_final": 1.0 + nrm(ks[23], (D_MODEL,), 0.02),
    }


def reference(x, meta_tokens, norm_mix, w_in, hgrn_lb_logits, hgrn_norm, gdn_conv, gdn_a_log,
              gdn_dt_bias, gdn_norm, gla_gk_w2, gla_gk_b, gla_norm, w_branch, w_out, norm_ffn,
              router_group_w, router_group_b, router_expert_w, router_expert_b,
              expert_w_gate, expert_w_up, expert_w_down, norm_final):
    b, s, d = x.shape
    dtype = x.dtype
    total = PAD_FRONT + N_META + s
    pad = jnp.zeros((b, PAD_FRONT, d), dtype)
    meta = jnp.broadcast_to(meta_tokens.astype(dtype)[None], (b, N_META, d))
    h = jnp.concatenate([pad, meta, x], axis=1)
    valid = (jnp.arange(total) >= PAD_FRONT).astype(jnp.float32)[None, :, None]

    lb_p = jax.nn.softmax(hgrn_lb_logits.astype(jnp.float32), axis=0)
    lb_all = jnp.maximum(jnp.cumsum(lb_p, axis=0) - lb_p[0:1], 0.0)

    split_points = np.cumsum(IN_SPLITS)[:-1].tolist()
    for layer in range(DEPTH):
        u = _rmsnorm(h, norm_mix[layer]).astype(jnp.float32) * valid
        (a_q, a_f, a_i, a_g, b_qkv, b_beta, b_decay, b_g,
         c_q, c_k, c_v, c_gk, c_g, gate_logits) = jnp.split(u @ w_in[layer], split_points, axis=-1)
        y_a = _hgrn2(a_q, a_f, a_i, a_g, lb_all[layer], hgrn_norm[layer], valid)
        y_b = _gated_deltanet(b_qkv, b_beta, b_decay, b_g, gdn_conv[layer], gdn_a_log[layer],
                              gdn_dt_bias[layer], gdn_norm[layer], valid)
        y_c = _gla(c_q, c_k, c_v, c_gk, c_g, gla_gk_w2[layer], gla_gk_b[layer], gla_norm[layer], valid)
        ys = jnp.stack([y_a, y_b, y_c], axis=2)
        gates = jax.nn.sigmoid(gate_logits.reshape(b, total, N_BRANCH, d))
        proj = jnp.einsum('blne,ned->blnd', ys, w_branch[layer])
        merged = jnp.sum(gates * proj, axis=2)
        h = h + (merged @ w_out[layer]).astype(dtype)
        u2 = _rmsnorm(h, norm_ffn[layer])
        h = h + _hier_moe(u2, router_group_w[layer], router_group_b[layer], router_expert_w[layer],
                          router_expert_b[layer], expert_w_gate[layer], expert_w_up[layer],
                          expert_w_down[layer]).astype(dtype)

    out = _rmsnorm(h, norm_final)
    return out[:, PAD_FRONT + N_META:, :]
```

```cpp
#include <hip/hip_runtime.h>
#include <cstdio>
#include <cstdint>

#define LAS __attribute__((address_space(3)))
typedef unsigned short bf16_t;
typedef short bf16x8 __attribute__((ext_vector_type(8)));
typedef float f32x4 __attribute__((ext_vector_type(4)));
typedef float f32x2 __attribute__((ext_vector_type(2)));
typedef unsigned u32x4 __attribute__((ext_vector_type(4)));
typedef unsigned u32x2 __attribute__((ext_vector_type(2)));

constexpr int D = 1024, NREAL = 16384, MROWS = 16640, META_ROW0 = 16384 + 48, META_END = 16384 + 64;
constexpr int NSLOT = 257;
constexpr int LDP = 5632;
constexpr int PC_AQ = 0, PC_AF = 512, PC_AI = 1024, PC_AG = 1536, PC_BQKV = 2048, PC_BG = 3584, PC_CQ = 4096, PC_CK = 4352, PC_CV = 4608, PC_CG = 5120;
constexpr int IN_COLS = 8728;
constexpr int NTHREADS = 512, NWAVES = 8;
constexpr int XG_ROWS = 40960;

constexpr size_t MiB = 1ull << 20;
constexpr size_t WS_CTL = 0, CTL_BYTES = 1 * MiB;
constexpr int CW_BAR = 4096, CW_CNT = 1024;
constexpr size_t SM_SW1 = 1 * MiB;
constexpr size_t SM_RWG = SM_SW1 + 2 * 24 * 1024 * 4;
constexpr size_t SM_RWE = SM_RWG + 2 * 4 * 1024 * 4;
constexpr size_t SM_LAB = SM_RWE + 2 * 32 * 1024 * 4;
constexpr size_t SM_GK = SM_LAB + 2 * 2 * 512 * 4;
constexpr size_t SM_BETA = SM_GK + (size_t)MROWS * 16 * 4;
constexpr size_t SM_LOGA = SM_BETA + (size_t)MROWS * 4 * 4;
constexpr size_t SM_TOK = SM_LOGA + (size_t)MROWS * 4 * 4;
constexpr size_t SM_WROW = SM_TOK + (size_t)MROWS * 8 * 4;
constexpr size_t SM_DECA = SM_WROW + (size_t)XG_ROWS * 4;
constexpr size_t SM_DECC = SM_DECA + 1028 * 128 * 4;
constexpr size_t SM_DECB = SM_DECC + 1028 * 64 * 4;
constexpr size_t SM_HALO = SM_DECB + 8192;
constexpr size_t SM_END = SM_HALO + 260 * 3 * 1536 * 2;
static_assert(SM_END <= 8 * MiB, "small region");
constexpr size_t WS_HMETA = 8 * MiB;
constexpr size_t WS_WMIX = 9 * MiB;
constexpr size_t WS_WGATE = 20 * MiB;
constexpr size_t WS_WBT = 26 * MiB;
constexpr size_t WS_WOT = 29 * MiB;
constexpr size_t WS_O = 31 * MiB;
constexpr size_t O_STRIDE = (size_t)MROWS * 512 * 2;
constexpr size_t WS_W1T = 31 * MiB;
constexpr size_t WS_W2T = 63 * MiB;
constexpr size_t WS_U = 80 * MiB;
constexpr size_t WS_P = 113 * MiB;
constexpr size_t WS_GT = 113 * MiB;
constexpr size_t WS_MERGED = 211 * MiB;
constexpr size_t WS_XG = 113 * MiB;
constexpr size_t WS_HG = 193 * MiB;
constexpr size_t WS_Y2 = 213 * MiB;
constexpr size_t WS_SCA = 294 * MiB;
constexpr size_t WS_QKD = 303 * MiB;
constexpr size_t WS_SCC = 312 * MiB;
constexpr size_t WS_K1TB = 321 * MiB;
constexpr size_t WS_END = 338 * MiB;

constexpr int LDS_BYTES = 147456;
constexpr int LDS_MISC = LDS_BYTES - 512;
constexpr int LDS_TAB = LDS_BYTES - 1536;
constexpr int LDS_SCRATCH = LDS_TAB;

typedef __bf16 bf16x2v __attribute__((ext_vector_type(2)));
__device__ __forceinline__ unsigned pk2(float lo, float hi) { const f32x2 v = {lo, hi}; return __builtin_bit_cast(unsigned, __builtin_convertvector(v, bf16x2v)); }
__device__ __forceinline__ bf16_t f2bf(float f) { return (bf16_t)(pk2(f, 0.f) & 0xffffu); }
__device__ __forceinline__ float bf2f(bf16_t b) { return __uint_as_float(((unsigned)b) << 16); }
__device__ __forceinline__ float bflo(unsigned w) { return __uint_as_float(w << 16); }
__device__ __forceinline__ float bfhi(unsigned w) { return __uint_as_float(w & 0xffff0000u); }
__device__ __forceinline__ float sigmoidf_(float x) { return 1.0f / (1.0f + __expf(-x)); }
__device__ __forceinline__ float siluf_(float x) { return x / (1.0f + __expf(-x)); }
__device__ __forceinline__ float logsigf_(float x) { return fminf(x, 0.f) - log1pf(__expf(-fabsf(x))); }
__device__ __forceinline__ float softplusf_(float x) { return fmaxf(x, 0.f) + log1pf(__expf(-fabsf(x))); }
__device__ __forceinline__ bool row_valid(int r) { return r < NREAL || (r >= META_ROW0 && r < META_END); }
__device__ __forceinline__ float wave_sum(float v) {
#pragma unroll
    for (int o = 1; o < 64; o <<= 1) v += __shfl_xor(v, o);
    return v;
}
#define LDS_WAIT() asm volatile("s_waitcnt lgkmcnt(0)" ::: "memory")

#define XB_TMO      128
#define XB_XCNT(j)  (256  + 64 * (j))
#define XB_XSUB(j)  (1280 + 64 * (j))
#define XB_XGEN(j)  (2304 + 64 * (j))
#define XB_TOP      3328
#define XB_TOPGEN   3392
#define XCD_BAR_WORDS 3456
#define XB_SPIN_CAP (1u << 18)
__device__ __forceinline__ unsigned xb_ld(unsigned* p)              { return __hip_atomic_load(p, __ATOMIC_RELAXED, __HIP_MEMORY_SCOPE_AGENT); }
__device__ __forceinline__ unsigned xb_add(unsigned* p, unsigned v) { return __hip_atomic_fetch_add(p, v, __ATOMIC_RELAXED, __HIP_MEMORY_SCOPE_AGENT); }
__device__ __forceinline__ unsigned xb_xcc_id() { return (unsigned)__builtin_amdgcn_s_getreg((3 << 11) | 20) & 0xFu; }
#define XB_SPIN(cond, bar) do { unsigned _sp = 0; while (cond) { __builtin_amdgcn_s_sleep(1); \
    if ((++_sp & 255u) == 0u) { if (xb_ld(&(bar)[XB_TMO])) break; if (_sp > XB_SPIN_CAP) { atomicAdd(&(bar)[XB_TMO], 1u); break; } } } } while (0)
struct XcdBarrier { unsigned* bar; unsigned x; volatile LAS unsigned* st; };
__device__ __forceinline__ XcdBarrier xcd_barrier_post(unsigned* bar, volatile LAS unsigned* st) {
    XcdBarrier b; b.bar = bar; b.x = xb_xcc_id(); b.st = st;
    if (threadIdx.x == 0) (void)xb_add(&bar[XB_XCNT(b.x)], 1u);
    return b;
}
__device__ __forceinline__ void xcd_barrier_complete(unsigned* bar, unsigned x, unsigned& nloc, unsigned& nx) {
    const unsigned G = gridDim.x * gridDim.y * gridDim.z;
    unsigned sum, cnt, mine, sp = 0u;
    for (;;) {
        sum = 0u; cnt = 0u; mine = 0u;
#pragma unroll
        for (unsigned j = 0; j < 16; ++j) { const unsigned c = xb_ld(&bar[XB_XCNT(j)]); sum += c; cnt += (c > 0u) ? 1u : 0u; mine = (j == x) ? c : mine; }
        if (sum == G) break;
        __builtin_amdgcn_s_sleep(1);
        if ((++sp & 255u) == 0u) { if (xb_ld(&bar[XB_TMO])) break; if (sp > XB_SPIN_CAP) { atomicAdd(&bar[XB_TMO], 1u); break; } }
    }
    nloc = mine > 0u ? mine : 1u; nx = cnt > 0u ? cnt : 1u;
}
__device__ __attribute__((noinline)) void xcd_barrier(unsigned* bar_, unsigned x_, volatile LAS unsigned* st_) {
    XcdBarrier b; b.bar = bar_; b.x = x_; b.st = st_;
    asm volatile("s_waitcnt vmcnt(0)" ::: "memory");
    __syncthreads();
    if (threadIdx.x == 0) {
        unsigned* bar = b.bar;
        __builtin_amdgcn_s_waitcnt(0);
        unsigned nloc = b.st[0], nx = b.st[1];
        if (nloc == 0u) { xcd_barrier_complete(bar, b.x, nloc, nx); b.st[0] = nloc; b.st[1] = nx; }
        const unsigned old = xb_add(&bar[XB_XSUB(b.x)], 1u);
        const unsigned gen = old / nloc;
        if (old + 1u == (gen + 1u) * nloc) {
            __builtin_amdgcn_fence(__ATOMIC_RELEASE, "agent");
            asm volatile("s_waitcnt vmcnt(0)" ::: "memory");
            const unsigned og = xb_add(&bar[XB_TOP], 1u);
            const unsigned tg = og / nx;
            if (og + 1u == (tg + 1u) * nx) xb_add(&bar[XB_TOPGEN], 1u);
            else XB_SPIN(xb_ld(&bar[XB_TOPGEN]) == tg, bar);
            __builtin_amdgcn_fence(__ATOMIC_ACQUIRE, "agent");
            xb_add(&bar[XB_XGEN(b.x)], 1u);
            asm volatile("s_waitcnt vmcnt(0)" ::: "memory");
        } else {
            XB_SPIN(xb_ld(&bar[XB_XGEN(b.x)]) == gen, bar);
            __builtin_amdgcn_fence(__ATOMIC_ACQUIRE, "agent");
            asm volatile("s_waitcnt vmcnt(0)" ::: "memory");
        }
    }
    __syncthreads();
}
namespace pg8 {
constexpr int BM = 256, BK = 64, HALF = 128, HTB = HALF * BK * 2, STAGE_BYTES = 8 * HTB, NXCD = 8, WGM = 8;
__host__ __device__ __forceinline__ int lds_byte(int r, int c) { const int st = (r >> 4) * 2 + (c >> 5), rr = r & 15, cc = c & 31, ob = rr * 64 + cc * 2; return st * 1024 + (ob ^ (((ob >> 9) & 1) << 5)); }
__host__ __device__ __forceinline__ void stage_rc(int b, int& R, int& C) { const int st = b / 1024, sb = b % 1024, swz = sb ^ (((sb >> 9) & 1) << 5); R = (st >> 1) * 16 + swz / 64; C = (st & 1) * 32 + (swz % 64) / 2; }
__host__ __device__ __forceinline__ int perm32(int rho) { const int n = rho >> 4, i = rho & 15; return 8 * (i >> 2) + 4 * n + (i & 3); }

struct Unit { int pm, pn, ex; };
struct Gemm { const bf16_t* A; const bf16_t* Bt; int M, N, K; };

struct StaticOrder {
    int nM, nN, nwg, G, c;
    __device__ void init(int M, int N, int G_, int c_) { nM = M / BM; nN = N / BM; nwg = nM * nN; G = G_; c = c_; }
    __device__ bool next(int i, Unit& u) const {
        const long L = (long)i * G + c; if (L >= nwg) return false;
        int wgid = (int)L; { const int q = nwg / NXCD, r = nwg % NXCD, xcd = wgid % NXCD, off = wgid / NXCD; wgid = (xcd < r ? xcd * (q + 1) : r * (q + 1) + (xcd - r) * q) + off; }
        const int nig = WGM * nN, gid = wgid / nig, fm = gid * WGM, gsz = (nM - fm) < WGM ? (nM - fm) : WGM;
        u.pm = fm + ((wgid % nig) % gsz); u.pn = (wgid % nig) / gsz; u.ex = 0; return true;
    }
    __device__ __forceinline__ void ptrs(const Gemm& g, const Unit& u, const char*& a, const char*& b) const {
        const size_t tstep = (size_t)BM * g.K * 2; a = (const char*)g.A + (size_t)u.pm * tstep; b = (const char*)g.Bt + (size_t)u.pn * tstep; }
};
struct MoeOrder {
    int G, c, npn, ntiles; const LAS unsigned char* tab; size_t estride;
    __device__ bool next(int i, Unit& u) const {
        const long L = (long)i * G + c; if (L >= (long)ntiles * npn) return false;
        u.pm = (int)(L / npn); u.pn = (int)(L % npn); u.ex = (int)tab[u.pm]; return true;
    }
    __device__ __forceinline__ void ptrs(const Gemm& g, const Unit& u, const char*& a, const char*& b) const {
        const size_t tstep = (size_t)BM * g.K * 2; a = (const char*)g.A + (size_t)u.pm * tstep; b = (const char*)g.Bt + (size_t)u.ex * estride + (size_t)u.pn * tstep; }
};

template <class Epi, class Sched>
__device__ __forceinline__ void gemm_phase(LAS unsigned char* lds, const int tid, const Gemm g, const Sched& S, const Epi& E) {
    const int wid = __builtin_amdgcn_readfirstlane(tid >> 6), lane = tid & 63, wr = wid >> 2, wc = wid & 3, fr = lane & 15, fq = lane >> 4;
    int K = g.K; asm volatile("" : "+s"(K));
    const int nt = K / BK;
    unsigned voffA[2], voffB[2];
#pragma unroll
    for (int i = 0; i < 2; ++i) { int R, C; stage_rc(tid * 16 + i * 8192, R, C); const int Rb = Epi::PERM ? ((R & ~31) + perm32(R & 31)) : R;
        voffA[i] = (unsigned)(R * K + C) * 2u; voffB[i] = (unsigned)(Rb * K + C) * 2u; }
    const size_t kstep = (size_t)(BK * 2);
    const size_t hstep = (size_t)HALF * K * 2;
    const unsigned ldsw = (unsigned)wid * 1024u;
    const int aoff = lds_byte(wr * 64 + fr, fq * 8), boff = lds_byte(wc * 32 + fr, fq * 8);
#define PG8_SA(b, h) (((b) * 2 + (h)) * HTB)
#define PG8_SB(b, h) ((4 + (b) * 2 + (h)) * HTB)
#define PG8_STAGE(bufoff, gbase, voff) do { _Pragma("unroll") for (int _i = 0; _i < 2; ++_i) \
        __builtin_amdgcn_global_load_lds((const unsigned*)((const char*)(gbase) + (voff)[_i]), (LAS unsigned*)(lds + (bufoff) + ldsw + _i * 8192), 16, 0, 0); } while (0)
#define PG8_LDA(dst, b, h) do { _Pragma("unroll") for (int m = 0; m < 4; ++m) _Pragma("unroll") for (int k = 0; k < 2; ++k) dst[m][k] = *(const LAS bf16x8*)(lds + PG8_SA(b, h) + aoff + m * 2048 + k * 1024); } while (0)
#define PG8_LDB(dst, b, h) do { _Pragma("unroll") for (int n = 0; n < 2; ++n) _Pragma("unroll") for (int k = 0; k < 2; ++k) dst[n][k] = *(const LAS bf16x8*)(lds + PG8_SB(b, h) + boff + n * 2048 + k * 1024); } while (0)
#define PG8_MMA(ai, bj, At, Bt) do { __builtin_amdgcn_s_setprio(1); _Pragma("unroll") for (int m = 0; m < 4; ++m) _Pragma("unroll") for (int n = 0; n < 2; ++n) _Pragma("unroll") for (int k = 0; k < 2; ++k) \
        acc[ai][bj][m][n] = __builtin_amdgcn_mfma_f32_16x16x32_bf16(Bt[n][k], At[m][k], acc[ai][bj][m][n], 0, 0, 0); __builtin_amdgcn_s_setprio(0); } while (0)
#define PG8_WAIT_V(n) asm volatile("s_waitcnt vmcnt(" #n ")" ::: "memory")
#define PG8_WAIT_L(n) asm volatile("s_waitcnt lgkmcnt(" #n ")" ::: "memory")
#define PG8_BAR __builtin_amdgcn_s_barrier()
#define PG8_SCHED __builtin_amdgcn_sched_barrier(0)
    Unit cur, nxt; int ui = 0;
    if (!S.next(0, cur)) return;
    f32x4 acc[2][2][4][2];
#pragma unroll
    for (int a = 0; a < 2; ++a)
#pragma unroll
        for (int b = 0; b < 2; ++b)
#pragma unroll
            for (int m = 0; m < 4; ++m)
#pragma unroll
                for (int n = 0; n < 2; ++n) acc[a][b][m][n] = (f32x4){0.f, 0.f, 0.f, 0.f};
    bf16x8 At[4][2], B0[2][2], B1[2][2];
    const char* cA; const char* cB; S.ptrs(g, cur, cA, cB);
    PG8_STAGE(PG8_SB(0, 0), cB, voffB); PG8_STAGE(PG8_SA(0, 0), cA, voffA); PG8_STAGE(PG8_SB(0, 1), cB + hstep, voffB); PG8_STAGE(PG8_SA(0, 1), cA + hstep, voffA);
    if (wr == 1) PG8_BAR;
    PG8_WAIT_V(4); PG8_BAR;
    PG8_STAGE(PG8_SB(1, 0), cB + kstep, voffB); PG8_STAGE(PG8_SA(1, 0), cA + kstep, voffA); PG8_STAGE(PG8_SB(1, 1), cB + hstep + kstep, voffB);
    PG8_WAIT_V(6); PG8_BAR;
    for (;;) {
        const bool has_next = S.next(ui + 1, nxt);
        const char* nA = cA; const char* nB = cB; if (has_next) S.ptrs(g, nxt, nA, nB);
        for (int t = 0; t < nt; t += 2) {
            const bool last = (t == nt - 2);
            const char* a1 = cA + (size_t)(t + 1) * kstep;
            const char* a2 = last ? nA : cA + (size_t)(t + 2) * kstep; const char* b2 = last ? nB : cB + (size_t)(t + 2) * kstep;
            const char* a3 = a2 + kstep; const char* b3 = b2 + kstep;
            PG8_LDB(B0, 0, 0); PG8_SCHED; PG8_LDA(At, 0, 0); PG8_STAGE(PG8_SA(1, 1), a1 + hstep, voffA);
            PG8_WAIT_L(8); PG8_BAR; PG8_WAIT_L(0); PG8_MMA(0, 0, At, B0); PG8_BAR; PG8_SCHED;
            PG8_LDB(B1, 0, 1); PG8_STAGE(PG8_SB(0, 0), b2, voffB);
            PG8_BAR; PG8_WAIT_L(0); PG8_MMA(0, 1, At, B1); PG8_BAR;
            PG8_LDA(At, 0, 1); PG8_STAGE(PG8_SA(0, 0), a2, voffA);
            PG8_BAR; PG8_WAIT_L(0); PG8_MMA(1, 0, At, B0); PG8_BAR; PG8_SCHED;
            PG8_STAGE(PG8_SB(0, 1), b2 + hstep, voffB);
            PG8_WAIT_V(6); PG8_BAR; PG8_MMA(1, 1, At, B1); PG8_BAR;
            PG8_LDB(B0, 1, 0); PG8_SCHED; PG8_LDA(At, 1, 0); PG8_STAGE(PG8_SA(0, 1), a2 + hstep, voffA);
            PG8_WAIT_L(8); PG8_BAR; PG8_WAIT_L(0); PG8_MMA(0, 0, At, B0); PG8_BAR; PG8_SCHED;
            PG8_LDB(B1, 1, 1); PG8_STAGE(PG8_SB(1, 0), b3, voffB);
            PG8_BAR; PG8_WAIT_L(0); PG8_MMA(0, 1, At, B1); PG8_BAR;
            PG8_LDA(At, 1, 1); PG8_STAGE(PG8_SA(1, 0), a3, voffA);
            PG8_BAR; PG8_WAIT_L(0); PG8_MMA(1, 0, At, B0); PG8_BAR; PG8_SCHED;
            PG8_STAGE(PG8_SB(1, 1), b3 + hstep, voffB);
            PG8_WAIT_V(6); PG8_BAR; PG8_MMA(1, 1, At, B1); PG8_BAR;
        }
        E(acc, cur, wr, wc, fr, fq);
        if (!has_next) break;
#pragma unroll
        for (int a = 0; a < 2; ++a)
#pragma unroll
            for (int b = 0; b < 2; ++b)
#pragma unroll
                for (int m = 0; m < 4; ++m)
#pragma unroll
                    for (int n = 0; n < 2; ++n) acc[a][b][m][n] = (f32x4){0.f, 0.f, 0.f, 0.f};
        cur = nxt; cA = nA; cB = nB; ++ui;
    }
    PG8_WAIT_V(0);
    if (wr == 0) PG8_BAR;
    PG8_BAR;
#undef PG8_SA
#undef PG8_SB
#undef PG8_STAGE
#undef PG8_LDA
#undef PG8_LDB
#undef PG8_MMA
#undef PG8_WAIT_V
#undef PG8_WAIT_L
#undef PG8_BAR
#undef PG8_SCHED
}

#define EPI_PERM_LOOP(...) \
    _Pragma("unroll") for (int ai = 0; ai < 2; ++ai) _Pragma("unroll") for (int m = 0; m < 4; ++m) { const int row = u.pm * BM + ai * HALF + wr * 64 + m * 16 + fr; \
        _Pragma("unroll") for (int bj = 0; bj < 2; ++bj) { const int col0 = u.pn * BM + bj * HALF + wc * 32 + 8 * fq; f32x4 v0 = acc[ai][bj][m][0], v1 = acc[ai][bj][m][1]; __VA_ARGS__ } __builtin_amdgcn_sched_barrier(0); }

struct EpiInProj {
    static constexpr bool PERM = true;
    bf16_t* P; bf16_t* halo;
    __device__ __forceinline__ void operator()(const f32x4 (&acc)[2][2][4][2], const Unit& u, int wr, int wc, int fr, int fq) const {
        const bool is_qkv = u.pn >= 8 && u.pn < 14;
        EPI_PERM_LOOP({
            u32x4 w; w.x = pk2(v0[0], v0[1]); w.y = pk2(v0[2], v0[3]); w.z = pk2(v1[0], v1[1]); w.w = pk2(v1[2], v1[3]);
            *(u32x4*)(P + (size_t)row * LDP + col0) = w;
            if (is_qkv && (row & 63) >= 61) *(u32x4*)(halo + ((size_t)(row >> 6) * 3 + ((row & 63) - 61)) * 1536 + (col0 - PC_BQKV)) = w;
        })
    }
};
__device__ __forceinline__ float lfg(float a, float lb1, float x) { const float b = lb1 + logsigf_(x), mx = fmaxf(a, b); return mx + __logf(__expf(a - mx) + __expf(b - mx)); }
struct EpiSigmoid {
    static constexpr bool PERM = true;
    bf16_t* O; int ldc;
    __device__ __forceinline__ void operator()(const f32x4 (&acc)[2][2][4][2], const Unit& u, int wr, int wc, int fr, int fq) const {
        EPI_PERM_LOOP({
            u32x4 w; w.x = pk2(sigmoidf_(v0[0]), sigmoidf_(v0[1])); w.y = pk2(sigmoidf_(v0[2]), sigmoidf_(v0[3])); w.z = pk2(sigmoidf_(v1[0]), sigmoidf_(v1[1])); w.w = pk2(sigmoidf_(v1[2]), sigmoidf_(v1[3]));
            *(u32x4*)(O + (size_t)row * ldc + col0) = w;
        })
    }
};
struct EpiBranch {
    static constexpr bool PERM = true;
    bf16_t* merged; const bf16_t* gt; int n;
    __device__ __forceinline__ void operator()(const f32x4 (&acc)[2][2][4][2], const Unit& u, int wr, int wc, int fr, int fq) const {
        EPI_PERM_LOOP({
            const u32x4 gw = *(const u32x4*)(gt + (size_t)row * 3072 + n * 1024 + col0);
            float x[8] = {v0[0] * bflo(gw.x), v0[1] * bfhi(gw.x), v0[2] * bflo(gw.y), v0[3] * bfhi(gw.y), v1[0] * bflo(gw.z), v1[1] * bfhi(gw.z), v1[2] * bflo(gw.w), v1[3] * bfhi(gw.w)};
            bf16_t* mp = merged + (size_t)row * 1024 + col0;
            if (n != 0) { const u32x4 o = *(const u32x4*)mp; x[0] += bflo(o.x); x[1] += bfhi(o.x); x[2] += bflo(o.y); x[3] += bfhi(o.y); x[4] += bflo(o.z); x[5] += bfhi(o.z); x[6] += bflo(o.w); x[7] += bfhi(o.w); }
            u32x4 w; w.x = pk2(x[0], x[1]); w.y = pk2(x[2], x[3]); w.z = pk2(x[4], x[5]); w.w = pk2(x[6], x[7]);
            *(u32x4*)mp = w;
        })
    }
};
struct EpiResidual {
    static constexpr bool PERM = false;
    float* hreal; float* hmeta;
    __device__ __forceinline__ void operator()(const f32x4 (&acc)[2][2][4][2], const Unit& u, int wr, int wc, int fr, int fq) const {
#pragma unroll
        for (int ai = 0; ai < 2; ++ai)
#pragma unroll
            for (int m = 0; m < 4; ++m) { const int row = u.pm * BM + ai * HALF + wr * 64 + m * 16 + fr;
                float* rowp = (row < NREAL ? hreal + (size_t)row * D : hmeta + (size_t)(row - NREAL) * D) + u.pn * BM + wc * 32 + 4 * fq;
#pragma unroll
                for (int bj = 0; bj < 2; ++bj)
#pragma unroll
                    for (int n = 0; n < 2; ++n) { f32x4* p = (f32x4*)(rowp + bj * HALF + n * 16); *p = *p + acc[ai][bj][m][n]; } }
    }
};
struct EpiMoeUp {
    static constexpr bool PERM = true;
    bf16_t* H;
    __device__ __forceinline__ void operator()(const f32x4 (&acc)[2][2][4][2], const Unit& u, int wr, int wc, int fr, int fq) const {
        EPI_PERM_LOOP({
            const int hc = col0 >> 1;
            u32x2 w; w.x = pk2(siluf_(v0[0]) * v1[0], siluf_(v0[1]) * v1[1]); w.y = pk2(siluf_(v0[2]) * v1[2], siluf_(v0[3]) * v1[3]);
            *(u32x2*)(H + (size_t)row * 256 + hc) = w;
        })
    }
};
struct EpiMoeDown {
    static constexpr bool PERM = true;
    bf16_t* Y; const float* wrow;
    __device__ __forceinline__ void operator()(const f32x4 (&acc)[2][2][4][2], const Unit& u, int wr, int wc, int fr, int fq) const {
        EPI_PERM_LOOP({
            const float s = wrow[row];
            u32x4 w; w.x = pk2(v0[0] * s, v0[1] * s); w.y = pk2(v0[2] * s, v0[3] * s); w.z = pk2(v1[0] * s, v1[1] * s); w.w = pk2(v1[2] * s, v1[3] * s);
            *(u32x4*)(Y + (size_t)row * 1024 + col0) = w;
        })
    }
};
}
struct Params { const float* in[24]; float* out; unsigned char* ws; int ph_lo, ph_hi; };
struct Frame {
    LAS unsigned char* lds; int tid, lane, wave, G, bid;
    float* out; unsigned char* ws; const float* const __attribute__((address_space(4)))* inp;
};
#define PHASE_FENCE(F) do { asm volatile("" : "+s"((F).ws), "+s"((F).out), "+s"((F).inp), "+v"((F).tid), "+s"((F).bid), "+s"((F).G)); \
    (F).lane = (F).tid & 63; (F).wave = __builtin_amdgcn_readfirstlane((F).tid >> 6); } while (0)
#define INP(i) (F.inp[(i)])
#define WSP(T, off) ((T*)(F.ws + (off)))
enum { I_X = 0, I_META, I_NORM_MIX, I_W_IN, I_LB, I_HGRN_NORM, I_GDN_CONV, I_GDN_ALOG, I_GDN_DT, I_GDN_NORM, I_GLA_W2, I_GLA_B, I_GLA_NORM, I_W_BRANCH, I_W_OUT, I_NORM_FFN,
       I_RG_W, I_RG_B, I_RE_W, I_RE_B, I_EW_GATE, I_EW_UP, I_EW_DOWN, I_NORM_FINAL };

__device__ __forceinline__ void transpose_item(const float* W, int ldw, int K, int nblk, bf16_t* WT, int row_off, int rowmode, LAS float* scr, int item, int lane) {
    const int kb = item / nblk, nb = item % nblk, k0 = 64 * kb, n0 = 32 * nb;
#pragma unroll 8
    for (int i = 0; i < 32; ++i) { const int kk = 2 * i + (lane >> 5); scr[kk * 33 + (lane & 31)] = W[(size_t)(k0 + kk) * ldw + n0 + (lane & 31)]; }
    LDS_WAIT(); asm volatile("" ::: "memory");
    const int c = lane & 7;
#pragma unroll
    for (int j = 0; j < 4; ++j) { const int n = (lane >> 3) + 8 * j; const LAS float* s = scr + (8 * c) * 33 + n;
        u32x4 o; o.x = pk2(s[0 * 33], s[1 * 33]); o.y = pk2(s[2 * 33], s[3 * 33]); o.z = pk2(s[4 * 33], s[5 * 33]); o.w = pk2(s[6 * 33], s[7 * 33]);
        const int nn = n0 + n; const int wrow = rowmode == 0 ? row_off + nn : row_off + 8 * (nn >> 2) + (nn & 3) + (rowmode == 2 ? 4 : 0);
        *(u32x4*)(WT + (size_t)wrow * K + k0 + 8 * c) = o; }
    LDS_WAIT(); asm volatile("" ::: "memory");
}

__device__ __forceinline__ void phase_pre(Frame& F) {
    const int gt = F.bid * NTHREADS + F.tid, NT = F.G * NTHREADS;
    float* sw1 = WSP(float, SM_SW1); float* rwg = WSP(float, SM_RWG); float* rwe = WSP(float, SM_RWE); float* lab = WSP(float, SM_LAB);
    for (int i = gt; i < 2 * 24 * 1024; i += NT) { const int l = i / (24 * 1024), c = (i / 1024) % 24, k = i % 1024;
        const int col = c < 16 ? 5128 + c : (c < 20 ? 3584 + (c - 16) : 3588 + (c - 20));
        sw1[i] = INP(I_W_IN)[((size_t)l * 1024 + k) * IN_COLS + col]; }
    for (int i = gt; i < 2 * 4 * 1024; i += NT) { const int l = i / (4 * 1024), c = (i / 1024) % 4, k = i % 1024; rwg[i] = INP(I_RG_W)[((size_t)l * 1024 + k) * 4 + c]; }
    for (int i = gt; i < 2 * 32 * 1024; i += NT) { const int l = i / (32 * 1024), c = (i / 1024) % 32, k = i % 1024; rwe[i] = INP(I_RE_W)[((size_t)l * 1024 + k) * 32 + c]; }
    for (int i = gt; i < 2 * 512; i += NT) { const int l = i / 512, c = i % 512; const float l0 = INP(I_LB)[c], l1 = INP(I_LB)[512 + c];
        const float p1 = 1.0f / (1.0f + expf(l0 - l1)); const float lb = l == 0 ? 0.f : p1;
        lab[l * 1024 + c] = logf(fmaxf(lb, 1e-30f)); lab[l * 1024 + 512 + c] = log1pf(-lb); }
}

__device__ __forceinline__ void convert_layer_weights(Frame& F, int l) {
    LAS float* scr = (LAS float*)(F.lds + F.wave * 16384);
    const int gw = F.bid * NWAVES + F.wave, NGW = F.G * NWAVES;
    const float* win = INP(I_W_IN) + (size_t)l * 1024 * IN_COLS;
    constexpr int I_MIX = 16 * 176, I_GATE = 16 * 96, I_BR = 8 * 32, I_OUT = 16 * 32, NITEMS = I_MIX + I_GATE + 3 * I_BR + I_OUT;
    for (int it = gw; it < NITEMS; it += NGW) {
        int r = it;
        if (r < I_MIX) { const int nb = r % 176, n0 = 32 * nb; const int shift = n0 < 3584 ? 0 : (n0 < 5120 ? 8 : 24);
            transpose_item(win + shift, IN_COLS, 1024, 176, WSP(bf16_t, WS_WMIX), 0, 0, scr, r, F.lane); continue; } r -= I_MIX;
        if (r < I_GATE) { transpose_item(win + 5656, IN_COLS, 1024, 96, WSP(bf16_t, WS_WGATE), 0, 0, scr, r, F.lane); continue; } r -= I_GATE;
        if (r < 3 * I_BR) { const int n = r / I_BR; transpose_item(INP(I_W_BRANCH) + ((size_t)l * 3 + n) * 512 * 1024, 1024, 512, 32, WSP(bf16_t, WS_WBT) + (size_t)n * 1024 * 512, 0, 0, scr, r % I_BR, F.lane); continue; } r -= 3 * I_BR;
        transpose_item(INP(I_W_OUT) + (size_t)l * 1024 * 1024, 1024, 1024, 32, WSP(bf16_t, WS_WOT), 0, 0, scr, r, F.lane);
    }
}
__device__ __forceinline__ void convert_expert_weights(Frame& F, int l) {
    LAS float* scr = (LAS float*)(F.lds + F.wave * 16384);
    const int gw = F.bid * NWAVES + F.wave, NGW = F.G * NWAVES;
    constexpr int I_G = 16 * 8, I_D = 4 * 32, PER = 2 * I_G + I_D;
    for (int it = gw; it < 32 * PER; it += NGW) {
        const int e = it / PER; int r = it % PER;
        bf16_t* w1t = WSP(bf16_t, WS_W1T) + (size_t)e * 512 * 1024; bf16_t* w2t = WSP(bf16_t, WS_W2T) + (size_t)e * 1024 * 256;
        if (r < I_G) { transpose_item(INP(I_EW_GATE) + ((size_t)l * 32 + e) * 1024 * 256, 256, 1024, 8, w1t, 0, 1, scr, r, F.lane); continue; } r -= I_G;
        if (r < I_G) { transpose_item(INP(I_EW_UP) + ((size_t)l * 32 + e) * 1024 * 256, 256, 1024, 8, w1t, 0, 2, scr, r, F.lane); continue; } r -= I_G;
        transpose_item(INP(I_EW_DOWN) + ((size_t)l * 32 + e) * 256 * 1024, 1024, 256, 32, w2t, 0, 0, scr, r, F.lane);
    }
}

__device__ __forceinline__ float* hrow(Frame& F, int r) { return r < NREAL ? F.out + (size_t)r * D : WSP(float, WS_HMETA) + (size_t)(r - NREAL) * D; }

__device__ __forceinline__ void load_row16(const float* p, int lane, float (&x)[16]) {
#pragma unroll
    for (int j = 0; j < 4; ++j) { const f32x4 v = *((const f32x4*)p + lane + 64 * j); x[4 * j] = v[0]; x[4 * j + 1] = v[1]; x[4 * j + 2] = v[2]; x[4 * j + 3] = v[3]; }
}
__device__ __forceinline__ void add_bf16_row16(const bf16_t* p, int lane, float (&x)[16]) {
#pragma unroll
    for (int j = 0; j < 4; ++j) { const u32x2 w = *((const u32x2*)p + lane + 64 * j); x[4 * j] += bflo(w.x); x[4 * j + 1] += bfhi(w.x); x[4 * j + 2] += bflo(w.y); x[4 * j + 3] += bfhi(w.y); }
}
__device__ __forceinline__ void store_row16(float* p, int lane, const float (&x)[16]) {
#pragma unroll
    for (int j = 0; j < 4; ++j) *((f32x4*)p + lane + 64 * j) = (f32x4){x[4 * j], x[4 * j + 1], x[4 * j + 2], x[4 * j + 3]};
}
__device__ __forceinline__ void store_bf16_row16(bf16_t* p, int lane, const float (&x)[16]) {
#pragma unroll
    for (int j = 0; j < 4; ++j) { u32x2 w; w.x = pk2(x[4 * j], x[4 * j + 1]); w.y = pk2(x[4 * j + 2], x[4 * j + 3]); *((u32x2*)p + lane + 64 * j) = w; }
}
__device__ __forceinline__ void fetch_h_row(Frame& F, int l, int r, float (&x)[16]) {
    if (l == 0) {
        const float* src = r < NREAL ? INP(I_X) + (size_t)r * D : INP(I_META) + (size_t)(r - META_ROW0) * D;
        load_row16(src, F.lane, x);
    } else {
        load_row16(hrow(F, r), F.lane, x);
        const unsigned* tok = WSP(unsigned, SM_TOK) + (size_t)r * 8;
        const unsigned g0 = tok[6], g1 = tok[7];
        add_bf16_row16(WSP(bf16_t, WS_Y2) + (size_t)g0 * 1024, F.lane, x);
        add_bf16_row16(WSP(bf16_t, WS_Y2) + (size_t)g1 * 1024, F.lane, x);
    }
}

__device__ __forceinline__ void phase_norm1(Frame& F, int l) {
    convert_layer_weights(F, l);
    __syncthreads();
    LAS float* sw = (LAS float*)F.lds;
    { const float* src = WSP(float, SM_SW1) + (size_t)l * 24 * 1024; for (int i = F.tid; i < 24 * 1024 / 4; i += NTHREADS) ((LAS f32x4*)sw)[i] = ((const f32x4*)src)[i]; }
    __syncthreads();
    const int gw = F.bid * NWAVES + F.wave, NGW = F.G * NWAVES, lane = F.lane;
    const float* nw = INP(I_NORM_MIX) + (size_t)l * D;
    float wv[16]; load_row16(nw, lane, wv);
    bf16_t* U = WSP(bf16_t, WS_U);
    for (int g = gw; g < MROWS / 4; g += NGW) {
        const int r0 = 4 * g;
        if (!row_valid(r0)) {
            float z[16];
#pragma unroll
            for (int j = 0; j < 16; ++j) z[j] = 0.f;
#pragma unroll
            for (int i = 0; i < 4; ++i) { store_bf16_row16(U + (size_t)(r0 + i) * D, lane, z); if (l == 0) store_row16(hrow(F, r0 + i), lane, z);
                if (lane < 16) WSP(float, SM_GK)[(size_t)(r0 + i) * 16 + lane] = 0.f;
                else if (lane < 20) WSP(float, SM_BETA)[(size_t)(r0 + i) * 4 + (lane - 16)] = 0.f;
                else if (lane < 24) WSP(float, SM_LOGA)[(size_t)(r0 + i) * 4 + (lane - 20)] = 0.f; }
            continue;
        }
        float x[4][16];
#pragma unroll
        for (int i = 0; i < 4; ++i) {
            fetch_h_row(F, l, r0 + i, x[i]);
            store_row16(hrow(F, r0 + i), lane, x[i]);
            float ss = 0.f;
#pragma unroll
            for (int j = 0; j < 16; ++j) ss += x[i][j] * x[i][j];
            const float rstd = rsqrtf(wave_sum(ss) * (1.0f / D) + 1e-6f);
#pragma unroll
            for (int j = 0; j < 16; ++j) x[i][j] = x[i][j] * rstd * wv[j];
            store_bf16_row16(U + (size_t)(r0 + i) * D, lane, x[i]);
        }
        float ov[4] = {0.f, 0.f, 0.f, 0.f};
#pragma unroll 1
        for (int c = 0; c < 24; ++c) {
            float a0 = 0.f, a1 = 0.f, a2 = 0.f, a3 = 0.f;
#pragma unroll
            for (int j = 0; j < 4; ++j) { const f32x4 w = *((const LAS f32x4*)(sw + c * 1024) + lane + 64 * j);
#pragma unroll
                for (int e = 0; e < 4; ++e) { a0 += x[0][4 * j + e] * w[e]; a1 += x[1][4 * j + e] * w[e]; a2 += x[2][4 * j + e] * w[e]; a3 += x[3][4 * j + e] * w[e]; } }
            a0 = wave_sum(a0); a1 = wave_sum(a1); a2 = wave_sum(a2); a3 = wave_sum(a3);
            if (lane == c) { ov[0] = a0; ov[1] = a1; ov[2] = a2; ov[3] = a3; }
        }
        float* GK = WSP(float, SM_GK); float* BETA = WSP(float, SM_BETA); float* LOGA = WSP(float, SM_LOGA);
#pragma unroll
        for (int i = 0; i < 4; ++i) {
            const float v = ov[i]; const int r = r0 + i;
            if (lane < 16) GK[(size_t)r * 16 + lane] = v;
            else if (lane < 20) BETA[(size_t)r * 4 + (lane - 16)] = sigmoidf_(v);
            else if (lane < 24) { const int h = lane - 20; LOGA[(size_t)r * 4 + h] = -expf(INP(I_GDN_ALOG)[l * 4 + h]) * softplusf_(v + INP(I_GDN_DT)[l * 4 + h]); }
        }
    }
}

__device__ __forceinline__ bf16x8 mk8(u32x4 w) { return __builtin_bit_cast(bf16x8, w); }
__device__ __forceinline__ bf16x8 mk8(u32x2 lo, u32x2 hi) { u32x4 w; w.x = lo.x; w.y = lo.y; w.z = hi.x; w.w = hi.y; return __builtin_bit_cast(bf16x8, w); }
__device__ __forceinline__ bf16x8 pack_acc2(const f32x4& a, const f32x4& b) { u32x4 w; w.x = pk2(a[0], a[1]); w.y = pk2(a[2], a[3]); w.z = pk2(b[0], b[1]); w.w = pk2(b[2], b[3]); return __builtin_bit_cast(bf16x8, w); }
#define MFMA16(a, b, c) __builtin_amdgcn_mfma_f32_16x16x32_bf16((a), (b), (c), 0, 0, 0)

template <int DK, bool IS_A>
__device__ __forceinline__ void prep_gla(Frame& F, int l, int slot, int h) {
    constexpr int NE = 64 * DK / NTHREADS;
    constexpr int QP = DK + 8;
    const int tid = F.tid, row0 = slot * 64, unit = slot * 4 + h;
    const int qcol = IS_A ? PC_AQ + h * 128 : PC_CQ + h * 64, kcol = IS_A ? PC_AF + h * 128 : PC_CK + h * 64, vcol = IS_A ? PC_AI + h * 128 : PC_CV + h * 128;
    bf16_t* P = WSP(bf16_t, WS_P);
    LAS float* bc = (LAS float*)F.lds;
    LAS bf16_t* qt = (LAS bf16_t*)(F.lds + 32768);
    LAS bf16_t* kt = qt + 64 * QP;
    LAS bf16_t* k1s = kt + 64 * QP;
    LAS bf16_t* vv = k1s + 64 * QP;
#pragma unroll 2
    for (int i = 0; i < NE; ++i) { const int e = tid + NTHREADS * i, t = e / DK, d = e % DK; float lf;
        if (IS_A) { const float* lab = WSP(float, SM_LAB) + l * 1024 + h * 128 + d; lf = pg8::lfg(lab[0], lab[512], bf2f(P[(size_t)(row0 + t) * LDP + kcol + d])); }
        else { const float* gk = WSP(float, SM_GK) + (size_t)(row0 + t) * 16; const float* w2 = INP(I_GLA_W2) + (size_t)l * 16 * 256 + h * 64 + d; float s = INP(I_GLA_B)[l * 256 + h * 64 + d];
#pragma unroll
            for (int j = 0; j < 16; ++j) s += gk[j] * w2[j * 256];
            lf = logsigf_(s) * (1.0f / 16.0f); }
        bc[t * DK + d] = lf; }
    __syncthreads();
    if (tid < DK) { float s = 0.f;
        for (int t = 0; t < 64; ++t) { s += bc[t * DK + tid]; bc[t * DK + tid] = s; }
        (IS_A ? WSP(float, SM_DECA) + (size_t)unit * 128 : WSP(float, SM_DECC) + (size_t)unit * 64)[tid] = __expf(s); }
    __syncthreads();
#pragma unroll 2
    for (int i = 0; i < NE; ++i) { const int e = tid + NTHREADS * i, t = e / DK, d = e % DK;
        const float b = bc[t * DK + d], bl = bc[63 * DK + d], rr = bc[31 * DK + d];
        bf16_t* qp = P + (size_t)(row0 + t) * LDP + qcol + d;
        const float q = IS_A ? siluf_(bf2f(*qp)) * 0.08838834764831845f : bf2f(*qp) * 0.125f;
        float k;
        if (IS_A) { const float* lab = WSP(float, SM_LAB) + l * 1024 + h * 128 + d; const float lf = pg8::lfg(lab[0], lab[512], bf2f(P[(size_t)(row0 + t) * LDP + kcol + d]));
            k = row_valid(row0 + t) ? -expm1f(lf) : 0.f; } else k = bf2f(P[(size_t)(row0 + t) * LDP + kcol + d]);
        *qp = f2bf(q * __expf(b));
        k1s[t * QP + d] = f2bf(k * __expf(bl - b));
        qt[t * QP + d] = f2bf(q * __expf(fminf(b - rr, 80.f)));
        kt[t * QP + d] = f2bf(k * __expf(fminf(rr - b, 80.f))); }
#pragma unroll 4
    for (int i = 0; i < 16; ++i) { const int e = tid + NTHREADS * i, s = e / 128, c = e % 128; vv[s * 136 + c] = P[(size_t)(row0 + s) * LDP + vcol + c]; }
    __syncthreads();
    for (int it = tid; it < DK * 8; it += NTHREADS) { const int d = it >> 3, oc = it & 7; unsigned short x[8];
#pragma unroll
        for (int j = 0; j < 8; ++j) x[j] = k1s[(8 * oc + j) * QP + d];
        u32x4 w; w.x = x[0] | (x[1] << 16); w.y = x[2] | (x[3] << 16); w.z = x[4] | (x[5] << 16); w.w = x[6] | (x[7] << 16);
        bf16_t* dst = IS_A ? P + (size_t)(row0 + (d >> 1)) * LDP + kcol + (d & 1) * 64 + 8 * oc : P + (size_t)(row0 + d) * LDP + kcol + 8 * oc;
        *(u32x4*)dst = w; }
    for (int it = tid; it < 128 * 8; it += NTHREADS) { const int c = it >> 3, oc = it & 7; unsigned short x[8];
#pragma unroll
        for (int j = 0; j < 8; ++j) x[j] = vv[(8 * oc + j) * 136 + c];
        u32x4 w; w.x = x[0] | (x[1] << 16); w.y = x[2] | (x[3] << 16); w.z = x[4] | (x[5] << 16); w.w = x[6] | (x[7] << 16);
        *(u32x4*)(P + (size_t)(row0 + (c >> 1)) * LDP + vcol + (c & 1) * 64 + 8 * oc) = w; }
    { const int w = F.wave, lane = F.lane, fr = lane & 15, fq = lane >> 4, mt = w >> 1;
        bf16_t* sc = (IS_A ? WSP(bf16_t, WS_SCA) : WSP(bf16_t, WS_SCC)) + (size_t)unit * 4096;
#pragma unroll
        for (int jn = 0; jn < 2; ++jn) { const int nt = (w & 1) * 2 + jn; f32x4 acc = {0.f, 0.f, 0.f, 0.f};
#pragma unroll
            for (int ks = 0; ks < DK / 32; ++ks) {
                const bf16x8 a = *(const LAS bf16x8*)(qt + (16 * mt + fr) * QP + 32 * ks + 8 * fq), b = *(const LAS bf16x8*)(kt + (16 * nt + fr) * QP + 32 * ks + 8 * fq);
                acc = MFMA16(a, b, acc); }
#pragma unroll
            for (int r = 0; r < 4; ++r) { const int t = 16 * mt + 4 * fq + r, s = 16 * nt + fr; sc[t * 64 + s] = (s <= t) ? f2bf(acc[r]) : (bf16_t)0; } }
    }
    __syncthreads();
}

__device__ __forceinline__ void prep_gdn(Frame& F, int l, int slot, int h) {
    const int tid = F.tid, lane = F.lane, row0 = slot * 64, unit = slot * 4 + h;
    bf16_t* P = WSP(bf16_t, WS_P);
    constexpr int NP = 136;
    LAS bf16_t* raw = (LAS bf16_t*)F.lds;
    LAS bf16_t* qn = (LAS bf16_t*)(F.lds + 17152);
    LAS bf16_t* kn = (LAS bf16_t*)(F.lds + 17152 + 17408);
    LAS float* kf = (LAS float*)(F.lds + 51968);
    LAS float* vf = (LAS float*)(F.lds + 51968 + 32768);
    LAS float* Am = (LAS float*)(F.lds + 51968 + 65536);
    LAS float* gs = (LAS float*)(F.lds + 51968 + 65536 + 17408);
    LAS float* cw = gs + 192;
    if (tid < 64) { float g = WSP(float, SM_LOGA)[(size_t)(row0 + tid) * 4 + h];
#pragma unroll
        for (int o = 1; o < 64; o <<= 1) { const float t = __shfl_up(g, o); if (lane >= o) g += t; }
        gs[tid] = g; gs[64 + tid] = WSP(float, SM_BETA)[(size_t)(row0 + tid) * 4 + h];
        if (tid == 63) WSP(float, SM_DECB)[unit] = __expf(g); }
    const int hslot = slot == 256 ? -1 : ((slot & 63) == 0 ? 256 : slot - 1);
    for (int comp = 0; comp < 3; ++comp) {
        const int col = PC_BQKV + comp * 512 + h * 128, ch0 = comp * 512 + h * 128;
        __syncthreads();
        for (int i = tid; i < 67 * 128; i += NTHREADS) { const int rr = i >> 7, c = i & 127; bf16_t v;
            if (rr < 3) v = hslot < 0 ? (bf16_t)0 : WSP(bf16_t, SM_HALO)[((size_t)hslot * 3 + rr) * 1536 + ch0 + c];
            else v = P[(size_t)(row0 + rr - 3) * LDP + col + c];
            raw[i] = v; }
        if (tid < 512) { const int j = tid >> 7, c = tid & 127; cw[tid] = INP(I_GDN_CONV)[((size_t)l * 4 + j) * 1536 + ch0 + c]; }
        __syncthreads();
        LAS float* dst = comp == 2 ? vf : kf;
#pragma unroll 2
        for (int i = 0; i < 16; ++i) { const int e = tid + NTHREADS * i, t = e >> 7, c = e & 127;
            const float x = cw[c] * bf2f(raw[t * 128 + c]) + cw[128 + c] * bf2f(raw[(t + 1) * 128 + c]) + cw[256 + c] * bf2f(raw[(t + 2) * 128 + c]) + cw[384 + c] * bf2f(raw[(t + 3) * 128 + c]);
            dst[t * 128 + c] = siluf_(x); }
        __syncthreads();
        if (comp < 2) {
            { const int t = tid >> 3, sub = tid & 7; float ss = 0.f;
#pragma unroll
                for (int j = 0; j < 16; ++j) { const float x = kf[t * 128 + sub * 16 + j]; ss += x * x; }
                ss += __shfl_xor(ss, 1); ss += __shfl_xor(ss, 2); ss += __shfl_xor(ss, 4);
                if (sub == 0) gs[128 + t] = rsqrtf(ss + 1e-6f); }
            __syncthreads();
#pragma unroll 2
            for (int i = 0; i < 16; ++i) { const int e = tid + NTHREADS * i, t = e >> 7, c = e & 127;
                const float x = kf[t * 128 + c] * gs[128 + t];
                if (comp == 0) qn[t * NP + c] = f2bf(x * 0.08838834764831845f); else { kf[t * 128 + c] = x; kn[t * NP + c] = f2bf(x); } }
        }
    }
    __syncthreads();
    { const float gl = gs[63];
        for (int it = tid; it < 128 * 8; it += NTHREADS) { const int d = it >> 3, oc = it & 7; float y[8];
#pragma unroll
            for (int j = 0; j < 8; ++j) y[j] = kf[(8 * oc + j) * 128 + d] * __expf(gl - gs[8 * oc + j]);
            u32x4 w; w.x = pk2(y[0], y[1]); w.y = pk2(y[2], y[3]); w.z = pk2(y[4], y[5]); w.w = pk2(y[6], y[7]);
            *(u32x4*)(WSP(bf16_t, WS_K1TB) + (size_t)unit * 8192 + d * 64 + 8 * oc) = w; }
#pragma unroll 2
        for (int i = 0; i < 16; ++i) { const int e = tid + NTHREADS * i, t = e >> 7, c = e & 127;
            P[(size_t)(row0 + t) * LDP + PC_BQKV + h * 128 + c] = f2bf(bf2f(qn[t * NP + c]) * __expf(gs[t])); }
    }
    { const int w = F.wave, fr = lane & 15, fq = lane >> 4;
        bf16_t* qkd = WSP(bf16_t, WS_QKD) + (size_t)unit * 4096;
#pragma unroll
        for (int jt = 0; jt < 4; ++jt) { const int tile = w * 4 + jt, which = tile >> 4, mt = (tile >> 2) & 3, nt = tile & 3;
            const LAS bf16_t* ap = which ? qn : kn; f32x4 acc = {0.f, 0.f, 0.f, 0.f};
#pragma unroll
            for (int ks = 0; ks < 4; ++ks) { const bf16x8 a = *(const LAS bf16x8*)(ap + (16 * mt + fr) * NP + 32 * ks + 8 * fq), b = *(const LAS bf16x8*)(kn + (16 * nt + fr) * NP + 32 * ks + 8 * fq); acc = MFMA16(a, b, acc); }
#pragma unroll
            for (int r = 0; r < 4; ++r) { const int t = 16 * mt + 4 * fq + r, s = 16 * nt + fr; const float dec = __expf(fminf(gs[t] - gs[s], 0.f));
                if (which) qkd[t * 64 + s] = (s <= t) ? f2bf(acc[r] * dec) : (bf16_t)0;
                else Am[s * 68 + t] = (s < t) ? gs[64 + t] * acc[r] * dec : 0.f; } }
    }
    __syncthreads();
#pragma unroll 2
    for (int i = 0; i < 16; ++i) { const int e = tid + NTHREADS * i, t = e >> 7; const float bt = gs[64 + t]; vf[e] *= bt; kf[e] *= bt * __expf(gs[t]); }
    __syncthreads();
    if (tid < 256) {
        LAS float* xs = (tid < 128 ? vf : kf) + (tid & 127);
#pragma unroll 1
        for (int ib = 0; ib < 4; ++ib) {
            float r[16];
#pragma unroll
            for (int ii = 0; ii < 16; ++ii) r[ii] = xs[(16 * ib + ii) * 128];
            const LAS float* at = Am + 16 * ib;
#pragma unroll 1
            for (int j = 0; j < 16 * ib; ++j) { const float xj = xs[j * 128];
                const f32x4 a0 = *(const LAS f32x4*)(at + j * 68), a1 = *(const LAS f32x4*)(at + j * 68 + 4), a2 = *(const LAS f32x4*)(at + j * 68 + 8), a3 = *(const LAS f32x4*)(at + j * 68 + 12);
                r[0] -= a0[0] * xj; r[1] -= a0[1] * xj; r[2] -= a0[2] * xj; r[3] -= a0[3] * xj; r[4] -= a1[0] * xj; r[5] -= a1[1] * xj; r[6] -= a1[2] * xj; r[7] -= a1[3] * xj;
                r[8] -= a2[0] * xj; r[9] -= a2[1] * xj; r[10] -= a2[2] * xj; r[11] -= a2[3] * xj; r[12] -= a3[0] * xj; r[13] -= a3[1] * xj; r[14] -= a3[2] * xj; r[15] -= a3[3] * xj; }
#pragma unroll
            for (int jj = 0; jj < 15; ++jj) { const LAS float* ar = at + (16 * ib + jj) * 68;
#pragma unroll
                for (int q4 = 0; q4 < 4; ++q4) { if (4 * q4 + 3 > jj) { const f32x4 a = *(const LAS f32x4*)(ar + 4 * q4);
#pragma unroll
                    for (int e = 0; e < 4; ++e) if (4 * q4 + e > jj) r[4 * q4 + e] -= a[e] * r[jj]; } } }
#pragma unroll
            for (int ii = 0; ii < 16; ++ii) xs[(16 * ib + ii) * 128] = r[ii];
        }
    }
    __syncthreads();
    for (int it = tid; it < 128 * 8; it += NTHREADS) { const int c = it >> 3, oc = it & 7; float y[8];
#pragma unroll
        for (int j = 0; j < 8; ++j) y[j] = vf[(8 * oc + j) * 128 + c];
        u32x4 w; w.x = pk2(y[0], y[1]); w.y = pk2(y[2], y[3]); w.z = pk2(y[4], y[5]); w.w = pk2(y[6], y[7]);
        *(u32x4*)(P + (size_t)(row0 + (c >> 1)) * LDP + PC_BQKV + 1024 + h * 128 + (c & 1) * 64 + 8 * oc) = w; }
#pragma unroll 2
    for (int i = 0; i < 16; ++i) { const int e = tid + NTHREADS * i, t = e >> 7, c = e & 127; P[(size_t)(row0 + t) * LDP + PC_BQKV + 512 + h * 128 + c] = f2bf(kf[e]); }
    __syncthreads();
}

__device__ __forceinline__ void phase_prep(Frame& F, int l) {
    for (int u = F.bid; u < NSLOT * 12; u += F.G) { const int slot = u / 12, r = u % 12, mixer = r >> 2, h = r & 3;
        if (mixer == 0) prep_gla<128, true>(F, l, slot, h);
        else if (mixer == 1) prep_gdn(F, l, slot, h);
        else prep_gla<64, false>(F, l, slot, h);
    }
}
__device__ __forceinline__ bf16x8 ld_perm(const bf16_t* rowp, int k0, int fq) { const u32x2 lo = *(const u32x2*)(rowp + k0 + 4 * fq), hi = *(const u32x2*)(rowp + k0 + 16 + 4 * fq); return mk8(lo, hi); }
__device__ __forceinline__ bf16x8 ld_nat(const bf16_t* rowp, int k0, int fq) { return mk8(*(const u32x4*)(rowp + k0 + 8 * fq)); }

template <int DK, bool IS_A>
__device__ __forceinline__ void scan_gla(Frame& F, int b, int h) {
    constexpr int NT = DK / 16;
    const int w = F.wave, lane = F.lane, fr = lane & 15, fq = lane >> 4, ecol = 16 * w + fr;
    const int qcol = IS_A ? PC_AQ + h * 128 : PC_CQ + h * 64, kcol = IS_A ? PC_AF + h * 128 : PC_CK + h * 64, vcol = IS_A ? PC_AI + h * 128 : PC_CV + h * 128;
    const bf16_t* P = WSP(bf16_t, WS_P);
    const bf16_t* SC = IS_A ? WSP(bf16_t, WS_SCA) : WSP(bf16_t, WS_SCC);
    const float* DEC = IS_A ? WSP(float, SM_DECA) : WSP(float, SM_DECC);
    bf16_t* O = WSP(bf16_t, WS_O) + (size_t)(IS_A ? 0 : 2) * MROWS * 512;
    f32x4 S[NT];
#pragma unroll
    for (int i = 0; i < NT; ++i) S[i] = (f32x4){0.f, 0.f, 0.f, 0.f};
    for (int step = 0; step < 65; ++step) {
        const int slot = step == 0 ? 256 : b * 64 + step - 1, row0 = slot * 64, unit = slot * 4 + h;
        const bf16_t* vtp = P + (size_t)(row0 + (ecol >> 1)) * LDP + vcol + (ecol & 1) * 64;
        bf16x8 bv[2]; bv[0] = ld_nat(vtp, 0, fq); bv[1] = ld_nat(vtp, 32, fq);
        bf16x8 Sb[NT / 2];
#pragma unroll
        for (int kp = 0; kp < NT / 2; ++kp) Sb[kp] = pack_acc2(S[2 * kp], S[2 * kp + 1]);
#pragma unroll
        for (int mt = 0; mt < 4; ++mt) {
            f32x4 acc = {0.f, 0.f, 0.f, 0.f};
            const bf16_t* qrow = P + (size_t)(row0 + 16 * mt + fr) * LDP + qcol;
#pragma unroll
            for (int kp = 0; kp < NT / 2; ++kp) acc = MFMA16(ld_perm(qrow, 32 * kp, fq), Sb[kp], acc);
            const bf16_t* srow = SC + (size_t)unit * 4096 + (16 * mt + fr) * 64;
#pragma unroll
            for (int ks = 0; ks < 2; ++ks) acc = MFMA16(ld_nat(srow, 32 * ks, fq), bv[ks], acc);
#pragma unroll
            for (int r = 0; r < 4; ++r) O[(size_t)(row0 + 16 * mt + 4 * fq + r) * 512 + h * 128 + ecol] = f2bf(acc[r]);
        }
        const float* dec = DEC + (size_t)unit * DK;
#pragma unroll
        for (int i = 0; i < NT; ++i) {
            const f32x4 d4 = *(const f32x4*)(dec + 16 * i + 4 * fq);
            S[i] = S[i] * d4;
            const int d = 16 * i + fr;
            const bf16_t* krow = IS_A ? P + (size_t)(row0 + (d >> 1)) * LDP + kcol + (d & 1) * 64 : P + (size_t)(row0 + d) * LDP + kcol;
#pragma unroll
            for (int ks = 0; ks < 2; ++ks) S[i] = MFMA16(ld_nat(krow, 32 * ks, fq), bv[ks], S[i]);
        }
    }
}
__device__ __forceinline__ void scan_gdn(Frame& F, int b, int h) {
    const int w = F.wave, lane = F.lane, fr = lane & 15, fq = lane >> 4, ecol = 16 * w + fr;
    const bf16_t* P = WSP(bf16_t, WS_P);
    bf16_t* O = WSP(bf16_t, WS_O) + (size_t)MROWS * 512;
    const int qcol = PC_BQKV + h * 128, wcol = PC_BQKV + 512 + h * 128, ucol = PC_BQKV + 1024 + h * 128;
    f32x4 S[8];
#pragma unroll
    for (int i = 0; i < 8; ++i) S[i] = (f32x4){0.f, 0.f, 0.f, 0.f};
    for (int step = 0; step < 65; ++step) {
        const int slot = step == 0 ? 256 : b * 64 + step - 1, row0 = slot * 64, unit = slot * 4 + h;
        bf16x8 Sb[4];
#pragma unroll
        for (int kp = 0; kp < 4; ++kp) Sb[kp] = pack_acc2(S[2 * kp], S[2 * kp + 1]);
        f32x4 vn[4];
        const bf16_t* utp = P + (size_t)(row0 + (ecol >> 1)) * LDP + ucol + (ecol & 1) * 64;
#pragma unroll
        for (int mt = 0; mt < 4; ++mt) {
            f32x4 acc = {0.f, 0.f, 0.f, 0.f};
            const bf16_t* wrow = P + (size_t)(row0 + 16 * mt + fr) * LDP + wcol;
#pragma unroll
            for (int kp = 0; kp < 4; ++kp) acc = MFMA16(ld_perm(wrow, 32 * kp, fq), Sb[kp], acc);
            const u32x2 uw = *(const u32x2*)(utp + 16 * mt + 4 * fq);
            vn[mt] = (f32x4){bflo(uw.x) - acc[0], bfhi(uw.x) - acc[1], bflo(uw.y) - acc[2], bfhi(uw.y) - acc[3]};
        }
        bf16x8 Vb[2]; Vb[0] = pack_acc2(vn[0], vn[1]); Vb[1] = pack_acc2(vn[2], vn[3]);
#pragma unroll
        for (int mt = 0; mt < 4; ++mt) {
            f32x4 acc = {0.f, 0.f, 0.f, 0.f};
            const bf16_t* qrow = P + (size_t)(row0 + 16 * mt + fr) * LDP + qcol;
#pragma unroll
            for (int kp = 0; kp < 4; ++kp) acc = MFMA16(ld_perm(qrow, 32 * kp, fq), Sb[kp], acc);
            const bf16_t* srow = WSP(bf16_t, WS_QKD) + (size_t)unit * 4096 + (16 * mt + fr) * 64;
#pragma unroll
            for (int kp = 0; kp < 2; ++kp) acc = MFMA16(ld_perm(srow, 32 * kp, fq), Vb[kp], acc);
#pragma unroll
            for (int r = 0; r < 4; ++r) O[(size_t)(row0 + 16 * mt + 4 * fq + r) * 512 + h * 128 + ecol] = f2bf(acc[r]);
        }
        const float a = WSP(float, SM_DECB)[unit];
#pragma unroll
        for (int i = 0; i < 8; ++i) {
            S[i] = S[i] * a;
            const bf16_t* krow = WSP(bf16_t, WS_K1TB) + (size_t)unit * 8192 + (16 * i + fr) * 64;
#pragma unroll
            for (int kp = 0; kp < 2; ++kp) S[i] = MFMA16(ld_perm(krow, 32 * kp, fq), Vb[kp], S[i]);
        }
    }
}
__device__ __forceinline__ void phase_scan(Frame& F) {
    if (F.bid >= 48) return;
    const int mixer = F.bid >> 4, b = (F.bid >> 2) & 3, h = F.bid & 3;
    if (mixer == 0) scan_gla<128, true>(F, b, h);
    else if (mixer == 1) scan_gdn(F, b, h);
    else scan_gla<64, false>(F, b, h);
}

__device__ __forceinline__ void phase_hnorm(Frame& F, int l) {
    const int gw = F.bid * NWAVES + F.wave, NGW = F.G * NWAVES, lane = F.lane;
    const bf16_t* P = WSP(bf16_t, WS_P);
    for (int it = gw; it < MROWS * 3; it += NGW) {
        const int r = it / 3, mx = it % 3;
        bf16_t* op = WSP(bf16_t, WS_O) + (size_t)mx * MROWS * 512 + (size_t)r * 512 + 8 * lane;
        if (!row_valid(r)) { *(u32x4*)op = (u32x4){0u, 0u, 0u, 0u}; continue; }
        const int gcol = mx == 0 ? PC_AG : (mx == 1 ? PC_BG : PC_CG);
        const float* nwb = mx == 0 ? INP(I_HGRN_NORM) : (mx == 1 ? INP(I_GDN_NORM) : INP(I_GLA_NORM)); const float* nw = nwb + (size_t)l * 128 + (8 * lane & 127);
        const u32x4 ow = *(const u32x4*)op, gw4 = *(const u32x4*)(P + (size_t)r * LDP + gcol + 8 * lane);
        float o[8] = {bflo(ow.x), bfhi(ow.x), bflo(ow.y), bfhi(ow.y), bflo(ow.z), bfhi(ow.z), bflo(ow.w), bfhi(ow.w)};
        const float g[8] = {siluf_(bflo(gw4.x)), siluf_(bfhi(gw4.x)), siluf_(bflo(gw4.y)), siluf_(bfhi(gw4.y)), siluf_(bflo(gw4.z)), siluf_(bfhi(gw4.z)), siluf_(bflo(gw4.w)), siluf_(bfhi(gw4.w))};
        float ss = 0.f;
#pragma unroll
        for (int j = 0; j < 8; ++j) ss += o[j] * o[j];
        ss += __shfl_xor(ss, 1); ss += __shfl_xor(ss, 2); ss += __shfl_xor(ss, 4); ss += __shfl_xor(ss, 8);
        const float rstd = rsqrtf(ss * (1.0f / 128.0f) + 1e-6f);
        const f32x4 n0 = *(const f32x4*)nw, n1 = *(const f32x4*)(nw + 4);
        const float nv[8] = {n0[0], n0[1], n0[2], n0[3], n1[0], n1[1], n1[2], n1[3]};
#pragma unroll
        for (int j = 0; j < 8; ++j) o[j] = o[j] * rstd * nv[j] * g[j];
        u32x4 y; y.x = pk2(o[0], o[1]); y.y = pk2(o[2], o[3]); y.z = pk2(o[4], o[5]); y.w = pk2(o[6], o[7]);
        *(u32x4*)op = y;
    }
}

__device__ __forceinline__ void phase_norm2(Frame& F, int l) {
    convert_expert_weights(F, l);
    __syncthreads();
    LAS float* sw = (LAS float*)F.lds;
    { const float* src = WSP(float, SM_RWE) + (size_t)l * 32 * 1024; for (int i = F.tid; i < 32 * 1024 / 4; i += NTHREADS) ((LAS f32x4*)sw)[i] = ((const f32x4*)src)[i]; }
    __syncthreads();
    const int gw = F.bid * NWAVES + F.wave, NGW = F.G * NWAVES, lane = F.lane;
    float wv[16]; load_row16(INP(I_NORM_FFN) + (size_t)l * D, lane, wv);
    bf16_t* U = WSP(bf16_t, WS_U);
    const float* rwg = WSP(float, SM_RWG) + (size_t)l * 4 * 1024;
    unsigned* cnt = WSP(unsigned, WS_CTL) + CW_CNT + l * 64;
    for (int g = gw; g < MROWS / 4; g += NGW) {
        const int r0 = 4 * g;
        if (!row_valid(r0)) continue;
        float x[4][16];
#pragma unroll
        for (int i = 0; i < 4; ++i) {
            load_row16(hrow(F, r0 + i), lane, x[i]);
            float ss = 0.f;
#pragma unroll
            for (int j = 0; j < 16; ++j) ss += x[i][j] * x[i][j];
            const float rstd = rsqrtf(wave_sum(ss) * (1.0f / D) + 1e-6f);
#pragma unroll
            for (int j = 0; j < 16; ++j) x[i][j] = x[i][j] * rstd * wv[j];
            store_bf16_row16(U + (size_t)(r0 + i) * D, lane, x[i]);
        }
        float lg[4][4];
#pragma unroll
        for (int c = 0; c < 4; ++c) {
            float a0 = 0.f, a1 = 0.f, a2 = 0.f, a3 = 0.f;
#pragma unroll
            for (int j = 0; j < 4; ++j) { const f32x4 w = *((const f32x4*)(rwg + c * 1024) + lane + 64 * j);
#pragma unroll
                for (int e = 0; e < 4; ++e) { a0 += x[0][4 * j + e] * w[e]; a1 += x[1][4 * j + e] * w[e]; a2 += x[2][4 * j + e] * w[e]; a3 += x[3][4 * j + e] * w[e]; } }
            const float bg = INP(I_RG_B)[l * 4 + c];
            lg[0][c] = wave_sum(a0) + bg; lg[1][c] = wave_sum(a1) + bg; lg[2][c] = wave_sum(a2) + bg; lg[3][c] = wave_sum(a3) + bg;
        }
#pragma unroll
        for (int i = 0; i < 4; ++i) {
            int gi = 0; float gm = lg[i][0];
#pragma unroll
            for (int c = 1; c < 4; ++c) if (lg[i][c] > gm) { gm = lg[i][c]; gi = c; }
            float gsum = 0.f;
#pragma unroll
            for (int c = 0; c < 4; ++c) gsum += __expf(lg[i][c] - gm);
            const float gval = 1.0f / gsum;
            gi = __builtin_amdgcn_readfirstlane(gi);
            int ea = 0, eb = 0; float la = -3.0e38f, lb = -3.0e38f;
#pragma unroll 1
            for (int c = 0; c < 8; ++c) {
                float a = 0.f;
#pragma unroll
                for (int j = 0; j < 4; ++j) { const f32x4 w = *((const LAS f32x4*)(sw + (gi * 8 + c) * 1024) + lane + 64 * j);
#pragma unroll
                    for (int e = 0; e < 4; ++e) a += x[i][4 * j + e] * w[e]; }
                const float el = wave_sum(a) + INP(I_RE_B)[l * 32 + gi * 8 + c];
                if (el > la) { lb = la; eb = ea; la = el; ea = c; } else if (el > lb) { lb = el; eb = c; }
            }
            const float wa = 1.0f / (1.0f + __expf(lb - la)), wb = 1.0f - wa;
            if (lane == 0) {
                const unsigned e0 = (unsigned)(gi * 8 + ea), e1 = (unsigned)(gi * 8 + eb);
                const unsigned p0 = atomicAdd(cnt + e0, 1u), p1 = atomicAdd(cnt + e1, 1u);
                unsigned* tok = WSP(unsigned, SM_TOK) + (size_t)(r0 + i) * 8;
                tok[0] = e0; tok[1] = p0; tok[2] = e1; tok[3] = p1; tok[4] = __float_as_uint(gval * wa); tok[5] = __float_as_uint(gval * wb);
            }
        }
    }
}

__device__ __forceinline__ int moe_tables(Frame& F, int l) {
    LAS int* offs = (LAS int*)(F.lds + LDS_TAB); LAS unsigned char* tab = (LAS unsigned char*)(F.lds + LDS_TAB + 384); LAS int* cn = (LAS int*)(F.lds + LDS_TAB + 192);
    const unsigned* cnt = WSP(unsigned, WS_CTL) + CW_CNT + l * 64;
    __syncthreads();
    if (F.tid < 32) cn[F.tid] = (int)__hip_atomic_load(cnt + F.tid, __ATOMIC_RELAXED, __HIP_MEMORY_SCOPE_AGENT);
    __syncthreads();
    if (F.tid == 0) { int acc = 0;
#pragma unroll 1
        for (int e = 0; e < 32; ++e) { offs[e] = acc; acc += ((cn[e] + 255) >> 8) << 8; }
        offs[32] = acc; }
    __syncthreads();
    if (F.tid < 160) { const int row = F.tid << 8; int e = 0;
#pragma unroll 1
        for (int k = 1; k < 32; ++k) if (offs[k] <= row) e = k;
        tab[F.tid] = (unsigned char)e; }
    __syncthreads();
    return offs[32] >> 8;
}

__device__ __forceinline__ void phase_gather(Frame& F, int l) {
    (void)moe_tables(F, l);
    const LAS int* offs = (const LAS int*)(F.lds + LDS_TAB); const LAS int* cn = (const LAS int*)(F.lds + LDS_TAB + 192);
    const int gw = F.bid * NWAVES + F.wave, NGW = F.G * NWAVES, lane = F.lane;
    const bf16_t* U = WSP(bf16_t, WS_U); bf16_t* XG = WSP(bf16_t, WS_XG); float* wrow = WSP(float, SM_WROW);
    for (int idx = gw; idx < NREAL + 16; idx += NGW) {
        const int r = idx < NREAL ? idx : META_ROW0 + (idx - NREAL);
        unsigned* tok = WSP(unsigned, SM_TOK) + (size_t)r * 8;
        const unsigned e0 = tok[0], p0 = tok[1], e1 = tok[2], p1 = tok[3];
        const unsigned g0 = (unsigned)offs[e0] + p0, g1 = (unsigned)offs[e1] + p1;
        if (lane == 0) { tok[6] = g0; tok[7] = g1; wrow[g0] = __uint_as_float(tok[4]); wrow[g1] = __uint_as_float(tok[5]); }
        const u32x4* src = (const u32x4*)(U + (size_t)r * D);
        const u32x4 a = src[lane], b = src[lane + 64];
        u32x4* d0 = (u32x4*)(XG + (size_t)g0 * D); u32x4* d1 = (u32x4*)(XG + (size_t)g1 * D);
        d0[lane] = a; d0[lane + 64] = b; d1[lane] = a; d1[lane + 64] = b;
    }
    for (int i = gw; i < 32 * 256; i += NGW) { const int e = i >> 8, j = i & 255; const int row = offs[e] + cn[e] + j;
        if (row < offs[e + 1]) { u32x4* d = (u32x4*)(XG + (size_t)row * D); d[lane] = (u32x4){0u, 0u, 0u, 0u}; d[lane + 64] = (u32x4){0u, 0u, 0u, 0u}; if (lane == 0) wrow[row] = 0.f; } }
}

__device__ __forceinline__ void phase_final(Frame& F) {
    const int gw = F.bid * NWAVES + F.wave, NGW = F.G * NWAVES, lane = F.lane;
    float wv[16]; load_row16(INP(I_NORM_FINAL), lane, wv);
    for (int r = gw; r < NREAL; r += NGW) {
        float x[16]; fetch_h_row(F, 2, r, x);
        float ss = 0.f;
#pragma unroll
        for (int j = 0; j < 16; ++j) ss += x[j] * x[j];
        const float rstd = rsqrtf(wave_sum(ss) * (1.0f / D) + 1e-6f);
#pragma unroll
        for (int j = 0; j < 16; ++j) x[j] = x[j] * rstd * wv[j];
        store_row16(F.out + (size_t)r * D, lane, x);
    }
}
constexpr int PH_PER_LAYER = 14, N_PHASES = 2 + 2 * PH_PER_LAYER;
#ifndef DBG_STOP
#define DBG_STOP 0
#endif
#ifndef DBG_SRC
#define DBG_SRC WS_P
#define DBG_LD LDP
#endif
#ifndef MK_ONE_LAUNCH
#define MK_ONE_LAUNCH 1
#endif

template <unsigned PHMASK_T>
__global__ void __launch_bounds__(NTHREADS, 2) hybrid_fwd(Params p) {
    extern __shared__ __attribute__((aligned(16))) unsigned char lds_raw[];
    Frame F;
    F.lds = (LAS unsigned char*)lds_raw; F.tid = threadIdx.x; F.lane = F.tid & 63; F.wave = __builtin_amdgcn_readfirstlane(F.tid >> 6); F.G = gridDim.x; F.bid = blockIdx.x;
    F.out = p.out; F.ws = p.ws; F.inp = (const float* const __attribute__((address_space(4)))*)__builtin_amdgcn_kernarg_segment_ptr();
    volatile LAS unsigned* MISC = (volatile LAS unsigned*)(F.lds + LDS_MISC);
    if (F.tid < 128) MISC[F.tid] = 0u;
    __syncthreads();
    const int lo = p.ph_lo, hi = p.ph_hi;
    XcdBarrier bar; bar.bar = WSP(unsigned, WS_CTL) + CW_BAR; bar.x = 0; bar.st = MISC + 8;
    if (hi - lo > 1) bar = xcd_barrier_post(WSP(unsigned, WS_CTL) + CW_BAR, MISC + 8);
#define EN(j) ((PHMASK_T >> (j)) & 1u)
#define IN(k) (lo <= (k) && (k) < hi)
#define SEAM(k) do { if (IN(k) && IN((k) + 1)) xcd_barrier(bar.bar, bar.x, bar.st); PHASE_FENCE(F); } while (0)
    PHASE_FENCE(F);
    if (EN(15) && IN(0)) phase_pre(F);
    SEAM(0);
    for (int l = 0; l < 2; ++l) {
        const int pb = 1 + PH_PER_LAYER * l;
        if (EN(0) && IN(pb + 0)) phase_norm1(F, l);
        SEAM(pb + 0);
        if (EN(1) && IN(pb + 1)) {
            pg8::Gemm g{WSP(bf16_t, WS_U), WSP(bf16_t, WS_WMIX), MROWS, LDP, D}; pg8::StaticOrder S; S.init(MROWS, LDP, F.G, F.bid);
            pg8::EpiInProj E{WSP(bf16_t, WS_P), WSP(bf16_t, SM_HALO)};
            pg8::gemm_phase(F.lds, F.tid, g, S, E);
        }
        SEAM(pb + 1);
        if (EN(2) && IN(pb + 2)) phase_prep(F, l);
        SEAM(pb + 2);
        if (EN(3) && IN(pb + 3)) phase_scan(F);
        SEAM(pb + 3);
        if (EN(4) && IN(pb + 4)) phase_hnorm(F, l);
        SEAM(pb + 4);
        if (EN(5) && IN(pb + 5)) {
            pg8::Gemm g{WSP(bf16_t, WS_U), WSP(bf16_t, WS_WGATE), MROWS, 3072, D}; pg8::StaticOrder S; S.init(MROWS, 3072, F.G, F.bid);
            pg8::EpiSigmoid E{WSP(bf16_t, WS_GT), 3072};
            pg8::gemm_phase(F.lds, F.tid, g, S, E);
        }
        SEAM(pb + 5);
        for (int n = 0; n < 3; ++n) {
            if (EN(6) && IN(pb + 6 + n)) {
                pg8::Gemm g{WSP(bf16_t, WS_O) + (size_t)n * MROWS * 512, WSP(bf16_t, WS_WBT) + (size_t)n * 1024 * 512, MROWS, D, 512}; pg8::StaticOrder S; S.init(MROWS, D, F.G, F.bid);
                pg8::EpiBranch E{WSP(bf16_t, WS_MERGED), WSP(bf16_t, WS_GT), n};
                pg8::gemm_phase(F.lds, F.tid, g, S, E);
            }
            SEAM(pb + 6 + n);
        }
        if (EN(9) && IN(pb + 9)) {
            pg8::Gemm g{WSP(bf16_t, WS_MERGED), WSP(bf16_t, WS_WOT), MROWS, D, D}; pg8::StaticOrder S; S.init(MROWS, D, F.G, F.bid);
            pg8::EpiResidual E{F.out, WSP(float, WS_HMETA)};
            pg8::gemm_phase(F.lds, F.tid, g, S, E);
        }
        SEAM(pb + 9);
        if (EN(10) && IN(pb + 10)) phase_norm2(F, l);
        SEAM(pb + 10);
        if (EN(11) && IN(pb + 11)) phase_gather(F, l);
        SEAM(pb + 11);
        if (EN(12) && IN(pb + 12)) {
            const int ntiles = moe_tables(F, l);
            pg8::Gemm g{WSP(bf16_t, WS_XG), WSP(bf16_t, WS_W1T), XG_ROWS, 512, D};
            pg8::MoeOrder S{F.G, F.bid, 2, ntiles, (const LAS unsigned char*)(F.lds + LDS_TAB + 384), (size_t)512 * 1024 * 2};
            pg8::EpiMoeUp E{WSP(bf16_t, WS_HG)};
            pg8::gemm_phase(F.lds, F.tid, g, S, E);
        }
        SEAM(pb + 12);
        if (EN(13) && IN(pb + 13)) {
            const int ntiles = moe_tables(F, l);
            pg8::Gemm g{WSP(bf16_t, WS_HG), WSP(bf16_t, WS_W2T), XG_ROWS, D, 256};
            pg8::MoeOrder S{F.G, F.bid, 4, ntiles, (const LAS unsigned char*)(F.lds + LDS_TAB + 384), (size_t)1024 * 256 * 2};
            pg8::EpiMoeDown E{WSP(bf16_t, WS_Y2), WSP(float, SM_WROW)};
            pg8::gemm_phase(F.lds, F.tid, g, S, E);
        }
        SEAM(pb + 13);
    }
#if DBG_STOP > 0
    if (EN(14) && IN(N_PHASES - 1)) { const int gt = F.bid * NTHREADS + F.tid, NT = F.G * NTHREADS;
#ifdef DBG_LIN
        { const bf16_t* s1 = WSP(bf16_t, DBG_SRC); const bf16_t* s2 = WSP(bf16_t, DBG_SRC2);
          for (size_t i = gt; i < (size_t)NREAL * D; i += NT) F.out[i] = i < (size_t)DBG_N1 ? bf2f(s1[i]) : (i < (size_t)DBG_N1 + DBG_N2 ? bf2f(s2[i - DBG_N1]) : 0.f); }
#else
        if (DBG_LD > 0) { const bf16_t* src = WSP(bf16_t, DBG_SRC); for (size_t i = gt; i < (size_t)NREAL * D; i += NT) { const size_t r = i >> 10, c = i & 1023; F.out[i] = bf2f(src[r * DBG_LD + (c * DBG_LD) / 1024]); } }
#endif
    }
#else
    if (EN(14) && IN(N_PHASES - 1)) phase_final(F);
#endif
#undef IN
#undef SEAM
}

#if MK_ONE_LAUNCH
constexpr unsigned KMASK[1] = {0xffffffffu};
#else
constexpr unsigned KMASK[3] = {0x0C19u, 0xC004u, 0x3262u};
#endif
template <unsigned M> static bool setup_kernel(int& per_cu) {
    if (hipFuncSetAttribute((const void*)hybrid_fwd<M>, hipFuncAttributeMaxDynamicSharedMemorySize, LDS_BYTES) != hipSuccess) return false;
    if (hipOccupancyMaxActiveBlocksPerMultiprocessor(&per_cu, (const void*)hybrid_fwd<M>, NTHREADS, LDS_BYTES) != hipSuccess) per_cu = 0;
    (void)hipGetLastError();
    return true;
}
static int phase_kind(int k) { if (k == 0) return 15; if (k == N_PHASES - 1) return 14; const int j = (k - 1) % PH_PER_LAYER; return (j >= 6 && j <= 8) ? 6 : j; }
extern "C" void kernel_launch(void* const* d_in, const int* in_sizes, int n_in, void* d_out, int out_size, void* d_ws, size_t ws_size, hipStream_t stream) {
    static int grid = 0;
    if (grid == 0) {
        if (n_in != 24 || in_sizes[0] != NREAL * D || out_size != NREAL * D || ws_size < WS_END) {
            fprintf(stderr, "kernel_launch: unexpected problem (n_in %d, in0 %d, out %d, ws %zu < %zu); nothing launched\n", n_in, n_in > 0 ? in_sizes[0] : -1, out_size, ws_size, (size_t)WS_END); grid = -1; return; }
        int dev = 0, cus = 0, per_cu = 0; bool ok = true;
        if (hipGetDevice(&dev) != hipSuccess || hipDeviceGetAttribute(&cus, hipDeviceAttributeMultiprocessorCount, dev) != hipSuccess) { grid = -1; return; }
#if MK_ONE_LAUNCH
        ok = setup_kernel<KMASK[0]>(per_cu);
#else
        ok = setup_kernel<KMASK[0]>(per_cu) && setup_kernel<KMASK[1]>(per_cu) && setup_kernel<KMASK[2]>(per_cu);
#endif
        if (!ok) { fprintf(stderr, "kernel_launch: hipFuncSetAttribute failed\n"); grid = -1; return; }
        if (per_cu < 1) fprintf(stderr, "kernel_launch: occupancy query says %d\n", per_cu);
        grid = cus;
    }
    if (grid < 0) return;
    if (hipMemsetAsync((char*)d_ws + WS_CTL, 0, CTL_BYTES, stream) != hipSuccess) return;
    Params p{};
    for (int i = 0; i < 24; ++i) p.in[i] = (const float*)d_in[i];
    p.out = (float*)d_out; p.ws = (unsigned char*)d_ws;
#if MK_ONE_LAUNCH
    p.ph_lo = 0; p.ph_hi = N_PHASES;
    hipLaunchKernelGGL(hybrid_fwd<KMASK[0]>, dim3(grid), dim3(NTHREADS), LDS_BYTES, stream, p);
#else
    for (int k = 0; k < N_PHASES; ++k) { if (DBG_STOP > 0 && k >= DBG_STOP && k != N_PHASES - 1) continue; p.ph_lo = k; p.ph_hi = k + 1; const unsigned bit = 1u << phase_kind(k);
        if (KMASK[0] & bit) hipLaunchKernelGGL(hybrid_fwd<KMASK[0]>, dim3(grid), dim3(NTHREADS), LDS_BYTES, stream, p);
        else if (KMASK[1] & bit) hipLaunchKernelGGL(hybrid_fwd<KMASK[1]>, dim3(grid), dim3(NTHREADS), LDS_BYTES, stream, p);
        else hipLaunchKernelGGL(hybrid_fwd<KMASK[2]>, dim3(grid), dim3(NTHREADS), LDS_BYTES, stream, p); }
#endif
}
```

```cpp
#include <hip/hip_runtime.h>
#include <cstdio>
#include <cstdint>

#define LAS __attribute__((address_space(3)))
typedef unsigned short bf16_t;
typedef short bf16x8 __attribute__((ext_vector_type(8)));
typedef float f32x4 __attribute__((ext_vector_type(4)));
typedef float f32x2 __attribute__((ext_vector_type(2)));
typedef unsigned u32x4 __attribute__((ext_vector_type(4)));
typedef unsigned u32x2 __attribute__((ext_vector_type(2)));

constexpr int D = 1024, NREAL = 16384, MROWS = 16640, META_ROW0 = 16384 + 48, META_END = 16384 + 64;
constexpr int NSLOT = 257;
constexpr int LDP = 5632;
constexpr int PC_AQ = 0, PC_AF = 512, PC_AI = 1024, PC_AG = 1536, PC_BQKV = 2048, PC_BG = 3584, PC_CQ = 4096, PC_CK = 4352, PC_CV = 4608, PC_CG = 5120;
constexpr int IN_COLS = 8728;
constexpr int NTHREADS = 512, NWAVES = 8;
constexpr int XG_ROWS = 40960;

constexpr size_t MiB = 1ull << 20;
constexpr size_t WS_CTL = 0, CTL_BYTES = 1 * MiB;
constexpr int CW_BAR = 4096, CW_CNT = 1024;
constexpr size_t SM_SW1 = 1 * MiB;
constexpr size_t SM_RWG = SM_SW1 + 2 * 24 * 1024 * 4;
constexpr size_t SM_RWE = SM_RWG + 2 * 4 * 1024 * 4;
constexpr size_t SM_LAB = SM_RWE + 2 * 32 * 1024 * 4;
constexpr size_t SM_GK = SM_LAB + 2 * 2 * 512 * 4;
constexpr size_t SM_BETA = SM_GK + (size_t)MROWS * 16 * 4;
constexpr size_t SM_LOGA = SM_BETA + (size_t)MROWS * 4 * 4;
constexpr size_t SM_TOK = SM_LOGA + (size_t)MROWS * 4 * 4;
constexpr size_t SM_WROW = SM_TOK + (size_t)MROWS * 8 * 4;
constexpr size_t SM_DECA = SM_WROW + (size_t)XG_ROWS * 4;
constexpr size_t SM_DECC = SM_DECA + 1028 * 128 * 4;
constexpr size_t SM_DECB = SM_DECC + 1028 * 64 * 4;
constexpr size_t SM_HALO = SM_DECB + 8192;
constexpr size_t SM_END = SM_HALO + 260 * 3 * 1536 * 2;
static_assert(SM_END <= 8 * MiB, "small region");
constexpr size_t WS_HMETA = 8 * MiB;
constexpr size_t WS_WMIX = 9 * MiB;
constexpr size_t WS_WGATE = 20 * MiB;
constexpr size_t WS_WBT = 26 * MiB;
constexpr size_t WS_WOT = 29 * MiB;
constexpr size_t WS_O = 31 * MiB;
constexpr size_t O_STRIDE = (size_t)MROWS * 512 * 2;
constexpr size_t WS_W1T = 31 * MiB;
constexpr size_t WS_W2T = 63 * MiB;
constexpr size_t WS_U = 80 * MiB;
constexpr size_t WS_P = 113 * MiB;
constexpr size_t WS_GT = 113 * MiB;
constexpr size_t WS_MERGED = 211 * MiB;
constexpr size_t WS_XG = 113 * MiB;
constexpr size_t WS_HG = 193 * MiB;
constexpr size_t WS_Y2 = 213 * MiB;
constexpr size_t WS_SCA = 294 * MiB;
constexpr size_t WS_QKD = 303 * MiB;
constexpr size_t WS_SCC = 312 * MiB;
constexpr size_t WS_K1TB = 321 * MiB;
constexpr size_t WS_END = 338 * MiB;

constexpr int LDS_BYTES = 147456;
constexpr int LDS_MISC = LDS_BYTES - 512;
constexpr int LDS_TAB = LDS_BYTES - 1536;
constexpr int LDS_SCRATCH = LDS_TAB;

typedef __bf16 bf16x2v __attribute__((ext_vector_type(2)));
__device__ __forceinline__ unsigned pk2(float lo, float hi) { const f32x2 v = {lo, hi}; return __builtin_bit_cast(unsigned, __builtin_convertvector(v, bf16x2v)); }
__device__ __forceinline__ bf16_t f2bf(float f) { return (bf16_t)(pk2(f, 0.f) & 0xffffu); }
__device__ __forceinline__ float bf2f(bf16_t b) { return __uint_as_float(((unsigned)b) << 16); }
__device__ __forceinline__ float bflo(unsigned w) { return __uint_as_float(w << 16); }
__device__ __forceinline__ float bfhi(unsigned w) { return __uint_as_float(w & 0xffff0000u); }
__device__ __forceinline__ float sigmoidf_(float x) { return 1.0f / (1.0f + __expf(-x)); }
__device__ __forceinline__ float siluf_(float x) { return x / (1.0f + __expf(-x)); }
__device__ __forceinline__ float logsigf_(float x) { return fminf(x, 0.f) - log1pf(__expf(-fabsf(x))); }
__device__ __forceinline__ float softplusf_(float x) { return fmaxf(x, 0.f) + log1pf(__expf(-fabsf(x))); }
__device__ __forceinline__ bool row_valid(int r) { return r < NREAL || (r >= META_ROW0 && r < META_END); }
__device__ __forceinline__ float wave_sum(float v) {
#pragma unroll
    for (int o = 1; o < 64; o <<= 1) v += __shfl_xor(v, o);
    return v;
}
#define LDS_WAIT() asm volatile("s_waitcnt lgkmcnt(0)" ::: "memory")

#define XB_TMO      128
#define XB_XCNT(j)  (256  + 64 * (j))
#define XB_XSUB(j)  (1280 + 64 * (j))
#define XB_XGEN(j)  (2304 + 64 * (j))
#define XB_TOP      3328
#define XB_TOPGEN   3392
#define XCD_BAR_WORDS 3456
#define XB_SPIN_CAP (1u << 18)
__device__ __forceinline__ unsigned xb_ld(unsigned* p)              { return __hip_atomic_load(p, __ATOMIC_RELAXED, __HIP_MEMORY_SCOPE_AGENT); }
__device__ __forceinline__ unsigned xb_add(unsigned* p, unsigned v) { return __hip_atomic_fetch_add(p, v, __ATOMIC_RELAXED, __HIP_MEMORY_SCOPE_AGENT); }
__device__ __forceinline__ unsigned xb_xcc_id() { return (unsigned)__builtin_amdgcn_s_getreg((3 << 11) | 20) & 0xFu; }
#define XB_SPIN(cond, bar) do { unsigned _sp = 0; while (cond) { __builtin_amdgcn_s_sleep(1); \
    if ((++_sp & 255u) == 0u) { if (xb_ld(&(bar)[XB_TMO])) break; if (_sp > XB_SPIN_CAP) { atomicAdd(&(bar)[XB_TMO], 1u); break; } } } } while (0)
struct XcdBarrier { unsigned* bar; unsigned x; volatile LAS unsigned* st; };
__device__ __forceinline__ XcdBarrier xcd_barrier_post(unsigned* bar, volatile LAS unsigned* st) {
    XcdBarrier b; b.bar = bar; b.x = xb_xcc_id(); b.st = st;
    if (threadIdx.x == 0) (void)xb_add(&bar[XB_XCNT(b.x)], 1u);
    return b;
}
__device__ __forceinline__ void xcd_barrier_complete(unsigned* bar, unsigned x, unsigned& nloc, unsigned& nx) {
    const unsigned G = gridDim.x * gridDim.y * gridDim.z;
    unsigned sum, cnt, mine, sp = 0u;
    for (;;) {
        sum = 0u; cnt = 0u; mine = 0u;
#pragma unroll
        for (unsigned j = 0; j < 16; ++j) { const unsigned c = xb_ld(&bar[XB_XCNT(j)]); sum += c; cnt += (c > 0u) ? 1u : 0u; mine = (j == x) ? c : mine; }
        if (sum == G) break;
        __builtin_amdgcn_s_sleep(1);
        if ((++sp & 255u) == 0u) { if (xb_ld(&bar[XB_TMO])) break; if (sp > XB_SPIN_CAP) { atomicAdd(&bar[XB_TMO], 1u); break; } }
    }
    nloc = mine > 0u ? mine : 1u; nx = cnt > 0u ? cnt : 1u;
}
__device__ __attribute__((noinline)) void xcd_barrier(unsigned* bar_, unsigned x_, volatile LAS unsigned* st_) {
    XcdBarrier b; b.bar = bar_; b.x = x_; b.st = st_;
    asm volatile("s_waitcnt vmcnt(0)" ::: "memory");
    __syncthreads();
    if (threadIdx.x == 0) {
        unsigned* bar = b.bar;
        __builtin_amdgcn_s_waitcnt(0);
        unsigned nloc = b.st[0], nx = b.st[1];
        if (nloc == 0u) { xcd_barrier_complete(bar, b.x, nloc, nx); b.st[0] = nloc; b.st[1] = nx; }
        const unsigned old = xb_add(&bar[XB_XSUB(b.x)], 1u);
        const unsigned gen = old / nloc;
        if (old + 1u == (gen + 1u) * nloc) {
            __builtin_amdgcn_fence(__ATOMIC_RELEASE, "agent");
            asm volatile("s_waitcnt vmcnt(0)" ::: "memory");
            const unsigned og = xb_add(&bar[XB_TOP], 1u);
            const unsigned tg = og / nx;
            if (og + 1u == (tg + 1u) * nx) xb_add(&bar[XB_TOPGEN], 1u);
            else XB_SPIN(xb_ld(&bar[XB_TOPGEN]) == tg, bar);
            __builtin_amdgcn_fence(__ATOMIC_ACQUIRE, "agent");
            xb_add(&bar[XB_XGEN(b.x)], 1u);
            asm volatile("s_waitcnt vmcnt(0)" ::: "memory");
        } else {
            XB_SPIN(xb_ld(&bar[XB_XGEN(b.x)]) == gen, bar);
            __builtin_amdgcn_fence(__ATOMIC_ACQUIRE, "agent");
            asm volatile("s_waitcnt vmcnt(0)" ::: "memory");
        }
    }
    __syncthreads();
}
namespace pg8 {
constexpr int BM = 256, BK = 64, HALF = 128, HTB = HALF * BK * 2, STAGE_BYTES = 8 * HTB, NXCD = 8, WGM = 8;
__host__ __device__ __forceinline__ int lds_byte(int r, int c) { const int st = (r >> 4) * 2 + (c >> 5), rr = r & 15, cc = c & 31, ob = rr * 64 + cc * 2; return st * 1024 + (ob ^ (((ob >> 9) & 1) << 5)); }
__host__ __device__ __forceinline__ void stage_rc(int b, int& R, int& C) { const int st = b / 1024, sb = b % 1024, swz = sb ^ (((sb >> 9) & 1) << 5); R = (st >> 1) * 16 + swz / 64; C = (st & 1) * 32 + (swz % 64) / 2; }
__host__ __device__ __forceinline__ int perm32(int rho) { const int n = rho >> 4, i = rho & 15; return 8 * (i >> 2) + 4 * n + (i & 3); }

struct Unit { int pm, pn, ex; };
struct Gemm { const bf16_t* A; const bf16_t* Bt; int M, N, K; };

struct StaticOrder {
    int nM, nN, nwg, G, c;
    __device__ void init(int M, int N, int G_, int c_) { nM = M / BM; nN = N / BM; nwg = nM * nN; G = G_; c = c_; }
    __device__ bool next(int i, Unit& u) const {
        const long L = (long)i * G + c; if (L >= nwg) return false;
        int wgid = (int)L; { const int q = nwg / NXCD, r = nwg % NXCD, xcd = wgid % NXCD, off = wgid / NXCD; wgid = (xcd < r ? xcd * (q + 1) : r * (q + 1) + (xcd - r) * q) + off; }
        const int nig = WGM * nN, gid = wgid / nig, fm = gid * WGM, gsz = (nM - fm) < WGM ? (nM - fm) : WGM;
        u.pm = fm + ((wgid % nig) % gsz); u.pn = (wgid % nig) / gsz; u.ex = 0; return true;
    }
    __device__ __forceinline__ void ptrs(const Gemm& g, const Unit& u, const char*& a, const char*& b) const {
        const size_t tstep = (size_t)BM * g.K * 2; a = (const char*)g.A + (size_t)u.pm * tstep; b = (const char*)g.Bt + (size_t)u.pn * tstep; }
};
struct MoeOrder {
    int G, c, npn, ntiles; const LAS unsigned char* tab; size_t estride;
    __device__ bool next(int i, Unit& u) const {
        const long L = (long)i * G + c; if (L >= (long)ntiles * npn) return false;
        u.pm = (int)(L / npn); u.pn = (int)(L % npn); u.ex = (int)tab[u.pm]; return true;
    }
    __device__ __forceinline__ void ptrs(const Gemm& g, const Unit& u, const char*& a, const char*& b) const {
        const size_t tstep = (size_t)BM * g.K * 2; a = (const char*)g.A + (size_t)u.pm * tstep; b = (const char*)g.Bt + (size_t)u.ex * estride + (size_t)u.pn * tstep; }
};

template <class Epi, class Sched>
__device__ __forceinline__ void gemm_phase(LAS unsigned char* lds, const int tid, const Gemm g, const Sched& S, const Epi& E) {
    const int wid = __builtin_amdgcn_readfirstlane(tid >> 6), lane = tid & 63, wr = wid >> 2, wc = wid & 3, fr = lane & 15, fq = lane >> 4;
    int K = g.K; asm volatile("" : "+s"(K));
    const int nt = K / BK;
    unsigned voffA[2], voffB[2];
#pragma unroll
    for (int i = 0; i < 2; ++i) { int R, C; stage_rc(tid * 16 + i * 8192, R, C); const int Rb = Epi::PERM ? ((R & ~31) + perm32(R & 31)) : R;
        voffA[i] = (unsigned)(R * K + C) * 2u; voffB[i] = (unsigned)(Rb * K + C) * 2u; }
    const size_t kstep = (size_t)(BK * 2);
    const size_t hstep = (size_t)HALF * K * 2;
    const unsigned ldsw = (unsigned)wid * 1024u;
    const int aoff = lds_byte(wr * 64 + fr, fq * 8), boff = lds_byte(wc * 32 + fr, fq * 8);
#define PG8_SA(b, h) (((b) * 2 + (h)) * HTB)
#define PG8_SB(b, h) ((4 + (b) * 2 + (h)) * HTB)
#define PG8_STAGE(bufoff, gbase, voff) do { _Pragma("unroll") for (int _i = 0; _i < 2; ++_i) \
        __builtin_amdgcn_global_load_lds((const unsigned*)((const char*)(gbase) + (voff)[_i]), (LAS unsigned*)(lds + (bufoff) + ldsw + _i * 8192), 16, 0, 0); } while (0)
#define PG8_LDA(dst, b, h) do { _Pragma("unroll") for (int m = 0; m < 4; ++m) _Pragma("unroll") for (int k = 0; k < 2; ++k) dst[m][k] = *(const LAS bf16x8*)(lds + PG8_SA(b, h) + aoff + m * 2048 + k * 1024); } while (0)
#define PG8_LDB(dst, b, h) do { _Pragma("unroll") for (int n = 0; n < 2; ++n) _Pragma("unroll") for (int k = 0; k < 2; ++k) dst[n][k] = *(const LAS bf16x8*)(lds + PG8_SB(b, h) + boff + n * 2048 + k * 1024); } while (0)
#define PG8_MMA(ai, bj, At, Bt) do { __builtin_amdgcn_s_setprio(1); _Pragma("unroll") for (int m = 0; m < 4; ++m) _Pragma("unroll") for (int n = 0; n < 2; ++n) _Pragma("unroll") for (int k = 0; k < 2; ++k) \
        acc[ai][bj][m][n] = __builtin_amdgcn_mfma_f32_16x16x32_bf16(Bt[n][k], At[m][k], acc[ai][bj][m][n], 0, 0, 0); __builtin_amdgcn_s_setprio(0); } while (0)
#define PG8_WAIT_V(n) asm volatile("s_waitcnt vmcnt(" #n ")" ::: "memory")
#define PG8_WAIT_L(n) asm volatile("s_waitcnt lgkmcnt(" #n ")" ::: "memory")
#define PG8_BAR __builtin_amdgcn_s_barrier()
#define PG8_SCHED __builtin_amdgcn_sched_barrier(0)
    Unit cur, nxt; int ui = 0;
    if (!S.next(0, cur)) return;
    f32x4 acc[2][2][4][2];
#pragma unroll
    for (int a = 0; a < 2; ++a)
#pragma unroll
        for (int b = 0; b < 2; ++b)
#pragma unroll
            for (int m = 0; m < 4; ++m)
#pragma unroll
                for (int n = 0; n < 2; ++n) acc[a][b][m][n] = (f32x4){0.f, 0.f, 0.f, 0.f};
    bf16x8 At[4][2], B0[2][2], B1[2][2];
    const char* cA; const char* cB; S.ptrs(g, cur, cA, cB);
    PG8_STAGE(PG8_SB(0, 0), cB, voffB); PG8_STAGE(PG8_SA(0, 0), cA, voffA); PG8_STAGE(PG8_SB(0, 1), cB + hstep, voffB); PG8_STAGE(PG8_SA(0, 1), cA + hstep, voffA);
    if (wr == 1) PG8_BAR;
    PG8_WAIT_V(4); PG8_BAR;
    PG8_STAGE(PG8_SB(1, 0), cB + kstep, voffB); PG8_STAGE(PG8_SA(1, 0), cA + kstep, voffA); PG8_STAGE(PG8_SB(1, 1), cB + hstep + kstep, voffB);
    PG8_WAIT_V(6); PG8_BAR;
    for (;;) {
        const bool has_next = S.next(ui + 1, nxt);
        const char* nA = cA; const char* nB = cB; if (has_next) S.ptrs(g, nxt, nA, nB);
        for (int t = 0; t < nt; t += 2) {
            const bool last = (t == nt - 2);
            const char* a1 = cA + (size_t)(t + 1) * kstep;
            const char* a2 = last ? nA : cA + (size_t)(t + 2) * kstep; const char* b2 = last ? nB : cB + (size_t)(t + 2) * kstep;
            const char* a3 = a2 + kstep; const char* b3 = b2 + kstep;
            PG8_LDB(B0, 0, 0); PG8_SCHED; PG8_LDA(At, 0, 0); PG8_STAGE(PG8_SA(1, 1), a1 + hstep, voffA);
            PG8_WAIT_L(8); PG8_BAR; PG8_WAIT_L(0); PG8_MMA(0, 0, At, B0); PG8_BAR; PG8_SCHED;
            PG8_LDB(B1, 0, 1); PG8_STAGE(PG8_SB(0, 0), b2, voffB);
            PG8_BAR; PG8_WAIT_L(0); PG8_MMA(0, 1, At, B1); PG8_BAR;
            PG8_LDA(At, 0, 1); PG8_STAGE(PG8_SA(0, 0), a2, voffA);
            PG8_BAR; PG8_WAIT_L(0); PG8_MMA(1, 0, At, B0); PG8_BAR; PG8_SCHED;
            PG8_STAGE(PG8_SB(0, 1), b2 + hstep, voffB);
            PG8_WAIT_V(6); PG8_BAR; PG8_MMA(1, 1, At, B1); PG8_BAR;
            PG8_LDB(B0, 1, 0); PG8_SCHED; PG8_LDA(At, 1, 0); PG8_STAGE(PG8_SA(0, 1), a2 + hstep, voffA);
            PG8_WAIT_L(8); PG8_BAR; PG8_WAIT_L(0); PG8_MMA(0, 0, At, B0); PG8_BAR; PG8_SCHED;
            PG8_LDB(B1, 1, 1); PG8_STAGE(PG8_SB(1, 0), b3, voffB);
            PG8_BAR; PG8_WAIT_L(0); PG8_MMA(0, 1, At, B1); PG8_BAR;
            PG8_LDA(At, 1, 1); PG8_STAGE(PG8_SA(1, 0), a3, voffA);
            PG8_BAR; PG8_WAIT_L(0); PG8_MMA(1, 0, At, B0); PG8_BAR; PG8_SCHED;
            PG8_STAGE(PG8_SB(1, 1), b3 + hstep, voffB);
            PG8_WAIT_V(6); PG8_BAR; PG8_MMA(1, 1, At, B1); PG8_BAR;
        }
        E(acc, cur, wr, wc, fr, fq);
        if (!has_next) break;
#pragma unroll
        for (int a = 0; a < 2; ++a)
#pragma unroll
            for (int b = 0; b < 2; ++b)
#pragma unroll
                for (int m = 0; m < 4; ++m)
#pragma unroll
                    for (int n = 0; n < 2; ++n) acc[a][b][m][n] = (f32x4){0.f, 0.f, 0.f, 0.f};
        cur = nxt; cA = nA; cB = nB; ++ui;
    }
    PG8_WAIT_V(0);
    if (wr == 0) PG8_BAR;
    PG8_BAR;
#undef PG8_SA
#undef PG8_SB
#undef PG8_STAGE
#undef PG8_LDA
#undef PG8_LDB
#undef PG8_MMA
#undef PG8_WAIT_V
#undef PG8_WAIT_L
#undef PG8_BAR
#undef PG8_SCHED
}

#define EPI_PERM_LOOP(...) \
    _Pragma("unroll") for (int ai = 0; ai < 2; ++ai) _Pragma("unroll") for (int m = 0; m < 4; ++m) { const int row = u.pm * BM + ai * HALF + wr * 64 + m * 16 + fr; \
        _Pragma("unroll") for (int bj = 0; bj < 2; ++bj) { const int col0 = u.pn * BM + bj * HALF + wc * 32 + 8 * fq; f32x4 v0 = acc[ai][bj][m][0], v1 = acc[ai][bj][m][1]; __VA_ARGS__ } __builtin_amdgcn_sched_barrier(0); }

struct EpiInProj {
    static constexpr bool PERM = true;
    bf16_t* P; bf16_t* halo;
    __device__ __forceinline__ void operator()(const f32x4 (&acc)[2][2][4][2], const Unit& u, int wr, int wc, int fr, int fq) const {
        const bool is_qkv = u.pn >= 8 && u.pn < 14;
        EPI_PERM_LOOP({
            u32x4 w; w.x = pk2(v0[0], v0[1]); w.y = pk2(v0[2], v0[3]); w.z = pk2(v1[0], v1[1]); w.w = pk2(v1[2], v1[3]);
            *(u32x4*)(P + (size_t)row * LDP + col0) = w;
            if (is_qkv && (row & 63) >= 61) *(u32x4*)(halo + ((size_t)(row >> 6) * 3 + ((row & 63) - 61)) * 1536 + (col0 - PC_BQKV)) = w;
        })
    }
};
__device__ __forceinline__ float lfg(float a, float lb1, float x) { const float b = lb1 + logsigf_(x), mx = fmaxf(a, b); return mx + __logf(__expf(a - mx) + __expf(b - mx)); }
struct EpiSigmoid {
    static constexpr bool PERM = true;
    bf16_t* O; int ldc;
    __device__ __forceinline__ void operator()(const f32x4 (&acc)[2][2][4][2], const Unit& u, int wr, int wc, int fr, int fq) const {
        EPI_PERM_LOOP({
            u32x4 w; w.x = pk2(sigmoidf_(v0[0]), sigmoidf_(v0[1])); w.y = pk2(sigmoidf_(v0[2]), sigmoidf_(v0[3])); w.z = pk2(sigmoidf_(v1[0]), sigmoidf_(v1[1])); w.w = pk2(sigmoidf_(v1[2]), sigmoidf_(v1[3]));
            *(u32x4*)(O + (size_t)row * ldc + col0) = w;
        })
    }
};
struct EpiBranch {
    static constexpr bool PERM = true;
    bf16_t* merged; const bf16_t* gt; int n;
    __device__ __forceinline__ void operator()(const f32x4 (&acc)[2][2][4][2], const Unit& u, int wr, int wc, int fr, int fq) const {
        EPI_PERM_LOOP({
            const u32x4 gw = *(const u32x4*)(gt + (size_t)row * 3072 + n * 1024 + col0);
            float x[8] = {v0[0] * bflo(gw.x), v0[1] * bfhi(gw.x), v0[2] * bflo(gw.y), v0[3] * bfhi(gw.y), v1[0] * bflo(gw.z), v1[1] * bfhi(gw.z), v1[2] * bflo(gw.w), v1[3] * bfhi(gw.w)};
            bf16_t* mp = merged + (size_t)row * 1024 + col0;
            if (n != 0) { const u32x4 o = *(const u32x4*)mp; x[0] += bflo(o.x); x[1] += bfhi(o.x); x[2] += bflo(o.y); x[3] += bfhi(o.y); x[4] += bflo(o.z); x[5] += bfhi(o.z); x[6] += bflo(o.w); x[7] += bfhi(o.w); }
            u32x4 w; w.x = pk2(x[0], x[1]); w.y = pk2(x[2], x[3]); w.z = pk2(x[4], x[5]); w.w = pk2(x[6], x[7]);
            *(u32x4*)mp = w;
        })
    }
};
struct EpiResidual {
    static constexpr bool PERM = false;
    float* hreal; float* hmeta;
    __device__ __forceinline__ void operator()(const f32x4 (&acc)[2][2][4][2], const Unit& u, int wr, int wc, int fr, int fq) const {
#pragma unroll
        for (int ai = 0; ai < 2; ++ai)
#pragma unroll
            for (int m = 0; m < 4; ++m) { const int row = u.pm * BM + ai * HALF + wr * 64 + m * 16 + fr;
                float* rowp = (row < NREAL ? hreal + (size_t)row * D : hmeta + (size_t)(row - NREAL) * D) + u.pn * BM + wc * 32 + 4 * fq;
#pragma unroll
                for (int bj = 0; bj < 2; ++bj)
#pragma unroll
                    for (int n = 0; n < 2; ++n) { f32x4* p = (f32x4*)(rowp + bj * HALF + n * 16); *p = *p + acc[ai][bj][m][n]; } }
    }
};
struct EpiMoeUp {
    static constexpr bool PERM = true;
    bf16_t* H;
    __device__ __forceinline__ void operator()(const f32x4 (&acc)[2][2][4][2], const Unit& u, int wr, int wc, int fr, int fq) const {
        EPI_PERM_LOOP({
            const int hc = col0 >> 1;
            u32x2 w; w.x = pk2(siluf_(v0[0]) * v1[0], siluf_(v0[1]) * v1[1]); w.y = pk2(siluf_(v0[2]) * v1[2], siluf_(v0[3]) * v1[3]);
            *(u32x2*)(H + (size_t)row * 256 + hc) = w;
        })
    }
};
struct EpiMoeDown {
    static constexpr bool PERM = true;
    bf16_t* Y; const float* wrow;
    __device__ __forceinline__ void operator()(const f32x4 (&acc)[2][2][4][2], const Unit& u, int wr, int wc, int fr, int fq) const {
        EPI_PERM_LOOP({
            const float s = wrow[row];
            u32x4 w; w.x = pk2(v0[0] * s, v0[1] * s); w.y = pk2(v0[2] * s, v0[3] * s); w.z = pk2(v1[0] * s, v1[1] * s); w.w = pk2(v1[2] * s, v1[3] * s);
            *(u32x4*)(Y + (size_t)row * 1024 + col0) = w;
        })
    }
};
}
struct Params { const float* in[24]; float* out; unsigned char* ws; int ph_lo, ph_hi; };
struct Frame {
    LAS unsigned char* lds; int tid, lane, wave, G, bid;
    float* out; unsigned char* ws; const float* const __attribute__((address_space(4)))* inp;
};
#define PHASE_FENCE(F) do { asm volatile("" : "+s"((F).ws), "+s"((F).out), "+s"((F).inp), "+v"((F).tid), "+s"((F).bid), "+s"((F).G)); \
    (F).lane = (F).tid & 63; (F).wave = __builtin_amdgcn_readfirstlane((F).tid >> 6); } while (0)
#define INP(i) (F.inp[(i)])
#define WSP(T, off) ((T*)(F.ws + (off)))
enum { I_X = 0, I_META, I_NORM_MIX, I_W_IN, I_LB, I_HGRN_NORM, I_GDN_CONV, I_GDN_ALOG, I_GDN_DT, I_GDN_NORM, I_GLA_W2, I_GLA_B, I_GLA_NORM, I_W_BRANCH, I_W_OUT, I_NORM_FFN,
       I_RG_W, I_RG_B, I_RE_W, I_RE_B, I_EW_GATE, I_EW_UP, I_EW_DOWN, I_NORM_FINAL };

__device__ __forceinline__ void transpose_item(const float* W, int ldw, int K, int nblk, bf16_t* WT, int row_off, int rowmode, LAS float* scr, int item, int lane) {
    const int kb = item / nblk, nb = item % nblk, k0 = 64 * kb, n0 = 32 * nb;
#pragma unroll 8
    for (int i = 0; i < 32; ++i) { const int kk = 2 * i + (lane >> 5); scr[kk * 33 + (lane & 31)] = W[(size_t)(k0 + kk) * ldw + n0 + (lane & 31)]; }
    LDS_WAIT(); asm volatile("" ::: "memory");
    const int c = lane & 7;
#pragma unroll
    for (int j = 0; j < 4; ++j) { const int n = (lane >> 3) + 8 * j; const LAS float* s = scr + (8 * c) * 33 + n;
        u32x4 o; o.x = pk2(s[0 * 33], s[1 * 33]); o.y = pk2(s[2 * 33], s[3 * 33]); o.z = pk2(s[4 * 33], s[5 * 33]); o.w = pk2(s[6 * 33], s[7 * 33]);
        const int nn = n0 + n; const int wrow = rowmode == 0 ? row_off + nn : row_off + 8 * (nn >> 2) + (nn & 3) + (rowmode == 2 ? 4 : 0);
        *(u32x4*)(WT + (size_t)wrow * K + k0 + 8 * c) = o; }
    LDS_WAIT(); asm volatile("" ::: "memory");
}

__device__ __forceinline__ void phase_pre(Frame& F) {
    const int gt = F.bid * NTHREADS + F.tid, NT = F.G * NTHREADS;
    float* sw1 = WSP(float, SM_SW1); float* rwg = WSP(float, SM_RWG); float* rwe = WSP(float, SM_RWE); float* lab = WSP(float, SM_LAB);
    for (int i = gt; i < 2 * 24 * 1024; i += NT) { const int l = i / (24 * 1024), c = (i / 1024) % 24, k = i % 1024;
        const int col = c < 16 ? 5128 + c : (c < 20 ? 3584 + (c - 16) : 3588 + (c - 20));
        sw1[i] = INP(I_W_IN)[((size_t)l * 1024 + k) * IN_COLS + col]; }
    for (int i = gt; i < 2 * 4 * 1024; i += NT) { const int l = i / (4 * 1024), c = (i / 1024) % 4, k = i % 1024; rwg[i] = INP(I_RG_W)[((size_t)l * 1024 + k) * 4 + c]; }
    for (int i = gt; i < 2 * 32 * 1024; i += NT) { const int l = i / (32 * 1024), c = (i / 1024) % 32, k = i % 1024; rwe[i] = INP(I_RE_W)[((size_t)l * 1024 + k) * 32 + c]; }
    for (int i = gt; i < 2 * 512; i += NT) { const int l = i / 512, c = i % 512; const float l0 = INP(I_LB)[c], l1 = INP(I_LB)[512 + c];
        const float p1 = 1.0f / (1.0f + expf(l0 - l1)); const float lb = l == 0 ? 0.f : p1;
        lab[l * 1024 + c] = logf(fmaxf(lb, 1e-30f)); lab[l * 1024 + 512 + c] = log1pf(-lb); }
}

__device__ __forceinline__ void convert_layer_weights(Frame& F, int l) {
    LAS float* scr = (LAS float*)(F.lds + F.wave * 16384);
    const int gw = F.bid * NWAVES + F.wave, NGW = F.G * NWAVES;
    const float* win = INP(I_W_IN) + (size_t)l * 1024 * IN_COLS;
    constexpr int I_MIX = 16 * 176, I_GATE = 16 * 96, I_BR = 8 * 32, I_OUT = 16 * 32, NITEMS = I_MIX + I_GATE + 3 * I_BR + I_OUT;
    for (int it = gw; it < NITEMS; it += NGW) {
        int r = it;
        if (r < I_MIX) { const int nb = r % 176, n0 = 32 * nb; const int shift = n0 < 3584 ? 0 : (n0 < 5120 ? 8 : 24);
            transpose_item(win + shift, IN_COLS, 1024, 176, WSP(bf16_t, WS_WMIX), 0, 0, scr, r, F.lane); continue; } r -= I_MIX;
        if (r < I_GATE) { transpose_item(win + 5656, IN_COLS, 1024, 96, WSP(bf16_t, WS_WGATE), 0, 0, scr, r, F.lane); continue; } r -= I_GATE;
        if (r < 3 * I_BR) { const int n = r / I_BR; transpose_item(INP(I_W_BRANCH) + ((size_t)l * 3 + n) * 512 * 1024, 1024, 512, 32, WSP(bf16_t, WS_WBT) + (size_t)n * 1024 * 512, 0, 0, scr, r % I_BR, F.lane); continue; } r -= 3 * I_BR;
        transpose_item(INP(I_W_OUT) + (size_t)l * 1024 * 1024, 1024, 1024, 32, WSP(bf16_t, WS_WOT), 0, 0, scr, r, F.lane);
    }
}
__device__ __forceinline__ void convert_expert_weights(Frame& F, int l) {
    LAS float* scr = (LAS float*)(F.lds + F.wave * 16384);
    const int gw = F.bid * NWAVES + F.wave, NGW = F.G * NWAVES;
    constexpr int I_G = 16 * 8, I_D = 4 * 32, PER = 2 * I_G + I_D;
    for (int it = gw; it < 32 * PER; it += NGW) {
        const int e = it / PER; int r = it % PER;
        bf16_t* w1t = WSP(bf16_t, WS_W1T) + (size_t)e * 512 * 1024; bf16_t* w2t = WSP(bf16_t, WS_W2T) + (size_t)e * 1024 * 256;
        if (r < I_G) { transpose_item(INP(I_EW_GATE) + ((size_t)l * 32 + e) * 1024 * 256, 256, 1024, 8, w1t, 0, 1, scr, r, F.lane); continue; } r -= I_G;
        if (r < I_G) { transpose_item(INP(I_EW_UP) + ((size_t)l * 32 + e) * 1024 * 256, 256, 1024, 8, w1t, 0, 2, scr, r, F.lane); continue; } r -= I_G;
        transpose_item(INP(I_EW_DOWN) + ((size_t)l * 32 + e) * 256 * 1024, 1024, 256, 32, w2t, 0, 0, scr, r, F.lane);
    }
}

__device__ __forceinline__ float* hrow(Frame& F, int r) { return r < NREAL ? F.out + (size_t)r * D : WSP(float, WS_HMETA) + (size_t)(r - NREAL) * D; }

__device__ __forceinline__ void load_row16(const float* p, int lane, float (&x)[16]) {
#pragma unroll
    for (int j = 0; j < 4; ++j) { const f32x4 v = *((const f32x4*)p + lane + 64 * j); x[4 * j] = v[0]; x[4 * j + 1] = v[1]; x[4 * j + 2] = v[2]; x[4 * j + 3] = v[3]; }
}
__device__ __forceinline__ void add_bf16_row16(const bf16_t* p, int lane, float (&x)[16]) {
#pragma unroll
    for (int j = 0; j < 4; ++j) { const u32x2 w = *((const u32x2*)p + lane + 64 * j); x[4 * j] += bflo(w.x); x[4 * j + 1] += bfhi(w.x); x[4 * j + 2] += bflo(w.y); x[4 * j + 3] += bfhi(w.y); }
}
__device__ __forceinline__ void store_row16(float* p, int lane, const float (&x)[16]) {
#pragma unroll
    for (int j = 0; j < 4; ++j) *((f32x4*)p + lane + 64 * j) = (f32x4){x[4 * j], x[4 * j + 1], x[4 * j + 2], x[4 * j + 3]};
}
__device__ __forceinline__ void store_bf16_row16(bf16_t* p, int lane, const float (&x)[16]) {
#pragma unroll
    for (int j = 0; j < 4; ++j) { u32x2 w; w.x = pk2(x[4 * j], x[4 * j + 1]); w.y = pk2(x[4 * j + 2], x[4 * j + 3]); *((u32x2*)p + lane + 64 * j) = w; }
}
__device__ __forceinline__ void fetch_h_row(Frame& F, int l, int r, float (&x)[16]) {
    if (l == 0) {
        const float* src = r < NREAL ? INP(I_X) + (size_t)r * D : INP(I_META) + (size_t)(r - META_ROW0) * D;
        load_row16(src, F.lane, x);
    } else {
        load_row16(hrow(F, r), F.lane, x);
        const unsigned* tok = WSP(unsigned, SM_TOK) + (size_t)r * 8;
        const unsigned g0 = tok[6], g1 = tok[7];
        add_bf16_row16(WSP(bf16_t, WS_Y2) + (size_t)g0 * 1024, F.lane, x);
        add_bf16_row16(WSP(bf16_t, WS_Y2) + (size_t)g1 * 1024, F.lane, x);
    }
}

__device__ __forceinline__ void phase_norm1(Frame& F, int l) {
    convert_layer_weights(F, l);
    __syncthreads();
    LAS float* sw = (LAS float*)F.lds;
    { const float* src = WSP(float, SM_SW1) + (size_t)l * 24 * 1024; for (int i = F.tid; i < 24 * 1024 / 4; i += NTHREADS) ((LAS f32x4*)sw)[i] = ((const f32x4*)src)[i]; }
    __syncthreads();
    const int gw = F.bid * NWAVES + F.wave, NGW = F.G * NWAVES, lane = F.lane;
    const float* nw = INP(I_NORM_MIX) + (size_t)l * D;
    float wv[16]; load_row16(nw, lane, wv);
    bf16_t* U = WSP(bf16_t, WS_U);
    for (int g = gw; g < MROWS / 4; g += NGW) {
        const int r0 = 4 * g;
        if (!row_valid(r0)) {
            float z[16];
#pragma unroll
            for (int j = 0; j < 16; ++j) z[j] = 0.f;
#pragma unroll
            for (int i = 0; i < 4; ++i) { store_bf16_row16(U + (size_t)(r0 + i) * D, lane, z); if (l == 0) store_row16(hrow(F, r0 + i), lane, z);
                if (lane < 16) WSP(float, SM_GK)[(size_t)(r0 + i) * 16 + lane] = 0.f;
                else if (lane < 20) WSP(float, SM_BETA)[(size_t)(r0 + i) * 4 + (lane - 16)] = 0.f;
                else if (lane < 24) WSP(float, SM_LOGA)[(size_t)(r0 + i) * 4 + (lane - 20)] = 0.f; }
            continue;
        }
        float x[4][16];
#pragma unroll
        for (int i = 0; i < 4; ++i) {
            fetch_h_row(F, l, r0 + i, x[i]);
            store_row16(hrow(F, r0 + i), lane, x[i]);
            float ss = 0.f;
#pragma unroll
            for (int j = 0; j < 16; ++j) ss += x[i][j] * x[i][j];
            const float rstd = rsqrtf(wave_sum(ss) * (1.0f / D) + 1e-6f);
#pragma unroll
            for (int j = 0; j < 16; ++j) x[i][j] = x[i][j] * rstd * wv[j];
            store_bf16_row16(U + (size_t)(r0 + i) * D, lane, x[i]);
        }
        float ov[4] = {0.f, 0.f, 0.f, 0.f};
#pragma unroll 1
        for (int c = 0; c < 24; ++c) {
            float a0 = 0.f, a1 = 0.f, a2 = 0.f, a3 = 0.f;
#pragma unroll
            for (int j = 0; j < 4; ++j) { const f32x4 w = *((const LAS f32x4*)(sw + c * 1024) + lane + 64 * j);
#pragma unroll
                for (int e = 0; e < 4; ++e) { a0 += x[0][4 * j + e] * w[e]; a1 += x[1][4 * j + e] * w[e]; a2 += x[2][4 * j + e] * w[e]; a3 += x[3][4 * j + e] * w[e]; } }
            a0 = wave_sum(a0); a1 = wave_sum(a1); a2 = wave_sum(a2); a3 = wave_sum(a3);
            if (lane == c) { ov[0] = a0; ov[1] = a1; ov[2] = a2; ov[3] = a3; }
        }
        float* GK = WSP(float, SM_GK); float* BETA = WSP(float, SM_BETA); float* LOGA = WSP(float, SM_LOGA);
#pragma unroll
        for (int i = 0; i < 4; ++i) {
            const float v = ov[i]; const int r = r0 + i;
            if (lane < 16) GK[(size_t)r * 16 + lane] = v;
            else if (lane < 20) BETA[(size_t)r * 4 + (lane - 16)] = sigmoidf_(v);
            else if (lane < 24) { const int h = lane - 20; LOGA[(size_t)r * 4 + h] = -expf(INP(I_GDN_ALOG)[l * 4 + h]) * softplusf_(v + INP(I_GDN_DT)[l * 4 + h]); }
        }
    }
}

__device__ __forceinline__ bf16x8 mk8(u32x4 w) { return __builtin_bit_cast(bf16x8, w); }
__device__ __forceinline__ bf16x8 mk8(u32x2 lo, u32x2 hi) { u32x4 w; w.x = lo.x; w.y = lo.y; w.z = hi.x; w.w = hi.y; return __builtin_bit_cast(bf16x8, w); }
__device__ __forceinline__ bf16x8 pack_acc2(const f32x4& a, const f32x4& b) { u32x4 w; w.x = pk2(a[0], a[1]); w.y = pk2(a[2], a[3]); w.z = pk2(b[0], b[1]); w.w = pk2(b[2], b[3]); return __builtin_bit_cast(bf16x8, w); }
#define MFMA16(a, b, c) __builtin_amdgcn_mfma_f32_16x16x32_bf16((a), (b), (c), 0, 0, 0)

__device__ __forceinline__ int permpos(int k) { const int kk = k & 31; return (k & ~31) + ((kk & 16) ? 8 * ((kk - 16) >> 2) + 4 + (kk & 3) : 8 * (kk >> 2) + (kk & 3)); }
template <int DK, bool IS_A>
__device__ __forceinline__ void prep_gla(Frame& F, int l, int slot, int h) {
    constexpr int NE = 64 * DK / NTHREADS;
    constexpr int QP = DK + 8;
    const int tid = F.tid, row0 = slot * 64, unit = slot * 4 + h;
    const int qcol = IS_A ? PC_AQ + h * 128 : PC_CQ + h * 64, kcol = IS_A ? PC_AF + h * 128 : PC_CK + h * 64, vcol = IS_A ? PC_AI + h * 128 : PC_CV + h * 128;
    bf16_t* P = WSP(bf16_t, WS_P);
    LAS float* bc = (LAS float*)F.lds;
    LAS bf16_t* qt = (LAS bf16_t*)(F.lds + 32768);
    LAS bf16_t* kt = qt + 64 * QP;
    LAS bf16_t* k1s = kt + 64 * QP;
    LAS bf16_t* vv = k1s + 64 * QP;
    LAS bf16_t* q1s = vv + 64 * 136;
#pragma unroll 2
    for (int i = 0; i < NE; ++i) { const int e = tid + NTHREADS * i, t = e / DK, d = e % DK; float lf;
        if (IS_A) { const float* lab = WSP(float, SM_LAB) + l * 1024 + h * 128 + d; lf = pg8::lfg(lab[0], lab[512], bf2f(P[(size_t)(row0 + t) * LDP + kcol + d])); }
        else { const float* gk = WSP(float, SM_GK) + (size_t)(row0 + t) * 16; const float* w2 = INP(I_GLA_W2) + (size_t)l * 16 * 256 + h * 64 + d; float s = INP(I_GLA_B)[l * 256 + h * 64 + d];
#pragma unroll
            for (int j = 0; j < 16; ++j) s += gk[j] * w2[j * 256];
            lf = logsigf_(s) * (1.0f / 16.0f); }
        bc[t * DK + d] = lf; }
    __syncthreads();
    if (tid < DK) { float s = 0.f;
        for (int t = 0; t < 64; ++t) { s += bc[t * DK + tid]; bc[t * DK + tid] = s; }
        (IS_A ? WSP(float, SM_DECA) + (size_t)unit * 128 : WSP(float, SM_DECC) + (size_t)unit * 64)[tid] = __expf(s); }
    __syncthreads();
#pragma unroll 2
    for (int i = 0; i < NE; ++i) { const int e = tid + NTHREADS * i, t = e / DK, d = e % DK;
        const float b = bc[t * DK + d], bl = bc[63 * DK + d], rr = bc[31 * DK + d];
        bf16_t* qp = P + (size_t)(row0 + t) * LDP + qcol + d;
        const float q = IS_A ? siluf_(bf2f(*qp)) * 0.08838834764831845f : bf2f(*qp) * 0.125f;
        float k;
        if (IS_A) { const float* lab = WSP(float, SM_LAB) + l * 1024 + h * 128 + d; const float lf = pg8::lfg(lab[0], lab[512], bf2f(P[(size_t)(row0 + t) * LDP + kcol + d]));
            k = row_valid(row0 + t) ? -expm1f(lf) : 0.f; } else k = bf2f(P[(size_t)(row0 + t) * LDP + kcol + d]);
        q1s[t * QP + d] = f2bf(q * __expf(b));
        k1s[t * QP + d] = f2bf(k * __expf(bl - b));
        qt[t * QP + d] = f2bf(q * __expf(fminf(b - rr, 80.f)));
        kt[t * QP + d] = f2bf(k * __expf(fminf(rr - b, 80.f))); }
#pragma unroll 4
    for (int i = 0; i < 16; ++i) { const int e = tid + NTHREADS * i, s = e / 128, c = e % 128; vv[s * 136 + c] = P[(size_t)(row0 + s) * LDP + vcol + c]; }
    __syncthreads();
    for (int it = tid; it < 64 * (DK / 8); it += NTHREADS) { const int t = it / (DK / 8), oc = it % (DK / 8), k0 = 32 * (oc >> 2) + 4 * (oc & 3); unsigned short x[8];
#pragma unroll
        for (int j = 0; j < 4; ++j) { x[j] = q1s[t * QP + k0 + j]; x[4 + j] = q1s[t * QP + k0 + 16 + j]; }
        u32x4 w; w.x = x[0] | (x[1] << 16); w.y = x[2] | (x[3] << 16); w.z = x[4] | (x[5] << 16); w.w = x[6] | (x[7] << 16);
        *(u32x4*)(P + (size_t)(row0 + t) * LDP + qcol + 8 * oc) = w; }
    for (int it = tid; it < DK * 8; it += NTHREADS) { const int d = it >> 3, oc = it & 7; unsigned short x[8];
#pragma unroll
        for (int j = 0; j < 8; ++j) x[j] = k1s[(8 * oc + j) * QP + d];
        u32x4 w; w.x = x[0] | (x[1] << 16); w.y = x[2] | (x[3] << 16); w.z = x[4] | (x[5] << 16); w.w = x[6] | (x[7] << 16);
        bf16_t* dst = IS_A ? P + (size_t)(row0 + (d >> 1)) * LDP + kcol + (d & 1) * 64 + 8 * oc : P + (size_t)(row0 + d) * LDP + kcol + 8 * oc;
        *(u32x4*)dst = w; }
    for (int it = tid; it < 128 * 8; it += NTHREADS) { const int c = it >> 3, oc = it & 7; unsigned short x[8];
#pragma unroll
        for (int j = 0; j < 8; ++j) x[j] = vv[(8 * oc + j) * 136 + c];
        u32x4 w; w.x = x[0] | (x[1] << 16); w.y = x[2] | (x[3] << 16); w.z = x[4] | (x[5] << 16); w.w = x[6] | (x[7] << 16);
        *(u32x4*)(P + (size_t)(row0 + (c >> 1)) * LDP + vcol + (c & 1) * 64 + 8 * oc) = w; }
    { const int w = F.wave, lane = F.lane, fr = lane & 15, fq = lane >> 4, mt = w >> 1;
        bf16_t* sc = (IS_A ? WSP(bf16_t, WS_SCA) : WSP(bf16_t, WS_SCC)) + (size_t)unit * 4096;
#pragma unroll
        for (int jn = 0; jn < 2; ++jn) { const int nt = (w & 1) * 2 + jn; f32x4 acc = {0.f, 0.f, 0.f, 0.f};
#pragma unroll
            for (int ks = 0; ks < DK / 32; ++ks) {
                const bf16x8 a = *(const LAS bf16x8*)(qt + (16 * mt + fr) * QP + 32 * ks + 8 * fq), b = *(const LAS bf16x8*)(kt + (16 * nt + fr) * QP + 32 * ks + 8 * fq);
                acc = MFMA16(a, b, acc); }
#pragma unroll
            for (int r = 0; r < 4; ++r) { const int t = 16 * mt + 4 * fq + r, s = 16 * nt + fr; sc[t * 64 + s] = (s <= t) ? f2bf(acc[r]) : (bf16_t)0; } }
    }
    __syncthreads();
}

__device__ __forceinline__ void prep_gdn(Frame& F, int l, int slot, int h) {
    const int tid = F.tid, lane = F.lane, row0 = slot * 64, unit = slot * 4 + h;
    bf16_t* P = WSP(bf16_t, WS_P);
    constexpr int NP = 136;
    LAS bf16_t* raw = (LAS bf16_t*)F.lds;
    LAS bf16_t* qn = (LAS bf16_t*)(F.lds + 17152);
    LAS bf16_t* kn = (LAS bf16_t*)(F.lds + 17152 + 17408);
    LAS float* kf = (LAS float*)(F.lds + 51968);
    LAS float* vf = (LAS float*)(F.lds + 51968 + 32768);
    LAS float* Am = (LAS float*)(F.lds + 51968 + 65536);
    LAS float* gs = (LAS float*)(F.lds + 51968 + 65536 + 17408);
    LAS float* cw = gs + 192;
    if (tid < 64) { float g = WSP(float, SM_LOGA)[(size_t)(row0 + tid) * 4 + h];
#pragma unroll
        for (int o = 1; o < 64; o <<= 1) { const float t = __shfl_up(g, o); if (lane >= o) g += t; }
        gs[tid] = g; gs[64 + tid] = WSP(float, SM_BETA)[(size_t)(row0 + tid) * 4 + h];
        if (tid == 63) WSP(float, SM_DECB)[unit] = __expf(g); }
    const int hslot = slot == 256 ? -1 : ((slot & 63) == 0 ? 256 : slot - 1);
    for (int comp = 0; comp < 3; ++comp) {
        const int col = PC_BQKV + comp * 512 + h * 128, ch0 = comp * 512 + h * 128;
        __syncthreads();
        for (int i = tid; i < 67 * 128; i += NTHREADS) { const int rr = i >> 7, c = i & 127; bf16_t v;
            if (rr < 3) v = hslot < 0 ? (bf16_t)0 : WSP(bf16_t, SM_HALO)[((size_t)hslot * 3 + rr) * 1536 + ch0 + c];
            else v = P[(size_t)(row0 + rr - 3) * LDP + col + c];
            raw[i] = v; }
        if (tid < 512) { const int j = tid >> 7, c = tid & 127; cw[tid] = INP(I_GDN_CONV)[((size_t)l * 4 + j) * 1536 + ch0 + c]; }
        __syncthreads();
        LAS float* dst = comp == 2 ? vf : kf;
#pragma unroll 2
        for (int i = 0; i < 16; ++i) { const int e = tid + NTHREADS * i, t = e >> 7, c = e & 127;
            const float x = cw[c] * bf2f(raw[t * 128 + c]) + cw[128 + c] * bf2f(raw[(t + 1) * 128 + c]) + cw[256 + c] * bf2f(raw[(t + 2) * 128 + c]) + cw[384 + c] * bf2f(raw[(t + 3) * 128 + c]);
            dst[t * 128 + c] = siluf_(x); }
        __syncthreads();
        if (comp < 2) {
            { const int t = tid >> 3, sub = tid & 7; float ss = 0.f;
#pragma unroll
                for (int j = 0; j < 16; ++j) { const float x = kf[t * 128 + sub * 16 + j]; ss += x * x; }
                ss += __shfl_xor(ss, 1); ss += __shfl_xor(ss, 2); ss += __shfl_xor(ss, 4);
                if (sub == 0) gs[128 + t] = rsqrtf(ss + 1e-6f); }
            __syncthreads();
#pragma unroll 2
            for (int i = 0; i < 16; ++i) { const int e = tid + NTHREADS * i, t = e >> 7, c = e & 127;
                const float x = kf[t * 128 + c] * gs[128 + t];
                if (comp == 0) qn[t * NP + c] = f2bf(x * 0.08838834764831845f); else { kf[t * 128 + c] = x; kn[t * NP + c] = f2bf(x); } }
        }
    }
    __syncthreads();
    { const float gl = gs[63];
        for (int it = tid; it < 128 * 8; it += NTHREADS) { const int d = it >> 3, oc = it & 7, s0 = 32 * (oc >> 2) + 4 * (oc & 3); float y[8];
#pragma unroll
            for (int j = 0; j < 8; ++j) { const int s = s0 + (j & 3) + (j >> 2) * 16; y[j] = kf[s * 128 + d] * __expf(gl - gs[s]); }
            u32x4 w; w.x = pk2(y[0], y[1]); w.y = pk2(y[2], y[3]); w.z = pk2(y[4], y[5]); w.w = pk2(y[6], y[7]);
            *(u32x4*)(WSP(bf16_t, WS_K1TB) + (size_t)unit * 8192 + d * 64 + 8 * oc) = w; }
#pragma unroll 2
        for (int i = 0; i < 16; ++i) { const int e = tid + NTHREADS * i, t = e >> 7, c = e & 127;
            P[(size_t)(row0 + t) * LDP + PC_BQKV + h * 128 + permpos(c)] = f2bf(bf2f(qn[t * NP + c]) * __expf(gs[t])); }
    }
    { const int w = F.wave, fr = lane & 15, fq = lane >> 4;
        bf16_t* qkd = WSP(bf16_t, WS_QKD) + (size_t)unit * 4096;
#pragma unroll
        for (int jt = 0; jt < 4; ++jt) { const int tile = w * 4 + jt, which = tile >> 4, mt = (tile >> 2) & 3, nt = tile & 3;
            const LAS bf16_t* ap = which ? qn : kn; f32x4 acc = {0.f, 0.f, 0.f, 0.f};
#pragma unroll
            for (int ks = 0; ks < 4; ++ks) { const bf16x8 a = *(const LAS bf16x8*)(ap + (16 * mt + fr) * NP + 32 * ks + 8 * fq), b = *(const LAS bf16x8*)(kn + (16 * nt + fr) * NP + 32 * ks + 8 * fq); acc = MFMA16(a, b, acc); }
#pragma unroll
            for (int r = 0; r < 4; ++r) { const int t = 16 * mt + 4 * fq + r, s = 16 * nt + fr; const float dec = __expf(fminf(gs[t] - gs[s], 0.f));
                if (which) qkd[t * 64 + permpos(s)] = (s <= t) ? f2bf(acc[r] * dec) : (bf16_t)0;
                else Am[s * 68 + t] = (s < t) ? gs[64 + t] * acc[r] * dec : 0.f; } }
    }
    __syncthreads();
#pragma unroll 2
    for (int i = 0; i < 16; ++i) { const int e = tid + NTHREADS * i, t = e >> 7; const float bt = gs[64 + t]; vf[e] *= bt; kf[e] *= bt * __expf(gs[t]); }
    __syncthreads();
    if (tid < 256) {
        LAS float* xs = (tid < 128 ? vf : kf) + (tid & 127);
#pragma unroll 1
        for (int ib = 0; ib < 4; ++ib) {
            float r[16];
#pragma unroll
            for (int ii = 0; ii < 16; ++ii) r[ii] = xs[(16 * ib + ii) * 128];
            const LAS float* at = Am + 16 * ib;
#pragma unroll 1
            for (int j = 0; j < 16 * ib; ++j) { const float xj = xs[j * 128];
                const f32x4 a0 = *(const LAS f32x4*)(at + j * 68), a1 = *(const LAS f32x4*)(at + j * 68 + 4), a2 = *(const LAS f32x4*)(at + j * 68 + 8), a3 = *(const LAS f32x4*)(at + j * 68 + 12);
                r[0] -= a0[0] * xj; r[1] -= a0[1] * xj; r[2] -= a0[2] * xj; r[3] -= a0[3] * xj; r[4] -= a1[0] * xj; r[5] -= a1[1] * xj; r[6] -= a1[2] * xj; r[7] -= a1[3] * xj;
                r[8] -= a2[0] * xj; r[9] -= a2[1] * xj; r[10] -= a2[2] * xj; r[11] -= a2[3] * xj; r[12] -= a3[0] * xj; r[13] -= a3[1] * xj; r[14] -= a3[2] * xj; r[15] -= a3[3] * xj; }
#pragma unroll
            for (int jj = 0; jj < 15; ++jj) { const LAS float* ar = at + (16 * ib + jj) * 68;
#pragma unroll
                for (int q4 = 0; q4 < 4; ++q4) { if (4 * q4 + 3 > jj) { const f32x4 a = *(const LAS f32x4*)(ar + 4 * q4);
#pragma unroll
                    for (int e = 0; e < 4; ++e) if (4 * q4 + e > jj) r[4 * q4 + e] -= a[e] * r[jj]; } } }
#pragma unroll
            for (int ii = 0; ii < 16; ++ii) xs[(16 * ib + ii) * 128] = r[ii];
        }
    }
    __syncthreads();
    for (int it = tid; it < 128 * 8; it += NTHREADS) { const int c = it >> 3, oc = it & 7; float y[8];
#pragma unroll
        for (int j = 0; j < 8; ++j) y[j] = vf[(8 * oc + j) * 128 + c];
        u32x4 w; w.x = pk2(y[0], y[1]); w.y = pk2(y[2], y[3]); w.z = pk2(y[4], y[5]); w.w = pk2(y[6], y[7]);
        *(u32x4*)(P + (size_t)(row0 + (c >> 1)) * LDP + PC_BQKV + 1024 + h * 128 + (c & 1) * 64 + 8 * oc) = w; }
#pragma unroll 2
    for (int i = 0; i < 16; ++i) { const int e = tid + NTHREADS * i, t = e >> 7, c = e & 127; P[(size_t)(row0 + t) * LDP + PC_BQKV + 512 + h * 128 + permpos(c)] = f2bf(kf[e]); }
    __syncthreads();
}

__device__ __forceinline__ void phase_prep(Frame& F, int l) {
    for (int u = F.bid; u < NSLOT * 12; u += F.G) { const int slot = u / 12, r = u % 12, mixer = r >> 2, h = r & 3;
        if (mixer == 0) prep_gla<128, true>(F, l, slot, h);
        else if (mixer == 1) prep_gdn(F, l, slot, h);
        else prep_gla<64, false>(F, l, slot, h);
    }
}
constexpr int SCAN_BUF = 57344;
template <int MX> struct ScanCfg;
template <> struct ScanCfg<0> { static constexpr int NM = 3, NI = 5; static constexpr int off(int m) { return m == 0 ? 0 : (m == 1 ? 16384 : 32768); } static constexpr int pitch(int m) { return m == 0 ? 256 : 128; } };
template <> struct ScanCfg<1> { static constexpr int NM = 4, NI = 7; static constexpr int off(int m) { return 16384 * m; } static constexpr int pitch(int m) { return m < 2 ? 256 : 128; } };
template <> struct ScanCfg<2> { static constexpr int NM = 3, NI = 3; static constexpr int off(int m) { return 8192 * m; } static constexpr int pitch(int m) { return 128; } };

template <int MX>
__device__ __forceinline__ void scan_mixer(Frame& F, int b, int h) {
    typedef ScanCfg<MX> C;
    constexpr int DK = MX == 2 ? 64 : 128, NT = DK / 16, NI = C::NI;
    const int w = F.wave, lane = F.lane, fr = lane & 15, fq = lane >> 4, ecol = 16 * w + fr;
    const char* Pb = (const char*)WSP(bf16_t, WS_P);
    const int qcol = MX == 0 ? PC_AQ + h * 128 : (MX == 1 ? PC_BQKV + h * 128 : PC_CQ + h * 64);
    const int kcol = MX == 0 ? PC_AF + h * 128 : (MX == 1 ? PC_BQKV + 512 + h * 128 : PC_CK + h * 64);
    const int vcol = MX == 0 ? PC_AI + h * 128 : (MX == 1 ? PC_BQKV + 1024 + h * 128 : PC_CV + h * 128);
    const char* SCb = (const char*)(MX == 0 ? WSP(bf16_t, WS_SCA) : (MX == 1 ? WSP(bf16_t, WS_QKD) : WSP(bf16_t, WS_SCC)));
    bf16_t* O = WSP(bf16_t, WS_O) + (size_t)MX * MROWS * 512;
    unsigned voff[NI]; int mi[NI];
#pragma unroll
    for (int i = 0; i < NI; ++i) { const int n = w + 8 * i, o = 1024 * n + 16 * lane; int m = 0;
#pragma unroll
        for (int q = 1; q < C::NM; ++q) if (o >= C::off(q)) m = q;
        int ro = o, pitch = 128;
#pragma unroll
        for (int q = 0; q < C::NM; ++q) if (m == q) { ro = o - C::off(q); pitch = C::pitch(q); }
        const int r = ro / pitch, pos = (ro % pitch) >> 4, pc = pos ^ (pitch == 256 ? (r & 15) : ((r >> 1) & 7));
        const bool packed = (MX == 0 && m == 1);
        const bool inP = (MX == 1) ? (m < 2) : (m < 2);
        voff[i] = (unsigned)(inP ? (packed ? (r >> 1) * (LDP * 2) + (r & 1) * 128 : r * (LDP * 2)) : r * pitch) + 16u * pc; mi[i] = m; }
    const unsigned x256_0 = (unsigned)(((0 | fq) ^ fr) << 4), x256_1 = (unsigned)(((4 | fq) ^ fr) << 4), x256_2 = (unsigned)(((8 | fq) ^ fr) << 4), x256_3 = (unsigned)(((12 | fq) ^ fr) << 4);
    const unsigned x128_0 = (unsigned)(((0 | fq) ^ ((fr >> 1) & 7)) << 4), x128_1 = (unsigned)(((4 | fq) ^ ((fr >> 1) & 7)) << 4);
    const unsigned x256[4] = {x256_0, x256_1, x256_2, x256_3}, x128[2] = {x128_0, x128_1};
#define SC_FRAG(buf, m, rt, kp) (*(const LAS bf16x8*)(F.lds + (buf) + C::off(m) + (16 * (rt) + fr) * C::pitch(m) + (C::pitch(m) == 256 ? x256[kp] : x128[(kp) & 1])))
    auto slot_of = [&](int step) { return step == 0 ? 256 : b * 64 + step - 1; };
    auto issue = [&](int step, int buf) {
        const int slot = slot_of(step), row0 = slot * 64, unit = slot * 4 + h;
        const char* base[4];
        if (MX == 1) { base[0] = Pb + ((size_t)row0 * LDP + kcol) * 2; base[1] = Pb + ((size_t)row0 * LDP + qcol) * 2; base[2] = (const char*)WSP(bf16_t, WS_K1TB) + (size_t)unit * 16384; base[3] = SCb + (size_t)unit * 8192; }
        else { base[0] = Pb + ((size_t)row0 * LDP + qcol) * 2; base[1] = Pb + ((size_t)row0 * LDP + kcol) * 2; base[2] = SCb + (size_t)unit * 8192; base[3] = base[2]; }
#pragma unroll
        for (int i = 0; i < NI; ++i) { const char* bs = mi[i] == 0 ? base[0] : (mi[i] == 1 ? base[1] : (mi[i] == 2 ? base[2] : base[3]));
            __builtin_amdgcn_global_load_lds((const unsigned*)(bs + voff[i]), (LAS unsigned*)(F.lds + buf + 1024 * (w + 8 * i)), 16, 0, 0); }
    };
    auto load_priv = [&](int step, u32x4 (&pv)[2]) {
        const int row0 = slot_of(step) * 64;
        const bf16_t* vt = (const bf16_t*)Pb + (size_t)(row0 + (ecol >> 1)) * LDP + vcol + (ecol & 1) * 64;
        if (MX == 1) { const u32x2 a = *(const u32x2*)(vt + 4 * fq), c = *(const u32x2*)(vt + 16 + 4 * fq), d = *(const u32x2*)(vt + 32 + 4 * fq), e = *(const u32x2*)(vt + 48 + 4 * fq);
            pv[0] = (u32x4){a.x, a.y, c.x, c.y}; pv[1] = (u32x4){d.x, d.y, e.x, e.y}; }
        else { pv[0] = *(const u32x4*)(vt + 8 * fq); pv[1] = *(const u32x4*)(vt + 32 + 8 * fq); }
    };
    f32x4 S[NT];
#pragma unroll
    for (int i = 0; i < NT; ++i) S[i] = (f32x4){0.f, 0.f, 0.f, 0.f};
    u32x4 pcur[2], pnxt[2];
    issue(0, 0); load_priv(0, pcur);
    for (int step = 0; step < 65; ++step) {
        const int buf = (step & 1) * SCAN_BUF, slot = slot_of(step), row0 = slot * 64, unit = slot * 4 + h;
        asm volatile("s_waitcnt vmcnt(0)" ::: "memory");
        __syncthreads();
        if (step + 1 < 65) { issue(step + 1, SCAN_BUF - buf); load_priv(step + 1, pnxt); }
        bf16x8 Sb[NT / 2];
#pragma unroll
        for (int kp = 0; kp < NT / 2; ++kp) Sb[kp] = pack_acc2(S[2 * kp], S[2 * kp + 1]);
        if (MX == 1) {
            f32x4 vn[4];
#pragma unroll
            for (int mt = 0; mt < 4; ++mt) { f32x4 acc = {0.f, 0.f, 0.f, 0.f};
#pragma unroll
                for (int kp = 0; kp < 4; ++kp) acc = MFMA16(SC_FRAG(buf, 0, mt, kp), Sb[kp], acc);
                const unsigned u0 = mt == 0 ? pcur[0].x : (mt == 1 ? pcur[0].z : (mt == 2 ? pcur[1].x : pcur[1].z)), u1 = mt == 0 ? pcur[0].y : (mt == 1 ? pcur[0].w : (mt == 2 ? pcur[1].y : pcur[1].w));
                vn[mt] = (f32x4){bflo(u0) - acc[0], bfhi(u0) - acc[1], bflo(u1) - acc[2], bfhi(u1) - acc[3]}; }
            bf16x8 Vb[2]; Vb[0] = pack_acc2(vn[0], vn[1]); Vb[1] = pack_acc2(vn[2], vn[3]);
#pragma unroll
            for (int mt = 0; mt < 4; ++mt) { f32x4 acc = {0.f, 0.f, 0.f, 0.f};
#pragma unroll
                for (int kp = 0; kp < 4; ++kp) acc = MFMA16(SC_FRAG(buf, 1, mt, kp), Sb[kp], acc);
#pragma unroll
                for (int kp = 0; kp < 2; ++kp) acc = MFMA16(SC_FRAG(buf, 3, mt, kp), Vb[kp], acc);
#pragma unroll
                for (int r = 0; r < 4; ++r) O[(size_t)(row0 + 16 * mt + 4 * fq + r) * 512 + h * 128 + ecol] = f2bf(acc[r]); }
            const float a = WSP(float, SM_DECB)[unit];
#pragma unroll
            for (int i = 0; i < 8; ++i) { S[i] = S[i] * a;
#pragma unroll
                for (int kp = 0; kp < 2; ++kp) S[i] = MFMA16(SC_FRAG(buf, 2, i, kp), Vb[kp], S[i]); }
        } else {
            const bf16x8 bv0 = mk8(pcur[0]), bv1 = mk8(pcur[1]);
#pragma unroll
            for (int mt = 0; mt < 4; ++mt) { f32x4 acc = {0.f, 0.f, 0.f, 0.f};
#pragma unroll
                for (int kp = 0; kp < NT / 2; ++kp) acc = MFMA16(SC_FRAG(buf, 0, mt, kp), Sb[kp], acc);
                acc = MFMA16(SC_FRAG(buf, 2, mt, 0), bv0, acc); acc = MFMA16(SC_FRAG(buf, 2, mt, 1), bv1, acc);
#pragma unroll
                for (int r = 0; r < 4; ++r) O[(size_t)(row0 + 16 * mt + 4 * fq + r) * 512 + h * 128 + ecol] = f2bf(acc[r]); }
            const float* dec = (MX == 0 ? WSP(float, SM_DECA) : WSP(float, SM_DECC)) + (size_t)unit * DK;
#pragma unroll
            for (int i = 0; i < NT; ++i) { const f32x4 d4 = *(const f32x4*)(dec + 16 * i + 4 * fq); S[i] = S[i] * d4;
                S[i] = MFMA16(SC_FRAG(buf, 1, i, 0), bv0, S[i]); S[i] = MFMA16(SC_FRAG(buf, 1, i, 1), bv1, S[i]); }
        }
        pcur[0] = pnxt[0]; pcur[1] = pnxt[1];
    }
#undef SC_FRAG
    asm volatile("s_waitcnt vmcnt(0)" ::: "memory");
    __syncthreads();
}
__device__ __forceinline__ void phase_scan(Frame& F) {
    if (F.bid >= 48) return;
    const int mixer = F.bid >> 4, b = (F.bid >> 2) & 3, h = F.bid & 3;
    if (mixer == 0) scan_mixer<0>(F, b, h);
    else if (mixer == 1) scan_mixer<1>(F, b, h);
    else scan_mixer<2>(F, b, h);
}

__device__ __forceinline__ void phase_hnorm(Frame& F, int l) {
    const int gw = F.bid * NWAVES + F.wave, NGW = F.G * NWAVES, lane = F.lane;
    const bf16_t* P = WSP(bf16_t, WS_P);
    for (int it = gw; it < MROWS * 3; it += NGW) {
        const int r = it / 3, mx = it % 3;
        bf16_t* op = WSP(bf16_t, WS_O) + (size_t)mx * MROWS * 512 + (size_t)r * 512 + 8 * lane;
        if (!row_valid(r)) { *(u32x4*)op = (u32x4){0u, 0u, 0u, 0u}; continue; }
        const int gcol = mx == 0 ? PC_AG : (mx == 1 ? PC_BG : PC_CG);
        const float* nwb = mx == 0 ? INP(I_HGRN_NORM) : (mx == 1 ? INP(I_GDN_NORM) : INP(I_GLA_NORM)); const float* nw = nwb + (size_t)l * 128 + (8 * lane & 127);
        const u32x4 ow = *(const u32x4*)op, gw4 = *(const u32x4*)(P + (size_t)r * LDP + gcol + 8 * lane);
        float o[8] = {bflo(ow.x), bfhi(ow.x), bflo(ow.y), bfhi(ow.y), bflo(ow.z), bfhi(ow.z), bflo(ow.w), bfhi(ow.w)};
        const float g[8] = {siluf_(bflo(gw4.x)), siluf_(bfhi(gw4.x)), siluf_(bflo(gw4.y)), siluf_(bfhi(gw4.y)), siluf_(bflo(gw4.z)), siluf_(bfhi(gw4.z)), siluf_(bflo(gw4.w)), siluf_(bfhi(gw4.w))};
        float ss = 0.f;
#pragma unroll
        for (int j = 0; j < 8; ++j) ss += o[j] * o[j];
        ss += __shfl_xor(ss, 1); ss += __shfl_xor(ss, 2); ss += __shfl_xor(ss, 4); ss += __shfl_xor(ss, 8);
        const float rstd = rsqrtf(ss * (1.0f / 128.0f) + 1e-6f);
        const f32x4 n0 = *(const f32x4*)nw, n1 = *(const f32x4*)(nw + 4);
        const float nv[8] = {n0[0], n0[1], n0[2], n0[3], n1[0], n1[1], n1[2], n1[3]};
#pragma unroll
        for (int j = 0; j < 8; ++j) o[j] = o[j] * rstd * nv[j] * g[j];
        u32x4 y; y.x = pk2(o[0], o[1]); y.y = pk2(o[2], o[3]); y.z = pk2(o[4], o[5]); y.w = pk2(o[6], o[7]);
        *(u32x4*)op = y;
    }
}

__device__ __forceinline__ void phase_norm2(Frame& F, int l) {
    convert_expert_weights(F, l);
    __syncthreads();
    LAS float* sw = (LAS float*)F.lds;
    { const float* src = WSP(float, SM_RWE) + (size_t)l * 32 * 1024; for (int i = F.tid; i < 32 * 1024 / 4; i += NTHREADS) ((LAS f32x4*)sw)[i] = ((const f32x4*)src)[i]; }
    __syncthreads();
    const int gw = F.bid * NWAVES + F.wave, NGW = F.G * NWAVES, lane = F.lane;
    float wv[16]; load_row16(INP(I_NORM_FFN) + (size_t)l * D, lane, wv);
    bf16_t* U = WSP(bf16_t, WS_U);
    const float* rwg = WSP(float, SM_RWG) + (size_t)l * 4 * 1024;
    unsigned* cnt = WSP(unsigned, WS_CTL) + CW_CNT + l * 64;
    for (int g = gw; g < MROWS / 4; g += NGW) {
        const int r0 = 4 * g;
        if (!row_valid(r0)) continue;
        float x[4][16];
#pragma unroll
        for (int i = 0; i < 4; ++i) {
            load_row16(hrow(F, r0 + i), lane, x[i]);
            float ss = 0.f;
#pragma unroll
            for (int j = 0; j < 16; ++j) ss += x[i][j] * x[i][j];
            const float rstd = rsqrtf(wave_sum(ss) * (1.0f / D) + 1e-6f);
#pragma unroll
            for (int j = 0; j < 16; ++j) x[i][j] = x[i][j] * rstd * wv[j];
            store_bf16_row16(U + (size_t)(r0 + i) * D, lane, x[i]);
        }
        float lg[4][4];
#pragma unroll
        for (int c = 0; c < 4; ++c) {
            float a0 = 0.f, a1 = 0.f, a2 = 0.f, a3 = 0.f;
#pragma unroll
            for (int j = 0; j < 4; ++j) { const f32x4 w = *((const f32x4*)(rwg + c * 1024) + lane + 64 * j);
#pragma unroll
                for (int e = 0; e < 4; ++e) { a0 += x[0][4 * j + e] * w[e]; a1 += x[1][4 * j + e] * w[e]; a2 += x[2][4 * j + e] * w[e]; a3 += x[3][4 * j + e] * w[e]; } }
            const float bg = INP(I_RG_B)[l * 4 + c];
            lg[0][c] = wave_sum(a0) + bg; lg[1][c] = wave_sum(a1) + bg; lg[2][c] = wave_sum(a2) + bg; lg[3][c] = wave_sum(a3) + bg;
        }
#pragma unroll
        for (int i = 0; i < 4; ++i) {
            int gi = 0; float gm = lg[i][0];
#pragma unroll
            for (int c = 1; c < 4; ++c) if (lg[i][c] > gm) { gm = lg[i][c]; gi = c; }
            float gsum = 0.f;
#pragma unroll
            for (int c = 0; c < 4; ++c) gsum += __expf(lg[i][c] - gm);
            const float gval = 1.0f / gsum;
            gi = __builtin_amdgcn_readfirstlane(gi);
            int ea = 0, eb = 0; float la = -3.0e38f, lb = -3.0e38f;
#pragma unroll 1
            for (int c = 0; c < 8; ++c) {
                float a = 0.f;
#pragma unroll
                for (int j = 0; j < 4; ++j) { const f32x4 w = *((const LAS f32x4*)(sw + (gi * 8 + c) * 1024) + lane + 64 * j);
#pragma unroll
                    for (int e = 0; e < 4; ++e) a += x[i][4 * j + e] * w[e]; }
                const float el = wave_sum(a) + INP(I_RE_B)[l * 32 + gi * 8 + c];
                if (el > la) { lb = la; eb = ea; la = el; ea = c; } else if (el > lb) { lb = el; eb = c; }
            }
            const float wa = 1.0f / (1.0f + __expf(lb - la)), wb = 1.0f - wa;
            if (lane == 0) {
                const unsigned e0 = (unsigned)(gi * 8 + ea), e1 = (unsigned)(gi * 8 + eb);
                const unsigned p0 = atomicAdd(cnt + e0, 1u), p1 = atomicAdd(cnt + e1, 1u);
                unsigned* tok = WSP(unsigned, SM_TOK) + (size_t)(r0 + i) * 8;
                tok[0] = e0; tok[1] = p0; tok[2] = e1; tok[3] = p1; tok[4] = __float_as_uint(gval * wa); tok[5] = __float_as_uint(gval * wb);
            }
        }
    }
}

__device__ __forceinline__ int moe_tables(Frame& F, int l) {
    LAS int* offs = (LAS int*)(F.lds + LDS_TAB); LAS unsigned char* tab = (LAS unsigned char*)(F.lds + LDS_TAB + 384); LAS int* cn = (LAS int*)(F.lds + LDS_TAB + 192);
    const unsigned* cnt = WSP(unsigned, WS_CTL) + CW_CNT + l * 64;
    __syncthreads();
    if (F.tid < 32) cn[F.tid] = (int)__hip_atomic_load(cnt + F.tid, __ATOMIC_RELAXED, __HIP_MEMORY_SCOPE_AGENT);
    __syncthreads();
    if (F.tid == 0) { int acc = 0;
#pragma unroll 1
        for (int e = 0; e < 32; ++e) { offs[e] = acc; acc += ((cn[e] + 255) >> 8) << 8; }
        offs[32] = acc; }
    __syncthreads();
    if (F.tid < 160) { const int row = F.tid << 8; int e = 0;
#pragma unroll 1
        for (int k = 1; k < 32; ++k) if (offs[k] <= row) e = k;
        tab[F.tid] = (unsigned char)e; }
    __syncthreads();
    return offs[32] >> 8;
}

__device__ __forceinline__ void phase_gather(Frame& F, int l) {
    (void)moe_tables(F, l);
    const LAS int* offs = (const LAS int*)(F.lds + LDS_TAB); const LAS int* cn = (const LAS int*)(F.lds + LDS_TAB + 192);
    const int gw = F.bid * NWAVES + F.wave, NGW = F.G * NWAVES, lane = F.lane;
    const bf16_t* U = WSP(bf16_t, WS_U); bf16_t* XG = WSP(bf16_t, WS_XG); float* wrow = WSP(float, SM_WROW);
    for (int idx = gw; idx < NREAL + 16; idx += NGW) {
        const int r = idx < NREAL ? idx : META_ROW0 + (idx - NREAL);
        unsigned* tok = WSP(unsigned, SM_TOK) + (size_t)r * 8;
        const unsigned e0 = tok[0], p0 = tok[1], e1 = tok[2], p1 = tok[3];
        const unsigned g0 = (unsigned)offs[e0] + p0, g1 = (unsigned)offs[e1] + p1;
        if (lane == 0) { tok[6] = g0; tok[7] = g1; wrow[g0] = __uint_as_float(tok[4]); wrow[g1] = __uint_as_float(tok[5]); }
        const u32x4* src = (const u32x4*)(U + (size_t)r * D);
        const u32x4 a = src[lane], b = src[lane + 64];
        u32x4* d0 = (u32x4*)(XG + (size_t)g0 * D); u32x4* d1 = (u32x4*)(XG + (size_t)g1 * D);
        d0[lane] = a; d0[lane + 64] = b; d1[lane] = a; d1[lane + 64] = b;
    }
    for (int i = gw; i < 32 * 256; i += NGW) { const int e = i >> 8, j = i & 255; const int row = offs[e] + cn[e] + j;
        if (row < offs[e + 1]) { u32x4* d = (u32x4*)(XG + (size_t)row * D); d[lane] = (u32x4){0u, 0u, 0u, 0u}; d[lane + 64] = (u32x4){0u, 0u, 0u, 0u}; if (lane == 0) wrow[row] = 0.f; } }
}

__device__ __forceinline__ void phase_final(Frame& F) {
    const int gw = F.bid * NWAVES + F.wave, NGW = F.G * NWAVES, lane = F.lane;
    float wv[16]; load_row16(INP(I_NORM_FINAL), lane, wv);
    for (int r = gw; r < NREAL; r += NGW) {
        float x[16]; fetch_h_row(F, 2, r, x);
        float ss = 0.f;
#pragma unroll
        for (int j = 0; j < 16; ++j) ss += x[j] * x[j];
        const float rstd = rsqrtf(wave_sum(ss) * (1.0f / D) + 1e-6f);
#pragma unroll
        for (int j = 0; j < 16; ++j) x[j] = x[j] * rstd * wv[j];
        store_row16(F.out + (size_t)r * D, lane, x);
    }
}
constexpr int PH_PER_LAYER = 14, N_PHASES = 2 + 2 * PH_PER_LAYER;
#ifndef DBG_STOP
#define DBG_STOP 0
#endif
#ifndef DBG_SRC
#define DBG_SRC WS_P
#define DBG_LD LDP
#endif
#ifndef DUP_MASK
#define DUP_MASK 0u
#endif
#define DUPN(j) (((DUP_MASK >> (j)) & 1u) ? 2 : 1)
#ifndef MK_ONE_LAUNCH
#define MK_ONE_LAUNCH 1
#endif

template <unsigned PHMASK_T>
__global__ void __launch_bounds__(NTHREADS, 2) hybrid_fwd(Params p) {
    extern __shared__ __attribute__((aligned(16))) unsigned char lds_raw[];
    Frame F;
    F.lds = (LAS unsigned char*)lds_raw; F.tid = threadIdx.x; F.lane = F.tid & 63; F.wave = __builtin_amdgcn_readfirstlane(F.tid >> 6); F.G = gridDim.x; F.bid = blockIdx.x;
    F.out = p.out; F.ws = p.ws; F.inp = (const float* const __attribute__((address_space(4)))*)__builtin_amdgcn_kernarg_segment_ptr();
    volatile LAS unsigned* MISC = (volatile LAS unsigned*)(F.lds + LDS_MISC);
    if (F.tid < 128) MISC[F.tid] = 0u;
    __syncthreads();
    const int lo = p.ph_lo, hi = p.ph_hi;
    XcdBarrier bar; bar.bar = WSP(unsigned, WS_CTL) + CW_BAR; bar.x = 0; bar.st = MISC + 8;
    if (hi - lo > 1) bar = xcd_barrier_post(WSP(unsigned, WS_CTL) + CW_BAR, MISC + 8);
#define EN(j) ((PHMASK_T >> (j)) & 1u)
#define IN(k) (lo <= (k) && (k) < hi)
#define SEAM(k) do { if (IN(k) && IN((k) + 1)) xcd_barrier(bar.bar, bar.x, bar.st); PHASE_FENCE(F); } while (0)
    PHASE_FENCE(F);
    if (EN(15) && IN(0)) phase_pre(F);
    SEAM(0);
    for (int l = 0; l < 2; ++l) {
        const int pb = 1 + PH_PER_LAYER * l;
        if (EN(0) && IN(pb + 0)) phase_norm1(F, l);
        SEAM(pb + 0);
        for (int rep = 0; rep < DUPN(1); ++rep) { if (rep) { xcd_barrier(bar.bar, bar.x, bar.st); PHASE_FENCE(F); }
        if (EN(1) && IN(pb + 1)) {
            pg8::Gemm g{WSP(bf16_t, WS_U), WSP(bf16_t, WS_WMIX), MROWS, LDP, D}; pg8::StaticOrder S; S.init(MROWS, LDP, F.G, F.bid);
            pg8::EpiInProj E{WSP(bf16_t, WS_P), WSP(bf16_t, SM_HALO)};
            pg8::gemm_phase(F.lds, F.tid, g, S, E);
        } }
        SEAM(pb + 1);
        if (EN(2) && IN(pb + 2)) phase_prep(F, l);
        SEAM(pb + 2);
        for (int rep = 0; rep < DUPN(3); ++rep) { if (rep) { xcd_barrier(bar.bar, bar.x, bar.st); PHASE_FENCE(F); } if (EN(3) && IN(pb + 3)) phase_scan(F); }
        SEAM(pb + 3);
        if (EN(4) && IN(pb + 4)) phase_hnorm(F, l);
        SEAM(pb + 4);
        for (int rep = 0; rep < DUPN(5); ++rep) { if (rep) { xcd_barrier(bar.bar, bar.x, bar.st); PHASE_FENCE(F); }
        if (EN(5) && IN(pb + 5)) {
            pg8::Gemm g{WSP(bf16_t, WS_U), WSP(bf16_t, WS_WGATE), MROWS, 3072, D}; pg8::StaticOrder S; S.init(MROWS, 3072, F.G, F.bid);
            pg8::EpiSigmoid E{WSP(bf16_t, WS_GT), 3072};
            pg8::gemm_phase(F.lds, F.tid, g, S, E);
        } }
        SEAM(pb + 5);
        for (int n = 0; n < 3; ++n) {
            if (EN(6) && IN(pb + 6 + n)) {
                pg8::Gemm g{WSP(bf16_t, WS_O) + (size_t)n * MROWS * 512, WSP(bf16_t, WS_WBT) + (size_t)n * 1024 * 512, MROWS, D, 512}; pg8::StaticOrder S; S.init(MROWS, D, F.G, F.bid);
                pg8::EpiBranch E{WSP(bf16_t, WS_MERGED), WSP(bf16_t, WS_GT), n};
                pg8::gemm_phase(F.lds, F.tid, g, S, E);
            }
            SEAM(pb + 6 + n);
        }
        if (EN(9) && IN(pb + 9)) {
            pg8::Gemm g{WSP(bf16_t, WS_MERGED), WSP(bf16_t, WS_WOT), MROWS, D, D}; pg8::StaticOrder S; S.init(MROWS, D, F.G, F.bid);
            pg8::EpiResidual E{F.out, WSP(float, WS_HMETA)};
            pg8::gemm_phase(F.lds, F.tid, g, S, E);
        }
        SEAM(pb + 9);
        if (EN(10) && IN(pb + 10)) phase_norm2(F, l);
        SEAM(pb + 10);
        for (int rep = 0; rep < DUPN(11); ++rep) { if (rep) { xcd_barrier(bar.bar, bar.x, bar.st); PHASE_FENCE(F); } if (EN(11) && IN(pb + 11)) phase_gather(F, l); }
        SEAM(pb + 11);
        if (EN(12) && IN(pb + 12)) {
            const int ntiles = moe_tables(F, l);
            pg8::Gemm g{WSP(bf16_t, WS_XG), WSP(bf16_t, WS_W1T), XG_ROWS, 512, D};
            pg8::MoeOrder S{F.G, F.bid, 2, ntiles, (const LAS unsigned char*)(F.lds + LDS_TAB + 384), (size_t)512 * 1024 * 2};
            pg8::EpiMoeUp E{WSP(bf16_t, WS_HG)};
            pg8::gemm_phase(F.lds, F.tid, g, S, E);
        }
        SEAM(pb + 12);
        if (EN(13) && IN(pb + 13)) {
            const int ntiles = moe_tables(F, l);
            pg8::Gemm g{WSP(bf16_t, WS_HG), WSP(bf16_t, WS_W2T), XG_ROWS, D, 256};
            pg8::MoeOrder S{F.G, F.bid, 4, ntiles, (const LAS unsigned char*)(F.lds + LDS_TAB + 384), (size_t)1024 * 256 * 2};
            pg8::EpiMoeDown E{WSP(bf16_t, WS_Y2), WSP(float, SM_WROW)};
            pg8::gemm_phase(F.lds, F.tid, g, S, E);
        }
        SEAM(pb + 13);
    }
#if DBG_STOP > 0
    if (EN(14) && IN(N_PHASES - 1)) { const int gt = F.bid * NTHREADS + F.tid, NT = F.G * NTHREADS;
#ifdef DBG_LIN
        { const bf16_t* s1 = WSP(bf16_t, DBG_SRC); const bf16_t* s2 = WSP(bf16_t, DBG_SRC2);
          for (size_t i = gt; i < (size_t)NREAL * D; i += NT) F.out[i] = i < (size_t)DBG_N1 ? bf2f(s1[i]) : (i < (size_t)DBG_N1 + DBG_N2 ? bf2f(s2[i - DBG_N1]) : 0.f); }
#else
        if (DBG_LD > 0) { const bf16_t* src = WSP(bf16_t, DBG_SRC); for (size_t i = gt; i < (size_t)NREAL * D; i += NT) { const size_t r = i >> 10, c = i & 1023; F.out[i] = bf2f(src[r * DBG_LD + (c * DBG_LD) / 1024]); } }
#endif
    }
#else
    if (EN(14) && IN(N_PHASES - 1)) phase_final(F);
#endif
#undef IN
#undef SEAM
}

#if MK_ONE_LAUNCH
constexpr unsigned KMASK[1] = {0xffffffffu};
#else
constexpr unsigned KMASK[3] = {0x0C19u, 0xC004u, 0x3262u};
#endif
template <unsigned M> static bool setup_kernel(int& per_cu) {
    if (hipFuncSetAttribute((const void*)hybrid_fwd<M>, hipFuncAttributeMaxDynamicSharedMemorySize, LDS_BYTES) != hipSuccess) return false;
    if (hipOccupancyMaxActiveBlocksPerMultiprocessor(&per_cu, (const void*)hybrid_fwd<M>, NTHREADS, LDS_BYTES) != hipSuccess) per_cu = 0;
    (void)hipGetLastError();
    return true;
}
static int phase_kind(int k) { if (k == 0) return 15; if (k == N_PHASES - 1) return 14; const int j = (k - 1) % PH_PER_LAYER; return (j >= 6 && j <= 8) ? 6 : j; }
extern "C" void kernel_launch(void* const* d_in, const int* in_sizes, int n_in, void* d_out, int out_size, void* d_ws, size_t ws_size, hipStream_t stream) {
    static int grid = 0;
    if (grid == 0) {
        if (n_in != 24 || in_sizes[0] != NREAL * D || out_size != NREAL * D || ws_size < WS_END) {
            fprintf(stderr, "kernel_launch: unexpected problem (n_in %d, in0 %d, out %d, ws %zu < %zu); nothing launched\n", n_in, n_in > 0 ? in_sizes[0] : -1, out_size, ws_size, (size_t)WS_END); grid = -1; return; }
        int dev = 0, cus = 0, per_cu = 0; bool ok = true;
        if (hipGetDevice(&dev) != hipSuccess || hipDeviceGetAttribute(&cus, hipDeviceAttributeMultiprocessorCount, dev) != hipSuccess) { grid = -1; return; }
#if MK_ONE_LAUNCH
        ok = setup_kernel<KMASK[0]>(per_cu);
#else
        ok = setup_kernel<KMASK[0]>(per_cu) && setup_kernel<KMASK[1]>(per_cu) && setup_kernel<KMASK[2]>(per_cu);
#endif
        if (!ok) { fprintf(stderr, "kernel_launch: hipFuncSetAttribute failed\n"); grid = -1; return; }
        if (per_cu < 1) fprintf(stderr, "kernel_launch: occupancy query says %d\n", per_cu);
        grid = cus;
    }
    if (grid < 0) return;
    if (hipMemsetAsync((char*)d_ws + WS_CTL, 0, CTL_BYTES, stream) != hipSuccess) return;
    Params p{};
    for (int i = 0; i < 24; ++i) p.in[i] = (const float*)d_in[i];
    p.out = (float*)d_out; p.ws = (unsigned char*)d_ws;
#if MK_ONE_LAUNCH
    p.ph_lo = 0; p.ph_hi = N_PHASES;
    hipLaunchKernelGGL(hybrid_fwd<KMASK[0]>, dim3(grid), dim3(NTHREADS), LDS_BYTES, stream, p);
#else
    for (int k = 0; k < N_PHASES; ++k) { if (DBG_STOP > 0 && k >= DBG_STOP && k != N_PHASES - 1) continue; p.ph_lo = k; p.ph_hi = k + 1; const unsigned bit = 1u << phase_kind(k);
        if (KMASK[0] & bit) hipLaunchKernelGGL(hybrid_fwd<KMASK[0]>, dim3(grid), dim3(NTHREADS), LDS_BYTES, stream, p);
        else if (KMASK[1] & bit) hipLaunchKernelGGL(hybrid_fwd<KMASK[1]>, dim3(grid), dim3(NTHREADS), LDS_BYTES, stream, p);
        else hipLaunchKernelGGL(hybrid_fwd<KMASK[2]>, dim3(grid), dim3(NTHREADS), LDS_BYTES, stream, p); }
#endif
}
```

```cpp
#include <hip/hip_runtime.h>
#include <cstdio>
#include <cstdint>

#define LAS __attribute__((address_space(3)))
typedef unsigned short bf16_t;
typedef short bf16x8 __attribute__((ext_vector_type(8)));
typedef float f32x4 __attribute__((ext_vector_type(4)));
typedef float f32x2 __attribute__((ext_vector_type(2)));
typedef unsigned u32x4 __attribute__((ext_vector_type(4)));
typedef unsigned u32x2 __attribute__((ext_vector_type(2)));

constexpr int D = 1024, NREAL = 16384, MROWS = 16640, META_ROW0 = 16384 + 48, META_END = 16384 + 64;
constexpr int NSLOT = 257;
constexpr int LDP = 5632;
constexpr int PC_AQ = 0, PC_AF = 512, PC_AI = 1024, PC_AG = 1536, PC_BQKV = 2048, PC_BG = 3584, PC_CQ = 4096, PC_CK = 4352, PC_CV = 4608, PC_CG = 5120;
constexpr int IN_COLS = 8728;
constexpr int NTHREADS = 512, NWAVES = 8;
constexpr int XG_ROWS = 40960;

constexpr size_t MiB = 1ull << 20;
constexpr size_t WS_CTL = 0, CTL_BYTES = 1 * MiB;
constexpr int CW_BAR = 4096, CW_CNT = 1024;
constexpr size_t SM_SW1 = 1 * MiB;
constexpr size_t SM_RWG = SM_SW1 + 2 * 24 * 1024 * 4;
constexpr size_t SM_RWE = SM_RWG + 2 * 4 * 1024 * 4;
constexpr size_t SM_LAB = SM_RWE + 2 * 32 * 1024 * 4;
constexpr size_t SM_GK = SM_LAB + 2 * 2 * 512 * 4;
constexpr size_t SM_BETA = SM_GK + (size_t)MROWS * 16 * 4;
constexpr size_t SM_LOGA = SM_BETA + (size_t)MROWS * 4 * 4;
constexpr size_t SM_TOK = SM_LOGA + (size_t)MROWS * 4 * 4;
constexpr size_t SM_WROW = SM_TOK + (size_t)MROWS * 8 * 4;
constexpr size_t SM_DECA = SM_WROW + (size_t)XG_ROWS * 4;
constexpr size_t SM_DECC = SM_DECA + 1028 * 128 * 4;
constexpr size_t SM_DECB = SM_DECC + 1028 * 64 * 4;
constexpr size_t SM_HALO = SM_DECB + 8192;
constexpr size_t SM_END = SM_HALO + 260 * 3 * 1536 * 2;
static_assert(SM_END <= 8 * MiB, "small region");
constexpr size_t WS_HMETA = 8 * MiB;
constexpr size_t WS_WMIX = 9 * MiB;
constexpr size_t WS_WGATE = 20 * MiB;
constexpr size_t WS_WBT = 26 * MiB;
constexpr size_t WS_WOT = 29 * MiB;
constexpr size_t WS_O = 31 * MiB;
constexpr size_t O_STRIDE = (size_t)MROWS * 512 * 2;
constexpr size_t WS_W1T = 31 * MiB;
constexpr size_t WS_W2T = 63 * MiB;
constexpr size_t WS_U = 80 * MiB;
constexpr size_t WS_P = 113 * MiB;
constexpr size_t WS_GT = 113 * MiB;
constexpr size_t WS_MERGED = 211 * MiB;
constexpr size_t WS_XG = 113 * MiB;
constexpr size_t WS_HG = 193 * MiB;
constexpr size_t WS_Y2 = 213 * MiB;
constexpr size_t WS_SCA = 294 * MiB;
constexpr size_t WS_QKD = 303 * MiB;
constexpr size_t WS_SCC = 312 * MiB;
constexpr size_t WS_K1TB = 321 * MiB;
constexpr size_t WS_END = 338 * MiB;

constexpr int LDS_BYTES = 163840;
constexpr int LDS_MISC = LDS_BYTES - 512;
constexpr int LDS_TAB = LDS_BYTES - 1536;
constexpr int LDS_SCRATCH = LDS_TAB;

typedef __bf16 bf16x2v __attribute__((ext_vector_type(2)));
__device__ __forceinline__ unsigned pk2(float lo, float hi) { const f32x2 v = {lo, hi}; return __builtin_bit_cast(unsigned, __builtin_convertvector(v, bf16x2v)); }
__device__ __forceinline__ bf16_t f2bf(float f) { return (bf16_t)(pk2(f, 0.f) & 0xffffu); }
__device__ __forceinline__ float bf2f(bf16_t b) { return __uint_as_float(((unsigned)b) << 16); }
__device__ __forceinline__ float bflo(unsigned w) { return __uint_as_float(w << 16); }
__device__ __forceinline__ float bfhi(unsigned w) { return __uint_as_float(w & 0xffff0000u); }
__device__ __forceinline__ float sigmoidf_(float x) { return __builtin_amdgcn_rcpf(1.0f + __expf(-x)); }
__device__ __forceinline__ float siluf_(float x) { return x * __builtin_amdgcn_rcpf(1.0f + __expf(-x)); }
__device__ __forceinline__ float logsigf_(float x) { return fminf(x, 0.f) - __logf(1.0f + __expf(-fabsf(x))); }
__device__ __forceinline__ float softplusf_(float x) { return fmaxf(x, 0.f) + log1pf(__expf(-fabsf(x))); }
__device__ __forceinline__ bool row_valid(int r) { return r < NREAL || (r >= META_ROW0 && r < META_END); }
__device__ __forceinline__ float wave_sum(float v) {
#define DPP_ADD(ctrl, rmask) v += __int_as_float(__builtin_amdgcn_update_dpp(0, __float_as_int(v), (ctrl), (rmask), 0xf, false))
    DPP_ADD(0x111, 0xf); DPP_ADD(0x112, 0xf); DPP_ADD(0x114, 0xf); DPP_ADD(0x118, 0xf);
    DPP_ADD(0x142, 0xa); DPP_ADD(0x143, 0xc);
#undef DPP_ADD
    return __int_as_float(__builtin_amdgcn_readlane(__float_as_int(v), 63));
}
#define LDS_WAIT() asm volatile("s_waitcnt lgkmcnt(0)" ::: "memory")

#define XB_TMO      128
#define XB_XCNT(j)  (256  + 64 * (j))
#define XB_XSUB(j)  (1280 + 64 * (j))
#define XB_XGEN(j)  (2304 + 64 * (j))
#define XB_TOP      3328
#define XB_TOPGEN   3392
#define XCD_BAR_WORDS 3456
#define XB_SPIN_CAP (1u << 18)
__device__ __forceinline__ unsigned xb_ld(unsigned* p)              { return __hip_atomic_load(p, __ATOMIC_RELAXED, __HIP_MEMORY_SCOPE_AGENT); }
__device__ __forceinline__ unsigned xb_add(unsigned* p, unsigned v) { return __hip_atomic_fetch_add(p, v, __ATOMIC_RELAXED, __HIP_MEMORY_SCOPE_AGENT); }
__device__ __forceinline__ unsigned xb_xcc_id() { return (unsigned)__builtin_amdgcn_s_getreg((3 << 11) | 20) & 0xFu; }
#define XB_SPIN(cond, bar) do { unsigned _sp = 0; while (cond) { __builtin_amdgcn_s_sleep(1); \
    if ((++_sp & 255u) == 0u) { if (xb_ld(&(bar)[XB_TMO])) break; if (_sp > XB_SPIN_CAP) { atomicAdd(&(bar)[XB_TMO], 1u); break; } } } } while (0)
struct XcdBarrier { unsigned* bar; unsigned x; volatile LAS unsigned* st; };
__device__ __forceinline__ XcdBarrier xcd_barrier_post(unsigned* bar, volatile LAS unsigned* st) {
    XcdBarrier b; b.bar = bar; b.x = xb_xcc_id(); b.st = st;
    if (threadIdx.x == 0) (void)xb_add(&bar[XB_XCNT(b.x)], 1u);
    return b;
}
__device__ __forceinline__ void xcd_barrier_complete(unsigned* bar, unsigned x, unsigned& nloc, unsigned& nx, const unsigned G) {
    unsigned sum, cnt, mine, sp = 0u;
    for (;;) {
        sum = 0u; cnt = 0u; mine = 0u;
#pragma unroll
        for (unsigned j = 0; j < 16; ++j) { const unsigned c = xb_ld(&bar[XB_XCNT(j)]); sum += c; cnt += (c > 0u) ? 1u : 0u; mine = (j == x) ? c : mine; }
        if (sum == G) break;
        __builtin_amdgcn_s_sleep(1);
        if ((++sp & 255u) == 0u) { if (xb_ld(&bar[XB_TMO])) break; if (sp > XB_SPIN_CAP) { atomicAdd(&bar[XB_TMO], 1u); break; } }
    }
    nloc = mine > 0u ? mine : 1u; nx = cnt > 0u ? cnt : 1u;
}
__device__ __attribute__((noinline)) void xcd_barrier(unsigned* bar_, unsigned x_, volatile LAS unsigned* st_, int tid_, unsigned G_) {
    XcdBarrier b; b.bar = bar_; b.x = x_; b.st = st_;
    asm volatile("s_waitcnt vmcnt(0)" ::: "memory");
    __syncthreads();
    if (tid_ == 0) {
        unsigned* bar = b.bar;
        __builtin_amdgcn_s_waitcnt(0);
        unsigned nloc = b.st[0], nx = b.st[1];
        if (nloc == 0u) { xcd_barrier_complete(bar, b.x, nloc, nx, G_); b.st[0] = nloc; b.st[1] = nx; }
        const unsigned old = xb_add(&bar[XB_XSUB(b.x)], 1u);
        const unsigned gen = old / nloc;
        if (old + 1u == (gen + 1u) * nloc) {
            __builtin_amdgcn_fence(__ATOMIC_RELEASE, "agent");
            asm volatile("s_waitcnt vmcnt(0)" ::: "memory");
            const unsigned og = xb_add(&bar[XB_TOP], 1u);
            const unsigned tg = og / nx;
            if (og + 1u == (tg + 1u) * nx) xb_add(&bar[XB_TOPGEN], 1u);
            else XB_SPIN(xb_ld(&bar[XB_TOPGEN]) == tg, bar);
            __builtin_amdgcn_fence(__ATOMIC_ACQUIRE, "agent");
            xb_add(&bar[XB_XGEN(b.x)], 1u);
            asm volatile("s_waitcnt vmcnt(0)" ::: "memory");
        } else {
            XB_SPIN(xb_ld(&bar[XB_XGEN(b.x)]) == gen, bar);
            __builtin_amdgcn_fence(__ATOMIC_ACQUIRE, "agent");
            asm volatile("s_waitcnt vmcnt(0)" ::: "memory");
        }
    }
    __syncthreads();
}
namespace pg8 {
constexpr int BM = 256, BK = 64, HALF = 128, HTB = HALF * BK * 2, STAGE_BYTES = 8 * HTB, NXCD = 8, WGM = 8;
__host__ __device__ __forceinline__ int lds_byte(int r, int c) { const int st = (r >> 4) * 2 + (c >> 5), rr = r & 15, cc = c & 31, ob = rr * 64 + cc * 2; return st * 1024 + (ob ^ (((ob >> 9) & 1) << 5)); }
__host__ __device__ __forceinline__ void stage_rc(int b, int& R, int& C) { const int st = b / 1024, sb = b % 1024, swz = sb ^ (((sb >> 9) & 1) << 5); R = (st >> 1) * 16 + swz / 64; C = (st & 1) * 32 + (swz % 64) / 2; }
__host__ __device__ __forceinline__ int perm32(int rho) { const int n = rho >> 4, i = rho & 15; return 8 * (i >> 2) + 4 * n + (i & 3); }

struct Unit { int pm, pn, ex; };
struct Gemm { const bf16_t* A; const bf16_t* Bt; int M, N, K; };

struct StaticOrder {
    int nM, nN, nwg, G, c;
    __device__ void init(int M, int N, int G_, int c_) { nM = M / BM; nN = N / BM; nwg = nM * nN; G = G_; c = c_; }
    __device__ bool next(int i, Unit& u) const {
        const long L = (long)i * G + c; if (L >= nwg) return false;
        int wgid = (int)L; { const int q = nwg / NXCD, r = nwg % NXCD, xcd = wgid % NXCD, off = wgid / NXCD; wgid = (xcd < r ? xcd * (q + 1) : r * (q + 1) + (xcd - r) * q) + off; }
        const int nig = WGM * nN, gid = wgid / nig, fm = gid * WGM, gsz = (nM - fm) < WGM ? (nM - fm) : WGM;
        u.pm = fm + ((wgid % nig) % gsz); u.pn = (wgid % nig) / gsz; u.ex = 0; return true;
    }
    __device__ __forceinline__ void ptrs(const Gemm& g, const Unit& u, const char*& a, const char*& b) const {
        const size_t tstep = (size_t)BM * g.K * 2; a = (const char*)g.A + (size_t)u.pm * tstep; b = (const char*)g.Bt + (size_t)u.pn * tstep; }
};
struct MoeOrder {
    int G, c, npn, ntiles; const LAS unsigned char* tab; size_t estride;
    __device__ bool next(int i, Unit& u) const {
        const long L = (long)i * G + c; if (L >= (long)ntiles * npn) return false;
        u.pm = (int)(L / npn); u.pn = (int)(L % npn); u.ex = (int)tab[u.pm]; return true;
    }
    __device__ __forceinline__ void ptrs(const Gemm& g, const Unit& u, const char*& a, const char*& b) const {
        const size_t tstep = (size_t)BM * g.K * 2; a = (const char*)g.A + (size_t)u.pm * tstep; b = (const char*)g.Bt + (size_t)u.ex * estride + (size_t)u.pn * tstep; }
};

template <class Epi, class Sched>
__device__ __forceinline__ void gemm_phase(LAS unsigned char* lds, const int tid, const Gemm g, const Sched& S, const Epi& E) {
    const int wid = __builtin_amdgcn_readfirstlane(tid >> 6), lane = tid & 63, wr = wid >> 2, wc = wid & 3, fr = lane & 15, fq = lane >> 4;
    int K = g.K; asm volatile("" : "+s"(K));
    const int nt = K / BK;
    unsigned voffA[2], voffB[2];
#pragma unroll
    for (int i = 0; i < 2; ++i) { int R, C; stage_rc(tid * 16 + i * 8192, R, C); const int Rb = Epi::PERM ? ((R & ~31) + perm32(R & 31)) : R;
        voffA[i] = (unsigned)(R * K + C) * 2u; voffB[i] = (unsigned)(Rb * K + C) * 2u; }
    const size_t kstep = (size_t)(BK * 2);
    const size_t hstep = (size_t)HALF * K * 2;
    const unsigned ldsw = (unsigned)wid * 1024u;
    const int aoff = lds_byte(wr * 64 + fr, fq * 8), boff = lds_byte(wc * 32 + fr, fq * 8);
#define PG8_SA(b, h) (((b) * 2 + (h)) * HTB)
#define PG8_SB(b, h) ((4 + (b) * 2 + (h)) * HTB)
#define PG8_STAGE(bufoff, gbase, voff) do { _Pragma("unroll") for (int _i = 0; _i < 2; ++_i) \
        __builtin_amdgcn_global_load_lds((const unsigned*)((const char*)(gbase) + (voff)[_i]), (LAS unsigned*)(lds + (bufoff) + ldsw + _i * 8192), 16, 0, 0); } while (0)
#define PG8_LDA(dst, b, h) do { _Pragma("unroll") for (int m = 0; m < 4; ++m) _Pragma("unroll") for (int k = 0; k < 2; ++k) dst[m][k] = *(const LAS bf16x8*)(lds + PG8_SA(b, h) + aoff + m * 2048 + k * 1024); } while (0)
#define PG8_LDB(dst, b, h) do { _Pragma("unroll") for (int n = 0; n < 2; ++n) _Pragma("unroll") for (int k = 0; k < 2; ++k) dst[n][k] = *(const LAS bf16x8*)(lds + PG8_SB(b, h) + boff + n * 2048 + k * 1024); } while (0)
#define PG8_MMA(ai, bj, At, Bt) do { __builtin_amdgcn_s_setprio(1); _Pragma("unroll") for (int m = 0; m < 4; ++m) _Pragma("unroll") for (int n = 0; n < 2; ++n) _Pragma("unroll") for (int k = 0; k < 2; ++k) \
        acc[ai][bj][m][n] = __builtin_amdgcn_mfma_f32_16x16x32_bf16(Bt[n][k], At[m][k], acc[ai][bj][m][n], 0, 0, 0); __builtin_amdgcn_s_setprio(0); } while (0)
#define PG8_WAIT_V(n) asm volatile("s_waitcnt vmcnt(" #n ")" ::: "memory")
#define PG8_WAIT_L(n) asm volatile("s_waitcnt lgkmcnt(" #n ")" ::: "memory")
#define PG8_BAR __builtin_amdgcn_s_barrier()
#define PG8_SCHED __builtin_amdgcn_sched_barrier(0)
    Unit cur, nxt; int ui = 0;
    if (!S.next(0, cur)) return;
    f32x4 acc[2][2][4][2];
#pragma unroll
    for (int a = 0; a < 2; ++a)
#pragma unroll
        for (int b = 0; b < 2; ++b)
#pragma unroll
            for (int m = 0; m < 4; ++m)
#pragma unroll
                for (int n = 0; n < 2; ++n) acc[a][b][m][n] = (f32x4){0.f, 0.f, 0.f, 0.f};
    bf16x8 At[4][2], B0[2][2], B1[2][2];
    const char* cA; const char* cB; S.ptrs(g, cur, cA, cB);
    PG8_STAGE(PG8_SB(0, 0), cB, voffB); PG8_STAGE(PG8_SA(0, 0), cA, voffA); PG8_STAGE(PG8_SB(0, 1), cB + hstep, voffB); PG8_STAGE(PG8_SA(0, 1), cA + hstep, voffA);
    if (wr == 1) PG8_BAR;
    PG8_WAIT_V(4); PG8_BAR;
    PG8_STAGE(PG8_SB(1, 0), cB + kstep, voffB); PG8_STAGE(PG8_SA(1, 0), cA + kstep, voffA); PG8_STAGE(PG8_SB(1, 1), cB + hstep + kstep, voffB);
    PG8_WAIT_V(6); PG8_BAR;
    for (;;) {
        const bool has_next = S.next(ui + 1, nxt);
        const char* nA = cA; const char* nB = cB; if (has_next) S.ptrs(g, nxt, nA, nB);
        for (int t = 0; t < nt; t += 2) {
            const bool last = (t == nt - 2);
            const char* a1 = cA + (size_t)(t + 1) * kstep;
            const char* a2 = last ? nA : cA + (size_t)(t + 2) * kstep; const char* b2 = last ? nB : cB + (size_t)(t + 2) * kstep;
            const char* a3 = a2 + kstep; const char* b3 = b2 + kstep;
            PG8_LDB(B0, 0, 0); PG8_SCHED; PG8_LDA(At, 0, 0); PG8_STAGE(PG8_SA(1, 1), a1 + hstep, voffA);
            PG8_WAIT_L(8); PG8_BAR; PG8_WAIT_L(0); PG8_MMA(0, 0, At, B0); PG8_BAR; PG8_SCHED;
            PG8_LDB(B1, 0, 1); PG8_STAGE(PG8_SB(0, 0), b2, voffB);
            PG8_BAR; PG8_WAIT_L(0); PG8_MMA(0, 1, At, B1); PG8_BAR;
            PG8_LDA(At, 0, 1); PG8_STAGE(PG8_SA(0, 0), a2, voffA);
            PG8_BAR; PG8_WAIT_L(0); PG8_MMA(1, 0, At, B0); PG8_BAR; PG8_SCHED;
            PG8_STAGE(PG8_SB(0, 1), b2 + hstep, voffB);
            PG8_WAIT_V(6); PG8_BAR; PG8_MMA(1, 1, At, B1); PG8_BAR;
            PG8_LDB(B0, 1, 0); PG8_SCHED; PG8_LDA(At, 1, 0); PG8_STAGE(PG8_SA(0, 1), a2 + hstep, voffA);
            PG8_WAIT_L(8); PG8_BAR; PG8_WAIT_L(0); PG8_MMA(0, 0, At, B0); PG8_BAR; PG8_SCHED;
            PG8_LDB(B1, 1, 1); PG8_STAGE(PG8_SB(1, 0), b3, voffB);
            PG8_BAR; PG8_WAIT_L(0); PG8_MMA(0, 1, At, B1); PG8_BAR;
            PG8_LDA(At, 1, 1); PG8_STAGE(PG8_SA(1, 0), a3, voffA);
            PG8_BAR; PG8_WAIT_L(0); PG8_MMA(1, 0, At, B0); PG8_BAR; PG8_SCHED;
            PG8_STAGE(PG8_SB(1, 1), b3 + hstep, voffB);
            PG8_WAIT_V(6); PG8_BAR; PG8_MMA(1, 1, At, B1); PG8_BAR;
        }
        E(acc, cur, wr, wc, fr, fq);
        if (!has_next) break;
#pragma unroll
        for (int a = 0; a < 2; ++a)
#pragma unroll
            for (int b = 0; b < 2; ++b)
#pragma unroll
                for (int m = 0; m < 4; ++m)
#pragma unroll
                    for (int n = 0; n < 2; ++n) acc[a][b][m][n] = (f32x4){0.f, 0.f, 0.f, 0.f};
        cur = nxt; cA = nA; cB = nB; ++ui;
    }
    PG8_WAIT_V(0);
    if (wr == 0) PG8_BAR;
    PG8_BAR;
#undef PG8_SA
#undef PG8_SB
#undef PG8_STAGE
#undef PG8_LDA
#undef PG8_LDB
#undef PG8_MMA
#undef PG8_WAIT_V
#undef PG8_WAIT_L
#undef PG8_BAR
#undef PG8_SCHED
}

#define EPI_PERM_LOOP(...) \
    _Pragma("unroll") for (int ai = 0; ai < 2; ++ai) _Pragma("unroll") for (int m = 0; m < 4; ++m) { const int row = u.pm * BM + ai * HALF + wr * 64 + m * 16 + fr; \
        _Pragma("unroll") for (int bj = 0; bj < 2; ++bj) { const int col0 = u.pn * BM + bj * HALF + wc * 32 + 8 * fq; f32x4 v0 = acc[ai][bj][m][0], v1 = acc[ai][bj][m][1]; __VA_ARGS__ } __builtin_amdgcn_sched_barrier(0); }

struct EpiInProj {
    static constexpr bool PERM = true;
    bf16_t* P; bf16_t* halo;
    __device__ __forceinline__ void operator()(const f32x4 (&acc)[2][2][4][2], const Unit& u, int wr, int wc, int fr, int fq) const {
        const bool is_qkv = u.pn >= 8 && u.pn < 14;
        EPI_PERM_LOOP({
            u32x4 w; w.x = pk2(v0[0], v0[1]); w.y = pk2(v0[2], v0[3]); w.z = pk2(v1[0], v1[1]); w.w = pk2(v1[2], v1[3]);
            *(u32x4*)(P + (size_t)row * LDP + col0) = w;
            if (is_qkv && (row & 63) >= 61) *(u32x4*)(halo + ((size_t)(row >> 6) * 3 + ((row & 63) - 61)) * 1536 + (col0 - PC_BQKV)) = w;
        })
    }
};
__device__ __forceinline__ float lfg(float a, float lb1, float x) { const float b = lb1 + logsigf_(x), mx = fmaxf(a, b); return mx + __logf(__expf(a - mx) + __expf(b - mx)); }
struct EpiSigmoid {
    static constexpr bool PERM = true;
    bf16_t* O; int ldc;
    __device__ __forceinline__ void operator()(const f32x4 (&acc)[2][2][4][2], const Unit& u, int wr, int wc, int fr, int fq) const {
        EPI_PERM_LOOP({
            u32x4 w; w.x = pk2(sigmoidf_(v0[0]), sigmoidf_(v0[1])); w.y = pk2(sigmoidf_(v0[2]), sigmoidf_(v0[3])); w.z = pk2(sigmoidf_(v1[0]), sigmoidf_(v1[1])); w.w = pk2(sigmoidf_(v1[2]), sigmoidf_(v1[3]));
            *(u32x4*)(O + (size_t)row * ldc + col0) = w;
        })
    }
};
struct EpiBranch {
    static constexpr bool PERM = true;
    bf16_t* merged; const bf16_t* gt; int n;
    __device__ __forceinline__ void operator()(const f32x4 (&acc)[2][2][4][2], const Unit& u, int wr, int wc, int fr, int fq) const {
        EPI_PERM_LOOP({
            const u32x4 gw = *(const u32x4*)(gt + (size_t)row * 3072 + n * 1024 + col0);
            float x[8] = {v0[0] * bflo(gw.x), v0[1] * bfhi(gw.x), v0[2] * bflo(gw.y), v0[3] * bfhi(gw.y), v1[0] * bflo(gw.z), v1[1] * bfhi(gw.z), v1[2] * bflo(gw.w), v1[3] * bfhi(gw.w)};
            bf16_t* mp = merged + (size_t)row * 1024 + col0;
            if (n != 0) { const u32x4 o = *(const u32x4*)mp; x[0] += bflo(o.x); x[1] += bfhi(o.x); x[2] += bflo(o.y); x[3] += bfhi(o.y); x[4] += bflo(o.z); x[5] += bfhi(o.z); x[6] += bflo(o.w); x[7] += bfhi(o.w); }
            u32x4 w; w.x = pk2(x[0], x[1]); w.y = pk2(x[2], x[3]); w.z = pk2(x[4], x[5]); w.w = pk2(x[6], x[7]);
            *(u32x4*)mp = w;
        })
    }
};
struct EpiResidual {
    static constexpr bool PERM = false;
    float* hreal; float* hmeta;
    __device__ __forceinline__ void operator()(const f32x4 (&acc)[2][2][4][2], const Unit& u, int wr, int wc, int fr, int fq) const {
#pragma unroll
        for (int ai = 0; ai < 2; ++ai)
#pragma unroll
            for (int m = 0; m < 4; ++m) { const int row = u.pm * BM + ai * HALF + wr * 64 + m * 16 + fr;
                float* rowp = (row < NREAL ? hreal + (size_t)row * D : hmeta + (size_t)(row - NREAL) * D) + u.pn * BM + wc * 32 + 4 * fq;
#pragma unroll
                for (int bj = 0; bj < 2; ++bj)
#pragma unroll
                    for (int n = 0; n < 2; ++n) { f32x4* p = (f32x4*)(rowp + bj * HALF + n * 16); *p = *p + acc[ai][bj][m][n]; } }
    }
};
struct EpiMoeUp {
    static constexpr bool PERM = true;
    bf16_t* H;
    __device__ __forceinline__ void operator()(const f32x4 (&acc)[2][2][4][2], const Unit& u, int wr, int wc, int fr, int fq) const {
        EPI_PERM_LOOP({
            const int hc = col0 >> 1;
            u32x2 w; w.x = pk2(siluf_(v0[0]) * v1[0], siluf_(v0[1]) * v1[1]); w.y = pk2(siluf_(v0[2]) * v1[2], siluf_(v0[3]) * v1[3]);
            *(u32x2*)(H + (size_t)row * 256 + hc) = w;
        })
    }
};
struct EpiMoeDown {
    static constexpr bool PERM = true;
    bf16_t* Y; const float* wrow;
    __device__ __forceinline__ void operator()(const f32x4 (&acc)[2][2][4][2], const Unit& u, int wr, int wc, int fr, int fq) const {
        EPI_PERM_LOOP({
            const float s = wrow[row];
            u32x4 w; w.x = pk2(v0[0] * s, v0[1] * s); w.y = pk2(v0[2] * s, v0[3] * s); w.z = pk2(v1[0] * s, v1[1] * s); w.w = pk2(v1[2] * s, v1[3] * s);
            *(u32x4*)(Y + (size_t)row * 1024 + col0) = w;
        })
    }
};
}
#define GAS __attribute__((address_space(1)))
struct Params { const float* in[24]; float* out; unsigned char* ws; int ph_lo, ph_hi; };
struct Frame {
    LAS unsigned char* lds; int tid, lane, wave, G, bid;
    __attribute__((address_space(1))) float* out; __attribute__((address_space(1))) unsigned char* ws; const float* const __attribute__((address_space(4)))* inp; int dry;
};
#define PHASE_FENCE(F) do { asm volatile("" : "+s"((F).ws), "+s"((F).out), "+s"((F).inp), "+v"((F).tid), "+s"((F).bid), "+s"((F).G)); \
    (F).lane = (F).tid & 63; (F).wave = __builtin_amdgcn_readfirstlane((F).tid >> 6); } while (0)
__device__ __forceinline__ const float* inp_ptr(const float* const __attribute__((address_space(4)))* inp, int i) { GAS const float* q = (GAS const float*)inp[i]; asm volatile("" : "+s"(q)); return (const float*)q; }
#define INP(i) inp_ptr(F.inp, (i))
#define WSP(T, off) ((T*)(GAS T*)(F.ws + (off)))
enum { I_X = 0, I_META, I_NORM_MIX, I_W_IN, I_LB, I_HGRN_NORM, I_GDN_CONV, I_GDN_ALOG, I_GDN_DT, I_GDN_NORM, I_GLA_W2, I_GLA_B, I_GLA_NORM, I_W_BRANCH, I_W_OUT, I_NORM_FFN,
       I_RG_W, I_RG_B, I_RE_W, I_RE_B, I_EW_GATE, I_EW_UP, I_EW_DOWN, I_NORM_FINAL };

__device__ __forceinline__ void transpose_item(const float* W, int ldw, int K, int nblk, bf16_t* WT, int row_off, int rowmode, LAS float* scr, int item, int lane) {
    const int kb = item / nblk, nb = item % nblk, k0 = 64 * kb, n0 = 32 * nb;
#pragma unroll 8
    for (int i = 0; i < 32; ++i) { const int kk = 2 * i + (lane >> 5); scr[kk * 33 + (lane & 31)] = W[(size_t)(k0 + kk) * ldw + n0 + (lane & 31)]; }
    LDS_WAIT(); asm volatile("" ::: "memory");
    const int c = lane & 7;
#pragma unroll
    for (int j = 0; j < 4; ++j) { const int n = (lane >> 3) + 8 * j; const LAS float* s = scr + (8 * c) * 33 + n;
        u32x4 o; o.x = pk2(s[0 * 33], s[1 * 33]); o.y = pk2(s[2 * 33], s[3 * 33]); o.z = pk2(s[4 * 33], s[5 * 33]); o.w = pk2(s[6 * 33], s[7 * 33]);
        const int nn = n0 + n; const int wrow = rowmode == 0 ? row_off + nn : row_off + 8 * (nn >> 2) + (nn & 3) + (rowmode == 2 ? 4 : 0);
        *(u32x4*)(WT + (size_t)wrow * K + k0 + 8 * c) = o; }
    LDS_WAIT(); asm volatile("" ::: "memory");
}

__device__ __forceinline__ void phase_pre(Frame& F) {
    const int gt = F.bid * NTHREADS + F.tid, NT = F.G * NTHREADS;
    float* sw1 = WSP(float, SM_SW1); float* rwg = WSP(float, SM_RWG); float* rwe = WSP(float, SM_RWE); float* lab = WSP(float, SM_LAB);
    for (int i = gt; i < 2 * 24 * 1024; i += NT) { const int l = i / (24 * 1024), c = (i / 1024) % 24, k = i % 1024;
        const int col = c < 16 ? 5128 + c : (c < 20 ? 3584 + (c - 16) : 3588 + (c - 20));
        sw1[i] = INP(I_W_IN)[((size_t)l * 1024 + k) * IN_COLS + col]; }
    for (int i = gt; i < 2 * 4 * 1024; i += NT) { const int l = i / (4 * 1024), c = (i / 1024) % 4, k = i % 1024; rwg[i] = INP(I_RG_W)[((size_t)l * 1024 + k) * 4 + c]; }
    for (int i = gt; i < 2 * 32 * 1024; i += NT) { const int l = i / (32 * 1024), c = (i / 1024) % 32, k = i % 1024; rwe[i] = INP(I_RE_W)[((size_t)l * 1024 + k) * 32 + c]; }
    for (int i = gt; i < 2 * 512; i += NT) { const int l = i / 512, c = i % 512; const float l0 = INP(I_LB)[c], l1 = INP(I_LB)[512 + c];
        const float p1 = 1.0f / (1.0f + expf(l0 - l1)); const float lb = l == 0 ? 0.f : p1;
        lab[l * 1024 + c] = logf(fmaxf(lb, 1e-30f)); lab[l * 1024 + 512 + c] = log1pf(-lb); }
}

__device__ __forceinline__ void convert_layer_weights(Frame& F, int l) {
    LAS float* scr = (LAS float*)(F.lds + F.wave * 16384);
    const int gw = F.bid * NWAVES + F.wave, NGW = F.G * NWAVES;
    const float* win = INP(I_W_IN) + (size_t)l * 1024 * IN_COLS;
    constexpr int I_MIX = 16 * 176, I_GATE = 16 * 96, I_BR = 8 * 32, I_OUT = 16 * 32, NITEMS = I_MIX + I_GATE + 3 * I_BR + I_OUT;
    for (int it = gw; it < NITEMS; it += NGW) {
        int r = it;
        if (r < I_MIX) { const int nb = r % 176, n0 = 32 * nb; const int shift = n0 < 3584 ? 0 : (n0 < 5120 ? 8 : 24);
            transpose_item(win + shift, IN_COLS, 1024, 176, WSP(bf16_t, WS_WMIX), 0, 0, scr, r, F.lane); continue; } r -= I_MIX;
        if (r < I_GATE) { transpose_item(win + 5656, IN_COLS, 1024, 96, WSP(bf16_t, WS_WGATE), 0, 0, scr, r, F.lane); continue; } r -= I_GATE;
        if (r < 3 * I_BR) { const int n = r / I_BR; transpose_item(INP(I_W_BRANCH) + ((size_t)l * 3 + n) * 512 * 1024, 1024, 512, 32, WSP(bf16_t, WS_WBT) + (size_t)n * 1024 * 512, 0, 0, scr, r % I_BR, F.lane); continue; } r -= 3 * I_BR;
        transpose_item(INP(I_W_OUT) + (size_t)l * 1024 * 1024, 1024, 1024, 32, WSP(bf16_t, WS_WOT), 0, 0, scr, r, F.lane);
    }
}
__device__ __forceinline__ void convert_expert_weights(Frame& F, int l) {
    LAS float* scr = (LAS float*)(F.lds + F.wave * 16384);
    const int gw = F.bid * NWAVES + F.wave, NGW = F.G * NWAVES;
    constexpr int I_G = 16 * 8, I_D = 4 * 32, PER = 2 * I_G + I_D;
    for (int it = gw; it < 32 * PER; it += NGW) {
        const int e = it / PER; int r = it % PER;
        bf16_t* w1t = WSP(bf16_t, WS_W1T) + (size_t)e * 512 * 1024; bf16_t* w2t = WSP(bf16_t, WS_W2T) + (size_t)e * 1024 * 256;
        if (r < I_G) { transpose_item(INP(I_EW_GATE) + ((size_t)l * 32 + e) * 1024 * 256, 256, 1024, 8, w1t, 0, 1, scr, r, F.lane); continue; } r -= I_G;
        if (r < I_G) { transpose_item(INP(I_EW_UP) + ((size_t)l * 32 + e) * 1024 * 256, 256, 1024, 8, w1t, 0, 2, scr, r, F.lane); continue; } r -= I_G;
        transpose_item(INP(I_EW_DOWN) + ((size_t)l * 32 + e) * 256 * 1024, 1024, 256, 32, w2t, 0, 0, scr, r, F.lane);
    }
}

#define OUTP ((float*)F.out)
__device__ __forceinline__ float* hrow(Frame& F, int r) { return r < NREAL ? OUTP + (size_t)r * D : WSP(float, WS_HMETA) + (size_t)(r - NREAL) * D; }

__device__ __forceinline__ void load_row16(const float* p, int lane, float (&x)[16]) {
#pragma unroll
    for (int j = 0; j < 4; ++j) { const f32x4 v = *((const f32x4*)p + lane + 64 * j); x[4 * j] = v[0]; x[4 * j + 1] = v[1]; x[4 * j + 2] = v[2]; x[4 * j + 3] = v[3]; }
}
__device__ __forceinline__ void add_bf16_row16(const bf16_t* p, int lane, float (&x)[16]) {
#pragma unroll
    for (int j = 0; j < 4; ++j) { const u32x2 w = *((const u32x2*)p + lane + 64 * j); x[4 * j] += bflo(w.x); x[4 * j + 1] += bfhi(w.x); x[4 * j + 2] += bflo(w.y); x[4 * j + 3] += bfhi(w.y); }
}
__device__ __forceinline__ void store_row16(float* p, int lane, const float (&x)[16]) {
#pragma unroll
    for (int j = 0; j < 4; ++j) *((f32x4*)p + lane + 64 * j) = (f32x4){x[4 * j], x[4 * j + 1], x[4 * j + 2], x[4 * j + 3]};
}
__device__ __forceinline__ void store_bf16_row16(bf16_t* p, int lane, const float (&x)[16]) {
#pragma unroll
    for (int j = 0; j < 4; ++j) { u32x2 w; w.x = pk2(x[4 * j], x[4 * j + 1]); w.y = pk2(x[4 * j + 2], x[4 * j + 3]); *((u32x2*)p + lane + 64 * j) = w; }
}
__device__ __forceinline__ void fetch_h_row(Frame& F, int l, int r, float (&x)[16]) {
    if (l == 0) {
        const float* src = r < NREAL ? INP(I_X) + (size_t)r * D : INP(I_META) + (size_t)(r - META_ROW0) * D;
        load_row16(src, F.lane, x);
    } else {
        load_row16(hrow(F, r), F.lane, x);
        const unsigned* tok = WSP(unsigned, SM_TOK) + (size_t)r * 8;
        const unsigned g0 = tok[6], g1 = tok[7];
        add_bf16_row16(WSP(bf16_t, WS_Y2) + (size_t)g0 * 1024, F.lane, x);
        add_bf16_row16(WSP(bf16_t, WS_Y2) + (size_t)g1 * 1024, F.lane, x);
    }
}

__device__ __forceinline__ void phase_norm1(Frame& F, int l) {
    convert_layer_weights(F, l);
    __syncthreads();
    LAS float* sw = (LAS float*)F.lds;
    { const float* src = WSP(float, SM_SW1) + (size_t)l * 24 * 1024; for (int i = F.tid; i < 24 * 1024 / 4; i += NTHREADS) ((LAS f32x4*)sw)[i] = ((const f32x4*)src)[i]; }
    __syncthreads();
    const int gw = F.bid * NWAVES + F.wave, NGW = F.G * NWAVES, lane = F.lane;
    const float* nw = INP(I_NORM_MIX) + (size_t)l * D;
    float wv[16]; load_row16(nw, lane, wv);
    bf16_t* U = WSP(bf16_t, WS_U);
    for (int g = gw; g < MROWS / 4; g += NGW) {
        const int r0 = 4 * g;
        if (!row_valid(r0)) {
            float z[16];
#pragma unroll
            for (int j = 0; j < 16; ++j) z[j] = 0.f;
#pragma unroll
            for (int i = 0; i < 4; ++i) { store_bf16_row16(U + (size_t)(r0 + i) * D, lane, z); if (l == 0) store_row16(hrow(F, r0 + i), lane, z);
                if (lane < 16) WSP(float, SM_GK)[(size_t)(r0 + i) * 16 + lane] = 0.f;
                else if (lane < 20) WSP(float, SM_BETA)[(size_t)(r0 + i) * 4 + (lane - 16)] = 0.f;
                else if (lane < 24) WSP(float, SM_LOGA)[(size_t)(r0 + i) * 4 + (lane - 20)] = 0.f; }
            continue;
        }
        float x[4][16];
#pragma unroll
        for (int i = 0; i < 4; ++i) {
            fetch_h_row(F, l, r0 + i, x[i]);
            store_row16(hrow(F, r0 + i), lane, x[i]);
            float ss = 0.f;
#pragma unroll
            for (int j = 0; j < 16; ++j) ss += x[i][j] * x[i][j];
            const float rstd = rsqrtf(wave_sum(ss) * (1.0f / D) + 1e-6f);
#pragma unroll
            for (int j = 0; j < 16; ++j) x[i][j] = x[i][j] * rstd * wv[j];
            store_bf16_row16(U + (size_t)(r0 + i) * D, lane, x[i]);
        }
        float ov[4] = {0.f, 0.f, 0.f, 0.f};
#pragma unroll 1
        for (int c = 0; c < 24; ++c) {
            float a0 = 0.f, a1 = 0.f, a2 = 0.f, a3 = 0.f;
#pragma unroll
            for (int j = 0; j < 4; ++j) { const f32x4 w = *((const LAS f32x4*)(sw + c * 1024) + lane + 64 * j);
#pragma unroll
                for (int e = 0; e < 4; ++e) { a0 += x[0][4 * j + e] * w[e]; a1 += x[1][4 * j + e] * w[e]; a2 += x[2][4 * j + e] * w[e]; a3 += x[3][4 * j + e] * w[e]; } }
            a0 = wave_sum(a0); a1 = wave_sum(a1); a2 = wave_sum(a2); a3 = wave_sum(a3);
            if (lane == c) { ov[0] = a0; ov[1] = a1; ov[2] = a2; ov[3] = a3; }
        }
        float* GK = WSP(float, SM_GK); float* BETA = WSP(float, SM_BETA); float* LOGA = WSP(float, SM_LOGA);
#pragma unroll
        for (int i = 0; i < 4; ++i) {
            const float v = ov[i]; const int r = r0 + i;
            if (lane < 16) GK[(size_t)r * 16 + lane] = v;
            else if (lane < 20) BETA[(size_t)r * 4 + (lane - 16)] = sigmoidf_(v);
            else if (lane < 24) { const int h = lane - 20; LOGA[(size_t)r * 4 + h] = -expf(INP(I_GDN_ALOG)[l * 4 + h]) * softplusf_(v + INP(I_GDN_DT)[l * 4 + h]); }
        }
    }
}

__device__ __forceinline__ bf16x8 mk8(u32x4 w) { return __builtin_bit_cast(bf16x8, w); }
__device__ __forceinline__ bf16x8 mk8(u32x2 lo, u32x2 hi) { u32x4 w; w.x = lo.x; w.y = lo.y; w.z = hi.x; w.w = hi.y; return __builtin_bit_cast(bf16x8, w); }
__device__ __forceinline__ bf16x8 pack_acc2(const f32x4& a, const f32x4& b) { u32x4 w; w.x = pk2(a[0], a[1]); w.y = pk2(a[2], a[3]); w.z = pk2(b[0], b[1]); w.w = pk2(b[2], b[3]); return __builtin_bit_cast(bf16x8, w); }
#define MFMA16(a, b, c) __builtin_amdgcn_mfma_f32_16x16x32_bf16((a), (b), (c), 0, 0, 0)

__device__ __forceinline__ int permpos(int k) { const int kk = k & 31; return (k & ~31) + ((kk & 16) ? 8 * ((kk - 16) >> 2) + 4 + (kk & 3) : 8 * (kk >> 2) + (kk & 3)); }
__device__ __forceinline__ float ldbf(GAS const bf16_t* p) { return bf2f(*p); }
#define ROWB(P, row, col) ((GAS const char*)(P) + ((size_t)(row) * LDP + (col)) * 2)
__device__ __forceinline__ float ldrow(GAS const char* rb, unsigned voff) { return bf2f(*(GAS const bf16_t*)(rb + voff)); }
__device__ __forceinline__ unsigned ldrow_u(GAS const char* rb, unsigned voff) { return (unsigned)*(GAS const bf16_t*)(rb + voff); }
__device__ __forceinline__ void strow(GAS const char* rb, unsigned voff, bf16_t v) { *(GAS bf16_t*)(rb + voff) = v; }

template <int DK, bool IS_A>
__device__ __forceinline__ void prep_gla(Frame& F, int l, int ug) {
    constexpr int QP = DK + 8, SUB = 2 * 64 * QP * 2 + 1024;
    int tid = F.tid; asm volatile("" : "+v"(tid));
    const int sg = __builtin_amdgcn_readfirstlane(tid >> 8), lt = tid & 255, c = lt & 127, hf = __builtin_amdgcn_readfirstlane(lt >> 7);
    const int unit = 2 * ug + sg, slot = unit >> 2, h = unit & 3, row0 = slot * 64, r0 = row0 + 32 * hf;
    const int qcol = IS_A ? PC_AQ + h * 128 : PC_CQ + h * 64, kcol = IS_A ? PC_AF + h * 128 : PC_CK + h * 64, vcol = IS_A ? PC_AI + h * 128 : PC_CV + h * 128;
    bf16_t* P = WSP(bf16_t, WS_P);
    LAS bf16_t* qt = (LAS bf16_t*)(F.lds + sg * SUB);
    LAS bf16_t* kt = qt + 64 * QP;
    LAS float* tot = (LAS float*)(kt + 64 * QP);
    const bool act = c < DK;
    float b[32];
    const unsigned vo = (unsigned)c * 2u, vop = (unsigned)permpos(c) * 2u;
    if (act) {
        float run = 0.f;
        if (IS_A) { const float* lab = WSP(float, SM_LAB) + l * 1024 + h * 128 + c; const float la = lab[0], lb = lab[512];
#pragma unroll
            for (int t = 0; t < 32; ++t) { run += pg8::lfg(la, lb, ldrow(ROWB(P, r0 + t, kcol), vo)); b[t] = run; }
        } else { float w2c[16]; const float* w2 = INP(I_GLA_W2) + (size_t)l * 16 * 256 + h * 64 + c; const float bias = INP(I_GLA_B)[l * 256 + h * 64 + c];
#pragma unroll
            for (int j = 0; j < 16; ++j) w2c[j] = w2[j * 256];
            const float* gk = WSP(float, SM_GK) + (size_t)r0 * 16;
#pragma unroll
            for (int t = 0; t < 32; ++t) { float s = bias;
#pragma unroll
                for (int j = 0; j < 16; ++j) s += gk[t * 16 + j] * w2c[j];
                run += logsigf_(s) * (1.0f / 16.0f); b[t] = run; }
        }
        tot[hf * 128 + c] = run;
    }
    __syncthreads();
    unsigned q1p[16], k1p[16];
    if (act) {
        const float bm = tot[c], bl = bm + tot[128 + c], boff = hf ? bm : 0.f;
        if (hf == 0 && !F.dry) (IS_A ? WSP(float, SM_DECA) + (size_t)unit * 128 : WSP(float, SM_DECC) + (size_t)unit * 64)[c] = __expf(bl);
#pragma unroll
        for (int t2 = 0; t2 < 16; ++t2) { float q1v[2], k1v[2];
#pragma unroll
            for (int u = 0; u < 2; ++u) { const int t = 2 * t2 + u; const float bt = b[t] + boff;
                const float qr = ldrow(ROWB(P, r0 + t, qcol), vo), q = IS_A ? siluf_(qr) * 0.08838834764831845f : qr * 0.125f;
                float k;
                if (IS_A) { const float lf = t == 0 ? b[0] : b[t] - b[t - 1]; k = row_valid(r0 + t) ? 1.0f - __expf(lf) : 0.f; } else k = ldrow(ROWB(P, r0 + t, kcol), vo);
                q1v[u] = q * __expf(bt); k1v[u] = k * __expf(bl - bt);
                qt[(32 * hf + t) * QP + c] = f2bf(q * __expf(fminf(bt - bm, 80.f))); kt[(32 * hf + t) * QP + c] = f2bf(k * __expf(fminf(bm - bt, 80.f))); }
            q1p[t2] = pk2(q1v[0], q1v[1]); k1p[t2] = pk2(k1v[0], k1v[1]); }
    }
    __syncthreads();
    if (act) {
        if (!F.dry) {
#pragma unroll
        for (int t2 = 0; t2 < 16; ++t2) { strow(ROWB(P, r0 + 2 * t2, qcol), vop, (bf16_t)(q1p[t2] & 0xffffu)); strow(ROWB(P, r0 + 2 * t2 + 1, qcol), vop, (bf16_t)(q1p[t2] >> 16)); } }
        bf16_t* kd = (IS_A ? P + (size_t)(row0 + (c >> 1)) * LDP + kcol + (c & 1) * 64 : P + (size_t)(row0 + c) * LDP + kcol) + 32 * hf;
#pragma unroll
        for (int o = 0; o < 4; ++o) if (!F.dry) *(u32x4*)(kd + 8 * o) = (u32x4){k1p[4 * o], k1p[4 * o + 1], k1p[4 * o + 2], k1p[4 * o + 3]};
    }
    { const int ws = (tid >> 6) & 3, lane = tid & 63, fr = lane & 15, fq = lane >> 4;
        bf16_t* sc = (IS_A ? WSP(bf16_t, WS_SCA) : WSP(bf16_t, WS_SCC)) + (size_t)unit * 4096;
#pragma unroll
        for (int jt = 0; jt < 4; ++jt) { const int mt = ws, nt = jt; f32x4 acc = {0.f, 0.f, 0.f, 0.f};
            if (nt <= mt) {
#pragma unroll
                for (int ks = 0; ks < DK / 32; ++ks) { const bf16x8 a = *(const LAS bf16x8*)(qt + (16 * mt + fr) * QP + 32 * ks + 8 * fq), bb = *(const LAS bf16x8*)(kt + (16 * nt + fr) * QP + 32 * ks + 8 * fq); acc = MFMA16(a, bb, acc); } }
#pragma unroll
            for (int r = 0; r < 4; ++r) { const int t = 16 * mt + 4 * fq + r, s = 16 * nt + fr; if (!F.dry) sc[t * 64 + s] = (s <= t) ? f2bf(acc[r]) : (bf16_t)0; } }
    }
    { unsigned vp[16];
#pragma unroll
        for (int t2 = 0; t2 < 16; ++t2) { vp[t2] = ldrow_u(ROWB(P, r0 + 2 * t2, vcol), vo) | (ldrow_u(ROWB(P, r0 + 2 * t2 + 1, vcol), vo) << 16); }
        __syncthreads();
        bf16_t* vd = P + (size_t)(row0 + (c >> 1)) * LDP + vcol + (c & 1) * 64 + 32 * hf;
#pragma unroll
        for (int o = 0; o < 4; ++o) if (!F.dry) *(u32x4*)(vd + 8 * o) = (u32x4){vp[4 * o], vp[4 * o + 1], vp[4 * o + 2], vp[4 * o + 3]}; }
    __syncthreads();
}

__device__ __forceinline__ void prep_gdn(Frame& F, int l, int ug) {
    constexpr int NP = 136, SUB = 2 * 64 * NP * 2 + 64 * 68 * 4 + 1024;
    int tid = F.tid; asm volatile("" : "+v"(tid));
    const int lane = tid & 63, sg = __builtin_amdgcn_readfirstlane(tid >> 8), lt = tid & 255, unit = 2 * ug + sg, slot = unit >> 2, h = unit & 3, row0 = slot * 64;
    bf16_t* P = WSP(bf16_t, WS_P);
    LAS bf16_t* qs = (LAS bf16_t*)(F.lds + sg * SUB);
    LAS bf16_t* ks = qs + 64 * NP;
    LAS float* AT = (LAS float*)(F.lds + sg * SUB + 2 * 64 * NP * 2);
    LAS float* gs = AT + 64 * 68;
    if (lt < 64) { const int valid_u = 1; (void)valid_u; float g = WSP(float, SM_LOGA)[(size_t)(row0 + lt) * 4 + h];
#pragma unroll
        for (int o = 1; o < 64; o <<= 1) { const float t = __shfl_up(g, o); if (lane >= o) g += t; }
        gs[lt] = g; gs[64 + lt] = WSP(float, SM_BETA)[(size_t)(row0 + lt) * 4 + h];
        if (lt == 63 && !F.dry) WSP(float, SM_DECB)[unit] = __expf(g); }
    const int hslot = slot == 256 ? -1 : ((slot & 63) == 0 ? 256 : slot - 1);
    float col[64];
    {
        const int c = lt & 127;
#pragma unroll
        for (int pass = 0; pass < 2; ++pass) {
            if (pass == 1 && lt >= 128) break;
            const int comp = lt >= 128 ? 1 : (pass == 0 ? 0 : 2), ch = comp * 512 + h * 128 + c;
            const float w0 = INP(I_GDN_CONV)[((size_t)l * 4 + 0) * 1536 + ch], w1 = INP(I_GDN_CONV)[((size_t)l * 4 + 1) * 1536 + ch], w2 = INP(I_GDN_CONV)[((size_t)l * 4 + 2) * 1536 + ch], w3 = INP(I_GDN_CONV)[((size_t)l * 4 + 3) * 1536 + ch];
            const unsigned voc = (unsigned)c * 2u; const int ccol = PC_BQKV + comp * 512 + h * 128;
            float x0 = 0.f, x1 = 0.f, x2 = 0.f;
            if (hslot >= 0) { const bf16_t* hp = WSP(bf16_t, SM_HALO) + (size_t)hslot * 3 * 1536 + ch; x0 = bf2f(hp[0]); x1 = bf2f(hp[1536]); x2 = bf2f(hp[3072]); }
#pragma unroll
            for (int t = 0; t < 64; ++t) { const float x3 = ldrow(ROWB(P, row0 + t, ccol), voc); const float y = siluf_(w0 * x0 + w1 * x1 + w2 * x2 + w3 * x3); x0 = x1; x1 = x2; x2 = x3;
                if (comp == 0) qs[t * NP + c] = f2bf(y); else { col[t] = y; if (comp == 1) ks[t * NP + c] = f2bf(y); } }
        }
    }
    __syncthreads();
    const int wv = (tid >> 6) & 3, fr = lane & 15, fq = lane >> 4;
#pragma unroll
    for (int jt = 0; jt < 2; ++jt) { const int which = jt, mt = wv; const LAS bf16_t* ap = which ? qs : ks; f32x4 a4 = {0.f, 0.f, 0.f, 0.f};
#pragma unroll
        for (int k4 = 0; k4 < 4; ++k4) { const bf16x8 a = *(const LAS bf16x8*)(ap + (16 * mt + fr) * NP + 32 * k4 + 8 * fq); a4 = MFMA16(a, a, a4); }
#pragma unroll
        for (int r = 0; r < 4; ++r) if (4 * fq + r == fr) { if (which == 0) gs[128 + 16 * mt + fr] = rsqrtf(a4[r] + 1e-6f); else gs[192 + 16 * mt + fr] = rsqrtf(a4[r] + 1e-6f) * 0.08838834764831845f; } }
    __syncthreads();
    { bf16_t* qkd = WSP(bf16_t, WS_QKD) + (size_t)unit * 4096;
#pragma unroll
        for (int jt = 0; jt < 8; ++jt) { const int tile = wv * 8 + jt, which = tile >> 4, mt = (tile >> 2) & 3, nt = tile & 3;
            const LAS bf16_t* ap = which ? qs : ks; f32x4 a4 = {0.f, 0.f, 0.f, 0.f};
            if (nt <= mt) {
#pragma unroll
                for (int k4 = 0; k4 < 4; ++k4) { const bf16x8 a = *(const LAS bf16x8*)(ap + (16 * mt + fr) * NP + 32 * k4 + 8 * fq), bb = *(const LAS bf16x8*)(ks + (16 * nt + fr) * NP + 32 * k4 + 8 * fq); a4 = MFMA16(a, bb, a4); } }
#pragma unroll
            for (int r = 0; r < 4; ++r) { const int t = 16 * mt + 4 * fq + r, s = 16 * nt + fr; const float dec = __expf(fminf(gs[t] - gs[s], 0.f)) * gs[128 + s];
                if (which) { if (!F.dry) qkd[t * 64 + permpos(s)] = (s <= t) ? f2bf(a4[r] * dec * gs[192 + t]) : (bf16_t)0; }
                else AT[s * 68 + t] = (s < t) ? gs[64 + t] * gs[128 + t] * a4[r] * dec : 0.f; } }
    }
    if (lt >= 128) { const int d = lt - 128; const float gl = gs[63]; bf16_t* dst = WSP(bf16_t, WS_K1TB) + (size_t)unit * 8192 + d * 64;
#pragma unroll
        for (int o = 0; o < 8; ++o) { const int s0 = 32 * (o >> 2) + 4 * (o & 3); float y[8];
#pragma unroll
            for (int j = 0; j < 8; ++j) { const int s = s0 + (j & 3) + (j >> 2) * 16; y[j] = col[s] * gs[128 + s] * __expf(gl - gs[s]); }
            if (!F.dry) *(u32x4*)(dst + 8 * o) = (u32x4){pk2(y[0], y[1]), pk2(y[2], y[3]), pk2(y[4], y[5]), pk2(y[6], y[7])}; }
    } else { const int pp = permpos(lt);
#pragma unroll 8
        for (int t = 0; t < 64; ++t) if (!F.dry) P[(size_t)(row0 + t) * LDP + PC_BQKV + h * 128 + pp] = f2bf(bf2f(qs[t * NP + lt]) * gs[192 + t] * __expf(gs[t])); }
    __syncthreads();
#pragma unroll
    for (int i = 0; i < 64; ++i) col[i] *= lt < 128 ? gs[64 + i] : gs[64 + i] * gs[128 + i] * __expf(gs[i]);
#pragma unroll
    for (int j = 0; j < 63; ++j) { const float xj = col[j]; asm volatile("" ::: "memory");
#pragma unroll
        for (int q4 = (j + 1) >> 2; q4 < 16; ++q4) { const f32x4 a = *(const LAS f32x4*)(AT + j * 68 + 4 * q4);
#pragma unroll
            for (int e = 0; e < 4; ++e) if (4 * q4 + e > j) col[4 * q4 + e] -= a[e] * xj; } }
    int tid2 = F.tid; asm volatile("" : "+v"(tid2)); const int lt2 = tid2 & 255, unit2 = 2 * ug + __builtin_amdgcn_readfirstlane(tid2 >> 8), row02 = (unit2 >> 2) * 64, h2 = unit2 & 3;
    if (lt2 < 128) { bf16_t* dst = P + (size_t)(row02 + (lt2 >> 1)) * LDP + PC_BQKV + 1024 + h2 * 128 + (lt2 & 1) * 64;
#pragma unroll
        for (int o = 0; o < 8; ++o) if (!F.dry) *(u32x4*)(dst + 8 * o) = (u32x4){pk2(col[8 * o], col[8 * o + 1]), pk2(col[8 * o + 2], col[8 * o + 3]), pk2(col[8 * o + 4], col[8 * o + 5]), pk2(col[8 * o + 6], col[8 * o + 7])};
    } else { const int pp = permpos(lt2 - 128);
        if (!F.dry) {
#pragma unroll
        for (int t = 0; t < 64; ++t) strow(ROWB(P, row02 + t, PC_BQKV + 512 + h2 * 128), (unsigned)pp * 2u, f2bf(col[t])); } }
    __syncthreads();
}

__device__ __forceinline__ void phase_prep(Frame& F, int l) {
#ifndef PREP_DRY_SEL
#define PREP_DRY_SEL 7
#endif
    const int sel = F.dry ? PREP_DRY_SEL : 7;
    if (sel & 1) for (int ug = F.bid; ug < 514; ug += F.G) prep_gla<128, true>(F, l, ug);
    if (sel & 2) for (int ug = F.bid; ug < 514; ug += F.G) prep_gdn(F, l, ug);
    if (sel & 4) for (int ug = F.bid; ug < 514; ug += F.G) prep_gla<64, false>(F, l, ug);
}
template <int K> struct RingK { static constexpr int value = K; };
template <int MX> struct ScanCfg;
template <> struct ScanCfg<0> { static constexpr int NM = 4, NE = 6, NL = 0, EB = 49152, LB = 0;
    static constexpr int ring(int m) { return 0; } static constexpr int off(int m) { return m == 0 ? 0 : (m == 1 ? 16384 : (m == 2 ? 32768 : 40960)); } static constexpr int pitch(int m) { return m == 0 ? 256 : 128; } };
template <> struct ScanCfg<1> { static constexpr int NM = 4, NE = 4, NL = 3, EB = 32768, LB = 24576;
    static constexpr int ring(int m) { return m < 2 ? 0 : 1; } static constexpr int off(int m) { return m == 0 ? 0 : (m == 1 ? 16384 : (m == 2 ? 0 : 16384)); } static constexpr int pitch(int m) { return m < 2 ? 256 : 128; } };
template <> struct ScanCfg<2> { static constexpr int NM = 4, NE = 4, NL = 0, EB = 32768, LB = 0;
    static constexpr int ring(int m) { return 0; } static constexpr int off(int m) { return 8192 * m; } static constexpr int pitch(int m) { return 128; } };

template <int MX>
__device__ __forceinline__ void scan_mixer(Frame& F, int b, int h) {
    typedef ScanCfg<MX> C;
    constexpr int DK = MX == 2 ? 64 : 128, NT = DK / 16, NE = C::NE, NL = C::NL, ND = MX == 1 ? 1 : NT, LBASE = 3 * C::EB;
    int tid_ = F.tid; asm volatile("" : "+v"(tid_));
    const int w = __builtin_amdgcn_readfirstlane(tid_ >> 6), lane = tid_ & 63, fr = lane & 15, fq = lane >> 4, ecol = 16 * w + fr;
    const char* Pb = (const char*)WSP(bf16_t, WS_P);
    const int qcol = MX == 0 ? PC_AQ + h * 128 : (MX == 1 ? PC_BQKV + h * 128 : PC_CQ + h * 64);
    const int kcol = MX == 0 ? PC_AF + h * 128 : (MX == 1 ? PC_BQKV + 512 + h * 128 : PC_CK + h * 64);
    const int vcol = MX == 0 ? PC_AI + h * 128 : (MX == 1 ? PC_BQKV + 1024 + h * 128 : PC_CV + h * 128);
    const char* SCb = (const char*)(MX == 0 ? WSP(bf16_t, WS_SCA) : (MX == 1 ? WSP(bf16_t, WS_QKD) : WSP(bf16_t, WS_SCC)));
    bf16_t* O = WSP(bf16_t, WS_O) + (size_t)MX * MROWS * 512;
    unsigned voffE[NE], voffL[NL > 0 ? NL : 1]; int miE[NE], miL[NL > 0 ? NL : 1];
    auto plan = [&](int ring, int n, unsigned& vo, int& mm) { const int o = 1024 * n + 16 * lane; int m = -1;
#pragma unroll
        for (int q = 0; q < C::NM; ++q) if (C::ring(q) == ring && o >= C::off(q)) m = q;
        int ro = o, pitch = 128;
#pragma unroll
        for (int q = 0; q < C::NM; ++q) if (m == q) { ro = o - C::off(q); pitch = C::pitch(q); }
        const int r = ro / pitch, pos = (ro % pitch) >> 4, pc = pos ^ (pitch == 256 ? (r & 15) : ((r >> 1) & 7));
        const int kind = (MX == 1) ? (m < 2 ? 0 : 2) : (m == 0 ? 0 : (m == 1 ? (MX == 0 ? 1 : 0) : 2));
        vo = (unsigned)(kind == 0 ? r * (LDP * 2) : (kind == 1 ? (r >> 1) * (LDP * 2) + (r & 1) * 128 : r * pitch)) + 16u * pc; mm = m;
        if (MX != 1 && m == 3) vo = (unsigned)(ro & (DK * 4 - 16)); };
#pragma unroll
    for (int i = 0; i < NE; ++i) plan(0, w + 8 * i, voffE[i], miE[i]);
#pragma unroll
    for (int i = 0; i < NL; ++i) plan(1, w + 8 * i, voffL[i], miL[i]);
    const unsigned x256_0 = (unsigned)(((0 | fq) ^ fr) << 4), x256_1 = (unsigned)(((4 | fq) ^ fr) << 4), x256_2 = (unsigned)(((8 | fq) ^ fr) << 4), x256_3 = (unsigned)(((12 | fq) ^ fr) << 4);
    const unsigned x128_0 = (unsigned)(((0 | fq) ^ ((fr >> 1) & 7)) << 4), x128_1 = (unsigned)(((4 | fq) ^ ((fr >> 1) & 7)) << 4);
    const unsigned x256[4] = {x256_0, x256_1, x256_2, x256_3}, x128[2] = {x128_0, x128_1};
#define SC_FRAG(slotbase, m, rt, kp) (*(const LAS bf16x8*)(F.lds + (slotbase) + C::off(m) + (16 * (rt) + fr) * C::pitch(m) + (C::pitch(m) == 256 ? x256[kp] : x128[(kp) & 1])))
    auto slot_of = [&](int step) { return step == 0 ? 256 : b * 64 + step - 1; };
    auto mbase = [&](int m, int step) -> const char* { const int slot = slot_of(step), row0 = slot * 64, unit = slot * 4 + h;
        if (MX == 1) return m == 0 ? Pb + ((size_t)row0 * LDP + kcol) * 2 : (m == 1 ? Pb + ((size_t)row0 * LDP + qcol) * 2 : (m == 2 ? (const char*)WSP(bf16_t, WS_K1TB) + (size_t)unit * 16384 : SCb + (size_t)unit * 8192));
        return m == 0 ? Pb + ((size_t)row0 * LDP + qcol) * 2 : (m == 1 ? Pb + ((size_t)row0 * LDP + kcol) * 2 : (m == 2 ? SCb + (size_t)unit * 8192 : (const char*)((MX == 0 ? WSP(float, SM_DECA) : WSP(float, SM_DECC)) + (size_t)unit * DK))); };
    auto issue_early = [&](int step, int slotbase) {
        const char* b0 = mbase(0, step); const char* b1 = mbase(1, step); const char* b2 = mbase(2, step); const char* b3 = MX == 1 ? b2 : mbase(3, step);
#pragma unroll
        for (int i = 0; i < NE; ++i) { const char* bs = miE[i] == 0 ? b0 : (miE[i] == 1 ? b1 : (miE[i] == 2 ? b2 : b3));
            __builtin_amdgcn_global_load_lds((const unsigned*)(bs + voffE[i]), (LAS unsigned*)(F.lds + slotbase + 1024 * (w + 8 * i)), 16, 0, 0); } };
    auto issue_late = [&](int step, int slotbase) {
        if (NL > 0) { const char* b2 = mbase(2, step); const char* b3 = mbase(3 < C::NM ? 3 : 2, step);
#pragma unroll
            for (int i = 0; i < NL; ++i) { const char* bs = miL[i] == 2 ? b2 : b3;
                __builtin_amdgcn_global_load_lds((const unsigned*)(bs + voffL[i]), (LAS unsigned*)(F.lds + slotbase + 1024 * (w + 8 * i)), 16, 0, 0); } } };
#define GLD4(dst, ptr) asm volatile("global_load_dwordx4 %0, %1, off" : "=&v"(dst) : "v"((GAS const void*)(ptr)) : "memory")
#define GLD2(dst, ptr) asm volatile("global_load_dwordx2 %0, %1, off" : "=&v"(dst) : "v"((GAS const void*)(ptr)) : "memory")
#define GLD1(dst, ptr) asm volatile("global_load_dword %0, %1, off" : "=&v"(dst) : "v"((GAS const void*)(ptr)) : "memory")
    struct PV { u32x4 a, b; u32x2 c, d, e, f; };
    auto load_pv = [&](int step, PV& R) {
        const int row0 = slot_of(step) * 64;
        const bf16_t* vt = (const bf16_t*)Pb + (size_t)(row0 + (ecol >> 1)) * LDP + vcol + (ecol & 1) * 64;
        if (MX == 1) { GLD2(R.c, vt + 4 * fq); GLD2(R.d, vt + 16 + 4 * fq); GLD2(R.e, vt + 32 + 4 * fq); GLD2(R.f, vt + 48 + 4 * fq); }
        else { GLD4(R.a, vt + 8 * fq); GLD4(R.b, vt + 32 + 8 * fq); } };
    f32x4 S[NT];
#pragma unroll
    for (int i = 0; i < NT; ++i) S[i] = (f32x4){0.f, 0.f, 0.f, 0.f};
    PV P0, P1, P2;
    unsigned opk[8] = {0u, 0u, 0u, 0u, 0u, 0u, 0u, 0u};
    auto store_o = [&](int step) { const int row0 = slot_of(step) * 64;
#pragma unroll
        for (int mt = 0; mt < 4; ++mt)
#pragma unroll
            for (int r = 0; r < 4; ++r) { GAS bf16_t* dst = (GAS bf16_t*)(O + (size_t)(row0 + 16 * mt + 4 * fq + r) * 512 + h * 128 + ecol); const unsigned v = opk[2 * mt + (r >> 1)];
                if (r & 1) asm volatile("global_store_short_d16_hi %0, %1, off" :: "v"(dst), "v"(v) : "memory"); else asm volatile("global_store_short %0, %1, off" :: "v"(dst), "v"(v) : "memory"); } };
    int eb = 0, lb = LBASE;
    float dnext = 0.f;
    auto body = [&](PV& cur, PV& tgt, int step) __attribute__((always_inline)) {
        const int eb2 = eb >= C::EB ? eb - C::EB : eb + 2 * C::EB;
        const int unit = slot_of(step) * 4 + h;
        if (MX == 1) asm volatile("s_waitcnt vmcnt(47)" ::: "memory"); else if (MX == 0) asm volatile("s_waitcnt vmcnt(24)" ::: "memory"); else asm volatile("s_waitcnt vmcnt(22)" ::: "memory");
        __builtin_amdgcn_s_barrier(); asm volatile("" ::: "memory");
        u32x4 pa = cur.a, pb = cur.b; u32x2 pc = cur.c, pd = cur.d, pe = cur.e, pf = cur.f;
        if (MX == 1) asm volatile("" : "+v"(pc), "+v"(pd), "+v"(pe), "+v"(pf)); else asm volatile("" : "+v"(pa), "+v"(pb));
        if (MX != 1) { if (step > 0) store_o(step - 1); else store_o(64 + 0 * step); }
        load_pv(step + 2 < 65 ? step + 2 : 64, tgt);
        issue_early(step + 2 < 65 ? step + 2 : 64, eb2);
        asm volatile("" ::: "memory");
        bf16x8 Sb[NT / 2];
#pragma unroll
        for (int kp = 0; kp < NT / 2; ++kp) Sb[kp] = pack_acc2(S[2 * kp], S[2 * kp + 1]);
        f32x4 o[4];
        bf16x8 fa[8], fb[8];
#define LD8(dst, sb, m, rbase, nk) _Pragma("unroll") for (int j = 0; j < 8; ++j) dst[j] = SC_FRAG(sb, m, (rbase) + j / (nk), j % (nk))
#define PIN() __builtin_amdgcn_sched_barrier(0)
        if (MX == 1) {
            f32x4 vn[4];
            LD8(fa, eb, 0, 0, 4); LD8(fb, eb, 0, 2, 4); PIN();
#pragma unroll
            for (int mt = 0; mt < 2; ++mt) { f32x4 acc = {0.f, 0.f, 0.f, 0.f};
#pragma unroll
                for (int kp = 0; kp < 4; ++kp) acc = MFMA16(fa[4 * mt + kp], Sb[kp], acc);
                vn[mt] = acc; }
            PIN(); LD8(fa, eb, 1, 0, 4); PIN();
#pragma unroll
            for (int mt = 0; mt < 2; ++mt) { f32x4 acc = {0.f, 0.f, 0.f, 0.f};
#pragma unroll
                for (int kp = 0; kp < 4; ++kp) acc = MFMA16(fb[4 * mt + kp], Sb[kp], acc);
                vn[2 + mt] = acc; }
#pragma unroll
            for (int mt = 0; mt < 4; ++mt) { const u32x2 uu = mt == 0 ? pc : (mt == 1 ? pd : (mt == 2 ? pe : pf));
                vn[mt] = (f32x4){bflo(uu.x) - vn[mt][0], bfhi(uu.x) - vn[mt][1], bflo(uu.y) - vn[mt][2], bfhi(uu.y) - vn[mt][3]}; }
            bf16x8 Vb[2]; Vb[0] = pack_acc2(vn[0], vn[1]); Vb[1] = pack_acc2(vn[2], vn[3]);
            PIN(); LD8(fb, eb, 1, 2, 4); PIN();
#pragma unroll
            for (int mt = 0; mt < 2; ++mt) { f32x4 acc = {0.f, 0.f, 0.f, 0.f};
#pragma unroll
                for (int kp = 0; kp < 4; ++kp) acc = MFMA16(fa[4 * mt + kp], Sb[kp], acc);
                o[mt] = acc; }
#pragma unroll
            for (int mt = 0; mt < 2; ++mt) { f32x4 acc = {0.f, 0.f, 0.f, 0.f};
#pragma unroll
                for (int kp = 0; kp < 4; ++kp) acc = MFMA16(fb[4 * mt + kp], Sb[kp], acc);
                o[2 + mt] = acc; }
            asm volatile("s_waitcnt vmcnt(24)" : "+v"(dnext) :: "memory");
            __builtin_amdgcn_s_barrier(); asm volatile("" ::: "memory");
            const float dsc = dnext;
            { const int un = slot_of(step + 1 < 65 ? step + 1 : 64) * 4 + h; GLD1(dnext, WSP(float, SM_DECB) + un); }
            issue_late(step + 1 < 65 ? step + 1 : 64, lb == LBASE ? LBASE + C::LB : LBASE);
            if (step > 0) store_o(step - 1); else store_o(64 + 0 * step);
            asm volatile("" ::: "memory");
            LD8(fa, lb, 3, 0, 2); LD8(fb, lb, 2, 0, 2); PIN();
#pragma unroll
            for (int mt = 0; mt < 4; ++mt) { o[mt] = MFMA16(fa[2 * mt], Vb[0], o[mt]); o[mt] = MFMA16(fa[2 * mt + 1], Vb[1], o[mt]); }
            PIN(); LD8(fa, lb, 2, 4, 2); PIN();
#pragma unroll
            for (int i = 0; i < 4; ++i) { S[i] = S[i] * dsc; S[i] = MFMA16(fb[2 * i], Vb[0], S[i]); S[i] = MFMA16(fb[2 * i + 1], Vb[1], S[i]); }
#pragma unroll
            for (int i = 0; i < 4; ++i) { S[4 + i] = S[4 + i] * dsc; S[4 + i] = MFMA16(fa[2 * i], Vb[0], S[4 + i]); S[4 + i] = MFMA16(fa[2 * i + 1], Vb[1], S[4 + i]); }
        } else {
            const bf16x8 bv0 = mk8(pa), bv1 = mk8(pb);
            if (MX == 0) {
                LD8(fa, eb, 0, 0, 4); LD8(fb, eb, 0, 2, 4); PIN();
#pragma unroll
                for (int mt = 0; mt < 2; ++mt) { f32x4 acc = {0.f, 0.f, 0.f, 0.f};
#pragma unroll
                    for (int kp = 0; kp < 4; ++kp) acc = MFMA16(fa[4 * mt + kp], Sb[kp], acc);
                    o[mt] = acc; }
                PIN(); LD8(fa, eb, 2, 0, 2); PIN();
#pragma unroll
                for (int mt = 0; mt < 2; ++mt) { f32x4 acc = {0.f, 0.f, 0.f, 0.f};
#pragma unroll
                    for (int kp = 0; kp < 4; ++kp) acc = MFMA16(fb[4 * mt + kp], Sb[kp], acc);
                    o[2 + mt] = acc; }
                PIN(); LD8(fb, eb, 1, 0, 2); PIN();
            } else {
                LD8(fa, eb, 0, 0, 2); LD8(fb, eb, 2, 0, 2); PIN();
#pragma unroll
                for (int mt = 0; mt < 4; ++mt) { f32x4 acc = {0.f, 0.f, 0.f, 0.f}; acc = MFMA16(fa[2 * mt], Sb[0], acc); acc = MFMA16(fa[2 * mt + 1], Sb[1], acc); o[mt] = acc; }
                PIN(); LD8(fa, eb, 1, 0, 2); PIN();
            }
#pragma unroll
            for (int mt = 0; mt < 4; ++mt) { o[mt] = MFMA16((MX == 0 ? fa : fb)[2 * mt], bv0, o[mt]); o[mt] = MFMA16((MX == 0 ? fa : fb)[2 * mt + 1], bv1, o[mt]); }
            if (MX == 0) { PIN(); LD8(fa, eb, 1, 4, 2); PIN(); }
#pragma unroll
            for (int i = 0; i < 4; ++i) { S[i] = S[i] * *(const LAS f32x4*)(F.lds + eb + C::off(3) + (16 * i + 4 * fq) * 4); S[i] = MFMA16((MX == 0 ? fb : fa)[2 * i], bv0, S[i]); S[i] = MFMA16((MX == 0 ? fb : fa)[2 * i + 1], bv1, S[i]); }
            if (MX == 0) {
#pragma unroll
                for (int i = 0; i < 4; ++i) { S[(4 + i) % NT] = S[(4 + i) % NT] * *(const LAS f32x4*)(F.lds + eb + C::off(3) + (16 * ((4 + i) % NT) + 4 * fq) * 4); S[(4 + i) % NT] = MFMA16(fa[2 * i], bv0, S[(4 + i) % NT]); S[(4 + i) % NT] = MFMA16(fa[2 * i + 1], bv1, S[(4 + i) % NT]); } }
        }
#undef LD8
#undef PIN
#pragma unroll
        for (int mt = 0; mt < 4; ++mt) { opk[2 * mt] = pk2(o[mt][0], o[mt][1]); opk[2 * mt + 1] = pk2(o[mt][2], o[mt][3]); }
        eb = eb + C::EB >= 3 * C::EB ? 0 : eb + C::EB;
        if (NL > 0) lb = lb == LBASE ? LBASE + C::LB : LBASE;
    };
    load_pv(0, P0); load_pv(1, P1); issue_early(0, 0); issue_late(0, LBASE); issue_early(1, C::EB);
    if (MX == 1) GLD1(dnext, WSP(float, SM_DECB) + (256 * 4 + h));
    asm volatile("s_waitcnt vmcnt(0)" ::: "memory");
    for (int step = 0; step < 65; step += 3) {
        body(P0, P2, step);
        if (step + 1 < 65) body(P1, P0, step + 1);
        if (step + 2 < 65) body(P2, P1, step + 2);
    }
#undef SC_FRAG
#undef GLD4
#undef GLD2
#undef GLD1
    store_o(64);
    asm volatile("s_waitcnt vmcnt(0)" ::: "memory");
    __syncthreads();
}
__device__ __forceinline__ void phase_scan(Frame& F) {
    if (F.bid >= 48) return;
    const int mixer = F.bid >> 4, b = (F.bid >> 2) & 3, h = F.bid & 3;
    if (mixer == 0) scan_mixer<0>(F, b, h);
    else if (mixer == 1) scan_mixer<1>(F, b, h);
    else scan_mixer<2>(F, b, h);
}

template <int KIND>
__device__ __forceinline__ void meta_gemm(Frame& F, const bf16_t* A, const bf16_t* Bt, int N, int K, int n) {
    const int gw = F.bid * NWAVES + F.wave, NGW = F.G * NWAVES, lane = F.lane, fr = lane & 15, fq = lane >> 4;
    for (int tile = gw; tile < N / 16; tile += NGW) {
        const bf16_t* ar = A + (size_t)fr * K + 8 * fq; const bf16_t* br = Bt + (size_t)(16 * tile + fr) * K + 8 * fq;
        f32x4 acc = {0.f, 0.f, 0.f, 0.f};
#pragma unroll 8
        for (int ks = 0; ks < K / 32; ++ks) acc = MFMA16(mk8(*(const u32x4*)(ar + 32 * ks)), mk8(*(const u32x4*)(br + 32 * ks)), acc);
#pragma unroll
        for (int r = 0; r < 4; ++r) { const int row = META_ROW0 + 4 * fq + r, col = 16 * tile + fr;
            if (KIND == 0) WSP(bf16_t, WS_GT)[(size_t)row * 3072 + col] = f2bf(sigmoidf_(acc[r]));
            else if (KIND == 1) { bf16_t* mp = WSP(bf16_t, WS_MERGED) + (size_t)row * 1024 + col; const float g = bf2f(WSP(bf16_t, WS_GT)[(size_t)row * 3072 + n * 1024 + col]);
                *mp = f2bf((n ? bf2f(*mp) : 0.f) + g * acc[r]); }
            else { float* hp = WSP(float, WS_HMETA) + (size_t)(row - NREAL) * D + col; *hp = *hp + acc[r]; } }
    }
}

__device__ __forceinline__ void phase_hnorm(Frame& F, int l) {
    const int gw = F.bid * NWAVES + F.wave, NGW = F.G * NWAVES, lane = F.lane;
    const bf16_t* P = WSP(bf16_t, WS_P);
    for (int it = gw; it < MROWS * 3; it += NGW) {
        const int r = it / 3, mx = it % 3;
        bf16_t* op = WSP(bf16_t, WS_O) + (size_t)mx * MROWS * 512 + (size_t)r * 512 + 8 * lane;
        if (!row_valid(r)) { if (!F.dry) *(u32x4*)op = (u32x4){0u, 0u, 0u, 0u}; continue; }
        const int gcol = mx == 0 ? PC_AG : (mx == 1 ? PC_BG : PC_CG);
        const float* nwb = mx == 0 ? INP(I_HGRN_NORM) : (mx == 1 ? INP(I_GDN_NORM) : INP(I_GLA_NORM)); const float* nw = nwb + (size_t)l * 128 + (8 * lane & 127);
        const u32x4 ow = *(const u32x4*)op, gw4 = *(const u32x4*)(P + (size_t)r * LDP + gcol + 8 * lane);
        float o[8] = {bflo(ow.x), bfhi(ow.x), bflo(ow.y), bfhi(ow.y), bflo(ow.z), bfhi(ow.z), bflo(ow.w), bfhi(ow.w)};
        const float g[8] = {siluf_(bflo(gw4.x)), siluf_(bfhi(gw4.x)), siluf_(bflo(gw4.y)), siluf_(bfhi(gw4.y)), siluf_(bflo(gw4.z)), siluf_(bfhi(gw4.z)), siluf_(bflo(gw4.w)), siluf_(bfhi(gw4.w))};
        float ss = 0.f;
#pragma unroll
        for (int j = 0; j < 8; ++j) ss += o[j] * o[j];
        ss += __shfl_xor(ss, 1); ss += __shfl_xor(ss, 2); ss += __shfl_xor(ss, 4); ss += __shfl_xor(ss, 8);
        const float rstd = rsqrtf(ss * (1.0f / 128.0f) + 1e-6f);
        const f32x4 n0 = *(const f32x4*)nw, n1 = *(const f32x4*)(nw + 4);
        const float nv[8] = {n0[0], n0[1], n0[2], n0[3], n1[0], n1[1], n1[2], n1[3]};
#pragma unroll
        for (int j = 0; j < 8; ++j) o[j] = o[j] * rstd * nv[j] * g[j];
        u32x4 y; y.x = pk2(o[0], o[1]); y.y = pk2(o[2], o[3]); y.z = pk2(o[4], o[5]); y.w = pk2(o[6], o[7]);
        if (!F.dry) *(u32x4*)op = y;
    }
}

__device__ __forceinline__ void phase_norm2(Frame& F, int l) {
    if (!F.dry) convert_expert_weights(F, l);
    __syncthreads();
    LAS float* sw = (LAS float*)F.lds;
    { const float* src = WSP(float, SM_RWE) + (size_t)l * 32 * 1024; for (int i = F.tid; i < 32 * 1024 / 4; i += NTHREADS) ((LAS f32x4*)sw)[i] = ((const f32x4*)src)[i]; }
    __syncthreads();
    const int gw = F.bid * NWAVES + F.wave, NGW = F.G * NWAVES, lane = F.lane;
    float wv[16]; load_row16(INP(I_NORM_FFN) + (size_t)l * D, lane, wv);
    bf16_t* U = WSP(bf16_t, WS_U);
    const float* rwg = WSP(float, SM_RWG) + (size_t)l * 4 * 1024;
    unsigned* cnt = WSP(unsigned, WS_CTL) + CW_CNT + l * 64;
    for (int g = gw; g < MROWS / 4; g += NGW) {
        const int r0 = 4 * g;
        if (!row_valid(r0)) continue;
        float x[4][16];
#pragma unroll
        for (int i = 0; i < 4; ++i) {
            load_row16(hrow(F, r0 + i), lane, x[i]);
            float ss = 0.f;
#pragma unroll
            for (int j = 0; j < 16; ++j) ss += x[i][j] * x[i][j];
            const float rstd = rsqrtf(wave_sum(ss) * (1.0f / D) + 1e-6f);
#pragma unroll
            for (int j = 0; j < 16; ++j) x[i][j] = x[i][j] * rstd * wv[j];
            if (!F.dry) store_bf16_row16(U + (size_t)(r0 + i) * D, lane, x[i]);
        }
        float lg[4][4];
#pragma unroll
        for (int c = 0; c < 4; ++c) {
            float a0 = 0.f, a1 = 0.f, a2 = 0.f, a3 = 0.f;
#pragma unroll
            for (int j = 0; j < 4; ++j) { const f32x4 w = *((const f32x4*)(rwg + c * 1024) + lane + 64 * j);
#pragma unroll
                for (int e = 0; e < 4; ++e) { a0 += x[0][4 * j + e] * w[e]; a1 += x[1][4 * j + e] * w[e]; a2 += x[2][4 * j + e] * w[e]; a3 += x[3][4 * j + e] * w[e]; } }
            const float bg = INP(I_RG_B)[l * 4 + c];
            lg[0][c] = wave_sum(a0) + bg; lg[1][c] = wave_sum(a1) + bg; lg[2][c] = wave_sum(a2) + bg; lg[3][c] = wave_sum(a3) + bg;
        }
#pragma unroll
        for (int i = 0; i < 4; ++i) {
            int gi = 0; float gm = lg[i][0];
#pragma unroll
            for (int c = 1; c < 4; ++c) if (lg[i][c] > gm) { gm = lg[i][c]; gi = c; }
            float gsum = 0.f;
#pragma unroll
            for (int c = 0; c < 4; ++c) gsum += __expf(lg[i][c] - gm);
            const float gval = 1.0f / gsum;
            gi = __builtin_amdgcn_readfirstlane(gi);
            int ea = 0, eb = 0; float la = -3.0e38f, lb = -3.0e38f;
#pragma unroll 1
            for (int c = 0; c < 8; ++c) {
                float a = 0.f;
#pragma unroll
                for (int j = 0; j < 4; ++j) { const f32x4 w = *((const LAS f32x4*)(sw + (gi * 8 + c) * 1024) + lane + 64 * j);
#pragma unroll
                    for (int e = 0; e < 4; ++e) a += x[i][4 * j + e] * w[e]; }
                const float el = wave_sum(a) + INP(I_RE_B)[l * 32 + gi * 8 + c];
                if (el > la) { lb = la; eb = ea; la = el; ea = c; } else if (el > lb) { lb = el; eb = c; }
            }
            const float wa = 1.0f / (1.0f + __expf(lb - la)), wb = 1.0f - wa;
            if (lane == 0 && !F.dry) {
                const unsigned e0 = (unsigned)(gi * 8 + ea), e1 = (unsigned)(gi * 8 + eb);
                const unsigned p0 = atomicAdd(cnt + e0, 1u), p1 = atomicAdd(cnt + e1, 1u);
                unsigned* tok = WSP(unsigned, SM_TOK) + (size_t)(r0 + i) * 8;
                tok[0] = e0; tok[1] = p0; tok[2] = e1; tok[3] = p1; tok[4] = __float_as_uint(gval * wa); tok[5] = __float_as_uint(gval * wb);
            }
        }
    }
}

__device__ __forceinline__ int moe_tables(Frame& F, int l) {
    LAS int* offs = (LAS int*)(F.lds + LDS_TAB); LAS unsigned char* tab = (LAS unsigned char*)(F.lds + LDS_TAB + 384); LAS int* cn = (LAS int*)(F.lds + LDS_TAB + 192);
    const unsigned* cnt = WSP(unsigned, WS_CTL) + CW_CNT + l * 64;
    __syncthreads();
    if (F.tid < 32) cn[F.tid] = (int)__hip_atomic_load(cnt + F.tid, __ATOMIC_RELAXED, __HIP_MEMORY_SCOPE_AGENT);
    __syncthreads();
    if (F.tid == 0) { int acc = 0;
#pragma unroll 1
        for (int e = 0; e < 32; ++e) { offs[e] = acc; acc += ((cn[e] + 255) >> 8) << 8; }
        offs[32] = acc; }
    __syncthreads();
    if (F.tid < 160) { const int row = F.tid << 8; int e = 0;
#pragma unroll 1
        for (int k = 1; k < 32; ++k) if (offs[k] <= row) e = k;
        tab[F.tid] = (unsigned char)e; }
    __syncthreads();
    return offs[32] >> 8;
}

__device__ __forceinline__ void phase_gather(Frame& F, int l) {
    (void)moe_tables(F, l);
    const LAS int* offs = (const LAS int*)(F.lds + LDS_TAB); const LAS int* cn = (const LAS int*)(F.lds + LDS_TAB + 192);
    const int gw = F.bid * NWAVES + F.wave, NGW = F.G * NWAVES, lane = F.lane;
    const bf16_t* U = WSP(bf16_t, WS_U); bf16_t* XG = WSP(bf16_t, WS_XG); float* wrow = WSP(float, SM_WROW);
    for (int idx = gw; idx < NREAL + 16; idx += NGW) {
        const int r = idx < NREAL ? idx : META_ROW0 + (idx - NREAL);
        unsigned* tok = WSP(unsigned, SM_TOK) + (size_t)r * 8;
        const unsigned e0 = tok[0], p0 = tok[1], e1 = tok[2], p1 = tok[3];
        const unsigned g0 = (unsigned)offs[e0] + p0, g1 = (unsigned)offs[e1] + p1;
        if (lane == 0) { tok[6] = g0; tok[7] = g1; wrow[g0] = __uint_as_float(tok[4]); wrow[g1] = __uint_as_float(tok[5]); }
        const u32x4* src = (const u32x4*)(U + (size_t)r * D);
        const u32x4 a = src[lane], b = src[lane + 64];
        u32x4* d0 = (u32x4*)(XG + (size_t)g0 * D); u32x4* d1 = (u32x4*)(XG + (size_t)g1 * D);
        d0[lane] = a; d0[lane + 64] = b; d1[lane] = a; d1[lane + 64] = b;
    }
    u32x4 zz = {0u, 0u, 0u, 0u}; asm volatile("" : "+v"(zz));
    for (int i = gw; i < 32 * 256; i += NGW) { const int e = i >> 8, j = i & 255; const int row = offs[e] + cn[e] + j;
        if (row < offs[e + 1]) { u32x4* d = (u32x4*)(XG + (size_t)row * D); d[lane] = zz; d[lane + 64] = zz; if (lane == 0) wrow[row] = 0.f; } }
}

__device__ __forceinline__ void phase_final(Frame& F) {
    const int gw = F.bid * NWAVES + F.wave, NGW = F.G * NWAVES, lane = F.lane;
    float wv[16]; load_row16(INP(I_NORM_FINAL), lane, wv);
    for (int r = gw; r < NREAL; r += NGW) {
        float x[16]; fetch_h_row(F, 2, r, x);
        float ss = 0.f;
#pragma unroll
        for (int j = 0; j < 16; ++j) ss += x[j] * x[j];
        const float rstd = rsqrtf(wave_sum(ss) * (1.0f / D) + 1e-6f);
#pragma unroll
        for (int j = 0; j < 16; ++j) x[j] = x[j] * rstd * wv[j];
        store_row16(OUTP + (size_t)r * D, lane, x);
    }
}
constexpr int PH_PER_LAYER = 14, N_PHASES = 2 + 2 * PH_PER_LAYER;
#ifndef DBG_STOP
#define DBG_STOP 0
#endif
#ifndef DBG_SRC
#define DBG_SRC WS_P
#define DBG_LD LDP
#endif
#ifndef DBG_TA
#define DBG_TA -1
#endif
#ifndef DBG_TB
#define DBG_TB -1
#endif
#ifndef DUP_MASK
#define DUP_MASK 0u
#endif
#define DUPN(j) (((DUP_MASK >> (j)) & 1u) ? 2 : 1)
#ifndef MK_ONE_LAUNCH
#define MK_ONE_LAUNCH 1
#endif

template <unsigned PHMASK_T>
__global__ void __launch_bounds__(NTHREADS, 2) hybrid_fwd(Params p) {
    extern __shared__ __attribute__((aligned(16))) unsigned char lds_raw[];
    Frame F;
    F.lds = (LAS unsigned char*)lds_raw; F.tid = threadIdx.x; F.lane = F.tid & 63; F.wave = __builtin_amdgcn_readfirstlane(F.tid >> 6); F.G = gridDim.x; F.bid = blockIdx.x; F.dry = 0;
    F.out = (GAS float*)p.out; F.ws = (GAS unsigned char*)p.ws; F.inp = (const float* const __attribute__((address_space(4)))*)__builtin_amdgcn_kernarg_segment_ptr();
    volatile LAS unsigned* MISC = (volatile LAS unsigned*)(F.lds + LDS_MISC);
    if (F.tid < 128) MISC[F.tid] = 0u;
    __syncthreads();
#if MK_ONE_LAUNCH
    constexpr int lo = 0, hi = N_PHASES;
#else
    const int lo = p.ph_lo, hi = p.ph_hi;
#endif
    if (hi - lo > 1) (void)xcd_barrier_post(WSP(unsigned, WS_CTL) + CW_BAR, MISC + 8);
#define GRID_BARRIER() xcd_barrier(WSP(unsigned, WS_CTL) + CW_BAR, xb_xcc_id(), (volatile LAS unsigned*)(F.lds + LDS_MISC) + 8, F.tid, (unsigned)F.G)
#define EN(j) ((PHMASK_T >> (j)) & 1u)
#define IN(k) (lo <= (k) && (k) < hi)
    if (DBG_TA >= 0 && F.tid == 0) { MISC[16] = (unsigned)__builtin_amdgcn_s_memrealtime(); MISC[17] = 0u; }
#define SEAM(k) do { if (IN(k) && IN((k) + 1)) GRID_BARRIER(); PHASE_FENCE(F); \
    if (DBG_TA >= 0 && F.tid == 0) { const unsigned t_now = (unsigned)__builtin_amdgcn_s_memrealtime(); const int kk = (k) == 0 ? 15 : (((k) - 1) % PH_PER_LAYER); const int kind = (kk >= 6 && kk <= 8) ? 6 : kk; \
        if (kind == DBG_TA) MISC[17] += t_now - MISC[16]; MISC[16] = t_now; } } while (0)
    PHASE_FENCE(F);
    if (EN(15) && IN(0)) phase_pre(F);
    SEAM(0);
    { constexpr int l = 0;
        const int pb = 1 + PH_PER_LAYER * l;
        for (int rep = 0; rep < (l == 0 ? DUPN(0) : 1); ++rep) { if (rep) { GRID_BARRIER(); PHASE_FENCE(F); } if (EN(0) && IN(pb + 0)) phase_norm1(F, l); }
        SEAM(pb + 0);
        for (int rep = 0; rep < DUPN(1); ++rep) { if (rep) { GRID_BARRIER(); PHASE_FENCE(F); }
        if (EN(1) && IN(pb + 1)) {
            pg8::Gemm g{WSP(bf16_t, WS_U), WSP(bf16_t, WS_WMIX), MROWS, LDP, D}; pg8::StaticOrder S; S.init(MROWS, LDP, F.G, F.bid);
            pg8::EpiInProj E{WSP(bf16_t, WS_P), WSP(bf16_t, SM_HALO)};
            pg8::gemm_phase(F.lds, F.tid, g, S, E);
        } }
        SEAM(pb + 1);
        for (int rep = 0; rep < DUPN(2); ++rep) { if (rep) { GRID_BARRIER(); PHASE_FENCE(F); F.dry = 1; asm volatile("" : "+s"(F.dry)); } if (EN(2) && IN(pb + 2)) phase_prep(F, l); F.dry = 0; }
        SEAM(pb + 2);
        for (int rep = 0; rep < DUPN(3); ++rep) { if (rep) { GRID_BARRIER(); PHASE_FENCE(F); } if (EN(3) && IN(pb + 3)) phase_scan(F); }
        SEAM(pb + 3);
        for (int rep = 0; rep < DUPN(4); ++rep) { if (rep) { GRID_BARRIER(); PHASE_FENCE(F); F.dry = 1; asm volatile("" : "+s"(F.dry)); } if (EN(4) && IN(pb + 4)) phase_hnorm(F, l); F.dry = 0; }
        SEAM(pb + 4);
        for (int rep = 0; rep < DUPN(5); ++rep) { if (rep) { GRID_BARRIER(); PHASE_FENCE(F); }
        if (EN(5) && IN(pb + 5)) {
            pg8::Gemm g{WSP(bf16_t, WS_U), WSP(bf16_t, WS_WGATE), NREAL, 3072, D}; pg8::StaticOrder S; S.init(NREAL, 3072, F.G, F.bid);
            pg8::EpiSigmoid E{WSP(bf16_t, WS_GT), 3072};
            pg8::gemm_phase(F.lds, F.tid, g, S, E);
            meta_gemm<0>(F, WSP(bf16_t, WS_U) + (size_t)META_ROW0 * D, WSP(bf16_t, WS_WGATE), 3072, D, 0);
        } }
        SEAM(pb + 5);
        for (int n = 0; n < 3; ++n) {
            if (EN(6) && IN(pb + 6 + n)) {
                pg8::Gemm g{WSP(bf16_t, WS_O) + (size_t)n * MROWS * 512, WSP(bf16_t, WS_WBT) + (size_t)n * 1024 * 512, NREAL, D, 512}; pg8::StaticOrder S; S.init(NREAL, D, F.G, F.bid);
                pg8::EpiBranch E{WSP(bf16_t, WS_MERGED), WSP(bf16_t, WS_GT), n};
                pg8::gemm_phase(F.lds, F.tid, g, S, E);
                meta_gemm<1>(F, WSP(bf16_t, WS_O) + (size_t)n * MROWS * 512 + (size_t)META_ROW0 * 512, WSP(bf16_t, WS_WBT) + (size_t)n * 1024 * 512, D, 512, n);
            }
            SEAM(pb + 6 + n);
        }
        if (EN(9) && IN(pb + 9)) {
            pg8::Gemm g{WSP(bf16_t, WS_MERGED), WSP(bf16_t, WS_WOT), NREAL, D, D}; pg8::StaticOrder S; S.init(NREAL, D, F.G, F.bid);
            pg8::EpiResidual E{OUTP, WSP(float, WS_HMETA)};
            pg8::gemm_phase(F.lds, F.tid, g, S, E);
            meta_gemm<2>(F, WSP(bf16_t, WS_MERGED) + (size_t)META_ROW0 * D, WSP(bf16_t, WS_WOT), D, D, 0);
        }
        SEAM(pb + 9);
        for (int rep = 0; rep < DUPN(10); ++rep) { if (rep) { GRID_BARRIER(); PHASE_FENCE(F); F.dry = 1; asm volatile("" : "+s"(F.dry)); } if (EN(10) && IN(pb + 10)) phase_norm2(F, l); F.dry = 0; }
        SEAM(pb + 10);
        for (int rep = 0; rep < DUPN(11); ++rep) { if (rep) { GRID_BARRIER(); PHASE_FENCE(F); } if (EN(11) && IN(pb + 11)) phase_gather(F, l); }
        SEAM(pb + 11);
        if (EN(12) && IN(pb + 12)) {
            const int ntiles = moe_tables(F, l);
            pg8::Gemm g{WSP(bf16_t, WS_XG), WSP(bf16_t, WS_W1T), XG_ROWS, 512, D};
            pg8::MoeOrder S{F.G, F.bid, 2, ntiles, (const LAS unsigned char*)(F.lds + LDS_TAB + 384), (size_t)512 * 1024 * 2};
            pg8::EpiMoeUp E{WSP(bf16_t, WS_HG)};
            pg8::gemm_phase(F.lds, F.tid, g, S, E);
        }
        SEAM(pb + 12);
        if (EN(13) && IN(pb + 13)) {
            const int ntiles = moe_tables(F, l);
            pg8::Gemm g{WSP(bf16_t, WS_HG), WSP(bf16_t, WS_W2T), XG_ROWS, D, 256};
            pg8::MoeOrder S{F.G, F.bid, 4, ntiles, (const LAS unsigned char*)(F.lds + LDS_TAB + 384), (size_t)1024 * 256 * 2};
            pg8::EpiMoeDown E{WSP(bf16_t, WS_Y2), WSP(float, SM_WROW)};
            pg8::gemm_phase(F.lds, F.tid, g, S, E);
        }
        SEAM(pb + 13);
    }
    { constexpr int l = 1;
        const int pb = 1 + PH_PER_LAYER * l;
        for (int rep = 0; rep < (l == 0 ? DUPN(0) : 1); ++rep) { if (rep) { GRID_BARRIER(); PHASE_FENCE(F); } if (EN(0) && IN(pb + 0)) phase_norm1(F, l); }
        SEAM(pb + 0);
        for (int rep = 0; rep < DUPN(1); ++rep) { if (rep) { GRID_BARRIER(); PHASE_FENCE(F); }
        if (EN(1) && IN(pb + 1)) {
            pg8::Gemm g{WSP(bf16_t, WS_U), WSP(bf16_t, WS_WMIX), MROWS, LDP, D}; pg8::StaticOrder S; S.init(MROWS, LDP, F.G, F.bid);
            pg8::EpiInProj E{WSP(bf16_t, WS_P), WSP(bf16_t, SM_HALO)};
            pg8::gemm_phase(F.lds, F.tid, g, S, E);
        } }
        SEAM(pb + 1);
        for (int rep = 0; rep < DUPN(2); ++rep) { if (rep) { GRID_BARRIER(); PHASE_FENCE(F); F.dry = 1; asm volatile("" : "+s"(F.dry)); } if (EN(2) && IN(pb + 2)) phase_prep(F, l); F.dry = 0; }
        SEAM(pb + 2);
        for (int rep = 0; rep < DUPN(3); ++rep) { if (rep) { GRID_BARRIER(); PHASE_FENCE(F); } if (EN(3) && IN(pb + 3)) phase_scan(F); }
        SEAM(pb + 3);
        for (int rep = 0; rep < DUPN(4); ++rep) { if (rep) { GRID_BARRIER(); PHASE_FENCE(F); F.dry = 1; asm volatile("" : "+s"(F.dry)); } if (EN(4) && IN(pb + 4)) phase_hnorm(F, l); F.dry = 0; }
        SEAM(pb + 4);
        for (int rep = 0; rep < DUPN(5); ++rep) { if (rep) { GRID_BARRIER(); PHASE_FENCE(F); }
        if (EN(5) && IN(pb + 5)) {
            pg8::Gemm g{WSP(bf16_t, WS_U), WSP(bf16_t, WS_WGATE), NREAL, 3072, D}; pg8::StaticOrder S; S.init(NREAL, 3072, F.G, F.bid);
            pg8::EpiSigmoid E{WSP(bf16_t, WS_GT), 3072};
            pg8::gemm_phase(F.lds, F.tid, g, S, E);
            meta_gemm<0>(F, WSP(bf16_t, WS_U) + (size_t)META_ROW0 * D, WSP(bf16_t, WS_WGATE), 3072, D, 0);
        } }
        SEAM(pb + 5);
        for (int n = 0; n < 3; ++n) {
            if (EN(6) && IN(pb + 6 + n)) {
                pg8::Gemm g{WSP(bf16_t, WS_O) + (size_t)n * MROWS * 512, WSP(bf16_t, WS_WBT) + (size_t)n * 1024 * 512, NREAL, D, 512}; pg8::StaticOrder S; S.init(NREAL, D, F.G, F.bid);
                pg8::EpiBranch E{WSP(bf16_t, WS_MERGED), WSP(bf16_t, WS_GT), n};
                pg8::gemm_phase(F.lds, F.tid, g, S, E);
                meta_gemm<1>(F, WSP(bf16_t, WS_O) + (size_t)n * MROWS * 512 + (size_t)META_ROW0 * 512, WSP(bf16_t, WS_WBT) + (size_t)n * 1024 * 512, D, 512, n);
            }
            SEAM(pb + 6 + n);
        }
        if (EN(9) && IN(pb + 9)) {
            pg8::Gemm g{WSP(bf16_t, WS_MERGED), WSP(bf16_t, WS_WOT), NREAL, D, D}; pg8::StaticOrder S; S.init(NREAL, D, F.G, F.bid);
            pg8::EpiResidual E{OUTP, WSP(float, WS_HMETA)};
            pg8::gemm_phase(F.lds, F.tid, g, S, E);
            meta_gemm<2>(F, WSP(bf16_t, WS_MERGED) + (size_t)META_ROW0 * D, WSP(bf16_t, WS_WOT), D, D, 0);
        }
        SEAM(pb + 9);
        for (int rep = 0; rep < DUPN(10); ++rep) { if (rep) { GRID_BARRIER(); PHASE_FENCE(F); F.dry = 1; asm volatile("" : "+s"(F.dry)); } if (EN(10) && IN(pb + 10)) phase_norm2(F, l); F.dry = 0; }
        SEAM(pb + 10);
        for (int rep = 0; rep < DUPN(11); ++rep) { if (rep) { GRID_BARRIER(); PHASE_FENCE(F); } if (EN(11) && IN(pb + 11)) phase_gather(F, l); }
        SEAM(pb + 11);
        if (EN(12) && IN(pb + 12)) {
            const int ntiles = moe_tables(F, l);
            pg8::Gemm g{WSP(bf16_t, WS_XG), WSP(bf16_t, WS_W1T), XG_ROWS, 512, D};
            pg8::MoeOrder S{F.G, F.bid, 2, ntiles, (const LAS unsigned char*)(F.lds + LDS_TAB + 384), (size_t)512 * 1024 * 2};
            pg8::EpiMoeUp E{WSP(bf16_t, WS_HG)};
            pg8::gemm_phase(F.lds, F.tid, g, S, E);
        }
        SEAM(pb + 12);
        if (EN(13) && IN(pb + 13)) {
            const int ntiles = moe_tables(F, l);
            pg8::Gemm g{WSP(bf16_t, WS_HG), WSP(bf16_t, WS_W2T), XG_ROWS, D, 256};
            pg8::MoeOrder S{F.G, F.bid, 4, ntiles, (const LAS unsigned char*)(F.lds + LDS_TAB + 384), (size_t)1024 * 256 * 2};
            pg8::EpiMoeDown E{WSP(bf16_t, WS_Y2), WSP(float, SM_WROW)};
            pg8::gemm_phase(F.lds, F.tid, g, S, E);
        }
        SEAM(pb + 13);
    }
#if DBG_STOP > 0
    if (EN(14) && IN(N_PHASES - 1)) { const int gt = F.bid * NTHREADS + F.tid, NT = F.G * NTHREADS;
#ifdef DBG_LIN
        { const bf16_t* s1 = WSP(bf16_t, DBG_SRC); const bf16_t* s2 = WSP(bf16_t, DBG_SRC2);
          for (size_t i = gt; i < (size_t)NREAL * D; i += NT) F.out[i] = i < (size_t)DBG_N1 ? bf2f(s1[i]) : (i < (size_t)DBG_N1 + DBG_N2 ? bf2f(s2[i - DBG_N1]) : 0.f); }
#else
        if (DBG_LD > 0) { const bf16_t* src = WSP(bf16_t, DBG_SRC); for (size_t i = gt; i < (size_t)NREAL * D; i += NT) { const size_t r = i >> 10, c = i & 1023; F.out[i] = bf2f(src[r * DBG_LD + (c * DBG_LD) / 1024]); } }
#endif
    }
#else
#ifdef DBG_XBAR
    for (int i = 0; i < DBG_XBAR; ++i) { GRID_BARRIER(); PHASE_FENCE(F); }
#endif
    if (EN(14) && IN(N_PHASES - 1)) phase_final(F);
    if (DBG_TA >= 0) { float* tw = WSP(float, WS_CTL) + 2048; if (F.bid == 0 && F.tid == 0) { tw[0] = (float)MISC[17] * 0.01f; }
        GRID_BARRIER(); PHASE_FENCE(F);
        const float v = WSP(float, WS_CTL)[2048] * (1.0f / 200.0f); const int gt = F.bid * NTHREADS + F.tid, NT = F.G * NTHREADS;
        for (size_t i = gt; i < (size_t)NREAL * D; i += NT) F.out[i] = v; }
#endif
#undef IN
#undef SEAM
}

#if MK_ONE_LAUNCH
#ifndef KM_ONE
#define KM_ONE 0xffffffffu
#endif
constexpr unsigned KMASK[1] = {KM_ONE};
#else
constexpr unsigned KMASK[3] = {0x0C19u, 0xC004u, 0x3262u};
#endif
template <unsigned M> static bool setup_kernel(int& per_cu) {
    if (hipFuncSetAttribute((const void*)hybrid_fwd<M>, hipFuncAttributeMaxDynamicSharedMemorySize, LDS_BYTES) != hipSuccess) return false;
    if (hipOccupancyMaxActiveBlocksPerMultiprocessor(&per_cu, (const void*)hybrid_fwd<M>, NTHREADS, LDS_BYTES) != hipSuccess) per_cu = 0;
    (void)hipGetLastError();
    return true;
}
static int phase_kind(int k) { if (k == 0) return 15; if (k == N_PHASES - 1) return 14; const int j = (k - 1) % PH_PER_LAYER; return (j >= 6 && j <= 8) ? 6 : j; }
extern "C" void kernel_launch(void* const* d_in, const int* in_sizes, int n_in, void* d_out, int out_size, void* d_ws, size_t ws_size, hipStream_t stream) {
    static int grid = 0;
    if (grid == 0) {
        if (n_in != 24 || in_sizes[0] != NREAL * D || out_size != NREAL * D || ws_size < WS_END) {
            fprintf(stderr, "kernel_launch: unexpected problem (n_in %d, in0 %d, out %d, ws %zu < %zu); nothing launched\n", n_in, n_in > 0 ? in_sizes[0] : -1, out_size, ws_size, (size_t)WS_END); grid = -1; return; }
        int dev = 0, cus = 0, per_cu = 0; bool ok = true;
        if (hipGetDevice(&dev) != hipSuccess || hipDeviceGetAttribute(&cus, hipDeviceAttributeMultiprocessorCount, dev) != hipSuccess) { grid = -1; return; }
#if MK_ONE_LAUNCH
        ok = setup_kernel<KMASK[0]>(per_cu);
#else
        ok = setup_kernel<KMASK[0]>(per_cu) && setup_kernel<KMASK[1]>(per_cu) && setup_kernel<KMASK[2]>(per_cu);
#endif
        if (!ok) { fprintf(stderr, "kernel_launch: hipFuncSetAttribute failed\n"); grid = -1; return; }
        if (per_cu < 1) fprintf(stderr, "kernel_launch: occupancy query says %d\n", per_cu);
        grid = cus;
    }
    if (grid < 0) return;
    if (hipMemsetAsync((char*)d_ws + WS_CTL, 0, CTL_BYTES, stream) != hipSuccess) return;
    Params p{};
    for (int i = 0; i < 24; ++i) p.in[i] = (const float*)d_in[i];
    p.out = (float*)d_out; p.ws = (unsigned char*)d_ws;
#if MK_ONE_LAUNCH
    p.ph_lo = 0; p.ph_hi = N_PHASES;
    hipLaunchKernelGGL(hybrid_fwd<KMASK[0]>, dim3(grid), dim3(NTHREADS), LDS_BYTES, stream, p);
#else
    for (int k = 0; k < N_PHASES; ++k) { if (DBG_STOP > 0 && k >= DBG_STOP && k != N_PHASES - 1) continue; p.ph_lo = k; p.ph_hi = k + 1; const unsigned bit = 1u << phase_kind(k);
        if (KMASK[0] & bit) hipLaunchKernelGGL(hybrid_fwd<KMASK[0]>, dim3(grid), dim3(NTHREADS), LDS_BYTES, stream, p);
        else if (KMASK[1] & bit) hipLaunchKernelGGL(hybrid_fwd<KMASK[1]>, dim3(grid), dim3(NTHREADS), LDS_BYTES, stream, p);
        else hipLaunchKernelGGL(hybrid_fwd<KMASK[2]>, dim3(grid), dim3(NTHREADS), LDS_BYTES, stream, p); }
#endif
}
```

```cpp
#include <hip/hip_runtime.h>
#include <cstdio>
#include <cstdint>

#define LAS __attribute__((address_space(3)))
typedef unsigned short bf16_t;
typedef short bf16x8 __attribute__((ext_vector_type(8)));
typedef float f32x4 __attribute__((ext_vector_type(4)));
typedef float f32x2 __attribute__((ext_vector_type(2)));
typedef unsigned u32x4 __attribute__((ext_vector_type(4)));
typedef unsigned u32x2 __attribute__((ext_vector_type(2)));

constexpr int D = 1024, NREAL = 16384, MROWS = 16640, META_ROW0 = 16384 + 48, META_END = 16384 + 64;
constexpr int NSLOT = 257;
constexpr int LDP = 5632;
constexpr int PC_AQ = 0, PC_AF = 512, PC_AI = 1024, PC_AG = 1536, PC_BQKV = 2048, PC_BG = 3584, PC_CQ = 4096, PC_CK = 4352, PC_CV = 4608, PC_CG = 5120;
constexpr int IN_COLS = 8728;
constexpr int NTHREADS = 512, NWAVES = 8;
constexpr int XG_ROWS = 40960;

constexpr size_t MiB = 1ull << 20;
constexpr size_t WS_CTL = 0, CTL_BYTES = 1 * MiB;
constexpr int CW_BAR = 4096, CW_CNT = 1024;
constexpr size_t SM_SW1 = 1 * MiB;
constexpr size_t SM_RWG = SM_SW1 + 2 * 24 * 1024 * 4;
constexpr size_t SM_RWE = SM_RWG + 2 * 4 * 1024 * 4;
constexpr size_t SM_LAB = SM_RWE + 2 * 32 * 1024 * 4;
constexpr size_t SM_GK = SM_LAB + 2 * 2 * 512 * 4;
constexpr size_t SM_BETA = SM_GK + (size_t)MROWS * 16 * 4;
constexpr size_t SM_LOGA = SM_BETA + (size_t)MROWS * 4 * 4;
constexpr size_t SM_TOK = SM_LOGA + (size_t)MROWS * 4 * 4;
constexpr size_t SM_WROW = SM_TOK + (size_t)MROWS * 8 * 4;
constexpr size_t SM_DECA = SM_WROW + (size_t)XG_ROWS * 4;
constexpr size_t SM_DECC = SM_DECA + 1028 * 128 * 4;
constexpr size_t SM_DECB = SM_DECC + 1028 * 64 * 4;
constexpr size_t SM_HALO = SM_DECB + 8192;
constexpr size_t SM_END = SM_HALO + 260 * 3 * 1536 * 2;
static_assert(SM_END <= 8 * MiB, "small region");
constexpr size_t WS_HMETA = 8 * MiB;
constexpr size_t WS_WMIX = 9 * MiB;
constexpr size_t WS_WGATE = 20 * MiB;
constexpr size_t WS_WBT = 26 * MiB;
constexpr size_t WS_WOT = 29 * MiB;
constexpr size_t WS_O = 31 * MiB;
constexpr size_t O_STRIDE = (size_t)MROWS * 512 * 2;
constexpr size_t WS_W1T = 31 * MiB;
constexpr size_t WS_W2T = 63 * MiB;
constexpr size_t WS_U = 80 * MiB;
constexpr size_t WS_P = 113 * MiB;
constexpr size_t WS_GT = 113 * MiB;
constexpr size_t WS_MERGED = 211 * MiB;
constexpr size_t WS_XG = 113 * MiB;
constexpr size_t WS_HG = 193 * MiB;
constexpr size_t WS_Y2 = 213 * MiB;
constexpr size_t WS_SCA = 294 * MiB;
constexpr size_t WS_QKD = 303 * MiB;
constexpr size_t WS_SCC = 312 * MiB;
constexpr size_t WS_K1TB = 321 * MiB;
constexpr size_t WS_END = 338 * MiB;

constexpr int LDS_BYTES = 163840;
constexpr int LDS_MISC = LDS_BYTES - 512;
constexpr int LDS_TAB = LDS_BYTES - 1536;
constexpr int LDS_SCRATCH = LDS_TAB;

typedef __bf16 bf16x2v __attribute__((ext_vector_type(2)));
__device__ __forceinline__ unsigned pk2(float lo, float hi) { const f32x2 v = {lo, hi}; return __builtin_bit_cast(unsigned, __builtin_convertvector(v, bf16x2v)); }
__device__ __forceinline__ bf16_t f2bf(float f) { return (bf16_t)(pk2(f, 0.f) & 0xffffu); }
__device__ __forceinline__ float bf2f(bf16_t b) { return __uint_as_float(((unsigned)b) << 16); }
__device__ __forceinline__ float bflo(unsigned w) { return __uint_as_float(w << 16); }
__device__ __forceinline__ float bfhi(unsigned w) { return __uint_as_float(w & 0xffff0000u); }
__device__ __forceinline__ float sigmoidf_(float x) { return __builtin_amdgcn_rcpf(1.0f + __expf(-x)); }
__device__ __forceinline__ float siluf_(float x) { return x * __builtin_amdgcn_rcpf(1.0f + __expf(-x)); }
__device__ __forceinline__ float logsigf_(float x) { return fminf(x, 0.f) - __logf(1.0f + __expf(-fabsf(x))); }
__device__ __forceinline__ float softplusf_(float x) { return fmaxf(x, 0.f) + log1pf(__expf(-fabsf(x))); }
__device__ __forceinline__ bool row_valid(int r) { return r < NREAL || (r >= META_ROW0 && r < META_END); }
__device__ __forceinline__ float wave_sum(float v) {
#define DPP_ADD(ctrl, rmask) v += __int_as_float(__builtin_amdgcn_update_dpp(0, __float_as_int(v), (ctrl), (rmask), 0xf, false))
    DPP_ADD(0x111, 0xf); DPP_ADD(0x112, 0xf); DPP_ADD(0x114, 0xf); DPP_ADD(0x118, 0xf);
    DPP_ADD(0x142, 0xa); DPP_ADD(0x143, 0xc);
#undef DPP_ADD
    return __int_as_float(__builtin_amdgcn_readlane(__float_as_int(v), 63));
}
#define LDS_WAIT() asm volatile("s_waitcnt lgkmcnt(0)" ::: "memory")

#define XB_TMO      128
#define XB_XCNT(j)  (256  + 64 * (j))
#define XB_XSUB(j)  (1280 + 64 * (j))
#define XB_XGEN(j)  (2304 + 64 * (j))
#define XB_TOP      3328
#define XB_TOPGEN   3392
#define XCD_BAR_WORDS 3456
#define XB_SPIN_CAP (1u << 18)
__device__ __forceinline__ unsigned xb_ld(unsigned* p)              { return __hip_atomic_load(p, __ATOMIC_RELAXED, __HIP_MEMORY_SCOPE_AGENT); }
__device__ __forceinline__ unsigned xb_add(unsigned* p, unsigned v) { return __hip_atomic_fetch_add(p, v, __ATOMIC_RELAXED, __HIP_MEMORY_SCOPE_AGENT); }
__device__ __forceinline__ unsigned xb_xcc_id() { return (unsigned)__builtin_amdgcn_s_getreg((3 << 11) | 20) & 0xFu; }
#define XB_SPIN(cond, bar) do { unsigned _sp = 0; while (cond) { __builtin_amdgcn_s_sleep(1); \
    if ((++_sp & 255u) == 0u) { if (xb_ld(&(bar)[XB_TMO])) break; if (_sp > XB_SPIN_CAP) { atomicAdd(&(bar)[XB_TMO], 1u); break; } } } } while (0)
struct XcdBarrier { unsigned* bar; unsigned x; volatile LAS unsigned* st; };
__device__ __forceinline__ XcdBarrier xcd_barrier_post(unsigned* bar, volatile LAS unsigned* st) {
    XcdBarrier b; b.bar = bar; b.x = xb_xcc_id(); b.st = st;
    if (threadIdx.x == 0) (void)xb_add(&bar[XB_XCNT(b.x)], 1u);
    return b;
}
__device__ __forceinline__ void xcd_barrier_complete(unsigned* bar, unsigned x, unsigned& nloc, unsigned& nx, const unsigned G) {
    unsigned sum, cnt, mine, sp = 0u;
    for (;;) {
        sum = 0u; cnt = 0u; mine = 0u;
#pragma unroll
        for (unsigned j = 0; j < 16; ++j) { const unsigned c = xb_ld(&bar[XB_XCNT(j)]); sum += c; cnt += (c > 0u) ? 1u : 0u; mine = (j == x) ? c : mine; }
        if (sum == G) break;
        __builtin_amdgcn_s_sleep(1);
        if ((++sp & 255u) == 0u) { if (xb_ld(&bar[XB_TMO])) break; if (sp > XB_SPIN_CAP) { atomicAdd(&bar[XB_TMO], 1u); break; } }
    }
    nloc = mine > 0u ? mine : 1u; nx = cnt > 0u ? cnt : 1u;
}
__device__ __attribute__((noinline)) void xcd_barrier(unsigned* bar_, unsigned x_, volatile LAS unsigned* st_, int tid_, unsigned G_) {
    XcdBarrier b; b.bar = bar_; b.x = x_; b.st = st_;
    asm volatile("s_waitcnt vmcnt(0)" ::: "memory");
    __syncthreads();
    if (tid_ == 0) {
        unsigned* bar = b.bar;
        __builtin_amdgcn_s_waitcnt(0);
        unsigned nloc = b.st[0], nx = b.st[1];
        if (nloc == 0u) { xcd_barrier_complete(bar, b.x, nloc, nx, G_); b.st[0] = nloc; b.st[1] = nx; }
        const unsigned old = xb_add(&bar[XB_XSUB(b.x)], 1u);
        const unsigned gen = old / nloc;
        if (old + 1u == (gen + 1u) * nloc) {
            __builtin_amdgcn_fence(__ATOMIC_RELEASE, "agent");
            asm volatile("s_waitcnt vmcnt(0)" ::: "memory");
            const unsigned og = xb_add(&bar[XB_TOP], 1u);
            const unsigned tg = og / nx;
            if (og + 1u == (tg + 1u) * nx) xb_add(&bar[XB_TOPGEN], 1u);
            else XB_SPIN(xb_ld(&bar[XB_TOPGEN]) == tg, bar);
            __builtin_amdgcn_fence(__ATOMIC_ACQUIRE, "agent");
            xb_add(&bar[XB_XGEN(b.x)], 1u);
            asm volatile("s_waitcnt vmcnt(0)" ::: "memory");
        } else {
            XB_SPIN(xb_ld(&bar[XB_XGEN(b.x)]) == gen, bar);
            __builtin_amdgcn_fence(__ATOMIC_ACQUIRE, "agent");
            asm volatile("s_waitcnt vmcnt(0)" ::: "memory");
        }
    }
    __syncthreads();
}
namespace pg8 {
constexpr int BM = 256, BK = 64, HALF = 128, HTB = HALF * BK * 2, STAGE_BYTES = 8 * HTB, NXCD = 8, WGM = 8;
__host__ __device__ __forceinline__ int lds_byte(int r, int c) { const int st = (r >> 4) * 2 + (c >> 5), rr = r & 15, cc = c & 31, ob = rr * 64 + cc * 2; return st * 1024 + (ob ^ (((ob >> 9) & 1) << 5)); }
__host__ __device__ __forceinline__ void stage_rc(int b, int& R, int& C) { const int st = b / 1024, sb = b % 1024, swz = sb ^ (((sb >> 9) & 1) << 5); R = (st >> 1) * 16 + swz / 64; C = (st & 1) * 32 + (swz % 64) / 2; }
__host__ __device__ __forceinline__ int perm32(int rho) { const int n = rho >> 4, i = rho & 15; return 8 * (i >> 2) + 4 * n + (i & 3); }

struct Unit { int pm, pn, ex; };
struct Gemm { const bf16_t* A; const bf16_t* Bt; int M, N, K; };

struct StaticOrder {
    int nM, nN, nwg, G, c;
    __device__ void init(int M, int N, int G_, int c_) { nM = M / BM; nN = N / BM; nwg = nM * nN; G = G_; c = c_; }
    __device__ bool next(int i, Unit& u) const {
        const long L = (long)i * G + c; if (L >= nwg) return false;
        int wgid = (int)L; { const int q = nwg / NXCD, r = nwg % NXCD, xcd = wgid % NXCD, off = wgid / NXCD; wgid = (xcd < r ? xcd * (q + 1) : r * (q + 1) + (xcd - r) * q) + off; }
        const int nig = WGM * nN, gid = wgid / nig, fm = gid * WGM, gsz = (nM - fm) < WGM ? (nM - fm) : WGM;
        u.pm = fm + ((wgid % nig) % gsz); u.pn = (wgid % nig) / gsz; u.ex = 0; return true;
    }
    __device__ __forceinline__ void ptrs(const Gemm& g, const Unit& u, const char*& a, const char*& b) const {
        const size_t tstep = (size_t)BM * g.K * 2; a = (const char*)g.A + (size_t)u.pm * tstep; b = (const char*)g.Bt + (size_t)u.pn * tstep; }
};
struct MoeOrder {
    int G, c, npn, ntiles; const LAS unsigned char* tab; size_t estride;
    __device__ bool next(int i, Unit& u) const {
        const long L = (long)i * G + c; if (L >= (long)ntiles * npn) return false;
        u.pm = (int)(L / npn); u.pn = (int)(L % npn); u.ex = (int)tab[u.pm]; return true;
    }
    __device__ __forceinline__ void ptrs(const Gemm& g, const Unit& u, const char*& a, const char*& b) const {
        const size_t tstep = (size_t)BM * g.K * 2; a = (const char*)g.A + (size_t)u.pm * tstep; b = (const char*)g.Bt + (size_t)u.ex * estride + (size_t)u.pn * tstep; }
};

template <class Epi, class Sched>
__device__ __forceinline__ void gemm_phase(LAS unsigned char* lds, const int tid, const Gemm g, const Sched& S, const Epi& E) {
    const int wid = __builtin_amdgcn_readfirstlane(tid >> 6), lane = tid & 63, wr = wid >> 2, wc = wid & 3, fr = lane & 15, fq = lane >> 4;
    int K = g.K; asm volatile("" : "+s"(K));
    const int nt = K / BK;
    unsigned voffA[2], voffB[2];
#pragma unroll
    for (int i = 0; i < 2; ++i) { int R, C; stage_rc(tid * 16 + i * 8192, R, C); const int Rb = Epi::PERM ? ((R & ~31) + perm32(R & 31)) : R;
        voffA[i] = (unsigned)(R * K + C) * 2u; voffB[i] = (unsigned)(Rb * K + C) * 2u; }
    const size_t kstep = (size_t)(BK * 2);
    const size_t hstep = (size_t)HALF * K * 2;
    const unsigned ldsw = (unsigned)wid * 1024u;
    const int aoff = lds_byte(wr * 64 + fr, fq * 8), boff = lds_byte(wc * 32 + fr, fq * 8);
#define PG8_SA(b, h) (((b) * 2 + (h)) * HTB)
#define PG8_SB(b, h) ((4 + (b) * 2 + (h)) * HTB)
#define PG8_STAGE(bufoff, gbase, voff) do { _Pragma("unroll") for (int _i = 0; _i < 2; ++_i) \
        __builtin_amdgcn_global_load_lds((const unsigned*)((const char*)(gbase) + (voff)[_i]), (LAS unsigned*)(lds + (bufoff) + ldsw + _i * 8192), 16, 0, 0); } while (0)
#define PG8_LDA(dst, b, h) do { _Pragma("unroll") for (int m = 0; m < 4; ++m) _Pragma("unroll") for (int k = 0; k < 2; ++k) dst[m][k] = *(const LAS bf16x8*)(lds + PG8_SA(b, h) + aoff + m * 2048 + k * 1024); } while (0)
#define PG8_LDB(dst, b, h) do { _Pragma("unroll") for (int n = 0; n < 2; ++n) _Pragma("unroll") for (int k = 0; k < 2; ++k) dst[n][k] = *(const LAS bf16x8*)(lds + PG8_SB(b, h) + boff + n * 2048 + k * 1024); } while (0)
#define PG8_MMA(ai, bj, At, Bt) do { __builtin_amdgcn_s_setprio(1); _Pragma("unroll") for (int m = 0; m < 4; ++m) _Pragma("unroll") for (int n = 0; n < 2; ++n) _Pragma("unroll") for (int k = 0; k < 2; ++k) \
        acc[ai][bj][m][n] = __builtin_amdgcn_mfma_f32_16x16x32_bf16(Bt[n][k], At[m][k], acc[ai][bj][m][n], 0, 0, 0); __builtin_amdgcn_s_setprio(0); } while (0)
#define PG8_WAIT_V(n) asm volatile("s_waitcnt vmcnt(" #n ")" ::: "memory")
#define PG8_WAIT_L(n) asm volatile("s_waitcnt lgkmcnt(" #n ")" ::: "memory")
#define PG8_BAR __builtin_amdgcn_s_barrier()
#define PG8_SCHED __builtin_amdgcn_sched_barrier(0)
    Unit cur, nxt; int ui = 0;
    if (!S.next(0, cur)) return;
    f32x4 acc[2][2][4][2];
#pragma unroll
    for (int a = 0; a < 2; ++a)
#pragma unroll
        for (int b = 0; b < 2; ++b)
#pragma unroll
            for (int m = 0; m < 4; ++m)
#pragma unroll
                for (int n = 0; n < 2; ++n) acc[a][b][m][n] = (f32x4){0.f, 0.f, 0.f, 0.f};
    bf16x8 At[4][2], B0[2][2], B1[2][2];
    const char* cA; const char* cB; S.ptrs(g, cur, cA, cB);
    PG8_STAGE(PG8_SB(0, 0), cB, voffB); PG8_STAGE(PG8_SA(0, 0), cA, voffA); PG8_STAGE(PG8_SB(0, 1), cB + hstep, voffB); PG8_STAGE(PG8_SA(0, 1), cA + hstep, voffA);
    if (wr == 1) PG8_BAR;
    PG8_WAIT_V(4); PG8_BAR;
    PG8_STAGE(PG8_SB(1, 0), cB + kstep, voffB); PG8_STAGE(PG8_SA(1, 0), cA + kstep, voffA); PG8_STAGE(PG8_SB(1, 1), cB + hstep + kstep, voffB);
    PG8_WAIT_V(6); PG8_BAR;
    for (;;) {
        const bool has_next = S.next(ui + 1, nxt);
        const char* nA = cA; const char* nB = cB; if (has_next) S.ptrs(g, nxt, nA, nB);
        for (int t = 0; t < nt; t += 2) {
            const bool last = (t == nt - 2);
            const char* a1 = cA + (size_t)(t + 1) * kstep;
            const char* a2 = last ? nA : cA + (size_t)(t + 2) * kstep; const char* b2 = last ? nB : cB + (size_t)(t + 2) * kstep;
            const char* a3 = a2 + kstep; const char* b3 = b2 + kstep;
            PG8_LDB(B0, 0, 0); PG8_SCHED; PG8_LDA(At, 0, 0); PG8_STAGE(PG8_SA(1, 1), a1 + hstep, voffA);
            PG8_WAIT_L(8); PG8_BAR; PG8_WAIT_L(0); PG8_MMA(0, 0, At, B0); PG8_BAR; PG8_SCHED;
            PG8_LDB(B1, 0, 1); PG8_STAGE(PG8_SB(0, 0), b2, voffB);
            PG8_BAR; PG8_WAIT_L(0); PG8_MMA(0, 1, At, B1); PG8_BAR;
            PG8_LDA(At, 0, 1); PG8_STAGE(PG8_SA(0, 0), a2, voffA);
            PG8_BAR; PG8_WAIT_L(0); PG8_MMA(1, 0, At, B0); PG8_BAR; PG8_SCHED;
            PG8_STAGE(PG8_SB(0, 1), b2 + hstep, voffB);
            PG8_WAIT_V(6); PG8_BAR; PG8_MMA(1, 1, At, B1); PG8_BAR;
            PG8_LDB(B0, 1, 0); PG8_SCHED; PG8_LDA(At, 1, 0); PG8_STAGE(PG8_SA(0, 1), a2 + hstep, voffA);
            PG8_WAIT_L(8); PG8_BAR; PG8_WAIT_L(0); PG8_MMA(0, 0, At, B0); PG8_BAR; PG8_SCHED;
            PG8_LDB(B1, 1, 1); PG8_STAGE(PG8_SB(1, 0), b3, voffB);
            PG8_BAR; PG8_WAIT_L(0); PG8_MMA(0, 1, At, B1); PG8_BAR;
            PG8_LDA(At, 1, 1); PG8_STAGE(PG8_SA(1, 0), a3, voffA);
            PG8_BAR; PG8_WAIT_L(0); PG8_MMA(1, 0, At, B0); PG8_BAR; PG8_SCHED;
            PG8_STAGE(PG8_SB(1, 1), b3 + hstep, voffB);
            PG8_WAIT_V(6); PG8_BAR; PG8_MMA(1, 1, At, B1); PG8_BAR;
        }
        E(acc, cur, wr, wc, fr, fq);
        if (!has_next) break;
#pragma unroll
        for (int a = 0; a < 2; ++a)
#pragma unroll
            for (int b = 0; b < 2; ++b)
#pragma unroll
                for (int m = 0; m < 4; ++m)
#pragma unroll
                    for (int n = 0; n < 2; ++n) acc[a][b][m][n] = (f32x4){0.f, 0.f, 0.f, 0.f};
        cur = nxt; cA = nA; cB = nB; ++ui;
    }
    PG8_WAIT_V(0);
    if (wr == 0) PG8_BAR;
    PG8_BAR;
#undef PG8_SA
#undef PG8_SB
#undef PG8_STAGE
#undef PG8_LDA
#undef PG8_LDB
#undef PG8_MMA
#undef PG8_WAIT_V
#undef PG8_WAIT_L
#undef PG8_BAR
#undef PG8_SCHED
}

#define EPI_PERM_LOOP(...) \
    _Pragma("unroll") for (int ai = 0; ai < 2; ++ai) _Pragma("unroll") for (int m = 0; m < 4; ++m) { const int row = u.pm * BM + ai * HALF + wr * 64 + m * 16 + fr; \
        _Pragma("unroll") for (int bj = 0; bj < 2; ++bj) { const int col0 = u.pn * BM + bj * HALF + wc * 32 + 8 * fq; f32x4 v0 = acc[ai][bj][m][0], v1 = acc[ai][bj][m][1]; __VA_ARGS__ } __builtin_amdgcn_sched_barrier(0); }

struct EpiInProj {
    static constexpr bool PERM = true;
    bf16_t* P; bf16_t* halo;
    __device__ __forceinline__ void operator()(const f32x4 (&acc)[2][2][4][2], const Unit& u, int wr, int wc, int fr, int fq) const {
        const bool is_qkv = u.pn >= 8 && u.pn < 14;
        EPI_PERM_LOOP({
            u32x4 w; w.x = pk2(v0[0], v0[1]); w.y = pk2(v0[2], v0[3]); w.z = pk2(v1[0], v1[1]); w.w = pk2(v1[2], v1[3]);
            *(u32x4*)(P + (size_t)row * LDP + col0) = w;
            if (is_qkv && (row & 63) >= 61) *(u32x4*)(halo + ((size_t)(row >> 6) * 3 + ((row & 63) - 61)) * 1536 + (col0 - PC_BQKV)) = w;
        })
    }
};
__device__ __forceinline__ float lfg(float a, float lb1, float x) { const float b = lb1 + logsigf_(x), mx = fmaxf(a, b); return mx + __logf(__expf(a - mx) + __expf(b - mx)); }
struct EpiSigmoid {
    static constexpr bool PERM = true;
    bf16_t* O; int ldc;
    __device__ __forceinline__ void operator()(const f32x4 (&acc)[2][2][4][2], const Unit& u, int wr, int wc, int fr, int fq) const {
        EPI_PERM_LOOP({
            u32x4 w; w.x = pk2(sigmoidf_(v0[0]), sigmoidf_(v0[1])); w.y = pk2(sigmoidf_(v0[2]), sigmoidf_(v0[3])); w.z = pk2(sigmoidf_(v1[0]), sigmoidf_(v1[1])); w.w = pk2(sigmoidf_(v1[2]), sigmoidf_(v1[3]));
            *(u32x4*)(O + (size_t)row * ldc + col0) = w;
        })
    }
};
struct EpiBranch {
    static constexpr bool PERM = true;
    bf16_t* merged; const bf16_t* gt; int n;
    __device__ __forceinline__ void operator()(const f32x4 (&acc)[2][2][4][2], const Unit& u, int wr, int wc, int fr, int fq) const {
        EPI_PERM_LOOP({
            const u32x4 gw = *(const u32x4*)(gt + (size_t)row * 3072 + n * 1024 + col0);
            float x[8] = {v0[0] * bflo(gw.x), v0[1] * bfhi(gw.x), v0[2] * bflo(gw.y), v0[3] * bfhi(gw.y), v1[0] * bflo(gw.z), v1[1] * bfhi(gw.z), v1[2] * bflo(gw.w), v1[3] * bfhi(gw.w)};
            bf16_t* mp = merged + (size_t)row * 1024 + col0;
            if (n != 0) { const u32x4 o = *(const u32x4*)mp; x[0] += bflo(o.x); x[1] += bfhi(o.x); x[2] += bflo(o.y); x[3] += bfhi(o.y); x[4] += bflo(o.z); x[5] += bfhi(o.z); x[6] += bflo(o.w); x[7] += bfhi(o.w); }
            u32x4 w; w.x = pk2(x[0], x[1]); w.y = pk2(x[2], x[3]); w.z = pk2(x[4], x[5]); w.w = pk2(x[6], x[7]);
            *(u32x4*)mp = w;
        })
    }
};
struct EpiResidual {
    static constexpr bool PERM = false;
    float* hreal; float* hmeta;
    __device__ __forceinline__ void operator()(const f32x4 (&acc)[2][2][4][2], const Unit& u, int wr, int wc, int fr, int fq) const {
#pragma unroll
        for (int ai = 0; ai < 2; ++ai)
#pragma unroll
            for (int m = 0; m < 4; ++m) { const int row = u.pm * BM + ai * HALF + wr * 64 + m * 16 + fr;
                float* rowp = (row < NREAL ? hreal + (size_t)row * D : hmeta + (size_t)(row - NREAL) * D) + u.pn * BM + wc * 32 + 4 * fq;
#pragma unroll
                for (int bj = 0; bj < 2; ++bj)
#pragma unroll
                    for (int n = 0; n < 2; ++n) { f32x4* p = (f32x4*)(rowp + bj * HALF + n * 16); *p = *p + acc[ai][bj][m][n]; } }
    }
};
struct EpiMoeUp {
    static constexpr bool PERM = true;
    bf16_t* H;
    __device__ __forceinline__ void operator()(const f32x4 (&acc)[2][2][4][2], const Unit& u, int wr, int wc, int fr, int fq) const {
        EPI_PERM_LOOP({
            const int hc = col0 >> 1;
            u32x2 w; w.x = pk2(siluf_(v0[0]) * v1[0], siluf_(v0[1]) * v1[1]); w.y = pk2(siluf_(v0[2]) * v1[2], siluf_(v0[3]) * v1[3]);
            *(u32x2*)(H + (size_t)row * 256 + hc) = w;
        })
    }
};
struct EpiMoeDown {
    static constexpr bool PERM = true;
    bf16_t* Y; const float* wrow;
    __device__ __forceinline__ void operator()(const f32x4 (&acc)[2][2][4][2], const Unit& u, int wr, int wc, int fr, int fq) const {
        EPI_PERM_LOOP({
            const float s = wrow[row];
            u32x4 w; w.x = pk2(v0[0] * s, v0[1] * s); w.y = pk2(v0[2] * s, v0[3] * s); w.z = pk2(v1[0] * s, v1[1] * s); w.w = pk2(v1[2] * s, v1[3] * s);
            *(u32x4*)(Y + (size_t)row * 1024 + col0) = w;
        })
    }
};
}
#define GAS __attribute__((address_space(1)))
struct Params { const float* in[24]; float* out; unsigned char* ws; int ph_lo, ph_hi; };
struct Frame {
    LAS unsigned char* lds; int tid, lane, wave, G, bid;
    __attribute__((address_space(1))) float* out; __attribute__((address_space(1))) unsigned char* ws; const float* const __attribute__((address_space(4)))* inp; int dry;
};
#define PHASE_FENCE(F) do { asm volatile("" : "+s"((F).ws), "+s"((F).out), "+s"((F).inp), "+v"((F).tid), "+s"((F).bid), "+s"((F).G)); \
    (F).lane = (F).tid & 63; (F).wave = __builtin_amdgcn_readfirstlane((F).tid >> 6); } while (0)
__device__ __forceinline__ const float* inp_ptr(const float* const __attribute__((address_space(4)))* inp, int i) { GAS const float* q = (GAS const float*)inp[i]; asm volatile("" : "+s"(q)); return (const float*)q; }
#define INP(i) inp_ptr(F.inp, (i))
#define WSP(T, off) ((T*)(GAS T*)(F.ws + (off)))
enum { I_X = 0, I_META, I_NORM_MIX, I_W_IN, I_LB, I_HGRN_NORM, I_GDN_CONV, I_GDN_ALOG, I_GDN_DT, I_GDN_NORM, I_GLA_W2, I_GLA_B, I_GLA_NORM, I_W_BRANCH, I_W_OUT, I_NORM_FFN,
       I_RG_W, I_RG_B, I_RE_W, I_RE_B, I_EW_GATE, I_EW_UP, I_EW_DOWN, I_NORM_FINAL };

__device__ __forceinline__ void transpose_item(const float* W, int ldw, int K, int nblk, bf16_t* WT, int row_off, int rowmode, LAS float* scr, int item, int lane) {
    const int kb = item / nblk, nb = item % nblk, k0 = 64 * kb, n0 = 32 * nb;
#pragma unroll 8
    for (int i = 0; i < 32; ++i) { const int kk = 2 * i + (lane >> 5); scr[kk * 33 + (lane & 31)] = W[(size_t)(k0 + kk) * ldw + n0 + (lane & 31)]; }
    LDS_WAIT(); asm volatile("" ::: "memory");
    const int c = lane & 7;
#pragma unroll
    for (int j = 0; j < 4; ++j) { const int n = (lane >> 3) + 8 * j; const LAS float* s = scr + (8 * c) * 33 + n;
        u32x4 o; o.x = pk2(s[0 * 33], s[1 * 33]); o.y = pk2(s[2 * 33], s[3 * 33]); o.z = pk2(s[4 * 33], s[5 * 33]); o.w = pk2(s[6 * 33], s[7 * 33]);
        const int nn = n0 + n; const int wrow = rowmode == 0 ? row_off + nn : row_off + 8 * (nn >> 2) + (nn & 3) + (rowmode == 2 ? 4 : 0);
        *(u32x4*)(WT + (size_t)wrow * K + k0 + 8 * c) = o; }
    LDS_WAIT(); asm volatile("" ::: "memory");
}

__device__ __forceinline__ void phase_pre(Frame& F) {
    const int gt = F.bid * NTHREADS + F.tid, NT = F.G * NTHREADS;
    float* sw1 = WSP(float, SM_SW1); float* rwg = WSP(float, SM_RWG); float* rwe = WSP(float, SM_RWE); float* lab = WSP(float, SM_LAB);
    for (int i = gt; i < 2 * 24 * 1024; i += NT) { const int l = i / (24 * 1024), c = (i / 1024) % 24, k = i % 1024;
        const int col = c < 16 ? 5128 + c : (c < 20 ? 3584 + (c - 16) : 3588 + (c - 20));
        sw1[i] = INP(I_W_IN)[((size_t)l * 1024 + k) * IN_COLS + col]; }
    for (int i = gt; i < 2 * 4 * 1024; i += NT) { const int l = i / (4 * 1024), c = (i / 1024) % 4, k = i % 1024; rwg[i] = INP(I_RG_W)[((size_t)l * 1024 + k) * 4 + c]; }
    for (int i = gt; i < 2 * 32 * 1024; i += NT) { const int l = i / (32 * 1024), c = (i / 1024) % 32, k = i % 1024; rwe[i] = INP(I_RE_W)[((size_t)l * 1024 + k) * 32 + c]; }
    for (int i = gt; i < 2 * 512; i += NT) { const int l = i / 512, c = i % 512; const float l0 = INP(I_LB)[c], l1 = INP(I_LB)[512 + c];
        const float p1 = 1.0f / (1.0f + expf(l0 - l1)); const float lb = l == 0 ? 0.f : p1;
        lab[l * 1024 + c] = logf(fmaxf(lb, 1e-30f)); lab[l * 1024 + 512 + c] = log1pf(-lb); }
}

__device__ __forceinline__ void convert_layer_weights(Frame& F, int l) {
    LAS float* scr = (LAS float*)(F.lds + F.wave * 16384);
    const int gw = F.bid * NWAVES + F.wave, NGW = F.G * NWAVES;
    const float* win = INP(I_W_IN) + (size_t)l * 1024 * IN_COLS;
    constexpr int I_MIX = 16 * 176, I_GATE = 16 * 96, I_BR = 8 * 32, I_OUT = 16 * 32, NITEMS = I_MIX + I_GATE + 3 * I_BR + I_OUT;
    for (int it = gw; it < NITEMS; it += NGW) {
        int r = it;
        if (r < I_MIX) { const int nb = r % 176, n0 = 32 * nb; const int shift = n0 < 3584 ? 0 : (n0 < 5120 ? 8 : 24);
            transpose_item(win + shift, IN_COLS, 1024, 176, WSP(bf16_t, WS_WMIX), 0, 0, scr, r, F.lane); continue; } r -= I_MIX;
        if (r < I_GATE) { transpose_item(win + 5656, IN_COLS, 1024, 96, WSP(bf16_t, WS_WGATE), 0, 0, scr, r, F.lane); continue; } r -= I_GATE;
        if (r < 3 * I_BR) { const int n = r / I_BR; transpose_item(INP(I_W_BRANCH) + ((size_t)l * 3 + n) * 512 * 1024, 1024, 512, 32, WSP(bf16_t, WS_WBT) + (size_t)n * 1024 * 512, 0, 0, scr, r % I_BR, F.lane); continue; } r -= 3 * I_BR;
        transpose_item(INP(I_W_OUT) + (size_t)l * 1024 * 1024, 1024, 1024, 32, WSP(bf16_t, WS_WOT), 0, 0, scr, r, F.lane);
    }
}
__device__ __forceinline__ void convert_expert_weights(Frame& F, int l) {
    LAS float* scr = (LAS float*)(F.lds + F.wave * 16384);
    const int gw = F.bid * NWAVES + F.wave, NGW = F.G * NWAVES;
    constexpr int I_G = 16 * 8, I_D = 4 * 32, PER = 2 * I_G + I_D;
    for (int it = gw; it < 32 * PER; it += NGW) {
        const int e = it / PER; int r = it % PER;
        bf16_t* w1t = WSP(bf16_t, WS_W1T) + (size_t)e * 512 * 1024; bf16_t* w2t = WSP(bf16_t, WS_W2T) + (size_t)e * 1024 * 256;
        if (r < I_G) { transpose_item(INP(I_EW_GATE) + ((size_t)l * 32 + e) * 1024 * 256, 256, 1024, 8, w1t, 0, 1, scr, r, F.lane); continue; } r -= I_G;
        if (r < I_G) { transpose_item(INP(I_EW_UP) + ((size_t)l * 32 + e) * 1024 * 256, 256, 1024, 8, w1t, 0, 2, scr, r, F.lane); continue; } r -= I_G;
        transpose_item(INP(I_EW_DOWN) + ((size_t)l * 32 + e) * 256 * 1024, 1024, 256, 32, w2t, 0, 0, scr, r, F.lane);
    }
}

#define OUTP ((float*)F.out)
__device__ __forceinline__ float* hrow(Frame& F, int r) { return r < NREAL ? OUTP + (size_t)r * D : WSP(float, WS_HMETA) + (size_t)(r - NREAL) * D; }

__device__ __forceinline__ void load_row16(const float* p, int lane, float (&x)[16]) {
#pragma unroll
    for (int j = 0; j < 4; ++j) { const f32x4 v = *((const f32x4*)p + lane + 64 * j); x[4 * j] = v[0]; x[4 * j + 1] = v[1]; x[4 * j + 2] = v[2]; x[4 * j + 3] = v[3]; }
}
__device__ __forceinline__ void add_bf16_row16(const bf16_t* p, int lane, float (&x)[16]) {
#pragma unroll
    for (int j = 0; j < 4; ++j) { const u32x2 w = *((const u32x2*)p + lane + 64 * j); x[4 * j] += bflo(w.x); x[4 * j + 1] += bfhi(w.x); x[4 * j + 2] += bflo(w.y); x[4 * j + 3] += bfhi(w.y); }
}
__device__ __forceinline__ void store_row16(float* p, int lane, const float (&x)[16]) {
#pragma unroll
    for (int j = 0; j < 4; ++j) *((f32x4*)p + lane + 64 * j) = (f32x4){x[4 * j], x[4 * j + 1], x[4 * j + 2], x[4 * j + 3]};
}
__device__ __forceinline__ void store_bf16_row16(bf16_t* p, int lane, const float (&x)[16]) {
#pragma unroll
    for (int j = 0; j < 4; ++j) { u32x2 w; w.x = pk2(x[4 * j], x[4 * j + 1]); w.y = pk2(x[4 * j + 2], x[4 * j + 3]); *((u32x2*)p + lane + 64 * j) = w; }
}
__device__ __forceinline__ void fetch_h_row(Frame& F, int l, int r, float (&x)[16]) {
    if (l == 0) {
        const float* src = r < NREAL ? INP(I_X) + (size_t)r * D : INP(I_META) + (size_t)(r - META_ROW0) * D;
        load_row16(src, F.lane, x);
    } else {
        load_row16(hrow(F, r), F.lane, x);
        const unsigned* tok = WSP(unsigned, SM_TOK) + (size_t)r * 8;
        const unsigned g0 = tok[6], g1 = tok[7];
        add_bf16_row16(WSP(bf16_t, WS_Y2) + (size_t)g0 * 1024, F.lane, x);
        add_bf16_row16(WSP(bf16_t, WS_Y2) + (size_t)g1 * 1024, F.lane, x);
    }
}

__device__ __forceinline__ void phase_norm1(Frame& F, int l) {
    convert_layer_weights(F, l);
    __syncthreads();
    LAS float* sw = (LAS float*)F.lds;
    { const float* src = WSP(float, SM_SW1) + (size_t)l * 24 * 1024; for (int i = F.tid; i < 24 * 1024 / 4; i += NTHREADS) ((LAS f32x4*)sw)[i] = ((const f32x4*)src)[i]; }
    __syncthreads();
    const int gw = F.bid * NWAVES + F.wave, NGW = F.G * NWAVES, lane = F.lane;
    const float* nw = INP(I_NORM_MIX) + (size_t)l * D;
    float wv[16]; load_row16(nw, lane, wv);
    bf16_t* U = WSP(bf16_t, WS_U);
    for (int g = gw; g < MROWS / 4; g += NGW) {
        const int r0 = 4 * g;
        if (!row_valid(r0)) {
            float z[16];
#pragma unroll
            for (int j = 0; j < 16; ++j) z[j] = 0.f;
#pragma unroll
            for (int i = 0; i < 4; ++i) { store_bf16_row16(U + (size_t)(r0 + i) * D, lane, z); if (l == 0) store_row16(hrow(F, r0 + i), lane, z);
                if (lane < 16) WSP(float, SM_GK)[(size_t)(r0 + i) * 16 + lane] = 0.f;
                else if (lane < 20) WSP(float, SM_BETA)[(size_t)(r0 + i) * 4 + (lane - 16)] = 0.f;
                else if (lane < 24) WSP(float, SM_LOGA)[(size_t)(r0 + i) * 4 + (lane - 20)] = 0.f; }
            continue;
        }
        float x[4][16];
#pragma unroll
        for (int i = 0; i < 4; ++i) {
            fetch_h_row(F, l, r0 + i, x[i]);
            store_row16(hrow(F, r0 + i), lane, x[i]);
            float ss = 0.f;
#pragma unroll
            for (int j = 0; j < 16; ++j) ss += x[i][j] * x[i][j];
            const float rstd = rsqrtf(wave_sum(ss) * (1.0f / D) + 1e-6f);
#pragma unroll
            for (int j = 0; j < 16; ++j) x[i][j] = x[i][j] * rstd * wv[j];
            store_bf16_row16(U + (size_t)(r0 + i) * D, lane, x[i]);
        }
        float ov[4] = {0.f, 0.f, 0.f, 0.f};
#pragma unroll 1
        for (int c = 0; c < 24; ++c) {
            float a0 = 0.f, a1 = 0.f, a2 = 0.f, a3 = 0.f;
#pragma unroll
            for (int j = 0; j < 4; ++j) { const f32x4 w = *((const LAS f32x4*)(sw + c * 1024) + lane + 64 * j);
#pragma unroll
                for (int e = 0; e < 4; ++e) { a0 += x[0][4 * j + e] * w[e]; a1 += x[1][4 * j + e] * w[e]; a2 += x[2][4 * j + e] * w[e]; a3 += x[3][4 * j + e] * w[e]; } }
            a0 = wave_sum(a0); a1 = wave_sum(a1); a2 = wave_sum(a2); a3 = wave_sum(a3);
            if (lane == c) { ov[0] = a0; ov[1] = a1; ov[2] = a2; ov[3] = a3; }
        }
        float* GK = WSP(float, SM_GK); float* BETA = WSP(float, SM_BETA); float* LOGA = WSP(float, SM_LOGA);
#pragma unroll
        for (int i = 0; i < 4; ++i) {
            const float v = ov[i]; const int r = r0 + i;
            if (lane < 16) GK[(size_t)r * 16 + lane] = v;
            else if (lane < 20) BETA[(size_t)r * 4 + (lane - 16)] = sigmoidf_(v);
            else if (lane < 24) { const int h = lane - 20; LOGA[(size_t)r * 4 + h] = -expf(INP(I_GDN_ALOG)[l * 4 + h]) * softplusf_(v + INP(I_GDN_DT)[l * 4 + h]); }
        }
    }
}

__device__ __forceinline__ bf16x8 mk8(u32x4 w) { return __builtin_bit_cast(bf16x8, w); }
__device__ __forceinline__ bf16x8 mk8(u32x2 lo, u32x2 hi) { u32x4 w; w.x = lo.x; w.y = lo.y; w.z = hi.x; w.w = hi.y; return __builtin_bit_cast(bf16x8, w); }
__device__ __forceinline__ bf16x8 pack_acc2(const f32x4& a, const f32x4& b) { u32x4 w; w.x = pk2(a[0], a[1]); w.y = pk2(a[2], a[3]); w.z = pk2(b[0], b[1]); w.w = pk2(b[2], b[3]); return __builtin_bit_cast(bf16x8, w); }
#define MFMA16(a, b, c) __builtin_amdgcn_mfma_f32_16x16x32_bf16((a), (b), (c), 0, 0, 0)

__device__ __forceinline__ int permpos(int k) { const int kk = k & 31; return (k & ~31) + ((kk & 16) ? 8 * ((kk - 16) >> 2) + 4 + (kk & 3) : 8 * (kk >> 2) + (kk & 3)); }
__device__ __forceinline__ float ldbf(GAS const bf16_t* p) { return bf2f(*p); }
#define ROWB(P, row, col) ((GAS const char*)(P) + ((size_t)(row) * LDP + (col)) * 2)
__device__ __forceinline__ float ldrow(GAS const char* rb, unsigned voff) { return bf2f(*(GAS const bf16_t*)(rb + voff)); }
__device__ __forceinline__ unsigned ldrow_u(GAS const char* rb, unsigned voff) { return (unsigned)*(GAS const bf16_t*)(rb + voff); }
__device__ __forceinline__ void strow(GAS const char* rb, unsigned voff, bf16_t v) { *(GAS bf16_t*)(rb + voff) = v; }

template <int DK, bool IS_A>
__device__ __forceinline__ void prep_gla(Frame& F, int l, int ug) {
    constexpr int QP = DK + 8, SUB = 2 * 64 * QP * 2 + 1024;
    int tid = F.tid; asm volatile("" : "+v"(tid));
    const int sg = __builtin_amdgcn_readfirstlane(tid >> 8), lt = tid & 255, c = lt & 127, hf = __builtin_amdgcn_readfirstlane(lt >> 7);
    const int unit = 2 * ug + sg, slot = unit >> 2, h = unit & 3, row0 = slot * 64, r0 = row0 + 32 * hf;
    const int qcol = IS_A ? PC_AQ + h * 128 : PC_CQ + h * 64, kcol = IS_A ? PC_AF + h * 128 : PC_CK + h * 64, vcol = IS_A ? PC_AI + h * 128 : PC_CV + h * 128;
    bf16_t* P = WSP(bf16_t, WS_P);
    LAS bf16_t* qt = (LAS bf16_t*)(F.lds + sg * SUB);
    LAS bf16_t* kt = qt + 64 * QP;
    LAS float* tot = (LAS float*)(kt + 64 * QP);
    const bool act = c < DK;
    float b[32];
    const unsigned vo = (unsigned)c * 2u, vop = (unsigned)permpos(c) * 2u;
    if (act) {
        float run = 0.f;
        if (IS_A) { const float* lab = WSP(float, SM_LAB) + l * 1024 + h * 128 + c; const float la = lab[0], lb = lab[512];
#pragma unroll
            for (int t = 0; t < 32; ++t) { run += pg8::lfg(la, lb, ldrow(ROWB(P, r0 + t, kcol), vo)); b[t] = run; }
        } else { float w2c[16]; const float* w2 = INP(I_GLA_W2) + (size_t)l * 16 * 256 + h * 64 + c; const float bias = INP(I_GLA_B)[l * 256 + h * 64 + c];
#pragma unroll
            for (int j = 0; j < 16; ++j) w2c[j] = w2[j * 256];
            const float* gk = WSP(float, SM_GK) + (size_t)r0 * 16;
#pragma unroll
            for (int t = 0; t < 32; ++t) { float s = bias;
#pragma unroll
                for (int j = 0; j < 16; ++j) s += gk[t * 16 + j] * w2c[j];
                run += logsigf_(s) * (1.0f / 16.0f); b[t] = run; }
        }
        tot[hf * 128 + c] = run;
    }
    __syncthreads();
    unsigned q1p[16], k1p[16];
    if (act) {
        const float bm = tot[c], bl = bm + tot[128 + c], boff = hf ? bm : 0.f;
        if (hf == 0 && !F.dry) (IS_A ? WSP(float, SM_DECA) + (size_t)unit * 128 : WSP(float, SM_DECC) + (size_t)unit * 64)[c] = __expf(bl);
#pragma unroll
        for (int t2 = 0; t2 < 16; ++t2) { float q1v[2], k1v[2];
#pragma unroll
            for (int u = 0; u < 2; ++u) { const int t = 2 * t2 + u; const float bt = b[t] + boff;
                const float qr = ldrow(ROWB(P, r0 + t, qcol), vo), q = IS_A ? siluf_(qr) * 0.08838834764831845f : qr * 0.125f;
                float k;
                if (IS_A) { const float lf = t == 0 ? b[0] : b[t] - b[t - 1]; k = row_valid(r0 + t) ? 1.0f - __expf(lf) : 0.f; } else k = ldrow(ROWB(P, r0 + t, kcol), vo);
                q1v[u] = q * __expf(bt); k1v[u] = k * __expf(bl - bt);
                qt[(32 * hf + t) * QP + c] = f2bf(q * __expf(fminf(bt - bm, 80.f))); kt[(32 * hf + t) * QP + c] = f2bf(k * __expf(fminf(bm - bt, 80.f))); }
            q1p[t2] = pk2(q1v[0], q1v[1]); k1p[t2] = pk2(k1v[0], k1v[1]); }
    }
    __syncthreads();
    if (act) {
        if (!F.dry) {
#pragma unroll
        for (int t2 = 0; t2 < 16; ++t2) { strow(ROWB(P, r0 + 2 * t2, qcol), vop, (bf16_t)(q1p[t2] & 0xffffu)); strow(ROWB(P, r0 + 2 * t2 + 1, qcol), vop, (bf16_t)(q1p[t2] >> 16)); } }
        bf16_t* kd = (IS_A ? P + (size_t)(row0 + (c >> 1)) * LDP + kcol + (c & 1) * 64 : P + (size_t)(row0 + c) * LDP + kcol) + 32 * hf;
#pragma unroll
        for (int o = 0; o < 4; ++o) if (!F.dry) *(u32x4*)(kd + 8 * o) = (u32x4){k1p[4 * o], k1p[4 * o + 1], k1p[4 * o + 2], k1p[4 * o + 3]};
    }
    { const int ws = (tid >> 6) & 3, lane = tid & 63, fr = lane & 15, fq = lane >> 4;
        bf16_t* sc = (IS_A ? WSP(bf16_t, WS_SCA) : WSP(bf16_t, WS_SCC)) + (size_t)unit * 4096;
#pragma unroll
        for (int jt = 0; jt < 4; ++jt) { const int mt = ws, nt = jt; f32x4 acc = {0.f, 0.f, 0.f, 0.f};
            if (nt <= mt) {
#pragma unroll
                for (int ks = 0; ks < DK / 32; ++ks) { const bf16x8 a = *(const LAS bf16x8*)(qt + (16 * mt + fr) * QP + 32 * ks + 8 * fq), bb = *(const LAS bf16x8*)(kt + (16 * nt + fr) * QP + 32 * ks + 8 * fq); acc = MFMA16(a, bb, acc); } }
#pragma unroll
            for (int r = 0; r < 4; ++r) { const int t = 16 * mt + 4 * fq + r, s = 16 * nt + fr; if (!F.dry) sc[t * 64 + s] = (s <= t) ? f2bf(acc[r]) : (bf16_t)0; } }
    }
    { unsigned vp[16];
#pragma unroll
        for (int t2 = 0; t2 < 16; ++t2) { vp[t2] = ldrow_u(ROWB(P, r0 + 2 * t2, vcol), vo) | (ldrow_u(ROWB(P, r0 + 2 * t2 + 1, vcol), vo) << 16); }
        __syncthreads();
        bf16_t* vd = P + (size_t)(row0 + (c >> 1)) * LDP + vcol + (c & 1) * 64 + 32 * hf;
#pragma unroll
        for (int o = 0; o < 4; ++o) if (!F.dry) *(u32x4*)(vd + 8 * o) = (u32x4){vp[4 * o], vp[4 * o + 1], vp[4 * o + 2], vp[4 * o + 3]}; }
    __syncthreads();
}

__device__ __forceinline__ void prep_gdn(Frame& F, int l, int ug) {
    constexpr int NP = 136, SUB = 2 * 64 * NP * 2 + 64 * 68 * 4 + 1024;
    int tid = F.tid; asm volatile("" : "+v"(tid));
    const int lane = tid & 63, sg = __builtin_amdgcn_readfirstlane(tid >> 8), lt = tid & 255, unit = 2 * ug + sg, slot = unit >> 2, h = unit & 3, row0 = slot * 64;
    bf16_t* P = WSP(bf16_t, WS_P);
    LAS bf16_t* qs = (LAS bf16_t*)(F.lds + sg * SUB);
    LAS bf16_t* ks = qs + 64 * NP;
    LAS float* AT = (LAS float*)(F.lds + sg * SUB + 2 * 64 * NP * 2);
    LAS float* gs = AT + 64 * 68;
    if (lt < 64) { const int valid_u = 1; (void)valid_u; float g = WSP(float, SM_LOGA)[(size_t)(row0 + lt) * 4 + h];
#pragma unroll
        for (int o = 1; o < 64; o <<= 1) { const float t = __shfl_up(g, o); if (lane >= o) g += t; }
        gs[lt] = g; gs[64 + lt] = WSP(float, SM_BETA)[(size_t)(row0 + lt) * 4 + h];
        if (lt == 63 && !F.dry) WSP(float, SM_DECB)[unit] = __expf(g); }
    const int hslot = slot == 256 ? -1 : ((slot & 63) == 0 ? 256 : slot - 1);
    float col[64];
    {
        const int c = lt & 127;
#pragma unroll
        for (int pass = 0; pass < 2; ++pass) {
            if (pass == 1 && lt >= 128) break;
            const int comp = lt >= 128 ? 1 : (pass == 0 ? 0 : 2), ch = comp * 512 + h * 128 + c;
            const float w0 = INP(I_GDN_CONV)[((size_t)l * 4 + 0) * 1536 + ch], w1 = INP(I_GDN_CONV)[((size_t)l * 4 + 1) * 1536 + ch], w2 = INP(I_GDN_CONV)[((size_t)l * 4 + 2) * 1536 + ch], w3 = INP(I_GDN_CONV)[((size_t)l * 4 + 3) * 1536 + ch];
            const unsigned voc = (unsigned)c * 2u; const int ccol = PC_BQKV + comp * 512 + h * 128;
            float x0 = 0.f, x1 = 0.f, x2 = 0.f;
            if (hslot >= 0) { const bf16_t* hp = WSP(bf16_t, SM_HALO) + (size_t)hslot * 3 * 1536 + ch; x0 = bf2f(hp[0]); x1 = bf2f(hp[1536]); x2 = bf2f(hp[3072]); }
#pragma unroll
            for (int t = 0; t < 64; ++t) { const float x3 = ldrow(ROWB(P, row0 + t, ccol), voc); const float y = siluf_(w0 * x0 + w1 * x1 + w2 * x2 + w3 * x3); x0 = x1; x1 = x2; x2 = x3;
                if (comp == 0) qs[t * NP + c] = f2bf(y); else { col[t] = y; if (comp == 1) ks[t * NP + c] = f2bf(y); } }
        }
    }
    __syncthreads();
    const int wv = (tid >> 6) & 3, fr = lane & 15, fq = lane >> 4;
#pragma unroll
    for (int jt = 0; jt < 2; ++jt) { const int which = jt, mt = wv; const LAS bf16_t* ap = which ? qs : ks; f32x4 a4 = {0.f, 0.f, 0.f, 0.f};
#pragma unroll
        for (int k4 = 0; k4 < 4; ++k4) { const bf16x8 a = *(const LAS bf16x8*)(ap + (16 * mt + fr) * NP + 32 * k4 + 8 * fq); a4 = MFMA16(a, a, a4); }
#pragma unroll
        for (int r = 0; r < 4; ++r) if (4 * fq + r == fr) { if (which == 0) gs[128 + 16 * mt + fr] = rsqrtf(a4[r] + 1e-6f); else gs[192 + 16 * mt + fr] = rsqrtf(a4[r] + 1e-6f) * 0.08838834764831845f; } }
    __syncthreads();
    { bf16_t* qkd = WSP(bf16_t, WS_QKD) + (size_t)unit * 4096;
#pragma unroll
        for (int jt = 0; jt < 8; ++jt) { const int tile = wv * 8 + jt, which = tile >> 4, mt = (tile >> 2) & 3, nt = tile & 3;
            const LAS bf16_t* ap = which ? qs : ks; f32x4 a4 = {0.f, 0.f, 0.f, 0.f};
            if (nt <= mt) {
#pragma unroll
                for (int k4 = 0; k4 < 4; ++k4) { const bf16x8 a = *(const LAS bf16x8*)(ap + (16 * mt + fr) * NP + 32 * k4 + 8 * fq), bb = *(const LAS bf16x8*)(ks + (16 * nt + fr) * NP + 32 * k4 + 8 * fq); a4 = MFMA16(a, bb, a4); } }
#pragma unroll
            for (int r = 0; r < 4; ++r) { const int t = 16 * mt + 4 * fq + r, s = 16 * nt + fr; const float dec = __expf(fminf(gs[t] - gs[s], 0.f)) * gs[128 + s];
                if (which) { if (!F.dry) qkd[t * 64 + permpos(s)] = (s <= t) ? f2bf(a4[r] * dec * gs[192 + t]) : (bf16_t)0; }
                else AT[s * 68 + t] = (s < t) ? gs[64 + t] * gs[128 + t] * a4[r] * dec : 0.f; } }
    }
    if (lt >= 128) { const int d = lt - 128; const float gl = gs[63]; bf16_t* dst = WSP(bf16_t, WS_K1TB) + (size_t)unit * 8192 + d * 64;
#pragma unroll
        for (int o = 0; o < 8; ++o) { const int s0 = 32 * (o >> 2) + 4 * (o & 3); float y[8];
#pragma unroll
            for (int j = 0; j < 8; ++j) { const int s = s0 + (j & 3) + (j >> 2) * 16; y[j] = col[s] * gs[128 + s] * __expf(gl - gs[s]); }
            if (!F.dry) *(u32x4*)(dst + 8 * o) = (u32x4){pk2(y[0], y[1]), pk2(y[2], y[3]), pk2(y[4], y[5]), pk2(y[6], y[7])}; }
    } else { const int pp = permpos(lt);
#pragma unroll 8
        for (int t = 0; t < 64; ++t) if (!F.dry) P[(size_t)(row0 + t) * LDP + PC_BQKV + h * 128 + pp] = f2bf(bf2f(qs[t * NP + lt]) * gs[192 + t] * __expf(gs[t])); }
    __syncthreads();
#pragma unroll
    for (int i = 0; i < 64; ++i) col[i] *= lt < 128 ? gs[64 + i] : gs[64 + i] * gs[128 + i] * __expf(gs[i]);
#pragma unroll
    for (int j = 0; j < 63; ++j) { const float xj = col[j]; asm volatile("" ::: "memory");
#pragma unroll
        for (int q4 = (j + 1) >> 2; q4 < 16; ++q4) { const f32x4 a = *(const LAS f32x4*)(AT + j * 68 + 4 * q4);
#pragma unroll
            for (int e = 0; e < 4; ++e) if (4 * q4 + e > j) col[4 * q4 + e] -= a[e] * xj; } }
    int tid2 = F.tid; asm volatile("" : "+v"(tid2)); const int lt2 = tid2 & 255, unit2 = 2 * ug + __builtin_amdgcn_readfirstlane(tid2 >> 8), row02 = (unit2 >> 2) * 64, h2 = unit2 & 3;
    if (lt2 < 128) { bf16_t* dst = P + (size_t)(row02 + (lt2 >> 1)) * LDP + PC_BQKV + 1024 + h2 * 128 + (lt2 & 1) * 64;
#pragma unroll
        for (int o = 0; o < 8; ++o) if (!F.dry) *(u32x4*)(dst + 8 * o) = (u32x4){pk2(col[8 * o], col[8 * o + 1]), pk2(col[8 * o + 2], col[8 * o + 3]), pk2(col[8 * o + 4], col[8 * o + 5]), pk2(col[8 * o + 6], col[8 * o + 7])};
    } else { const int pp = permpos(lt2 - 128);
        if (!F.dry) {
#pragma unroll
        for (int t = 0; t < 64; ++t) strow(ROWB(P, row02 + t, PC_BQKV + 512 + h2 * 128), (unsigned)pp * 2u, f2bf(col[t])); } }
    __syncthreads();
}

__device__ __forceinline__ void phase_prep(Frame& F, int l) {
#ifndef PREP_DRY_SEL
#define PREP_DRY_SEL 7
#endif
    const int sel = F.dry ? PREP_DRY_SEL : 7;
    if (sel & 1) for (int ug = F.bid; ug < 514; ug += F.G) prep_gla<128, true>(F, l, ug);
    if (sel & 2) for (int ug = F.bid; ug < 514; ug += F.G) prep_gdn(F, l, ug);
    if (sel & 4) for (int ug = F.bid; ug < 514; ug += F.G) prep_gla<64, false>(F, l, ug);
}
constexpr int SCAN_BUF = 57344;
template <int MX> struct ScanCfg;
template <> struct ScanCfg<0> { static constexpr int NM = 3, NI = 5; static constexpr int off(int m) { return m == 0 ? 0 : (m == 1 ? 16384 : 32768); } static constexpr int pitch(int m) { return m == 0 ? 256 : 128; } };
template <> struct ScanCfg<1> { static constexpr int NM = 4, NI = 7; static constexpr int off(int m) { return 16384 * m; } static constexpr int pitch(int m) { return m < 2 ? 256 : 128; } };
template <> struct ScanCfg<2> { static constexpr int NM = 3, NI = 3; static constexpr int off(int m) { return 8192 * m; } static constexpr int pitch(int m) { return 128; } };

template <int MX>
__device__ __forceinline__ void scan_mixer(Frame& F, int b, int h) {
    typedef ScanCfg<MX> C;
    constexpr int DK = MX == 2 ? 64 : 128, NT = DK / 16, NI = C::NI;
    const int w = F.wave, lane = F.lane, fr = lane & 15, fq = lane >> 4, ecol = 16 * w + fr;
    const char* Pb = (const char*)WSP(bf16_t, WS_P);
    const int qcol = MX == 0 ? PC_AQ + h * 128 : (MX == 1 ? PC_BQKV + h * 128 : PC_CQ + h * 64);
    const int kcol = MX == 0 ? PC_AF + h * 128 : (MX == 1 ? PC_BQKV + 512 + h * 128 : PC_CK + h * 64);
    const int vcol = MX == 0 ? PC_AI + h * 128 : (MX == 1 ? PC_BQKV + 1024 + h * 128 : PC_CV + h * 128);
    const char* SCb = (const char*)(MX == 0 ? WSP(bf16_t, WS_SCA) : (MX == 1 ? WSP(bf16_t, WS_QKD) : WSP(bf16_t, WS_SCC)));
    bf16_t* O = WSP(bf16_t, WS_O) + (size_t)MX * MROWS * 512;
    unsigned voff[NI]; int mi[NI];
#pragma unroll
    for (int i = 0; i < NI; ++i) { const int n = w + 8 * i, o = 1024 * n + 16 * lane; int m = 0;
#pragma unroll
        for (int q = 1; q < C::NM; ++q) if (o >= C::off(q)) m = q;
        int ro = o, pitch = 128;
#pragma unroll
        for (int q = 0; q < C::NM; ++q) if (m == q) { ro = o - C::off(q); pitch = C::pitch(q); }
        const int r = ro / pitch, pos = (ro % pitch) >> 4, pc = pos ^ (pitch == 256 ? (r & 15) : ((r >> 1) & 7));
        const bool packed = (MX == 0 && m == 1);
        const bool inP = (MX == 1) ? (m < 2) : (m < 2);
        voff[i] = (unsigned)(inP ? (packed ? (r >> 1) * (LDP * 2) + (r & 1) * 128 : r * (LDP * 2)) : r * pitch) + 16u * pc; mi[i] = m; }
    const unsigned x256_0 = (unsigned)(((0 | fq) ^ fr) << 4), x256_1 = (unsigned)(((4 | fq) ^ fr) << 4), x256_2 = (unsigned)(((8 | fq) ^ fr) << 4), x256_3 = (unsigned)(((12 | fq) ^ fr) << 4);
    const unsigned x128_0 = (unsigned)(((0 | fq) ^ ((fr >> 1) & 7)) << 4), x128_1 = (unsigned)(((4 | fq) ^ ((fr >> 1) & 7)) << 4);
    const unsigned x256[4] = {x256_0, x256_1, x256_2, x256_3}, x128[2] = {x128_0, x128_1};
#define SC_FRAG(buf, m, rt, kp) (*(const LAS bf16x8*)(F.lds + (buf) + C::off(m) + (16 * (rt) + fr) * C::pitch(m) + (C::pitch(m) == 256 ? x256[kp] : x128[(kp) & 1])))
    auto slot_of = [&](int step) { return step == 0 ? 256 : b * 64 + step - 1; };
    auto issue = [&](int step, int buf) {
        const int slot = slot_of(step), row0 = slot * 64, unit = slot * 4 + h;
        const char* base[4];
        if (MX == 1) { base[0] = Pb + ((size_t)row0 * LDP + kcol) * 2; base[1] = Pb + ((size_t)row0 * LDP + qcol) * 2; base[2] = (const char*)WSP(bf16_t, WS_K1TB) + (size_t)unit * 16384; base[3] = SCb + (size_t)unit * 8192; }
        else { base[0] = Pb + ((size_t)row0 * LDP + qcol) * 2; base[1] = Pb + ((size_t)row0 * LDP + kcol) * 2; base[2] = SCb + (size_t)unit * 8192; base[3] = base[2]; }
#pragma unroll
        for (int i = 0; i < NI; ++i) { const char* bs = mi[i] == 0 ? base[0] : (mi[i] == 1 ? base[1] : (mi[i] == 2 ? base[2] : base[3]));
            __builtin_amdgcn_global_load_lds((const unsigned*)(bs + voff[i]), (LAS unsigned*)(F.lds + buf + 1024 * (w + 8 * i)), 16, 0, 0); }
    };
    auto load_priv = [&](int step, u32x4 (&pv)[2]) {
        const int row0 = slot_of(step) * 64;
        const bf16_t* vt = (const bf16_t*)Pb + (size_t)(row0 + (ecol >> 1)) * LDP + vcol + (ecol & 1) * 64;
        if (MX == 1) { const u32x2 a = *(const u32x2*)(vt + 4 * fq), c = *(const u32x2*)(vt + 16 + 4 * fq), d = *(const u32x2*)(vt + 32 + 4 * fq), e = *(const u32x2*)(vt + 48 + 4 * fq);
            pv[0] = (u32x4){a.x, a.y, c.x, c.y}; pv[1] = (u32x4){d.x, d.y, e.x, e.y}; }
        else { pv[0] = *(const u32x4*)(vt + 8 * fq); pv[1] = *(const u32x4*)(vt + 32 + 8 * fq); }
    };
    f32x4 S[NT];
#pragma unroll
    for (int i = 0; i < NT; ++i) S[i] = (f32x4){0.f, 0.f, 0.f, 0.f};
    u32x4 pcur[2], pnxt[2];
    issue(0, 0); load_priv(0, pcur);
    for (int step = 0; step < 65; ++step) {
        const int buf = (step & 1) * SCAN_BUF, slot = slot_of(step), row0 = slot * 64, unit = slot * 4 + h;
        asm volatile("s_waitcnt vmcnt(0)" ::: "memory");
        __syncthreads();
        if (step + 1 < 65) { issue(step + 1, SCAN_BUF - buf); load_priv(step + 1, pnxt); }
        bf16x8 Sb[NT / 2];
#pragma unroll
        for (int kp = 0; kp < NT / 2; ++kp) Sb[kp] = pack_acc2(S[2 * kp], S[2 * kp + 1]);
        if (MX == 1) {
            f32x4 vn[4];
#pragma unroll
            for (int mt = 0; mt < 4; ++mt) { f32x4 acc = {0.f, 0.f, 0.f, 0.f};
#pragma unroll
                for (int kp = 0; kp < 4; ++kp) acc = MFMA16(SC_FRAG(buf, 0, mt, kp), Sb[kp], acc);
                const unsigned u0 = mt == 0 ? pcur[0].x : (mt == 1 ? pcur[0].z : (mt == 2 ? pcur[1].x : pcur[1].z)), u1 = mt == 0 ? pcur[0].y : (mt == 1 ? pcur[0].w : (mt == 2 ? pcur[1].y : pcur[1].w));
                vn[mt] = (f32x4){bflo(u0) - acc[0], bfhi(u0) - acc[1], bflo(u1) - acc[2], bfhi(u1) - acc[3]}; }
            bf16x8 Vb[2]; Vb[0] = pack_acc2(vn[0], vn[1]); Vb[1] = pack_acc2(vn[2], vn[3]);
#pragma unroll
            for (int mt = 0; mt < 4; ++mt) { f32x4 acc = {0.f, 0.f, 0.f, 0.f};
#pragma unroll
                for (int kp = 0; kp < 4; ++kp) acc = MFMA16(SC_FRAG(buf, 1, mt, kp), Sb[kp], acc);
#pragma unroll
                for (int kp = 0; kp < 2; ++kp) acc = MFMA16(SC_FRAG(buf, 3, mt, kp), Vb[kp], acc);
#pragma unroll
                for (int r = 0; r < 4; ++r) O[(size_t)(row0 + 16 * mt + 4 * fq + r) * 512 + h * 128 + ecol] = f2bf(acc[r]); }
            const float a = WSP(float, SM_DECB)[unit];
#pragma unroll
            for (int i = 0; i < 8; ++i) { S[i] = S[i] * a;
#pragma unroll
                for (int kp = 0; kp < 2; ++kp) S[i] = MFMA16(SC_FRAG(buf, 2, i, kp), Vb[kp], S[i]); }
        } else {
            const bf16x8 bv0 = mk8(pcur[0]), bv1 = mk8(pcur[1]);
#pragma unroll
            for (int mt = 0; mt < 4; ++mt) { f32x4 acc = {0.f, 0.f, 0.f, 0.f};
#pragma unroll
                for (int kp = 0; kp < NT / 2; ++kp) acc = MFMA16(SC_FRAG(buf, 0, mt, kp), Sb[kp], acc);
                acc = MFMA16(SC_FRAG(buf, 2, mt, 0), bv0, acc); acc = MFMA16(SC_FRAG(buf, 2, mt, 1), bv1, acc);
#pragma unroll
                for (int r = 0; r < 4; ++r) O[(size_t)(row0 + 16 * mt + 4 * fq + r) * 512 + h * 128 + ecol] = f2bf(acc[r]); }
            const float* dec = (MX == 0 ? WSP(float, SM_DECA) : WSP(float, SM_DECC)) + (size_t)unit * DK;
#pragma unroll
            for (int i = 0; i < NT; ++i) { const f32x4 d4 = *(const f32x4*)(dec + 16 * i + 4 * fq); S[i] = S[i] * d4;
                S[i] = MFMA16(SC_FRAG(buf, 1, i, 0), bv0, S[i]); S[i] = MFMA16(SC_FRAG(buf, 1, i, 1), bv1, S[i]); }
        }
        pcur[0] = pnxt[0]; pcur[1] = pnxt[1];
    }
#undef SC_FRAG
    asm volatile("s_waitcnt vmcnt(0)" ::: "memory");
    __syncthreads();
}
__device__ __forceinline__ void phase_scan(Frame& F) {
    if (F.bid >= 48) return;
    const int mixer = F.bid >> 4, b = (F.bid >> 2) & 3, h = F.bid & 3;
    if (mixer == 0) scan_mixer<0>(F, b, h);
    else if (mixer == 1) scan_mixer<1>(F, b, h);
    else scan_mixer<2>(F, b, h);
}

template <int KIND>
__device__ __forceinline__ void meta_gemm(Frame& F, const bf16_t* A, const bf16_t* Bt, int N, int K, int n) {
    const int gw = F.bid * NWAVES + F.wave, NGW = F.G * NWAVES, lane = F.lane, fr = lane & 15, fq = lane >> 4;
    for (int tile = gw; tile < N / 16; tile += NGW) {
        const bf16_t* ar = A + (size_t)fr * K + 8 * fq; const bf16_t* br = Bt + (size_t)(16 * tile + fr) * K + 8 * fq;
        f32x4 acc = {0.f, 0.f, 0.f, 0.f};
#pragma unroll 8
        for (int ks = 0; ks < K / 32; ++ks) acc = MFMA16(mk8(*(const u32x4*)(ar + 32 * ks)), mk8(*(const u32x4*)(br + 32 * ks)), acc);
#pragma unroll
        for (int r = 0; r < 4; ++r) { const int row = META_ROW0 + 4 * fq + r, col = 16 * tile + fr;
            if (KIND == 0) WSP(bf16_t, WS_GT)[(size_t)row * 3072 + col] = f2bf(sigmoidf_(acc[r]));
            else if (KIND == 1) { bf16_t* mp = WSP(bf16_t, WS_MERGED) + (size_t)row * 1024 + col; const float g = bf2f(WSP(bf16_t, WS_GT)[(size_t)row * 3072 + n * 1024 + col]);
                *mp = f2bf((n ? bf2f(*mp) : 0.f) + g * acc[r]); }
            else { float* hp = WSP(float, WS_HMETA) + (size_t)(row - NREAL) * D + col; *hp = *hp + acc[r]; } }
    }
}

__device__ __forceinline__ void phase_hnorm(Frame& F, int l) {
    const int gw = F.bid * NWAVES + F.wave, NGW = F.G * NWAVES, lane = F.lane;
    const bf16_t* P = WSP(bf16_t, WS_P);
    for (int it = gw; it < MROWS * 3; it += NGW) {
        const int r = it / 3, mx = it % 3;
        bf16_t* op = WSP(bf16_t, WS_O) + (size_t)mx * MROWS * 512 + (size_t)r * 512 + 8 * lane;
        if (!row_valid(r)) { if (!F.dry) *(u32x4*)op = (u32x4){0u, 0u, 0u, 0u}; continue; }
        const int gcol = mx == 0 ? PC_AG : (mx == 1 ? PC_BG : PC_CG);
        const float* nwb = mx == 0 ? INP(I_HGRN_NORM) : (mx == 1 ? INP(I_GDN_NORM) : INP(I_GLA_NORM)); const float* nw = nwb + (size_t)l * 128 + (8 * lane & 127);
        const u32x4 ow = *(const u32x4*)op, gw4 = *(const u32x4*)(P + (size_t)r * LDP + gcol + 8 * lane);
        float o[8] = {bflo(ow.x), bfhi(ow.x), bflo(ow.y), bfhi(ow.y), bflo(ow.z), bfhi(ow.z), bflo(ow.w), bfhi(ow.w)};
        const float g[8] = {siluf_(bflo(gw4.x)), siluf_(bfhi(gw4.x)), siluf_(bflo(gw4.y)), siluf_(bfhi(gw4.y)), siluf_(bflo(gw4.z)), siluf_(bfhi(gw4.z)), siluf_(bflo(gw4.w)), siluf_(bfhi(gw4.w))};
        float ss = 0.f;
#pragma unroll
        for (int j = 0; j < 8; ++j) ss += o[j] * o[j];
        ss += __shfl_xor(ss, 1); ss += __shfl_xor(ss, 2); ss += __shfl_xor(ss, 4); ss += __shfl_xor(ss, 8);
        const float rstd = rsqrtf(ss * (1.0f / 128.0f) + 1e-6f);
        const f32x4 n0 = *(const f32x4*)nw, n1 = *(const f32x4*)(nw + 4);
        const float nv[8] = {n0[0], n0[1], n0[2], n0[3], n1[0], n1[1], n1[2], n1[3]};
#pragma unroll
        for (int j = 0; j < 8; ++j) o[j] = o[j] * rstd * nv[j] * g[j];
        u32x4 y; y.x = pk2(o[0], o[1]); y.y = pk2(o[2], o[3]); y.z = pk2(o[4], o[5]); y.w = pk2(o[6], o[7]);
        if (!F.dry) *(u32x4*)op = y;
    }
}

__device__ __forceinline__ void phase_norm2(Frame& F, int l) {
    if (!F.dry) convert_expert_weights(F, l);
    __syncthreads();
    LAS float* sw = (LAS float*)F.lds;
    { const float* src = WSP(float, SM_RWE) + (size_t)l * 32 * 1024; for (int i = F.tid; i < 32 * 1024 / 4; i += NTHREADS) ((LAS f32x4*)sw)[i] = ((const f32x4*)src)[i]; }
    __syncthreads();
    const int gw = F.bid * NWAVES + F.wave, NGW = F.G * NWAVES, lane = F.lane;
    float wv[16]; load_row16(INP(I_NORM_FFN) + (size_t)l * D, lane, wv);
    bf16_t* U = WSP(bf16_t, WS_U);
    const float* rwg = WSP(float, SM_RWG) + (size_t)l * 4 * 1024;
    unsigned* cnt = WSP(unsigned, WS_CTL) + CW_CNT + l * 64;
    LAS unsigned* lcnt = (LAS unsigned*)(F.lds + LDS_TAB);
    if (F.tid < 64) lcnt[F.tid] = 0u;
    __syncthreads();
    for (int g = gw; g < MROWS / 4; g += NGW) {
        const int r0 = 4 * g;
        if (!row_valid(r0)) continue;
        float x[4][16];
#pragma unroll
        for (int i = 0; i < 4; ++i) {
            load_row16(hrow(F, r0 + i), lane, x[i]);
            float ss = 0.f;
#pragma unroll
            for (int j = 0; j < 16; ++j) ss += x[i][j] * x[i][j];
            const float rstd = rsqrtf(wave_sum(ss) * (1.0f / D) + 1e-6f);
#pragma unroll
            for (int j = 0; j < 16; ++j) x[i][j] = x[i][j] * rstd * wv[j];
            if (!F.dry) store_bf16_row16(U + (size_t)(r0 + i) * D, lane, x[i]);
        }
        float lg[4][4];
#pragma unroll
        for (int c = 0; c < 4; ++c) {
            float a0 = 0.f, a1 = 0.f, a2 = 0.f, a3 = 0.f;
#pragma unroll
            for (int j = 0; j < 4; ++j) { const f32x4 w = *((const f32x4*)(rwg + c * 1024) + lane + 64 * j);
#pragma unroll
                for (int e = 0; e < 4; ++e) { a0 += x[0][4 * j + e] * w[e]; a1 += x[1][4 * j + e] * w[e]; a2 += x[2][4 * j + e] * w[e]; a3 += x[3][4 * j + e] * w[e]; } }
            const float bg = INP(I_RG_B)[l * 4 + c];
            lg[0][c] = wave_sum(a0) + bg; lg[1][c] = wave_sum(a1) + bg; lg[2][c] = wave_sum(a2) + bg; lg[3][c] = wave_sum(a3) + bg;
        }
#pragma unroll
        for (int i = 0; i < 4; ++i) {
            int gi = 0; float gm = lg[i][0];
#pragma unroll
            for (int c = 1; c < 4; ++c) if (lg[i][c] > gm) { gm = lg[i][c]; gi = c; }
            float gsum = 0.f;
#pragma unroll
            for (int c = 0; c < 4; ++c) gsum += __expf(lg[i][c] - gm);
            const float gval = 1.0f / gsum;
            gi = __builtin_amdgcn_readfirstlane(gi);
            int ea = 0, eb = 0; float la = -3.0e38f, lb = -3.0e38f;
#pragma unroll 1
            for (int c = 0; c < 8; ++c) {
                float a = 0.f;
#pragma unroll
                for (int j = 0; j < 4; ++j) { const f32x4 w = *((const LAS f32x4*)(sw + (gi * 8 + c) * 1024) + lane + 64 * j);
#pragma unroll
                    for (int e = 0; e < 4; ++e) a += x[i][4 * j + e] * w[e]; }
                const float el = wave_sum(a) + INP(I_RE_B)[l * 32 + gi * 8 + c];
                if (el > la) { lb = la; eb = ea; la = el; ea = c; } else if (el > lb) { lb = el; eb = c; }
            }
            const float wa = 1.0f / (1.0f + __expf(lb - la)), wb = 1.0f - wa;
            if (lane == 0 && !F.dry) {
                const unsigned e0 = (unsigned)(gi * 8 + ea), e1 = (unsigned)(gi * 8 + eb);
                const unsigned p0 = __hip_atomic_fetch_add(lcnt + e0, 1u, __ATOMIC_RELAXED, __HIP_MEMORY_SCOPE_WORKGROUP), p1 = __hip_atomic_fetch_add(lcnt + e1, 1u, __ATOMIC_RELAXED, __HIP_MEMORY_SCOPE_WORKGROUP);
                unsigned* tok = WSP(unsigned, SM_TOK) + (size_t)(r0 + i) * 8;
                tok[0] = e0; tok[1] = p0; tok[2] = e1; tok[3] = p1; tok[4] = __float_as_uint(gval * wa); tok[5] = __float_as_uint(gval * wb);
            }
        }
    }
    __syncthreads();
    if (F.tid < 32 && !F.dry) lcnt[32 + F.tid] = atomicAdd(cnt + F.tid, lcnt[F.tid]);
    __syncthreads();
    if (!F.dry) for (int g = gw; g < MROWS / 4; g += NGW) { const int r0 = 4 * g; if (!row_valid(r0)) continue;
        if (lane < 4) { unsigned* tok = WSP(unsigned, SM_TOK) + (size_t)(r0 + lane) * 8; tok[1] += lcnt[32 + tok[0]]; tok[3] += lcnt[32 + tok[2]]; } }
}

__device__ __forceinline__ int moe_tables(Frame& F, int l) {
    LAS int* offs = (LAS int*)(F.lds + LDS_TAB); LAS unsigned char* tab = (LAS unsigned char*)(F.lds + LDS_TAB + 384); LAS int* cn = (LAS int*)(F.lds + LDS_TAB + 192);
    const unsigned* cnt = WSP(unsigned, WS_CTL) + CW_CNT + l * 64;
    __syncthreads();
    if (F.tid < 32) cn[F.tid] = (int)__hip_atomic_load(cnt + F.tid, __ATOMIC_RELAXED, __HIP_MEMORY_SCOPE_AGENT);
    __syncthreads();
    if (F.tid == 0) { int acc = 0;
#pragma unroll 1
        for (int e = 0; e < 32; ++e) { offs[e] = acc; acc += ((cn[e] + 255) >> 8) << 8; }
        offs[32] = acc; }
    __syncthreads();
    if (F.tid < 160) { const int row = F.tid << 8; int e = 0;
#pragma unroll 1
        for (int k = 1; k < 32; ++k) if (offs[k] <= row) e = k;
        tab[F.tid] = (unsigned char)e; }
    __syncthreads();
    return offs[32] >> 8;
}

__device__ __forceinline__ void phase_gather(Frame& F, int l) {
    (void)moe_tables(F, l);
    const LAS int* offs = (const LAS int*)(F.lds + LDS_TAB); const LAS int* cn = (const LAS int*)(F.lds + LDS_TAB + 192);
    const int gw = F.bid * NWAVES + F.wave, NGW = F.G * NWAVES, lane = F.lane;
    const bf16_t* U = WSP(bf16_t, WS_U); bf16_t* XG = WSP(bf16_t, WS_XG); float* wrow = WSP(float, SM_WROW);
    for (int idx = gw; idx < NREAL + 16; idx += NGW) {
        const int r = idx < NREAL ? idx : META_ROW0 + (idx - NREAL);
        unsigned* tok = WSP(unsigned, SM_TOK) + (size_t)r * 8;
        const unsigned e0 = tok[0], p0 = tok[1], e1 = tok[2], p1 = tok[3];
        const unsigned g0 = (unsigned)offs[e0] + p0, g1 = (unsigned)offs[e1] + p1;
        if (lane == 0) { tok[6] = g0; tok[7] = g1; wrow[g0] = __uint_as_float(tok[4]); wrow[g1] = __uint_as_float(tok[5]); }
        const u32x4* src = (const u32x4*)(U + (size_t)r * D);
        const u32x4 a = src[lane], b = src[lane + 64];
        u32x4* d0 = (u32x4*)(XG + (size_t)g0 * D); u32x4* d1 = (u32x4*)(XG + (size_t)g1 * D);
        d0[lane] = a; d0[lane + 64] = b; d1[lane] = a; d1[lane + 64] = b;
    }
    u32x4 zz = {0u, 0u, 0u, 0u}; asm volatile("" : "+v"(zz));
    for (int i = gw; i < 32 * 256; i += NGW) { const int e = i >> 8, j = i & 255; const int row = offs[e] + cn[e] + j;
        if (row < offs[e + 1]) { u32x4* d = (u32x4*)(XG + (size_t)row * D); d[lane] = zz; d[lane + 64] = zz; if (lane == 0) wrow[row] = 0.f; } }
}

__device__ __forceinline__ void phase_final(Frame& F) {
    const int gw = F.bid * NWAVES + F.wave, NGW = F.G * NWAVES, lane = F.lane;
    float wv[16]; load_row16(INP(I_NORM_FINAL), lane, wv);
    for (int r = gw; r < NREAL; r += NGW) {
        float x[16]; fetch_h_row(F, 2, r, x);
        float ss = 0.f;
#pragma unroll
        for (int j = 0; j < 16; ++j) ss += x[j] * x[j];
        const float rstd = rsqrtf(wave_sum(ss) * (1.0f / D) + 1e-6f);
#pragma unroll
        for (int j = 0; j < 16; ++j) x[j] = x[j] * rstd * wv[j];
        store_row16(OUTP + (size_t)r * D, lane, x);
    }
}
constexpr int PH_PER_LAYER = 14, N_PHASES = 2 + 2 * PH_PER_LAYER;
#ifndef DBG_STOP
#define DBG_STOP 0
#endif
#ifndef DBG_SRC
#define DBG_SRC WS_P
#define DBG_LD LDP
#endif
#ifndef DBG_TA
#define DBG_TA -1
#endif
#ifndef DBG_TB
#define DBG_TB -1
#endif
#ifndef DUP_MASK
#define DUP_MASK 0u
#endif
#define DUPN(j) (((DUP_MASK >> (j)) & 1u) ? 2 : 1)
#ifndef MK_ONE_LAUNCH
#define MK_ONE_LAUNCH 1
#endif

template <unsigned PHMASK_T>
__global__ void __launch_bounds__(NTHREADS, 2) hybrid_fwd(Params p) {
    extern __shared__ __attribute__((aligned(16))) unsigned char lds_raw[];
    Frame F;
    F.lds = (LAS unsigned char*)lds_raw; F.tid = threadIdx.x; F.lane = F.tid & 63; F.wave = __builtin_amdgcn_readfirstlane(F.tid >> 6); F.G = gridDim.x; F.bid = blockIdx.x; F.dry = 0;
    F.out = (GAS float*)p.out; F.ws = (GAS unsigned char*)p.ws; F.inp = (const float* const __attribute__((address_space(4)))*)__builtin_amdgcn_kernarg_segment_ptr();
    volatile LAS unsigned* MISC = (volatile LAS unsigned*)(F.lds + LDS_MISC);
    if (F.tid < 128) MISC[F.tid] = 0u;
    __syncthreads();
#if MK_ONE_LAUNCH
    constexpr int lo = 0, hi = N_PHASES;
#else
    const int lo = p.ph_lo, hi = p.ph_hi;
#endif
    if (hi - lo > 1) (void)xcd_barrier_post(WSP(unsigned, WS_CTL) + CW_BAR, MISC + 8);
#define GRID_BARRIER() xcd_barrier(WSP(unsigned, WS_CTL) + CW_BAR, xb_xcc_id(), (volatile LAS unsigned*)(F.lds + LDS_MISC) + 8, F.tid, (unsigned)F.G)
#define EN(j) ((PHMASK_T >> (j)) & 1u)
#define IN(k) (lo <= (k) && (k) < hi)
    if (DBG_TA >= 0 && F.tid == 0) { MISC[16] = (unsigned)__builtin_amdgcn_s_memrealtime(); MISC[17] = 0u; }
#define SEAM(k) do { if (IN(k) && IN((k) + 1)) GRID_BARRIER(); PHASE_FENCE(F); \
    if (DBG_TA >= 0 && F.tid == 0) { const unsigned t_now = (unsigned)__builtin_amdgcn_s_memrealtime(); const int kk = (k) == 0 ? 15 : (((k) - 1) % PH_PER_LAYER); const int kind = (kk >= 6 && kk <= 8) ? 6 : kk; \
        if (kind == DBG_TA) MISC[17] += t_now - MISC[16]; MISC[16] = t_now; } } while (0)
    PHASE_FENCE(F);
    if (EN(15) && IN(0)) phase_pre(F);
    SEAM(0);
    { constexpr int l = 0;
        const int pb = 1 + PH_PER_LAYER * l;
        for (int rep = 0; rep < (l == 0 ? DUPN(0) : 1); ++rep) { if (rep) { GRID_BARRIER(); PHASE_FENCE(F); } if (EN(0) && IN(pb + 0)) phase_norm1(F, l); }
        SEAM(pb + 0);
        for (int rep = 0; rep < DUPN(1); ++rep) { if (rep) { GRID_BARRIER(); PHASE_FENCE(F); }
        if (EN(1) && IN(pb + 1)) {
            pg8::Gemm g{WSP(bf16_t, WS_U), WSP(bf16_t, WS_WMIX), MROWS, LDP, D}; pg8::StaticOrder S; S.init(MROWS, LDP, F.G, F.bid);
            pg8::EpiInProj E{WSP(bf16_t, WS_P), WSP(bf16_t, SM_HALO)};
            pg8::gemm_phase(F.lds, F.tid, g, S, E);
        } }
        SEAM(pb + 1);
        for (int rep = 0; rep < DUPN(2); ++rep) { if (rep) { GRID_BARRIER(); PHASE_FENCE(F); F.dry = 1; asm volatile("" : "+s"(F.dry)); } if (EN(2) && IN(pb + 2)) phase_prep(F, l); F.dry = 0; }
        SEAM(pb + 2);
        for (int rep = 0; rep < DUPN(3); ++rep) { if (rep) { GRID_BARRIER(); PHASE_FENCE(F); } if (EN(3) && IN(pb + 3)) phase_scan(F); }
        SEAM(pb + 3);
        for (int rep = 0; rep < DUPN(4); ++rep) { if (rep) { GRID_BARRIER(); PHASE_FENCE(F); F.dry = 1; asm volatile("" : "+s"(F.dry)); } if (EN(4) && IN(pb + 4)) phase_hnorm(F, l); F.dry = 0; }
        SEAM(pb + 4);
        for (int rep = 0; rep < DUPN(5); ++rep) { if (rep) { GRID_BARRIER(); PHASE_FENCE(F); }
        if (EN(5) && IN(pb + 5)) {
            pg8::Gemm g{WSP(bf16_t, WS_U), WSP(bf16_t, WS_WGATE), NREAL, 3072, D}; pg8::StaticOrder S; S.init(NREAL, 3072, F.G, F.bid);
            pg8::EpiSigmoid E{WSP(bf16_t, WS_GT), 3072};
            pg8::gemm_phase(F.lds, F.tid, g, S, E);
            meta_gemm<0>(F, WSP(bf16_t, WS_U) + (size_t)META_ROW0 * D, WSP(bf16_t, WS_WGATE), 3072, D, 0);
        } }
        SEAM(pb + 5);
        for (int n = 0; n < 3; ++n) {
            if (EN(6) && IN(pb + 6 + n)) {
                pg8::Gemm g{WSP(bf16_t, WS_O) + (size_t)n * MROWS * 512, WSP(bf16_t, WS_WBT) + (size_t)n * 1024 * 512, NREAL, D, 512}; pg8::StaticOrder S; S.init(NREAL, D, F.G, F.bid);
                pg8::EpiBranch E{WSP(bf16_t, WS_MERGED), WSP(bf16_t, WS_GT), n};
                pg8::gemm_phase(F.lds, F.tid, g, S, E);
                meta_gemm<1>(F, WSP(bf16_t, WS_O) + (size_t)n * MROWS * 512 + (size_t)META_ROW0 * 512, WSP(bf16_t, WS_WBT) + (size_t)n * 1024 * 512, D, 512, n);
            }
            SEAM(pb + 6 + n);
        }
        if (EN(9) && IN(pb + 9)) {
            pg8::Gemm g{WSP(bf16_t, WS_MERGED), WSP(bf16_t, WS_WOT), NREAL, D, D}; pg8::StaticOrder S; S.init(NREAL, D, F.G, F.bid);
            pg8::EpiResidual E{OUTP, WSP(float, WS_HMETA)};
            pg8::gemm_phase(F.lds, F.tid, g, S, E);
            meta_gemm<2>(F, WSP(bf16_t, WS_MERGED) + (size_t)META_ROW0 * D, WSP(bf16_t, WS_WOT), D, D, 0);
        }
        SEAM(pb + 9);
        for (int rep = 0; rep < DUPN(10); ++rep) { if (rep) { GRID_BARRIER(); PHASE_FENCE(F); F.dry = 1; asm volatile("" : "+s"(F.dry)); } if (EN(10) && IN(pb + 10)) phase_norm2(F, l); F.dry = 0; }
        SEAM(pb + 10);
        for (int rep = 0; rep < DUPN(11); ++rep) { if (rep) { GRID_BARRIER(); PHASE_FENCE(F); } if (EN(11) && IN(pb + 11)) phase_gather(F, l); }
        SEAM(pb + 11);
        if (EN(12) && IN(pb + 12)) {
            const int ntiles = moe_tables(F, l);
            pg8::Gemm g{WSP(bf16_t, WS_XG), WSP(bf16_t, WS_W1T), XG_ROWS, 512, D};
            pg8::MoeOrder S{F.G, F.bid, 2, ntiles, (const LAS unsigned char*)(F.lds + LDS_TAB + 384), (size_t)512 * 1024 * 2};
            pg8::EpiMoeUp E{WSP(bf16_t, WS_HG)};
            pg8::gemm_phase(F.lds, F.tid, g, S, E);
        }
        SEAM(pb + 12);
        if (EN(13) && IN(pb + 13)) {
            const int ntiles = moe_tables(F, l);
            pg8::Gemm g{WSP(bf16_t, WS_HG), WSP(bf16_t, WS_W2T), XG_ROWS, D, 256};
            pg8::MoeOrder S{F.G, F.bid, 4, ntiles, (const LAS unsigned char*)(F.lds + LDS_TAB + 384), (size_t)1024 * 256 * 2};
            pg8::EpiMoeDown E{WSP(bf16_t, WS_Y2), WSP(float, SM_WROW)};
            pg8::gemm_phase(F.lds, F.tid, g, S, E);
        }
        SEAM(pb + 13);
    }
    { constexpr int l = 1;
        const int pb = 1 + PH_PER_LAYER * l;
        for (int rep = 0; rep < (l == 0 ? DUPN(0) : 1); ++rep) { if (rep) { GRID_BARRIER(); PHASE_FENCE(F); } if (EN(0) && IN(pb + 0)) phase_norm1(F, l); }
        SEAM(pb + 0);
        for (int rep = 0; rep < DUPN(1); ++rep) { if (rep) { GRID_BARRIER(); PHASE_FENCE(F); }
        if (EN(1) && IN(pb + 1)) {
            pg8::Gemm g{WSP(bf16_t, WS_U), WSP(bf16_t, WS_WMIX), MROWS, LDP, D}; pg8::StaticOrder S; S.init(MROWS, LDP, F.G, F.bid);
            pg8::EpiInProj E{WSP(bf16_t, WS_P), WSP(bf16_t, SM_HALO)};
            pg8::gemm_phase(F.lds, F.tid, g, S, E);
        } }
        SEAM(pb + 1);
        for (int rep = 0; rep < DUPN(2); ++rep) { if (rep) { GRID_BARRIER(); PHASE_FENCE(F); F.dry = 1; asm volatile("" : "+s"(F.dry)); } if (EN(2) && IN(pb + 2)) phase_prep(F, l); F.dry = 0; }
        SEAM(pb + 2);
        for (int rep = 0; rep < DUPN(3); ++rep) { if (rep) { GRID_BARRIER(); PHASE_FENCE(F); } if (EN(3) && IN(pb + 3)) phase_scan(F); }
        SEAM(pb + 3);
        for (int rep = 0; rep < DUPN(4); ++rep) { if (rep) { GRID_BARRIER(); PHASE_FENCE(F); F.dry = 1; asm volatile("" : "+s"(F.dry)); } if (EN(4) && IN(pb + 4)) phase_hnorm(F, l); F.dry = 0; }
        SEAM(pb + 4);
        for (int rep = 0; rep < DUPN(5); ++rep) { if (rep) { GRID_BARRIER(); PHASE_FENCE(F); }
        if (EN(5) && IN(pb + 5)) {
            pg8::Gemm g{WSP(bf16_t, WS_U), WSP(bf16_t, WS_WGATE), NREAL, 3072, D}; pg8::StaticOrder S; S.init(NREAL, 3072, F.G, F.bid);
            pg8::EpiSigmoid E{WSP(bf16_t, WS_GT), 3072};
            pg8::gemm_phase(F.lds, F.tid, g, S, E);
            meta_gemm<0>(F, WSP(bf16_t, WS_U) + (size_t)META_ROW0 * D, WSP(bf16_t, WS_WGATE), 3072, D, 0);
        } }
        SEAM(pb + 5);
        for (int n = 0; n < 3; ++n) {
            if (EN(6) && IN(pb + 6 + n)) {
                pg8::Gemm g{WSP(bf16_t, WS_O) + (size_t)n * MROWS * 512, WSP(bf16_t, WS_WBT) + (size_t)n * 1024 * 512, NREAL, D, 512}; pg8::StaticOrder S; S.init(NREAL, D, F.G, F.bid);
                pg8::EpiBranch E{WSP(bf16_t, WS_MERGED), WSP(bf16_t, WS_GT), n};
                pg8::gemm_phase(F.lds, F.tid, g, S, E);
                meta_gemm<1>(F, WSP(bf16_t, WS_O) + (size_t)n * MROWS * 512 + (size_t)META_ROW0 * 512, WSP(bf16_t, WS_WBT) + (size_t)n * 1024 * 512, D, 512, n);
            }
            SEAM(pb + 6 + n);
        }
        if (EN(9) && IN(pb + 9)) {
            pg8::Gemm g{WSP(bf16_t, WS_MERGED), WSP(bf16_t, WS_WOT), NREAL, D, D}; pg8::StaticOrder S; S.init(NREAL, D, F.G, F.bid);
            pg8::EpiResidual E{OUTP, WSP(float, WS_HMETA)};
            pg8::gemm_phase(F.lds, F.tid, g, S, E);
            meta_gemm<2>(F, WSP(bf16_t, WS_MERGED) + (size_t)META_ROW0 * D, WSP(bf16_t, WS_WOT), D, D, 0);
        }
        SEAM(pb + 9);
        for (int rep = 0; rep < DUPN(10); ++rep) { if (rep) { GRID_BARRIER(); PHASE_FENCE(F); F.dry = 1; asm volatile("" : "+s"(F.dry)); } if (EN(10) && IN(pb + 10)) phase_norm2(F, l); F.dry = 0; }
        SEAM(pb + 10);
        for (int rep = 0; rep < DUPN(11); ++rep) { if (rep) { GRID_BARRIER(); PHASE_FENCE(F); } if (EN(11) && IN(pb + 11)) phase_gather(F, l); }
        SEAM(pb + 11);
        if (EN(12) && IN(pb + 12)) {
            const int ntiles = moe_tables(F, l);
            pg8::Gemm g{WSP(bf16_t, WS_XG), WSP(bf16_t, WS_W1T), XG_ROWS, 512, D};
            pg8::MoeOrder S{F.G, F.bid, 2, ntiles, (const LAS unsigned char*)(F.lds + LDS_TAB + 384), (size_t)512 * 1024 * 2};
            pg8::EpiMoeUp E{WSP(bf16_t, WS_HG)};
            pg8::gemm_phase(F.lds, F.tid, g, S, E);
        }
        SEAM(pb + 12);
        if (EN(13) && IN(pb + 13)) {
            const int ntiles = moe_tables(F, l);
            pg8::Gemm g{WSP(bf16_t, WS_HG), WSP(bf16_t, WS_W2T), XG_ROWS, D, 256};
            pg8::MoeOrder S{F.G, F.bid, 4, ntiles, (const LAS unsigned char*)(F.lds + LDS_TAB + 384), (size_t)1024 * 256 * 2};
            pg8::EpiMoeDown E{WSP(bf16_t, WS_Y2), WSP(float, SM_WROW)};
            pg8::gemm_phase(F.lds, F.tid, g, S, E);
        }
        SEAM(pb + 13);
    }
#if DBG_STOP > 0
    if (EN(14) && IN(N_PHASES - 1)) { const int gt = F.bid * NTHREADS + F.tid, NT = F.G * NTHREADS;
#ifdef DBG_LIN
        { const bf16_t* s1 = WSP(bf16_t, DBG_SRC); const bf16_t* s2 = WSP(bf16_t, DBG_SRC2);
          for (size_t i = gt; i < (size_t)NREAL * D; i += NT) F.out[i] = i < (size_t)DBG_N1 ? bf2f(s1[i]) : (i < (size_t)DBG_N1 + DBG_N2 ? bf2f(s2[i - DBG_N1]) : 0.f); }
#else
        if (DBG_LD > 0) { const bf16_t* src = WSP(bf16_t, DBG_SRC); for (size_t i = gt; i < (size_t)NREAL * D; i += NT) { const size_t r = i >> 10, c = i & 1023; F.out[i] = bf2f(src[r * DBG_LD + (c * DBG_LD) / 1024]); } }
#endif
    }
#else
#ifdef DBG_XBAR
    for (int i = 0; i < DBG_XBAR; ++i) { GRID_BARRIER(); PHASE_FENCE(F); }
#endif
    if (EN(14) && IN(N_PHASES - 1)) phase_final(F);
    if (DBG_TA >= 0) { float* tw = WSP(float, WS_CTL) + 2048; if (F.bid == 0 && F.tid == 0) { tw[0] = (float)MISC[17] * 0.01f; }
        GRID_BARRIER(); PHASE_FENCE(F);
        const float v = WSP(float, WS_CTL)[2048] * (1.0f / 200.0f); const int gt = F.bid * NTHREADS + F.tid, NT = F.G * NTHREADS;
        for (size_t i = gt; i < (size_t)NREAL * D; i += NT) F.out[i] = v; }
#endif
#undef IN
#undef SEAM
}

#if MK_ONE_LAUNCH
#ifndef KM_ONE
#define KM_ONE 0xffffffffu
#endif
constexpr unsigned KMASK[1] = {KM_ONE};
#else
constexpr unsigned KMASK[3] = {0x0C19u, 0xC004u, 0x3262u};
#endif
template <unsigned M> static bool setup_kernel(int& per_cu) {
    if (hipFuncSetAttribute((const void*)hybrid_fwd<M>, hipFuncAttributeMaxDynamicSharedMemorySize, LDS_BYTES) != hipSuccess) return false;
    if (hipOccupancyMaxActiveBlocksPerMultiprocessor(&per_cu, (const void*)hybrid_fwd<M>, NTHREADS, LDS_BYTES) != hipSuccess) per_cu = 0;
    (void)hipGetLastError();
    return true;
}
static int phase_kind(int k) { if (k == 0) return 15; if (k == N_PHASES - 1) return 14; const int j = (k - 1) % PH_PER_LAYER; return (j >= 6 && j <= 8) ? 6 : j; }
extern "C" void kernel_launch(void* const* d_in, const int* in_sizes, int n_in, void* d_out, int out_size, void* d_ws, size_t ws_size, hipStream_t stream) {
    static int grid = 0;
    if (grid == 0) {
        if (n_in != 24 || in_sizes[0] != NREAL * D || out_size != NREAL * D || ws_size < WS_END) {
            fprintf(stderr, "kernel_launch: unexpected problem (n_in %d, in0 %d, out %d, ws %zu < %zu); nothing launched\n", n_in, n_in > 0 ? in_sizes[0] : -1, out_size, ws_size, (size_t)WS_END); grid = -1; return; }
        int dev = 0, cus = 0, per_cu = 0; bool ok = true;
        if (hipGetDevice(&dev) != hipSuccess || hipDeviceGetAttribute(&cus, hipDeviceAttributeMultiprocessorCount, dev) != hipSuccess) { grid = -1; return; }
#if MK_ONE_LAUNCH
        ok = setup_kernel<KMASK[0]>(per_cu);
#else
        ok = setup_kernel<KMASK[0]>(per_cu) && setup_kernel<KMASK[1]>(per_cu) && setup_kernel<KMASK[2]>(per_cu);
#endif
        if (!ok) { fprintf(stderr, "kernel_launch: hipFuncSetAttribute failed\n"); grid = -1; return; }
        if (per_cu < 1) fprintf(stderr, "kernel_launch: occupancy query says %d\n", per_cu);
        grid = cus;
    }
    if (grid < 0) return;
    if (hipMemsetAsync((char*)d_ws + WS_CTL, 0, CTL_BYTES, stream) != hipSuccess) return;
    Params p{};
    for (int i = 0; i < 24; ++i) p.in[i] = (const float*)d_in[i];
    p.out = (float*)d_out; p.ws = (unsigned char*)d_ws;
#if MK_ONE_LAUNCH
    p.ph_lo = 0; p.ph_hi = N_PHASES;
    hipLaunchKernelGGL(hybrid_fwd<KMASK[0]>, dim3(grid), dim3(NTHREADS), LDS_BYTES, stream, p);
#else
    for (int k = 0; k < N_PHASES; ++k) { if (DBG_STOP > 0 && k >= DBG_STOP && k != N_PHASES - 1) continue; p.ph_lo = k; p.ph_hi = k + 1; const unsigned bit = 1u << phase_kind(k);
        if (KMASK[0] & bit) hipLaunchKernelGGL(hybrid_fwd<KMASK[0]>, dim3(grid), dim3(NTHREADS), LDS_BYTES, stream, p);
        else if (KMASK[1] & bit) hipLaunchKernelGGL(hybrid_fwd<KMASK[1]>, dim3(grid), dim3(NTHREADS), LDS_BYTES, stream, p);
        else hipLaunchKernelGGL(hybrid_fwd<KMASK[2]>, dim3(grid), dim3(NTHREADS), LDS_BYTES, stream, p); }
#endif
}
```

```cpp
#include <hip/hip_runtime.h>
#include <cstdio>
#include <cstdint>

#define LAS __attribute__((address_space(3)))
typedef unsigned short bf16_t;
typedef short bf16x8 __attribute__((ext_vector_type(8)));
typedef float f32x4 __attribute__((ext_vector_type(4)));
typedef float f32x2 __attribute__((ext_vector_type(2)));
typedef unsigned u32x4 __attribute__((ext_vector_type(4)));
typedef unsigned u32x2 __attribute__((ext_vector_type(2)));

constexpr int D = 1024, NREAL = 16384, MROWS = 16640, META_ROW0 = 16384 + 48, META_END = 16384 + 64;
constexpr int NSLOT = 257;
constexpr int LDP = 5632;
constexpr int PC_AQ = 0, PC_AF = 512, PC_AI = 1024, PC_AG = 1536, PC_BQKV = 2048, PC_BG = 3584, PC_CQ = 4096, PC_CK = 4352, PC_CV = 4608, PC_CG = 5120;
constexpr int IN_COLS = 8728;
constexpr int NTHREADS = 512, NWAVES = 8;
constexpr int XG_ROWS = 40960;

constexpr size_t MiB = 1ull << 20;
constexpr size_t WS_CTL = 0, CTL_BYTES = 1 * MiB;
constexpr int CW_BAR = 4096, CW_CNT = 1024;
constexpr size_t SM_SW1 = 1 * MiB;
constexpr size_t SM_RWG = SM_SW1 + 2 * 24 * 1024 * 4;
constexpr size_t SM_RWE = SM_RWG + 2 * 4 * 1024 * 4;
constexpr size_t SM_LAB = SM_RWE + 2 * 32 * 1024 * 4;
constexpr size_t SM_GK = SM_LAB + 2 * 2 * 512 * 4;
constexpr size_t SM_BETA = SM_GK + (size_t)MROWS * 16 * 4;
constexpr size_t SM_LOGA = SM_BETA + (size_t)MROWS * 4 * 4;
constexpr size_t SM_TOK = SM_LOGA + (size_t)MROWS * 4 * 4;
constexpr size_t SM_WROW = SM_TOK + (size_t)MROWS * 8 * 4;
constexpr size_t SM_DECA = SM_WROW + (size_t)XG_ROWS * 4;
constexpr size_t SM_DECC = SM_DECA + 1028 * 128 * 4;
constexpr size_t SM_DECB = SM_DECC + 1028 * 64 * 4;
constexpr size_t SM_HALO = SM_DECB + 8192;
constexpr size_t SM_END = SM_HALO + 260 * 3 * 1536 * 2;
static_assert(SM_END <= 8 * MiB, "small region");
constexpr size_t WS_HMETA = 8 * MiB;
constexpr size_t WS_WMIX = 9 * MiB;
constexpr size_t WS_WGATE = 20 * MiB;
constexpr size_t WS_WBT = 26 * MiB;
constexpr size_t WS_WOT = 29 * MiB;
constexpr size_t WS_O = 31 * MiB;
constexpr size_t O_STRIDE = (size_t)MROWS * 512 * 2;
constexpr size_t WS_W1T = 31 * MiB;
constexpr size_t WS_W2T = 63 * MiB;
constexpr size_t WS_U = 80 * MiB;
constexpr size_t WS_P = 113 * MiB;
constexpr size_t WS_GT = 113 * MiB;
constexpr size_t WS_MERGED = 211 * MiB;
constexpr size_t WS_XG = 113 * MiB;
constexpr size_t WS_HG = 193 * MiB;
constexpr size_t WS_Y2 = 213 * MiB;
constexpr size_t WS_SCA = 294 * MiB;
constexpr size_t WS_QKD = 303 * MiB;
constexpr size_t WS_SCC = 312 * MiB;
constexpr size_t WS_K1TB = 321 * MiB;
constexpr size_t WS_END = 338 * MiB;

constexpr int LDS_BYTES = 163840;
constexpr int LDS_MISC = LDS_BYTES - 512;
constexpr int LDS_TAB = LDS_BYTES - 1536;
constexpr int LDS_SCRATCH = LDS_TAB;

typedef __bf16 bf16x2v __attribute__((ext_vector_type(2)));
__device__ __forceinline__ unsigned pk2(float lo, float hi) { const f32x2 v = {lo, hi}; return __builtin_bit_cast(unsigned, __builtin_convertvector(v, bf16x2v)); }
__device__ __forceinline__ bf16_t f2bf(float f) { return (bf16_t)(pk2(f, 0.f) & 0xffffu); }
__device__ __forceinline__ float bf2f(bf16_t b) { return __uint_as_float(((unsigned)b) << 16); }
__device__ __forceinline__ float bflo(unsigned w) { return __uint_as_float(w << 16); }
__device__ __forceinline__ float bfhi(unsigned w) { return __uint_as_float(w & 0xffff0000u); }
__device__ __forceinline__ float sigmoidf_(float x) { return __builtin_amdgcn_rcpf(1.0f + __expf(-x)); }
__device__ __forceinline__ float siluf_(float x) { return x * __builtin_amdgcn_rcpf(1.0f + __expf(-x)); }
__device__ __forceinline__ float logsigf_(float x) { return fminf(x, 0.f) - __logf(1.0f + __expf(-fabsf(x))); }
__device__ __forceinline__ float softplusf_(float x) { return fmaxf(x, 0.f) + log1pf(__expf(-fabsf(x))); }
__device__ __forceinline__ bool row_valid(int r) { return r < NREAL || (r >= META_ROW0 && r < META_END); }
__device__ __forceinline__ float wave_sum(float v) {
#define DPP_ADD(ctrl, rmask) v += __int_as_float(__builtin_amdgcn_update_dpp(0, __float_as_int(v), (ctrl), (rmask), 0xf, false))
    DPP_ADD(0x111, 0xf); DPP_ADD(0x112, 0xf); DPP_ADD(0x114, 0xf); DPP_ADD(0x118, 0xf);
    DPP_ADD(0x142, 0xa); DPP_ADD(0x143, 0xc);
#undef DPP_ADD
    return __int_as_float(__builtin_amdgcn_readlane(__float_as_int(v), 63));
}
#define LDS_WAIT() asm volatile("s_waitcnt lgkmcnt(0)" ::: "memory")

#define XB_TMO      128
#define XB_XCNT(j)  (256  + 64 * (j))
#define XB_XSUB(j)  (1280 + 64 * (j))
#define XB_XGEN(j)  (2304 + 64 * (j))
#define XB_TOP      3328
#define XB_TOPGEN   3392
#define XCD_BAR_WORDS 3456
#define XB_SPIN_CAP (1u << 18)
__device__ __forceinline__ unsigned xb_ld(unsigned* p)              { return __hip_atomic_load(p, __ATOMIC_RELAXED, __HIP_MEMORY_SCOPE_AGENT); }
__device__ __forceinline__ unsigned xb_add(unsigned* p, unsigned v) { return __hip_atomic_fetch_add(p, v, __ATOMIC_RELAXED, __HIP_MEMORY_SCOPE_AGENT); }
__device__ __forceinline__ unsigned xb_xcc_id() { return (unsigned)__builtin_amdgcn_s_getreg((3 << 11) | 20) & 0xFu; }
#define XB_SPIN(cond, bar) do { unsigned _sp = 0; while (cond) { __builtin_amdgcn_s_sleep(1); \
    if ((++_sp & 255u) == 0u) { if (xb_ld(&(bar)[XB_TMO])) break; if (_sp > XB_SPIN_CAP) { atomicAdd(&(bar)[XB_TMO], 1u); break; } } } } while (0)
struct XcdBarrier { unsigned* bar; unsigned x; volatile LAS unsigned* st; };
__device__ __forceinline__ XcdBarrier xcd_barrier_post(unsigned* bar, volatile LAS unsigned* st) {
    XcdBarrier b; b.bar = bar; b.x = xb_xcc_id(); b.st = st;
    if (threadIdx.x == 0) (void)xb_add(&bar[XB_XCNT(b.x)], 1u);
    return b;
}
__device__ __forceinline__ void xcd_barrier_complete(unsigned* bar, unsigned x, unsigned& nloc, unsigned& nx, const unsigned G) {
    unsigned sum, cnt, mine, sp = 0u;
    for (;;) {
        sum = 0u; cnt = 0u; mine = 0u;
#pragma unroll
        for (unsigned j = 0; j < 16; ++j) { const unsigned c = xb_ld(&bar[XB_XCNT(j)]); sum += c; cnt += (c > 0u) ? 1u : 0u; mine = (j == x) ? c : mine; }
        if (sum == G) break;
        __builtin_amdgcn_s_sleep(1);
        if ((++sp & 255u) == 0u) { if (xb_ld(&bar[XB_TMO])) break; if (sp > XB_SPIN_CAP) { atomicAdd(&bar[XB_TMO], 1u); break; } }
    }
    nloc = mine > 0u ? mine : 1u; nx = cnt > 0u ? cnt : 1u;
}
__device__ __attribute__((noinline)) void xcd_barrier(unsigned* bar_, unsigned x_, volatile LAS unsigned* st_, int tid_, unsigned G_) {
    XcdBarrier b; b.bar = bar_; b.x = x_; b.st = st_;
    asm volatile("s_waitcnt vmcnt(0)" ::: "memory");
    __syncthreads();
    if (tid_ == 0) {
        unsigned* bar = b.bar;
        __builtin_amdgcn_s_waitcnt(0);
        unsigned nloc = b.st[0], nx = b.st[1];
        if (nloc == 0u) { xcd_barrier_complete(bar, b.x, nloc, nx, G_); b.st[0] = nloc; b.st[1] = nx; }
        const unsigned old = xb_add(&bar[XB_XSUB(b.x)], 1u);
        const unsigned gen = old / nloc;
        if (old + 1u == (gen + 1u) * nloc) {
            __builtin_amdgcn_fence(__ATOMIC_RELEASE, "agent");
            asm volatile("s_waitcnt vmcnt(0)" ::: "memory");
            const unsigned og = xb_add(&bar[XB_TOP], 1u);
            const unsigned tg = og / nx;
            if (og + 1u == (tg + 1u) * nx) xb_add(&bar[XB_TOPGEN], 1u);
            else XB_SPIN(xb_ld(&bar[XB_TOPGEN]) == tg, bar);
            __builtin_amdgcn_fence(__ATOMIC_ACQUIRE, "agent");
            xb_add(&bar[XB_XGEN(b.x)], 1u);
            asm volatile("s_waitcnt vmcnt(0)" ::: "memory");
        } else {
            XB_SPIN(xb_ld(&bar[XB_XGEN(b.x)]) == gen, bar);
            __builtin_amdgcn_fence(__ATOMIC_ACQUIRE, "agent");
            asm volatile("s_waitcnt vmcnt(0)" ::: "memory");
        }
    }
    __syncthreads();
}
namespace pg8 {
constexpr int BM = 256, BK = 64, HALF = 128, HTB = HALF * BK * 2, STAGE_BYTES = 8 * HTB, NXCD = 8, WGM = 8;
__host__ __device__ __forceinline__ int lds_byte(int r, int c) { const int st = (r >> 4) * 2 + (c >> 5), rr = r & 15, cc = c & 31, ob = rr * 64 + cc * 2; return st * 1024 + (ob ^ (((ob >> 9) & 1) << 5)); }
__host__ __device__ __forceinline__ void stage_rc(int b, int& R, int& C) { const int st = b / 1024, sb = b % 1024, swz = sb ^ (((sb >> 9) & 1) << 5); R = (st >> 1) * 16 + swz / 64; C = (st & 1) * 32 + (swz % 64) / 2; }
__host__ __device__ __forceinline__ int perm32(int rho) { const int n = rho >> 4, i = rho & 15; return 8 * (i >> 2) + 4 * n + (i & 3); }

struct Unit { int pm, pn, ex; };
struct Gemm { const bf16_t* A; const bf16_t* Bt; int M, N, K; };

struct StaticOrder {
    int nM, nN, nwg, G, c;
    __device__ void init(int M, int N, int G_, int c_) { nM = M / BM; nN = N / BM; nwg = nM * nN; G = G_; c = c_; }
    __device__ bool next(int i, Unit& u) const {
        const long L = (long)i * G + c; if (L >= nwg) return false;
        int wgid = (int)L; { const int q = nwg / NXCD, r = nwg % NXCD, xcd = wgid % NXCD, off = wgid / NXCD; wgid = (xcd < r ? xcd * (q + 1) : r * (q + 1) + (xcd - r) * q) + off; }
        const int nig = WGM * nN, gid = wgid / nig, fm = gid * WGM, gsz = (nM - fm) < WGM ? (nM - fm) : WGM;
        u.pm = fm + ((wgid % nig) % gsz); u.pn = (wgid % nig) / gsz; u.ex = 0; return true;
    }
    __device__ __forceinline__ void ptrs(const Gemm& g, const Unit& u, const char*& a, const char*& b) const {
        const size_t tstep = (size_t)BM * g.K * 2; a = (const char*)g.A + (size_t)u.pm * tstep; b = (const char*)g.Bt + (size_t)u.pn * tstep; }
};
struct MoeOrder {
    int G, c, npn, ntiles; const LAS unsigned char* tab; size_t estride;
    __device__ bool next(int i, Unit& u) const {
        const long L = (long)i * G + c; if (L >= (long)ntiles * npn) return false;
        u.pm = (int)(L / npn); u.pn = (int)(L % npn); u.ex = (int)tab[u.pm]; return true;
    }
    __device__ __forceinline__ void ptrs(const Gemm& g, const Unit& u, const char*& a, const char*& b) const {
        const size_t tstep = (size_t)BM * g.K * 2; a = (const char*)g.A + (size_t)u.pm * tstep; b = (const char*)g.Bt + (size_t)u.ex * estride + (size_t)u.pn * tstep; }
};

template <class Epi, class Sched>
__device__ __forceinline__ void gemm_phase(LAS unsigned char* lds, const int tid, const Gemm g, const Sched& S, const Epi& E) {
    const int wid = __builtin_amdgcn_readfirstlane(tid >> 6), lane = tid & 63, wr = wid >> 2, wc = wid & 3, fr = lane & 15, fq = lane >> 4;
    int K = g.K; asm volatile("" : "+s"(K));
    const int nt = K / BK;
    unsigned voffA[2], voffB[2];
#pragma unroll
    for (int i = 0; i < 2; ++i) { int R, C; stage_rc(tid * 16 + i * 8192, R, C); const int Rb = Epi::PERM ? ((R & ~31) + perm32(R & 31)) : R;
        voffA[i] = (unsigned)(R * K + C) * 2u; voffB[i] = (unsigned)(Rb * K + C) * 2u; }
    const size_t kstep = (size_t)(BK * 2);
    const size_t hstep = (size_t)HALF * K * 2;
    const unsigned ldsw = (unsigned)wid * 1024u;
    const int aoff = lds_byte(wr * 64 + fr, fq * 8), boff = lds_byte(wc * 32 + fr, fq * 8);
#define PG8_SA(b, h) (((b) * 2 + (h)) * HTB)
#define PG8_SB(b, h) ((4 + (b) * 2 + (h)) * HTB)
#define PG8_STAGE(bufoff, gbase, voff) do { _Pragma("unroll") for (int _i = 0; _i < 2; ++_i) \
        __builtin_amdgcn_global_load_lds((const unsigned*)((const char*)(gbase) + (voff)[_i]), (LAS unsigned*)(lds + (bufoff) + ldsw + _i * 8192), 16, 0, 0); } while (0)
#define PG8_LDA(dst, b, h) do { _Pragma("unroll") for (int m = 0; m < 4; ++m) _Pragma("unroll") for (int k = 0; k < 2; ++k) dst[m][k] = *(const LAS bf16x8*)(lds + PG8_SA(b, h) + aoff + m * 2048 + k * 1024); } while (0)
#define PG8_LDB(dst, b, h) do { _Pragma("unroll") for (int n = 0; n < 2; ++n) _Pragma("unroll") for (int k = 0; k < 2; ++k) dst[n][k] = *(const LAS bf16x8*)(lds + PG8_SB(b, h) + boff + n * 2048 + k * 1024); } while (0)
#define PG8_MMA(ai, bj, At, Bt) do { __builtin_amdgcn_s_setprio(1); _Pragma("unroll") for (int m = 0; m < 4; ++m) _Pragma("unroll") for (int n = 0; n < 2; ++n) _Pragma("unroll") for (int k = 0; k < 2; ++k) \
        acc[ai][bj][m][n] = __builtin_amdgcn_mfma_f32_16x16x32_bf16(Bt[n][k], At[m][k], acc[ai][bj][m][n], 0, 0, 0); __builtin_amdgcn_s_setprio(0); } while (0)
#define PG8_WAIT_V(n) asm volatile("s_waitcnt vmcnt(" #n ")" ::: "memory")
#define PG8_WAIT_L(n) asm volatile("s_waitcnt lgkmcnt(" #n ")" ::: "memory")
#define PG8_BAR __builtin_amdgcn_s_barrier()
#define PG8_SCHED __builtin_amdgcn_sched_barrier(0)
    Unit cur, nxt; int ui = 0;
    if (!S.next(0, cur)) return;
    f32x4 acc[2][2][4][2];
#pragma unroll
    for (int a = 0; a < 2; ++a)
#pragma unroll
        for (int b = 0; b < 2; ++b)
#pragma unroll
            for (int m = 0; m < 4; ++m)
#pragma unroll
                for (int n = 0; n < 2; ++n) acc[a][b][m][n] = (f32x4){0.f, 0.f, 0.f, 0.f};
    bf16x8 At[4][2], B0[2][2], B1[2][2];
    const char* cA; const char* cB; S.ptrs(g, cur, cA, cB);
    PG8_STAGE(PG8_SB(0, 0), cB, voffB); PG8_STAGE(PG8_SA(0, 0), cA, voffA); PG8_STAGE(PG8_SB(0, 1), cB + hstep, voffB); PG8_STAGE(PG8_SA(0, 1), cA + hstep, voffA);
    if (wr == 1) PG8_BAR;
    PG8_WAIT_V(4); PG8_BAR;
    PG8_STAGE(PG8_SB(1, 0), cB + kstep, voffB); PG8_STAGE(PG8_SA(1, 0), cA + kstep, voffA); PG8_STAGE(PG8_SB(1, 1), cB + hstep + kstep, voffB);
    PG8_WAIT_V(6); PG8_BAR;
    for (;;) {
        const bool has_next = S.next(ui + 1, nxt);
        const char* nA = cA; const char* nB = cB; if (has_next) S.ptrs(g, nxt, nA, nB);
        for (int t = 0; t < nt; t += 2) {
            const bool last = (t == nt - 2);
            const char* a1 = cA + (size_t)(t + 1) * kstep;
            const char* a2 = last ? nA : cA + (size_t)(t + 2) * kstep; const char* b2 = last ? nB : cB + (size_t)(t + 2) * kstep;
            const char* a3 = a2 + kstep; const char* b3 = b2 + kstep;
            PG8_LDB(B0, 0, 0); PG8_SCHED; PG8_LDA(At, 0, 0); PG8_STAGE(PG8_SA(1, 1), a1 + hstep, voffA);
            PG8_WAIT_L(8); PG8_BAR; PG8_WAIT_L(0); PG8_MMA(0, 0, At, B0); PG8_BAR; PG8_SCHED;
            PG8_LDB(B1, 0, 1); PG8_STAGE(PG8_SB(0, 0), b2, voffB);
            PG8_BAR; PG8_WAIT_L(0); PG8_MMA(0, 1, At, B1); PG8_BAR;
            PG8_LDA(At, 0, 1); PG8_STAGE(PG8_SA(0, 0), a2, voffA);
            PG8_BAR; PG8_WAIT_L(0); PG8_MMA(1, 0, At, B0); PG8_BAR; PG8_SCHED;
            PG8_STAGE(PG8_SB(0, 1), b2 + hstep, voffB);
            PG8_WAIT_V(6); PG8_BAR; PG8_MMA(1, 1, At, B1); PG8_BAR;
            PG8_LDB(B0, 1, 0); PG8_SCHED; PG8_LDA(At, 1, 0); PG8_STAGE(PG8_SA(0, 1), a2 + hstep, voffA);
            PG8_WAIT_L(8); PG8_BAR; PG8_WAIT_L(0); PG8_MMA(0, 0, At, B0); PG8_BAR; PG8_SCHED;
            PG8_LDB(B1, 1, 1); PG8_STAGE(PG8_SB(1, 0), b3, voffB);
            PG8_BAR; PG8_WAIT_L(0); PG8_MMA(0, 1, At, B1); PG8_BAR;
            PG8_LDA(At, 1, 1); PG8_STAGE(PG8_SA(1, 0), a3, voffA);
            PG8_BAR; PG8_WAIT_L(0); PG8_MMA(1, 0, At, B0); PG8_BAR; PG8_SCHED;
            PG8_STAGE(PG8_SB(1, 1), b3 + hstep, voffB);
            PG8_WAIT_V(6); PG8_BAR; PG8_MMA(1, 1, At, B1); PG8_BAR;
        }
        E(acc, cur, wr, wc, fr, fq);
        if (!has_next) break;
#pragma unroll
        for (int a = 0; a < 2; ++a)
#pragma unroll
            for (int b = 0; b < 2; ++b)
#pragma unroll
                for (int m = 0; m < 4; ++m)
#pragma unroll
                    for (int n = 0; n < 2; ++n) acc[a][b][m][n] = (f32x4){0.f, 0.f, 0.f, 0.f};
        cur = nxt; cA = nA; cB = nB; ++ui;
    }
    PG8_WAIT_V(0);
    if (wr == 0) PG8_BAR;
    PG8_BAR;
#undef PG8_SA
#undef PG8_SB
#undef PG8_STAGE
#undef PG8_LDA
#undef PG8_LDB
#undef PG8_MMA
#undef PG8_WAIT_V
#undef PG8_WAIT_L
#undef PG8_BAR
#undef PG8_SCHED
}

#define EPI_PERM_LOOP(...) \
    _Pragma("unroll") for (int ai = 0; ai < 2; ++ai) _Pragma("unroll") for (int m = 0; m < 4; ++m) { const int row = u.pm * BM + ai * HALF + wr * 64 + m * 16 + fr; \
        _Pragma("unroll") for (int bj = 0; bj < 2; ++bj) { const int col0 = u.pn * BM + bj * HALF + wc * 32 + 8 * fq; f32x4 v0 = acc[ai][bj][m][0], v1 = acc[ai][bj][m][1]; __VA_ARGS__ } if (EPI_PIN) __builtin_amdgcn_sched_barrier(0); }

struct EpiInProj {
    static constexpr bool PERM = true, EPI_PIN = true;
    bf16_t* P; bf16_t* halo;
    __device__ __forceinline__ void operator()(const f32x4 (&acc)[2][2][4][2], const Unit& u, int wr, int wc, int fr, int fq) const {
        const bool is_qkv = u.pn >= 8 && u.pn < 14;
        EPI_PERM_LOOP({
            u32x4 w; w.x = pk2(v0[0], v0[1]); w.y = pk2(v0[2], v0[3]); w.z = pk2(v1[0], v1[1]); w.w = pk2(v1[2], v1[3]);
            *(u32x4*)(P + (size_t)row * LDP + col0) = w;
            if (is_qkv && (row & 63) >= 61) *(u32x4*)(halo + ((size_t)(row >> 6) * 3 + ((row & 63) - 61)) * 1536 + (col0 - PC_BQKV)) = w;
        })
    }
};
__device__ __forceinline__ float lfg(float a, float lb1, float x) { const float b = lb1 + logsigf_(x), mx = fmaxf(a, b); return mx + __logf(__expf(a - mx) + __expf(b - mx)); }
struct EpiSigmoid {
    static constexpr bool PERM = true, EPI_PIN = true;
    bf16_t* O; int ldc;
    __device__ __forceinline__ void operator()(const f32x4 (&acc)[2][2][4][2], const Unit& u, int wr, int wc, int fr, int fq) const {
        EPI_PERM_LOOP({
            u32x4 w; w.x = pk2(sigmoidf_(v0[0]), sigmoidf_(v0[1])); w.y = pk2(sigmoidf_(v0[2]), sigmoidf_(v0[3])); w.z = pk2(sigmoidf_(v1[0]), sigmoidf_(v1[1])); w.w = pk2(sigmoidf_(v1[2]), sigmoidf_(v1[3]));
            *(u32x4*)(O + (size_t)row * ldc + col0) = w;
        })
    }
};
struct EpiBranch {
    static constexpr bool PERM = true, EPI_PIN = false;
    bf16_t* merged; const bf16_t* gt; int n;
    __device__ __forceinline__ void operator()(const f32x4 (&acc)[2][2][4][2], const Unit& u, int wr, int wc, int fr, int fq) const {
        EPI_PERM_LOOP({
            const u32x4 gw = *(const u32x4*)(gt + (size_t)row * 3072 + n * 1024 + col0);
            float x[8] = {v0[0] * bflo(gw.x), v0[1] * bfhi(gw.x), v0[2] * bflo(gw.y), v0[3] * bfhi(gw.y), v1[0] * bflo(gw.z), v1[1] * bfhi(gw.z), v1[2] * bflo(gw.w), v1[3] * bfhi(gw.w)};
            bf16_t* mp = merged + (size_t)row * 1024 + col0;
            if (n != 0) { const u32x4 o = *(const u32x4*)mp; x[0] += bflo(o.x); x[1] += bfhi(o.x); x[2] += bflo(o.y); x[3] += bfhi(o.y); x[4] += bflo(o.z); x[5] += bfhi(o.z); x[6] += bflo(o.w); x[7] += bfhi(o.w); }
            u32x4 w; w.x = pk2(x[0], x[1]); w.y = pk2(x[2], x[3]); w.z = pk2(x[4], x[5]); w.w = pk2(x[6], x[7]);
            *(u32x4*)mp = w;
        })
    }
};
struct EpiResidual {
    static constexpr bool PERM = false;
    float* hreal; float* hmeta;
    __device__ __forceinline__ void operator()(const f32x4 (&acc)[2][2][4][2], const Unit& u, int wr, int wc, int fr, int fq) const {
#pragma unroll
        for (int ai = 0; ai < 2; ++ai)
#pragma unroll
            for (int m = 0; m < 4; ++m) { const int row = u.pm * BM + ai * HALF + wr * 64 + m * 16 + fr;
                float* rowp = (row < NREAL ? hreal + (size_t)row * D : hmeta + (size_t)(row - NREAL) * D) + u.pn * BM + wc * 32 + 4 * fq;
#pragma unroll
                for (int bj = 0; bj < 2; ++bj)
#pragma unroll
                    for (int n = 0; n < 2; ++n) { f32x4* p = (f32x4*)(rowp + bj * HALF + n * 16); *p = *p + acc[ai][bj][m][n]; } }
    }
};
struct EpiMoeUp {
    static constexpr bool PERM = true, EPI_PIN = true;
    bf16_t* H;
    __device__ __forceinline__ void operator()(const f32x4 (&acc)[2][2][4][2], const Unit& u, int wr, int wc, int fr, int fq) const {
        EPI_PERM_LOOP({
            const int hc = col0 >> 1;
            u32x2 w; w.x = pk2(siluf_(v0[0]) * v1[0], siluf_(v0[1]) * v1[1]); w.y = pk2(siluf_(v0[2]) * v1[2], siluf_(v0[3]) * v1[3]);
            *(u32x2*)(H + (size_t)row * 256 + hc) = w;
        })
    }
};
struct EpiMoeDown {
    static constexpr bool PERM = true, EPI_PIN = false;
    bf16_t* Y; const float* wrow;
    __device__ __forceinline__ void operator()(const f32x4 (&acc)[2][2][4][2], const Unit& u, int wr, int wc, int fr, int fq) const {
        EPI_PERM_LOOP({
            const float s = wrow[row];
            u32x4 w; w.x = pk2(v0[0] * s, v0[1] * s); w.y = pk2(v0[2] * s, v0[3] * s); w.z = pk2(v1[0] * s, v1[1] * s); w.w = pk2(v1[2] * s, v1[3] * s);
            *(u32x4*)(Y + (size_t)row * 1024 + col0) = w;
        })
    }
};
}
#define GAS __attribute__((address_space(1)))
struct Params { const float* in[24]; float* out; unsigned char* ws; int ph_lo, ph_hi; };
struct Frame {
    LAS unsigned char* lds; int tid, lane, wave, G, bid;
    __attribute__((address_space(1))) float* out; __attribute__((address_space(1))) unsigned char* ws; const float* const __attribute__((address_space(4)))* inp; int dry;
};
#define PHASE_FENCE(F) do { asm volatile("" : "+s"((F).ws), "+s"((F).out), "+s"((F).inp), "+v"((F).tid), "+s"((F).bid), "+s"((F).G)); \
    (F).lane = (F).tid & 63; (F).wave = __builtin_amdgcn_readfirstlane((F).tid >> 6); } while (0)
__device__ __forceinline__ const float* inp_ptr(const float* const __attribute__((address_space(4)))* inp, int i) { GAS const float* q = (GAS const float*)inp[i]; asm volatile("" : "+s"(q)); return (const float*)q; }
#define INP(i) inp_ptr(F.inp, (i))
#define WSP(T, off) ((T*)(GAS T*)(F.ws + (off)))
enum { I_X = 0, I_META, I_NORM_MIX, I_W_IN, I_LB, I_HGRN_NORM, I_GDN_CONV, I_GDN_ALOG, I_GDN_DT, I_GDN_NORM, I_GLA_W2, I_GLA_B, I_GLA_NORM, I_W_BRANCH, I_W_OUT, I_NORM_FFN,
       I_RG_W, I_RG_B, I_RE_W, I_RE_B, I_EW_GATE, I_EW_UP, I_EW_DOWN, I_NORM_FINAL };

__device__ __forceinline__ void transpose_item(const float* W, int ldw, int K, int nblk, bf16_t* WT, int row_off, int rowmode, LAS float* scr, int item, int lane) {
    const int kb = item / nblk, nb = item % nblk, k0 = 64 * kb, n0 = 32 * nb;
#pragma unroll 8
    for (int i = 0; i < 32; ++i) { const int kk = 2 * i + (lane >> 5); scr[kk * 33 + (lane & 31)] = W[(size_t)(k0 + kk) * ldw + n0 + (lane & 31)]; }
    LDS_WAIT(); asm volatile("" ::: "memory");
    const int c = lane & 7;
#pragma unroll
    for (int j = 0; j < 4; ++j) { const int n = (lane >> 3) + 8 * j; const LAS float* s = scr + (8 * c) * 33 + n;
        u32x4 o; o.x = pk2(s[0 * 33], s[1 * 33]); o.y = pk2(s[2 * 33], s[3 * 33]); o.z = pk2(s[4 * 33], s[5 * 33]); o.w = pk2(s[6 * 33], s[7 * 33]);
        const int nn = n0 + n; const int wrow = rowmode == 0 ? row_off + nn : row_off + 8 * (nn >> 2) + (nn & 3) + (rowmode == 2 ? 4 : 0);
        *(u32x4*)(WT + (size_t)wrow * K + k0 + 8 * c) = o; }
    LDS_WAIT(); asm volatile("" ::: "memory");
}

__device__ __forceinline__ void phase_pre(Frame& F) {
    const int gt = F.bid * NTHREADS + F.tid, NT = F.G * NTHREADS;
    float* sw1 = WSP(float, SM_SW1); float* rwg = WSP(float, SM_RWG); float* rwe = WSP(float, SM_RWE); float* lab = WSP(float, SM_LAB);
    for (int i = gt; i < 2 * 24 * 1024; i += NT) { const int l = i / (24 * 1024), c = (i / 1024) % 24, k = i % 1024;
        const int col = c < 16 ? 5128 + c : (c < 20 ? 3584 + (c - 16) : 3588 + (c - 20));
        sw1[i] = INP(I_W_IN)[((size_t)l * 1024 + k) * IN_COLS + col]; }
    for (int i = gt; i < 2 * 4 * 1024; i += NT) { const int l = i / (4 * 1024), c = (i / 1024) % 4, k = i % 1024; rwg[i] = INP(I_RG_W)[((size_t)l * 1024 + k) * 4 + c]; }
    for (int i = gt; i < 2 * 32 * 1024; i += NT) { const int l = i / (32 * 1024), c = (i / 1024) % 32, k = i % 1024; rwe[i] = INP(I_RE_W)[((size_t)l * 1024 + k) * 32 + c]; }
    for (int i = gt; i < 2 * 512; i += NT) { const int l = i / 512, c = i % 512; const float l0 = INP(I_LB)[c], l1 = INP(I_LB)[512 + c];
        const float p1 = 1.0f / (1.0f + expf(l0 - l1)); const float lb = l == 0 ? 0.f : p1;
        lab[l * 1024 + c] = logf(fmaxf(lb, 1e-30f)); lab[l * 1024 + 512 + c] = log1pf(-lb); }
}

__device__ __forceinline__ void convert_layer_weights(Frame& F, int l) {
    LAS float* scr = (LAS float*)(F.lds + F.wave * 16384);
    const int gw = F.bid * NWAVES + F.wave, NGW = F.G * NWAVES;
    const float* win = INP(I_W_IN) + (size_t)l * 1024 * IN_COLS;
    constexpr int I_MIX = 16 * 176, I_GATE = 16 * 96, I_BR = 8 * 32, I_OUT = 16 * 32, NITEMS = I_MIX + I_GATE + 3 * I_BR + I_OUT;
    for (int it = gw; it < NITEMS; it += NGW) {
        int r = it;
        if (r < I_MIX) { const int nb = r % 176, n0 = 32 * nb; const int shift = n0 < 3584 ? 0 : (n0 < 5120 ? 8 : 24);
            transpose_item(win + shift, IN_COLS, 1024, 176, WSP(bf16_t, WS_WMIX), 0, 0, scr, r, F.lane); continue; } r -= I_MIX;
        if (r < I_GATE) { transpose_item(win + 5656, IN_COLS, 1024, 96, WSP(bf16_t, WS_WGATE), 0, 0, scr, r, F.lane); continue; } r -= I_GATE;
        if (r < 3 * I_BR) { const int n = r / I_BR; transpose_item(INP(I_W_BRANCH) + ((size_t)l * 3 + n) * 512 * 1024, 1024, 512, 32, WSP(bf16_t, WS_WBT) + (size_t)n * 1024 * 512, 0, 0, scr, r % I_BR, F.lane); continue; } r -= 3 * I_BR;
        transpose_item(INP(I_W_OUT) + (size_t)l * 1024 * 1024, 1024, 1024, 32, WSP(bf16_t, WS_WOT), 0, 0, scr, r, F.lane);
    }
}
__device__ __forceinline__ void convert_expert_weights(Frame& F, int l) {
    LAS float* scr = (LAS float*)(F.lds + F.wave * 16384);
    const int gw = F.bid * NWAVES + F.wave, NGW = F.G * NWAVES;
    constexpr int I_G = 16 * 8, I_D = 4 * 32, PER = 2 * I_G + I_D;
    for (int it = gw; it < 32 * PER; it += NGW) {
        const int e = it / PER; int r = it % PER;
        bf16_t* w1t = WSP(bf16_t, WS_W1T) + (size_t)e * 512 * 1024; bf16_t* w2t = WSP(bf16_t, WS_W2T) + (size_t)e * 1024 * 256;
        if (r < I_G) { transpose_item(INP(I_EW_GATE) + ((size_t)l * 32 + e) * 1024 * 256, 256, 1024, 8, w1t, 0, 1, scr, r, F.lane); continue; } r -= I_G;
        if (r < I_G) { transpose_item(INP(I_EW_UP) + ((size_t)l * 32 + e) * 1024 * 256, 256, 1024, 8, w1t, 0, 2, scr, r, F.lane); continue; } r -= I_G;
        transpose_item(INP(I_EW_DOWN) + ((size_t)l * 32 + e) * 256 * 1024, 1024, 256, 32, w2t, 0, 0, scr, r, F.lane);
    }
}

#define OUTP ((float*)F.out)
__device__ __forceinline__ float* hrow(Frame& F, int r) { return r < NREAL ? OUTP + (size_t)r * D : WSP(float, WS_HMETA) + (size_t)(r - NREAL) * D; }

__device__ __forceinline__ void load_row16(const float* p, int lane, float (&x)[16]) {
#pragma unroll
    for (int j = 0; j < 4; ++j) { const f32x4 v = *((const f32x4*)p + lane + 64 * j); x[4 * j] = v[0]; x[4 * j + 1] = v[1]; x[4 * j + 2] = v[2]; x[4 * j + 3] = v[3]; }
}
__device__ __forceinline__ void add_bf16_row16(const bf16_t* p, int lane, float (&x)[16]) {
#pragma unroll
    for (int j = 0; j < 4; ++j) { const u32x2 w = *((const u32x2*)p + lane + 64 * j); x[4 * j] += bflo(w.x); x[4 * j + 1] += bfhi(w.x); x[4 * j + 2] += bflo(w.y); x[4 * j + 3] += bfhi(w.y); }
}
__device__ __forceinline__ void store_row16(float* p, int lane, const float (&x)[16]) {
#pragma unroll
    for (int j = 0; j < 4; ++j) *((f32x4*)p + lane + 64 * j) = (f32x4){x[4 * j], x[4 * j + 1], x[4 * j + 2], x[4 * j + 3]};
}
__device__ __forceinline__ void store_bf16_row16(bf16_t* p, int lane, const float (&x)[16]) {
#pragma unroll
    for (int j = 0; j < 4; ++j) { u32x2 w; w.x = pk2(x[4 * j], x[4 * j + 1]); w.y = pk2(x[4 * j + 2], x[4 * j + 3]); *((u32x2*)p + lane + 64 * j) = w; }
}
__device__ __forceinline__ void fetch_h_row(Frame& F, int l, int r, float (&x)[16]) {
    if (l == 0) {
        const float* src = r < NREAL ? INP(I_X) + (size_t)r * D : INP(I_META) + (size_t)(r - META_ROW0) * D;
        load_row16(src, F.lane, x);
    } else {
        load_row16(hrow(F, r), F.lane, x);
        const unsigned* tok = WSP(unsigned, SM_TOK) + (size_t)r * 8;
        const unsigned g0 = tok[6], g1 = tok[7];
        add_bf16_row16(WSP(bf16_t, WS_Y2) + (size_t)g0 * 1024, F.lane, x);
        add_bf16_row16(WSP(bf16_t, WS_Y2) + (size_t)g1 * 1024, F.lane, x);
    }
}

__device__ __forceinline__ void phase_norm1(Frame& F, int l) {
    convert_layer_weights(F, l);
    __syncthreads();
    LAS float* sw = (LAS float*)F.lds;
    { const float* src = WSP(float, SM_SW1) + (size_t)l * 24 * 1024; for (int i = F.tid; i < 24 * 1024 / 4; i += NTHREADS) ((LAS f32x4*)sw)[i] = ((const f32x4*)src)[i]; }
    __syncthreads();
    const int gw = F.bid * NWAVES + F.wave, NGW = F.G * NWAVES, lane = F.lane;
    const float* nw = INP(I_NORM_MIX) + (size_t)l * D;
    float wv[16]; load_row16(nw, lane, wv);
    bf16_t* U = WSP(bf16_t, WS_U);
    const float alog_l = (lane >= 20 && lane < 24) ? INP(I_GDN_ALOG)[l * 4 + (lane - 20)] : 0.f, dt_l = (lane >= 20 && lane < 24) ? INP(I_GDN_DT)[l * 4 + (lane - 20)] : 0.f;
    const float nega_l = -expf(alog_l);
    for (int g = gw; g < MROWS / 4; g += NGW) {
        const int r0 = 4 * g;
        if (!row_valid(r0)) {
            float z[16];
#pragma unroll
            for (int j = 0; j < 16; ++j) z[j] = 0.f;
#pragma unroll
            for (int i = 0; i < 4; ++i) { store_bf16_row16(U + (size_t)(r0 + i) * D, lane, z); if (l == 0) store_row16(hrow(F, r0 + i), lane, z);
                if (lane < 16) WSP(float, SM_GK)[(size_t)(r0 + i) * 16 + lane] = 0.f;
                else if (lane < 20) WSP(float, SM_BETA)[(size_t)(r0 + i) * 4 + (lane - 16)] = 0.f;
                else if (lane < 24) WSP(float, SM_LOGA)[(size_t)(r0 + i) * 4 + (lane - 20)] = 0.f; }
            continue;
        }
        float x[4][16];
#pragma unroll
        for (int i = 0; i < 4; ++i) {
            fetch_h_row(F, l, r0 + i, x[i]);
            store_row16(hrow(F, r0 + i), lane, x[i]);
            float ss = 0.f;
#pragma unroll
            for (int j = 0; j < 16; ++j) ss += x[i][j] * x[i][j];
            const float rstd = rsqrtf(wave_sum(ss) * (1.0f / D) + 1e-6f);
#pragma unroll
            for (int j = 0; j < 16; ++j) x[i][j] = x[i][j] * rstd * wv[j];
            store_bf16_row16(U + (size_t)(r0 + i) * D, lane, x[i]);
        }
        float ov[4] = {0.f, 0.f, 0.f, 0.f};
#pragma unroll 2
        for (int c = 0; c < 24; ++c) {
            float a0 = 0.f, a1 = 0.f, a2 = 0.f, a3 = 0.f;
#pragma unroll
            for (int j = 0; j < 4; ++j) { const f32x4 w = *((const LAS f32x4*)(sw + c * 1024) + lane + 64 * j);
#pragma unroll
                for (int e = 0; e < 4; ++e) { a0 += x[0][4 * j + e] * w[e]; a1 += x[1][4 * j + e] * w[e]; a2 += x[2][4 * j + e] * w[e]; a3 += x[3][4 * j + e] * w[e]; } }
            a0 = wave_sum(a0); a1 = wave_sum(a1); a2 = wave_sum(a2); a3 = wave_sum(a3);
            if (lane == c) { ov[0] = a0; ov[1] = a1; ov[2] = a2; ov[3] = a3; }
        }
        float* GK = WSP(float, SM_GK); float* BETA = WSP(float, SM_BETA); float* LOGA = WSP(float, SM_LOGA);
#pragma unroll
        for (int i = 0; i < 4; ++i) {
            const float v = ov[i]; const int r = r0 + i;
            if (lane < 16) GK[(size_t)r * 16 + lane] = v;
            else if (lane < 20) BETA[(size_t)r * 4 + (lane - 16)] = sigmoidf_(v);
            else if (lane < 24) { const int h = lane - 20; LOGA[(size_t)r * 4 + h] = nega_l * softplusf_(v + dt_l); }
        }
    }
}

__device__ __forceinline__ bf16x8 mk8(u32x4 w) { return __builtin_bit_cast(bf16x8, w); }
__device__ __forceinline__ bf16x8 mk8(u32x2 lo, u32x2 hi) { u32x4 w; w.x = lo.x; w.y = lo.y; w.z = hi.x; w.w = hi.y; return __builtin_bit_cast(bf16x8, w); }
__device__ __forceinline__ bf16x8 pack_acc2(const f32x4& a, const f32x4& b) { u32x4 w; w.x = pk2(a[0], a[1]); w.y = pk2(a[2], a[3]); w.z = pk2(b[0], b[1]); w.w = pk2(b[2], b[3]); return __builtin_bit_cast(bf16x8, w); }
#define MFMA16(a, b, c) __builtin_amdgcn_mfma_f32_16x16x32_bf16((a), (b), (c), 0, 0, 0)

__device__ __forceinline__ int permpos(int k) { const int kk = k & 31; return (k & ~31) + ((kk & 16) ? 8 * ((kk - 16) >> 2) + 4 + (kk & 3) : 8 * (kk >> 2) + (kk & 3)); }
__device__ __forceinline__ float ldbf(GAS const bf16_t* p) { return bf2f(*p); }
#define ROWB(P, row, col) ((GAS const char*)(P) + ((size_t)(row) * LDP + (col)) * 2)
__device__ __forceinline__ float ldrow(GAS const char* rb, unsigned voff) { return bf2f(*(GAS const bf16_t*)(rb + voff)); }
__device__ __forceinline__ unsigned ldrow_u(GAS const char* rb, unsigned voff) { return (unsigned)*(GAS const bf16_t*)(rb + voff); }
__device__ __forceinline__ void strow(GAS const char* rb, unsigned voff, bf16_t v) { *(GAS bf16_t*)(rb + voff) = v; }

template <int DK, bool IS_A>
__device__ __forceinline__ void prep_gla(Frame& F, int l, int ug) {
    constexpr int QP = DK + 8, SUB = 2 * 64 * QP * 2 + 1024;
    int tid = F.tid; asm volatile("" : "+v"(tid));
    const int sg = __builtin_amdgcn_readfirstlane(tid >> 8), lt = tid & 255, c = lt & 127, hf = __builtin_amdgcn_readfirstlane(lt >> 7);
    const int unit = 2 * ug + sg, slot = unit >> 2, h = unit & 3, row0 = slot * 64, r0 = row0 + 32 * hf;
    const int qcol = IS_A ? PC_AQ + h * 128 : PC_CQ + h * 64, kcol = IS_A ? PC_AF + h * 128 : PC_CK + h * 64, vcol = IS_A ? PC_AI + h * 128 : PC_CV + h * 128;
    bf16_t* P = WSP(bf16_t, WS_P);
    LAS bf16_t* qt = (LAS bf16_t*)(F.lds + sg * SUB);
    LAS bf16_t* kt = qt + 64 * QP;
    LAS float* tot = (LAS float*)(kt + 64 * QP);
    const bool act = c < DK;
    float b[32];
    const unsigned vo = (unsigned)c * 2u, vop = (unsigned)permpos(c) * 2u;
    if (act) {
        float run = 0.f;
        if (IS_A) { const float* lab = WSP(float, SM_LAB) + l * 1024 + h * 128 + c; const float la = lab[0], lb = lab[512];
#pragma unroll
            for (int t = 0; t < 32; ++t) { run += pg8::lfg(la, lb, ldrow(ROWB(P, r0 + t, kcol), vo)); b[t] = run; }
        } else { float w2c[16]; const float* w2 = INP(I_GLA_W2) + (size_t)l * 16 * 256 + h * 64 + c; const float bias = INP(I_GLA_B)[l * 256 + h * 64 + c];
#pragma unroll
            for (int j = 0; j < 16; ++j) w2c[j] = w2[j * 256];
            const float* gk = WSP(float, SM_GK) + (size_t)r0 * 16;
#pragma unroll
            for (int t = 0; t < 32; ++t) { float s = bias;
#pragma unroll
                for (int j = 0; j < 16; ++j) s += gk[t * 16 + j] * w2c[j];
                run += logsigf_(s) * (1.0f / 16.0f); b[t] = run; }
        }
        tot[hf * 128 + c] = run;
    }
    __syncthreads();
    unsigned q1p[16], k1p[16];
    if (act) {
        const float bm = tot[c], bl = bm + tot[128 + c], boff = hf ? bm : 0.f;
        if (hf == 0 && !F.dry) (IS_A ? WSP(float, SM_DECA) + (size_t)unit * 128 : WSP(float, SM_DECC) + (size_t)unit * 64)[c] = __expf(bl);
#pragma unroll
        for (int t2 = 0; t2 < 16; ++t2) { float q1v[2], k1v[2];
#pragma unroll
            for (int u = 0; u < 2; ++u) { const int t = 2 * t2 + u; const float bt = b[t] + boff;
                const float qr = ldrow(ROWB(P, r0 + t, qcol), vo), q = IS_A ? siluf_(qr) * 0.08838834764831845f : qr * 0.125f;
                float k;
                if (IS_A) { const float lf = t == 0 ? b[0] : b[t] - b[t - 1]; k = row_valid(r0 + t) ? 1.0f - __expf(lf) : 0.f; } else k = ldrow(ROWB(P, r0 + t, kcol), vo);
                q1v[u] = q * __expf(bt); k1v[u] = k * __expf(bl - bt);
                qt[(32 * hf + t) * QP + c] = f2bf(q * __expf(fminf(bt - bm, 80.f))); kt[(32 * hf + t) * QP + c] = f2bf(k * __expf(fminf(bm - bt, 80.f))); }
            q1p[t2] = pk2(q1v[0], q1v[1]); k1p[t2] = pk2(k1v[0], k1v[1]); }
    }
    __syncthreads();
    if (act) {
        if (!F.dry) {
#pragma unroll
        for (int t2 = 0; t2 < 16; ++t2) { strow(ROWB(P, r0 + 2 * t2, qcol), vop, (bf16_t)(q1p[t2] & 0xffffu)); strow(ROWB(P, r0 + 2 * t2 + 1, qcol), vop, (bf16_t)(q1p[t2] >> 16)); } }
        bf16_t* kd = (IS_A ? P + (size_t)(row0 + (c >> 1)) * LDP + kcol + (c & 1) * 64 : P + (size_t)(row0 + c) * LDP + kcol) + 32 * hf;
#pragma unroll
        for (int o = 0; o < 4; ++o) if (!F.dry) *(u32x4*)(kd + 8 * o) = (u32x4){k1p[4 * o], k1p[4 * o + 1], k1p[4 * o + 2], k1p[4 * o + 3]};
    }
    { const int ws = (tid >> 6) & 3, lane = tid & 63, fr = lane & 15, fq = lane >> 4;
        bf16_t* sc = (IS_A ? WSP(bf16_t, WS_SCA) : WSP(bf16_t, WS_SCC)) + (size_t)unit * 4096;
#pragma unroll
        for (int jt = 0; jt < 4; ++jt) { const int mt = ws, nt = jt; f32x4 acc = {0.f, 0.f, 0.f, 0.f};
            if (nt <= mt) {
#pragma unroll
                for (int ks = 0; ks < DK / 32; ++ks) { const bf16x8 a = *(const LAS bf16x8*)(qt + (16 * mt + fr) * QP + 32 * ks + 8 * fq), bb = *(const LAS bf16x8*)(kt + (16 * nt + fr) * QP + 32 * ks + 8 * fq); acc = MFMA16(a, bb, acc); } }
#pragma unroll
            for (int r = 0; r < 4; ++r) { const int t = 16 * mt + 4 * fq + r, s = 16 * nt + fr; if (!F.dry) sc[t * 64 + s] = (s <= t) ? f2bf(acc[r]) : (bf16_t)0; } }
    }
    { unsigned vp[16];
#pragma unroll
        for (int t2 = 0; t2 < 16; ++t2) { vp[t2] = ldrow_u(ROWB(P, r0 + 2 * t2, vcol), vo) | (ldrow_u(ROWB(P, r0 + 2 * t2 + 1, vcol), vo) << 16); }
        __syncthreads();
        bf16_t* vd = P + (size_t)(row0 + (c >> 1)) * LDP + vcol + (c & 1) * 64 + 32 * hf;
#pragma unroll
        for (int o = 0; o < 4; ++o) if (!F.dry) *(u32x4*)(vd + 8 * o) = (u32x4){vp[4 * o], vp[4 * o + 1], vp[4 * o + 2], vp[4 * o + 3]}; }
    __syncthreads();
}

__device__ __forceinline__ void prep_gdn(Frame& F, int l, int ug) {
    constexpr int NP = 136, SUB = 2 * 64 * NP * 2 + 64 * 68 * 4 + 1024 + 2304;
    int tid = F.tid; asm volatile("" : "+v"(tid));
    const int lane = tid & 63, sg = __builtin_amdgcn_readfirstlane(tid >> 8), lt = tid & 255, unit = 2 * ug + sg, slot = unit >> 2, h = unit & 3, row0 = slot * 64;
    bf16_t* P = WSP(bf16_t, WS_P);
    LAS bf16_t* qs = (LAS bf16_t*)(F.lds + sg * SUB);
    LAS bf16_t* ks = qs + 64 * NP;
    LAS float* AT = (LAS float*)(F.lds + sg * SUB + 2 * 64 * NP * 2);
    LAS float* gs = AT + 64 * 68;
    if (lt < 64) { const int valid_u = 1; (void)valid_u; float g = WSP(float, SM_LOGA)[(size_t)(row0 + lt) * 4 + h];
#pragma unroll
        for (int o = 1; o < 64; o <<= 1) { const float t = __shfl_up(g, o); if (lane >= o) g += t; }
        gs[lt] = g; gs[64 + lt] = WSP(float, SM_BETA)[(size_t)(row0 + lt) * 4 + h];
        if (lt == 63 && !F.dry) WSP(float, SM_DECB)[unit] = __expf(g); }
    const int hslot = slot == 256 ? -1 : ((slot & 63) == 0 ? 256 : slot - 1);
    LAS bf16_t* rvs = (LAS bf16_t*)AT;
    LAS bf16_t* hl = (LAS bf16_t*)(gs + 256);
    for (int idx = lt; idx < 64 * 48; idx += 256) { const int row = idx / 48, pc = idx % 48, comp = pc >> 4, c8 = (pc & 15) * 8;
        const u32x4 v = *(const u32x4*)(P + (size_t)(row0 + row) * LDP + PC_BQKV + comp * 512 + h * 128 + c8);
        *(LAS u32x4*)((comp == 0 ? qs : (comp == 1 ? ks : rvs)) + row * NP + c8) = v; }
    if (lt < 144) { const int rr = lt / 48, pc = lt % 48, comp = pc >> 4, c8 = (pc & 15) * 8; u32x4 v = {0u, 0u, 0u, 0u};
        if (hslot >= 0) v = *(const u32x4*)(WSP(bf16_t, SM_HALO) + ((size_t)hslot * 3 + rr) * 1536 + comp * 512 + h * 128 + c8);
        *(LAS u32x4*)(hl + rr * 384 + comp * 128 + c8) = v; }
    __syncthreads();
    float col[64];
    {
        const int c = lt & 127;
#pragma unroll
        for (int pass = 0; pass < 2; ++pass) {
            if (pass == 1 && lt >= 128) break;
            const int comp = lt >= 128 ? 1 : (pass == 0 ? 0 : 2), ch = comp * 512 + h * 128 + c;
            const float w0 = INP(I_GDN_CONV)[((size_t)l * 4 + 0) * 1536 + ch], w1 = INP(I_GDN_CONV)[((size_t)l * 4 + 1) * 1536 + ch], w2 = INP(I_GDN_CONV)[((size_t)l * 4 + 2) * 1536 + ch], w3 = INP(I_GDN_CONV)[((size_t)l * 4 + 3) * 1536 + ch];
            LAS bf16_t* src = (comp == 0 ? qs : (comp == 1 ? ks : rvs)) + c;
            float x0 = bf2f(hl[comp * 128 + c]), x1 = bf2f(hl[384 + comp * 128 + c]), x2 = bf2f(hl[768 + comp * 128 + c]);
#pragma unroll
            for (int t = 0; t < 64; ++t) { const float x3 = bf2f(src[t * NP]); const float y = siluf_(w0 * x0 + w1 * x1 + w2 * x2 + w3 * x3); x0 = x1; x1 = x2; x2 = x3;
                if (comp == 0) src[t * NP] = f2bf(y); else { col[t] = y; if (comp == 1) src[t * NP] = f2bf(y); } }
        }
    }
    __syncthreads();
    const int wv = (tid >> 6) & 3, fr = lane & 15, fq = lane >> 4;
#pragma unroll
    for (int jt = 0; jt < 2; ++jt) { const int which = jt, mt = wv; const LAS bf16_t* ap = which ? qs : ks; f32x4 a4 = {0.f, 0.f, 0.f, 0.f};
#pragma unroll
        for (int k4 = 0; k4 < 4; ++k4) { const bf16x8 a = *(const LAS bf16x8*)(ap + (16 * mt + fr) * NP + 32 * k4 + 8 * fq); a4 = MFMA16(a, a, a4); }
#pragma unroll
        for (int r = 0; r < 4; ++r) if (4 * fq + r == fr) { if (which == 0) gs[128 + 16 * mt + fr] = rsqrtf(a4[r] + 1e-6f); else gs[192 + 16 * mt + fr] = rsqrtf(a4[r] + 1e-6f) * 0.08838834764831845f; } }
    __syncthreads();
    { bf16_t* qkd = WSP(bf16_t, WS_QKD) + (size_t)unit * 4096;
#pragma unroll
        for (int jt = 0; jt < 8; ++jt) { const int tile = wv * 8 + jt, which = tile >> 4, mt = (tile >> 2) & 3, nt = tile & 3;
            const LAS bf16_t* ap = which ? qs : ks; f32x4 a4 = {0.f, 0.f, 0.f, 0.f};
            if (nt <= mt) {
#pragma unroll
                for (int k4 = 0; k4 < 4; ++k4) { const bf16x8 a = *(const LAS bf16x8*)(ap + (16 * mt + fr) * NP + 32 * k4 + 8 * fq), bb = *(const LAS bf16x8*)(ks + (16 * nt + fr) * NP + 32 * k4 + 8 * fq); a4 = MFMA16(a, bb, a4); } }
#pragma unroll
            for (int r = 0; r < 4; ++r) { const int t = 16 * mt + 4 * fq + r, s = 16 * nt + fr; const float dec = __expf(fminf(gs[t] - gs[s], 0.f)) * gs[128 + s];
                if (which) { if (!F.dry) qkd[t * 64 + permpos(s)] = (s <= t) ? f2bf(a4[r] * dec * gs[192 + t]) : (bf16_t)0; }
                else AT[s * 68 + t] = (s < t) ? gs[64 + t] * gs[128 + t] * a4[r] * dec : 0.f; } }
    }
    if (lt >= 128) { const int d = lt - 128; const float gl = gs[63]; bf16_t* dst = WSP(bf16_t, WS_K1TB) + (size_t)unit * 8192 + d * 64;
#pragma unroll
        for (int o = 0; o < 8; ++o) { const int s0 = 32 * (o >> 2) + 4 * (o & 3); float y[8];
#pragma unroll
            for (int j = 0; j < 8; ++j) { const int s = s0 + (j & 3) + (j >> 2) * 16; y[j] = col[s] * gs[128 + s] * __expf(gl - gs[s]); }
            if (!F.dry) *(u32x4*)(dst + 8 * o) = (u32x4){pk2(y[0], y[1]), pk2(y[2], y[3]), pk2(y[4], y[5]), pk2(y[6], y[7])}; }
    } else { const int pp = permpos(lt);
#pragma unroll 8
        for (int t = 0; t < 64; ++t) if (!F.dry) P[(size_t)(row0 + t) * LDP + PC_BQKV + h * 128 + pp] = f2bf(bf2f(qs[t * NP + lt]) * gs[192 + t] * __expf(gs[t])); }
    __syncthreads();
#pragma unroll
    for (int i = 0; i < 64; ++i) col[i] *= lt < 128 ? gs[64 + i] : gs[64 + i] * gs[128 + i] * __expf(gs[i]);
#pragma unroll
    for (int j = 0; j < 63; ++j) { const float xj = col[j]; asm volatile("" ::: "memory");
#pragma unroll
        for (int q4 = (j + 1) >> 2; q4 < 16; ++q4) { const f32x4 a = *(const LAS f32x4*)(AT + j * 68 + 4 * q4);
#pragma unroll
            for (int e = 0; e < 4; ++e) if (4 * q4 + e > j) col[4 * q4 + e] -= a[e] * xj; } }
    int tid2 = F.tid; asm volatile("" : "+v"(tid2)); const int lt2 = tid2 & 255, unit2 = 2 * ug + __builtin_amdgcn_readfirstlane(tid2 >> 8), row02 = (unit2 >> 2) * 64, h2 = unit2 & 3;
    if (lt2 < 128) { bf16_t* dst = P + (size_t)(row02 + (lt2 >> 1)) * LDP + PC_BQKV + 1024 + h2 * 128 + (lt2 & 1) * 64;
#pragma unroll
        for (int o = 0; o < 8; ++o) if (!F.dry) *(u32x4*)(dst + 8 * o) = (u32x4){pk2(col[8 * o], col[8 * o + 1]), pk2(col[8 * o + 2], col[8 * o + 3]), pk2(col[8 * o + 4], col[8 * o + 5]), pk2(col[8 * o + 6], col[8 * o + 7])};
    } else { const int pp = permpos(lt2 - 128);
        if (!F.dry) {
#pragma unroll
        for (int t = 0; t < 64; ++t) strow(ROWB(P, row02 + t, PC_BQKV + 512 + h2 * 128), (unsigned)pp * 2u, f2bf(col[t])); } }
    __syncthreads();
}

__device__ __forceinline__ void phase_prep(Frame& F, int l) {
#ifndef PREP_DRY_SEL
#define PREP_DRY_SEL 7
#endif
    const int sel = F.dry ? PREP_DRY_SEL : 7;
    if (sel & 1) for (int ug = F.bid; ug < 514; ug += F.G) prep_gla<128, true>(F, l, ug);
    if (sel & 2) for (int ug = F.bid; ug < 514; ug += F.G) prep_gdn(F, l, ug);
    if (sel & 4) for (int ug = F.bid; ug < 514; ug += F.G) prep_gla<64, false>(F, l, ug);
}
constexpr int SCAN_BUF = 57344;
template <int MX> struct ScanCfg;
template <> struct ScanCfg<0> { static constexpr int NM = 3, NI = 5; static constexpr int off(int m) { return m == 0 ? 0 : (m == 1 ? 16384 : 32768); } static constexpr int pitch(int m) { return m == 0 ? 256 : 128; } };
template <> struct ScanCfg<1> { static constexpr int NM = 4, NI = 7; static constexpr int off(int m) { return 16384 * m; } static constexpr int pitch(int m) { return m < 2 ? 256 : 128; } };
template <> struct ScanCfg<2> { static constexpr int NM = 3, NI = 3; static constexpr int off(int m) { return 8192 * m; } static constexpr int pitch(int m) { return 128; } };

template <int MX>
__device__ __forceinline__ void scan_mixer(Frame& F, int b, int h) {
    typedef ScanCfg<MX> C;
    constexpr int DK = MX == 2 ? 64 : 128, NT = DK / 16, NI = C::NI;
    const int w = F.wave, lane = F.lane, fr = lane & 15, fq = lane >> 4, ecol = 16 * w + fr;
    const char* Pb = (const char*)WSP(bf16_t, WS_P);
    const int qcol = MX == 0 ? PC_AQ + h * 128 : (MX == 1 ? PC_BQKV + h * 128 : PC_CQ + h * 64);
    const int kcol = MX == 0 ? PC_AF + h * 128 : (MX == 1 ? PC_BQKV + 512 + h * 128 : PC_CK + h * 64);
    const int vcol = MX == 0 ? PC_AI + h * 128 : (MX == 1 ? PC_BQKV + 1024 + h * 128 : PC_CV + h * 128);
    const char* SCb = (const char*)(MX == 0 ? WSP(bf16_t, WS_SCA) : (MX == 1 ? WSP(bf16_t, WS_QKD) : WSP(bf16_t, WS_SCC)));
    bf16_t* O = WSP(bf16_t, WS_O) + (size_t)MX * MROWS * 512;
    unsigned voff[NI]; int mi[NI];
#pragma unroll
    for (int i = 0; i < NI; ++i) { const int n = w + 8 * i, o = 1024 * n + 16 * lane; int m = 0;
#pragma unroll
        for (int q = 1; q < C::NM; ++q) if (o >= C::off(q)) m = q;
        int ro = o, pitch = 128;
#pragma unroll
        for (int q = 0; q < C::NM; ++q) if (m == q) { ro = o - C::off(q); pitch = C::pitch(q); }
        const int r = ro / pitch, pos = (ro % pitch) >> 4, pc = pos ^ (pitch == 256 ? (r & 15) : ((r >> 1) & 7));
        const bool packed = (MX == 0 && m == 1);
        const bool inP = (MX == 1) ? (m < 2) : (m < 2);
        voff[i] = (unsigned)(inP ? (packed ? (r >> 1) * (LDP * 2) + (r & 1) * 128 : r * (LDP * 2)) : r * pitch) + 16u * pc; mi[i] = m; }
    const unsigned x256_0 = (unsigned)(((0 | fq) ^ fr) << 4), x256_1 = (unsigned)(((4 | fq) ^ fr) << 4), x256_2 = (unsigned)(((8 | fq) ^ fr) << 4), x256_3 = (unsigned)(((12 | fq) ^ fr) << 4);
    const unsigned x128_0 = (unsigned)(((0 | fq) ^ ((fr >> 1) & 7)) << 4), x128_1 = (unsigned)(((4 | fq) ^ ((fr >> 1) & 7)) << 4);
    const unsigned x256[4] = {x256_0, x256_1, x256_2, x256_3}, x128[2] = {x128_0, x128_1};
#define SC_FRAG(buf, m, rt, kp) (*(const LAS bf16x8*)(F.lds + (buf) + C::off(m) + (16 * (rt) + fr) * C::pitch(m) + (C::pitch(m) == 256 ? x256[kp] : x128[(kp) & 1])))
    auto slot_of = [&](int step) { return step == 0 ? 256 : b * 64 + step - 1; };
    auto issue = [&](int step, int buf) {
        const int slot = slot_of(step), row0 = slot * 64, unit = slot * 4 + h;
        const char* base[4];
        if (MX == 1) { base[0] = Pb + ((size_t)row0 * LDP + kcol) * 2; base[1] = Pb + ((size_t)row0 * LDP + qcol) * 2; base[2] = (const char*)WSP(bf16_t, WS_K1TB) + (size_t)unit * 16384; base[3] = SCb + (size_t)unit * 8192; }
        else { base[0] = Pb + ((size_t)row0 * LDP + qcol) * 2; base[1] = Pb + ((size_t)row0 * LDP + kcol) * 2; base[2] = SCb + (size_t)unit * 8192; base[3] = base[2]; }
#pragma unroll
        for (int i = 0; i < NI; ++i) { const char* bs = mi[i] == 0 ? base[0] : (mi[i] == 1 ? base[1] : (mi[i] == 2 ? base[2] : base[3]));
            __builtin_amdgcn_global_load_lds((const unsigned*)(bs + voff[i]), (LAS unsigned*)(F.lds + buf + 1024 * (w + 8 * i)), 16, 0, 0); }
    };
    auto load_priv = [&](int step, u32x4 (&pv)[2]) {
        const int row0 = slot_of(step) * 64;
        const bf16_t* vt = (const bf16_t*)Pb + (size_t)(row0 + (ecol >> 1)) * LDP + vcol + (ecol & 1) * 64;
        if (MX == 1) { const u32x2 a = *(const u32x2*)(vt + 4 * fq), c = *(const u32x2*)(vt + 16 + 4 * fq), d = *(const u32x2*)(vt + 32 + 4 * fq), e = *(const u32x2*)(vt + 48 + 4 * fq);
            pv[0] = (u32x4){a.x, a.y, c.x, c.y}; pv[1] = (u32x4){d.x, d.y, e.x, e.y}; }
        else { pv[0] = *(const u32x4*)(vt + 8 * fq); pv[1] = *(const u32x4*)(vt + 32 + 8 * fq); }
    };
    f32x4 S[NT];
#pragma unroll
    for (int i = 0; i < NT; ++i) S[i] = (f32x4){0.f, 0.f, 0.f, 0.f};
    u32x4 pcur[2], pnxt[2];
    issue(0, 0); load_priv(0, pcur);
    for (int step = 0; step < 65; ++step) {
        const int buf = (step & 1) * SCAN_BUF, slot = slot_of(step), row0 = slot * 64, unit = slot * 4 + h;
        asm volatile("s_waitcnt vmcnt(0)" ::: "memory");
        __syncthreads();
        if (step + 1 < 65) { issue(step + 1, SCAN_BUF - buf); load_priv(step + 1, pnxt); }
        bf16x8 Sb[NT / 2];
#pragma unroll
        for (int kp = 0; kp < NT / 2; ++kp) Sb[kp] = pack_acc2(S[2 * kp], S[2 * kp + 1]);
        if (MX == 1) {
            f32x4 vn[4];
#pragma unroll
            for (int mt = 0; mt < 4; ++mt) { f32x4 acc = {0.f, 0.f, 0.f, 0.f};
#pragma unroll
                for (int kp = 0; kp < 4; ++kp) acc = MFMA16(SC_FRAG(buf, 0, mt, kp), Sb[kp], acc);
                const unsigned u0 = mt == 0 ? pcur[0].x : (mt == 1 ? pcur[0].z : (mt == 2 ? pcur[1].x : pcur[1].z)), u1 = mt == 0 ? pcur[0].y : (mt == 1 ? pcur[0].w : (mt == 2 ? pcur[1].y : pcur[1].w));
                vn[mt] = (f32x4){bflo(u0) - acc[0], bfhi(u0) - acc[1], bflo(u1) - acc[2], bfhi(u1) - acc[3]}; }
            bf16x8 Vb[2]; Vb[0] = pack_acc2(vn[0], vn[1]); Vb[1] = pack_acc2(vn[2], vn[3]);
#pragma unroll
            for (int mt = 0; mt < 4; ++mt) { f32x4 acc = {0.f, 0.f, 0.f, 0.f};
#pragma unroll
                for (int kp = 0; kp < 4; ++kp) acc = MFMA16(SC_FRAG(buf, 1, mt, kp), Sb[kp], acc);
#pragma unroll
                for (int kp = 0; kp < 2; ++kp) acc = MFMA16(SC_FRAG(buf, 3, mt, kp), Vb[kp], acc);
#pragma unroll
                for (int r = 0; r < 4; ++r) O[(size_t)(row0 + 16 * mt + 4 * fq + r) * 512 + h * 128 + ecol] = f2bf(acc[r]); }
            const float a = WSP(float, SM_DECB)[unit];
#pragma unroll
            for (int i = 0; i < 8; ++i) { S[i] = S[i] * a;
#pragma unroll
                for (int kp = 0; kp < 2; ++kp) S[i] = MFMA16(SC_FRAG(buf, 2, i, kp), Vb[kp], S[i]); }
        } else {
            const bf16x8 bv0 = mk8(pcur[0]), bv1 = mk8(pcur[1]);
#pragma unroll
            for (int mt = 0; mt < 4; ++mt) { f32x4 acc = {0.f, 0.f, 0.f, 0.f};
#pragma unroll
                for (int kp = 0; kp < NT / 2; ++kp) acc = MFMA16(SC_FRAG(buf, 0, mt, kp), Sb[kp], acc);
                acc = MFMA16(SC_FRAG(buf, 2, mt, 0), bv0, acc); acc = MFMA16(SC_FRAG(buf, 2, mt, 1), bv1, acc);
#pragma unroll
                for (int r = 0; r < 4; ++r) O[(size_t)(row0 + 16 * mt + 4 * fq + r) * 512 + h * 128 + ecol] = f2bf(acc[r]); }
            const float* dec = (MX == 0 ? WSP(float, SM_DECA) : WSP(float, SM_DECC)) + (size_t)unit * DK;
#pragma unroll
            for (int i = 0; i < NT; ++i) { const f32x4 d4 = *(const f32x4*)(dec + 16 * i + 4 * fq); S[i] = S[i] * d4;
                S[i] = MFMA16(SC_FRAG(buf, 1, i, 0), bv0, S[i]); S[i] = MFMA16(SC_FRAG(buf, 1, i, 1), bv1, S[i]); }
        }
        pcur[0] = pnxt[0]; pcur[1] = pnxt[1];
    }
#undef SC_FRAG
    asm volatile("s_waitcnt vmcnt(0)" ::: "memory");
    __syncthreads();
}
__device__ __forceinline__ void phase_scan(Frame& F) {
    if (F.bid >= 48) return;
    const int mixer = F.bid >> 4, b = (F.bid >> 2) & 3, h = F.bid & 3;
    if (mixer == 0) scan_mixer<0>(F, b, h);
    else if (mixer == 1) scan_mixer<1>(F, b, h);
    else scan_mixer<2>(F, b, h);
}

template <int KIND>
__device__ __forceinline__ void meta_gemm(Frame& F, const bf16_t* A, const bf16_t* Bt, int N, int K, int n) {
    const int gw = F.bid * NWAVES + F.wave, NGW = F.G * NWAVES, lane = F.lane, fr = lane & 15, fq = lane >> 4;
    for (int tile = gw; tile < N / 16; tile += NGW) {
        const bf16_t* ar = A + (size_t)fr * K + 8 * fq; const bf16_t* br = Bt + (size_t)(16 * tile + fr) * K + 8 * fq;
        f32x4 acc = {0.f, 0.f, 0.f, 0.f};
#pragma unroll 8
        for (int ks = 0; ks < K / 32; ++ks) acc = MFMA16(mk8(*(const u32x4*)(ar + 32 * ks)), mk8(*(const u32x4*)(br + 32 * ks)), acc);
#pragma unroll
        for (int r = 0; r < 4; ++r) { const int row = META_ROW0 + 4 * fq + r, col = 16 * tile + fr;
            if (KIND == 0) WSP(bf16_t, WS_GT)[(size_t)row * 3072 + col] = f2bf(sigmoidf_(acc[r]));
            else if (KIND == 1) { bf16_t* mp = WSP(bf16_t, WS_MERGED) + (size_t)row * 1024 + col; const float g = bf2f(WSP(bf16_t, WS_GT)[(size_t)row * 3072 + n * 1024 + col]);
                *mp = f2bf((n ? bf2f(*mp) : 0.f) + g * acc[r]); }
            else { float* hp = WSP(float, WS_HMETA) + (size_t)(row - NREAL) * D + col; *hp = *hp + acc[r]; } }
    }
}

__device__ __forceinline__ void phase_hnorm(Frame& F, int l) {
    const int gw = F.bid * NWAVES + F.wave, NGW = F.G * NWAVES, lane = F.lane;
    const bf16_t* P = WSP(bf16_t, WS_P);
    LAS float* nws = (LAS float*)F.lds;
    if (F.tid < 384) { const int mxw = F.tid >> 7; const float* src = mxw == 0 ? INP(I_HGRN_NORM) : (mxw == 1 ? INP(I_GDN_NORM) : INP(I_GLA_NORM)); nws[F.tid] = src[(size_t)l * 128 + (F.tid & 127)]; }
    __syncthreads();
    for (int it = gw; it < MROWS * 3; it += NGW) {
        const int r = it / 3, mx = it % 3;
        bf16_t* op = WSP(bf16_t, WS_O) + (size_t)mx * MROWS * 512 + (size_t)r * 512 + 8 * lane;
        if (!row_valid(r)) { if (!F.dry) *(u32x4*)op = (u32x4){0u, 0u, 0u, 0u}; continue; }
        const int gcol = mx == 0 ? PC_AG : (mx == 1 ? PC_BG : PC_CG);
        const LAS float* nw = nws + mx * 128 + (8 * lane & 127);
        const u32x4 ow = *(const u32x4*)op, gw4 = *(const u32x4*)(P + (size_t)r * LDP + gcol + 8 * lane);
        float o[8] = {bflo(ow.x), bfhi(ow.x), bflo(ow.y), bfhi(ow.y), bflo(ow.z), bfhi(ow.z), bflo(ow.w), bfhi(ow.w)};
        const float g[8] = {siluf_(bflo(gw4.x)), siluf_(bfhi(gw4.x)), siluf_(bflo(gw4.y)), siluf_(bfhi(gw4.y)), siluf_(bflo(gw4.z)), siluf_(bfhi(gw4.z)), siluf_(bflo(gw4.w)), siluf_(bfhi(gw4.w))};
        float ss = 0.f;
#pragma unroll
        for (int j = 0; j < 8; ++j) ss += o[j] * o[j];
        ss += __shfl_xor(ss, 1); ss += __shfl_xor(ss, 2); ss += __shfl_xor(ss, 4); ss += __shfl_xor(ss, 8);
        const float rstd = rsqrtf(ss * (1.0f / 128.0f) + 1e-6f);
        const f32x4 n0 = *(const LAS f32x4*)nw, n1 = *(const LAS f32x4*)(nw + 4);
        const float nv[8] = {n0[0], n0[1], n0[2], n0[3], n1[0], n1[1], n1[2], n1[3]};
#pragma unroll
        for (int j = 0; j < 8; ++j) o[j] = o[j] * rstd * nv[j] * g[j];
        u32x4 y; y.x = pk2(o[0], o[1]); y.y = pk2(o[2], o[3]); y.z = pk2(o[4], o[5]); y.w = pk2(o[6], o[7]);
        if (!F.dry) *(u32x4*)op = y;
    }
}

__device__ __forceinline__ void phase_norm2(Frame& F, int l) {
    if (!F.dry) convert_expert_weights(F, l);
    __syncthreads();
    LAS float* sw = (LAS float*)F.lds;
    { const float* src = WSP(float, SM_RWE) + (size_t)l * 32 * 1024; for (int i = F.tid; i < 32 * 1024 / 4; i += NTHREADS) ((LAS f32x4*)sw)[i] = ((const f32x4*)src)[i]; }
    LAS float* rbias = sw + 32 * 1024;
    if (F.tid < 32) rbias[F.tid] = INP(I_RE_B)[l * 32 + F.tid]; else if (F.tid < 36) rbias[F.tid] = INP(I_RG_B)[l * 4 + (F.tid - 32)];
    __syncthreads();
    const int gw = F.bid * NWAVES + F.wave, NGW = F.G * NWAVES, lane = F.lane;
    float wv[16]; load_row16(INP(I_NORM_FFN) + (size_t)l * D, lane, wv);
    bf16_t* U = WSP(bf16_t, WS_U);
    const float* rwg = WSP(float, SM_RWG) + (size_t)l * 4 * 1024;
    unsigned* cnt = WSP(unsigned, WS_CTL) + CW_CNT + l * 64;
    LAS unsigned* lcnt = (LAS unsigned*)(F.lds + LDS_TAB);
    if (F.tid < 64) lcnt[F.tid] = 0u;
    __syncthreads();
    for (int g = gw; g < MROWS / 4; g += NGW) {
        const int r0 = 4 * g;
        if (!row_valid(r0)) continue;
        float x[4][16];
#pragma unroll
        for (int i = 0; i < 4; ++i) {
            load_row16(hrow(F, r0 + i), lane, x[i]);
            float ss = 0.f;
#pragma unroll
            for (int j = 0; j < 16; ++j) ss += x[i][j] * x[i][j];
            const float rstd = rsqrtf(wave_sum(ss) * (1.0f / D) + 1e-6f);
#pragma unroll
            for (int j = 0; j < 16; ++j) x[i][j] = x[i][j] * rstd * wv[j];
            if (!F.dry) store_bf16_row16(U + (size_t)(r0 + i) * D, lane, x[i]);
        }
#ifndef NORM2_SKIP
#define NORM2_SKIP 0
#endif
        if (F.dry && (NORM2_SKIP & 4)) continue;
        float lg[4][4];
#pragma unroll
        for (int c = 0; c < 4; ++c) {
            float a0 = 0.f, a1 = 0.f, a2 = 0.f, a3 = 0.f;
#pragma unroll
            for (int j = 0; j < 4; ++j) { const f32x4 w = *((const f32x4*)(rwg + c * 1024) + lane + 64 * j);
#pragma unroll
                for (int e = 0; e < 4; ++e) { a0 += x[0][4 * j + e] * w[e]; a1 += x[1][4 * j + e] * w[e]; a2 += x[2][4 * j + e] * w[e]; a3 += x[3][4 * j + e] * w[e]; } }
            const float bg = rbias[32 + c];
            lg[0][c] = wave_sum(a0) + bg; lg[1][c] = wave_sum(a1) + bg; lg[2][c] = wave_sum(a2) + bg; lg[3][c] = wave_sum(a3) + bg;
        }
#pragma unroll
        for (int i = 0; i < 4; ++i) {
            int gi = 0; float gm = lg[i][0];
#pragma unroll
            for (int c = 1; c < 4; ++c) if (lg[i][c] > gm) { gm = lg[i][c]; gi = c; }
            float gsum = 0.f;
#pragma unroll
            for (int c = 0; c < 4; ++c) gsum += __expf(lg[i][c] - gm);
            const float gval = 1.0f / gsum;
            gi = __builtin_amdgcn_readfirstlane(gi);
            int ea = 0, eb = 0; float la = -3.0e38f, lb = -3.0e38f;
            const LAS float* swg = sw + gi * 8 * 1024;
#pragma unroll 1
            for (int cb = 0; cb < ((F.dry && (NORM2_SKIP & 2)) ? 0 : 8); cb += 4) {
                float a0 = 0.f, a1 = 0.f, a2 = 0.f, a3 = 0.f;
#pragma unroll
                for (int j = 0; j < 4; ++j) { const f32x4 w0 = *((const LAS f32x4*)(swg + (cb + 0) * 1024) + lane + 64 * j), w1 = *((const LAS f32x4*)(swg + (cb + 1) * 1024) + lane + 64 * j), w2 = *((const LAS f32x4*)(swg + (cb + 2) * 1024) + lane + 64 * j), w3 = *((const LAS f32x4*)(swg + (cb + 3) * 1024) + lane + 64 * j);
#pragma unroll
                    for (int e = 0; e < 4; ++e) { const float xv = x[i][4 * j + e]; a0 += xv * w0[e]; a1 += xv * w1[e]; a2 += xv * w2[e]; a3 += xv * w3[e]; } }
                const float e0 = wave_sum(a0) + rbias[gi * 8 + cb], e1 = wave_sum(a1) + rbias[gi * 8 + cb + 1], e2 = wave_sum(a2) + rbias[gi * 8 + cb + 2], e3 = wave_sum(a3) + rbias[gi * 8 + cb + 3];
                const float ev[4] = {e0, e1, e2, e3};
#pragma unroll
                for (int q = 0; q < 4; ++q) { const float el = ev[q]; const int c = cb + q; if (el > la) { lb = la; eb = ea; la = el; ea = c; } else if (el > lb) { lb = el; eb = c; } }
            }
            const float wa = 1.0f / (1.0f + __expf(lb - la)), wb = 1.0f - wa;
            if (lane == 0 && !F.dry) {
                const unsigned e0 = (unsigned)(gi * 8 + ea), e1 = (unsigned)(gi * 8 + eb);
                const unsigned p0 = __hip_atomic_fetch_add(lcnt + e0, 1u, __ATOMIC_RELAXED, __HIP_MEMORY_SCOPE_WORKGROUP), p1 = __hip_atomic_fetch_add(lcnt + e1, 1u, __ATOMIC_RELAXED, __HIP_MEMORY_SCOPE_WORKGROUP);
                unsigned* tok = WSP(unsigned, SM_TOK) + (size_t)(r0 + i) * 8;
                tok[0] = e0; tok[1] = p0; tok[2] = e1; tok[3] = p1; tok[4] = __float_as_uint(gval * wa); tok[5] = __float_as_uint(gval * wb);
            }
        }
    }
    __syncthreads();
    if (F.tid < 32 && !F.dry) lcnt[32 + F.tid] = atomicAdd(cnt + F.tid, lcnt[F.tid]);
    __syncthreads();
    if (!F.dry) for (int g = gw; g < MROWS / 4; g += NGW) { const int r0 = 4 * g; if (!row_valid(r0)) continue;
        if (lane < 4) { unsigned* tok = WSP(unsigned, SM_TOK) + (size_t)(r0 + lane) * 8; tok[1] += lcnt[32 + tok[0]]; tok[3] += lcnt[32 + tok[2]]; } }
}

__device__ __forceinline__ int moe_tables(Frame& F, int l) {
    LAS int* offs = (LAS int*)(F.lds + LDS_TAB); LAS unsigned char* tab = (LAS unsigned char*)(F.lds + LDS_TAB + 384); LAS int* cn = (LAS int*)(F.lds + LDS_TAB + 192);
    const unsigned* cnt = WSP(unsigned, WS_CTL) + CW_CNT + l * 64;
    __syncthreads();
    if (F.tid < 32) cn[F.tid] = (int)__hip_atomic_load(cnt + F.tid, __ATOMIC_RELAXED, __HIP_MEMORY_SCOPE_AGENT);
    __syncthreads();
    if (F.tid == 0) { int acc = 0;
#pragma unroll 1
        for (int e = 0; e < 32; ++e) { offs[e] = acc; acc += ((cn[e] + 255) >> 8) << 8; }
        offs[32] = acc; }
    __syncthreads();
    if (F.tid < 160) { const int row = F.tid << 8; int e = 0;
#pragma unroll 1
        for (int k = 1; k < 32; ++k) if (offs[k] <= row) e = k;
        tab[F.tid] = (unsigned char)e; }
    __syncthreads();
    return offs[32] >> 8;
}

__device__ __forceinline__ void phase_gather(Frame& F, int l) {
    (void)moe_tables(F, l);
    const LAS int* offs = (const LAS int*)(F.lds + LDS_TAB); const LAS int* cn = (const LAS int*)(F.lds + LDS_TAB + 192);
    const int gw = F.bid * NWAVES + F.wave, NGW = F.G * NWAVES, lane = F.lane;
    const bf16_t* U = WSP(bf16_t, WS_U); bf16_t* XG = WSP(bf16_t, WS_XG); float* wrow = WSP(float, SM_WROW);
    for (int idx = gw; idx < NREAL + 16; idx += NGW) {
        const int r = idx < NREAL ? idx : META_ROW0 + (idx - NREAL);
        unsigned* tok = WSP(unsigned, SM_TOK) + (size_t)r * 8;
        const unsigned e0 = tok[0], p0 = tok[1], e1 = tok[2], p1 = tok[3];
        const unsigned g0 = (unsigned)offs[e0] + p0, g1 = (unsigned)offs[e1] + p1;
        if (lane == 0) { tok[6] = g0; tok[7] = g1; wrow[g0] = __uint_as_float(tok[4]); wrow[g1] = __uint_as_float(tok[5]); }
        const u32x4* src = (const u32x4*)(U + (size_t)r * D);
        const u32x4 a = src[lane], b = src[lane + 64];
        u32x4* d0 = (u32x4*)(XG + (size_t)g0 * D); u32x4* d1 = (u32x4*)(XG + (size_t)g1 * D);
        d0[lane] = a; d0[lane + 64] = b; d1[lane] = a; d1[lane + 64] = b;
    }
    u32x4 zz = {0u, 0u, 0u, 0u}; asm volatile("" : "+v"(zz));
    for (int i = gw; i < 32 * 256; i += NGW) { const int e = i >> 8, j = i & 255; const int row = offs[e] + cn[e] + j;
        if (row < offs[e + 1]) { u32x4* d = (u32x4*)(XG + (size_t)row * D); d[lane] = zz; d[lane + 64] = zz; if (lane == 0) wrow[row] = 0.f; } }
}

__device__ __forceinline__ void phase_final(Frame& F) {
    const int gw = F.bid * NWAVES + F.wave, NGW = F.G * NWAVES, lane = F.lane;
    float wv[16]; load_row16(INP(I_NORM_FINAL), lane, wv);
    for (int r = gw; r < NREAL; r += NGW) {
        float x[16]; fetch_h_row(F, 2, r, x);
        float ss = 0.f;
#pragma unroll
        for (int j = 0; j < 16; ++j) ss += x[j] * x[j];
        const float rstd = rsqrtf(wave_sum(ss) * (1.0f / D) + 1e-6f);
#pragma unroll
        for (int j = 0; j < 16; ++j) x[j] = x[j] * rstd * wv[j];
        store_row16(OUTP + (size_t)r * D, lane, x);
    }
}
constexpr int PH_PER_LAYER = 14, N_PHASES = 2 + 2 * PH_PER_LAYER;
#ifndef DBG_STOP
#define DBG_STOP 0
#endif
#ifndef DBG_SRC
#define DBG_SRC WS_P
#define DBG_LD LDP
#endif
#ifndef DBG_TA
#define DBG_TA -1
#endif
#ifndef DBG_TB
#define DBG_TB -1
#endif
#ifndef DUP_MASK
#define DUP_MASK 0u
#endif
#define DUPN(j) (((DUP_MASK >> (j)) & 1u) ? 2 : 1)
#ifndef MK_ONE_LAUNCH
#define MK_ONE_LAUNCH 1
#endif

template <unsigned PHMASK_T>
__global__ void __launch_bounds__(NTHREADS, 2) hybrid_fwd(Params p) {
    extern __shared__ __attribute__((aligned(16))) unsigned char lds_raw[];
    Frame F;
    F.lds = (LAS unsigned char*)lds_raw; F.tid = threadIdx.x; F.lane = F.tid & 63; F.wave = __builtin_amdgcn_readfirstlane(F.tid >> 6); F.G = gridDim.x; F.bid = blockIdx.x; F.dry = 0;
    F.out = (GAS float*)p.out; F.ws = (GAS unsigned char*)p.ws; F.inp = (const float* const __attribute__((address_space(4)))*)__builtin_amdgcn_kernarg_segment_ptr();
    volatile LAS unsigned* MISC = (volatile LAS unsigned*)(F.lds + LDS_MISC);
    if (F.tid < 128) MISC[F.tid] = 0u;
    __syncthreads();
#if MK_ONE_LAUNCH
    constexpr int lo = 0, hi = N_PHASES;
#else
    const int lo = p.ph_lo, hi = p.ph_hi;
#endif
    if (hi - lo > 1) (void)xcd_barrier_post(WSP(unsigned, WS_CTL) + CW_BAR, MISC + 8);
#define GRID_BARRIER() xcd_barrier(WSP(unsigned, WS_CTL) + CW_BAR, xb_xcc_id(), (volatile LAS unsigned*)(F.lds + LDS_MISC) + 8, F.tid, (unsigned)F.G)
#define EN(j) ((PHMASK_T >> (j)) & 1u)
#define IN(k) (lo <= (k) && (k) < hi)
    if (DBG_TA >= 0 && F.tid == 0) { MISC[16] = (unsigned)__builtin_amdgcn_s_memrealtime(); MISC[17] = 0u; }
#define SEAM(k) do { if (IN(k) && IN((k) + 1)) GRID_BARRIER(); PHASE_FENCE(F); \
    if (DBG_TA >= 0 && F.tid == 0) { const unsigned t_now = (unsigned)__builtin_amdgcn_s_memrealtime(); const int kk = (k) == 0 ? 15 : (((k) - 1) % PH_PER_LAYER); const int kind = (kk >= 6 && kk <= 8) ? 6 : kk; \
        if (kind == DBG_TA) MISC[17] += t_now - MISC[16]; MISC[16] = t_now; } } while (0)
    PHASE_FENCE(F);
    if (EN(15) && IN(0)) phase_pre(F);
    SEAM(0);
    { constexpr int l = 0;
        const int pb = 1 + PH_PER_LAYER * l;
        for (int rep = 0; rep < (l == 0 ? DUPN(0) : 1); ++rep) { if (rep) { GRID_BARRIER(); PHASE_FENCE(F); } if (EN(0) && IN(pb + 0)) phase_norm1(F, l); }
        SEAM(pb + 0);
        for (int rep = 0; rep < DUPN(1); ++rep) { if (rep) { GRID_BARRIER(); PHASE_FENCE(F); }
        if (EN(1) && IN(pb + 1)) {
            pg8::Gemm g{WSP(bf16_t, WS_U), WSP(bf16_t, WS_WMIX), MROWS, LDP, D}; pg8::StaticOrder S; S.init(MROWS, LDP, F.G, F.bid);
            pg8::EpiInProj E{WSP(bf16_t, WS_P), WSP(bf16_t, SM_HALO)};
            pg8::gemm_phase(F.lds, F.tid, g, S, E);
        } }
        SEAM(pb + 1);
        for (int rep = 0; rep < DUPN(2); ++rep) { if (rep) { GRID_BARRIER(); PHASE_FENCE(F); F.dry = 1; asm volatile("" : "+s"(F.dry)); } if (EN(2) && IN(pb + 2)) phase_prep(F, l); F.dry = 0; }
        SEAM(pb + 2);
        for (int rep = 0; rep < DUPN(3); ++rep) { if (rep) { GRID_BARRIER(); PHASE_FENCE(F); } if (EN(3) && IN(pb + 3)) phase_scan(F); }
        SEAM(pb + 3);
        for (int rep = 0; rep < DUPN(4); ++rep) { if (rep) { GRID_BARRIER(); PHASE_FENCE(F); F.dry = 1; asm volatile("" : "+s"(F.dry)); } if (EN(4) && IN(pb + 4)) phase_hnorm(F, l); F.dry = 0; }
        SEAM(pb + 4);
        for (int rep = 0; rep < DUPN(5); ++rep) { if (rep) { GRID_BARRIER(); PHASE_FENCE(F); }
        if (EN(5) && IN(pb + 5)) {
            pg8::Gemm g{WSP(bf16_t, WS_U), WSP(bf16_t, WS_WGATE), NREAL, 3072, D}; pg8::StaticOrder S; S.init(NREAL, 3072, F.G, F.bid);
            pg8::EpiSigmoid E{WSP(bf16_t, WS_GT), 3072};
            pg8::gemm_phase(F.lds, F.tid, g, S, E);
            meta_gemm<0>(F, WSP(bf16_t, WS_U) + (size_t)META_ROW0 * D, WSP(bf16_t, WS_WGATE), 3072, D, 0);
        } }
        SEAM(pb + 5);
        for (int n = 0; n < 3; ++n) {
            if (EN(6) && IN(pb + 6 + n)) {
                pg8::Gemm g{WSP(bf16_t, WS_O) + (size_t)n * MROWS * 512, WSP(bf16_t, WS_WBT) + (size_t)n * 1024 * 512, NREAL, D, 512}; pg8::StaticOrder S; S.init(NREAL, D, F.G, F.bid);
                pg8::EpiBranch E{WSP(bf16_t, WS_MERGED), WSP(bf16_t, WS_GT), n};
                pg8::gemm_phase(F.lds, F.tid, g, S, E);
                meta_gemm<1>(F, WSP(bf16_t, WS_O) + (size_t)n * MROWS * 512 + (size_t)META_ROW0 * 512, WSP(bf16_t, WS_WBT) + (size_t)n * 1024 * 512, D, 512, n);
            }
            SEAM(pb + 6 + n);
        }
        if (EN(9) && IN(pb + 9)) {
            pg8::Gemm g{WSP(bf16_t, WS_MERGED), WSP(bf16_t, WS_WOT), NREAL, D, D}; pg8::StaticOrder S; S.init(NREAL, D, F.G, F.bid);
            pg8::EpiResidual E{OUTP, WSP(float, WS_HMETA)};
            pg8::gemm_phase(F.lds, F.tid, g, S, E);
            meta_gemm<2>(F, WSP(bf16_t, WS_MERGED) + (size_t)META_ROW0 * D, WSP(bf16_t, WS_WOT), D, D, 0);
        }
        SEAM(pb + 9);
        for (int rep = 0; rep < DUPN(10); ++rep) { if (rep) { GRID_BARRIER(); PHASE_FENCE(F); F.dry = 1; asm volatile("" : "+s"(F.dry)); } if (EN(10) && IN(pb + 10)) phase_norm2(F, l); F.dry = 0; }
        SEAM(pb + 10);
        for (int rep = 0; rep < DUPN(11); ++rep) { if (rep) { GRID_BARRIER(); PHASE_FENCE(F); } if (EN(11) && IN(pb + 11)) phase_gather(F, l); }
        SEAM(pb + 11);
        for (int rep = 0; rep < DUPN(12); ++rep) { if (rep) { GRID_BARRIER(); PHASE_FENCE(F); }
        if (EN(12) && IN(pb + 12)) {
            const int ntiles = moe_tables(F, l);
            pg8::Gemm g{WSP(bf16_t, WS_XG), WSP(bf16_t, WS_W1T), XG_ROWS, 512, D};
            pg8::MoeOrder S{F.G, F.bid, 2, ntiles, (const LAS unsigned char*)(F.lds + LDS_TAB + 384), (size_t)512 * 1024 * 2};
            pg8::EpiMoeUp E{WSP(bf16_t, WS_HG)};
            pg8::gemm_phase(F.lds, F.tid, g, S, E);
        } }
        SEAM(pb + 12);
        for (int rep = 0; rep < DUPN(13); ++rep) { if (rep) { GRID_BARRIER(); PHASE_FENCE(F); }
        if (EN(13) && IN(pb + 13)) {
            const int ntiles = moe_tables(F, l);
            pg8::Gemm g{WSP(bf16_t, WS_HG), WSP(bf16_t, WS_W2T), XG_ROWS, D, 256};
            pg8::MoeOrder S{F.G, F.bid, 4, ntiles, (const LAS unsigned char*)(F.lds + LDS_TAB + 384), (size_t)1024 * 256 * 2};
            pg8::EpiMoeDown E{WSP(bf16_t, WS_Y2), WSP(float, SM_WROW)};
            pg8::gemm_phase(F.lds, F.tid, g, S, E);
        } }
        SEAM(pb + 13);
    }
    { constexpr int l = 1;
        const int pb = 1 + PH_PER_LAYER * l;
        for (int rep = 0; rep < (l == 0 ? DUPN(0) : 1); ++rep) { if (rep) { GRID_BARRIER(); PHASE_FENCE(F); } if (EN(0) && IN(pb + 0)) phase_norm1(F, l); }
        SEAM(pb + 0);
        for (int rep = 0; rep < DUPN(1); ++rep) { if (rep) { GRID_BARRIER(); PHASE_FENCE(F); }
        if (EN(1) && IN(pb + 1)) {
            pg8::Gemm g{WSP(bf16_t, WS_U), WSP(bf16_t, WS_WMIX), MROWS, LDP, D}; pg8::StaticOrder S; S.init(MROWS, LDP, F.G, F.bid);
            pg8::EpiInProj E{WSP(bf16_t, WS_P), WSP(bf16_t, SM_HALO)};
            pg8::gemm_phase(F.lds, F.tid, g, S, E);
        } }
        SEAM(pb + 1);
        for (int rep = 0; rep < DUPN(2); ++rep) { if (rep) { GRID_BARRIER(); PHASE_FENCE(F); F.dry = 1; asm volatile("" : "+s"(F.dry)); } if (EN(2) && IN(pb + 2)) phase_prep(F, l); F.dry = 0; }
        SEAM(pb + 2);
        for (int rep = 0; rep < DUPN(3); ++rep) { if (rep) { GRID_BARRIER(); PHASE_FENCE(F); } if (EN(3) && IN(pb + 3)) phase_scan(F); }
        SEAM(pb + 3);
        for (int rep = 0; rep < DUPN(4); ++rep) { if (rep) { GRID_BARRIER(); PHASE_FENCE(F); F.dry = 1; asm volatile("" : "+s"(F.dry)); } if (EN(4) && IN(pb + 4)) phase_hnorm(F, l); F.dry = 0; }
        SEAM(pb + 4);
        for (int rep = 0; rep < DUPN(5); ++rep) { if (rep) { GRID_BARRIER(); PHASE_FENCE(F); }
        if (EN(5) && IN(pb + 5)) {
            pg8::Gemm g{WSP(bf16_t, WS_U), WSP(bf16_t, WS_WGATE), NREAL, 3072, D}; pg8::StaticOrder S; S.init(NREAL, 3072, F.G, F.bid);
            pg8::EpiSigmoid E{WSP(bf16_t, WS_GT), 3072};
            pg8::gemm_phase(F.lds, F.tid, g, S, E);
            meta_gemm<0>(F, WSP(bf16_t, WS_U) + (size_t)META_ROW0 * D, WSP(bf16_t, WS_WGATE), 3072, D, 0);
        } }
        SEAM(pb + 5);
        for (int n = 0; n < 3; ++n) {
            if (EN(6) && IN(pb + 6 + n)) {
                pg8::Gemm g{WSP(bf16_t, WS_O) + (size_t)n * MROWS * 512, WSP(bf16_t, WS_WBT) + (size_t)n * 1024 * 512, NREAL, D, 512}; pg8::StaticOrder S; S.init(NREAL, D, F.G, F.bid);
                pg8::EpiBranch E{WSP(bf16_t, WS_MERGED), WSP(bf16_t, WS_GT), n};
                pg8::gemm_phase(F.lds, F.tid, g, S, E);
                meta_gemm<1>(F, WSP(bf16_t, WS_O) + (size_t)n * MROWS * 512 + (size_t)META_ROW0 * 512, WSP(bf16_t, WS_WBT) + (size_t)n * 1024 * 512, D, 512, n);
            }
            SEAM(pb + 6 + n);
        }
        if (EN(9) && IN(pb + 9)) {
            pg8::Gemm g{WSP(bf16_t, WS_MERGED), WSP(bf16_t, WS_WOT), NREAL, D, D}; pg8::StaticOrder S; S.init(NREAL, D, F.G, F.bid);
            pg8::EpiResidual E{OUTP, WSP(float, WS_HMETA)};
            pg8::gemm_phase(F.lds, F.tid, g, S, E);
            meta_gemm<2>(F, WSP(bf16_t, WS_MERGED) + (size_t)META_ROW0 * D, WSP(bf16_t, WS_WOT), D, D, 0);
        }
        SEAM(pb + 9);
        for (int rep = 0; rep < DUPN(10); ++rep) { if (rep) { GRID_BARRIER(); PHASE_FENCE(F); F.dry = 1; asm volatile("" : "+s"(F.dry)); } if (EN(10) && IN(pb + 10)) phase_norm2(F, l); F.dry = 0; }
        SEAM(pb + 10);
        for (int rep = 0; rep < DUPN(11); ++rep) { if (rep) { GRID_BARRIER(); PHASE_FENCE(F); } if (EN(11) && IN(pb + 11)) phase_gather(F, l); }
        SEAM(pb + 11);
        for (int rep = 0; rep < DUPN(12); ++rep) { if (rep) { GRID_BARRIER(); PHASE_FENCE(F); }
        if (EN(12) && IN(pb + 12)) {
            const int ntiles = moe_tables(F, l);
            pg8::Gemm g{WSP(bf16_t, WS_XG), WSP(bf16_t, WS_W1T), XG_ROWS, 512, D};
            pg8::MoeOrder S{F.G, F.bid, 2, ntiles, (const LAS unsigned char*)(F.lds + LDS_TAB + 384), (size_t)512 * 1024 * 2};
            pg8::EpiMoeUp E{WSP(bf16_t, WS_HG)};
            pg8::gemm_phase(F.lds, F.tid, g, S, E);
        } }
        SEAM(pb + 12);
        for (int rep = 0; rep < DUPN(13); ++rep) { if (rep) { GRID_BARRIER(); PHASE_FENCE(F); }
        if (EN(13) && IN(pb + 13)) {
            const int ntiles = moe_tables(F, l);
            pg8::Gemm g{WSP(bf16_t, WS_HG), WSP(bf16_t, WS_W2T), XG_ROWS, D, 256};
            pg8::MoeOrder S{F.G, F.bid, 4, ntiles, (const LAS unsigned char*)(F.lds + LDS_TAB + 384), (size_t)1024 * 256 * 2};
            pg8::EpiMoeDown E{WSP(bf16_t, WS_Y2), WSP(float, SM_WROW)};
            pg8::gemm_phase(F.lds, F.tid, g, S, E);
        } }
        SEAM(pb + 13);
    }
#if DBG_STOP > 0
    if (EN(14) && IN(N_PHASES - 1)) { const int gt = F.bid * NTHREADS + F.tid, NT = F.G * NTHREADS;
#ifdef DBG_LIN
        { const bf16_t* s1 = WSP(bf16_t, DBG_SRC); const bf16_t* s2 = WSP(bf16_t, DBG_SRC2);
          for (size_t i = gt; i < (size_t)NREAL * D; i += NT) F.out[i] = i < (size_t)DBG_N1 ? bf2f(s1[i]) : (i < (size_t)DBG_N1 + DBG_N2 ? bf2f(s2[i - DBG_N1]) : 0.f); }
#else
        if (DBG_LD > 0) { const bf16_t* src = WSP(bf16_t, DBG_SRC); for (size_t i = gt; i < (size_t)NREAL * D; i += NT) { const size_t r = i >> 10, c = i & 1023; F.out[i] = bf2f(src[r * DBG_LD + (c * DBG_LD) / 1024]); } }
#endif
    }
#else
#ifdef DBG_XBAR
    for (int i = 0; i < DBG_XBAR; ++i) { GRID_BARRIER(); PHASE_FENCE(F); }
#endif
    if (EN(14) && IN(N_PHASES - 1)) phase_final(F);
    if (DBG_TA >= 0) { float* tw = WSP(float, WS_CTL) + 2048; if (F.bid == 0 && F.tid == 0) { tw[0] = (float)MISC[17] * 0.01f; }
        GRID_BARRIER(); PHASE_FENCE(F);
        const float v = WSP(float, WS_CTL)[2048] * (1.0f / 200.0f); const int gt = F.bid * NTHREADS + F.tid, NT = F.G * NTHREADS;
        for (size_t i = gt; i < (size_t)NREAL * D; i += NT) F.out[i] = v; }
#endif
#undef IN
#undef SEAM
}

#if MK_ONE_LAUNCH
#ifndef KM_ONE
#define KM_ONE 0xffffffffu
#endif
constexpr unsigned KMASK[1] = {KM_ONE};
#else
constexpr unsigned KMASK[3] = {0x0C19u, 0xC004u, 0x3262u};
#endif
template <unsigned M> static bool setup_kernel(int& per_cu) {
    if (hipFuncSetAttribute((const void*)hybrid_fwd<M>, hipFuncAttributeMaxDynamicSharedMemorySize, LDS_BYTES) != hipSuccess) return false;
    if (hipOccupancyMaxActiveBlocksPerMultiprocessor(&per_cu, (const void*)hybrid_fwd<M>, NTHREADS, LDS_BYTES) != hipSuccess) per_cu = 0;
    (void)hipGetLastError();
    return true;
}
static int phase_kind(int k) { if (k == 0) return 15; if (k == N_PHASES - 1) return 14; const int j = (k - 1) % PH_PER_LAYER; return (j >= 6 && j <= 8) ? 6 : j; }
extern "C" void kernel_launch(void* const* d_in, const int* in_sizes, int n_in, void* d_out, int out_size, void* d_ws, size_t ws_size, hipStream_t stream) {
    static int grid = 0;
    if (grid == 0) {
        if (n_in != 24 || in_sizes[0] != NREAL * D || out_size != NREAL * D || ws_size < WS_END) {
            fprintf(stderr, "kernel_launch: unexpected problem (n_in %d, in0 %d, out %d, ws %zu < %zu); nothing launched\n", n_in, n_in > 0 ? in_sizes[0] : -1, out_size, ws_size, (size_t)WS_END); grid = -1; return; }
        int dev = 0, cus = 0, per_cu = 0; bool ok = true;
        if (hipGetDevice(&dev) != hipSuccess || hipDeviceGetAttribute(&cus, hipDeviceAttributeMultiprocessorCount, dev) != hipSuccess) { grid = -1; return; }
#if MK_ONE_LAUNCH
        ok = setup_kernel<KMASK[0]>(per_cu);
#else
        ok = setup_kernel<KMASK[0]>(per_cu) && setup_kernel<KMASK[1]>(per_cu) && setup_kernel<KMASK[2]>(per_cu);
#endif
        if (!ok) { fprintf(stderr, "kernel_launch: hipFuncSetAttribute failed\n"); grid = -1; return; }
        if (per_cu < 1) fprintf(stderr, "kernel_launch: occupancy query says %d\n", per_cu);
        grid = cus;
    }
    if (grid < 0) return;
    if (hipMemsetAsync((char*)d_ws + WS_CTL, 0, CTL_BYTES, stream) != hipSuccess) return;
    Params p{};
    for (int i = 0; i < 24; ++i) p.in[i] = (const float*)d_in[i];
    p.out = (float*)d_out; p.ws = (unsigned char*)d_ws;
#if MK_ONE_LAUNCH
    p.ph_lo = 0; p.ph_hi = N_PHASES;
    hipLaunchKernelGGL(hybrid_fwd<KMASK[0]>, dim3(grid), dim3(NTHREADS), LDS_BYTES, stream, p);
#else
    for (int k = 0; k < N_PHASES; ++k) { if (DBG_STOP > 0 && k >= DBG_STOP && k != N_PHASES - 1) continue; p.ph_lo = k; p.ph_hi = k + 1; const unsigned bit = 1u << phase_kind(k);
        if (KMASK[0] & bit) hipLaunchKernelGGL(hybrid_fwd<KMASK[0]>, dim3(grid), dim3(NTHREADS), LDS_BYTES, stream, p);
        else if (KMASK[1] & bit) hipLaunchKernelGGL(hybrid_fwd<KMASK[1]>, dim3(grid), dim3(NTHREADS), LDS_BYTES, stream, p);
        else hipLaunchKernelGGL(hybrid_fwd<KMASK[2]>, dim3(grid), dim3(NTHREADS), LDS_BYTES, stream, p); }
#endif
}
```

```cpp
#include <hip/hip_runtime.h>
#include <cstdio>
#include <cstdint>

#define LAS __attribute__((address_space(3)))
typedef unsigned short bf16_t;
typedef short bf16x8 __attribute__((ext_vector_type(8)));
typedef float f32x4 __attribute__((ext_vector_type(4)));
typedef float f32x2 __attribute__((ext_vector_type(2)));
typedef unsigned u32x4 __attribute__((ext_vector_type(4)));
typedef unsigned u32x2 __attribute__((ext_vector_type(2)));

constexpr int D = 1024, NREAL = 16384, MROWS = 16640, META_ROW0 = 16384 + 48, META_END = 16384 + 64;
constexpr int NSLOT = 257;
constexpr int LDP = 5632;
constexpr int PC_AQ = 0, PC_AF = 512, PC_AI = 1024, PC_AG = 1536, PC_BQKV = 2048, PC_BG = 3584, PC_CQ = 4096, PC_CK = 4352, PC_CV = 4608, PC_CG = 5120;
constexpr int IN_COLS = 8728;
constexpr int NTHREADS = 512, NWAVES = 8;
constexpr int XG_ROWS = 40960;

constexpr size_t MiB = 1ull << 20;
constexpr size_t WS_CTL = 0, CTL_BYTES = 1 * MiB;
constexpr int CW_BAR = 4096, CW_CNT = 1024;
constexpr size_t SM_SW1 = 1 * MiB;
constexpr size_t SM_RWG = SM_SW1 + 2 * 24 * 1024 * 4;
constexpr size_t SM_RWE = SM_RWG + 2 * 4 * 1024 * 4;
constexpr size_t SM_LAB = SM_RWE + 2 * 32 * 1024 * 4;
constexpr size_t SM_GK = SM_LAB + 2 * 2 * 512 * 4;
constexpr size_t SM_BETA = SM_GK + (size_t)MROWS * 16 * 4;
constexpr size_t SM_LOGA = SM_BETA + (size_t)MROWS * 4 * 4;
constexpr size_t SM_TOK = SM_LOGA + (size_t)MROWS * 4 * 4;
constexpr size_t SM_WROW = SM_TOK + (size_t)MROWS * 8 * 4;
constexpr size_t SM_DECA = SM_WROW + (size_t)XG_ROWS * 4;
constexpr size_t SM_DECC = SM_DECA + 1028 * 128 * 4;
constexpr size_t SM_DECB = SM_DECC + 1028 * 64 * 4;
constexpr size_t SM_HALO = SM_DECB + 8192;
constexpr size_t SM_END = SM_HALO + 260 * 3 * 1536 * 2;
static_assert(SM_END <= 8 * MiB, "small region");
constexpr size_t WS_HMETA = 8 * MiB;
constexpr size_t WS_WMIX = 9 * MiB;
constexpr size_t WS_WGATE = 20 * MiB;
constexpr size_t WS_WBT = 26 * MiB;
constexpr size_t WS_WOT = 29 * MiB;
constexpr size_t WS_O = 31 * MiB;
constexpr size_t O_STRIDE = (size_t)MROWS * 512 * 2;
constexpr size_t WS_W1T = 31 * MiB;
constexpr size_t WS_W2T = 63 * MiB;
constexpr size_t WS_U = 80 * MiB;
constexpr size_t WS_P = 113 * MiB;
constexpr size_t WS_GT = 113 * MiB;
constexpr size_t WS_MERGED = 211 * MiB;
constexpr size_t WS_XG = 113 * MiB;
constexpr size_t WS_HG = 193 * MiB;
constexpr size_t WS_Y2 = 213 * MiB;
constexpr size_t WS_SCA = 294 * MiB;
constexpr size_t WS_QKD = 303 * MiB;
constexpr size_t WS_SCC = 312 * MiB;
constexpr size_t WS_K1TB = 321 * MiB;
constexpr size_t WS_END = 338 * MiB;

constexpr int LDS_BYTES = 163840;
constexpr int LDS_MISC = LDS_BYTES - 512;
constexpr int LDS_TAB = LDS_BYTES - 1536;
constexpr int LDS_SCRATCH = LDS_TAB;

typedef __bf16 bf16x2v __attribute__((ext_vector_type(2)));
__device__ __forceinline__ unsigned pk2(float lo, float hi) { const f32x2 v = {lo, hi}; return __builtin_bit_cast(unsigned, __builtin_convertvector(v, bf16x2v)); }
__device__ __forceinline__ bf16_t f2bf(float f) { return (bf16_t)(pk2(f, 0.f) & 0xffffu); }
__device__ __forceinline__ float bf2f(bf16_t b) { return __uint_as_float(((unsigned)b) << 16); }
__device__ __forceinline__ float bflo(unsigned w) { return __uint_as_float(w << 16); }
__device__ __forceinline__ float bfhi(unsigned w) { return __uint_as_float(w & 0xffff0000u); }
__device__ __forceinline__ float sigmoidf_(float x) { return __builtin_amdgcn_rcpf(1.0f + __expf(-x)); }
__device__ __forceinline__ float siluf_(float x) { return x * __builtin_amdgcn_rcpf(1.0f + __expf(-x)); }
__device__ __forceinline__ float logsigf_(float x) { return fminf(x, 0.f) - __logf(1.0f + __expf(-fabsf(x))); }
__device__ __forceinline__ float softplusf_(float x) { return fmaxf(x, 0.f) + log1pf(__expf(-fabsf(x))); }
__device__ __forceinline__ bool row_valid(int r) { return r < NREAL || (r >= META_ROW0 && r < META_END); }
__device__ __forceinline__ float wave_sum(float v) {
#define DPP_ADD(ctrl, rmask) v += __int_as_float(__builtin_amdgcn_update_dpp(0, __float_as_int(v), (ctrl), (rmask), 0xf, false))
    DPP_ADD(0x111, 0xf); DPP_ADD(0x112, 0xf); DPP_ADD(0x114, 0xf); DPP_ADD(0x118, 0xf);
    DPP_ADD(0x142, 0xa); DPP_ADD(0x143, 0xc);
#undef DPP_ADD
    return __int_as_float(__builtin_amdgcn_readlane(__float_as_int(v), 63));
}
#define LDS_WAIT() asm volatile("s_waitcnt lgkmcnt(0)" ::: "memory")

#define XB_TMO      128
#define XB_XCNT(j)  (256  + 64 * (j))
#define XB_XSUB(j)  (1280 + 64 * (j))
#define XB_XGEN(j)  (2304 + 64 * (j))
#define XB_TOP      3328
#define XB_TOPGEN   3392
#define XCD_BAR_WORDS 3456
#define XB_SPIN_CAP (1u << 18)
__device__ __forceinline__ unsigned xb_ld(unsigned* p)              { return __hip_atomic_load(p, __ATOMIC_RELAXED, __HIP_MEMORY_SCOPE_AGENT); }
__device__ __forceinline__ unsigned xb_add(unsigned* p, unsigned v) { return __hip_atomic_fetch_add(p, v, __ATOMIC_RELAXED, __HIP_MEMORY_SCOPE_AGENT); }
__device__ __forceinline__ unsigned xb_xcc_id() { return (unsigned)__builtin_amdgcn_s_getreg((3 << 11) | 20) & 0xFu; }
#define XB_SPIN(cond, bar) do { unsigned _sp = 0; while (cond) { __builtin_amdgcn_s_sleep(1); \
    if ((++_sp & 255u) == 0u) { if (xb_ld(&(bar)[XB_TMO])) break; if (_sp > XB_SPIN_CAP) { atomicAdd(&(bar)[XB_TMO], 1u); break; } } } } while (0)
struct XcdBarrier { unsigned* bar; unsigned x; volatile LAS unsigned* st; };
__device__ __forceinline__ XcdBarrier xcd_barrier_post(unsigned* bar, volatile LAS unsigned* st) {
    XcdBarrier b; b.bar = bar; b.x = xb_xcc_id(); b.st = st;
    if (threadIdx.x == 0) (void)xb_add(&bar[XB_XCNT(b.x)], 1u);
    return b;
}
__device__ __forceinline__ void xcd_barrier_complete(unsigned* bar, unsigned x, unsigned& nloc, unsigned& nx, const unsigned G) {
    unsigned sum, cnt, mine, sp = 0u;
    for (;;) {
        sum = 0u; cnt = 0u; mine = 0u;
#pragma unroll
        for (unsigned j = 0; j < 16; ++j) { const unsigned c = xb_ld(&bar[XB_XCNT(j)]); sum += c; cnt += (c > 0u) ? 1u : 0u; mine = (j == x) ? c : mine; }
        if (sum == G) break;
        __builtin_amdgcn_s_sleep(1);
        if ((++sp & 255u) == 0u) { if (xb_ld(&bar[XB_TMO])) break; if (sp > XB_SPIN_CAP) { atomicAdd(&bar[XB_TMO], 1u); break; } }
    }
    nloc = mine > 0u ? mine : 1u; nx = cnt > 0u ? cnt : 1u;
}
__device__ __attribute__((noinline)) void xcd_barrier(unsigned* bar_, unsigned x_, volatile LAS unsigned* st_, int tid_, unsigned G_) {
    XcdBarrier b; b.bar = bar_; b.x = x_; b.st = st_;
    asm volatile("s_waitcnt vmcnt(0)" ::: "memory");
    __syncthreads();
    if (tid_ == 0) {
        unsigned* bar = b.bar;
        __builtin_amdgcn_s_waitcnt(0);
        unsigned nloc = b.st[0], nx = b.st[1];
        if (nloc == 0u) { xcd_barrier_complete(bar, b.x, nloc, nx, G_); b.st[0] = nloc; b.st[1] = nx; }
        const unsigned old = xb_add(&bar[XB_XSUB(b.x)], 1u);
        const unsigned gen = old / nloc;
        if (old + 1u == (gen + 1u) * nloc) {
            __builtin_amdgcn_fence(__ATOMIC_RELEASE, "agent");
            asm volatile("s_waitcnt vmcnt(0)" ::: "memory");
            const unsigned og = xb_add(&bar[XB_TOP], 1u);
            const unsigned tg = og / nx;
            if (og + 1u == (tg + 1u) * nx) xb_add(&bar[XB_TOPGEN], 1u);
            else XB_SPIN(xb_ld(&bar[XB_TOPGEN]) == tg, bar);
            __builtin_amdgcn_fence(__ATOMIC_ACQUIRE, "agent");
            xb_add(&bar[XB_XGEN(b.x)], 1u);
            asm volatile("s_waitcnt vmcnt(0)" ::: "memory");
        } else {
            XB_SPIN(xb_ld(&bar[XB_XGEN(b.x)]) == gen, bar);
            __builtin_amdgcn_fence(__ATOMIC_ACQUIRE, "agent");
            asm volatile("s_waitcnt vmcnt(0)" ::: "memory");
        }
    }
    __syncthreads();
}
namespace pg8 {
constexpr int BM = 256, BK = 64, HALF = 128, HTB = HALF * BK * 2, STAGE_BYTES = 8 * HTB, NXCD = 8, WGM = 8;
__host__ __device__ __forceinline__ int lds_byte(int r, int c) { const int st = (r >> 4) * 2 + (c >> 5), rr = r & 15, cc = c & 31, ob = rr * 64 + cc * 2; return st * 1024 + (ob ^ (((ob >> 9) & 1) << 5)); }
__host__ __device__ __forceinline__ void stage_rc(int b, int& R, int& C) { const int st = b / 1024, sb = b % 1024, swz = sb ^ (((sb >> 9) & 1) << 5); R = (st >> 1) * 16 + swz / 64; C = (st & 1) * 32 + (swz % 64) / 2; }
__host__ __device__ __forceinline__ int perm32(int rho) { const int n = rho >> 4, i = rho & 15; return 8 * (i >> 2) + 4 * n + (i & 3); }

struct Unit { int pm, pn, ex; };
struct Gemm { const bf16_t* A; const bf16_t* Bt; int M, N, K; };

struct StaticOrder {
    int nM, nN, nwg, G, c;
    __device__ void init(int M, int N, int G_, int c_) { nM = M / BM; nN = N / BM; nwg = nM * nN; G = G_; c = c_; }
    __device__ bool next(int i, Unit& u) const {
        const long L = (long)i * G + c; if (L >= nwg) return false;
        int wgid = (int)L; { const int q = nwg / NXCD, r = nwg % NXCD, xcd = wgid % NXCD, off = wgid / NXCD; wgid = (xcd < r ? xcd * (q + 1) : r * (q + 1) + (xcd - r) * q) + off; }
        const int nig = WGM * nN, gid = wgid / nig, fm = gid * WGM, gsz = (nM - fm) < WGM ? (nM - fm) : WGM;
        u.pm = fm + ((wgid % nig) % gsz); u.pn = (wgid % nig) / gsz; u.ex = 0; return true;
    }
    __device__ __forceinline__ void ptrs(const Gemm& g, const Unit& u, const char*& a, const char*& b) const {
        const size_t tstep = (size_t)BM * g.K * 2; a = (const char*)g.A + (size_t)u.pm * tstep; b = (const char*)g.Bt + (size_t)u.pn * tstep; }
};
struct MoeOrder {
    int G, c, npn, ntiles; const LAS unsigned char* tab; size_t estride;
    __device__ bool next(int i, Unit& u) const {
        const long L = (long)i * G + c; if (L >= (long)ntiles * npn) return false;
        u.pm = (int)(L / npn); u.pn = (int)(L % npn); u.ex = (int)tab[u.pm]; return true;
    }
    __device__ __forceinline__ void ptrs(const Gemm& g, const Unit& u, const char*& a, const char*& b) const {
        const size_t tstep = (size_t)BM * g.K * 2; a = (const char*)g.A + (size_t)u.pm * tstep; b = (const char*)g.Bt + (size_t)u.ex * estride + (size_t)u.pn * tstep; }
};

template <class Epi, class Sched>
__device__ __forceinline__ void gemm_phase(LAS unsigned char* lds, const int tid, const Gemm g, const Sched& S, const Epi& E) {
    const int wid = __builtin_amdgcn_readfirstlane(tid >> 6), lane = tid & 63, wr = wid >> 2, wc = wid & 3, fr = lane & 15, fq = lane >> 4;
    int K = g.K; asm volatile("" : "+s"(K));
    const int nt = K / BK;
    unsigned voffA[2], voffB[2];
#pragma unroll
    for (int i = 0; i < 2; ++i) { int R, C; stage_rc(tid * 16 + i * 8192, R, C); const int Rb = Epi::PERM ? ((R & ~31) + perm32(R & 31)) : R;
        voffA[i] = (unsigned)(R * K + C) * 2u; voffB[i] = (unsigned)(Rb * K + C) * 2u; }
    const size_t kstep = (size_t)(BK * 2);
    const size_t hstep = (size_t)HALF * K * 2;
    const unsigned ldsw = (unsigned)wid * 1024u;
    const int aoff = lds_byte(wr * 64 + fr, fq * 8), boff = lds_byte(wc * 32 + fr, fq * 8);
#define PG8_SA(b, h) (((b) * 2 + (h)) * HTB)
#define PG8_SB(b, h) ((4 + (b) * 2 + (h)) * HTB)
#define PG8_STAGE(bufoff, gbase, voff) do { _Pragma("unroll") for (int _i = 0; _i < 2; ++_i) \
        __builtin_amdgcn_global_load_lds((const unsigned*)((const char*)(gbase) + (voff)[_i]), (LAS unsigned*)(lds + (bufoff) + ldsw + _i * 8192), 16, 0, 0); } while (0)
#define PG8_LDA(dst, b, h) do { _Pragma("unroll") for (int m = 0; m < 4; ++m) _Pragma("unroll") for (int k = 0; k < 2; ++k) dst[m][k] = *(const LAS bf16x8*)(lds + PG8_SA(b, h) + aoff + m * 2048 + k * 1024); } while (0)
#define PG8_LDB(dst, b, h) do { _Pragma("unroll") for (int n = 0; n < 2; ++n) _Pragma("unroll") for (int k = 0; k < 2; ++k) dst[n][k] = *(const LAS bf16x8*)(lds + PG8_SB(b, h) + boff + n * 2048 + k * 1024); } while (0)
#define PG8_MMA(ai, bj, At, Bt) do { __builtin_amdgcn_s_setprio(1); _Pragma("unroll") for (int m = 0; m < 4; ++m) _Pragma("unroll") for (int n = 0; n < 2; ++n) _Pragma("unroll") for (int k = 0; k < 2; ++k) \
        acc[ai][bj][m][n] = __builtin_amdgcn_mfma_f32_16x16x32_bf16(Bt[n][k], At[m][k], acc[ai][bj][m][n], 0, 0, 0); __builtin_amdgcn_s_setprio(0); } while (0)
#define PG8_WAIT_V(n) asm volatile("s_waitcnt vmcnt(" #n ")" ::: "memory")
#define PG8_WAIT_L(n) asm volatile("s_waitcnt lgkmcnt(" #n ")" ::: "memory")
#define PG8_BAR __builtin_amdgcn_s_barrier()
#define PG8_SCHED __builtin_amdgcn_sched_barrier(0)
    Unit cur, nxt; int ui = 0;
    if (!S.next(0, cur)) return;
    f32x4 acc[2][2][4][2];
#pragma unroll
    for (int a = 0; a < 2; ++a)
#pragma unroll
        for (int b = 0; b < 2; ++b)
#pragma unroll
            for (int m = 0; m < 4; ++m)
#pragma unroll
                for (int n = 0; n < 2; ++n) acc[a][b][m][n] = (f32x4){0.f, 0.f, 0.f, 0.f};
    bf16x8 At[4][2], B0[2][2], B1[2][2];
    const char* cA; const char* cB; S.ptrs(g, cur, cA, cB);
    PG8_STAGE(PG8_SB(0, 0), cB, voffB); PG8_STAGE(PG8_SA(0, 0), cA, voffA); PG8_STAGE(PG8_SB(0, 1), cB + hstep, voffB); PG8_STAGE(PG8_SA(0, 1), cA + hstep, voffA);
    if (wr == 1) PG8_BAR;
    PG8_WAIT_V(4); PG8_BAR;
    PG8_STAGE(PG8_SB(1, 0), cB + kstep, voffB); PG8_STAGE(PG8_SA(1, 0), cA + kstep, voffA); PG8_STAGE(PG8_SB(1, 1), cB + hstep + kstep, voffB);
    PG8_WAIT_V(6); PG8_BAR;
    for (;;) {
        const bool has_next = S.next(ui + 1, nxt);
        const char* nA = cA; const char* nB = cB; if (has_next) S.ptrs(g, nxt, nA, nB);
        for (int t = 0; t < nt; t += 2) {
            const bool last = (t == nt - 2);
            const char* a1 = cA + (size_t)(t + 1) * kstep;
            const char* a2 = last ? nA : cA + (size_t)(t + 2) * kstep; const char* b2 = last ? nB : cB + (size_t)(t + 2) * kstep;
            const char* a3 = a2 + kstep; const char* b3 = b2 + kstep;
            PG8_LDB(B0, 0, 0); PG8_SCHED; PG8_LDA(At, 0, 0); PG8_STAGE(PG8_SA(1, 1), a1 + hstep, voffA);
            PG8_WAIT_L(8); PG8_BAR; PG8_WAIT_L(0); PG8_MMA(0, 0, At, B0); PG8_BAR; PG8_SCHED;
            PG8_LDB(B1, 0, 1); PG8_STAGE(PG8_SB(0, 0), b2, voffB);
            PG8_BAR; PG8_WAIT_L(0); PG8_MMA(0, 1, At, B1); PG8_BAR;
            PG8_LDA(At, 0, 1); PG8_STAGE(PG8_SA(0, 0), a2, voffA);
            PG8_BAR; PG8_WAIT_L(0); PG8_MMA(1, 0, At, B0); PG8_BAR; PG8_SCHED;
            PG8_STAGE(PG8_SB(0, 1), b2 + hstep, voffB);
            PG8_WAIT_V(6); PG8_BAR; PG8_MMA(1, 1, At, B1); PG8_BAR;
            PG8_LDB(B0, 1, 0); PG8_SCHED; PG8_LDA(At, 1, 0); PG8_STAGE(PG8_SA(0, 1), a2 + hstep, voffA);
            PG8_WAIT_L(8); PG8_BAR; PG8_WAIT_L(0); PG8_MMA(0, 0, At, B0); PG8_BAR; PG8_SCHED;
            PG8_LDB(B1, 1, 1); PG8_STAGE(PG8_SB(1, 0), b3, voffB);
            PG8_BAR; PG8_WAIT_L(0); PG8_MMA(0, 1, At, B1); PG8_BAR;
            PG8_LDA(At, 1, 1); PG8_STAGE(PG8_SA(1, 0), a3, voffA);
            PG8_BAR; PG8_WAIT_L(0); PG8_MMA(1, 0, At, B0); PG8_BAR; PG8_SCHED;
            PG8_STAGE(PG8_SB(1, 1), b3 + hstep, voffB);
            PG8_WAIT_V(6); PG8_BAR; PG8_MMA(1, 1, At, B1); PG8_BAR;
        }
        E(acc, cur, wr, wc, fr, fq);
        if (!has_next) break;
#pragma unroll
        for (int a = 0; a < 2; ++a)
#pragma unroll
            for (int b = 0; b < 2; ++b)
#pragma unroll
                for (int m = 0; m < 4; ++m)
#pragma unroll
                    for (int n = 0; n < 2; ++n) acc[a][b][m][n] = (f32x4){0.f, 0.f, 0.f, 0.f};
        cur = nxt; cA = nA; cB = nB; ++ui;
    }
    PG8_WAIT_V(0);
    if (wr == 0) PG8_BAR;
    PG8_BAR;
#undef PG8_SA
#undef PG8_SB
#undef PG8_STAGE
#undef PG8_LDA
#undef PG8_LDB
#undef PG8_MMA
#undef PG8_WAIT_V
#undef PG8_WAIT_L
#undef PG8_BAR
#undef PG8_SCHED
}

#define EPI_PERM_LOOP(...) \
    _Pragma("unroll") for (int ai = 0; ai < 2; ++ai) _Pragma("unroll") for (int m = 0; m < 4; ++m) { const int row = u.pm * BM + ai * HALF + wr * 64 + m * 16 + fr; \
        _Pragma("unroll") for (int bj = 0; bj < 2; ++bj) { const int col0 = u.pn * BM + bj * HALF + wc * 32 + 8 * fq; f32x4 v0 = acc[ai][bj][m][0], v1 = acc[ai][bj][m][1]; __VA_ARGS__ } if (EPI_PIN) __builtin_amdgcn_sched_barrier(0); }

struct EpiInProj {
    static constexpr bool PERM = true, EPI_PIN = true;
    bf16_t* P; bf16_t* halo;
    __device__ __forceinline__ void operator()(const f32x4 (&acc)[2][2][4][2], const Unit& u, int wr, int wc, int fr, int fq) const {
        const bool is_qkv = u.pn >= 8 && u.pn < 14;
        EPI_PERM_LOOP({
            u32x4 w; w.x = pk2(v0[0], v0[1]); w.y = pk2(v0[2], v0[3]); w.z = pk2(v1[0], v1[1]); w.w = pk2(v1[2], v1[3]);
            *(u32x4*)(P + (size_t)row * LDP + col0) = w;
            if (is_qkv && (row & 63) >= 61) *(u32x4*)(halo + ((size_t)(row >> 6) * 3 + ((row & 63) - 61)) * 1536 + (col0 - PC_BQKV)) = w;
        })
    }
};
__device__ __forceinline__ float lfg(float a, float lb1, float x) { const float b = lb1 + logsigf_(x), mx = fmaxf(a, b); return mx + __logf(__expf(a - mx) + __expf(b - mx)); }
struct EpiSigmoid {
    static constexpr bool PERM = true, EPI_PIN = true;
    bf16_t* O; int ldc;
    __device__ __forceinline__ void operator()(const f32x4 (&acc)[2][2][4][2], const Unit& u, int wr, int wc, int fr, int fq) const {
        EPI_PERM_LOOP({
            u32x4 w; w.x = pk2(sigmoidf_(v0[0]), sigmoidf_(v0[1])); w.y = pk2(sigmoidf_(v0[2]), sigmoidf_(v0[3])); w.z = pk2(sigmoidf_(v1[0]), sigmoidf_(v1[1])); w.w = pk2(sigmoidf_(v1[2]), sigmoidf_(v1[3]));
            *(u32x4*)(O + (size_t)row * ldc + col0) = w;
        })
    }
};
struct EpiBranch {
    static constexpr bool PERM = true, EPI_PIN = false;
    bf16_t* merged; const bf16_t* gt; int n;
    __device__ __forceinline__ void operator()(const f32x4 (&acc)[2][2][4][2], const Unit& u, int wr, int wc, int fr, int fq) const {
        EPI_PERM_LOOP({
            const u32x4 gw = *(const u32x4*)(gt + (size_t)row * 3072 + n * 1024 + col0);
            float x[8] = {v0[0] * bflo(gw.x), v0[1] * bfhi(gw.x), v0[2] * bflo(gw.y), v0[3] * bfhi(gw.y), v1[0] * bflo(gw.z), v1[1] * bfhi(gw.z), v1[2] * bflo(gw.w), v1[3] * bfhi(gw.w)};
            bf16_t* mp = merged + (size_t)row * 1024 + col0;
            if (n != 0) { const u32x4 o = *(const u32x4*)mp; x[0] += bflo(o.x); x[1] += bfhi(o.x); x[2] += bflo(o.y); x[3] += bfhi(o.y); x[4] += bflo(o.z); x[5] += bfhi(o.z); x[6] += bflo(o.w); x[7] += bfhi(o.w); }
            u32x4 w; w.x = pk2(x[0], x[1]); w.y = pk2(x[2], x[3]); w.z = pk2(x[4], x[5]); w.w = pk2(x[6], x[7]);
            *(u32x4*)mp = w;
        })
    }
};
struct EpiResidual {
    static constexpr bool PERM = false;
    float* hreal; float* hmeta;
    __device__ __forceinline__ void operator()(const f32x4 (&acc)[2][2][4][2], const Unit& u, int wr, int wc, int fr, int fq) const {
#pragma unroll
        for (int ai = 0; ai < 2; ++ai)
#pragma unroll
            for (int m = 0; m < 4; ++m) { const int row = u.pm * BM + ai * HALF + wr * 64 + m * 16 + fr;
                float* rowp = (row < NREAL ? hreal + (size_t)row * D : hmeta + (size_t)(row - NREAL) * D) + u.pn * BM + wc * 32 + 4 * fq;
#pragma unroll
                for (int bj = 0; bj < 2; ++bj)
#pragma unroll
                    for (int n = 0; n < 2; ++n) { f32x4* p = (f32x4*)(rowp + bj * HALF + n * 16); *p = *p + acc[ai][bj][m][n]; } }
    }
};
struct EpiMoeUp {
    static constexpr bool PERM = true, EPI_PIN = true;
    bf16_t* H;
    __device__ __forceinline__ void operator()(const f32x4 (&acc)[2][2][4][2], const Unit& u, int wr, int wc, int fr, int fq) const {
        EPI_PERM_LOOP({
            const int hc = col0 >> 1;
            u32x2 w; w.x = pk2(siluf_(v0[0]) * v1[0], siluf_(v0[1]) * v1[1]); w.y = pk2(siluf_(v0[2]) * v1[2], siluf_(v0[3]) * v1[3]);
            *(u32x2*)(H + (size_t)row * 256 + hc) = w;
        })
    }
};
struct EpiMoeDown {
    static constexpr bool PERM = true, EPI_PIN = false;
    bf16_t* Y; const float* wrow;
    __device__ __forceinline__ void operator()(const f32x4 (&acc)[2][2][4][2], const Unit& u, int wr, int wc, int fr, int fq) const {
        EPI_PERM_LOOP({
            const float s = wrow[row];
            u32x4 w; w.x = pk2(v0[0] * s, v0[1] * s); w.y = pk2(v0[2] * s, v0[3] * s); w.z = pk2(v1[0] * s, v1[1] * s); w.w = pk2(v1[2] * s, v1[3] * s);
            *(u32x4*)(Y + (size_t)row * 1024 + col0) = w;
        })
    }
};
}
#define GAS __attribute__((address_space(1)))
struct Params { const float* in[24]; float* out; unsigned char* ws; int ph_lo, ph_hi; };
struct Frame {
    LAS unsigned char* lds; int tid, lane, wave, G, bid;
    __attribute__((address_space(1))) float* out; __attribute__((address_space(1))) unsigned char* ws; const float* const __attribute__((address_space(4)))* inp; int dry;
};
#define PHASE_FENCE(F) do { asm volatile("" : "+s"((F).ws), "+s"((F).out), "+s"((F).inp), "+v"((F).tid), "+s"((F).bid), "+s"((F).G)); \
    (F).lane = (F).tid & 63; (F).wave = __builtin_amdgcn_readfirstlane((F).tid >> 6); } while (0)
__device__ __forceinline__ const float* inp_ptr(const float* const __attribute__((address_space(4)))* inp, int i) { GAS const float* q = (GAS const float*)inp[i]; asm volatile("" : "+s"(q)); return (const float*)q; }
#define INP(i) inp_ptr(F.inp, (i))
#define WSP(T, off) ((T*)(GAS T*)(F.ws + (off)))
enum { I_X = 0, I_META, I_NORM_MIX, I_W_IN, I_LB, I_HGRN_NORM, I_GDN_CONV, I_GDN_ALOG, I_GDN_DT, I_GDN_NORM, I_GLA_W2, I_GLA_B, I_GLA_NORM, I_W_BRANCH, I_W_OUT, I_NORM_FFN,
       I_RG_W, I_RG_B, I_RE_W, I_RE_B, I_EW_GATE, I_EW_UP, I_EW_DOWN, I_NORM_FINAL };

__device__ __forceinline__ void transpose_item(const float* W, int ldw, int K, int nblk, bf16_t* WT, int row_off, int rowmode, LAS float* scr, int item, int lane) {
    const int kb = item / nblk, nb = item % nblk, k0 = 64 * kb, n0 = 32 * nb;
#pragma unroll 8
    for (int i = 0; i < 32; ++i) { const int kk = 2 * i + (lane >> 5); scr[kk * 33 + (lane & 31)] = W[(size_t)(k0 + kk) * ldw + n0 + (lane & 31)]; }
    LDS_WAIT(); asm volatile("" ::: "memory");
    const int c = lane & 7;
#pragma unroll
    for (int j = 0; j < 4; ++j) { const int n = (lane >> 3) + 8 * j; const LAS float* s = scr + (8 * c) * 33 + n;
        u32x4 o; o.x = pk2(s[0 * 33], s[1 * 33]); o.y = pk2(s[2 * 33], s[3 * 33]); o.z = pk2(s[4 * 33], s[5 * 33]); o.w = pk2(s[6 * 33], s[7 * 33]);
        const int nn = n0 + n; const int wrow = rowmode == 0 ? row_off + nn : row_off + 8 * (nn >> 2) + (nn & 3) + (rowmode == 2 ? 4 : 0);
        *(u32x4*)(WT + (size_t)wrow * K + k0 + 8 * c) = o; }
    LDS_WAIT(); asm volatile("" ::: "memory");
}

__device__ __forceinline__ void phase_pre(Frame& F) {
    const int gt = F.bid * NTHREADS + F.tid, NT = F.G * NTHREADS;
    float* sw1 = WSP(float, SM_SW1); float* rwg = WSP(float, SM_RWG); float* rwe = WSP(float, SM_RWE); float* lab = WSP(float, SM_LAB);
    for (int i = gt; i < 2 * 24 * 1024; i += NT) { const int l = i / (24 * 1024), c = (i / 1024) % 24, k = i % 1024;
        const int col = c < 16 ? 5128 + c : (c < 20 ? 3584 + (c - 16) : 3588 + (c - 20));
        sw1[i] = INP(I_W_IN)[((size_t)l * 1024 + k) * IN_COLS + col]; }
    for (int i = gt; i < 2 * 4 * 1024; i += NT) { const int l = i / (4 * 1024), c = (i / 1024) % 4, k = i % 1024; rwg[i] = INP(I_RG_W)[((size_t)l * 1024 + k) * 4 + c]; }
    for (int i = gt; i < 2 * 32 * 1024; i += NT) { const int l = i / (32 * 1024), c = (i / 1024) % 32, k = i % 1024; rwe[i] = INP(I_RE_W)[((size_t)l * 1024 + k) * 32 + c]; }
    for (int i = gt; i < 2 * 512; i += NT) { const int l = i / 512, c = i % 512; const float l0 = INP(I_LB)[c], l1 = INP(I_LB)[512 + c];
        const float p1 = 1.0f / (1.0f + expf(l0 - l1)); const float lb = l == 0 ? 0.f : p1;
        lab[l * 1024 + c] = logf(fmaxf(lb, 1e-30f)); lab[l * 1024 + 512 + c] = log1pf(-lb); }
}

__device__ __forceinline__ void convert_layer_weights(Frame& F, int l) {
    LAS float* scr = (LAS float*)(F.lds + F.wave * 16384);
    const int gw = F.bid * NWAVES + F.wave, NGW = F.G * NWAVES;
    const float* win = INP(I_W_IN) + (size_t)l * 1024 * IN_COLS;
    constexpr int I_MIX = 16 * 176, I_GATE = 16 * 96, I_BR = 8 * 32, I_OUT = 16 * 32, NITEMS = I_MIX + I_GATE + 3 * I_BR + I_OUT;
    for (int it = gw; it < NITEMS; it += NGW) {
        int r = it;
        if (r < I_MIX) { const int nb = r % 176, n0 = 32 * nb; const int shift = n0 < 3584 ? 0 : (n0 < 5120 ? 8 : 24);
            transpose_item(win + shift, IN_COLS, 1024, 176, WSP(bf16_t, WS_WMIX), 0, 0, scr, r, F.lane); continue; } r -= I_MIX;
        if (r < I_GATE) { transpose_item(win + 5656, IN_COLS, 1024, 96, WSP(bf16_t, WS_WGATE), 0, 0, scr, r, F.lane); continue; } r -= I_GATE;
        if (r < 3 * I_BR) { const int n = r / I_BR; transpose_item(INP(I_W_BRANCH) + ((size_t)l * 3 + n) * 512 * 1024, 1024, 512, 32, WSP(bf16_t, WS_WBT) + (size_t)n * 1024 * 512, 0, 0, scr, r % I_BR, F.lane); continue; } r -= 3 * I_BR;
        transpose_item(INP(I_W_OUT) + (size_t)l * 1024 * 1024, 1024, 1024, 32, WSP(bf16_t, WS_WOT), 0, 0, scr, r, F.lane);
    }
}
__device__ __forceinline__ void convert_expert_weights(Frame& F, int l) {
    LAS float* scr = (LAS float*)(F.lds + F.wave * 16384);
    const int gw = F.bid * NWAVES + F.wave, NGW = F.G * NWAVES;
    constexpr int I_G = 16 * 8, I_D = 4 * 32, PER = 2 * I_G + I_D;
    for (int it = gw; it < 32 * PER; it += NGW) {
        const int e = it / PER; int r = it % PER;
        bf16_t* w1t = WSP(bf16_t, WS_W1T) + (size_t)e * 512 * 1024; bf16_t* w2t = WSP(bf16_t, WS_W2T) + (size_t)e * 1024 * 256;
        if (r < I_G) { transpose_item(INP(I_EW_GATE) + ((size_t)l * 32 + e) * 1024 * 256, 256, 1024, 8, w1t, 0, 1, scr, r, F.lane); continue; } r -= I_G;
        if (r < I_G) { transpose_item(INP(I_EW_UP) + ((size_t)l * 32 + e) * 1024 * 256, 256, 1024, 8, w1t, 0, 2, scr, r, F.lane); continue; } r -= I_G;
        transpose_item(INP(I_EW_DOWN) + ((size_t)l * 32 + e) * 256 * 1024, 1024, 256, 32, w2t, 0, 0, scr, r, F.lane);
    }
}

#define OUTP ((float*)F.out)
__device__ __forceinline__ float* hrow(Frame& F, int r) { return r < NREAL ? OUTP + (size_t)r * D : WSP(float, WS_HMETA) + (size_t)(r - NREAL) * D; }

__device__ __forceinline__ void load_row16(const float* p, int lane, float (&x)[16]) {
#pragma unroll
    for (int j = 0; j < 4; ++j) { const f32x4 v = *((const f32x4*)p + lane + 64 * j); x[4 * j] = v[0]; x[4 * j + 1] = v[1]; x[4 * j + 2] = v[2]; x[4 * j + 3] = v[3]; }
}
__device__ __forceinline__ void add_bf16_row16(const bf16_t* p, int lane, float (&x)[16]) {
#pragma unroll
    for (int j = 0; j < 4; ++j) { const u32x2 w = *((const u32x2*)p + lane + 64 * j); x[4 * j] += bflo(w.x); x[4 * j + 1] += bfhi(w.x); x[4 * j + 2] += bflo(w.y); x[4 * j + 3] += bfhi(w.y); }
}
__device__ __forceinline__ void store_row16(float* p, int lane, const float (&x)[16]) {
#pragma unroll
    for (int j = 0; j < 4; ++j) *((f32x4*)p + lane + 64 * j) = (f32x4){x[4 * j], x[4 * j + 1], x[4 * j + 2], x[4 * j + 3]};
}
__device__ __forceinline__ void store_bf16_row16(bf16_t* p, int lane, const float (&x)[16]) {
#pragma unroll
    for (int j = 0; j < 4; ++j) { u32x2 w; w.x = pk2(x[4 * j], x[4 * j + 1]); w.y = pk2(x[4 * j + 2], x[4 * j + 3]); *((u32x2*)p + lane + 64 * j) = w; }
}
__device__ __forceinline__ void fetch_h_row(Frame& F, int l, int r, float (&x)[16]) {
    if (l == 0) {
        const float* src = r < NREAL ? INP(I_X) + (size_t)r * D : INP(I_META) + (size_t)(r - META_ROW0) * D;
        load_row16(src, F.lane, x);
    } else {
        load_row16(hrow(F, r), F.lane, x);
        const unsigned* tok = WSP(unsigned, SM_TOK) + (size_t)r * 8;
        const unsigned g0 = tok[6], g1 = tok[7];
        add_bf16_row16(WSP(bf16_t, WS_Y2) + (size_t)g0 * 1024, F.lane, x);
        add_bf16_row16(WSP(bf16_t, WS_Y2) + (size_t)g1 * 1024, F.lane, x);
    }
}

__device__ __forceinline__ void phase_norm1(Frame& F, int l) {
    convert_layer_weights(F, l);
    __syncthreads();
    LAS float* sw = (LAS float*)F.lds;
    { const float* src = WSP(float, SM_SW1) + (size_t)l * 24 * 1024; for (int i = F.tid; i < 24 * 1024 / 4; i += NTHREADS) ((LAS f32x4*)sw)[i] = ((const f32x4*)src)[i]; }
    __syncthreads();
    const int gw = F.bid * NWAVES + F.wave, NGW = F.G * NWAVES, lane = F.lane;
    const float* nw = INP(I_NORM_MIX) + (size_t)l * D;
    float wv[16]; load_row16(nw, lane, wv);
    bf16_t* U = WSP(bf16_t, WS_U);
    const float alog_l = (lane >= 20 && lane < 24) ? INP(I_GDN_ALOG)[l * 4 + (lane - 20)] : 0.f, dt_l = (lane >= 20 && lane < 24) ? INP(I_GDN_DT)[l * 4 + (lane - 20)] : 0.f;
    const float nega_l = -expf(alog_l);
    for (int g = gw; g < MROWS / 4; g += NGW) {
        const int r0 = 4 * g;
        if (!row_valid(r0)) {
            float z[16];
#pragma unroll
            for (int j = 0; j < 16; ++j) z[j] = 0.f;
#pragma unroll
            for (int i = 0; i < 4; ++i) { store_bf16_row16(U + (size_t)(r0 + i) * D, lane, z); if (l == 0) store_row16(hrow(F, r0 + i), lane, z);
                if (lane < 16) WSP(float, SM_GK)[(size_t)(r0 + i) * 16 + lane] = 0.f;
                else if (lane < 20) WSP(float, SM_BETA)[(size_t)(r0 + i) * 4 + (lane - 16)] = 0.f;
                else if (lane < 24) WSP(float, SM_LOGA)[(size_t)(r0 + i) * 4 + (lane - 20)] = 0.f; }
            continue;
        }
        float x[4][16];
#pragma unroll
        for (int i = 0; i < 4; ++i) {
            fetch_h_row(F, l, r0 + i, x[i]);
            store_row16(hrow(F, r0 + i), lane, x[i]);
            float ss = 0.f;
#pragma unroll
            for (int j = 0; j < 16; ++j) ss += x[i][j] * x[i][j];
            const float rstd = rsqrtf(wave_sum(ss) * (1.0f / D) + 1e-6f);
#pragma unroll
            for (int j = 0; j < 16; ++j) x[i][j] = x[i][j] * rstd * wv[j];
            store_bf16_row16(U + (size_t)(r0 + i) * D, lane, x[i]);
        }
        float ov[4] = {0.f, 0.f, 0.f, 0.f};
#pragma unroll 2
        for (int c = 0; c < 24; ++c) {
            float a0 = 0.f, a1 = 0.f, a2 = 0.f, a3 = 0.f;
#pragma unroll
            for (int j = 0; j < 4; ++j) { const f32x4 w = *((const LAS f32x4*)(sw + c * 1024) + lane + 64 * j);
#pragma unroll
                for (int e = 0; e < 4; ++e) { a0 += x[0][4 * j + e] * w[e]; a1 += x[1][4 * j + e] * w[e]; a2 += x[2][4 * j + e] * w[e]; a3 += x[3][4 * j + e] * w[e]; } }
            a0 = wave_sum(a0); a1 = wave_sum(a1); a2 = wave_sum(a2); a3 = wave_sum(a3);
            if (lane == c) { ov[0] = a0; ov[1] = a1; ov[2] = a2; ov[3] = a3; }
        }
        float* GK = WSP(float, SM_GK); float* BETA = WSP(float, SM_BETA); float* LOGA = WSP(float, SM_LOGA);
#pragma unroll
        for (int i = 0; i < 4; ++i) {
            const float v = ov[i]; const int r = r0 + i;
            if (lane < 16) GK[(size_t)r * 16 + lane] = v;
            else if (lane < 20) BETA[(size_t)r * 4 + (lane - 16)] = sigmoidf_(v);
            else if (lane < 24) { const int h = lane - 20; LOGA[(size_t)r * 4 + h] = nega_l * softplusf_(v + dt_l); }
        }
    }
}

__device__ __forceinline__ bf16x8 mk8(u32x4 w) { return __builtin_bit_cast(bf16x8, w); }
__device__ __forceinline__ bf16x8 mk8(u32x2 lo, u32x2 hi) { u32x4 w; w.x = lo.x; w.y = lo.y; w.z = hi.x; w.w = hi.y; return __builtin_bit_cast(bf16x8, w); }
__device__ __forceinline__ bf16x8 pack_acc2(const f32x4& a, const f32x4& b) { u32x4 w; w.x = pk2(a[0], a[1]); w.y = pk2(a[2], a[3]); w.z = pk2(b[0], b[1]); w.w = pk2(b[2], b[3]); return __builtin_bit_cast(bf16x8, w); }
#define MFMA16(a, b, c) __builtin_amdgcn_mfma_f32_16x16x32_bf16((a), (b), (c), 0, 0, 0)

__device__ __forceinline__ int permpos(int k) { const int kk = k & 31; return (k & ~31) + ((kk & 16) ? 8 * ((kk - 16) >> 2) + 4 + (kk & 3) : 8 * (kk >> 2) + (kk & 3)); }
__device__ __forceinline__ float ldbf(GAS const bf16_t* p) { return bf2f(*p); }
#define ROWB(P, row, col) ((GAS const char*)(P) + ((size_t)(row) * LDP + (col)) * 2)
__device__ __forceinline__ float ldrow(GAS const char* rb, unsigned voff) { return bf2f(*(GAS const bf16_t*)(rb + voff)); }
__device__ __forceinline__ unsigned ldrow_u(GAS const char* rb, unsigned voff) { return (unsigned)*(GAS const bf16_t*)(rb + voff); }
__device__ __forceinline__ void strow(GAS const char* rb, unsigned voff, bf16_t v) { *(GAS bf16_t*)(rb + voff) = v; }

template <int DK, bool IS_A>
__device__ __forceinline__ void prep_gla(Frame& F, int l, int ug) {
    constexpr int QP = DK + 8, SUB = 2 * 64 * QP * 2 + 1024;
    int tid = F.tid; asm volatile("" : "+v"(tid));
    const int sg = __builtin_amdgcn_readfirstlane(tid >> 8), lt = tid & 255, c = lt & 127, hf = __builtin_amdgcn_readfirstlane(lt >> 7);
    const int unit = 2 * ug + sg, slot = unit >> 2, h = unit & 3, row0 = slot * 64, r0 = row0 + 32 * hf;
    const int qcol = IS_A ? PC_AQ + h * 128 : PC_CQ + h * 64, kcol = IS_A ? PC_AF + h * 128 : PC_CK + h * 64, vcol = IS_A ? PC_AI + h * 128 : PC_CV + h * 128;
    bf16_t* P = WSP(bf16_t, WS_P);
    LAS bf16_t* qt = (LAS bf16_t*)(F.lds + sg * SUB);
    LAS bf16_t* kt = qt + 64 * QP;
    LAS float* tot = (LAS float*)(kt + 64 * QP);
    const bool act = c < DK;
    float b[32];
    const unsigned vo = (unsigned)c * 2u, vop = (unsigned)permpos(c) * 2u;
    if (act) {
        float run = 0.f;
        if (IS_A) { const float* lab = WSP(float, SM_LAB) + l * 1024 + h * 128 + c; const float la = lab[0], lb = lab[512];
#pragma unroll
            for (int t = 0; t < 32; ++t) { run += pg8::lfg(la, lb, ldrow(ROWB(P, r0 + t, kcol), vo)); b[t] = run; }
        } else { float w2c[16]; const float* w2 = INP(I_GLA_W2) + (size_t)l * 16 * 256 + h * 64 + c; const float bias = INP(I_GLA_B)[l * 256 + h * 64 + c];
#pragma unroll
            for (int j = 0; j < 16; ++j) w2c[j] = w2[j * 256];
            const float* gk = WSP(float, SM_GK) + (size_t)r0 * 16;
#pragma unroll
            for (int t = 0; t < 32; ++t) { float s = bias;
#pragma unroll
                for (int j = 0; j < 16; ++j) s += gk[t * 16 + j] * w2c[j];
                run += logsigf_(s) * (1.0f / 16.0f); b[t] = run; }
        }
        tot[hf * 128 + c] = run;
    }
    __syncthreads();
    unsigned q1p[16], k1p[16];
    if (act) {
        const float bm = tot[c], bl = bm + tot[128 + c], boff = hf ? bm : 0.f;
        if (hf == 0 && !F.dry) (IS_A ? WSP(float, SM_DECA) + (size_t)unit * 128 : WSP(float, SM_DECC) + (size_t)unit * 64)[c] = __expf(bl);
#pragma unroll
        for (int t2 = 0; t2 < 16; ++t2) { float q1v[2], k1v[2];
#pragma unroll
            for (int u = 0; u < 2; ++u) { const int t = 2 * t2 + u; const float bt = b[t] + boff;
                const float qr = ldrow(ROWB(P, r0 + t, qcol), vo), q = IS_A ? siluf_(qr) * 0.08838834764831845f : qr * 0.125f;
                float k;
                if (IS_A) { const float lf = t == 0 ? b[0] : b[t] - b[t - 1]; k = row_valid(r0 + t) ? 1.0f - __expf(lf) : 0.f; } else k = ldrow(ROWB(P, r0 + t, kcol), vo);
                q1v[u] = q * __expf(bt); k1v[u] = k * __expf(bl - bt);
                qt[(32 * hf + t) * QP + c] = f2bf(q * __expf(fminf(bt - bm, 80.f))); kt[(32 * hf + t) * QP + c] = f2bf(k * __expf(fminf(bm - bt, 80.f))); }
            q1p[t2] = pk2(q1v[0], q1v[1]); k1p[t2] = pk2(k1v[0], k1v[1]); }
    }
    __syncthreads();
    if (act) {
        if (!F.dry) {
#pragma unroll
        for (int t2 = 0; t2 < 16; ++t2) { strow(ROWB(P, r0 + 2 * t2, qcol), vop, (bf16_t)(q1p[t2] & 0xffffu)); strow(ROWB(P, r0 + 2 * t2 + 1, qcol), vop, (bf16_t)(q1p[t2] >> 16)); } }
        bf16_t* kd = (IS_A ? P + (size_t)(row0 + (c >> 1)) * LDP + kcol + (c & 1) * 64 : P + (size_t)(row0 + c) * LDP + kcol) + 32 * hf;
#pragma unroll
        for (int o = 0; o < 4; ++o) if (!F.dry) *(u32x4*)(kd + 8 * o) = (u32x4){k1p[4 * o], k1p[4 * o + 1], k1p[4 * o + 2], k1p[4 * o + 3]};
    }
    { const int ws = (tid >> 6) & 3, lane = tid & 63, fr = lane & 15, fq = lane >> 4;
        bf16_t* sc = (IS_A ? WSP(bf16_t, WS_SCA) : WSP(bf16_t, WS_SCC)) + (size_t)unit * 4096;
#pragma unroll
        for (int jt = 0; jt < 4; ++jt) { const int mt = ws, nt = jt; f32x4 acc = {0.f, 0.f, 0.f, 0.f};
            if (nt <= mt) {
#pragma unroll
                for (int ks = 0; ks < DK / 32; ++ks) { const bf16x8 a = *(const LAS bf16x8*)(qt + (16 * mt + fr) * QP + 32 * ks + 8 * fq), bb = *(const LAS bf16x8*)(kt + (16 * nt + fr) * QP + 32 * ks + 8 * fq); acc = MFMA16(a, bb, acc); } }
#pragma unroll
            for (int r = 0; r < 4; ++r) { const int t = 16 * mt + 4 * fq + r, s = 16 * nt + fr; if (!F.dry) sc[t * 64 + s] = (s <= t) ? f2bf(acc[r]) : (bf16_t)0; } }
    }
    { unsigned vp[16];
#pragma unroll
        for (int t2 = 0; t2 < 16; ++t2) { vp[t2] = ldrow_u(ROWB(P, r0 + 2 * t2, vcol), vo) | (ldrow_u(ROWB(P, r0 + 2 * t2 + 1, vcol), vo) << 16); }
        __syncthreads();
        bf16_t* vd = P + (size_t)(row0 + (c >> 1)) * LDP + vcol + (c & 1) * 64 + 32 * hf;
#pragma unroll
        for (int o = 0; o < 4; ++o) if (!F.dry) *(u32x4*)(vd + 8 * o) = (u32x4){vp[4 * o], vp[4 * o + 1], vp[4 * o + 2], vp[4 * o + 3]}; }
    __syncthreads();
}

__device__ __forceinline__ void prep_gdn(Frame& F, int l, int ug) {
    constexpr int NP = 136, SUB = 2 * 64 * NP * 2 + 64 * 68 * 4 + 1024 + 2304;
    int tid = F.tid; asm volatile("" : "+v"(tid));
    const int lane = tid & 63, sg = __builtin_amdgcn_readfirstlane(tid >> 8), lt = tid & 255, unit = 2 * ug + sg, slot = unit >> 2, h = unit & 3, row0 = slot * 64;
    bf16_t* P = WSP(bf16_t, WS_P);
    LAS bf16_t* qs = (LAS bf16_t*)(F.lds + sg * SUB);
    LAS bf16_t* ks = qs + 64 * NP;
    LAS float* AT = (LAS float*)(F.lds + sg * SUB + 2 * 64 * NP * 2);
    LAS float* gs = AT + 64 * 68;
    if (lt < 64) { const int valid_u = 1; (void)valid_u; float g = WSP(float, SM_LOGA)[(size_t)(row0 + lt) * 4 + h];
#pragma unroll
        for (int o = 1; o < 64; o <<= 1) { const float t = __shfl_up(g, o); if (lane >= o) g += t; }
        gs[lt] = g; gs[64 + lt] = WSP(float, SM_BETA)[(size_t)(row0 + lt) * 4 + h];
        if (lt == 63 && !F.dry) WSP(float, SM_DECB)[unit] = __expf(g); }
    const int hslot = slot == 256 ? -1 : ((slot & 63) == 0 ? 256 : slot - 1);
    LAS bf16_t* rvs = (LAS bf16_t*)AT;
    LAS bf16_t* hl = (LAS bf16_t*)(gs + 256);
    for (int idx = lt; idx < 64 * 48; idx += 256) { const int row = idx / 48, pc = idx % 48, comp = pc >> 4, c8 = (pc & 15) * 8;
        const u32x4 v = *(const u32x4*)(P + (size_t)(row0 + row) * LDP + PC_BQKV + comp * 512 + h * 128 + c8);
        *(LAS u32x4*)((comp == 0 ? qs : (comp == 1 ? ks : rvs)) + row * NP + c8) = v; }
    if (lt < 144) { const int rr = lt / 48, pc = lt % 48, comp = pc >> 4, c8 = (pc & 15) * 8; u32x4 v = {0u, 0u, 0u, 0u};
        if (hslot >= 0) v = *(const u32x4*)(WSP(bf16_t, SM_HALO) + ((size_t)hslot * 3 + rr) * 1536 + comp * 512 + h * 128 + c8);
        *(LAS u32x4*)(hl + rr * 384 + comp * 128 + c8) = v; }
    __syncthreads();
    float col[64];
    {
        const int c = lt & 127;
#pragma unroll
        for (int pass = 0; pass < 2; ++pass) {
            if (pass == 1 && lt >= 128) break;
            const int comp = lt >= 128 ? 1 : (pass == 0 ? 0 : 2), ch = comp * 512 + h * 128 + c;
            const float w0 = INP(I_GDN_CONV)[((size_t)l * 4 + 0) * 1536 + ch], w1 = INP(I_GDN_CONV)[((size_t)l * 4 + 1) * 1536 + ch], w2 = INP(I_GDN_CONV)[((size_t)l * 4 + 2) * 1536 + ch], w3 = INP(I_GDN_CONV)[((size_t)l * 4 + 3) * 1536 + ch];
            LAS bf16_t* src = (comp == 0 ? qs : (comp == 1 ? ks : rvs)) + c;
            float x0 = bf2f(hl[comp * 128 + c]), x1 = bf2f(hl[384 + comp * 128 + c]), x2 = bf2f(hl[768 + comp * 128 + c]);
#pragma unroll
            for (int t = 0; t < 64; ++t) { const float x3 = bf2f(src[t * NP]); const float y = siluf_(w0 * x0 + w1 * x1 + w2 * x2 + w3 * x3); x0 = x1; x1 = x2; x2 = x3;
                if (comp == 0) src[t * NP] = f2bf(y); else { col[t] = y; if (comp == 1) src[t * NP] = f2bf(y); } }
        }
    }
    __syncthreads();
    const int wv = (tid >> 6) & 3, fr = lane & 15, fq = lane >> 4;
#pragma unroll
    for (int jt = 0; jt < 2; ++jt) { const int which = jt, mt = wv; const LAS bf16_t* ap = which ? qs : ks; f32x4 a4 = {0.f, 0.f, 0.f, 0.f};
#pragma unroll
        for (int k4 = 0; k4 < 4; ++k4) { const bf16x8 a = *(const LAS bf16x8*)(ap + (16 * mt + fr) * NP + 32 * k4 + 8 * fq); a4 = MFMA16(a, a, a4); }
#pragma unroll
        for (int r = 0; r < 4; ++r) if (4 * fq + r == fr) { if (which == 0) gs[128 + 16 * mt + fr] = rsqrtf(a4[r] + 1e-6f); else gs[192 + 16 * mt + fr] = rsqrtf(a4[r] + 1e-6f) * 0.08838834764831845f; } }
    __syncthreads();
    { bf16_t* qkd = WSP(bf16_t, WS_QKD) + (size_t)unit * 4096;
#pragma unroll
        for (int jt = 0; jt < 8; ++jt) { const int tile = wv * 8 + jt, which = tile >> 4, mt = (tile >> 2) & 3, nt = tile & 3;
            const LAS bf16_t* ap = which ? qs : ks; f32x4 a4 = {0.f, 0.f, 0.f, 0.f};
            if (nt <= mt) {
#pragma unroll
                for (int k4 = 0; k4 < 4; ++k4) { const bf16x8 a = *(const LAS bf16x8*)(ap + (16 * mt + fr) * NP + 32 * k4 + 8 * fq), bb = *(const LAS bf16x8*)(ks + (16 * nt + fr) * NP + 32 * k4 + 8 * fq); a4 = MFMA16(a, bb, a4); } }
#pragma unroll
            for (int r = 0; r < 4; ++r) { const int t = 16 * mt + 4 * fq + r, s = 16 * nt + fr; const float dec = __expf(fminf(gs[t] - gs[s], 0.f)) * gs[128 + s];
                if (which) { if (!F.dry) qkd[t * 64 + permpos(s)] = (s <= t) ? f2bf(a4[r] * dec * gs[192 + t]) : (bf16_t)0; }
                else AT[s * 68 + t] = (s < t) ? gs[64 + t] * gs[128 + t] * a4[r] * dec : 0.f; } }
    }
    if (lt >= 128) { const int d = lt - 128; const float gl = gs[63]; bf16_t* dst = WSP(bf16_t, WS_K1TB) + (size_t)unit * 8192 + d * 64;
#pragma unroll
        for (int o = 0; o < 8; ++o) { const int s0 = 32 * (o >> 2) + 4 * (o & 3); float y[8];
#pragma unroll
            for (int j = 0; j < 8; ++j) { const int s = s0 + (j & 3) + (j >> 2) * 16; y[j] = col[s] * gs[128 + s] * __expf(gl - gs[s]); }
            if (!F.dry) *(u32x4*)(dst + 8 * o) = (u32x4){pk2(y[0], y[1]), pk2(y[2], y[3]), pk2(y[4], y[5]), pk2(y[6], y[7])}; }
    } else { const int pp = permpos(lt);
#pragma unroll 8
        for (int t = 0; t < 64; ++t) if (!F.dry) P[(size_t)(row0 + t) * LDP + PC_BQKV + h * 128 + pp] = f2bf(bf2f(qs[t * NP + lt]) * gs[192 + t] * __expf(gs[t])); }
    __syncthreads();
#pragma unroll
    for (int i = 0; i < 64; ++i) col[i] *= lt < 128 ? gs[64 + i] : gs[64 + i] * gs[128 + i] * __expf(gs[i]);
#pragma unroll
    for (int j = 0; j < 63; ++j) { const float xj = col[j]; asm volatile("" ::: "memory");
#pragma unroll
        for (int q4 = (j + 1) >> 2; q4 < 16; ++q4) { const f32x4 a = *(const LAS f32x4*)(AT + j * 68 + 4 * q4);
#pragma unroll
            for (int e = 0; e < 4; ++e) if (4 * q4 + e > j) col[4 * q4 + e] -= a[e] * xj; } }
    int tid2 = F.tid; asm volatile("" : "+v"(tid2)); const int lt2 = tid2 & 255, unit2 = 2 * ug + __builtin_amdgcn_readfirstlane(tid2 >> 8), row02 = (unit2 >> 2) * 64, h2 = unit2 & 3;
    if (lt2 < 128) { bf16_t* dst = P + (size_t)(row02 + (lt2 >> 1)) * LDP + PC_BQKV + 1024 + h2 * 128 + (lt2 & 1) * 64;
#pragma unroll
        for (int o = 0; o < 8; ++o) if (!F.dry) *(u32x4*)(dst + 8 * o) = (u32x4){pk2(col[8 * o], col[8 * o + 1]), pk2(col[8 * o + 2], col[8 * o + 3]), pk2(col[8 * o + 4], col[8 * o + 5]), pk2(col[8 * o + 6], col[8 * o + 7])};
    } else { const int pp = permpos(lt2 - 128);
        if (!F.dry) {
#pragma unroll
        for (int t = 0; t < 64; ++t) strow(ROWB(P, row02 + t, PC_BQKV + 512 + h2 * 128), (unsigned)pp * 2u, f2bf(col[t])); } }
    __syncthreads();
}

__device__ __forceinline__ void phase_prep(Frame& F, int l) {
#ifndef PREP_DRY_SEL
#define PREP_DRY_SEL 7
#endif
    const int sel = F.dry ? PREP_DRY_SEL : 7;
    if (sel & 1) for (int ug = F.bid; ug < 514; ug += F.G) prep_gla<128, true>(F, l, ug);
    if (sel & 2) for (int ug = F.bid; ug < 514; ug += F.G) prep_gdn(F, l, ug);
    if (sel & 4) for (int ug = F.bid; ug < 514; ug += F.G) prep_gla<64, false>(F, l, ug);
}
constexpr int SCAN_BUF = 57344;
template <int MX> struct ScanCfg;
template <> struct ScanCfg<0> { static constexpr int NM = 3, NI = 5; static constexpr int off(int m) { return m == 0 ? 0 : (m == 1 ? 16384 : 32768); } static constexpr int pitch(int m) { return m == 0 ? 256 : 128; } };
template <> struct ScanCfg<1> { static constexpr int NM = 4, NI = 7; static constexpr int off(int m) { return 16384 * m; } static constexpr int pitch(int m) { return m < 2 ? 256 : 128; } };
template <> struct ScanCfg<2> { static constexpr int NM = 3, NI = 3; static constexpr int off(int m) { return 8192 * m; } static constexpr int pitch(int m) { return 128; } };

template <int MX>
__device__ __forceinline__ void scan_mixer(Frame& F, int b, int h) {
    typedef ScanCfg<MX> C;
    constexpr int DK = MX == 2 ? 64 : 128, NT = DK / 16, NI = C::NI;
    const int w = F.wave, lane = F.lane, fr = lane & 15, fq = lane >> 4, ecol = 16 * w + fr;
    const char* Pb = (const char*)WSP(bf16_t, WS_P);
    const int qcol = MX == 0 ? PC_AQ + h * 128 : (MX == 1 ? PC_BQKV + h * 128 : PC_CQ + h * 64);
    const int kcol = MX == 0 ? PC_AF + h * 128 : (MX == 1 ? PC_BQKV + 512 + h * 128 : PC_CK + h * 64);
    const int vcol = MX == 0 ? PC_AI + h * 128 : (MX == 1 ? PC_BQKV + 1024 + h * 128 : PC_CV + h * 128);
    const char* SCb = (const char*)(MX == 0 ? WSP(bf16_t, WS_SCA) : (MX == 1 ? WSP(bf16_t, WS_QKD) : WSP(bf16_t, WS_SCC)));
    bf16_t* O = WSP(bf16_t, WS_O) + (size_t)MX * MROWS * 512;
    unsigned voff[NI]; int mi[NI];
#pragma unroll
    for (int i = 0; i < NI; ++i) { const int n = w + 8 * i, o = 1024 * n + 16 * lane; int m = 0;
#pragma unroll
        for (int q = 1; q < C::NM; ++q) if (o >= C::off(q)) m = q;
        int ro = o, pitch = 128;
#pragma unroll
        for (int q = 0; q < C::NM; ++q) if (m == q) { ro = o - C::off(q); pitch = C::pitch(q); }
        const int r = ro / pitch, pos = (ro % pitch) >> 4, pc = pos ^ (pitch == 256 ? (r & 15) : ((r >> 1) & 7));
        const bool packed = (MX == 0 && m == 1);
        const bool inP = (MX == 1) ? (m < 2) : (m < 2);
        voff[i] = (unsigned)(inP ? (packed ? (r >> 1) * (LDP * 2) + (r & 1) * 128 : r * (LDP * 2)) : r * pitch) + 16u * pc; mi[i] = m; }
    const unsigned x256_0 = (unsigned)(((0 | fq) ^ fr) << 4), x256_1 = (unsigned)(((4 | fq) ^ fr) << 4), x256_2 = (unsigned)(((8 | fq) ^ fr) << 4), x256_3 = (unsigned)(((12 | fq) ^ fr) << 4);
    const unsigned x128_0 = (unsigned)(((0 | fq) ^ ((fr >> 1) & 7)) << 4), x128_1 = (unsigned)(((4 | fq) ^ ((fr >> 1) & 7)) << 4);
    const unsigned x256[4] = {x256_0, x256_1, x256_2, x256_3}, x128[2] = {x128_0, x128_1};
#define SC_FRAG(buf, m, rt, kp) (*(const LAS bf16x8*)(F.lds + (buf) + C::off(m) + (16 * (rt) + fr) * C::pitch(m) + (C::pitch(m) == 256 ? x256[kp] : x128[(kp) & 1])))
    auto slot_of = [&](int step) { return step == 0 ? 256 : b * 64 + step - 1; };
    auto issue = [&](int step, int buf) {
        const int slot = slot_of(step), row0 = slot * 64, unit = slot * 4 + h;
        const char* base[4];
        if (MX == 1) { base[0] = Pb + ((size_t)row0 * LDP + kcol) * 2; base[1] = Pb + ((size_t)row0 * LDP + qcol) * 2; base[2] = (const char*)WSP(bf16_t, WS_K1TB) + (size_t)unit * 16384; base[3] = SCb + (size_t)unit * 8192; }
        else { base[0] = Pb + ((size_t)row0 * LDP + qcol) * 2; base[1] = Pb + ((size_t)row0 * LDP + kcol) * 2; base[2] = SCb + (size_t)unit * 8192; base[3] = base[2]; }
#pragma unroll
        for (int i = 0; i < NI; ++i) { const char* bs = mi[i] == 0 ? base[0] : (mi[i] == 1 ? base[1] : (mi[i] == 2 ? base[2] : base[3]));
            __builtin_amdgcn_global_load_lds((const unsigned*)(bs + voff[i]), (LAS unsigned*)(F.lds + buf + 1024 * (w + 8 * i)), 16, 0, 0); }
    };
    auto load_priv = [&](int step, u32x4 (&pv)[2]) {
        const int row0 = slot_of(step) * 64;
        const bf16_t* vt = (const bf16_t*)Pb + (size_t)(row0 + (ecol >> 1)) * LDP + vcol + (ecol & 1) * 64;
        if (MX == 1) { const u32x2 a = *(const u32x2*)(vt + 4 * fq), c = *(const u32x2*)(vt + 16 + 4 * fq), d = *(const u32x2*)(vt + 32 + 4 * fq), e = *(const u32x2*)(vt + 48 + 4 * fq);
            pv[0] = (u32x4){a.x, a.y, c.x, c.y}; pv[1] = (u32x4){d.x, d.y, e.x, e.y}; }
        else { pv[0] = *(const u32x4*)(vt + 8 * fq); pv[1] = *(const u32x4*)(vt + 32 + 8 * fq); }
    };
    f32x4 S[NT];
#pragma unroll
    for (int i = 0; i < NT; ++i) S[i] = (f32x4){0.f, 0.f, 0.f, 0.f};
    u32x4 pcur[2], pnxt[2];
    issue(0, 0); load_priv(0, pcur);
    for (int step = 0; step < 65; ++step) {
        const int buf = (step & 1) * SCAN_BUF, slot = slot_of(step), row0 = slot * 64, unit = slot * 4 + h;
        asm volatile("s_waitcnt vmcnt(0)" ::: "memory");
        __syncthreads();
        if (step + 1 < 65) { issue(step + 1, SCAN_BUF - buf); load_priv(step + 1, pnxt); }
        bf16x8 Sb[NT / 2];
#pragma unroll
        for (int kp = 0; kp < NT / 2; ++kp) Sb[kp] = pack_acc2(S[2 * kp], S[2 * kp + 1]);
        if (MX == 1) {
            f32x4 vn[4];
#pragma unroll
            for (int mt = 0; mt < 4; ++mt) { f32x4 acc = {0.f, 0.f, 0.f, 0.f};
#pragma unroll
                for (int kp = 0; kp < 4; ++kp) acc = MFMA16(SC_FRAG(buf, 0, mt, kp), Sb[kp], acc);
                const unsigned u0 = mt == 0 ? pcur[0].x : (mt == 1 ? pcur[0].z : (mt == 2 ? pcur[1].x : pcur[1].z)), u1 = mt == 0 ? pcur[0].y : (mt == 1 ? pcur[0].w : (mt == 2 ? pcur[1].y : pcur[1].w));
                vn[mt] = (f32x4){bflo(u0) - acc[0], bfhi(u0) - acc[1], bflo(u1) - acc[2], bfhi(u1) - acc[3]}; }
            bf16x8 Vb[2]; Vb[0] = pack_acc2(vn[0], vn[1]); Vb[1] = pack_acc2(vn[2], vn[3]);
#pragma unroll
            for (int mt = 0; mt < 4; ++mt) { f32x4 acc = {0.f, 0.f, 0.f, 0.f};
#pragma unroll
                for (int kp = 0; kp < 4; ++kp) acc = MFMA16(SC_FRAG(buf, 1, mt, kp), Sb[kp], acc);
#pragma unroll
                for (int kp = 0; kp < 2; ++kp) acc = MFMA16(SC_FRAG(buf, 3, mt, kp), Vb[kp], acc);
#pragma unroll
                for (int r = 0; r < 4; ++r) O[(size_t)(row0 + 16 * mt + 4 * fq + r) * 512 + h * 128 + ecol] = f2bf(acc[r]); }
            const float a = WSP(float, SM_DECB)[unit];
#pragma unroll
            for (int i = 0; i < 8; ++i) { S[i] = S[i] * a;
#pragma unroll
                for (int kp = 0; kp < 2; ++kp) S[i] = MFMA16(SC_FRAG(buf, 2, i, kp), Vb[kp], S[i]); }
        } else {
            const bf16x8 bv0 = mk8(pcur[0]), bv1 = mk8(pcur[1]);
#pragma unroll
            for (int mt = 0; mt < 4; ++mt) { f32x4 acc = {0.f, 0.f, 0.f, 0.f};
#pragma unroll
                for (int kp = 0; kp < NT / 2; ++kp) acc = MFMA16(SC_FRAG(buf, 0, mt, kp), Sb[kp], acc);
                acc = MFMA16(SC_FRAG(buf, 2, mt, 0), bv0, acc); acc = MFMA16(SC_FRAG(buf, 2, mt, 1), bv1, acc);
#pragma unroll
                for (int r = 0; r < 4; ++r) O[(size_t)(row0 + 16 * mt + 4 * fq + r) * 512 + h * 128 + ecol] = f2bf(acc[r]); }
            const float* dec = (MX == 0 ? WSP(float, SM_DECA) : WSP(float, SM_DECC)) + (size_t)unit * DK;
#pragma unroll
            for (int i = 0; i < NT; ++i) { const f32x4 d4 = *(const f32x4*)(dec + 16 * i + 4 * fq); S[i] = S[i] * d4;
                S[i] = MFMA16(SC_FRAG(buf, 1, i, 0), bv0, S[i]); S[i] = MFMA16(SC_FRAG(buf, 1, i, 1), bv1, S[i]); }
        }
        pcur[0] = pnxt[0]; pcur[1] = pnxt[1];
    }
#undef SC_FRAG
    asm volatile("s_waitcnt vmcnt(0)" ::: "memory");
    __syncthreads();
}
__device__ __forceinline__ void phase_scan(Frame& F) {
    if (F.bid >= 48) return;
    const int mixer = F.bid >> 4, b = (F.bid >> 2) & 3, h = F.bid & 3;
    if (mixer == 0) scan_mixer<0>(F, b, h);
    else if (mixer == 1) scan_mixer<1>(F, b, h);
    else scan_mixer<2>(F, b, h);
}

template <int KIND>
__device__ __forceinline__ void meta_gemm(Frame& F, const bf16_t* A, const bf16_t* Bt, int N, int K, int n) {
    const int gw = F.bid * NWAVES + F.wave, NGW = F.G * NWAVES, lane = F.lane, fr = lane & 15, fq = lane >> 4;
    for (int tile = gw; tile < N / 16; tile += NGW) {
        const bf16_t* ar = A + (size_t)fr * K + 8 * fq; const bf16_t* br = Bt + (size_t)(16 * tile + fr) * K + 8 * fq;
        f32x4 acc = {0.f, 0.f, 0.f, 0.f};
#pragma unroll 8
        for (int ks = 0; ks < K / 32; ++ks) acc = MFMA16(mk8(*(const u32x4*)(ar + 32 * ks)), mk8(*(const u32x4*)(br + 32 * ks)), acc);
#pragma unroll
        for (int r = 0; r < 4; ++r) { const int row = META_ROW0 + 4 * fq + r, col = 16 * tile + fr;
            if (KIND == 0) WSP(bf16_t, WS_GT)[(size_t)row * 3072 + col] = f2bf(sigmoidf_(acc[r]));
            else if (KIND == 1) { bf16_t* mp = WSP(bf16_t, WS_MERGED) + (size_t)row * 1024 + col; const float g = bf2f(WSP(bf16_t, WS_GT)[(size_t)row * 3072 + n * 1024 + col]);
                *mp = f2bf((n ? bf2f(*mp) : 0.f) + g * acc[r]); }
            else { float* hp = WSP(float, WS_HMETA) + (size_t)(row - NREAL) * D + col; *hp = *hp + acc[r]; } }
    }
}

__device__ __forceinline__ void phase_hnorm(Frame& F, int l) {
    const int gw = F.bid * NWAVES + F.wave, NGW = F.G * NWAVES, lane = F.lane;
    const bf16_t* P = WSP(bf16_t, WS_P);
    LAS float* nws = (LAS float*)F.lds;
    if (F.tid < 384) { const int mxw = F.tid >> 7; const float* src = mxw == 0 ? INP(I_HGRN_NORM) : (mxw == 1 ? INP(I_GDN_NORM) : INP(I_GLA_NORM)); nws[F.tid] = src[(size_t)l * 128 + (F.tid & 127)]; }
    __syncthreads();
    for (int r = gw; r < MROWS; r += NGW) {
        bf16_t* op0 = WSP(bf16_t, WS_O) + (size_t)r * 512 + 8 * lane;
        if (!row_valid(r)) { if (!F.dry) {
#pragma unroll
            for (int mx = 0; mx < 3; ++mx) *(u32x4*)(op0 + (size_t)mx * MROWS * 512) = (u32x4){0u, 0u, 0u, 0u}; } continue; }
        u32x4 ow[3], gv[3];
#pragma unroll
        for (int mx = 0; mx < 3; ++mx) { ow[mx] = *(const u32x4*)(op0 + (size_t)mx * MROWS * 512); gv[mx] = *(const u32x4*)(P + (size_t)r * LDP + (mx == 0 ? PC_AG : (mx == 1 ? PC_BG : PC_CG)) + 8 * lane); }
#pragma unroll
        for (int mx = 0; mx < 3; ++mx) {
            const LAS float* nw = nws + mx * 128 + (8 * lane & 127);
            float o[8] = {bflo(ow[mx].x), bfhi(ow[mx].x), bflo(ow[mx].y), bfhi(ow[mx].y), bflo(ow[mx].z), bfhi(ow[mx].z), bflo(ow[mx].w), bfhi(ow[mx].w)};
            const float g[8] = {siluf_(bflo(gv[mx].x)), siluf_(bfhi(gv[mx].x)), siluf_(bflo(gv[mx].y)), siluf_(bfhi(gv[mx].y)), siluf_(bflo(gv[mx].z)), siluf_(bfhi(gv[mx].z)), siluf_(bflo(gv[mx].w)), siluf_(bfhi(gv[mx].w))};
            float ss = 0.f;
#pragma unroll
            for (int j = 0; j < 8; ++j) ss += o[j] * o[j];
            ss += __shfl_xor(ss, 1); ss += __shfl_xor(ss, 2); ss += __shfl_xor(ss, 4); ss += __shfl_xor(ss, 8);
            const float rstd = rsqrtf(ss * (1.0f / 128.0f) + 1e-6f);
            const f32x4 n0 = *(const LAS f32x4*)nw, n1 = *(const LAS f32x4*)(nw + 4);
            const float nv[8] = {n0[0], n0[1], n0[2], n0[3], n1[0], n1[1], n1[2], n1[3]};
#pragma unroll
            for (int j = 0; j < 8; ++j) o[j] = o[j] * rstd * nv[j] * g[j];
            u32x4 y; y.x = pk2(o[0], o[1]); y.y = pk2(o[2], o[3]); y.z = pk2(o[4], o[5]); y.w = pk2(o[6], o[7]);
            if (!F.dry) *(u32x4*)(op0 + (size_t)mx * MROWS * 512) = y;
        }
    }
}

__device__ __forceinline__ void phase_norm2(Frame& F, int l) {
    if (!F.dry) convert_expert_weights(F, l);
    __syncthreads();
    LAS float* sw = (LAS float*)F.lds;
    { const float* src = WSP(float, SM_RWE) + (size_t)l * 32 * 1024; for (int i = F.tid; i < 32 * 1024 / 4; i += NTHREADS) ((LAS f32x4*)sw)[i] = ((const f32x4*)src)[i]; }
    LAS float* rbias = sw + 32 * 1024;
    if (F.tid < 32) rbias[F.tid] = INP(I_RE_B)[l * 32 + F.tid]; else if (F.tid < 36) rbias[F.tid] = INP(I_RG_B)[l * 4 + (F.tid - 32)];
    __syncthreads();
    const int gw = F.bid * NWAVES + F.wave, NGW = F.G * NWAVES, lane = F.lane;
    float wv[16]; load_row16(INP(I_NORM_FFN) + (size_t)l * D, lane, wv);
    bf16_t* U = WSP(bf16_t, WS_U);
    const float* rwg = WSP(float, SM_RWG) + (size_t)l * 4 * 1024;
    unsigned* cnt = WSP(unsigned, WS_CTL) + CW_CNT + l * 64;
    LAS unsigned* lcnt = (LAS unsigned*)(F.lds + LDS_TAB);
    if (F.tid < 64) lcnt[F.tid] = 0u;
    __syncthreads();
    for (int g = gw; g < MROWS / 4; g += NGW) {
        const int r0 = 4 * g;
        if (!row_valid(r0)) continue;
        float x[4][16];
#pragma unroll
        for (int i = 0; i < 4; ++i) {
            load_row16(hrow(F, r0 + i), lane, x[i]);
            float ss = 0.f;
#pragma unroll
            for (int j = 0; j < 16; ++j) ss += x[i][j] * x[i][j];
            const float rstd = rsqrtf(wave_sum(ss) * (1.0f / D) + 1e-6f);
#pragma unroll
            for (int j = 0; j < 16; ++j) x[i][j] = x[i][j] * rstd * wv[j];
            if (!F.dry) store_bf16_row16(U + (size_t)(r0 + i) * D, lane, x[i]);
        }
#ifndef NORM2_SKIP
#define NORM2_SKIP 0
#endif
        if (F.dry && (NORM2_SKIP & 4)) continue;
        float lg[4][4];
#pragma unroll
        for (int c = 0; c < 4; ++c) {
            float a0 = 0.f, a1 = 0.f, a2 = 0.f, a3 = 0.f;
#pragma unroll
            for (int j = 0; j < 4; ++j) { const f32x4 w = *((const f32x4*)(rwg + c * 1024) + lane + 64 * j);
#pragma unroll
                for (int e = 0; e < 4; ++e) { a0 += x[0][4 * j + e] * w[e]; a1 += x[1][4 * j + e] * w[e]; a2 += x[2][4 * j + e] * w[e]; a3 += x[3][4 * j + e] * w[e]; } }
            const float bg = rbias[32 + c];
            lg[0][c] = wave_sum(a0) + bg; lg[1][c] = wave_sum(a1) + bg; lg[2][c] = wave_sum(a2) + bg; lg[3][c] = wave_sum(a3) + bg;
        }
#pragma unroll
        for (int i = 0; i < 4; ++i) {
            int gi = 0; float gm = lg[i][0];
#pragma unroll
            for (int c = 1; c < 4; ++c) if (lg[i][c] > gm) { gm = lg[i][c]; gi = c; }
            float gsum = 0.f;
#pragma unroll
            for (int c = 0; c < 4; ++c) gsum += __expf(lg[i][c] - gm);
            const float gval = 1.0f / gsum;
            gi = __builtin_amdgcn_readfirstlane(gi);
            int ea = 0, eb = 0; float la = -3.0e38f, lb = -3.0e38f;
            const LAS float* swg = sw + gi * 8 * 1024;
#pragma unroll 1
            for (int cb = 0; cb < ((F.dry && (NORM2_SKIP & 2)) ? 0 : 8); cb += 4) {
                float a0 = 0.f, a1 = 0.f, a2 = 0.f, a3 = 0.f;
#pragma unroll
                for (int j = 0; j < 4; ++j) { const f32x4 w0 = *((const LAS f32x4*)(swg + (cb + 0) * 1024) + lane + 64 * j), w1 = *((const LAS f32x4*)(swg + (cb + 1) * 1024) + lane + 64 * j), w2 = *((const LAS f32x4*)(swg + (cb + 2) * 1024) + lane + 64 * j), w3 = *((const LAS f32x4*)(swg + (cb + 3) * 1024) + lane + 64 * j);
#pragma unroll
                    for (int e = 0; e < 4; ++e) { const float xv = x[i][4 * j + e]; a0 += xv * w0[e]; a1 += xv * w1[e]; a2 += xv * w2[e]; a3 += xv * w3[e]; } }
                const float e0 = wave_sum(a0) + rbias[gi * 8 + cb], e1 = wave_sum(a1) + rbias[gi * 8 + cb + 1], e2 = wave_sum(a2) + rbias[gi * 8 + cb + 2], e3 = wave_sum(a3) + rbias[gi * 8 + cb + 3];
                const float ev[4] = {e0, e1, e2, e3};
#pragma unroll
                for (int q = 0; q < 4; ++q) { const float el = ev[q]; const int c = cb + q; if (el > la) { lb = la; eb = ea; la = el; ea = c; } else if (el > lb) { lb = el; eb = c; } }
            }
            const float wa = 1.0f / (1.0f + __expf(lb - la)), wb = 1.0f - wa;
            if (lane == 0 && !F.dry) {
                const unsigned e0 = (unsigned)(gi * 8 + ea), e1 = (unsigned)(gi * 8 + eb);
                const unsigned p0 = __hip_atomic_fetch_add(lcnt + e0, 1u, __ATOMIC_RELAXED, __HIP_MEMORY_SCOPE_WORKGROUP), p1 = __hip_atomic_fetch_add(lcnt + e1, 1u, __ATOMIC_RELAXED, __HIP_MEMORY_SCOPE_WORKGROUP);
                unsigned* tok = WSP(unsigned, SM_TOK) + (size_t)(r0 + i) * 8;
                tok[0] = e0; tok[1] = p0; tok[2] = e1; tok[3] = p1; tok[4] = __float_as_uint(gval * wa); tok[5] = __float_as_uint(gval * wb);
            }
        }
    }
    __syncthreads();
    if (F.tid < 32 && !F.dry) lcnt[32 + F.tid] = atomicAdd(cnt + F.tid, lcnt[F.tid]);
    __syncthreads();
    if (!F.dry) for (int g = gw; g < MROWS / 4; g += NGW) { const int r0 = 4 * g; if (!row_valid(r0)) continue;
        if (lane < 4) { unsigned* tok = WSP(unsigned, SM_TOK) + (size_t)(r0 + lane) * 8; tok[1] += lcnt[32 + tok[0]]; tok[3] += lcnt[32 + tok[2]]; } }
}

__device__ __forceinline__ int moe_tables(Frame& F, int l) {
    LAS int* offs = (LAS int*)(F.lds + LDS_TAB); LAS unsigned char* tab = (LAS unsigned char*)(F.lds + LDS_TAB + 384); LAS int* cn = (LAS int*)(F.lds + LDS_TAB + 192);
    const unsigned* cnt = WSP(unsigned, WS_CTL) + CW_CNT + l * 64;
    __syncthreads();
    if (F.tid < 32) cn[F.tid] = (int)__hip_atomic_load(cnt + F.tid, __ATOMIC_RELAXED, __HIP_MEMORY_SCOPE_AGENT);
    __syncthreads();
    if (F.tid == 0) { int acc = 0;
#pragma unroll 1
        for (int e = 0; e < 32; ++e) { offs[e] = acc; acc += ((cn[e] + 255) >> 8) << 8; }
        offs[32] = acc; }
    __syncthreads();
    if (F.tid < 160) { const int row = F.tid << 8; int e = 0;
#pragma unroll 1
        for (int k = 1; k < 32; ++k) if (offs[k] <= row) e = k;
        tab[F.tid] = (unsigned char)e; }
    __syncthreads();
    return offs[32] >> 8;
}

__device__ __forceinline__ void phase_gather(Frame& F, int l) {
    (void)moe_tables(F, l);
    const LAS int* offs = (const LAS int*)(F.lds + LDS_TAB); const LAS int* cn = (const LAS int*)(F.lds + LDS_TAB + 192);
    const int gw = F.bid * NWAVES + F.wave, NGW = F.G * NWAVES, lane = F.lane;
    const bf16_t* U = WSP(bf16_t, WS_U); bf16_t* XG = WSP(bf16_t, WS_XG); float* wrow = WSP(float, SM_WROW);
    for (int idx = gw; idx < NREAL + 16; idx += NGW) {
        const int r = idx < NREAL ? idx : META_ROW0 + (idx - NREAL);
        unsigned* tok = WSP(unsigned, SM_TOK) + (size_t)r * 8;
        const unsigned e0 = tok[0], p0 = tok[1], e1 = tok[2], p1 = tok[3];
        const unsigned g0 = (unsigned)offs[e0] + p0, g1 = (unsigned)offs[e1] + p1;
        if (lane == 0) { tok[6] = g0; tok[7] = g1; wrow[g0] = __uint_as_float(tok[4]); wrow[g1] = __uint_as_float(tok[5]); }
        const u32x4* src = (const u32x4*)(U + (size_t)r * D);
        const u32x4 a = src[lane], b = src[lane + 64];
        u32x4* d0 = (u32x4*)(XG + (size_t)g0 * D); u32x4* d1 = (u32x4*)(XG + (size_t)g1 * D);
        d0[lane] = a; d0[lane + 64] = b; d1[lane] = a; d1[lane + 64] = b;
    }
    u32x4 zz = {0u, 0u, 0u, 0u}; asm volatile("" : "+v"(zz));
    for (int i = gw; i < 32 * 256; i += NGW) { const int e = i >> 8, j = i & 255; const int row = offs[e] + cn[e] + j;
        if (row < offs[e + 1]) { u32x4* d = (u32x4*)(XG + (size_t)row * D); d[lane] = zz; d[lane + 64] = zz; if (lane == 0) wrow[row] = 0.f; } }
}

__device__ __forceinline__ void phase_final(Frame& F) {
    const int gw = F.bid * NWAVES + F.wave, NGW = F.G * NWAVES, lane = F.lane;
    float wv[16]; load_row16(INP(I_NORM_FINAL), lane, wv);
    for (int r = gw; r < NREAL; r += 2 * NGW) {
        const int r2 = r + NGW;
        float x[16], y[16]; fetch_h_row(F, 2, r, x); fetch_h_row(F, 2, r2, y);
        float ss = 0.f, s2 = 0.f;
#pragma unroll
        for (int j = 0; j < 16; ++j) { ss += x[j] * x[j]; s2 += y[j] * y[j]; }
        const float rstd = rsqrtf(wave_sum(ss) * (1.0f / D) + 1e-6f), rstd2 = rsqrtf(wave_sum(s2) * (1.0f / D) + 1e-6f);
#pragma unroll
        for (int j = 0; j < 16; ++j) { x[j] = x[j] * rstd * wv[j]; y[j] = y[j] * rstd2 * wv[j]; }
        store_row16(OUTP + (size_t)r * D, lane, x); store_row16(OUTP + (size_t)r2 * D, lane, y);
    }
}
constexpr int PH_PER_LAYER = 14, N_PHASES = 2 + 2 * PH_PER_LAYER;
#ifndef DBG_STOP
#define DBG_STOP 0
#endif
#ifndef DBG_SRC
#define DBG_SRC WS_P
#define DBG_LD LDP
#endif
#ifndef DBG_TA
#define DBG_TA -1
#endif
#ifndef DBG_TB
#define DBG_TB -1
#endif
#ifndef DUP_MASK
#define DUP_MASK 0u
#endif
#define DUPN(j) (((DUP_MASK >> (j)) & 1u) ? 2 : 1)
#ifndef MK_ONE_LAUNCH
#define MK_ONE_LAUNCH 1
#endif

template <unsigned PHMASK_T>
__global__ void __launch_bounds__(NTHREADS, 2) hybrid_fwd(Params p) {
    extern __shared__ __attribute__((aligned(16))) unsigned char lds_raw[];
    Frame F;
    F.lds = (LAS unsigned char*)lds_raw; F.tid = threadIdx.x; F.lane = F.tid & 63; F.wave = __builtin_amdgcn_readfirstlane(F.tid >> 6); F.G = gridDim.x; F.bid = blockIdx.x; F.dry = 0;
    F.out = (GAS float*)p.out; F.ws = (GAS unsigned char*)p.ws; F.inp = (const float* const __attribute__((address_space(4)))*)__builtin_amdgcn_kernarg_segment_ptr();
    volatile LAS unsigned* MISC = (volatile LAS unsigned*)(F.lds + LDS_MISC);
    if (F.tid < 128) MISC[F.tid] = 0u;
    __syncthreads();
#if MK_ONE_LAUNCH
    constexpr int lo = 0, hi = N_PHASES;
#else
    const int lo = p.ph_lo, hi = p.ph_hi;
#endif
    if (hi - lo > 1) (void)xcd_barrier_post(WSP(unsigned, WS_CTL) + CW_BAR, MISC + 8);
#define GRID_BARRIER() xcd_barrier(WSP(unsigned, WS_CTL) + CW_BAR, xb_xcc_id(), (volatile LAS unsigned*)(F.lds + LDS_MISC) + 8, F.tid, (unsigned)F.G)
#define EN(j) ((PHMASK_T >> (j)) & 1u)
#define IN(k) (lo <= (k) && (k) < hi)
    if (DBG_TA >= 0 && F.tid == 0) { MISC[16] = (unsigned)__builtin_amdgcn_s_memrealtime(); MISC[17] = 0u; }
#define SEAM(k) do { if (IN(k) && IN((k) + 1)) GRID_BARRIER(); PHASE_FENCE(F); \
    if (DBG_TA >= 0 && F.tid == 0) { const unsigned t_now = (unsigned)__builtin_amdgcn_s_memrealtime(); const int kk = (k) == 0 ? 15 : (((k) - 1) % PH_PER_LAYER); const int kind = (kk >= 6 && kk <= 8) ? 6 : kk; \
        if (kind == DBG_TA) MISC[17] += t_now - MISC[16]; MISC[16] = t_now; } } while (0)
    PHASE_FENCE(F);
    if (EN(15) && IN(0)) phase_pre(F);
    SEAM(0);
    { constexpr int l = 0;
        const int pb = 1 + PH_PER_LAYER * l;
        for (int rep = 0; rep < (l == 0 ? DUPN(0) : 1); ++rep) { if (rep) { GRID_BARRIER(); PHASE_FENCE(F); } if (EN(0) && IN(pb + 0)) phase_norm1(F, l); }
        SEAM(pb + 0);
        for (int rep = 0; rep < DUPN(1); ++rep) { if (rep) { GRID_BARRIER(); PHASE_FENCE(F); }
        if (EN(1) && IN(pb + 1)) {
            pg8::Gemm g{WSP(bf16_t, WS_U), WSP(bf16_t, WS_WMIX), MROWS, LDP, D}; pg8::StaticOrder S; S.init(MROWS, LDP, F.G, F.bid);
            pg8::EpiInProj E{WSP(bf16_t, WS_P), WSP(bf16_t, SM_HALO)};
            pg8::gemm_phase(F.lds, F.tid, g, S, E);
        } }
        SEAM(pb + 1);
        for (int rep = 0; rep < DUPN(2); ++rep) { if (rep) { GRID_BARRIER(); PHASE_FENCE(F); F.dry = 1; asm volatile("" : "+s"(F.dry)); } if (EN(2) && IN(pb + 2)) phase_prep(F, l); F.dry = 0; }
        SEAM(pb + 2);
        for (int rep = 0; rep < DUPN(3); ++rep) { if (rep) { GRID_BARRIER(); PHASE_FENCE(F); } if (EN(3) && IN(pb + 3)) phase_scan(F); }
        SEAM(pb + 3);
        for (int rep = 0; rep < DUPN(4); ++rep) { if (rep) { GRID_BARRIER(); PHASE_FENCE(F); F.dry = 1; asm volatile("" : "+s"(F.dry)); } if (EN(4) && IN(pb + 4)) phase_hnorm(F, l); F.dry = 0; }
        SEAM(pb + 4);
        for (int rep = 0; rep < DUPN(5); ++rep) { if (rep) { GRID_BARRIER(); PHASE_FENCE(F); }
        if (EN(5) && IN(pb + 5)) {
            pg8::Gemm g{WSP(bf16_t, WS_U), WSP(bf16_t, WS_WGATE), NREAL, 3072, D}; pg8::StaticOrder S; S.init(NREAL, 3072, F.G, F.bid);
            pg8::EpiSigmoid E{WSP(bf16_t, WS_GT), 3072};
            pg8::gemm_phase(F.lds, F.tid, g, S, E);
            meta_gemm<0>(F, WSP(bf16_t, WS_U) + (size_t)META_ROW0 * D, WSP(bf16_t, WS_WGATE), 3072, D, 0);
        } }
        SEAM(pb + 5);
        for (int n = 0; n < 3; ++n) {
            if (EN(6) && IN(pb + 6 + n)) {
                pg8::Gemm g{WSP(bf16_t, WS_O) + (size_t)n * MROWS * 512, WSP(bf16_t, WS_WBT) + (size_t)n * 1024 * 512, NREAL, D, 512}; pg8::StaticOrder S; S.init(NREAL, D, F.G, F.bid);
                pg8::EpiBranch E{WSP(bf16_t, WS_MERGED), WSP(bf16_t, WS_GT), n};
                pg8::gemm_phase(F.lds, F.tid, g, S, E);
                meta_gemm<1>(F, WSP(bf16_t, WS_O) + (size_t)n * MROWS * 512 + (size_t)META_ROW0 * 512, WSP(bf16_t, WS_WBT) + (size_t)n * 1024 * 512, D, 512, n);
            }
            SEAM(pb + 6 + n);
        }
        if (EN(9) && IN(pb + 9)) {
            pg8::Gemm g{WSP(bf16_t, WS_MERGED), WSP(bf16_t, WS_WOT), NREAL, D, D}; pg8::StaticOrder S; S.init(NREAL, D, F.G, F.bid);
            pg8::EpiResidual E{OUTP, WSP(float, WS_HMETA)};
            pg8::gemm_phase(F.lds, F.tid, g, S, E);
            meta_gemm<2>(F, WSP(bf16_t, WS_MERGED) + (size_t)META_ROW0 * D, WSP(bf16_t, WS_WOT), D, D, 0);
        }
        SEAM(pb + 9);
        for (int rep = 0; rep < DUPN(10); ++rep) { if (rep) { GRID_BARRIER(); PHASE_FENCE(F); F.dry = 1; asm volatile("" : "+s"(F.dry)); } if (EN(10) && IN(pb + 10)) phase_norm2(F, l); F.dry = 0; }
        SEAM(pb + 10);
        for (int rep = 0; rep < DUPN(11); ++rep) { if (rep) { GRID_BARRIER(); PHASE_FENCE(F); } if (EN(11) && IN(pb + 11)) phase_gather(F, l); }
        SEAM(pb + 11);
        for (int rep = 0; rep < DUPN(12); ++rep) { if (rep) { GRID_BARRIER(); PHASE_FENCE(F); }
        if (EN(12) && IN(pb + 12)) {
            const int ntiles = moe_tables(F, l);
            pg8::Gemm g{WSP(bf16_t, WS_XG), WSP(bf16_t, WS_W1T), XG_ROWS, 512, D};
            pg8::MoeOrder S{F.G, F.bid, 2, ntiles, (const LAS unsigned char*)(F.lds + LDS_TAB + 384), (size_t)512 * 1024 * 2};
            pg8::EpiMoeUp E{WSP(bf16_t, WS_HG)};
            pg8::gemm_phase(F.lds, F.tid, g, S, E);
        } }
        SEAM(pb + 12);
        for (int rep = 0; rep < DUPN(13); ++rep) { if (rep) { GRID_BARRIER(); PHASE_FENCE(F); }
        if (EN(13) && IN(pb + 13)) {
            const int ntiles = moe_tables(F, l);
            pg8::Gemm g{WSP(bf16_t, WS_HG), WSP(bf16_t, WS_W2T), XG_ROWS, D, 256};
            pg8::MoeOrder S{F.G, F.bid, 4, ntiles, (const LAS unsigned char*)(F.lds + LDS_TAB + 384), (size_t)1024 * 256 * 2};
            pg8::EpiMoeDown E{WSP(bf16_t, WS_Y2), WSP(float, SM_WROW)};
            pg8::gemm_phase(F.lds, F.tid, g, S, E);
        } }
        SEAM(pb + 13);
    }
    { constexpr int l = 1;
        const int pb = 1 + PH_PER_LAYER * l;
        for (int rep = 0; rep < (l == 0 ? DUPN(0) : 1); ++rep) { if (rep) { GRID_BARRIER(); PHASE_FENCE(F); } if (EN(0) && IN(pb + 0)) phase_norm1(F, l); }
        SEAM(pb + 0);
        for (int rep = 0; rep < DUPN(1); ++rep) { if (rep) { GRID_BARRIER(); PHASE_FENCE(F); }
        if (EN(1) && IN(pb + 1)) {
            pg8::Gemm g{WSP(bf16_t, WS_U), WSP(bf16_t, WS_WMIX), MROWS, LDP, D}; pg8::StaticOrder S; S.init(MROWS, LDP, F.G, F.bid);
            pg8::EpiInProj E{WSP(bf16_t, WS_P), WSP(bf16_t, SM_HALO)};
            pg8::gemm_phase(F.lds, F.tid, g, S, E);
        } }
        SEAM(pb + 1);
        for (int rep = 0; rep < DUPN(2); ++rep) { if (rep) { GRID_BARRIER(); PHASE_FENCE(F); F.dry = 1; asm volatile("" : "+s"(F.dry)); } if (EN(2) && IN(pb + 2)) phase_prep(F, l); F.dry = 0; }
        SEAM(pb + 2);
        for (int rep = 0; rep < DUPN(3); ++rep) { if (rep) { GRID_BARRIER(); PHASE_FENCE(F); } if (EN(3) && IN(pb + 3)) phase_scan(F); }
        SEAM(pb + 3);
        for (int rep = 0; rep < DUPN(4); ++rep) { if (rep) { GRID_BARRIER(); PHASE_FENCE(F); F.dry = 1; asm volatile("" : "+s"(F.dry)); } if (EN(4) && IN(pb + 4)) phase_hnorm(F, l); F.dry = 0; }
        SEAM(pb + 4);
        for (int rep = 0; rep < DUPN(5); ++rep) { if (rep) { GRID_BARRIER(); PHASE_FENCE(F); }
        if (EN(5) && IN(pb + 5)) {
            pg8::Gemm g{WSP(bf16_t, WS_U), WSP(bf16_t, WS_WGATE), NREAL, 3072, D}; pg8::StaticOrder S; S.init(NREAL, 3072, F.G, F.bid);
            pg8::EpiSigmoid E{WSP(bf16_t, WS_GT), 3072};
            pg8::gemm_phase(F.lds, F.tid, g, S, E);
            meta_gemm<0>(F, WSP(bf16_t, WS_U) + (size_t)META_ROW0 * D, WSP(bf16_t, WS_WGATE), 3072, D, 0);
        } }
        SEAM(pb + 5);
        for (int n = 0; n < 3; ++n) {
            if (EN(6) && IN(pb + 6 + n)) {
                pg8::Gemm g{WSP(bf16_t, WS_O) + (size_t)n * MROWS * 512, WSP(bf16_t, WS_WBT) + (size_t)n * 1024 * 512, NREAL, D, 512}; pg8::StaticOrder S; S.init(NREAL, D, F.G, F.bid);
                pg8::EpiBranch E{WSP(bf16_t, WS_MERGED), WSP(bf16_t, WS_GT), n};
                pg8::gemm_phase(F.lds, F.tid, g, S, E);
                meta_gemm<1>(F, WSP(bf16_t, WS_O) + (size_t)n * MROWS * 512 + (size_t)META_ROW0 * 512, WSP(bf16_t, WS_WBT) + (size_t)n * 1024 * 512, D, 512, n);
            }
            SEAM(pb + 6 + n);
        }
        if (EN(9) && IN(pb + 9)) {
            pg8::Gemm g{WSP(bf16_t, WS_MERGED), WSP(bf16_t, WS_WOT), NREAL, D, D}; pg8::StaticOrder S; S.init(NREAL, D, F.G, F.bid);
            pg8::EpiResidual E{OUTP, WSP(float, WS_HMETA)};
            pg8::gemm_phase(F.lds, F.tid, g, S, E);
            meta_gemm<2>(F, WSP(bf16_t, WS_MERGED) + (size_t)META_ROW0 * D, WSP(bf16_t, WS_WOT), D, D, 0);
        }
        SEAM(pb + 9);
        for (int rep = 0; rep < DUPN(10); ++rep) { if (rep) { GRID_BARRIER(); PHASE_FENCE(F); F.dry = 1; asm volatile("" : "+s"(F.dry)); } if (EN(10) && IN(pb + 10)) phase_norm2(F, l); F.dry = 0; }
        SEAM(pb + 10);
        for (int rep = 0; rep < DUPN(11); ++rep) { if (rep) { GRID_BARRIER(); PHASE_FENCE(F); } if (EN(11) && IN(pb + 11)) phase_gather(F, l); }
        SEAM(pb + 11);
        for (int rep = 0; rep < DUPN(12); ++rep) { if (rep) { GRID_BARRIER(); PHASE_FENCE(F); }
        if (EN(12) && IN(pb + 12)) {
            const int ntiles = moe_tables(F, l);
            pg8::Gemm g{WSP(bf16_t, WS_XG), WSP(bf16_t, WS_W1T), XG_ROWS, 512, D};
            pg8::MoeOrder S{F.G, F.bid, 2, ntiles, (const LAS unsigned char*)(F.lds + LDS_TAB + 384), (size_t)512 * 1024 * 2};
            pg8::EpiMoeUp E{WSP(bf16_t, WS_HG)};
            pg8::gemm_phase(F.lds, F.tid, g, S, E);
        } }
        SEAM(pb + 12);
        for (int rep = 0; rep < DUPN(13); ++rep) { if (rep) { GRID_BARRIER(); PHASE_FENCE(F); }
        if (EN(13) && IN(pb + 13)) {
            const int ntiles = moe_tables(F, l);
            pg8::Gemm g{WSP(bf16_t, WS_HG), WSP(bf16_t, WS_W2T), XG_ROWS, D, 256};
            pg8::MoeOrder S{F.G, F.bid, 4, ntiles, (const LAS unsigned char*)(F.lds + LDS_TAB + 384), (size_t)1024 * 256 * 2};
            pg8::EpiMoeDown E{WSP(bf16_t, WS_Y2), WSP(float, SM_WROW)};
            pg8::gemm_phase(F.lds, F.tid, g, S, E);
        } }
        SEAM(pb + 13);
    }
#if DBG_STOP > 0
    if (EN(14) && IN(N_PHASES - 1)) { const int gt = F.bid * NTHREADS + F.tid, NT = F.G * NTHREADS;
#ifdef DBG_LIN
        { const bf16_t* s1 = WSP(bf16_t, DBG_SRC); const bf16_t* s2 = WSP(bf16_t, DBG_SRC2);
          for (size_t i = gt; i < (size_t)NREAL * D; i += NT) F.out[i] = i < (size_t)DBG_N1 ? bf2f(s1[i]) : (i < (size_t)DBG_N1 + DBG_N2 ? bf2f(s2[i - DBG_N1]) : 0.f); }
#else
        if (DBG_LD > 0) { const bf16_t* src = WSP(bf16_t, DBG_SRC); for (size_t i = gt; i < (size_t)NREAL * D; i += NT) { const size_t r = i >> 10, c = i & 1023; F.out[i] = bf2f(src[r * DBG_LD + (c * DBG_LD) / 1024]); } }
#endif
    }
#else
#ifdef DBG_XBAR
    for (int i = 0; i < DBG_XBAR; ++i) { GRID_BARRIER(); PHASE_FENCE(F); }
#endif
    if (EN(14) && IN(N_PHASES - 1)) phase_final(F);
    if (DBG_TA >= 0) { float* tw = WSP(float, WS_CTL) + 2048; if (F.bid == 0 && F.tid == 0) { tw[0] = (float)MISC[17] * 0.01f; }
        GRID_BARRIER(); PHASE_FENCE(F);
        const float v = WSP(float, WS_CTL)[2048] * (1.0f / 200.0f); const int gt = F.bid * NTHREADS + F.tid, NT = F.G * NTHREADS;
        for (size_t i = gt; i < (size_t)NREAL * D; i += NT) F.out[i] = v; }
#endif
#undef IN
#undef SEAM
}

#if MK_ONE_LAUNCH
#ifndef KM_ONE
#define KM_ONE 0xffffffffu
#endif
constexpr unsigned KMASK[1] = {KM_ONE};
#else
constexpr unsigned KMASK[3] = {0x0C19u, 0xC004u, 0x3262u};
#endif
template <unsigned M> static bool setup_kernel(int& per_cu) {
    if (hipFuncSetAttribute((const void*)hybrid_fwd<M>, hipFuncAttributeMaxDynamicSharedMemorySize, LDS_BYTES) != hipSuccess) return false;
    if (hipOccupancyMaxActiveBlocksPerMultiprocessor(&per_cu, (const void*)hybrid_fwd<M>, NTHREADS, LDS_BYTES) != hipSuccess) per_cu = 0;
    (void)hipGetLastError();
    return true;
}
static int phase_kind(int k) { if (k == 0) return 15; if (k == N_PHASES - 1) return 14; const int j = (k - 1) % PH_PER_LAYER; return (j >= 6 && j <= 8) ? 6 : j; }
extern "C" void kernel_launch(void* const* d_in, const int* in_sizes, int n_in, void* d_out, int out_size, void* d_ws, size_t ws_size, hipStream_t stream) {
    static int grid = 0;
    if (grid == 0) {
        if (n_in != 24 || in_sizes[0] != NREAL * D || out_size != NREAL * D || ws_size < WS_END) {
            fprintf(stderr, "kernel_launch: unexpected problem (n_in %d, in0 %d, out %d, ws %zu < %zu); nothing launched\n", n_in, n_in > 0 ? in_sizes[0] : -1, out_size, ws_size, (size_t)WS_END); grid = -1; return; }
        int dev = 0, cus = 0, per_cu = 0; bool ok = true;
        if (hipGetDevice(&dev) != hipSuccess || hipDeviceGetAttribute(&cus, hipDeviceAttributeMultiprocessorCount, dev) != hipSuccess) { grid = -1; return; }
#if MK_ONE_LAUNCH
        ok = setup_kernel<KMASK[0]>(per_cu);
#else
        ok = setup_kernel<KMASK[0]>(per_cu) && setup_kernel<KMASK[1]>(per_cu) && setup_kernel<KMASK[2]>(per_cu);
#endif
        if (!ok) { fprintf(stderr, "kernel_launch: hipFuncSetAttribute failed\n"); grid = -1; return; }
        if (per_cu < 1) fprintf(stderr, "kernel_launch: occupancy query says %d\n", per_cu);
        grid = cus;
    }
    if (grid < 0) return;
    if (hipMemsetAsync((char*)d_ws + WS_CTL, 0, CTL_BYTES, stream) != hipSuccess) return;
    Params p{};
    for (int i = 0; i < 24; ++i) p.in[i] = (const float*)d_in[i];
    p.out = (float*)d_out; p.ws = (unsigned char*)d_ws;
#if MK_ONE_LAUNCH
    p.ph_lo = 0; p.ph_hi = N_PHASES;
    hipLaunchKernelGGL(hybrid_fwd<KMASK[0]>, dim3(grid), dim3(NTHREADS), LDS_BYTES, stream, p);
#else
    for (int k = 0; k < N_PHASES; ++k) { if (DBG_STOP > 0 && k >= DBG_STOP && k != N_PHASES - 1) continue; p.ph_lo = k; p.ph_hi = k + 1; const unsigned bit = 1u << phase_kind(k);
        if (KMASK[0] & bit) hipLaunchKernelGGL(hybrid_fwd<KMASK[0]>, dim3(grid), dim3(NTHREADS), LDS_BYTES, stream, p);
        else if (KMASK[1] & bit) hipLaunchKernelGGL(hybrid_fwd<KMASK[1]>, dim3(grid), dim3(NTHREADS), LDS_BYTES, stream, p);
        else hipLaunchKernelGGL(hybrid_fwd<KMASK[2]>, dim3(grid), dim3(NTHREADS), LDS_BYTES, stream, p); }
#endif
}
```

```cpp
#include <hip/hip_runtime.h>
#include <cstdio>
#include <cstdint>

#define LAS __attribute__((address_space(3)))
typedef unsigned short bf16_t;
typedef short bf16x8 __attribute__((ext_vector_type(8)));
typedef float f32x4 __attribute__((ext_vector_type(4)));
typedef float f32x2 __attribute__((ext_vector_type(2)));
typedef unsigned u32x4 __attribute__((ext_vector_type(4)));
typedef unsigned u32x2 __attribute__((ext_vector_type(2)));

constexpr int D = 1024, NREAL = 16384, MROWS = 16640, META_ROW0 = 16384 + 48, META_END = 16384 + 64;
constexpr int NSLOT = 257;
constexpr int LDP = 5632;
constexpr int PC_AQ = 0, PC_AF = 512, PC_AI = 1024, PC_AG = 1536, PC_BQKV = 2048, PC_BG = 3584, PC_CQ = 4096, PC_CK = 4352, PC_CV = 4608, PC_CG = 5120;
constexpr int IN_COLS = 8728;
constexpr int NTHREADS = 512, NWAVES = 8;
constexpr int XG_ROWS = 40960;

constexpr size_t MiB = 1ull << 20;
constexpr size_t WS_CTL = 0, CTL_BYTES = 1 * MiB;
constexpr int CW_BAR = 4096, CW_CNT = 1024;
constexpr size_t SM_SW1 = 1 * MiB;
constexpr size_t SM_RWG = SM_SW1 + 2 * 24 * 1024 * 4;
constexpr size_t SM_RWE = SM_RWG + 2 * 4 * 1024 * 4;
constexpr size_t SM_LAB = SM_RWE + 2 * 32 * 1024 * 4;
constexpr size_t SM_GK = SM_LAB + 2 * 2 * 512 * 4;
constexpr size_t SM_BETA = SM_GK + (size_t)MROWS * 16 * 4;
constexpr size_t SM_LOGA = SM_BETA + (size_t)MROWS * 4 * 4;
constexpr size_t SM_TOK = SM_LOGA + (size_t)MROWS * 4 * 4;
constexpr size_t SM_WROW = SM_TOK + (size_t)MROWS * 8 * 4;
constexpr size_t SM_DECA = SM_WROW + (size_t)XG_ROWS * 4;
constexpr size_t SM_DECC = SM_DECA + 1028 * 128 * 4;
constexpr size_t SM_DECB = SM_DECC + 1028 * 64 * 4;
constexpr size_t SM_HALO = SM_DECB + 8192;
constexpr size_t SM_END = SM_HALO + 260 * 3 * 1536 * 2;
static_assert(SM_END <= 8 * MiB, "small region");
constexpr size_t WS_HMETA = 8 * MiB;
constexpr size_t WS_WMIX = 9 * MiB;
constexpr size_t WS_WGATE = 20 * MiB;
constexpr size_t WS_WBT = 26 * MiB;
constexpr size_t WS_WOT = 29 * MiB;
constexpr size_t WS_O = 31 * MiB;
constexpr size_t O_STRIDE = (size_t)MROWS * 512 * 2;
constexpr size_t WS_W1T = 31 * MiB;
constexpr size_t WS_W2T = 63 * MiB;
constexpr size_t WS_U = 80 * MiB;
constexpr size_t WS_P = 113 * MiB;
constexpr size_t WS_GT = 113 * MiB;
constexpr size_t WS_MERGED = 211 * MiB;
constexpr size_t WS_XG = 113 * MiB;
constexpr size_t WS_HG = 193 * MiB;
constexpr size_t WS_Y2 = 213 * MiB;
constexpr size_t WS_SCA = 294 * MiB;
constexpr size_t WS_QKD = 303 * MiB;
constexpr size_t WS_SCC = 312 * MiB;
constexpr size_t WS_K1TB = 321 * MiB;
constexpr size_t WS_END = 338 * MiB;

constexpr int LDS_BYTES = 163840;
constexpr int LDS_MISC = LDS_BYTES - 512;
constexpr int LDS_TAB = LDS_BYTES - 1536;
constexpr int LDS_SCRATCH = LDS_TAB;

typedef __bf16 bf16x2v __attribute__((ext_vector_type(2)));
__device__ __forceinline__ unsigned pk2(float lo, float hi) { const f32x2 v = {lo, hi}; return __builtin_bit_cast(unsigned, __builtin_convertvector(v, bf16x2v)); }
__device__ __forceinline__ bf16_t f2bf(float f) { return (bf16_t)(pk2(f, 0.f) & 0xffffu); }
__device__ __forceinline__ float bf2f(bf16_t b) { return __uint_as_float(((unsigned)b) << 16); }
__device__ __forceinline__ float bflo(unsigned w) { return __uint_as_float(w << 16); }
__device__ __forceinline__ float bfhi(unsigned w) { return __uint_as_float(w & 0xffff0000u); }
__device__ __forceinline__ float sigmoidf_(float x) { return __builtin_amdgcn_rcpf(1.0f + __expf(-x)); }
__device__ __forceinline__ float siluf_(float x) { return x * __builtin_amdgcn_rcpf(1.0f + __expf(-x)); }
__device__ __forceinline__ float logsigf_(float x) { return fminf(x, 0.f) - __logf(1.0f + __expf(-fabsf(x))); }
__device__ __forceinline__ float softplusf_(float x) { return fmaxf(x, 0.f) + log1pf(__expf(-fabsf(x))); }
__device__ __forceinline__ bool row_valid(int r) { return r < NREAL || (r >= META_ROW0 && r < META_END); }
__device__ __forceinline__ float wave_sum(float v) {
#define DPP_ADD(ctrl, rmask) v += __int_as_float(__builtin_amdgcn_update_dpp(0, __float_as_int(v), (ctrl), (rmask), 0xf, false))
    DPP_ADD(0x111, 0xf); DPP_ADD(0x112, 0xf); DPP_ADD(0x114, 0xf); DPP_ADD(0x118, 0xf);
    DPP_ADD(0x142, 0xa); DPP_ADD(0x143, 0xc);
#undef DPP_ADD
    return __int_as_float(__builtin_amdgcn_readlane(__float_as_int(v), 63));
}
#define LDS_WAIT() asm volatile("s_waitcnt lgkmcnt(0)" ::: "memory")

#define XB_TMO      128
#define XB_XCNT(j)  (256  + 64 * (j))
#define XB_XSUB(j)  (1280 + 64 * (j))
#define XB_XGEN(j)  (2304 + 64 * (j))
#define XB_TOP      3328
#define XB_TOPGEN   3392
#define XCD_BAR_WORDS 3456
#define XB_SPIN_CAP (1u << 18)
__device__ __forceinline__ unsigned xb_ld(unsigned* p)              { return __hip_atomic_load(p, __ATOMIC_RELAXED, __HIP_MEMORY_SCOPE_AGENT); }
__device__ __forceinline__ unsigned xb_add(unsigned* p, unsigned v) { return __hip_atomic_fetch_add(p, v, __ATOMIC_RELAXED, __HIP_MEMORY_SCOPE_AGENT); }
__device__ __forceinline__ unsigned xb_xcc_id() { return (unsigned)__builtin_amdgcn_s_getreg((3 << 11) | 20) & 0xFu; }
#define XB_SPIN(cond, bar) do { unsigned _sp = 0; while (cond) { __builtin_amdgcn_s_sleep(1); \
    if ((++_sp & 255u) == 0u) { if (xb_ld(&(bar)[XB_TMO])) break; if (_sp > XB_SPIN_CAP) { atomicAdd(&(bar)[XB_TMO], 1u); break; } } } } while (0)
struct XcdBarrier { unsigned* bar; unsigned x; volatile LAS unsigned* st; };
__device__ __forceinline__ XcdBarrier xcd_barrier_post(unsigned* bar, volatile LAS unsigned* st) {
    XcdBarrier b; b.bar = bar; b.x = xb_xcc_id(); b.st = st;
    if (threadIdx.x == 0) (void)xb_add(&bar[XB_XCNT(b.x)], 1u);
    return b;
}
__device__ __forceinline__ void xcd_barrier_complete(unsigned* bar, unsigned x, unsigned& nloc, unsigned& nx, const unsigned G) {
    unsigned sum, cnt, mine, sp = 0u;
    for (;;) {
        sum = 0u; cnt = 0u; mine = 0u;
#pragma unroll
        for (unsigned j = 0; j < 16; ++j) { const unsigned c = xb_ld(&bar[XB_XCNT(j)]); sum += c; cnt += (c > 0u) ? 1u : 0u; mine = (j == x) ? c : mine; }
        if (sum == G) break;
        __builtin_amdgcn_s_sleep(1);
        if ((++sp & 255u) == 0u) { if (xb_ld(&bar[XB_TMO])) break; if (sp > XB_SPIN_CAP) { atomicAdd(&bar[XB_TMO], 1u); break; } }
    }
    nloc = mine > 0u ? mine : 1u; nx = cnt > 0u ? cnt : 1u;
}
__device__ __attribute__((noinline)) void xcd_barrier(unsigned* bar_, unsigned x_, volatile LAS unsigned* st_, int tid_, unsigned G_) {
    XcdBarrier b; b.bar = bar_; b.x = x_; b.st = st_;
    asm volatile("s_waitcnt vmcnt(0)" ::: "memory");
    __syncthreads();
    if (tid_ == 0) {
        unsigned* bar = b.bar;
        __builtin_amdgcn_s_waitcnt(0);
        unsigned nloc = b.st[0], nx = b.st[1];
        if (nloc == 0u) { xcd_barrier_complete(bar, b.x, nloc, nx, G_); b.st[0] = nloc; b.st[1] = nx; }
        const unsigned old = xb_add(&bar[XB_XSUB(b.x)], 1u);
        const unsigned gen = old / nloc;
        if (old + 1u == (gen + 1u) * nloc) {
            __builtin_amdgcn_fence(__ATOMIC_RELEASE, "agent");
            asm volatile("s_waitcnt vmcnt(0)" ::: "memory");
            const unsigned og = xb_add(&bar[XB_TOP], 1u);
            const unsigned tg = og / nx;
            if (og + 1u == (tg + 1u) * nx) xb_add(&bar[XB_TOPGEN], 1u);
            else XB_SPIN(xb_ld(&bar[XB_TOPGEN]) == tg, bar);
            __builtin_amdgcn_fence(__ATOMIC_ACQUIRE, "agent");
            xb_add(&bar[XB_XGEN(b.x)], 1u);
            asm volatile("s_waitcnt vmcnt(0)" ::: "memory");
        } else {
            XB_SPIN(xb_ld(&bar[XB_XGEN(b.x)]) == gen, bar);
            __builtin_amdgcn_fence(__ATOMIC_ACQUIRE, "agent");
            asm volatile("s_waitcnt vmcnt(0)" ::: "memory");
        }
    }
    __syncthreads();
}
namespace pg8 {
constexpr int BM = 256, BK = 64, HALF = 128, HTB = HALF * BK * 2, STAGE_BYTES = 8 * HTB, NXCD = 8, WGM = 8;
__host__ __device__ __forceinline__ int lds_byte(int r, int c) { const int st = (r >> 4) * 2 + (c >> 5), rr = r & 15, cc = c & 31, ob = rr * 64 + cc * 2; return st * 1024 + (ob ^ (((ob >> 9) & 1) << 5)); }
__host__ __device__ __forceinline__ void stage_rc(int b, int& R, int& C) { const int st = b / 1024, sb = b % 1024, swz = sb ^ (((sb >> 9) & 1) << 5); R = (st >> 1) * 16 + swz / 64; C = (st & 1) * 32 + (swz % 64) / 2; }
__host__ __device__ __forceinline__ int perm32(int rho) { const int n = rho >> 4, i = rho & 15; return 8 * (i >> 2) + 4 * n + (i & 3); }

struct Unit { int pm, pn, ex; };
struct Gemm { const bf16_t* A; const bf16_t* Bt; int M, N, K; };

struct StaticOrder {
    int nM, nN, nwg, G, c;
    __device__ void init(int M, int N, int G_, int c_) { nM = M / BM; nN = N / BM; nwg = nM * nN; G = G_; c = c_; }
    __device__ bool next(int i, Unit& u) const {
        const long L = (long)i * G + c; if (L >= nwg) return false;
        int wgid = (int)L; { const int q = nwg / NXCD, r = nwg % NXCD, xcd = wgid % NXCD, off = wgid / NXCD; wgid = (xcd < r ? xcd * (q + 1) : r * (q + 1) + (xcd - r) * q) + off; }
        const int nig = WGM * nN, gid = wgid / nig, fm = gid * WGM, gsz = (nM - fm) < WGM ? (nM - fm) : WGM;
        u.pm = fm + ((wgid % nig) % gsz); u.pn = (wgid % nig) / gsz; u.ex = 0; return true;
    }
    __device__ __forceinline__ void ptrs(const Gemm& g, const Unit& u, const char*& a, const char*& b) const {
        const size_t tstep = (size_t)BM * g.K * 2; a = (const char*)g.A + (size_t)u.pm * tstep; b = (const char*)g.Bt + (size_t)u.pn * tstep; }
};
struct MoeOrder {
    int G, c, npn, ntiles; const LAS unsigned char* tab; size_t estride;
    __device__ bool next(int i, Unit& u) const {
        const long L = (long)i * G + c; if (L >= (long)ntiles * npn) return false;
        u.pm = (int)(L / npn); u.pn = (int)(L % npn); u.ex = (int)tab[u.pm]; return true;
    }
    __device__ __forceinline__ void ptrs(const Gemm& g, const Unit& u, const char*& a, const char*& b) const {
        const size_t tstep = (size_t)BM * g.K * 2; a = (const char*)g.A + (size_t)u.pm * tstep; b = (const char*)g.Bt + (size_t)u.ex * estride + (size_t)u.pn * tstep; }
};

template <class Epi, class Sched>
__device__ __forceinline__ void gemm_phase(LAS unsigned char* lds, const int tid, const Gemm g, const Sched& S, const Epi& E) {
    const int wid = __builtin_amdgcn_readfirstlane(tid >> 6), lane = tid & 63, wr = wid >> 2, wc = wid & 3, fr = lane & 15, fq = lane >> 4;
    int K = g.K; asm volatile("" : "+s"(K));
    const int nt = K / BK;
    unsigned voffA[2], voffB[2];
#pragma unroll
    for (int i = 0; i < 2; ++i) { int R, C; stage_rc(tid * 16 + i * 8192, R, C); const int Rb = Epi::PERM ? ((R & ~31) + perm32(R & 31)) : R;
        voffA[i] = (unsigned)(R * K + C) * 2u; voffB[i] = (unsigned)(Rb * K + C) * 2u; }
    const size_t kstep = (size_t)(BK * 2);
    const size_t hstep = (size_t)HALF * K * 2;
    const unsigned ldsw = (unsigned)wid * 1024u;
    const int aoff = lds_byte(wr * 64 + fr, fq * 8), boff = lds_byte(wc * 32 + fr, fq * 8);
#define PG8_SA(b, h) (((b) * 2 + (h)) * HTB)
#define PG8_SB(b, h) ((4 + (b) * 2 + (h)) * HTB)
#define PG8_STAGE(bufoff, gbase, voff) do { _Pragma("unroll") for (int _i = 0; _i < 2; ++_i) \
        __builtin_amdgcn_global_load_lds((const unsigned*)((const char*)(gbase) + (voff)[_i]), (LAS unsigned*)(lds + (bufoff) + ldsw + _i * 8192), 16, 0, 0); } while (0)
#define PG8_LDA(dst, b, h) do { _Pragma("unroll") for (int m = 0; m < 4; ++m) _Pragma("unroll") for (int k = 0; k < 2; ++k) dst[m][k] = *(const LAS bf16x8*)(lds + PG8_SA(b, h) + aoff + m * 2048 + k * 1024); } while (0)
#define PG8_LDB(dst, b, h) do { _Pragma("unroll") for (int n = 0; n < 2; ++n) _Pragma("unroll") for (int k = 0; k < 2; ++k) dst[n][k] = *(const LAS bf16x8*)(lds + PG8_SB(b, h) + boff + n * 2048 + k * 1024); } while (0)
#define PG8_MMA(ai, bj, At, Bt) do { __builtin_amdgcn_s_setprio(1); _Pragma("unroll") for (int m = 0; m < 4; ++m) _Pragma("unroll") for (int n = 0; n < 2; ++n) _Pragma("unroll") for (int k = 0; k < 2; ++k) \
        acc[ai][bj][m][n] = __builtin_amdgcn_mfma_f32_16x16x32_bf16(Bt[n][k], At[m][k], acc[ai][bj][m][n], 0, 0, 0); __builtin_amdgcn_s_setprio(0); } while (0)
#define PG8_WAIT_V(n) asm volatile("s_waitcnt vmcnt(" #n ")" ::: "memory")
#define PG8_WAIT_L(n) asm volatile("s_waitcnt lgkmcnt(" #n ")" ::: "memory")
#define PG8_BAR __builtin_amdgcn_s_barrier()
#define PG8_SCHED __builtin_amdgcn_sched_barrier(0)
    Unit cur, nxt; int ui = 0;
    if (!S.next(0, cur)) return;
    f32x4 acc[2][2][4][2];
#pragma unroll
    for (int a = 0; a < 2; ++a)
#pragma unroll
        for (int b = 0; b < 2; ++b)
#pragma unroll
            for (int m = 0; m < 4; ++m)
#pragma unroll
                for (int n = 0; n < 2; ++n) acc[a][b][m][n] = (f32x4){0.f, 0.f, 0.f, 0.f};
    bf16x8 At[4][2], B0[2][2], B1[2][2];
    const char* cA; const char* cB; S.ptrs(g, cur, cA, cB);
    PG8_STAGE(PG8_SB(0, 0), cB, voffB); PG8_STAGE(PG8_SA(0, 0), cA, voffA); PG8_STAGE(PG8_SB(0, 1), cB + hstep, voffB); PG8_STAGE(PG8_SA(0, 1), cA + hstep, voffA);
    if (wr == 1) PG8_BAR;
    PG8_WAIT_V(4); PG8_BAR;
    PG8_STAGE(PG8_SB(1, 0), cB + kstep, voffB); PG8_STAGE(PG8_SA(1, 0), cA + kstep, voffA); PG8_STAGE(PG8_SB(1, 1), cB + hstep + kstep, voffB);
    PG8_WAIT_V(6); PG8_BAR;
    for (;;) {
        const bool has_next = S.next(ui + 1, nxt);
        const char* nA = cA; const char* nB = cB; if (has_next) S.ptrs(g, nxt, nA, nB);
        for (int t = 0; t < nt; t += 2) {
            const bool last = (t == nt - 2);
            const char* a1 = cA + (size_t)(t + 1) * kstep;
            const char* a2 = last ? nA : cA + (size_t)(t + 2) * kstep; const char* b2 = last ? nB : cB + (size_t)(t + 2) * kstep;
            const char* a3 = a2 + kstep; const char* b3 = b2 + kstep;
            PG8_LDB(B0, 0, 0); PG8_SCHED; PG8_LDA(At, 0, 0); PG8_STAGE(PG8_SA(1, 1), a1 + hstep, voffA);
            PG8_WAIT_L(8); PG8_BAR; PG8_WAIT_L(0); PG8_MMA(0, 0, At, B0); PG8_BAR; PG8_SCHED;
            PG8_LDB(B1, 0, 1); PG8_STAGE(PG8_SB(0, 0), b2, voffB);
            PG8_BAR; PG8_WAIT_L(0); PG8_MMA(0, 1, At, B1); PG8_BAR;
            PG8_LDA(At, 0, 1); PG8_STAGE(PG8_SA(0, 0), a2, voffA);
            PG8_BAR; PG8_WAIT_L(0); PG8_MMA(1, 0, At, B0); PG8_BAR; PG8_SCHED;
            PG8_STAGE(PG8_SB(0, 1), b2 + hstep, voffB);
            PG8_WAIT_V(6); PG8_BAR; PG8_MMA(1, 1, At, B1); PG8_BAR;
            PG8_LDB(B0, 1, 0); PG8_SCHED; PG8_LDA(At, 1, 0); PG8_STAGE(PG8_SA(0, 1), a2 + hstep, voffA);
            PG8_WAIT_L(8); PG8_BAR; PG8_WAIT_L(0); PG8_MMA(0, 0, At, B0); PG8_BAR; PG8_SCHED;
            PG8_LDB(B1, 1, 1); PG8_STAGE(PG8_SB(1, 0), b3, voffB);
            PG8_BAR; PG8_WAIT_L(0); PG8_MMA(0, 1, At, B1); PG8_BAR;
            PG8_LDA(At, 1, 1); PG8_STAGE(PG8_SA(1, 0), a3, voffA);
            PG8_BAR; PG8_WAIT_L(0); PG8_MMA(1, 0, At, B0); PG8_BAR; PG8_SCHED;
            PG8_STAGE(PG8_SB(1, 1), b3 + hstep, voffB);
            PG8_WAIT_V(6); PG8_BAR; PG8_MMA(1, 1, At, B1); PG8_BAR;
        }
        E(acc, cur, wr, wc, fr, fq);
        if (!has_next) break;
#pragma unroll
        for (int a = 0; a < 2; ++a)
#pragma unroll
            for (int b = 0; b < 2; ++b)
#pragma unroll
                for (int m = 0; m < 4; ++m)
#pragma unroll
                    for (int n = 0; n < 2; ++n) acc[a][b][m][n] = (f32x4){0.f, 0.f, 0.f, 0.f};
        cur = nxt; cA = nA; cB = nB; ++ui;
    }
    PG8_WAIT_V(0);
    if (wr == 0) PG8_BAR;
    PG8_BAR;
#undef PG8_SA
#undef PG8_SB
#undef PG8_STAGE
#undef PG8_LDA
#undef PG8_LDB
#undef PG8_MMA
#undef PG8_WAIT_V
#undef PG8_WAIT_L
#undef PG8_BAR
#undef PG8_SCHED
}

#define EPI_PERM_LOOP(...) \
    _Pragma("unroll") for (int ai = 0; ai < 2; ++ai) _Pragma("unroll") for (int m = 0; m < 4; ++m) { const int row = u.pm * BM + ai * HALF + wr * 64 + m * 16 + fr; \
        _Pragma("unroll") for (int bj = 0; bj < 2; ++bj) { const int col0 = u.pn * BM + bj * HALF + wc * 32 + 8 * fq; f32x4 v0 = acc[ai][bj][m][0], v1 = acc[ai][bj][m][1]; __VA_ARGS__ } if (EPI_PIN) __builtin_amdgcn_sched_barrier(0); }

struct EpiInProj {
    static constexpr bool PERM = true, EPI_PIN = true;
    bf16_t* P; bf16_t* halo;
    __device__ __forceinline__ void operator()(const f32x4 (&acc)[2][2][4][2], const Unit& u, int wr, int wc, int fr, int fq) const {
        const bool is_qkv = u.pn >= 8 && u.pn < 14;
        EPI_PERM_LOOP({
            u32x4 w; w.x = pk2(v0[0], v0[1]); w.y = pk2(v0[2], v0[3]); w.z = pk2(v1[0], v1[1]); w.w = pk2(v1[2], v1[3]);
            *(u32x4*)(P + (size_t)row * LDP + col0) = w;
            if (is_qkv && (row & 63) >= 61) *(u32x4*)(halo + ((size_t)(row >> 6) * 3 + ((row & 63) - 61)) * 1536 + (col0 - PC_BQKV)) = w;
        })
    }
};
__device__ __forceinline__ float lfg(float lb, float oml, float x) { return __logf(lb + oml * __builtin_amdgcn_rcpf(1.0f + __expf(-x)) + 1e-30f); }
struct EpiSigmoid {
    static constexpr bool PERM = true, EPI_PIN = true;
    bf16_t* O; int ldc;
    __device__ __forceinline__ void operator()(const f32x4 (&acc)[2][2][4][2], const Unit& u, int wr, int wc, int fr, int fq) const {
        EPI_PERM_LOOP({
            u32x4 w; w.x = pk2(sigmoidf_(v0[0]), sigmoidf_(v0[1])); w.y = pk2(sigmoidf_(v0[2]), sigmoidf_(v0[3])); w.z = pk2(sigmoidf_(v1[0]), sigmoidf_(v1[1])); w.w = pk2(sigmoidf_(v1[2]), sigmoidf_(v1[3]));
            *(u32x4*)(O + (size_t)row * ldc + col0) = w;
        })
    }
};
struct EpiBranch {
    static constexpr bool PERM = true, EPI_PIN = false;
    bf16_t* merged; const bf16_t* gt; int n;
    __device__ __forceinline__ void operator()(const f32x4 (&acc)[2][2][4][2], const Unit& u, int wr, int wc, int fr, int fq) const {
        EPI_PERM_LOOP({
            const u32x4 gw = *(const u32x4*)(gt + (size_t)row * 3072 + n * 1024 + col0);
            float x[8] = {v0[0] * bflo(gw.x), v0[1] * bfhi(gw.x), v0[2] * bflo(gw.y), v0[3] * bfhi(gw.y), v1[0] * bflo(gw.z), v1[1] * bfhi(gw.z), v1[2] * bflo(gw.w), v1[3] * bfhi(gw.w)};
            bf16_t* mp = merged + (size_t)row * 1024 + col0;
            if (n != 0) { const u32x4 o = *(const u32x4*)mp; x[0] += bflo(o.x); x[1] += bfhi(o.x); x[2] += bflo(o.y); x[3] += bfhi(o.y); x[4] += bflo(o.z); x[5] += bfhi(o.z); x[6] += bflo(o.w); x[7] += bfhi(o.w); }
            u32x4 w; w.x = pk2(x[0], x[1]); w.y = pk2(x[2], x[3]); w.z = pk2(x[4], x[5]); w.w = pk2(x[6], x[7]);
            *(u32x4*)mp = w;
        })
    }
};
struct EpiResidual {
    static constexpr bool PERM = false;
    float* hreal; float* hmeta;
    __device__ __forceinline__ void operator()(const f32x4 (&acc)[2][2][4][2], const Unit& u, int wr, int wc, int fr, int fq) const {
#pragma unroll
        for (int ai = 0; ai < 2; ++ai)
#pragma unroll
            for (int m = 0; m < 4; ++m) { const int row = u.pm * BM + ai * HALF + wr * 64 + m * 16 + fr;
                float* rowp = (row < NREAL ? hreal + (size_t)row * D : hmeta + (size_t)(row - NREAL) * D) + u.pn * BM + wc * 32 + 4 * fq;
#pragma unroll
                for (int bj = 0; bj < 2; ++bj)
#pragma unroll
                    for (int n = 0; n < 2; ++n) { f32x4* p = (f32x4*)(rowp + bj * HALF + n * 16); *p = *p + acc[ai][bj][m][n]; } }
    }
};
struct EpiMoeUp {
    static constexpr bool PERM = true, EPI_PIN = true;
    bf16_t* H;
    __device__ __forceinline__ void operator()(const f32x4 (&acc)[2][2][4][2], const Unit& u, int wr, int wc, int fr, int fq) const {
        EPI_PERM_LOOP({
            const int hc = col0 >> 1;
            u32x2 w; w.x = pk2(siluf_(v0[0]) * v1[0], siluf_(v0[1]) * v1[1]); w.y = pk2(siluf_(v0[2]) * v1[2], siluf_(v0[3]) * v1[3]);
            *(u32x2*)(H + (size_t)row * 256 + hc) = w;
        })
    }
};
struct EpiMoeDown {
    static constexpr bool PERM = true, EPI_PIN = false;
    bf16_t* Y; const float* wrow;
    __device__ __forceinline__ void operator()(const f32x4 (&acc)[2][2][4][2], const Unit& u, int wr, int wc, int fr, int fq) const {
        EPI_PERM_LOOP({
            const float s = wrow[row];
            u32x4 w; w.x = pk2(v0[0] * s, v0[1] * s); w.y = pk2(v0[2] * s, v0[3] * s); w.z = pk2(v1[0] * s, v1[1] * s); w.w = pk2(v1[2] * s, v1[3] * s);
            *(u32x4*)(Y + (size_t)row * 1024 + col0) = w;
        })
    }
};
}
#define GAS __attribute__((address_space(1)))
struct Params { const float* in[24]; float* out; unsigned char* ws; int ph_lo, ph_hi; };
struct Frame {
    LAS unsigned char* lds; int tid, lane, wave, G, bid;
    __attribute__((address_space(1))) float* out; __attribute__((address_space(1))) unsigned char* ws; const float* const __attribute__((address_space(4)))* inp; int dry;
};
#define PHASE_FENCE(F) do { asm volatile("" : "+s"((F).ws), "+s"((F).out), "+s"((F).inp), "+v"((F).tid), "+s"((F).bid), "+s"((F).G)); \
    (F).lane = (F).tid & 63; (F).wave = __builtin_amdgcn_readfirstlane((F).tid >> 6); } while (0)
__device__ __forceinline__ const float* inp_ptr(const float* const __attribute__((address_space(4)))* inp, int i) { GAS const float* q = (GAS const float*)inp[i]; asm volatile("" : "+s"(q)); return (const float*)q; }
#define INP(i) inp_ptr(F.inp, (i))
#define WSP(T, off) ((T*)(GAS T*)(F.ws + (off)))
enum { I_X = 0, I_META, I_NORM_MIX, I_W_IN, I_LB, I_HGRN_NORM, I_GDN_CONV, I_GDN_ALOG, I_GDN_DT, I_GDN_NORM, I_GLA_W2, I_GLA_B, I_GLA_NORM, I_W_BRANCH, I_W_OUT, I_NORM_FFN,
       I_RG_W, I_RG_B, I_RE_W, I_RE_B, I_EW_GATE, I_EW_UP, I_EW_DOWN, I_NORM_FINAL };

__device__ __forceinline__ void transpose_item(const float* W, int ldw, int K, int nblk, bf16_t* WT, int row_off, int rowmode, LAS float* scr, int item, int lane) {
    const int kb = item / nblk, nb = item % nblk, k0 = 64 * kb, n0 = 32 * nb;
    { f32x4 v[8]; const int n4 = 4 * (lane & 7);
#pragma unroll
        for (int i = 0; i < 8; ++i) v[i] = *(const f32x4*)(W + (size_t)(k0 + 8 * i + (lane >> 3)) * ldw + n0 + n4);
#pragma unroll
        for (int i = 0; i < 8; ++i) { LAS float* d = scr + (8 * i + (lane >> 3)) * 33 + n4; d[0] = v[i][0]; d[1] = v[i][1]; d[2] = v[i][2]; d[3] = v[i][3]; } }
    LDS_WAIT(); asm volatile("" ::: "memory");
    const int c = lane & 7;
#pragma unroll
    for (int j = 0; j < 4; ++j) { const int n = (lane >> 3) + 8 * j; const LAS float* s = scr + (8 * c) * 33 + n;
        u32x4 o; o.x = pk2(s[0 * 33], s[1 * 33]); o.y = pk2(s[2 * 33], s[3 * 33]); o.z = pk2(s[4 * 33], s[5 * 33]); o.w = pk2(s[6 * 33], s[7 * 33]);
        const int nn = n0 + n; const int wrow = rowmode == 0 ? row_off + nn : row_off + 8 * (nn >> 2) + (nn & 3) + (rowmode == 2 ? 4 : 0);
        *(u32x4*)(WT + (size_t)wrow * K + k0 + 8 * c) = o; }
    LDS_WAIT(); asm volatile("" ::: "memory");
}

__device__ __forceinline__ void phase_pre(Frame& F) {
    const int gt = F.bid * NTHREADS + F.tid, NT = F.G * NTHREADS;
    float* sw1 = WSP(float, SM_SW1); float* rwg = WSP(float, SM_RWG); float* rwe = WSP(float, SM_RWE); float* lab = WSP(float, SM_LAB);
    for (int i = gt; i < 2 * 24 * 1024; i += NT) { const int l = i / (24 * 1024), c = (i / 1024) % 24, k = i % 1024;
        const int col = c < 16 ? 5128 + c : (c < 20 ? 3584 + (c - 16) : 3588 + (c - 20));
        sw1[i] = INP(I_W_IN)[((size_t)l * 1024 + k) * IN_COLS + col]; }
    for (int i = gt; i < 2 * 4 * 1024; i += NT) { const int l = i / (4 * 1024), c = (i / 1024) % 4, k = i % 1024; rwg[i] = INP(I_RG_W)[((size_t)l * 1024 + k) * 4 + c]; }
    for (int i = gt; i < 2 * 32 * 1024; i += NT) { const int l = i / (32 * 1024), c = (i / 1024) % 32, k = i % 1024; rwe[i] = INP(I_RE_W)[((size_t)l * 1024 + k) * 32 + c]; }
    for (int i = gt; i < 2 * 512; i += NT) { const int l = i / 512, c = i % 512; const float l0 = INP(I_LB)[c], l1 = INP(I_LB)[512 + c];
        const float p1 = 1.0f / (1.0f + expf(l0 - l1)); const float lb = l == 0 ? 0.f : p1;
        lab[l * 1024 + c] = lb; lab[l * 1024 + 512 + c] = 1.0f - lb; }
}

__device__ __forceinline__ void convert_layer_weights(Frame& F, int l) {
    LAS float* scr = (LAS float*)(F.lds + F.wave * 16384);
    const int gw = F.bid * NWAVES + F.wave, NGW = F.G * NWAVES;
    const float* win = INP(I_W_IN) + (size_t)l * 1024 * IN_COLS;
    constexpr int I_MIX = 16 * 176, I_GATE = 16 * 96, I_BR = 8 * 32, I_OUT = 16 * 32, NITEMS = I_MIX + I_GATE + 3 * I_BR + I_OUT;
    for (int it = gw; it < NITEMS; it += NGW) {
        int r = it;
        if (r < I_MIX) { const int nb = r % 176, n0 = 32 * nb; const int shift = n0 < 3584 ? 0 : (n0 < 5120 ? 8 : 24);
            transpose_item(win + shift, IN_COLS, 1024, 176, WSP(bf16_t, WS_WMIX), 0, 0, scr, r, F.lane); continue; } r -= I_MIX;
        if (r < I_GATE) { transpose_item(win + 5656, IN_COLS, 1024, 96, WSP(bf16_t, WS_WGATE), 0, 0, scr, r, F.lane); continue; } r -= I_GATE;
        if (r < 3 * I_BR) { const int n = r / I_BR; transpose_item(INP(I_W_BRANCH) + ((size_t)l * 3 + n) * 512 * 1024, 1024, 512, 32, WSP(bf16_t, WS_WBT) + (size_t)n * 1024 * 512, 0, 0, scr, r % I_BR, F.lane); continue; } r -= 3 * I_BR;
        transpose_item(INP(I_W_OUT) + (size_t)l * 1024 * 1024, 1024, 1024, 32, WSP(bf16_t, WS_WOT), 0, 0, scr, r, F.lane);
    }
}
__device__ __forceinline__ void convert_expert_weights(Frame& F, int l) {
    LAS float* scr = (LAS float*)(F.lds + F.wave * 16384);
    const int gw = F.bid * NWAVES + F.wave, NGW = F.G * NWAVES;
    constexpr int I_G = 16 * 8, I_D = 4 * 32, PER = 2 * I_G + I_D;
    for (int it = gw; it < 32 * PER; it += NGW) {
        const int e = it / PER; int r = it % PER;
        bf16_t* w1t = WSP(bf16_t, WS_W1T) + (size_t)e * 512 * 1024; bf16_t* w2t = WSP(bf16_t, WS_W2T) + (size_t)e * 1024 * 256;
        if (r < I_G) { transpose_item(INP(I_EW_GATE) + ((size_t)l * 32 + e) * 1024 * 256, 256, 1024, 8, w1t, 0, 1, scr, r, F.lane); continue; } r -= I_G;
        if (r < I_G) { transpose_item(INP(I_EW_UP) + ((size_t)l * 32 + e) * 1024 * 256, 256, 1024, 8, w1t, 0, 2, scr, r, F.lane); continue; } r -= I_G;
        transpose_item(INP(I_EW_DOWN) + ((size_t)l * 32 + e) * 256 * 1024, 1024, 256, 32, w2t, 0, 0, scr, r, F.lane);
    }
}

#define OUTP ((float*)F.out)
__device__ __forceinline__ float* hrow(Frame& F, int r) { return r < NREAL ? OUTP + (size_t)r * D : WSP(float, WS_HMETA) + (size_t)(r - NREAL) * D; }

__device__ __forceinline__ void load_row16(const float* p, int lane, float (&x)[16]) {
#pragma unroll
    for (int j = 0; j < 4; ++j) { const f32x4 v = *((const f32x4*)p + lane + 64 * j); x[4 * j] = v[0]; x[4 * j + 1] = v[1]; x[4 * j + 2] = v[2]; x[4 * j + 3] = v[3]; }
}
__device__ __forceinline__ void add_bf16_row16(const bf16_t* p, int lane, float (&x)[16]) {
#pragma unroll
    for (int j = 0; j < 4; ++j) { const u32x2 w = *((const u32x2*)p + lane + 64 * j); x[4 * j] += bflo(w.x); x[4 * j + 1] += bfhi(w.x); x[4 * j + 2] += bflo(w.y); x[4 * j + 3] += bfhi(w.y); }
}
__device__ __forceinline__ void store_row16(float* p, int lane, const float (&x)[16]) {
#pragma unroll
    for (int j = 0; j < 4; ++j) *((f32x4*)p + lane + 64 * j) = (f32x4){x[4 * j], x[4 * j + 1], x[4 * j + 2], x[4 * j + 3]};
}
__device__ __forceinline__ void store_bf16_row16(bf16_t* p, int lane, const float (&x)[16]) {
#pragma unroll
    for (int j = 0; j < 4; ++j) { u32x2 w; w.x = pk2(x[4 * j], x[4 * j + 1]); w.y = pk2(x[4 * j + 2], x[4 * j + 3]); *((u32x2*)p + lane + 64 * j) = w; }
}
__device__ __forceinline__ void fetch_h_row(Frame& F, int l, int r, float (&x)[16]) {
    if (l == 0) {
        const float* src = r < NREAL ? INP(I_X) + (size_t)r * D : INP(I_META) + (size_t)(r - META_ROW0) * D;
        load_row16(src, F.lane, x);
    } else {
        load_row16(hrow(F, r), F.lane, x);
        const unsigned* tok = WSP(unsigned, SM_TOK) + (size_t)r * 8;
        const unsigned g0 = tok[6], g1 = tok[7];
        add_bf16_row16(WSP(bf16_t, WS_Y2) + (size_t)g0 * 1024, F.lane, x);
        add_bf16_row16(WSP(bf16_t, WS_Y2) + (size_t)g1 * 1024, F.lane, x);
    }
}

__device__ __forceinline__ void phase_norm1(Frame& F, int l) {
    convert_layer_weights(F, l);
    __syncthreads();
    LAS float* sw = (LAS float*)F.lds;
    { const float* src = WSP(float, SM_SW1) + (size_t)l * 24 * 1024; for (int i = F.tid; i < 24 * 1024 / 4; i += NTHREADS) ((LAS f32x4*)sw)[i] = ((const f32x4*)src)[i]; }
    __syncthreads();
    const int gw = F.bid * NWAVES + F.wave, NGW = F.G * NWAVES, lane = F.lane;
    const float* nw = INP(I_NORM_MIX) + (size_t)l * D;
    float wv[16]; load_row16(nw, lane, wv);
    bf16_t* U = WSP(bf16_t, WS_U);
    const float alog_l = (lane >= 20 && lane < 24) ? INP(I_GDN_ALOG)[l * 4 + (lane - 20)] : 0.f, dt_l = (lane >= 20 && lane < 24) ? INP(I_GDN_DT)[l * 4 + (lane - 20)] : 0.f;
    const float nega_l = -expf(alog_l);
    for (int g = gw; g < MROWS / 4; g += NGW) {
        const int r0 = 4 * g;
        if (!row_valid(r0)) {
            float z[16];
#pragma unroll
            for (int j = 0; j < 16; ++j) z[j] = 0.f;
#pragma unroll
            for (int i = 0; i < 4; ++i) { store_bf16_row16(U + (size_t)(r0 + i) * D, lane, z); if (l == 0) store_row16(hrow(F, r0 + i), lane, z);
                if (lane < 16) WSP(float, SM_GK)[(size_t)(r0 + i) * 16 + lane] = 0.f;
                else if (lane < 20) WSP(float, SM_BETA)[(size_t)(r0 + i) * 4 + (lane - 16)] = 0.f;
                else if (lane < 24) WSP(float, SM_LOGA)[(size_t)(r0 + i) * 4 + (lane - 20)] = 0.f; }
            continue;
        }
        float x[4][16];
#pragma unroll
        for (int i = 0; i < 4; ++i) {
            fetch_h_row(F, l, r0 + i, x[i]);
            store_row16(hrow(F, r0 + i), lane, x[i]);
            float ss = 0.f;
#pragma unroll
            for (int j = 0; j < 16; ++j) ss += x[i][j] * x[i][j];
            const float rstd = rsqrtf(wave_sum(ss) * (1.0f / D) + 1e-6f);
#pragma unroll
            for (int j = 0; j < 16; ++j) x[i][j] = x[i][j] * rstd * wv[j];
            store_bf16_row16(U + (size_t)(r0 + i) * D, lane, x[i]);
        }
        float ov[4] = {0.f, 0.f, 0.f, 0.f};
#pragma unroll 2
        for (int c = 0; c < 24; ++c) {
            float a0 = 0.f, a1 = 0.f, a2 = 0.f, a3 = 0.f;
#pragma unroll
            for (int j = 0; j < 4; ++j) { const f32x4 w = *((const LAS f32x4*)(sw + c * 1024) + lane + 64 * j);
#pragma unroll
                for (int e = 0; e < 4; ++e) { a0 += x[0][4 * j + e] * w[e]; a1 += x[1][4 * j + e] * w[e]; a2 += x[2][4 * j + e] * w[e]; a3 += x[3][4 * j + e] * w[e]; } }
            a0 = wave_sum(a0); a1 = wave_sum(a1); a2 = wave_sum(a2); a3 = wave_sum(a3);
            if (lane == c) { ov[0] = a0; ov[1] = a1; ov[2] = a2; ov[3] = a3; }
        }
        float* GK = WSP(float, SM_GK); float* BETA = WSP(float, SM_BETA); float* LOGA = WSP(float, SM_LOGA);
#pragma unroll
        for (int i = 0; i < 4; ++i) {
            const float v = ov[i]; const int r = r0 + i;
            if (lane < 16) GK[(size_t)r * 16 + lane] = v;
            else if (lane < 20) BETA[(size_t)r * 4 + (lane - 16)] = sigmoidf_(v);
            else if (lane < 24) { const int h = lane - 20; LOGA[(size_t)r * 4 + h] = nega_l * softplusf_(v + dt_l); }
        }
    }
}

__device__ __forceinline__ bf16x8 mk8(u32x4 w) { return __builtin_bit_cast(bf16x8, w); }
__device__ __forceinline__ bf16x8 mk8(u32x2 lo, u32x2 hi) { u32x4 w; w.x = lo.x; w.y = lo.y; w.z = hi.x; w.w = hi.y; return __builtin_bit_cast(bf16x8, w); }
__device__ __forceinline__ bf16x8 pack_acc2(const f32x4& a, const f32x4& b) { u32x4 w; w.x = pk2(a[0], a[1]); w.y = pk2(a[2], a[3]); w.z = pk2(b[0], b[1]); w.w = pk2(b[2], b[3]); return __builtin_bit_cast(bf16x8, w); }
#define MFMA16(a, b, c) __builtin_amdgcn_mfma_f32_16x16x32_bf16((a), (b), (c), 0, 0, 0)

__device__ __forceinline__ int permpos(int k) { const int kk = k & 31; return (k & ~31) + ((kk & 16) ? 8 * ((kk - 16) >> 2) + 4 + (kk & 3) : 8 * (kk >> 2) + (kk & 3)); }
__device__ __forceinline__ float ldbf(GAS const bf16_t* p) { return bf2f(*p); }
#define ROWB(P, row, col) ((GAS const char*)(P) + ((size_t)(row) * LDP + (col)) * 2)
__device__ __forceinline__ float ldrow(GAS const char* rb, unsigned voff) { return bf2f(*(GAS const bf16_t*)(rb + voff)); }
__device__ __forceinline__ unsigned ldrow_u(GAS const char* rb, unsigned voff) { return (unsigned)*(GAS const bf16_t*)(rb + voff); }
__device__ __forceinline__ void strow(GAS const char* rb, unsigned voff, bf16_t v) { *(GAS bf16_t*)(rb + voff) = v; }

template <int DK, bool IS_A>
__device__ __forceinline__ void prep_gla(Frame& F, int l, int ug) {
    constexpr int QP = DK + 8, SUB = 2 * 64 * QP * 2 + 1024;
    int tid = F.tid; asm volatile("" : "+v"(tid));
    const int sg = __builtin_amdgcn_readfirstlane(tid >> 8), lt = tid & 255, c = lt & 127, hf = __builtin_amdgcn_readfirstlane(lt >> 7);
    const int unit = 2 * ug + sg, slot = unit >> 2, h = unit & 3, row0 = slot * 64, r0 = row0 + 32 * hf;
    const int qcol = IS_A ? PC_AQ + h * 128 : PC_CQ + h * 64, kcol = IS_A ? PC_AF + h * 128 : PC_CK + h * 64, vcol = IS_A ? PC_AI + h * 128 : PC_CV + h * 128;
    bf16_t* P = WSP(bf16_t, WS_P);
    LAS bf16_t* qt = (LAS bf16_t*)(F.lds + sg * SUB);
    LAS bf16_t* kt = qt + 64 * QP;
    LAS float* tot = (LAS float*)(kt + 64 * QP);
    const bool act = c < DK;
    float b[32];
    const unsigned vo = (unsigned)c * 2u, vop = (unsigned)permpos(c) * 2u;
    if (act) {
        float run = 0.f;
        if (IS_A) { const float* lab = WSP(float, SM_LAB) + l * 1024 + h * 128 + c; const float la = lab[0], lb = lab[512];
#pragma unroll
            for (int t = 0; t < 32; ++t) { run += pg8::lfg(la, lb, ldrow(ROWB(P, r0 + t, kcol), vo)); b[t] = run; }
        } else { float w2c[16]; const float* w2 = INP(I_GLA_W2) + (size_t)l * 16 * 256 + h * 64 + c; const float bias = INP(I_GLA_B)[l * 256 + h * 64 + c];
#pragma unroll
            for (int j = 0; j < 16; ++j) w2c[j] = w2[j * 256];
            const float* gk = WSP(float, SM_GK) + (size_t)r0 * 16;
#pragma unroll
            for (int t = 0; t < 32; ++t) { float s = bias;
#pragma unroll
                for (int j = 0; j < 16; ++j) s += gk[t * 16 + j] * w2c[j];
                run += logsigf_(s) * (1.0f / 16.0f); b[t] = run; }
        }
        tot[hf * 128 + c] = run;
    }
    __syncthreads();
    unsigned q1p[16], k1p[16];
    if (act) {
        const float bm = tot[c], bl = bm + tot[128 + c], boff = hf ? bm : 0.f;
        if (hf == 0 && !F.dry) (IS_A ? WSP(float, SM_DECA) + (size_t)unit * 128 : WSP(float, SM_DECC) + (size_t)unit * 64)[c] = __expf(bl);
#pragma unroll
        for (int t2 = 0; t2 < 16; ++t2) { float q1v[2], k1v[2];
#pragma unroll
            for (int u = 0; u < 2; ++u) { const int t = 2 * t2 + u; const float bt = b[t] + boff;
                const float qr = ldrow(ROWB(P, r0 + t, qcol), vo), q = IS_A ? siluf_(qr) * 0.08838834764831845f : qr * 0.125f;
                float k;
                if (IS_A) { const float lf = t == 0 ? b[0] : b[t] - b[t - 1]; k = row_valid(r0 + t) ? 1.0f - __expf(lf) : 0.f; } else k = ldrow(ROWB(P, r0 + t, kcol), vo);
                q1v[u] = q * __expf(bt); k1v[u] = k * __expf(bl - bt);
                qt[(32 * hf + t) * QP + c] = f2bf(q * __expf(fminf(bt - bm, 80.f))); kt[(32 * hf + t) * QP + c] = f2bf(k * __expf(fminf(bm - bt, 80.f))); }
            q1p[t2] = pk2(q1v[0], q1v[1]); k1p[t2] = pk2(k1v[0], k1v[1]); }
    }
    __syncthreads();
    if (act) {
        if (!F.dry) {
#pragma unroll
        for (int t2 = 0; t2 < 16; ++t2) { strow(ROWB(P, r0 + 2 * t2, qcol), vop, (bf16_t)(q1p[t2] & 0xffffu)); strow(ROWB(P, r0 + 2 * t2 + 1, qcol), vop, (bf16_t)(q1p[t2] >> 16)); } }
        bf16_t* kd = (IS_A ? P + (size_t)(row0 + (c >> 1)) * LDP + kcol + (c & 1) * 64 : P + (size_t)(row0 + c) * LDP + kcol) + 32 * hf;
#pragma unroll
        for (int o = 0; o < 4; ++o) if (!F.dry) *(u32x4*)(kd + 8 * o) = (u32x4){k1p[4 * o], k1p[4 * o + 1], k1p[4 * o + 2], k1p[4 * o + 3]};
    }
    { const int ws = (tid >> 6) & 3, lane = tid & 63, fr = lane & 15, fq = lane >> 4;
        bf16_t* sc = (IS_A ? WSP(bf16_t, WS_SCA) : WSP(bf16_t, WS_SCC)) + (size_t)unit * 4096;
#pragma unroll
        for (int jt = 0; jt < 4; ++jt) { const int mt = ws, nt = jt; f32x4 acc = {0.f, 0.f, 0.f, 0.f};
            if (nt <= mt) {
#pragma unroll
                for (int ks = 0; ks < DK / 32; ++ks) { const bf16x8 a = *(const LAS bf16x8*)(qt + (16 * mt + fr) * QP + 32 * ks + 8 * fq), bb = *(const LAS bf16x8*)(kt + (16 * nt + fr) * QP + 32 * ks + 8 * fq); acc = MFMA16(a, bb, acc); } }
#pragma unroll
            for (int r = 0; r < 4; ++r) { const int t = 16 * mt + 4 * fq + r, s = 16 * nt + fr; if (!F.dry) sc[t * 64 + s] = (s <= t) ? f2bf(acc[r]) : (bf16_t)0; } }
    }
    { unsigned vp[16];
#pragma unroll
        for (int t2 = 0; t2 < 16; ++t2) { vp[t2] = ldrow_u(ROWB(P, r0 + 2 * t2, vcol), vo) | (ldrow_u(ROWB(P, r0 + 2 * t2 + 1, vcol), vo) << 16); }
        __syncthreads();
        bf16_t* vd = P + (size_t)(row0 + (c >> 1)) * LDP + vcol + (c & 1) * 64 + 32 * hf;
#pragma unroll
        for (int o = 0; o < 4; ++o) if (!F.dry) *(u32x4*)(vd + 8 * o) = (u32x4){vp[4 * o], vp[4 * o + 1], vp[4 * o + 2], vp[4 * o + 3]}; }
    __syncthreads();
}

__device__ __forceinline__ void prep_gdn(Frame& F, int l, int ug) {
    constexpr int NP = 136, SUB = 2 * 64 * NP * 2 + 64 * 68 * 4 + 1024 + 2304;
    int tid = F.tid; asm volatile("" : "+v"(tid));
    const int lane = tid & 63, sg = __builtin_amdgcn_readfirstlane(tid >> 8), lt = tid & 255, unit = 2 * ug + sg, slot = unit >> 2, h = unit & 3, row0 = slot * 64;
    bf16_t* P = WSP(bf16_t, WS_P);
    LAS bf16_t* qs = (LAS bf16_t*)(F.lds + sg * SUB);
    LAS bf16_t* ks = qs + 64 * NP;
    LAS float* AT = (LAS float*)(F.lds + sg * SUB + 2 * 64 * NP * 2);
    LAS float* gs = AT + 64 * 68;
    if (lt < 64) { const int valid_u = 1; (void)valid_u; float g = WSP(float, SM_LOGA)[(size_t)(row0 + lt) * 4 + h];
#pragma unroll
        for (int o = 1; o < 64; o <<= 1) { const float t = __shfl_up(g, o); if (lane >= o) g += t; }
        gs[lt] = g; gs[64 + lt] = WSP(float, SM_BETA)[(size_t)(row0 + lt) * 4 + h];
        if (lt == 63 && !F.dry) WSP(float, SM_DECB)[unit] = __expf(g); }
    const int hslot = slot == 256 ? -1 : ((slot & 63) == 0 ? 256 : slot - 1);
    LAS bf16_t* rvs = (LAS bf16_t*)AT;
    LAS bf16_t* hl = (LAS bf16_t*)(gs + 256);
    for (int idx = lt; idx < 64 * 48; idx += 256) { const int row = idx / 48, pc = idx % 48, comp = pc >> 4, c8 = (pc & 15) * 8;
        const u32x4 v = *(const u32x4*)(P + (size_t)(row0 + row) * LDP + PC_BQKV + comp * 512 + h * 128 + c8);
        *(LAS u32x4*)((comp == 0 ? qs : (comp == 1 ? ks : rvs)) + row * NP + c8) = v; }
    if (lt < 144) { const int rr = lt / 48, pc = lt % 48, comp = pc >> 4, c8 = (pc & 15) * 8; u32x4 v = {0u, 0u, 0u, 0u};
        if (hslot >= 0) v = *(const u32x4*)(WSP(bf16_t, SM_HALO) + ((size_t)hslot * 3 + rr) * 1536 + comp * 512 + h * 128 + c8);
        *(LAS u32x4*)(hl + rr * 384 + comp * 128 + c8) = v; }
    __syncthreads();
    float col[64];
    {
        const int c = lt & 127;
#pragma unroll
        for (int pass = 0; pass < 2; ++pass) {
            if (pass == 1 && lt >= 128) break;
            const int comp = lt >= 128 ? 1 : (pass == 0 ? 0 : 2), ch = comp * 512 + h * 128 + c;
            const float w0 = INP(I_GDN_CONV)[((size_t)l * 4 + 0) * 1536 + ch], w1 = INP(I_GDN_CONV)[((size_t)l * 4 + 1) * 1536 + ch], w2 = INP(I_GDN_CONV)[((size_t)l * 4 + 2) * 1536 + ch], w3 = INP(I_GDN_CONV)[((size_t)l * 4 + 3) * 1536 + ch];
            LAS bf16_t* src = (comp == 0 ? qs : (comp == 1 ? ks : rvs)) + c;
            float x0 = bf2f(hl[comp * 128 + c]), x1 = bf2f(hl[384 + comp * 128 + c]), x2 = bf2f(hl[768 + comp * 128 + c]);
#pragma unroll
            for (int t = 0; t < 64; ++t) { const float x3 = bf2f(src[t * NP]); const float y = siluf_(w0 * x0 + w1 * x1 + w2 * x2 + w3 * x3); x0 = x1; x1 = x2; x2 = x3;
                if (comp == 0) src[t * NP] = f2bf(y); else { col[t] = y; if (comp == 1) src[t * NP] = f2bf(y); } }
        }
    }
    __syncthreads();
    const int wv = (tid >> 6) & 3, fr = lane & 15, fq = lane >> 4;
#pragma unroll
    for (int jt = 0; jt < 2; ++jt) { const int which = jt, mt = wv; const LAS bf16_t* ap = which ? qs : ks; f32x4 a4 = {0.f, 0.f, 0.f, 0.f};
#pragma unroll
        for (int k4 = 0; k4 < 4; ++k4) { const bf16x8 a = *(const LAS bf16x8*)(ap + (16 * mt + fr) * NP + 32 * k4 + 8 * fq); a4 = MFMA16(a, a, a4); }
#pragma unroll
        for (int r = 0; r < 4; ++r) if (4 * fq + r == fr) { if (which == 0) gs[128 + 16 * mt + fr] = rsqrtf(a4[r] + 1e-6f); else gs[192 + 16 * mt + fr] = rsqrtf(a4[r] + 1e-6f) * 0.08838834764831845f; } }
    __syncthreads();
    { bf16_t* qkd = WSP(bf16_t, WS_QKD) + (size_t)unit * 4096;
#pragma unroll
        for (int jt = 0; jt < 8; ++jt) { const int tile = wv * 8 + jt, which = tile >> 4, mt = (tile >> 2) & 3, nt = tile & 3;
            const LAS bf16_t* ap = which ? qs : ks; f32x4 a4 = {0.f, 0.f, 0.f, 0.f};
            if (nt <= mt) {
#pragma unroll
                for (int k4 = 0; k4 < 4; ++k4) { const bf16x8 a = *(const LAS bf16x8*)(ap + (16 * mt + fr) * NP + 32 * k4 + 8 * fq), bb = *(const LAS bf16x8*)(ks + (16 * nt + fr) * NP + 32 * k4 + 8 * fq); a4 = MFMA16(a, bb, a4); } }
#pragma unroll
            for (int r = 0; r < 4; ++r) { const int t = 16 * mt + 4 * fq + r, s = 16 * nt + fr; const float dec = __expf(fminf(gs[t] - gs[s], 0.f)) * gs[128 + s];
                if (which) { if (!F.dry) qkd[t * 64 + permpos(s)] = (s <= t) ? f2bf(a4[r] * dec * gs[192 + t]) : (bf16_t)0; }
                else AT[s * 68 + t] = (s < t) ? gs[64 + t] * gs[128 + t] * a4[r] * dec : 0.f; } }
    }
    if (lt >= 128) { const int d = lt - 128; const float gl = gs[63]; bf16_t* dst = WSP(bf16_t, WS_K1TB) + (size_t)unit * 8192 + d * 64;
#pragma unroll
        for (int o = 0; o < 8; ++o) { const int s0 = 32 * (o >> 2) + 4 * (o & 3); float y[8];
#pragma unroll
            for (int j = 0; j < 8; ++j) { const int s = s0 + (j & 3) + (j >> 2) * 16; y[j] = col[s] * gs[128 + s] * __expf(gl - gs[s]); }
            if (!F.dry) *(u32x4*)(dst + 8 * o) = (u32x4){pk2(y[0], y[1]), pk2(y[2], y[3]), pk2(y[4], y[5]), pk2(y[6], y[7])}; }
    } else { const int pp = permpos(lt);
#pragma unroll 8
        for (int t = 0; t < 64; ++t) if (!F.dry) P[(size_t)(row0 + t) * LDP + PC_BQKV + h * 128 + pp] = f2bf(bf2f(qs[t * NP + lt]) * gs[192 + t] * __expf(gs[t])); }
    __syncthreads();
#pragma unroll
    for (int i = 0; i < 64; ++i) col[i] *= lt < 128 ? gs[64 + i] : gs[64 + i] * gs[128 + i] * __expf(gs[i]);
#pragma unroll
    for (int j = 0; j < 63; ++j) { const float xj = col[j]; asm volatile("" ::: "memory");
#pragma unroll
        for (int q4 = (j + 1) >> 2; q4 < 16; ++q4) { const f32x4 a = *(const LAS f32x4*)(AT + j * 68 + 4 * q4);
#pragma unroll
            for (int e = 0; e < 4; ++e) if (4 * q4 + e > j) col[4 * q4 + e] -= a[e] * xj; } }
    int tid2 = F.tid; asm volatile("" : "+v"(tid2)); const int lt2 = tid2 & 255, unit2 = 2 * ug + __builtin_amdgcn_readfirstlane(tid2 >> 8), row02 = (unit2 >> 2) * 64, h2 = unit2 & 3;
    if (lt2 < 128) { bf16_t* dst = P + (size_t)(row02 + (lt2 >> 1)) * LDP + PC_BQKV + 1024 + h2 * 128 + (lt2 & 1) * 64;
#pragma unroll
        for (int o = 0; o < 8; ++o) if (!F.dry) *(u32x4*)(dst + 8 * o) = (u32x4){pk2(col[8 * o], col[8 * o + 1]), pk2(col[8 * o + 2], col[8 * o + 3]), pk2(col[8 * o + 4], col[8 * o + 5]), pk2(col[8 * o + 6], col[8 * o + 7])};
    } else { const int pp = permpos(lt2 - 128);
        if (!F.dry) {
#pragma unroll
        for (int t = 0; t < 64; ++t) strow(ROWB(P, row02 + t, PC_BQKV + 512 + h2 * 128), (unsigned)pp * 2u, f2bf(col[t])); } }
    __syncthreads();
}

__device__ __forceinline__ void prep_set(Frame& F, int l, int set, int nblk, int bidx) {
    const int nsl = set == 0 ? 65 : 64, np = 2 * nsl;
    auto ug_of = [&](int vp) { int j = vp >> 1, slot; if (set == 0) { slot = j == 0 ? 256 : ((j - 1) >> 4) * 64 + ((j - 1) & 15); } else slot = (j >> 4) * 64 + 16 * set + (j & 15); return 2 * slot + (vp & 1); };
    auto first_of = [&](int base) { int r = (bidx - base) % nblk; if (r < 0) r += nblk; return base + r; };
    for (int i = first_of(0); i < np; i += nblk) prep_gdn(F, l, ug_of(i));
    for (int i = first_of(np); i < 2 * np; i += nblk) prep_gla<128, true>(F, l, ug_of(i - np));
    for (int i = first_of(2 * np); i < 3 * np; i += nblk) prep_gla<64, false>(F, l, ug_of(i - 2 * np));
}
constexpr int SCAN_BUF = 57344;
template <int MX> struct ScanCfg;
template <> struct ScanCfg<0> { static constexpr int NM = 3, NI = 5; static constexpr int off(int m) { return m == 0 ? 0 : (m == 1 ? 16384 : 32768); } static constexpr int pitch(int m) { return m == 0 ? 256 : 128; } };
template <> struct ScanCfg<1> { static constexpr int NM = 4, NI = 7; static constexpr int off(int m) { return 16384 * m; } static constexpr int pitch(int m) { return m < 2 ? 256 : 128; } };
template <> struct ScanCfg<2> { static constexpr int NM = 3, NI = 3; static constexpr int off(int m) { return 8192 * m; } static constexpr int pitch(int m) { return 128; } };

#define SCAN_GRID_BARRIER() do { xcd_barrier(WSP(unsigned, WS_CTL) + CW_BAR, xb_xcc_id(), (volatile LAS unsigned*)(F.lds + LDS_MISC) + 8, F.tid, (unsigned)F.G); asm volatile("" ::: "memory"); } while (0)
template <int MX>
__device__ __forceinline__ void scan_mixer(Frame& F, int b, int h) {
    typedef ScanCfg<MX> C;
    constexpr int DK = MX == 2 ? 64 : 128, NT = DK / 16, NI = C::NI;
    const int w = F.wave, lane = F.lane, fr = lane & 15, fq = lane >> 4, ecol = 16 * w + fr;
    const char* Pb = (const char*)WSP(bf16_t, WS_P);
    const int qcol = MX == 0 ? PC_AQ + h * 128 : (MX == 1 ? PC_BQKV + h * 128 : PC_CQ + h * 64);
    const int kcol = MX == 0 ? PC_AF + h * 128 : (MX == 1 ? PC_BQKV + 512 + h * 128 : PC_CK + h * 64);
    const int vcol = MX == 0 ? PC_AI + h * 128 : (MX == 1 ? PC_BQKV + 1024 + h * 128 : PC_CV + h * 128);
    const char* SCb = (const char*)(MX == 0 ? WSP(bf16_t, WS_SCA) : (MX == 1 ? WSP(bf16_t, WS_QKD) : WSP(bf16_t, WS_SCC)));
    bf16_t* O = WSP(bf16_t, WS_O) + (size_t)MX * MROWS * 512;
    unsigned voff[NI]; int mi[NI];
#pragma unroll
    for (int i = 0; i < NI; ++i) { const int n = w + 8 * i, o = 1024 * n + 16 * lane; int m = 0;
#pragma unroll
        for (int q = 1; q < C::NM; ++q) if (o >= C::off(q)) m = q;
        int ro = o, pitch = 128;
#pragma unroll
        for (int q = 0; q < C::NM; ++q) if (m == q) { ro = o - C::off(q); pitch = C::pitch(q); }
        const int r = ro / pitch, pos = (ro % pitch) >> 4, pc = pos ^ (pitch == 256 ? (r & 15) : ((r >> 1) & 7));
        const bool packed = (MX == 0 && m == 1);
        const bool inP = (MX == 1) ? (m < 2) : (m < 2);
        voff[i] = (unsigned)(inP ? (packed ? (r >> 1) * (LDP * 2) + (r & 1) * 128 : r * (LDP * 2)) : r * pitch) + 16u * pc; mi[i] = m; }
    const unsigned x256_0 = (unsigned)(((0 | fq) ^ fr) << 4), x256_1 = (unsigned)(((4 | fq) ^ fr) << 4), x256_2 = (unsigned)(((8 | fq) ^ fr) << 4), x256_3 = (unsigned)(((12 | fq) ^ fr) << 4);
    const unsigned x128_0 = (unsigned)(((0 | fq) ^ ((fr >> 1) & 7)) << 4), x128_1 = (unsigned)(((4 | fq) ^ ((fr >> 1) & 7)) << 4);
    const unsigned x256[4] = {x256_0, x256_1, x256_2, x256_3}, x128[2] = {x128_0, x128_1};
#define SC_FRAG(buf, m, rt, kp) (*(const LAS bf16x8*)(F.lds + (buf) + C::off(m) + (16 * (rt) + fr) * C::pitch(m) + (C::pitch(m) == 256 ? x256[kp] : x128[(kp) & 1])))
    auto slot_of = [&](int step) { return step == 0 ? 256 : b * 64 + step - 1; };
    auto issue = [&](int step, int buf) {
        const int slot = slot_of(step), row0 = slot * 64, unit = slot * 4 + h;
        const char* base[4];
        if (MX == 1) { base[0] = Pb + ((size_t)row0 * LDP + kcol) * 2; base[1] = Pb + ((size_t)row0 * LDP + qcol) * 2; base[2] = (const char*)WSP(bf16_t, WS_K1TB) + (size_t)unit * 16384; base[3] = SCb + (size_t)unit * 8192; }
        else { base[0] = Pb + ((size_t)row0 * LDP + qcol) * 2; base[1] = Pb + ((size_t)row0 * LDP + kcol) * 2; base[2] = SCb + (size_t)unit * 8192; base[3] = base[2]; }
#pragma unroll
        for (int i = 0; i < NI; ++i) { const char* bs = mi[i] == 0 ? base[0] : (mi[i] == 1 ? base[1] : (mi[i] == 2 ? base[2] : base[3]));
            __builtin_amdgcn_global_load_lds((const unsigned*)(bs + voff[i]), (LAS unsigned*)(F.lds + buf + 1024 * (w + 8 * i)), 16, 0, 0); }
    };
    auto load_priv = [&](int step, u32x4 (&pv)[2]) {
        const int row0 = slot_of(step) * 64;
        const bf16_t* vt = (const bf16_t*)Pb + (size_t)(row0 + (ecol >> 1)) * LDP + vcol + (ecol & 1) * 64;
        if (MX == 1) { const u32x2 a = *(const u32x2*)(vt + 4 * fq), c = *(const u32x2*)(vt + 16 + 4 * fq), d = *(const u32x2*)(vt + 32 + 4 * fq), e = *(const u32x2*)(vt + 48 + 4 * fq);
            pv[0] = (u32x4){a.x, a.y, c.x, c.y}; pv[1] = (u32x4){d.x, d.y, e.x, e.y}; }
        else { pv[0] = *(const u32x4*)(vt + 8 * fq); pv[1] = *(const u32x4*)(vt + 32 + 8 * fq); }
    };
    f32x4 S[NT];
#pragma unroll
    for (int i = 0; i < NT; ++i) S[i] = (f32x4){0.f, 0.f, 0.f, 0.f};
    u32x4 pcur[2], pnxt[2];
    auto first_of_set = [](int s) { return s == 17 || s == 33 || s == 49; };
    issue(0, 0); load_priv(0, pcur);
    for (int step = 0; step < 65; ++step) {
        const int buf = (step & 1) * SCAN_BUF, slot = slot_of(step), row0 = slot * 64, unit = slot * 4 + h;
        if (first_of_set(step)) { SCAN_GRID_BARRIER(); issue(step, buf); load_priv(step, pcur); }
        asm volatile("s_waitcnt vmcnt(0)" ::: "memory");
        __syncthreads();
        if (step + 1 < 65 && !first_of_set(step + 1)) { issue(step + 1, SCAN_BUF - buf); load_priv(step + 1, pnxt); }
        bf16x8 Sb[NT / 2];
#pragma unroll
        for (int kp = 0; kp < NT / 2; ++kp) Sb[kp] = pack_acc2(S[2 * kp], S[2 * kp + 1]);
        if (MX == 1) {
            f32x4 vn[4];
#pragma unroll
            for (int mt = 0; mt < 4; ++mt) { f32x4 acc = {0.f, 0.f, 0.f, 0.f};
#pragma unroll
                for (int kp = 0; kp < 4; ++kp) acc = MFMA16(SC_FRAG(buf, 0, mt, kp), Sb[kp], acc);
                const unsigned u0 = mt == 0 ? pcur[0].x : (mt == 1 ? pcur[0].z : (mt == 2 ? pcur[1].x : pcur[1].z)), u1 = mt == 0 ? pcur[0].y : (mt == 1 ? pcur[0].w : (mt == 2 ? pcur[1].y : pcur[1].w));
                vn[mt] = (f32x4){bflo(u0) - acc[0], bfhi(u0) - acc[1], bflo(u1) - acc[2], bfhi(u1) - acc[3]}; }
            bf16x8 Vb[2]; Vb[0] = pack_acc2(vn[0], vn[1]); Vb[1] = pack_acc2(vn[2], vn[3]);
#pragma unroll
            for (int mt = 0; mt < 4; ++mt) { f32x4 acc = {0.f, 0.f, 0.f, 0.f};
#pragma unroll
                for (int kp = 0; kp < 4; ++kp) acc = MFMA16(SC_FRAG(buf, 1, mt, kp), Sb[kp], acc);
#pragma unroll
                for (int kp = 0; kp < 2; ++kp) acc = MFMA16(SC_FRAG(buf, 3, mt, kp), Vb[kp], acc);
#pragma unroll
                for (int r = 0; r < 4; ++r) O[(size_t)(row0 + 16 * mt + 4 * fq + r) * 512 + h * 128 + ecol] = f2bf(acc[r]); }
            const float a = WSP(float, SM_DECB)[unit];
#pragma unroll
            for (int i = 0; i < 8; ++i) { S[i] = S[i] * a;
#pragma unroll
                for (int kp = 0; kp < 2; ++kp) S[i] = MFMA16(SC_FRAG(buf, 2, i, kp), Vb[kp], S[i]); }
        } else {
            const bf16x8 bv0 = mk8(pcur[0]), bv1 = mk8(pcur[1]);
#pragma unroll
            for (int mt = 0; mt < 4; ++mt) { f32x4 acc = {0.f, 0.f, 0.f, 0.f};
#pragma unroll
                for (int kp = 0; kp < NT / 2; ++kp) acc = MFMA16(SC_FRAG(buf, 0, mt, kp), Sb[kp], acc);
                acc = MFMA16(SC_FRAG(buf, 2, mt, 0), bv0, acc); acc = MFMA16(SC_FRAG(buf, 2, mt, 1), bv1, acc);
#pragma unroll
                for (int r = 0; r < 4; ++r) O[(size_t)(row0 + 16 * mt + 4 * fq + r) * 512 + h * 128 + ecol] = f2bf(acc[r]); }
            const float* dec = (MX == 0 ? WSP(float, SM_DECA) : WSP(float, SM_DECC)) + (size_t)unit * DK;
#pragma unroll
            for (int i = 0; i < NT; ++i) { const f32x4 d4 = *(const f32x4*)(dec + 16 * i + 4 * fq); S[i] = S[i] * d4;
                S[i] = MFMA16(SC_FRAG(buf, 1, i, 0), bv0, S[i]); S[i] = MFMA16(SC_FRAG(buf, 1, i, 1), bv1, S[i]); }
        }
        pcur[0] = pnxt[0]; pcur[1] = pnxt[1];
    }
#undef SC_FRAG
    asm volatile("s_waitcnt vmcnt(0)" ::: "memory");
    __syncthreads();
}
__device__ __forceinline__ void phase_scan(Frame& F, int l) {
    if (F.bid >= 48) { for (int k = 1; k < 4; ++k) { prep_set(F, l, k, F.G - 48, F.bid - 48); SCAN_GRID_BARRIER(); } return; }
    const int mixer = F.bid >> 4, b = (F.bid >> 2) & 3, h = F.bid & 3;
    if (mixer == 0) scan_mixer<0>(F, b, h);
    else if (mixer == 1) scan_mixer<1>(F, b, h);
    else scan_mixer<2>(F, b, h);
}

template <int KIND>
__device__ __forceinline__ void meta_gemm(Frame& F, const bf16_t* A, const bf16_t* Bt, int N, int K, int n) {
    const int gw = F.bid * NWAVES + F.wave, NGW = F.G * NWAVES, lane = F.lane, fr = lane & 15, fq = lane >> 4;
    for (int tile = gw; tile < N / 16; tile += NGW) {
        const bf16_t* ar = A + (size_t)fr * K + 8 * fq; const bf16_t* br = Bt + (size_t)(16 * tile + fr) * K + 8 * fq;
        f32x4 acc = {0.f, 0.f, 0.f, 0.f};
#pragma unroll 8
        for (int ks = 0; ks < K / 32; ++ks) acc = MFMA16(mk8(*(const u32x4*)(ar + 32 * ks)), mk8(*(const u32x4*)(br + 32 * ks)), acc);
#pragma unroll
        for (int r = 0; r < 4; ++r) { const int row = META_ROW0 + 4 * fq + r, col = 16 * tile + fr;
            if (KIND == 0) WSP(bf16_t, WS_GT)[(size_t)row * 3072 + col] = f2bf(sigmoidf_(acc[r]));
            else if (KIND == 1) { bf16_t* mp = WSP(bf16_t, WS_MERGED) + (size_t)row * 1024 + col; const float g = bf2f(WSP(bf16_t, WS_GT)[(size_t)row * 3072 + n * 1024 + col]);
                *mp = f2bf((n ? bf2f(*mp) : 0.f) + g * acc[r]); }
            else { float* hp = WSP(float, WS_HMETA) + (size_t)(row - NREAL) * D + col; *hp = *hp + acc[r]; } }
    }
}

__device__ __forceinline__ void phase_hnorm(Frame& F, int l) {
    const int gw = F.bid * NWAVES + F.wave, NGW = F.G * NWAVES, lane = F.lane;
    const bf16_t* P = WSP(bf16_t, WS_P);
    LAS float* nws = (LAS float*)F.lds;
    if (F.tid < 384) { const int mxw = F.tid >> 7; const float* src = mxw == 0 ? INP(I_HGRN_NORM) : (mxw == 1 ? INP(I_GDN_NORM) : INP(I_GLA_NORM)); nws[F.tid] = src[(size_t)l * 128 + (F.tid & 127)]; }
    __syncthreads();
    for (int r = gw; r < MROWS; r += NGW) {
        bf16_t* op0 = WSP(bf16_t, WS_O) + (size_t)r * 512 + 8 * lane;
        if (!row_valid(r)) { if (!F.dry) {
#pragma unroll
            for (int mx = 0; mx < 3; ++mx) *(u32x4*)(op0 + (size_t)mx * MROWS * 512) = (u32x4){0u, 0u, 0u, 0u}; } continue; }
        u32x4 ow[3], gv[3];
#pragma unroll
        for (int mx = 0; mx < 3; ++mx) { ow[mx] = *(const u32x4*)(op0 + (size_t)mx * MROWS * 512); gv[mx] = *(const u32x4*)(P + (size_t)r * LDP + (mx == 0 ? PC_AG : (mx == 1 ? PC_BG : PC_CG)) + 8 * lane); }
#pragma unroll
        for (int mx = 0; mx < 3; ++mx) {
            const LAS float* nw = nws + mx * 128 + (8 * lane & 127);
            float o[8] = {bflo(ow[mx].x), bfhi(ow[mx].x), bflo(ow[mx].y), bfhi(ow[mx].y), bflo(ow[mx].z), bfhi(ow[mx].z), bflo(ow[mx].w), bfhi(ow[mx].w)};
            const float g[8] = {siluf_(bflo(gv[mx].x)), siluf_(bfhi(gv[mx].x)), siluf_(bflo(gv[mx].y)), siluf_(bfhi(gv[mx].y)), siluf_(bflo(gv[mx].z)), siluf_(bfhi(gv[mx].z)), siluf_(bflo(gv[mx].w)), siluf_(bfhi(gv[mx].w))};
            float ss = 0.f;
#pragma unroll
            for (int j = 0; j < 8; ++j) ss += o[j] * o[j];
            ss += __shfl_xor(ss, 1); ss += __shfl_xor(ss, 2); ss += __shfl_xor(ss, 4); ss += __shfl_xor(ss, 8);
            const float rstd = rsqrtf(ss * (1.0f / 128.0f) + 1e-6f);
            const f32x4 n0 = *(const LAS f32x4*)nw, n1 = *(const LAS f32x4*)(nw + 4);
            const float nv[8] = {n0[0], n0[1], n0[2], n0[3], n1[0], n1[1], n1[2], n1[3]};
#pragma unroll
            for (int j = 0; j < 8; ++j) o[j] = o[j] * rstd * nv[j] * g[j];
            u32x4 y; y.x = pk2(o[0], o[1]); y.y = pk2(o[2], o[3]); y.z = pk2(o[4], o[5]); y.w = pk2(o[6], o[7]);
            if (!F.dry) *(u32x4*)(op0 + (size_t)mx * MROWS * 512) = y;
        }
    }
}

__device__ __forceinline__ void phase_norm2(Frame& F, int l) {
    if (!F.dry) convert_expert_weights(F, l);
    __syncthreads();
    LAS float* sw = (LAS float*)F.lds;
    { const float* src = WSP(float, SM_RWE) + (size_t)l * 32 * 1024; for (int i = F.tid; i < 32 * 1024 / 4; i += NTHREADS) ((LAS f32x4*)sw)[i] = ((const f32x4*)src)[i]; }
    LAS float* rbias = sw + 32 * 1024;
    if (F.tid < 32) rbias[F.tid] = INP(I_RE_B)[l * 32 + F.tid]; else if (F.tid < 36) rbias[F.tid] = INP(I_RG_B)[l * 4 + (F.tid - 32)];
    __syncthreads();
    const int gw = F.bid * NWAVES + F.wave, NGW = F.G * NWAVES, lane = F.lane;
    float wv[16]; load_row16(INP(I_NORM_FFN) + (size_t)l * D, lane, wv);
    bf16_t* U = WSP(bf16_t, WS_U);
    const float* rwg = WSP(float, SM_RWG) + (size_t)l * 4 * 1024;
    unsigned* cnt = WSP(unsigned, WS_CTL) + CW_CNT + l * 64;
    LAS unsigned* lcnt = (LAS unsigned*)(F.lds + LDS_TAB);
    if (F.tid < 64) lcnt[F.tid] = 0u;
    __syncthreads();
    for (int g = gw; g < MROWS / 4; g += NGW) {
        const int r0 = 4 * g;
        if (!row_valid(r0)) continue;
        float x[4][16];
#pragma unroll
        for (int i = 0; i < 4; ++i) {
            load_row16(hrow(F, r0 + i), lane, x[i]);
            float ss = 0.f;
#pragma unroll
            for (int j = 0; j < 16; ++j) ss += x[i][j] * x[i][j];
            const float rstd = rsqrtf(wave_sum(ss) * (1.0f / D) + 1e-6f);
#pragma unroll
            for (int j = 0; j < 16; ++j) x[i][j] = x[i][j] * rstd * wv[j];
            if (!F.dry) store_bf16_row16(U + (size_t)(r0 + i) * D, lane, x[i]);
        }
#ifndef NORM2_SKIP
#define NORM2_SKIP 0
#endif
        if (F.dry && (NORM2_SKIP & 4)) continue;
        float lg[4][4];
#pragma unroll
        for (int c = 0; c < 4; ++c) {
            float a0 = 0.f, a1 = 0.f, a2 = 0.f, a3 = 0.f;
#pragma unroll
            for (int j = 0; j < 4; ++j) { const f32x4 w = *((const f32x4*)(rwg + c * 1024) + lane + 64 * j);
#pragma unroll
                for (int e = 0; e < 4; ++e) { a0 += x[0][4 * j + e] * w[e]; a1 += x[1][4 * j + e] * w[e]; a2 += x[2][4 * j + e] * w[e]; a3 += x[3][4 * j + e] * w[e]; } }
            const float bg = rbias[32 + c];
            lg[0][c] = wave_sum(a0) + bg; lg[1][c] = wave_sum(a1) + bg; lg[2][c] = wave_sum(a2) + bg; lg[3][c] = wave_sum(a3) + bg;
        }
#pragma unroll
        for (int i = 0; i < 4; ++i) {
            int gi = 0; float gm = lg[i][0];
#pragma unroll
            for (int c = 1; c < 4; ++c) if (lg[i][c] > gm) { gm = lg[i][c]; gi = c; }
            float gsum = 0.f;
#pragma unroll
            for (int c = 0; c < 4; ++c) gsum += __expf(lg[i][c] - gm);
            const float gval = 1.0f / gsum;
            gi = __builtin_amdgcn_readfirstlane(gi);
            int ea = 0, eb = 0; float la = -3.0e38f, lb = -3.0e38f;
            const LAS float* swg = sw + gi * 8 * 1024;
#pragma unroll 1
            for (int cb = 0; cb < ((F.dry && (NORM2_SKIP & 2)) ? 0 : 8); cb += 4) {
                float a0 = 0.f, a1 = 0.f, a2 = 0.f, a3 = 0.f;
#pragma unroll
                for (int j = 0; j < 4; ++j) { const f32x4 w0 = *((const LAS f32x4*)(swg + (cb + 0) * 1024) + lane + 64 * j), w1 = *((const LAS f32x4*)(swg + (cb + 1) * 1024) + lane + 64 * j), w2 = *((const LAS f32x4*)(swg + (cb + 2) * 1024) + lane + 64 * j), w3 = *((const LAS f32x4*)(swg + (cb + 3) * 1024) + lane + 64 * j);
#pragma unroll
                    for (int e = 0; e < 4; ++e) { const float xv = x[i][4 * j + e]; a0 += xv * w0[e]; a1 += xv * w1[e]; a2 += xv * w2[e]; a3 += xv * w3[e]; } }
                const float e0 = wave_sum(a0) + rbias[gi * 8 + cb], e1 = wave_sum(a1) + rbias[gi * 8 + cb + 1], e2 = wave_sum(a2) + rbias[gi * 8 + cb + 2], e3 = wave_sum(a3) + rbias[gi * 8 + cb + 3];
                const float ev[4] = {e0, e1, e2, e3};
#pragma unroll
                for (int q = 0; q < 4; ++q) { const float el = ev[q]; const int c = cb + q; if (el > la) { lb = la; eb = ea; la = el; ea = c; } else if (el > lb) { lb = el; eb = c; } }
            }
            const float wa = 1.0f / (1.0f + __expf(lb - la)), wb = 1.0f - wa;
            if (lane == 0 && !F.dry) {
                const unsigned e0 = (unsigned)(gi * 8 + ea), e1 = (unsigned)(gi * 8 + eb);
                const unsigned p0 = __hip_atomic_fetch_add(lcnt + e0, 1u, __ATOMIC_RELAXED, __HIP_MEMORY_SCOPE_WORKGROUP), p1 = __hip_atomic_fetch_add(lcnt + e1, 1u, __ATOMIC_RELAXED, __HIP_MEMORY_SCOPE_WORKGROUP);
                unsigned* tok = WSP(unsigned, SM_TOK) + (size_t)(r0 + i) * 8;
                tok[0] = e0; tok[1] = p0; tok[2] = e1; tok[3] = p1; tok[4] = __float_as_uint(gval * wa); tok[5] = __float_as_uint(gval * wb);
            }
        }
    }
    __syncthreads();
    if (F.tid < 32 && !F.dry) lcnt[32 + F.tid] = atomicAdd(cnt + F.tid, lcnt[F.tid]);
    __syncthreads();
    if (!F.dry) for (int g = gw; g < MROWS / 4; g += NGW) { const int r0 = 4 * g; if (!row_valid(r0)) continue;
        if (lane < 4) { unsigned* tok = WSP(unsigned, SM_TOK) + (size_t)(r0 + lane) * 8; tok[1] += lcnt[32 + tok[0]]; tok[3] += lcnt[32 + tok[2]]; } }
}

__device__ __forceinline__ int moe_tables(Frame& F, int l) {
    LAS int* offs = (LAS int*)(F.lds + LDS_TAB); LAS unsigned char* tab = (LAS unsigned char*)(F.lds + LDS_TAB + 384); LAS int* cn = (LAS int*)(F.lds + LDS_TAB + 192);
    const unsigned* cnt = WSP(unsigned, WS_CTL) + CW_CNT + l * 64;
    __syncthreads();
    if (F.tid < 32) cn[F.tid] = (int)__hip_atomic_load(cnt + F.tid, __ATOMIC_RELAXED, __HIP_MEMORY_SCOPE_AGENT);
    __syncthreads();
    if (F.tid == 0) { int acc = 0;
#pragma unroll 1
        for (int e = 0; e < 32; ++e) { offs[e] = acc; acc += ((cn[e] + 255) >> 8) << 8; }
        offs[32] = acc; }
    __syncthreads();
    if (F.tid < 160) { const int row = F.tid << 8; int e = 0;
#pragma unroll 1
        for (int k = 1; k < 32; ++k) if (offs[k] <= row) e = k;
        tab[F.tid] = (unsigned char)e; }
    __syncthreads();
    return offs[32] >> 8;
}

__device__ __forceinline__ void phase_gather(Frame& F, int l) {
    (void)moe_tables(F, l);
    const LAS int* offs = (const LAS int*)(F.lds + LDS_TAB); const LAS int* cn = (const LAS int*)(F.lds + LDS_TAB + 192);
    const int gw = F.bid * NWAVES + F.wave, NGW = F.G * NWAVES, lane = F.lane;
    const bf16_t* U = WSP(bf16_t, WS_U); bf16_t* XG = WSP(bf16_t, WS_XG); float* wrow = WSP(float, SM_WROW);
    for (int idx = gw; idx < NREAL + 16; idx += 2 * NGW) {
        const int idx2 = idx + NGW; const bool has2 = idx2 < NREAL + 16;
        const int r = idx < NREAL ? idx : META_ROW0 + (idx - NREAL), r2 = has2 ? (idx2 < NREAL ? idx2 : META_ROW0 + (idx2 - NREAL)) : r;
        unsigned* tok = WSP(unsigned, SM_TOK) + (size_t)r * 8; unsigned* tok2 = WSP(unsigned, SM_TOK) + (size_t)r2 * 8;
        const u32x4 ta = *(const u32x4*)tok, tb = *(const u32x4*)tok2; const u32x2 wa = *(const u32x2*)(tok + 4), wb = *(const u32x2*)(tok2 + 4);
        const unsigned g0 = (unsigned)offs[ta.x] + ta.y, g1 = (unsigned)offs[ta.z] + ta.w, h0 = (unsigned)offs[tb.x] + tb.y, h1 = (unsigned)offs[tb.z] + tb.w;
        const u32x4* src = (const u32x4*)(U + (size_t)r * D); const u32x4* src2 = (const u32x4*)(U + (size_t)r2 * D);
        const u32x4 a = src[lane], b = src[lane + 64], c = src2[lane], d = src2[lane + 64];
        if (lane == 0) { tok[6] = g0; tok[7] = g1; wrow[g0] = __uint_as_float(wa.x); wrow[g1] = __uint_as_float(wa.y); }
        u32x4* d0 = (u32x4*)(XG + (size_t)g0 * D); u32x4* d1 = (u32x4*)(XG + (size_t)g1 * D);
        d0[lane] = a; d0[lane + 64] = b; d1[lane] = a; d1[lane + 64] = b;
        if (has2) { if (lane == 0) { tok2[6] = h0; tok2[7] = h1; wrow[h0] = __uint_as_float(wb.x); wrow[h1] = __uint_as_float(wb.y); }
            u32x4* e0 = (u32x4*)(XG + (size_t)h0 * D); u32x4* e1 = (u32x4*)(XG + (size_t)h1 * D);
            e0[lane] = c; e0[lane + 64] = d; e1[lane] = c; e1[lane + 64] = d; }
    }
    u32x4 zz = {0u, 0u, 0u, 0u}; asm volatile("" : "+v"(zz));
    for (int i = gw; i < 32 * 256; i += NGW) { const int e = i >> 8, j = i & 255; const int row = offs[e] + cn[e] + j;
        if (row < offs[e + 1]) { u32x4* d = (u32x4*)(XG + (size_t)row * D); d[lane] = zz; d[lane + 64] = zz; if (lane == 0) wrow[row] = 0.f; } }
}

__device__ __forceinline__ void phase_final(Frame& F) {
    const int gw = F.bid * NWAVES + F.wave, NGW = F.G * NWAVES, lane = F.lane;
    float wv[16]; load_row16(INP(I_NORM_FINAL), lane, wv);
    for (int r = gw; r < NREAL; r += 2 * NGW) {
        const int r2 = r + NGW;
        float x[16], y[16]; fetch_h_row(F, 2, r, x); fetch_h_row(F, 2, r2, y);
        float ss = 0.f, s2 = 0.f;
#pragma unroll
        for (int j = 0; j < 16; ++j) { ss += x[j] * x[j]; s2 += y[j] * y[j]; }
        const float rstd = rsqrtf(wave_sum(ss) * (1.0f / D) + 1e-6f), rstd2 = rsqrtf(wave_sum(s2) * (1.0f / D) + 1e-6f);
#pragma unroll
        for (int j = 0; j < 16; ++j) { x[j] = x[j] * rstd * wv[j]; y[j] = y[j] * rstd2 * wv[j]; }
        store_row16(OUTP + (size_t)r * D, lane, x); store_row16(OUTP + (size_t)r2 * D, lane, y);
    }
}
constexpr int PH_PER_LAYER = 14, N_PHASES = 2 + 2 * PH_PER_LAYER;
#ifndef DBG_STOP
#define DBG_STOP 0
#endif
#ifndef DBG_SRC
#define DBG_SRC WS_P
#define DBG_LD LDP
#endif
#ifndef DBG_TA
#define DBG_TA -1
#endif
#ifndef DBG_TQ
#define DBG_TQ 16.0f
#endif
#ifndef DBG_TB
#define DBG_TB -1
#endif
#ifndef DUP_MASK
#define DUP_MASK 0u
#endif
#define DUPN(j) (((DUP_MASK >> (j)) & 1u) ? 2 : 1)
#ifndef MK_ONE_LAUNCH
#define MK_ONE_LAUNCH 1
#endif

template <unsigned PHMASK_T>
__global__ void __launch_bounds__(NTHREADS, 2) hybrid_fwd(Params p) {
    extern __shared__ __attribute__((aligned(16))) unsigned char lds_raw[];
    Frame F;
    F.lds = (LAS unsigned char*)lds_raw; F.tid = threadIdx.x; F.lane = F.tid & 63; F.wave = __builtin_amdgcn_readfirstlane(F.tid >> 6); F.G = gridDim.x; F.bid = blockIdx.x; F.dry = 0;
    F.out = (GAS float*)p.out; F.ws = (GAS unsigned char*)p.ws; F.inp = (const float* const __attribute__((address_space(4)))*)__builtin_amdgcn_kernarg_segment_ptr();
    volatile LAS unsigned* MISC = (volatile LAS unsigned*)(F.lds + LDS_MISC);
    if (F.tid < 128) MISC[F.tid] = 0u;
    __syncthreads();
#if MK_ONE_LAUNCH
    constexpr int lo = 0, hi = N_PHASES;
#else
    const int lo = p.ph_lo, hi = p.ph_hi;
#endif
    if (hi - lo > 1) (void)xcd_barrier_post(WSP(unsigned, WS_CTL) + CW_BAR, MISC + 8);
#define GRID_BARRIER() xcd_barrier(WSP(unsigned, WS_CTL) + CW_BAR, xb_xcc_id(), (volatile LAS unsigned*)(F.lds + LDS_MISC) + 8, F.tid, (unsigned)F.G)
#define EN(j) ((PHMASK_T >> (j)) & 1u)
#define IN(k) (lo <= (k) && (k) < hi)
    if (DBG_TA >= 0 && F.tid == 0) { MISC[16] = (unsigned)__builtin_amdgcn_s_memrealtime(); MISC[17] = 0u; }
#define SEAM(k) do { if (IN(k) && IN((k) + 1)) GRID_BARRIER(); PHASE_FENCE(F); \
    if (DBG_TA >= 0 && F.tid == 0) { const unsigned t_now = (unsigned)__builtin_amdgcn_s_memrealtime(); const int kk = (k) == 0 ? 15 : (((k) - 1) % PH_PER_LAYER); const int kind = (kk >= 6 && kk <= 8) ? 6 : kk; \
        if (kind == DBG_TA) MISC[17] += t_now - MISC[16]; MISC[16] = t_now; } } while (0)
    PHASE_FENCE(F);
    if (EN(15) && IN(0)) phase_pre(F);
    SEAM(0);
    { constexpr int l = 0;
        const int pb = 1 + PH_PER_LAYER * l;
        for (int rep = 0; rep < (l == 0 ? DUPN(0) : 1); ++rep) { if (rep) { GRID_BARRIER(); PHASE_FENCE(F); } if (EN(0) && IN(pb + 0)) phase_norm1(F, l); }
        SEAM(pb + 0);
        for (int rep = 0; rep < DUPN(1); ++rep) { if (rep) { GRID_BARRIER(); PHASE_FENCE(F); }
        if (EN(1) && IN(pb + 1)) {
            pg8::Gemm g{WSP(bf16_t, WS_U), WSP(bf16_t, WS_WMIX), MROWS, LDP, D}; pg8::StaticOrder S; S.init(MROWS, LDP, F.G, F.bid);
            pg8::EpiInProj E{WSP(bf16_t, WS_P), WSP(bf16_t, SM_HALO)};
            pg8::gemm_phase(F.lds, F.tid, g, S, E);
        } }
        SEAM(pb + 1);
        if (EN(2) && IN(pb + 2)) prep_set(F, l, 0, F.G, F.bid);
        SEAM(pb + 2);
        if (EN(3) && IN(pb + 3)) phase_scan(F, l);
        SEAM(pb + 3);
        for (int rep = 0; rep < DUPN(4); ++rep) { if (rep) { GRID_BARRIER(); PHASE_FENCE(F); F.dry = 1; asm volatile("" : "+s"(F.dry)); } if (EN(4) && IN(pb + 4)) phase_hnorm(F, l); F.dry = 0; }
        SEAM(pb + 4);
        for (int rep = 0; rep < DUPN(5); ++rep) { if (rep) { GRID_BARRIER(); PHASE_FENCE(F); }
        if (EN(5) && IN(pb + 5)) {
            pg8::Gemm g{WSP(bf16_t, WS_U), WSP(bf16_t, WS_WGATE), NREAL, 3072, D}; pg8::StaticOrder S; S.init(NREAL, 3072, F.G, F.bid);
            pg8::EpiSigmoid E{WSP(bf16_t, WS_GT), 3072};
            pg8::gemm_phase(F.lds, F.tid, g, S, E);
            meta_gemm<0>(F, WSP(bf16_t, WS_U) + (size_t)META_ROW0 * D, WSP(bf16_t, WS_WGATE), 3072, D, 0);
        } }
        SEAM(pb + 5);
        for (int n = 0; n < 3; ++n) {
            if (EN(6) && IN(pb + 6 + n)) {
                pg8::Gemm g{WSP(bf16_t, WS_O) + (size_t)n * MROWS * 512, WSP(bf16_t, WS_WBT) + (size_t)n * 1024 * 512, NREAL, D, 512}; pg8::StaticOrder S; S.init(NREAL, D, F.G, F.bid);
                pg8::EpiBranch E{WSP(bf16_t, WS_MERGED), WSP(bf16_t, WS_GT), n};
                pg8::gemm_phase(F.lds, F.tid, g, S, E);
                meta_gemm<1>(F, WSP(bf16_t, WS_O) + (size_t)n * MROWS * 512 + (size_t)META_ROW0 * 512, WSP(bf16_t, WS_WBT) + (size_t)n * 1024 * 512, D, 512, n);
            }
            SEAM(pb + 6 + n);
        }
        if (EN(9) && IN(pb + 9)) {
            pg8::Gemm g{WSP(bf16_t, WS_MERGED), WSP(bf16_t, WS_WOT), NREAL, D, D}; pg8::StaticOrder S; S.init(NREAL, D, F.G, F.bid);
            pg8::EpiResidual E{OUTP, WSP(float, WS_HMETA)};
            pg8::gemm_phase(F.lds, F.tid, g, S, E);
            meta_gemm<2>(F, WSP(bf16_t, WS_MERGED) + (size_t)META_ROW0 * D, WSP(bf16_t, WS_WOT), D, D, 0);
        }
        SEAM(pb + 9);
        for (int rep = 0; rep < DUPN(10); ++rep) { if (rep) { GRID_BARRIER(); PHASE_FENCE(F); F.dry = 1; asm volatile("" : "+s"(F.dry)); } if (EN(10) && IN(pb + 10)) phase_norm2(F, l); F.dry = 0; }
        SEAM(pb + 10);
        for (int rep = 0; rep < DUPN(11); ++rep) { if (rep) { GRID_BARRIER(); PHASE_FENCE(F); } if (EN(11) && IN(pb + 11)) phase_gather(F, l); }
        SEAM(pb + 11);
        for (int rep = 0; rep < DUPN(12); ++rep) { if (rep) { GRID_BARRIER(); PHASE_FENCE(F); }
        if (EN(12) && IN(pb + 12)) {
            const int ntiles = moe_tables(F, l);
            pg8::Gemm g{WSP(bf16_t, WS_XG), WSP(bf16_t, WS_W1T), XG_ROWS, 512, D};
            pg8::MoeOrder S{F.G, F.bid, 2, ntiles, (const LAS unsigned char*)(F.lds + LDS_TAB + 384), (size_t)512 * 1024 * 2};
            pg8::EpiMoeUp E{WSP(bf16_t, WS_HG)};
            pg8::gemm_phase(F.lds, F.tid, g, S, E);
        } }
        SEAM(pb + 12);
        for (int rep = 0; rep < DUPN(13); ++rep) { if (rep) { GRID_BARRIER(); PHASE_FENCE(F); }
        if (EN(13) && IN(pb + 13)) {
            const int ntiles = moe_tables(F, l);
            pg8::Gemm g{WSP(bf16_t, WS_HG), WSP(bf16_t, WS_W2T), XG_ROWS, D, 256};
            pg8::MoeOrder S{F.G, F.bid, 4, ntiles, (const LAS unsigned char*)(F.lds + LDS_TAB + 384), (size_t)1024 * 256 * 2};
            pg8::EpiMoeDown E{WSP(bf16_t, WS_Y2), WSP(float, SM_WROW)};
            pg8::gemm_phase(F.lds, F.tid, g, S, E);
        } }
        SEAM(pb + 13);
    }
    { constexpr int l = 1;
        const int pb = 1 + PH_PER_LAYER * l;
        for (int rep = 0; rep < (l == 0 ? DUPN(0) : 1); ++rep) { if (rep) { GRID_BARRIER(); PHASE_FENCE(F); } if (EN(0) && IN(pb + 0)) phase_norm1(F, l); }
        SEAM(pb + 0);
        for (int rep = 0; rep < DUPN(1); ++rep) { if (rep) { GRID_BARRIER(); PHASE_FENCE(F); }
        if (EN(1) && IN(pb + 1)) {
            pg8::Gemm g{WSP(bf16_t, WS_U), WSP(bf16_t, WS_WMIX), MROWS, LDP, D}; pg8::StaticOrder S; S.init(MROWS, LDP, F.G, F.bid);
            pg8::EpiInProj E{WSP(bf16_t, WS_P), WSP(bf16_t, SM_HALO)};
            pg8::gemm_phase(F.lds, F.tid, g, S, E);
        } }
        SEAM(pb + 1);
        if (EN(2) && IN(pb + 2)) prep_set(F, l, 0, F.G, F.bid);
        SEAM(pb + 2);
        if (EN(3) && IN(pb + 3)) phase_scan(F, l);
        SEAM(pb + 3);
        for (int rep = 0; rep < DUPN(4); ++rep) { if (rep) { GRID_BARRIER(); PHASE_FENCE(F); F.dry = 1; asm volatile("" : "+s"(F.dry)); } if (EN(4) && IN(pb + 4)) phase_hnorm(F, l); F.dry = 0; }
        SEAM(pb + 4);
        for (int rep = 0; rep < DUPN(5); ++rep) { if (rep) { GRID_BARRIER(); PHASE_FENCE(F); }
        if (EN(5) && IN(pb + 5)) {
            pg8::Gemm g{WSP(bf16_t, WS_U), WSP(bf16_t, WS_WGATE), NREAL, 3072, D}; pg8::StaticOrder S; S.init(NREAL, 3072, F.G, F.bid);
            pg8::EpiSigmoid E{WSP(bf16_t, WS_GT), 3072};
            pg8::gemm_phase(F.lds, F.tid, g, S, E);
            meta_gemm<0>(F, WSP(bf16_t, WS_U) + (size_t)META_ROW0 * D, WSP(bf16_t, WS_WGATE), 3072, D, 0);
        } }
        SEAM(pb + 5);
        for (int n = 0; n < 3; ++n) {
            if (EN(6) && IN(pb + 6 + n)) {
                pg8::Gemm g{WSP(bf16_t, WS_O) + (size_t)n * MROWS * 512, WSP(bf16_t, WS_WBT) + (size_t)n * 1024 * 512, NREAL, D, 512}; pg8::StaticOrder S; S.init(NREAL, D, F.G, F.bid);
                pg8::EpiBranch E{WSP(bf16_t, WS_MERGED), WSP(bf16_t, WS_GT), n};
                pg8::gemm_phase(F.lds, F.tid, g, S, E);
                meta_gemm<1>(F, WSP(bf16_t, WS_O) + (size_t)n * MROWS * 512 + (size_t)META_ROW0 * 512, WSP(bf16_t, WS_WBT) + (size_t)n * 1024 * 512, D, 512, n);
            }
            SEAM(pb + 6 + n);
        }
        if (EN(9) && IN(pb + 9)) {
            pg8::Gemm g{WSP(bf16_t, WS_MERGED), WSP(bf16_t, WS_WOT), NREAL, D, D}; pg8::StaticOrder S; S.init(NREAL, D, F.G, F.bid);
            pg8::EpiResidual E{OUTP, WSP(float, WS_HMETA)};
            pg8::gemm_phase(F.lds, F.tid, g, S, E);
            meta_gemm<2>(F, WSP(bf16_t, WS_MERGED) + (size_t)META_ROW0 * D, WSP(bf16_t, WS_WOT), D, D, 0);
        }
        SEAM(pb + 9);
        for (int rep = 0; rep < DUPN(10); ++rep) { if (rep) { GRID_BARRIER(); PHASE_FENCE(F); F.dry = 1; asm volatile("" : "+s"(F.dry)); } if (EN(10) && IN(pb + 10)) phase_norm2(F, l); F.dry = 0; }
        SEAM(pb + 10);
        for (int rep = 0; rep < DUPN(11); ++rep) { if (rep) { GRID_BARRIER(); PHASE_FENCE(F); } if (EN(11) && IN(pb + 11)) phase_gather(F, l); }
        SEAM(pb + 11);
        for (int rep = 0; rep < DUPN(12); ++rep) { if (rep) { GRID_BARRIER(); PHASE_FENCE(F); }
        if (EN(12) && IN(pb + 12)) {
            const int ntiles = moe_tables(F, l);
            pg8::Gemm g{WSP(bf16_t, WS_XG), WSP(bf16_t, WS_W1T), XG_ROWS, 512, D};
            pg8::MoeOrder S{F.G, F.bid, 2, ntiles, (const LAS unsigned char*)(F.lds + LDS_TAB + 384), (size_t)512 * 1024 * 2};
            pg8::EpiMoeUp E{WSP(bf16_t, WS_HG)};
            pg8::gemm_phase(F.lds, F.tid, g, S, E);
        } }
        SEAM(pb + 12);
        for (int rep = 0; rep < DUPN(13); ++rep) { if (rep) { GRID_BARRIER(); PHASE_FENCE(F); }
        if (EN(13) && IN(pb + 13)) {
            const int ntiles = moe_tables(F, l);
            pg8::Gemm g{WSP(bf16_t, WS_HG), WSP(bf16_t, WS_W2T), XG_ROWS, D, 256};
            pg8::MoeOrder S{F.G, F.bid, 4, ntiles, (const LAS unsigned char*)(F.lds + LDS_TAB + 384), (size_t)1024 * 256 * 2};
            pg8::EpiMoeDown E{WSP(bf16_t, WS_Y2), WSP(float, SM_WROW)};
            pg8::gemm_phase(F.lds, F.tid, g, S, E);
        } }
        SEAM(pb + 13);
    }
#if DBG_STOP > 0
    if (EN(14) && IN(N_PHASES - 1)) { const int gt = F.bid * NTHREADS + F.tid, NT = F.G * NTHREADS;
#ifdef DBG_LIN
        { const bf16_t* s1 = WSP(bf16_t, DBG_SRC); const bf16_t* s2 = WSP(bf16_t, DBG_SRC2);
          for (size_t i = gt; i < (size_t)NREAL * D; i += NT) F.out[i] = i < (size_t)DBG_N1 ? bf2f(s1[i]) : (i < (size_t)DBG_N1 + DBG_N2 ? bf2f(s2[i - DBG_N1]) : 0.f); }
#else
        if (DBG_LD > 0) { const bf16_t* src = WSP(bf16_t, DBG_SRC); for (size_t i = gt; i < (size_t)NREAL * D; i += NT) { const size_t r = i >> 10, c = i & 1023; F.out[i] = bf2f(src[r * DBG_LD + (c * DBG_LD) / 1024]); } }
#endif
    }
#else
#ifdef DBG_XBAR
    for (int i = 0; i < DBG_XBAR; ++i) { GRID_BARRIER(); PHASE_FENCE(F); }
#endif
    if (EN(14) && IN(N_PHASES - 1)) phase_final(F);
    if (DBG_TA >= 0) { float* tw = WSP(float, WS_CTL) + 2048; if (F.bid == 0 && F.tid == 0) { tw[0] = (float)MISC[17] * 0.01f; }
        GRID_BARRIER(); PHASE_FENCE(F);
        const float v = floorf(WSP(float, WS_CTL)[2048] * (1.0f / DBG_TQ)) * 0.25f;
        const int gt = F.bid * NTHREADS + F.tid, NT = F.G * NTHREADS;
        for (size_t i = gt; i < (size_t)NREAL * D; i += NT) F.out[i] = v; }
#endif
#undef IN
#undef SEAM
}

#if MK_ONE_LAUNCH
#ifndef KM_ONE
#define KM_ONE 0xffffffffu
#endif
constexpr unsigned KMASK[1] = {KM_ONE};
#else
constexpr unsigned KMASK[3] = {0x0C19u, 0xC004u, 0x3262u};
#endif
template <unsigned M> static bool setup_kernel(int& per_cu) {
    if (hipFuncSetAttribute((const void*)hybrid_fwd<M>, hipFuncAttributeMaxDynamicSharedMemorySize, LDS_BYTES) != hipSuccess) return false;
    if (hipOccupancyMaxActiveBlocksPerMultiprocessor(&per_cu, (const void*)hybrid_fwd<M>, NTHREADS, LDS_BYTES) != hipSuccess) per_cu = 0;
    (void)hipGetLastError();
    return true;
}
static int phase_kind(int k) { if (k == 0) return 15; if (k == N_PHASES - 1) return 14; const int j = (k - 1) % PH_PER_LAYER; return (j >= 6 && j <= 8) ? 6 : j; }
extern "C" void kernel_launch(void* const* d_in, const int* in_sizes, int n_in, void* d_out, int out_size, void* d_ws, size_t ws_size, hipStream_t stream) {
    static int grid = 0;
    if (grid == 0) {
        if (n_in != 24 || in_sizes[0] != NREAL * D || out_size != NREAL * D || ws_size < WS_END) {
            fprintf(stderr, "kernel_launch: unexpected problem (n_in %d, in0 %d, out %d, ws %zu < %zu); nothing launched\n", n_in, n_in > 0 ? in_sizes[0] : -1, out_size, ws_size, (size_t)WS_END); grid = -1; return; }
        int dev = 0, cus = 0, per_cu = 0; bool ok = true;
        if (hipGetDevice(&dev) != hipSuccess || hipDeviceGetAttribute(&cus, hipDeviceAttributeMultiprocessorCount, dev) != hipSuccess) { grid = -1; return; }
#if MK_ONE_LAUNCH
        ok = setup_kernel<KMASK[0]>(per_cu);
#else
        ok = setup_kernel<KMASK[0]>(per_cu) && setup_kernel<KMASK[1]>(per_cu) && setup_kernel<KMASK[2]>(per_cu);
#endif
        if (!ok) { fprintf(stderr, "kernel_launch: hipFuncSetAttribute failed\n"); grid = -1; return; }
        if (per_cu < 1) fprintf(stderr, "kernel_launch: occupancy query says %d\n", per_cu);
        grid = cus;
    }
    if (grid < 0) return;
    if (hipMemsetAsync((char*)d_ws + WS_CTL, 0, CTL_BYTES, stream) != hipSuccess) return;
    Params p{};
    for (int i = 0; i < 24; ++i) p.in[i] = (const float*)d_in[i];
    p.out = (float*)d_out; p.ws = (unsigned char*)d_ws;
#if MK_ONE_LAUNCH
    p.ph_lo = 0; p.ph_hi = N_PHASES;
    hipLaunchKernelGGL(hybrid_fwd<KMASK[0]>, dim3(grid), dim3(NTHREADS), LDS_BYTES, stream, p);
#else
    for (int k = 0; k < N_PHASES; ++k) { if (DBG_STOP > 0 && k >= DBG_STOP && k != N_PHASES - 1) continue; p.ph_lo = k; p.ph_hi = k + 1; const unsigned bit = 1u << phase_kind(k);
        if (KMASK[0] & bit) hipLaunchKernelGGL(hybrid_fwd<KMASK[0]>, dim3(grid), dim3(NTHREADS), LDS_BYTES, stream, p);
        else if (KMASK[1] & bit) hipLaunchKernelGGL(hybrid_fwd<KMASK[1]>, dim3(grid), dim3(NTHREADS), LDS_BYTES, stream, p);
        else hipLaunchKernelGGL(hybrid_fwd<KMASK[2]>, dim3(grid), dim3(NTHREADS), LDS_BYTES, stream, p); }
#endif
}
```

```cpp
#include <hip/hip_runtime.h>
#include <cstdio>
#include <cstdint>

#define LAS __attribute__((address_space(3)))
typedef unsigned short bf16_t;
typedef short bf16x8 __attribute__((ext_vector_type(8)));
typedef float f32x4 __attribute__((ext_vector_type(4)));
typedef float f32x2 __attribute__((ext_vector_type(2)));
typedef unsigned u32x4 __attribute__((ext_vector_type(4)));
typedef unsigned u32x2 __attribute__((ext_vector_type(2)));

constexpr int D = 1024, NREAL = 16384, MROWS = 16640, META_ROW0 = 16384 + 48, META_END = 16384 + 64;
constexpr int NSLOT = 257;
constexpr int LDP = 5632;
constexpr int PC_AQ = 0, PC_AF = 512, PC_AI = 1024, PC_AG = 1536, PC_BQKV = 2048, PC_BG = 3584, PC_CQ = 4096, PC_CK = 4352, PC_CV = 4608, PC_CG = 5120;
constexpr int IN_COLS = 8728;
constexpr int NTHREADS = 512, NWAVES = 8;
constexpr int XG_ROWS = 40960;

constexpr size_t MiB = 1ull << 20;
constexpr size_t WS_CTL = 0, CTL_BYTES = 1 * MiB;
constexpr int CW_BAR = 4096, CW_CNT = 1024;
constexpr size_t SM_SW1 = 1 * MiB;
constexpr size_t SM_RWG = SM_SW1 + 2 * 24 * 1024 * 4;
constexpr size_t SM_RWE = SM_RWG + 2 * 4 * 1024 * 4;
constexpr size_t SM_LAB = SM_RWE + 2 * 32 * 1024 * 4;
constexpr size_t SM_GK = SM_LAB + 2 * 2 * 512 * 4;
constexpr size_t SM_BETA = SM_GK + (size_t)MROWS * 16 * 4;
constexpr size_t SM_LOGA = SM_BETA + (size_t)MROWS * 4 * 4;
constexpr size_t SM_TOK = SM_LOGA + (size_t)MROWS * 4 * 4;
constexpr size_t SM_WROW = SM_TOK + (size_t)MROWS * 8 * 4;
constexpr size_t SM_DECA = SM_WROW + (size_t)XG_ROWS * 4;
constexpr size_t SM_DECC = SM_DECA + 1028 * 128 * 4;
constexpr size_t SM_DECB = SM_DECC + 1028 * 64 * 4;
constexpr size_t SM_HALO = SM_DECB + 8192;
constexpr size_t SM_END = SM_HALO + 260 * 3 * 1536 * 2;
static_assert(SM_END <= 8 * MiB, "small region");
constexpr size_t WS_HMETA = 8 * MiB;
constexpr size_t WS_WMIX = 9 * MiB;
constexpr size_t WS_WGATE = 20 * MiB;
constexpr size_t WS_WBT = 26 * MiB;
constexpr size_t WS_WOT = 29 * MiB;
constexpr size_t WS_O = 31 * MiB;
constexpr size_t O_STRIDE = (size_t)MROWS * 512 * 2;
constexpr size_t WS_W1T = 31 * MiB;
constexpr size_t WS_W2T = 63 * MiB;
constexpr size_t WS_U = 80 * MiB;
constexpr size_t WS_P = 113 * MiB;
constexpr size_t WS_GT = 113 * MiB;
constexpr size_t WS_MERGED = 211 * MiB;
constexpr size_t WS_XG = 113 * MiB;
constexpr size_t WS_HG = 193 * MiB;
constexpr size_t WS_Y2 = 213 * MiB;
constexpr size_t WS_SCA = 294 * MiB;
constexpr size_t WS_QKD = 303 * MiB;
constexpr size_t WS_SCC = 312 * MiB;
constexpr size_t WS_K1TB = 321 * MiB;
constexpr size_t WS_END = 338 * MiB;

constexpr int LDS_BYTES = 163840;
constexpr int LDS_MISC = LDS_BYTES - 512;
constexpr int LDS_TAB = LDS_BYTES - 1536;
constexpr int LDS_SCRATCH = LDS_TAB;

typedef __bf16 bf16x2v __attribute__((ext_vector_type(2)));
__device__ __forceinline__ unsigned pk2(float lo, float hi) { const f32x2 v = {lo, hi}; return __builtin_bit_cast(unsigned, __builtin_convertvector(v, bf16x2v)); }
__device__ __forceinline__ bf16_t f2bf(float f) { return (bf16_t)(pk2(f, 0.f) & 0xffffu); }
__device__ __forceinline__ float bf2f(bf16_t b) { return __uint_as_float(((unsigned)b) << 16); }
__device__ __forceinline__ float bflo(unsigned w) { return __uint_as_float(w << 16); }
__device__ __forceinline__ float bfhi(unsigned w) { return __uint_as_float(w & 0xffff0000u); }
__device__ __forceinline__ float sigmoidf_(float x) { return __builtin_amdgcn_rcpf(1.0f + __expf(-x)); }
__device__ __forceinline__ float siluf_(float x) { return x * __builtin_amdgcn_rcpf(1.0f + __expf(-x)); }
__device__ __forceinline__ float logsigf_(float x) { return fminf(x, 0.f) - __logf(1.0f + __expf(-fabsf(x))); }
__device__ __forceinline__ float softplusf_(float x) { return fmaxf(x, 0.f) + log1pf(__expf(-fabsf(x))); }
__device__ __forceinline__ bool row_valid(int r) { return r < NREAL || (r >= META_ROW0 && r < META_END); }
__device__ __forceinline__ float wave_sum(float v) {
#define DPP_ADD(ctrl, rmask) v += __int_as_float(__builtin_amdgcn_update_dpp(0, __float_as_int(v), (ctrl), (rmask), 0xf, false))
    DPP_ADD(0x111, 0xf); DPP_ADD(0x112, 0xf); DPP_ADD(0x114, 0xf); DPP_ADD(0x118, 0xf);
    DPP_ADD(0x142, 0xa); DPP_ADD(0x143, 0xc);
#undef DPP_ADD
    return __int_as_float(__builtin_amdgcn_readlane(__float_as_int(v), 63));
}
#define LDS_WAIT() asm volatile("s_waitcnt lgkmcnt(0)" ::: "memory")

#define XB_TMO      128
#define XB_XCNT(j)  (256  + 64 * (j))
#define XB_XSUB(j)  (1280 + 64 * (j))
#define XB_XGEN(j)  (2304 + 64 * (j))
#define XB_TOP      3328
#define XB_TOPGEN   3392
#define XCD_BAR_WORDS 3456
#define XB_SPIN_CAP (1u << 18)
__device__ __forceinline__ unsigned xb_ld(unsigned* p)              { return __hip_atomic_load(p, __ATOMIC_RELAXED, __HIP_MEMORY_SCOPE_AGENT); }
__device__ __forceinline__ unsigned xb_add(unsigned* p, unsigned v) { return __hip_atomic_fetch_add(p, v, __ATOMIC_RELAXED, __HIP_MEMORY_SCOPE_AGENT); }
__device__ __forceinline__ unsigned xb_xcc_id() { return (unsigned)__builtin_amdgcn_s_getreg((3 << 11) | 20) & 0xFu; }
#define XB_SPIN(cond, bar) do { unsigned _sp = 0; while (cond) { __builtin_amdgcn_s_sleep(1); \
    if ((++_sp & 255u) == 0u) { if (xb_ld(&(bar)[XB_TMO])) break; if (_sp > XB_SPIN_CAP) { atomicAdd(&(bar)[XB_TMO], 1u); break; } } } } while (0)
struct XcdBarrier { unsigned* bar; unsigned x; volatile LAS unsigned* st; };
__device__ __forceinline__ XcdBarrier xcd_barrier_post(unsigned* bar, volatile LAS unsigned* st) {
    XcdBarrier b; b.bar = bar; b.x = xb_xcc_id(); b.st = st;
    if (threadIdx.x == 0) (void)xb_add(&bar[XB_XCNT(b.x)], 1u);
    return b;
}
__device__ __forceinline__ void xcd_barrier_complete(unsigned* bar, unsigned x, unsigned& nloc, unsigned& nx, const unsigned G) {
    unsigned sum, cnt, mine, sp = 0u;
    for (;;) {
        sum = 0u; cnt = 0u; mine = 0u;
#pragma unroll
        for (unsigned j = 0; j < 16; ++j) { const unsigned c = xb_ld(&bar[XB_XCNT(j)]); sum += c; cnt += (c > 0u) ? 1u : 0u; mine = (j == x) ? c : mine; }
        if (sum == G) break;
        __builtin_amdgcn_s_sleep(1);
        if ((++sp & 255u) == 0u) { if (xb_ld(&bar[XB_TMO])) break; if (sp > XB_SPIN_CAP) { atomicAdd(&bar[XB_TMO], 1u); break; } }
    }
    nloc = mine > 0u ? mine : 1u; nx = cnt > 0u ? cnt : 1u;
}
__device__ __attribute__((noinline)) void xcd_barrier(unsigned* bar_, unsigned x_, volatile LAS unsigned* st_, int tid_, unsigned G_) {
    XcdBarrier b; b.bar = bar_; b.x = x_; b.st = st_;
    asm volatile("s_waitcnt vmcnt(0)" ::: "memory");
    __syncthreads();
    if (tid_ == 0) {
        unsigned* bar = b.bar;
        __builtin_amdgcn_s_waitcnt(0);
        unsigned nloc = b.st[0], nx = b.st[1];
        if (nloc == 0u) { xcd_barrier_complete(bar, b.x, nloc, nx, G_); b.st[0] = nloc; b.st[1] = nx; }
        const unsigned old = xb_add(&bar[XB_XSUB(b.x)], 1u);
        const unsigned gen = old / nloc;
        if (old + 1u == (gen + 1u) * nloc) {
            __builtin_amdgcn_fence(__ATOMIC_RELEASE, "agent");
            asm volatile("s_waitcnt vmcnt(0)" ::: "memory");
            const unsigned og = xb_add(&bar[XB_TOP], 1u);
            const unsigned tg = og / nx;
            if (og + 1u == (tg + 1u) * nx) xb_add(&bar[XB_TOPGEN], 1u);
            else XB_SPIN(xb_ld(&bar[XB_TOPGEN]) == tg, bar);
            __builtin_amdgcn_fence(__ATOMIC_ACQUIRE, "agent");
            xb_add(&bar[XB_XGEN(b.x)], 1u);
            asm volatile("s_waitcnt vmcnt(0)" ::: "memory");
        } else {
            XB_SPIN(xb_ld(&bar[XB_XGEN(b.x)]) == gen, bar);
            __builtin_amdgcn_fence(__ATOMIC_ACQUIRE, "agent");
            asm volatile("s_waitcnt vmcnt(0)" ::: "memory");
        }
    }
    __syncthreads();
}

#ifndef PROF_ON
#define PROF_ON 0
#endif
#if PROF_ON
#define PROF_SLOTS(F) WSP(unsigned, WS_CTL + 524288)
#define PROF_MARK(F, k) do { if ((F).bid == PROF_BID && (F).tid == 0) PROF_SLOTS(F)[k] = (unsigned)__builtin_amdgcn_s_memrealtime(); } while (0)
#if PROF_IN & 1
#define PROF_MARKI(F, k) PROF_MARK(F, k)
#else
#define PROF_MARKI(F, k) do { } while (0)
#endif
#if PROF_IN & 2
#define PROF_MARKG(F, k) PROF_MARK(F, k)
#else
#define PROF_MARKG(F, k) do { } while (0)
#endif
#define PROF_SPIN(F) do { if ((F).bid == PROF_BID && (F).tid == 0) { unsigned qa_ = (PROF_SLOTS(F)[PROF_A1] - PROF_SLOTS(F)[PROF_A0] + 50u) / 100u, qb_ = (PROF_SLOTS(F)[PROF_B1] - PROF_SLOTS(F)[PROF_B0] + 50u) / 100u; \
    qa_ = qa_ > 127u ? 127u : qa_; qb_ = qb_ > 127u ? 127u : qb_; const unsigned d_ = (qa_ + 128u * qb_) * 1600u; const unsigned t0_ = (unsigned)__builtin_amdgcn_s_memrealtime(); \
    while ((unsigned)__builtin_amdgcn_s_memrealtime() - t0_ < d_) __builtin_amdgcn_s_sleep(8); } } while (0)
#else
#define PROF_MARK(F, k) do { } while (0)
#define PROF_MARKI(F, k) do { } while (0)
#define PROF_MARKG(F, k) do { } while (0)
#define PROF_SPIN(F) do { } while (0)
#endif
namespace pg8 {
constexpr int BM = 256, BK = 64, HALF = 128, HTB = HALF * BK * 2, STAGE_BYTES = 8 * HTB, NXCD = 8, WGM = 8;
__host__ __device__ __forceinline__ int lds_byte(int r, int c) { const int st = (r >> 4) * 2 + (c >> 5), rr = r & 15, cc = c & 31, ob = rr * 64 + cc * 2; return st * 1024 + (ob ^ (((ob >> 9) & 1) << 5)); }
__host__ __device__ __forceinline__ void stage_rc(int b, int& R, int& C) { const int st = b / 1024, sb = b % 1024, swz = sb ^ (((sb >> 9) & 1) << 5); R = (st >> 1) * 16 + swz / 64; C = (st & 1) * 32 + (swz % 64) / 2; }
__host__ __device__ __forceinline__ int perm32(int rho) { const int n = rho >> 4, i = rho & 15; return 8 * (i >> 2) + 4 * n + (i & 3); }

struct Unit { int pm, pn, ex; };
struct Gemm { const bf16_t* A; const bf16_t* Bt; int M, N, K; };

struct StaticOrder {
    int nM, nN, nwg, G, c;
    __device__ void init(int M, int N, int G_, int c_) { nM = M / BM; nN = N / BM; nwg = nM * nN; G = G_; c = c_; }
    __device__ bool next(int i, Unit& u) const {
        const long L = (long)i * G + c; if (L >= nwg) return false;
        int wgid = (int)L; { const int q = nwg / NXCD, r = nwg % NXCD, xcd = wgid % NXCD, off = wgid / NXCD; wgid = (xcd < r ? xcd * (q + 1) : r * (q + 1) + (xcd - r) * q) + off; }
        const int nig = WGM * nN, gid = wgid / nig, fm = gid * WGM, gsz = (nM - fm) < WGM ? (nM - fm) : WGM;
        u.pm = fm + ((wgid % nig) % gsz); u.pn = (wgid % nig) / gsz; u.ex = 0; return true;
    }
    __device__ __forceinline__ void ptrs(const Gemm& g, const Unit& u, const char*& a, const char*& b) const {
        const size_t tstep = (size_t)BM * g.K * 2; a = (const char*)g.A + (size_t)u.pm * tstep; b = (const char*)g.Bt + (size_t)u.pn * tstep; }
};
struct MoeOrder {
    int G, c, npn, ntiles; const LAS unsigned char* tab; size_t estride;
    __device__ bool next(int i, Unit& u) const {
        const long L = (long)i * G + c; if (L >= (long)ntiles * npn) return false;
        u.pm = (int)(L / npn); u.pn = (int)(L % npn); u.ex = (int)tab[u.pm]; return true;
    }
    __device__ __forceinline__ void ptrs(const Gemm& g, const Unit& u, const char*& a, const char*& b) const {
        const size_t tstep = (size_t)BM * g.K * 2; a = (const char*)g.A + (size_t)u.pm * tstep; b = (const char*)g.Bt + (size_t)u.ex * estride + (size_t)u.pn * tstep; }
};

template <class Epi, class Sched>
__device__ __forceinline__ void gemm_phase(LAS unsigned char* lds, const int tid, const Gemm g, const Sched& S, const Epi& E) {
    const int wid = __builtin_amdgcn_readfirstlane(tid >> 6), lane = tid & 63, wr = wid >> 2, wc = wid & 3, fr = lane & 15, fq = lane >> 4;
    int K = g.K; asm volatile("" : "+s"(K));
    const int nt = K / BK;
    unsigned voffA[2], voffB[2];
#pragma unroll
    for (int i = 0; i < 2; ++i) { int R, C; stage_rc(tid * 16 + i * 8192, R, C); const int Rb = Epi::PERM ? ((R & ~31) + perm32(R & 31)) : R;
        voffA[i] = (unsigned)(R * K + C) * 2u; voffB[i] = (unsigned)(Rb * K + C) * 2u; }
    const size_t kstep = (size_t)(BK * 2);
    const size_t hstep = (size_t)HALF * K * 2;
    const unsigned ldsw = (unsigned)wid * 1024u;
    const int aoff = lds_byte(wr * 64 + fr, fq * 8), boff = lds_byte(wc * 32 + fr, fq * 8);
#define PG8_SA(b, h) (((b) * 2 + (h)) * HTB)
#define PG8_SB(b, h) ((4 + (b) * 2 + (h)) * HTB)
#define PG8_STAGE(bufoff, gbase, voff) do { _Pragma("unroll") for (int _i = 0; _i < 2; ++_i) \
        __builtin_amdgcn_global_load_lds((const unsigned*)((const char*)(gbase) + (voff)[_i]), (LAS unsigned*)(lds + (bufoff) + ldsw + _i * 8192), 16, 0, 0); } while (0)
#define PG8_LDA(dst, b, h) do { _Pragma("unroll") for (int m = 0; m < 4; ++m) _Pragma("unroll") for (int k = 0; k < 2; ++k) dst[m][k] = *(const LAS bf16x8*)(lds + PG8_SA(b, h) + aoff + m * 2048 + k * 1024); } while (0)
#define PG8_LDB(dst, b, h) do { _Pragma("unroll") for (int n = 0; n < 2; ++n) _Pragma("unroll") for (int k = 0; k < 2; ++k) dst[n][k] = *(const LAS bf16x8*)(lds + PG8_SB(b, h) + boff + n * 2048 + k * 1024); } while (0)
#define PG8_MMA(ai, bj, At, Bt) do { __builtin_amdgcn_s_setprio(1); _Pragma("unroll") for (int m = 0; m < 4; ++m) _Pragma("unroll") for (int n = 0; n < 2; ++n) _Pragma("unroll") for (int k = 0; k < 2; ++k) \
        acc[ai][bj][m][n] = __builtin_amdgcn_mfma_f32_16x16x32_bf16(Bt[n][k], At[m][k], acc[ai][bj][m][n], 0, 0, 0); __builtin_amdgcn_s_setprio(0); } while (0)
#define PG8_WAIT_V(n) asm volatile("s_waitcnt vmcnt(" #n ")" ::: "memory")
#define PG8_WAIT_L(n) asm volatile("s_waitcnt lgkmcnt(" #n ")" ::: "memory")
#define PG8_BAR __builtin_amdgcn_s_barrier()
#define PG8_SCHED __builtin_amdgcn_sched_barrier(0)
    Unit cur, nxt; int ui = 0;
    if (!S.next(0, cur)) return;
    f32x4 acc[2][2][4][2];
#pragma unroll
    for (int a = 0; a < 2; ++a)
#pragma unroll
        for (int b = 0; b < 2; ++b)
#pragma unroll
            for (int m = 0; m < 4; ++m)
#pragma unroll
                for (int n = 0; n < 2; ++n) acc[a][b][m][n] = (f32x4){0.f, 0.f, 0.f, 0.f};
    bf16x8 At[4][2], B0[2][2], B1[2][2];
    const char* cA; const char* cB; S.ptrs(g, cur, cA, cB);
    PG8_STAGE(PG8_SB(0, 0), cB, voffB); PG8_STAGE(PG8_SA(0, 0), cA, voffA); PG8_STAGE(PG8_SB(0, 1), cB + hstep, voffB); PG8_STAGE(PG8_SA(0, 1), cA + hstep, voffA);
    if (wr == 1) PG8_BAR;
    PG8_WAIT_V(4); PG8_BAR;
    PG8_STAGE(PG8_SB(1, 0), cB + kstep, voffB); PG8_STAGE(PG8_SA(1, 0), cA + kstep, voffA); PG8_STAGE(PG8_SB(1, 1), cB + hstep + kstep, voffB);
    PG8_WAIT_V(6); PG8_BAR;
    for (;;) {
        const bool has_next = S.next(ui + 1, nxt);
        const char* nA = cA; const char* nB = cB; if (has_next) S.ptrs(g, nxt, nA, nB);
        for (int t = 0; t < nt; t += 2) {
            const bool last = (t == nt - 2);
            const char* a1 = cA + (size_t)(t + 1) * kstep;
            const char* a2 = last ? nA : cA + (size_t)(t + 2) * kstep; const char* b2 = last ? nB : cB + (size_t)(t + 2) * kstep;
            const char* a3 = a2 + kstep; const char* b3 = b2 + kstep;
            PG8_LDB(B0, 0, 0); PG8_SCHED; PG8_LDA(At, 0, 0); PG8_STAGE(PG8_SA(1, 1), a1 + hstep, voffA);
            PG8_WAIT_L(8); PG8_BAR; PG8_WAIT_L(0); PG8_MMA(0, 0, At, B0); PG8_BAR; PG8_SCHED;
            PG8_LDB(B1, 0, 1); PG8_STAGE(PG8_SB(0, 0), b2, voffB);
            PG8_BAR; PG8_WAIT_L(0); PG8_MMA(0, 1, At, B1); PG8_BAR;
            PG8_LDA(At, 0, 1); PG8_STAGE(PG8_SA(0, 0), a2, voffA);
            PG8_BAR; PG8_WAIT_L(0); PG8_MMA(1, 0, At, B0); PG8_BAR; PG8_SCHED;
            PG8_STAGE(PG8_SB(0, 1), b2 + hstep, voffB);
            PG8_WAIT_V(6); PG8_BAR; PG8_MMA(1, 1, At, B1); PG8_BAR;
            PG8_LDB(B0, 1, 0); PG8_SCHED; PG8_LDA(At, 1, 0); PG8_STAGE(PG8_SA(0, 1), a2 + hstep, voffA);
            PG8_WAIT_L(8); PG8_BAR; PG8_WAIT_L(0); PG8_MMA(0, 0, At, B0); PG8_BAR; PG8_SCHED;
            PG8_LDB(B1, 1, 1); PG8_STAGE(PG8_SB(1, 0), b3, voffB);
            PG8_BAR; PG8_WAIT_L(0); PG8_MMA(0, 1, At, B1); PG8_BAR;
            PG8_LDA(At, 1, 1); PG8_STAGE(PG8_SA(1, 0), a3, voffA);
            PG8_BAR; PG8_WAIT_L(0); PG8_MMA(1, 0, At, B0); PG8_BAR; PG8_SCHED;
            PG8_STAGE(PG8_SB(1, 1), b3 + hstep, voffB);
            PG8_WAIT_V(6); PG8_BAR; PG8_MMA(1, 1, At, B1); PG8_BAR;
        }
        E(acc, cur, wr, wc, fr, fq);
        if (!has_next) break;
#pragma unroll
        for (int a = 0; a < 2; ++a)
#pragma unroll
            for (int b = 0; b < 2; ++b)
#pragma unroll
                for (int m = 0; m < 4; ++m)
#pragma unroll
                    for (int n = 0; n < 2; ++n) acc[a][b][m][n] = (f32x4){0.f, 0.f, 0.f, 0.f};
        cur = nxt; cA = nA; cB = nB; ++ui;
    }
    PG8_WAIT_V(0);
    if (wr == 0) PG8_BAR;
    PG8_BAR;
#undef PG8_SA
#undef PG8_SB
#undef PG8_STAGE
#undef PG8_LDA
#undef PG8_LDB
#undef PG8_MMA
#undef PG8_WAIT_V
#undef PG8_WAIT_L
#undef PG8_BAR
#undef PG8_SCHED
}

#define EPI_PERM_LOOP(...) \
    _Pragma("unroll") for (int ai = 0; ai < 2; ++ai) _Pragma("unroll") for (int m = 0; m < 4; ++m) { const int row = u.pm * BM + ai * HALF + wr * 64 + m * 16 + fr; \
        _Pragma("unroll") for (int bj = 0; bj < 2; ++bj) { const int col0 = u.pn * BM + bj * HALF + wc * 32 + 8 * fq; f32x4 v0 = acc[ai][bj][m][0], v1 = acc[ai][bj][m][1]; __VA_ARGS__ } if (EPI_PIN) __builtin_amdgcn_sched_barrier(0); }

struct EpiInProj {
    static constexpr bool PERM = true, EPI_PIN = true;
    bf16_t* P; bf16_t* halo;
    __device__ __forceinline__ void operator()(const f32x4 (&acc)[2][2][4][2], const Unit& u, int wr, int wc, int fr, int fq) const {
        const bool is_qkv = u.pn >= 8 && u.pn < 14;
        EPI_PERM_LOOP({
            u32x4 w; w.x = pk2(v0[0], v0[1]); w.y = pk2(v0[2], v0[3]); w.z = pk2(v1[0], v1[1]); w.w = pk2(v1[2], v1[3]);
            *(u32x4*)(P + (size_t)row * LDP + col0) = w;
            if (is_qkv && (row & 63) >= 61) *(u32x4*)(halo + ((size_t)(row >> 6) * 3 + ((row & 63) - 61)) * 1536 + (col0 - PC_BQKV)) = w;
        })
    }
};
__device__ __forceinline__ float lfg(float lb, float oml, float x) { return __logf(lb + oml * __builtin_amdgcn_rcpf(1.0f + __expf(-x)) + 1e-30f); }
struct EpiSigmoid {
    static constexpr bool PERM = true, EPI_PIN = true;
    bf16_t* O; int ldc;
    __device__ __forceinline__ void operator()(const f32x4 (&acc)[2][2][4][2], const Unit& u, int wr, int wc, int fr, int fq) const {
        EPI_PERM_LOOP({
            u32x4 w; w.x = pk2(sigmoidf_(v0[0]), sigmoidf_(v0[1])); w.y = pk2(sigmoidf_(v0[2]), sigmoidf_(v0[3])); w.z = pk2(sigmoidf_(v1[0]), sigmoidf_(v1[1])); w.w = pk2(sigmoidf_(v1[2]), sigmoidf_(v1[3]));
            *(u32x4*)(O + (size_t)row * ldc + col0) = w;
        })
    }
};
struct EpiBranch {
    static constexpr bool PERM = true, EPI_PIN = false;
    bf16_t* merged; const bf16_t* gt; int n;
    __device__ __forceinline__ void operator()(const f32x4 (&acc)[2][2][4][2], const Unit& u, int wr, int wc, int fr, int fq) const {
        EPI_PERM_LOOP({
            const u32x4 gw = *(const u32x4*)(gt + (size_t)row * 3072 + n * 1024 + col0);
            float x[8] = {v0[0] * bflo(gw.x), v0[1] * bfhi(gw.x), v0[2] * bflo(gw.y), v0[3] * bfhi(gw.y), v1[0] * bflo(gw.z), v1[1] * bfhi(gw.z), v1[2] * bflo(gw.w), v1[3] * bfhi(gw.w)};
            bf16_t* mp = merged + (size_t)row * 1024 + col0;
            if (n != 0) { const u32x4 o = *(const u32x4*)mp; x[0] += bflo(o.x); x[1] += bfhi(o.x); x[2] += bflo(o.y); x[3] += bfhi(o.y); x[4] += bflo(o.z); x[5] += bfhi(o.z); x[6] += bflo(o.w); x[7] += bfhi(o.w); }
            u32x4 w; w.x = pk2(x[0], x[1]); w.y = pk2(x[2], x[3]); w.z = pk2(x[4], x[5]); w.w = pk2(x[6], x[7]);
            *(u32x4*)mp = w;
        })
    }
};
struct EpiResidual {
    static constexpr bool PERM = false;
    float* hreal; float* hmeta;
    __device__ __forceinline__ void operator()(const f32x4 (&acc)[2][2][4][2], const Unit& u, int wr, int wc, int fr, int fq) const {
#pragma unroll
        for (int ai = 0; ai < 2; ++ai)
#pragma unroll
            for (int m = 0; m < 4; ++m) { const int row = u.pm * BM + ai * HALF + wr * 64 + m * 16 + fr;
                float* rowp = (row < NREAL ? hreal + (size_t)row * D : hmeta + (size_t)(row - NREAL) * D) + u.pn * BM + wc * 32 + 4 * fq;
#pragma unroll
                for (int bj = 0; bj < 2; ++bj)
#pragma unroll
                    for (int n = 0; n < 2; ++n) { f32x4* p = (f32x4*)(rowp + bj * HALF + n * 16); *p = *p + acc[ai][bj][m][n]; } }
    }
};
struct EpiMoeUp {
    static constexpr bool PERM = true, EPI_PIN = true;
    bf16_t* H;
    __device__ __forceinline__ void operator()(const f32x4 (&acc)[2][2][4][2], const Unit& u, int wr, int wc, int fr, int fq) const {
        EPI_PERM_LOOP({
            const int hc = col0 >> 1;
            u32x2 w; w.x = pk2(siluf_(v0[0]) * v1[0], siluf_(v0[1]) * v1[1]); w.y = pk2(siluf_(v0[2]) * v1[2], siluf_(v0[3]) * v1[3]);
            *(u32x2*)(H + (size_t)row * 256 + hc) = w;
        })
    }
};
struct EpiMoeDown {
    static constexpr bool PERM = true, EPI_PIN = false;
    bf16_t* Y; const float* wrow;
    __device__ __forceinline__ void operator()(const f32x4 (&acc)[2][2][4][2], const Unit& u, int wr, int wc, int fr, int fq) const {
        EPI_PERM_LOOP({
            const float s = wrow[row];
            u32x4 w; w.x = pk2(v0[0] * s, v0[1] * s); w.y = pk2(v0[2] * s, v0[3] * s); w.z = pk2(v1[0] * s, v1[1] * s); w.w = pk2(v1[2] * s, v1[3] * s);
            *(u32x4*)(Y + (size_t)row * 1024 + col0) = w;
        })
    }
};
}
#define GAS __attribute__((address_space(1)))
struct Params { const float* in[24]; float* out; unsigned char* ws; int ph_lo, ph_hi; };
struct Frame {
    LAS unsigned char* lds; int tid, lane, wave, G, bid;
    __attribute__((address_space(1))) float* out; __attribute__((address_space(1))) unsigned char* ws; const float* const __attribute__((address_space(4)))* inp; int dry;
};
#define PHASE_FENCE(F) do { asm volatile("" : "+s"((F).ws), "+s"((F).out), "+s"((F).inp), "+v"((F).tid), "+s"((F).bid), "+s"((F).G)); \
    (F).lane = (F).tid & 63; (F).wave = __builtin_amdgcn_readfirstlane((F).tid >> 6); } while (0)
__device__ __forceinline__ const float* inp_ptr(const float* const __attribute__((address_space(4)))* inp, int i) { GAS const float* q = (GAS const float*)inp[i]; asm volatile("" : "+s"(q)); return (const float*)q; }
#define INP(i) inp_ptr(F.inp, (i))
#define WSP(T, off) ((T*)(GAS T*)(F.ws + (off)))
enum { I_X = 0, I_META, I_NORM_MIX, I_W_IN, I_LB, I_HGRN_NORM, I_GDN_CONV, I_GDN_ALOG, I_GDN_DT, I_GDN_NORM, I_GLA_W2, I_GLA_B, I_GLA_NORM, I_W_BRANCH, I_W_OUT, I_NORM_FFN,
       I_RG_W, I_RG_B, I_RE_W, I_RE_B, I_EW_GATE, I_EW_UP, I_EW_DOWN, I_NORM_FINAL };

__device__ __forceinline__ void transpose_item(const float* W, int ldw, int K, int nblk, bf16_t* WT, int row_off, int rowmode, LAS float* scr, int item, int lane) {
    const int kb = item / nblk, nb = item % nblk, k0 = 64 * kb, n0 = 32 * nb;
    { f32x4 v[8]; const int n4 = 4 * (lane & 7);
#pragma unroll
        for (int i = 0; i < 8; ++i) v[i] = *(const f32x4*)(W + (size_t)(k0 + 8 * i + (lane >> 3)) * ldw + n0 + n4);
#pragma unroll
        for (int i = 0; i < 8; ++i) { LAS float* d = scr + (8 * i + (lane >> 3)) * 33 + n4; d[0] = v[i][0]; d[1] = v[i][1]; d[2] = v[i][2]; d[3] = v[i][3]; } }
    LDS_WAIT(); asm volatile("" ::: "memory");
    const int c = lane & 7;
#pragma unroll
    for (int j = 0; j < 4; ++j) { const int n = (lane >> 3) + 8 * j; const LAS float* s = scr + (8 * c) * 33 + n;
        u32x4 o; o.x = pk2(s[0 * 33], s[1 * 33]); o.y = pk2(s[2 * 33], s[3 * 33]); o.z = pk2(s[4 * 33], s[5 * 33]); o.w = pk2(s[6 * 33], s[7 * 33]);
        const int nn = n0 + n; const int wrow = rowmode == 0 ? row_off + nn : row_off + 8 * (nn >> 2) + (nn & 3) + (rowmode == 2 ? 4 : 0);
        *(u32x4*)(WT + (size_t)wrow * K + k0 + 8 * c) = o; }
    LDS_WAIT(); asm volatile("" ::: "memory");
}

__device__ __forceinline__ void phase_pre(Frame& F) {
    const int gt = F.bid * NTHREADS + F.tid, NT = F.G * NTHREADS;
    float* sw1 = WSP(float, SM_SW1); float* rwg = WSP(float, SM_RWG); float* rwe = WSP(float, SM_RWE); float* lab = WSP(float, SM_LAB);
    for (int i = gt; i < 2 * 24 * 1024; i += NT) { const int l = i / (24 * 1024), c = (i / 1024) % 24, k = i % 1024;
        const int col = c < 16 ? 5128 + c : (c < 20 ? 3584 + (c - 16) : 3588 + (c - 20));
        sw1[i] = INP(I_W_IN)[((size_t)l * 1024 + k) * IN_COLS + col]; }
    for (int i = gt; i < 2 * 4 * 1024; i += NT) { const int l = i / (4 * 1024), c = (i / 1024) % 4, k = i % 1024; rwg[i] = INP(I_RG_W)[((size_t)l * 1024 + k) * 4 + c]; }
    for (int i = gt; i < 2 * 32 * 1024; i += NT) { const int l = i / (32 * 1024), c = (i / 1024) % 32, k = i % 1024; rwe[i] = INP(I_RE_W)[((size_t)l * 1024 + k) * 32 + c]; }
    for (int i = gt; i < 2 * 512; i += NT) { const int l = i / 512, c = i % 512; const float l0 = INP(I_LB)[c], l1 = INP(I_LB)[512 + c];
        const float p1 = 1.0f / (1.0f + expf(l0 - l1)); const float lb = l == 0 ? 0.f : p1;
        lab[l * 1024 + c] = lb; lab[l * 1024 + 512 + c] = 1.0f - lb; }
}

__device__ __forceinline__ void convert_layer_weights(Frame& F, int l) {
    LAS float* scr = (LAS float*)(F.lds + F.wave * 16384);
    const int gw = F.bid * NWAVES + F.wave, NGW = F.G * NWAVES;
    const float* win = INP(I_W_IN) + (size_t)l * 1024 * IN_COLS;
    constexpr int I_MIX = 16 * 176, I_GATE = 16 * 96, I_BR = 8 * 32, I_OUT = 16 * 32, NITEMS = I_MIX + I_GATE + 3 * I_BR + I_OUT;
    for (int it = gw; it < NITEMS; it += NGW) {
        int r = it;
        if (r < I_MIX) { const int nb = r % 176, n0 = 32 * nb; const int shift = n0 < 3584 ? 0 : (n0 < 5120 ? 8 : 24);
            transpose_item(win + shift, IN_COLS, 1024, 176, WSP(bf16_t, WS_WMIX), 0, 0, scr, r, F.lane); continue; } r -= I_MIX;
        if (r < I_GATE) { transpose_item(win + 5656, IN_COLS, 1024, 96, WSP(bf16_t, WS_WGATE), 0, 0, scr, r, F.lane); continue; } r -= I_GATE;
        if (r < 3 * I_BR) { const int n = r / I_BR; transpose_item(INP(I_W_BRANCH) + ((size_t)l * 3 + n) * 512 * 1024, 1024, 512, 32, WSP(bf16_t, WS_WBT) + (size_t)n * 1024 * 512, 0, 0, scr, r % I_BR, F.lane); continue; } r -= 3 * I_BR;
        transpose_item(INP(I_W_OUT) + (size_t)l * 1024 * 1024, 1024, 1024, 32, WSP(bf16_t, WS_WOT), 0, 0, scr, r, F.lane);
    }
}
__device__ __forceinline__ void convert_expert_weights(Frame& F, int l) {
    LAS float* scr = (LAS float*)(F.lds + F.wave * 16384);
    const int gw = F.bid * NWAVES + F.wave, NGW = F.G * NWAVES;
    constexpr int I_G = 16 * 8, I_D = 4 * 32, PER = 2 * I_G + I_D;
    for (int it = gw; it < 32 * PER; it += NGW) {
        const int e = it / PER; int r = it % PER;
        bf16_t* w1t = WSP(bf16_t, WS_W1T) + (size_t)e * 512 * 1024; bf16_t* w2t = WSP(bf16_t, WS_W2T) + (size_t)e * 1024 * 256;
        if (r < I_G) { transpose_item(INP(I_EW_GATE) + ((size_t)l * 32 + e) * 1024 * 256, 256, 1024, 8, w1t, 0, 1, scr, r, F.lane); continue; } r -= I_G;
        if (r < I_G) { transpose_item(INP(I_EW_UP) + ((size_t)l * 32 + e) * 1024 * 256, 256, 1024, 8, w1t, 0, 2, scr, r, F.lane); continue; } r -= I_G;
        transpose_item(INP(I_EW_DOWN) + ((size_t)l * 32 + e) * 256 * 1024, 1024, 256, 32, w2t, 0, 0, scr, r, F.lane);
    }
}

#define OUTP ((float*)F.out)
__device__ __forceinline__ float* hrow(Frame& F, int r) { return r < NREAL ? OUTP + (size_t)r * D : WSP(float, WS_HMETA) + (size_t)(r - NREAL) * D; }

__device__ __forceinline__ void load_row16(const float* p, int lane, float (&x)[16]) {
#pragma unroll
    for (int j = 0; j < 4; ++j) { const f32x4 v = *((const f32x4*)p + lane + 64 * j); x[4 * j] = v[0]; x[4 * j + 1] = v[1]; x[4 * j + 2] = v[2]; x[4 * j + 3] = v[3]; }
}
__device__ __forceinline__ void add_bf16_row16(const bf16_t* p, int lane, float (&x)[16]) {
#pragma unroll
    for (int j = 0; j < 4; ++j) { const u32x2 w = *((const u32x2*)p + lane + 64 * j); x[4 * j] += bflo(w.x); x[4 * j + 1] += bfhi(w.x); x[4 * j + 2] += bflo(w.y); x[4 * j + 3] += bfhi(w.y); }
}
__device__ __forceinline__ void store_row16(float* p, int lane, const float (&x)[16]) {
#pragma unroll
    for (int j = 0; j < 4; ++j) *((f32x4*)p + lane + 64 * j) = (f32x4){x[4 * j], x[4 * j + 1], x[4 * j + 2], x[4 * j + 3]};
}
__device__ __forceinline__ void store_bf16_row16(bf16_t* p, int lane, const float (&x)[16]) {
#pragma unroll
    for (int j = 0; j < 4; ++j) { u32x2 w; w.x = pk2(x[4 * j], x[4 * j + 1]); w.y = pk2(x[4 * j + 2], x[4 * j + 3]); *((u32x2*)p + lane + 64 * j) = w; }
}
__device__ __forceinline__ void fetch_h_row(Frame& F, int l, int r, float (&x)[16]) {
    if (l == 0) {
        const float* src = r < NREAL ? INP(I_X) + (size_t)r * D : INP(I_META) + (size_t)(r - META_ROW0) * D;
        load_row16(src, F.lane, x);
    } else {
        load_row16(hrow(F, r), F.lane, x);
        const unsigned* tok = WSP(unsigned, SM_TOK) + (size_t)r * 8;
        const unsigned g0 = tok[6], g1 = tok[7];
        add_bf16_row16(WSP(bf16_t, WS_Y2) + (size_t)g0 * 1024, F.lane, x);
        add_bf16_row16(WSP(bf16_t, WS_Y2) + (size_t)g1 * 1024, F.lane, x);
    }
}

__device__ __forceinline__ void phase_norm1(Frame& F, int l) {
    convert_layer_weights(F, l);
    __syncthreads();
    LAS float* sw = (LAS float*)F.lds;
    { const float* src = WSP(float, SM_SW1) + (size_t)l * 24 * 1024; for (int i = F.tid; i < 24 * 1024 / 4; i += NTHREADS) ((LAS f32x4*)sw)[i] = ((const f32x4*)src)[i]; }
    __syncthreads();
    const int gw = F.bid * NWAVES + F.wave, NGW = F.G * NWAVES, lane = F.lane;
    const float* nw = INP(I_NORM_MIX) + (size_t)l * D;
    float wv[16]; load_row16(nw, lane, wv);
    bf16_t* U = WSP(bf16_t, WS_U);
    const float alog_l = (lane >= 20 && lane < 24) ? INP(I_GDN_ALOG)[l * 4 + (lane - 20)] : 0.f, dt_l = (lane >= 20 && lane < 24) ? INP(I_GDN_DT)[l * 4 + (lane - 20)] : 0.f;
    const float nega_l = -expf(alog_l);
    for (int g = gw; g < MROWS / 4; g += NGW) {
        const int r0 = 4 * g;
        if (!row_valid(r0)) {
            float z[16];
#pragma unroll
            for (int j = 0; j < 16; ++j) z[j] = 0.f;
#pragma unroll
            for (int i = 0; i < 4; ++i) { store_bf16_row16(U + (size_t)(r0 + i) * D, lane, z); if (l == 0) store_row16(hrow(F, r0 + i), lane, z);
                if (lane < 16) WSP(float, SM_GK)[(size_t)(r0 + i) * 16 + lane] = 0.f;
                else if (lane < 20) WSP(float, SM_BETA)[(size_t)(r0 + i) * 4 + (lane - 16)] = 0.f;
                else if (lane < 24) WSP(float, SM_LOGA)[(size_t)(r0 + i) * 4 + (lane - 20)] = 0.f; }
            continue;
        }
        float x[4][16];
#pragma unroll
        for (int i = 0; i < 4; ++i) {
            fetch_h_row(F, l, r0 + i, x[i]);
            store_row16(hrow(F, r0 + i), lane, x[i]);
            float ss = 0.f;
#pragma unroll
            for (int j = 0; j < 16; ++j) ss += x[i][j] * x[i][j];
            const float rstd = rsqrtf(wave_sum(ss) * (1.0f / D) + 1e-6f);
#pragma unroll
            for (int j = 0; j < 16; ++j) x[i][j] = x[i][j] * rstd * wv[j];
            store_bf16_row16(U + (size_t)(r0 + i) * D, lane, x[i]);
        }
        float ov[4] = {0.f, 0.f, 0.f, 0.f};
#pragma unroll 2
        for (int c = 0; c < 24; ++c) {
            float a0 = 0.f, a1 = 0.f, a2 = 0.f, a3 = 0.f;
#pragma unroll
            for (int j = 0; j < 4; ++j) { const f32x4 w = *((const LAS f32x4*)(sw + c * 1024) + lane + 64 * j);
#pragma unroll
                for (int e = 0; e < 4; ++e) { a0 += x[0][4 * j + e] * w[e]; a1 += x[1][4 * j + e] * w[e]; a2 += x[2][4 * j + e] * w[e]; a3 += x[3][4 * j + e] * w[e]; } }
            a0 = wave_sum(a0); a1 = wave_sum(a1); a2 = wave_sum(a2); a3 = wave_sum(a3);
            if (lane == c) { ov[0] = a0; ov[1] = a1; ov[2] = a2; ov[3] = a3; }
        }
        float* GK = WSP(float, SM_GK); float* BETA = WSP(float, SM_BETA); float* LOGA = WSP(float, SM_LOGA);
#pragma unroll
        for (int i = 0; i < 4; ++i) {
            const float v = ov[i]; const int r = r0 + i;
            if (lane < 16) GK[(size_t)r * 16 + lane] = v;
            else if (lane < 20) BETA[(size_t)r * 4 + (lane - 16)] = sigmoidf_(v);
            else if (lane < 24) { const int h = lane - 20; LOGA[(size_t)r * 4 + h] = nega_l * softplusf_(v + dt_l); }
        }
    }
}

__device__ __forceinline__ bf16x8 mk8(u32x4 w) { return __builtin_bit_cast(bf16x8, w); }
__device__ __forceinline__ bf16x8 mk8(u32x2 lo, u32x2 hi) { u32x4 w; w.x = lo.x; w.y = lo.y; w.z = hi.x; w.w = hi.y; return __builtin_bit_cast(bf16x8, w); }
__device__ __forceinline__ bf16x8 pack_acc2(const f32x4& a, const f32x4& b) { u32x4 w; w.x = pk2(a[0], a[1]); w.y = pk2(a[2], a[3]); w.z = pk2(b[0], b[1]); w.w = pk2(b[2], b[3]); return __builtin_bit_cast(bf16x8, w); }
#define MFMA16(a, b, c) __builtin_amdgcn_mfma_f32_16x16x32_bf16((a), (b), (c), 0, 0, 0)

__device__ __forceinline__ int permpos(int k) { const int kk = k & 31; return (k & ~31) + ((kk & 16) ? 8 * ((kk - 16) >> 2) + 4 + (kk & 3) : 8 * (kk >> 2) + (kk & 3)); }
__device__ __forceinline__ float ldbf(GAS const bf16_t* p) { return bf2f(*p); }
#define ROWB(P, row, col) ((GAS const char*)(P) + ((size_t)(row) * LDP + (col)) * 2)
__device__ __forceinline__ float ldrow(GAS const char* rb, unsigned voff) { return bf2f(*(GAS const bf16_t*)(rb + voff)); }
__device__ __forceinline__ unsigned ldrow_u(GAS const char* rb, unsigned voff) { return (unsigned)*(GAS const bf16_t*)(rb + voff); }
__device__ __forceinline__ void strow(GAS const char* rb, unsigned voff, bf16_t v) { *(GAS bf16_t*)(rb + voff) = v; }

template <int DK, bool IS_A>
__device__ __forceinline__ void prep_gla(Frame& F, int l, int ug) {
    constexpr int QP = DK + 8, SUB = 2 * 64 * QP * 2 + 1024 + (IS_A ? 0 : 4096);
    PROF_MARK(F, IS_A ? 7 : 8);
    int tid = F.tid; asm volatile("" : "+v"(tid));
    const int sg = __builtin_amdgcn_readfirstlane(tid >> 8), lt = tid & 255, c = lt & 127, hf = __builtin_amdgcn_readfirstlane(lt >> 7);
    const int unit = 2 * ug + sg, slot = unit >> 2, h = unit & 3, row0 = slot * 64, r0 = row0 + 32 * hf;
    const int qcol = IS_A ? PC_AQ + h * 128 : PC_CQ + h * 64, kcol = IS_A ? PC_AF + h * 128 : PC_CK + h * 64, vcol = IS_A ? PC_AI + h * 128 : PC_CV + h * 128;
    bf16_t* P = WSP(bf16_t, WS_P);
    LAS bf16_t* qt = (LAS bf16_t*)(F.lds + sg * SUB);
    LAS bf16_t* kt = qt + 64 * QP;
    LAS float* tot = (LAS float*)(kt + 64 * QP);
    const bool act = c < DK;
    if (!IS_A) { LAS float* gkl = tot + 256;
        ((LAS f32x4*)gkl)[lt] = ((const f32x4*)(WSP(float, SM_GK) + (size_t)row0 * 16))[lt];
        __syncthreads(); }
    float b[32];
    const unsigned vo = (unsigned)c * 2u, vop = (unsigned)permpos(c) * 2u;
    if (act) {
        float run = 0.f;
        if (IS_A) { const float* lab = WSP(float, SM_LAB) + l * 1024 + h * 128 + c; const float la = lab[0], lb = lab[512];
#pragma unroll
            for (int t = 0; t < 32; ++t) { run += pg8::lfg(la, lb, ldrow(ROWB(P, r0 + t, kcol), vo)); b[t] = run; }
        } else { float w2c[16]; const float* w2 = INP(I_GLA_W2) + (size_t)l * 16 * 256 + h * 64 + c; const float bias = INP(I_GLA_B)[l * 256 + h * 64 + c];
#pragma unroll
            for (int j = 0; j < 16; ++j) w2c[j] = w2[j * 256];
            const LAS float* gk = tot + 256 + 32 * hf * 16;
#pragma unroll
            for (int t = 0; t < 32; ++t) { float s = bias;
#pragma unroll
                for (int j = 0; j < 16; ++j) s += gk[t * 16 + j] * w2c[j];
                run += logsigf_(s) * (1.0f / 16.0f); b[t] = run; }
        }
        tot[hf * 128 + c] = run;
    }
    __syncthreads();
    PROF_MARKI(F, IS_A ? 25 : 15);
    unsigned q1p[16], k1p[16];
    if (act) {
        const float bm = tot[c], bl = bm + tot[128 + c], boff = hf ? bm : 0.f;
        if (hf == 0 && !F.dry) (IS_A ? WSP(float, SM_DECA) + (size_t)unit * 128 : WSP(float, SM_DECC) + (size_t)unit * 64)[c] = __expf(bl);
#pragma unroll
        for (int t2 = 0; t2 < 16; ++t2) { float q1v[2], k1v[2];
#pragma unroll
            for (int u = 0; u < 2; ++u) { const int t = 2 * t2 + u; const float bt = b[t] + boff;
                const float qr = ldrow(ROWB(P, r0 + t, qcol), vo), q = IS_A ? siluf_(qr) * 0.08838834764831845f : qr * 0.125f;
                float k;
                if (IS_A) { const float lf = t == 0 ? b[0] : b[t] - b[t - 1]; k = row_valid(r0 + t) ? 1.0f - __expf(lf) : 0.f; } else k = ldrow(ROWB(P, r0 + t, kcol), vo);
                q1v[u] = q * __expf(bt); k1v[u] = k * __expf(bl - bt);
                qt[(32 * hf + t) * QP + c] = f2bf(q * __expf(fminf(bt - bm, 80.f))); kt[(32 * hf + t) * QP + c] = f2bf(k * __expf(fminf(bm - bt, 80.f))); }
            q1p[t2] = pk2(q1v[0], q1v[1]); k1p[t2] = pk2(k1v[0], k1v[1]); }
    }
    __syncthreads();
    PROF_MARKI(F, IS_A ? 26 : 16);
    if (act) {
        if (!F.dry) {
#pragma unroll
        for (int t2 = 0; t2 < 16; ++t2) { strow(ROWB(P, r0 + 2 * t2, qcol), vop, (bf16_t)(q1p[t2] & 0xffffu)); strow(ROWB(P, r0 + 2 * t2 + 1, qcol), vop, (bf16_t)(q1p[t2] >> 16)); } }
        bf16_t* kd = (IS_A ? P + (size_t)(row0 + (c >> 1)) * LDP + kcol + (c & 1) * 64 : P + (size_t)(row0 + c) * LDP + kcol) + 32 * hf;
#pragma unroll
        for (int o = 0; o < 4; ++o) if (!F.dry) *(u32x4*)(kd + 8 * o) = (u32x4){k1p[4 * o], k1p[4 * o + 1], k1p[4 * o + 2], k1p[4 * o + 3]};
    }
    { const int ws = (tid >> 6) & 3, lane = tid & 63, fr = lane & 15, fq = lane >> 4;
        bf16_t* sc = (IS_A ? WSP(bf16_t, WS_SCA) : WSP(bf16_t, WS_SCC)) + (size_t)unit * 4096;
#pragma unroll
        for (int jt = 0; jt < 4; ++jt) { const int mt = ws, nt = jt; f32x4 acc = {0.f, 0.f, 0.f, 0.f};
            if (nt <= mt) {
#pragma unroll
                for (int ks = 0; ks < DK / 32; ++ks) { const bf16x8 a = *(const LAS bf16x8*)(qt + (16 * mt + fr) * QP + 32 * ks + 8 * fq), bb = *(const LAS bf16x8*)(kt + (16 * nt + fr) * QP + 32 * ks + 8 * fq); acc = MFMA16(a, bb, acc); } }
#pragma unroll
            for (int r = 0; r < 4; ++r) { const int t = 16 * mt + 4 * fq + r, s = 16 * nt + fr; if (!F.dry) sc[t * 64 + s] = (s <= t) ? f2bf(acc[r]) : (bf16_t)0; } }
    }
    PROF_MARKI(F, IS_A ? 27 : 17);
    { unsigned vp[16];
#pragma unroll
        for (int t2 = 0; t2 < 16; ++t2) { vp[t2] = ldrow_u(ROWB(P, r0 + 2 * t2, vcol), vo) | (ldrow_u(ROWB(P, r0 + 2 * t2 + 1, vcol), vo) << 16); }
        __syncthreads();
        PROF_MARKI(F, IS_A ? 28 : 18);
        bf16_t* vd = P + (size_t)(row0 + (c >> 1)) * LDP + vcol + (c & 1) * 64 + 32 * hf;
#pragma unroll
        for (int o = 0; o < 4; ++o) if (!F.dry) *(u32x4*)(vd + 8 * o) = (u32x4){vp[4 * o], vp[4 * o + 1], vp[4 * o + 2], vp[4 * o + 3]}; }
    __syncthreads();
    PROF_MARK(F, IS_A ? 13 : 14);
}

__device__ __forceinline__ void prep_gdn(Frame& F, int l, int ug) {
    constexpr int NP = 136, SUB = 2 * 64 * NP * 2 + 64 * 68 * 4 + 1024 + 2304;
    PROF_MARK(F, 1);
    int tid = F.tid; asm volatile("" : "+v"(tid));
    const int lane = tid & 63, sg = __builtin_amdgcn_readfirstlane(tid >> 8), lt = tid & 255, unit = 2 * ug + sg, slot = unit >> 2, h = unit & 3, row0 = slot * 64;
    bf16_t* P = WSP(bf16_t, WS_P);
    LAS bf16_t* qs = (LAS bf16_t*)(F.lds + sg * SUB);
    LAS bf16_t* ks = qs + 64 * NP;
    LAS float* AT = (LAS float*)(F.lds + sg * SUB + 2 * 64 * NP * 2);
    LAS float* gs = AT + 64 * 68;
    if (lt < 64) { const int valid_u = 1; (void)valid_u; float g = WSP(float, SM_LOGA)[(size_t)(row0 + lt) * 4 + h];
#pragma unroll
        for (int o = 1; o < 64; o <<= 1) { const float t = __shfl_up(g, o); if (lane >= o) g += t; }
        gs[lt] = g; gs[64 + lt] = WSP(float, SM_BETA)[(size_t)(row0 + lt) * 4 + h];
        if (lt == 63 && !F.dry) WSP(float, SM_DECB)[unit] = __expf(g); }
    const int hslot = slot == 256 ? -1 : ((slot & 63) == 0 ? 256 : slot - 1);
    LAS bf16_t* rvs = (LAS bf16_t*)AT;
    LAS bf16_t* hl = (LAS bf16_t*)(gs + 256);
    for (int idx = lt; idx < 64 * 48; idx += 256) { const int row = idx / 48, pc = idx % 48, comp = pc >> 4, c8 = (pc & 15) * 8;
        const u32x4 v = *(const u32x4*)(P + (size_t)(row0 + row) * LDP + PC_BQKV + comp * 512 + h * 128 + c8);
        *(LAS u32x4*)((comp == 0 ? qs : (comp == 1 ? ks : rvs)) + row * NP + c8) = v; }
    if (lt < 144) { const int rr = lt / 48, pc = lt % 48, comp = pc >> 4, c8 = (pc & 15) * 8; u32x4 v = {0u, 0u, 0u, 0u};
        if (hslot >= 0) v = *(const u32x4*)(WSP(bf16_t, SM_HALO) + ((size_t)hslot * 3 + rr) * 1536 + comp * 512 + h * 128 + c8);
        *(LAS u32x4*)(hl + rr * 384 + comp * 128 + c8) = v; }
    __syncthreads();
    PROF_MARKG(F, 2);
    float col[64];
    {
        const int c = lt & 127;
#pragma unroll
        for (int pass = 0; pass < 2; ++pass) {
            if (pass == 1 && lt >= 128) break;
            const int comp = lt >= 128 ? 1 : (pass == 0 ? 0 : 2), ch = comp * 512 + h * 128 + c;
            const float w0 = INP(I_GDN_CONV)[((size_t)l * 4 + 0) * 1536 + ch], w1 = INP(I_GDN_CONV)[((size_t)l * 4 + 1) * 1536 + ch], w2 = INP(I_GDN_CONV)[((size_t)l * 4 + 2) * 1536 + ch], w3 = INP(I_GDN_CONV)[((size_t)l * 4 + 3) * 1536 + ch];
            LAS bf16_t* src = (comp == 0 ? qs : (comp == 1 ? ks : rvs)) + c;
            float x0 = bf2f(hl[comp * 128 + c]), x1 = bf2f(hl[384 + comp * 128 + c]), x2 = bf2f(hl[768 + comp * 128 + c]);
#pragma unroll
            for (int t = 0; t < 64; ++t) { const float x3 = bf2f(src[t * NP]); const float y = siluf_(w0 * x0 + w1 * x1 + w2 * x2 + w3 * x3); x0 = x1; x1 = x2; x2 = x3;
                if (comp == 0) src[t * NP] = f2bf(y); else { col[t] = y; if (comp == 1) src[t * NP] = f2bf(y); } }
        }
    }
    __syncthreads();
    PROF_MARKG(F, 3);
    const int wv = (tid >> 6) & 3, fr = lane & 15, fq = lane >> 4;
#pragma unroll
    for (int jt = 0; jt < 2; ++jt) { const int which = jt, mt = wv; const LAS bf16_t* ap = which ? qs : ks; f32x4 a4 = {0.f, 0.f, 0.f, 0.f};
#pragma unroll
        for (int k4 = 0; k4 < 4; ++k4) { const bf16x8 a = *(const LAS bf16x8*)(ap + (16 * mt + fr) * NP + 32 * k4 + 8 * fq); a4 = MFMA16(a, a, a4); }
#pragma unroll
        for (int r = 0; r < 4; ++r) if (4 * fq + r == fr) { if (which == 0) gs[128 + 16 * mt + fr] = rsqrtf(a4[r] + 1e-6f); else gs[192 + 16 * mt + fr] = rsqrtf(a4[r] + 1e-6f) * 0.08838834764831845f; } }
    __syncthreads();
    { bf16_t* qkd = WSP(bf16_t, WS_QKD) + (size_t)unit * 4096;
#pragma unroll
        for (int jt = 0; jt < 8; ++jt) { const int tile = wv * 8 + jt, which = tile >> 4, mt = (tile >> 2) & 3, nt = tile & 3;
            const LAS bf16_t* ap = which ? qs : ks; f32x4 a4 = {0.f, 0.f, 0.f, 0.f};
            if (nt <= mt) {
#pragma unroll
                for (int k4 = 0; k4 < 4; ++k4) { const bf16x8 a = *(const LAS bf16x8*)(ap + (16 * mt + fr) * NP + 32 * k4 + 8 * fq), bb = *(const LAS bf16x8*)(ks + (16 * nt + fr) * NP + 32 * k4 + 8 * fq); a4 = MFMA16(a, bb, a4); } }
#pragma unroll
            for (int r = 0; r < 4; ++r) { const int t = 16 * mt + 4 * fq + r, s = 16 * nt + fr; const float dec = __expf(fminf(gs[t] - gs[s], 0.f)) * gs[128 + s];
                if (which) { if (!F.dry) qkd[t * 64 + permpos(s)] = (s <= t) ? f2bf(a4[r] * dec * gs[192 + t]) : (bf16_t)0; }
                else AT[s * 68 + t] = (s < t) ? gs[64 + t] * gs[128 + t] * a4[r] * dec : 0.f; } }
    }
    PROF_MARKG(F, 4);
    if (lt >= 128) { const int d = lt - 128; const float gl = gs[63]; bf16_t* dst = WSP(bf16_t, WS_K1TB) + (size_t)unit * 8192 + d * 64;
#pragma unroll
        for (int o = 0; o < 8; ++o) { const int s0 = 32 * (o >> 2) + 4 * (o & 3); float y[8];
#pragma unroll
            for (int j = 0; j < 8; ++j) { const int s = s0 + (j & 3) + (j >> 2) * 16; y[j] = col[s] * gs[128 + s] * __expf(gl - gs[s]); }
            if (!F.dry) *(u32x4*)(dst + 8 * o) = (u32x4){pk2(y[0], y[1]), pk2(y[2], y[3]), pk2(y[4], y[5]), pk2(y[6], y[7])}; }
    } else { const int pp = permpos(lt);
#pragma unroll 8
        for (int t = 0; t < 64; ++t) if (!F.dry) P[(size_t)(row0 + t) * LDP + PC_BQKV + h * 128 + pp] = f2bf(bf2f(qs[t * NP + lt]) * gs[192 + t] * __expf(gs[t])); }
    __syncthreads();
    PROF_MARKG(F, 5);
#pragma unroll
    for (int i = 0; i < 64; ++i) col[i] *= lt < 128 ? gs[64 + i] : gs[64 + i] * gs[128 + i] * __expf(gs[i]);
#pragma unroll
    for (int j = 0; j < 63; ++j) { const float xj = col[j]; asm volatile("" ::: "memory");
#pragma unroll
        for (int q4 = (j + 1) >> 2; q4 < 16; ++q4) { const f32x4 a = *(const LAS f32x4*)(AT + j * 68 + 4 * q4);
#pragma unroll
            for (int e = 0; e < 4; ++e) if (4 * q4 + e > j) col[4 * q4 + e] -= a[e] * xj; } }
    PROF_MARKG(F, 6);
    int tid2 = F.tid; asm volatile("" : "+v"(tid2)); const int lt2 = tid2 & 255, unit2 = 2 * ug + __builtin_amdgcn_readfirstlane(tid2 >> 8), row02 = (unit2 >> 2) * 64, h2 = unit2 & 3;
    if (lt2 < 128) { bf16_t* dst = P + (size_t)(row02 + (lt2 >> 1)) * LDP + PC_BQKV + 1024 + h2 * 128 + (lt2 & 1) * 64;
#pragma unroll
        for (int o = 0; o < 8; ++o) if (!F.dry) *(u32x4*)(dst + 8 * o) = (u32x4){pk2(col[8 * o], col[8 * o + 1]), pk2(col[8 * o + 2], col[8 * o + 3]), pk2(col[8 * o + 4], col[8 * o + 5]), pk2(col[8 * o + 6], col[8 * o + 7])};
    } else { const int pp = permpos(lt2 - 128);
        if (!F.dry) {
#pragma unroll
        for (int t = 0; t < 64; ++t) strow(ROWB(P, row02 + t, PC_BQKV + 512 + h2 * 128), (unsigned)pp * 2u, f2bf(col[t])); } }
    __syncthreads();
    PROF_MARK(F, 9);
}

__device__ __forceinline__ void prep_set(Frame& F, int l, int set, int nblk, int bidx) {
    const int nsl = set == 0 ? 65 : 64, np = 2 * nsl;
    auto ug_of = [&](int vp) { int j = vp >> 1, slot; if (set == 0) { slot = j == 0 ? 256 : ((j - 1) >> 4) * 64 + ((j - 1) & 15); } else slot = (j >> 4) * 64 + 16 * set + (j & 15); return 2 * slot + (vp & 1); };
    auto first_of = [&](int base) { int r = (bidx - base) % nblk; if (r < 0) r += nblk; return base + r; };
    if (nblk < 2 * np) {
        if (bidx < np) { prep_gdn(F, l, ug_of(bidx)); prep_gla<64, false>(F, l, ug_of(bidx)); }
        else { const int nr = nblk - np; for (int i = bidx - np; i < np; i += nr) prep_gla<128, true>(F, l, ug_of(i)); }
        return; }
    for (int i = first_of(0); i < np; i += nblk) prep_gdn(F, l, ug_of(i));
    for (int i = first_of(np); i < 2 * np; i += nblk) prep_gla<128, true>(F, l, ug_of(i - np));
    for (int i = first_of(2 * np); i < 3 * np; i += nblk) prep_gla<64, false>(F, l, ug_of(i - 2 * np));
}
constexpr int SCAN_BUF = 57344;
template <int MX> struct ScanCfg;
template <> struct ScanCfg<0> { static constexpr int NM = 3, NI = 5; static constexpr int off(int m) { return m == 0 ? 0 : (m == 1 ? 16384 : 32768); } static constexpr int pitch(int m) { return m == 0 ? 256 : 128; } };
template <> struct ScanCfg<1> { static constexpr int NM = 4, NI = 7; static constexpr int off(int m) { return 16384 * m; } static constexpr int pitch(int m) { return m < 2 ? 256 : 128; } };
template <> struct ScanCfg<2> { static constexpr int NM = 3, NI = 3; static constexpr int off(int m) { return 8192 * m; } static constexpr int pitch(int m) { return 128; } };

#define SCAN_GRID_BARRIER() do { xcd_barrier(WSP(unsigned, WS_CTL) + CW_BAR, xb_xcc_id(), (volatile LAS unsigned*)(F.lds + LDS_MISC) + 8, F.tid, (unsigned)F.G); asm volatile("" ::: "memory"); } while (0)
template <int MX>
__device__ __forceinline__ void scan_mixer(Frame& F, int b, int h) {
    typedef ScanCfg<MX> C;
    constexpr int DK = MX == 2 ? 64 : 128, NT = DK / 16, NI = C::NI;
    const int w = F.wave, lane = F.lane, fr = lane & 15, fq = lane >> 4, ecol = 16 * w + fr;
    const char* Pb = (const char*)WSP(bf16_t, WS_P);
    const int qcol = MX == 0 ? PC_AQ + h * 128 : (MX == 1 ? PC_BQKV + h * 128 : PC_CQ + h * 64);
    const int kcol = MX == 0 ? PC_AF + h * 128 : (MX == 1 ? PC_BQKV + 512 + h * 128 : PC_CK + h * 64);
    const int vcol = MX == 0 ? PC_AI + h * 128 : (MX == 1 ? PC_BQKV + 1024 + h * 128 : PC_CV + h * 128);
    const char* SCb = (const char*)(MX == 0 ? WSP(bf16_t, WS_SCA) : (MX == 1 ? WSP(bf16_t, WS_QKD) : WSP(bf16_t, WS_SCC)));
    bf16_t* O = WSP(bf16_t, WS_O) + (size_t)MX * MROWS * 512;
    unsigned voff[NI]; int mi[NI];
#pragma unroll
    for (int i = 0; i < NI; ++i) { const int n = w + 8 * i, o = 1024 * n + 16 * lane; int m = 0;
#pragma unroll
        for (int q = 1; q < C::NM; ++q) if (o >= C::off(q)) m = q;
        int ro = o, pitch = 128;
#pragma unroll
        for (int q = 0; q < C::NM; ++q) if (m == q) { ro = o - C::off(q); pitch = C::pitch(q); }
        const int r = ro / pitch, pos = (ro % pitch) >> 4, pc = pos ^ (pitch == 256 ? (r & 15) : ((r >> 1) & 7));
        const bool packed = (MX == 0 && m == 1);
        const bool inP = (MX == 1) ? (m < 2) : (m < 2);
        voff[i] = (unsigned)(inP ? (packed ? (r >> 1) * (LDP * 2) + (r & 1) * 128 : r * (LDP * 2)) : r * pitch) + 16u * pc; mi[i] = m; }
    const unsigned x256_0 = (unsigned)(((0 | fq) ^ fr) << 4), x256_1 = (unsigned)(((4 | fq) ^ fr) << 4), x256_2 = (unsigned)(((8 | fq) ^ fr) << 4), x256_3 = (unsigned)(((12 | fq) ^ fr) << 4);
    const unsigned x128_0 = (unsigned)(((0 | fq) ^ ((fr >> 1) & 7)) << 4), x128_1 = (unsigned)(((4 | fq) ^ ((fr >> 1) & 7)) << 4);
    const unsigned x256[4] = {x256_0, x256_1, x256_2, x256_3}, x128[2] = {x128_0, x128_1};
#define SC_FRAG(buf, m, rt, kp) (*(const LAS bf16x8*)(F.lds + (buf) + C::off(m) + (16 * (rt) + fr) * C::pitch(m) + (C::pitch(m) == 256 ? x256[kp] : x128[(kp) & 1])))
    auto slot_of = [&](int step) { return step == 0 ? 256 : b * 64 + step - 1; };
    auto issue = [&](int step, int buf) {
        const int slot = slot_of(step), row0 = slot * 64, unit = slot * 4 + h;
        const char* base[4];
        if (MX == 1) { base[0] = Pb + ((size_t)row0 * LDP + kcol) * 2; base[1] = Pb + ((size_t)row0 * LDP + qcol) * 2; base[2] = (const char*)WSP(bf16_t, WS_K1TB) + (size_t)unit * 16384; base[3] = SCb + (size_t)unit * 8192; }
        else { base[0] = Pb + ((size_t)row0 * LDP + qcol) * 2; base[1] = Pb + ((size_t)row0 * LDP + kcol) * 2; base[2] = SCb + (size_t)unit * 8192; base[3] = base[2]; }
#pragma unroll
        for (int i = 0; i < NI; ++i) { const char* bs = mi[i] == 0 ? base[0] : (mi[i] == 1 ? base[1] : (mi[i] == 2 ? base[2] : base[3]));
            __builtin_amdgcn_global_load_lds((const unsigned*)(bs + voff[i]), (LAS unsigned*)(F.lds + buf + 1024 * (w + 8 * i)), 16, 0, 0); }
    };
    auto load_priv = [&](int step, u32x4 (&pv)[2]) {
        const int row0 = slot_of(step) * 64;
        const bf16_t* vt = (const bf16_t*)Pb + (size_t)(row0 + (ecol >> 1)) * LDP + vcol + (ecol & 1) * 64;
        if (MX == 1) { const u32x2 a = *(const u32x2*)(vt + 4 * fq), c = *(const u32x2*)(vt + 16 + 4 * fq), d = *(const u32x2*)(vt + 32 + 4 * fq), e = *(const u32x2*)(vt + 48 + 4 * fq);
            pv[0] = (u32x4){a.x, a.y, c.x, c.y}; pv[1] = (u32x4){d.x, d.y, e.x, e.y}; }
        else { pv[0] = *(const u32x4*)(vt + 8 * fq); pv[1] = *(const u32x4*)(vt + 32 + 8 * fq); }
    };
    f32x4 S[NT];
#pragma unroll
    for (int i = 0; i < NT; ++i) S[i] = (f32x4){0.f, 0.f, 0.f, 0.f};
    u32x4 pcur[2], pnxt[2];
    auto first_of_set = [](int s) { return s == 17 || s == 33 || s == 49; };
    issue(0, 0); load_priv(0, pcur);
    for (int step = 0; step < 65; ++step) {
        const int buf = (step & 1) * SCAN_BUF, slot = slot_of(step), row0 = slot * 64, unit = slot * 4 + h;
        if (first_of_set(step)) { PROF_MARK(F, 20); SCAN_GRID_BARRIER(); PROF_MARK(F, 21); issue(step, buf); load_priv(step, pcur); }
        asm volatile("s_waitcnt vmcnt(0)" ::: "memory");
        __syncthreads();
        if (step + 1 < 65 && !first_of_set(step + 1)) { issue(step + 1, SCAN_BUF - buf); load_priv(step + 1, pnxt); }
        bf16x8 Sb[NT / 2];
#pragma unroll
        for (int kp = 0; kp < NT / 2; ++kp) Sb[kp] = pack_acc2(S[2 * kp], S[2 * kp + 1]);
        if (MX == 1) {
            f32x4 vn[4];
#pragma unroll
            for (int mt = 0; mt < 4; ++mt) { f32x4 acc = {0.f, 0.f, 0.f, 0.f};
#pragma unroll
                for (int kp = 0; kp < 4; ++kp) acc = MFMA16(SC_FRAG(buf, 0, mt, kp), Sb[kp], acc);
                const unsigned u0 = mt == 0 ? pcur[0].x : (mt == 1 ? pcur[0].z : (mt == 2 ? pcur[1].x : pcur[1].z)), u1 = mt == 0 ? pcur[0].y : (mt == 1 ? pcur[0].w : (mt == 2 ? pcur[1].y : pcur[1].w));
                vn[mt] = (f32x4){bflo(u0) - acc[0], bfhi(u0) - acc[1], bflo(u1) - acc[2], bfhi(u1) - acc[3]}; }
            bf16x8 Vb[2]; Vb[0] = pack_acc2(vn[0], vn[1]); Vb[1] = pack_acc2(vn[2], vn[3]);
#pragma unroll
            for (int mt = 0; mt < 4; ++mt) { f32x4 acc = {0.f, 0.f, 0.f, 0.f};
#pragma unroll
                for (int kp = 0; kp < 4; ++kp) acc = MFMA16(SC_FRAG(buf, 1, mt, kp), Sb[kp], acc);
#pragma unroll
                for (int kp = 0; kp < 2; ++kp) acc = MFMA16(SC_FRAG(buf, 3, mt, kp), Vb[kp], acc);
#pragma unroll
                for (int r = 0; r < 4; ++r) O[(size_t)(row0 + 16 * mt + 4 * fq + r) * 512 + h * 128 + ecol] = f2bf(acc[r]); }
            const float a = WSP(float, SM_DECB)[unit];
#pragma unroll
            for (int i = 0; i < 8; ++i) { S[i] = S[i] * a;
#pragma unroll
                for (int kp = 0; kp < 2; ++kp) S[i] = MFMA16(SC_FRAG(buf, 2, i, kp), Vb[kp], S[i]); }
        } else {
            const bf16x8 bv0 = mk8(pcur[0]), bv1 = mk8(pcur[1]);
#pragma unroll
            for (int mt = 0; mt < 4; ++mt) { f32x4 acc = {0.f, 0.f, 0.f, 0.f};
#pragma unroll
                for (int kp = 0; kp < NT / 2; ++kp) acc = MFMA16(SC_FRAG(buf, 0, mt, kp), Sb[kp], acc);
                acc = MFMA16(SC_FRAG(buf, 2, mt, 0), bv0, acc); acc = MFMA16(SC_FRAG(buf, 2, mt, 1), bv1, acc);
#pragma unroll
                for (int r = 0; r < 4; ++r) O[(size_t)(row0 + 16 * mt + 4 * fq + r) * 512 + h * 128 + ecol] = f2bf(acc[r]); }
            const float* dec = (MX == 0 ? WSP(float, SM_DECA) : WSP(float, SM_DECC)) + (size_t)unit * DK;
#pragma unroll
            for (int i = 0; i < NT; ++i) { const f32x4 d4 = *(const f32x4*)(dec + 16 * i + 4 * fq); S[i] = S[i] * d4;
                S[i] = MFMA16(SC_FRAG(buf, 1, i, 0), bv0, S[i]); S[i] = MFMA16(SC_FRAG(buf, 1, i, 1), bv1, S[i]); }
        }
        pcur[0] = pnxt[0]; pcur[1] = pnxt[1];
    }
#undef SC_FRAG
    asm volatile("s_waitcnt vmcnt(0)" ::: "memory");
    __syncthreads();
    PROF_MARK(F, 22);
}
__device__ __forceinline__ void phase_scan(Frame& F, int l) {
#if PROF_ON
    if (F.bid >= 48) { for (int k = 1; k < 4; ++k) { PROF_MARK(F, 10); prep_set(F, l, k, F.G - 48, F.bid - 48); PROF_MARK(F, 11); SCAN_GRID_BARRIER(); PROF_MARK(F, 12); } return; }
#else
    if (F.bid >= 48) { for (int k = 1; k < 4; ++k) { prep_set(F, l, k, F.G - 48, F.bid - 48); SCAN_GRID_BARRIER(); } return; }
#endif
    const int mixer = F.bid >> 4, b = (F.bid >> 2) & 3, h = F.bid & 3;
    if (mixer == 0) scan_mixer<0>(F, b, h);
    else if (mixer == 1) scan_mixer<1>(F, b, h);
    else scan_mixer<2>(F, b, h);
}

template <int KIND>
__device__ __forceinline__ void meta_gemm(Frame& F, const bf16_t* A, const bf16_t* Bt, int N, int K, int n) {
    const int gw = F.bid * NWAVES + F.wave, NGW = F.G * NWAVES, lane = F.lane, fr = lane & 15, fq = lane >> 4;
    for (int tile = gw; tile < N / 16; tile += NGW) {
        const bf16_t* ar = A + (size_t)fr * K + 8 * fq; const bf16_t* br = Bt + (size_t)(16 * tile + fr) * K + 8 * fq;
        f32x4 acc = {0.f, 0.f, 0.f, 0.f};
#pragma unroll 8
        for (int ks = 0; ks < K / 32; ++ks) acc = MFMA16(mk8(*(const u32x4*)(ar + 32 * ks)), mk8(*(const u32x4*)(br + 32 * ks)), acc);
#pragma unroll
        for (int r = 0; r < 4; ++r) { const int row = META_ROW0 + 4 * fq + r, col = 16 * tile + fr;
            if (KIND == 0) WSP(bf16_t, WS_GT)[(size_t)row * 3072 + col] = f2bf(sigmoidf_(acc[r]));
            else if (KIND == 1) { bf16_t* mp = WSP(bf16_t, WS_MERGED) + (size_t)row * 1024 + col; const float g = bf2f(WSP(bf16_t, WS_GT)[(size_t)row * 3072 + n * 1024 + col]);
                *mp = f2bf((n ? bf2f(*mp) : 0.f) + g * acc[r]); }
            else { float* hp = WSP(float, WS_HMETA) + (size_t)(row - NREAL) * D + col; *hp = *hp + acc[r]; } }
    }
}

__device__ __forceinline__ void phase_hnorm(Frame& F, int l) {
    const int gw = F.bid * NWAVES + F.wave, NGW = F.G * NWAVES, lane = F.lane;
    const bf16_t* P = WSP(bf16_t, WS_P);
    LAS float* nws = (LAS float*)F.lds;
    if (F.tid < 384) { const int mxw = F.tid >> 7; const float* src = mxw == 0 ? INP(I_HGRN_NORM) : (mxw == 1 ? INP(I_GDN_NORM) : INP(I_GLA_NORM)); nws[F.tid] = src[(size_t)l * 128 + (F.tid & 127)]; }
    __syncthreads();
    for (int r = gw; r < MROWS; r += NGW) {
        bf16_t* op0 = WSP(bf16_t, WS_O) + (size_t)r * 512 + 8 * lane;
        if (!row_valid(r)) { if (!F.dry) {
#pragma unroll
            for (int mx = 0; mx < 3; ++mx) *(u32x4*)(op0 + (size_t)mx * MROWS * 512) = (u32x4){0u, 0u, 0u, 0u}; } continue; }
        u32x4 ow[3], gv[3];
#pragma unroll
        for (int mx = 0; mx < 3; ++mx) { ow[mx] = *(const u32x4*)(op0 + (size_t)mx * MROWS * 512); gv[mx] = *(const u32x4*)(P + (size_t)r * LDP + (mx == 0 ? PC_AG : (mx == 1 ? PC_BG : PC_CG)) + 8 * lane); }
#pragma unroll
        for (int mx = 0; mx < 3; ++mx) {
            const LAS float* nw = nws + mx * 128 + (8 * lane & 127);
            float o[8] = {bflo(ow[mx].x), bfhi(ow[mx].x), bflo(ow[mx].y), bfhi(ow[mx].y), bflo(ow[mx].z), bfhi(ow[mx].z), bflo(ow[mx].w), bfhi(ow[mx].w)};
            const float g[8] = {siluf_(bflo(gv[mx].x)), siluf_(bfhi(gv[mx].x)), siluf_(bflo(gv[mx].y)), siluf_(bfhi(gv[mx].y)), siluf_(bflo(gv[mx].z)), siluf_(bfhi(gv[mx].z)), siluf_(bflo(gv[mx].w)), siluf_(bfhi(gv[mx].w))};
            float ss = 0.f;
#pragma unroll
            for (int j = 0; j < 8; ++j) ss += o[j] * o[j];
            ss += __shfl_xor(ss, 1); ss += __shfl_xor(ss, 2); ss += __shfl_xor(ss, 4); ss += __shfl_xor(ss, 8);
            const float rstd = rsqrtf(ss * (1.0f / 128.0f) + 1e-6f);
            const f32x4 n0 = *(const LAS f32x4*)nw, n1 = *(const LAS f32x4*)(nw + 4);
            const float nv[8] = {n0[0], n0[1], n0[2], n0[3], n1[0], n1[1], n1[2], n1[3]};
#pragma unroll
            for (int j = 0; j < 8; ++j) o[j] = o[j] * rstd * nv[j] * g[j];
            u32x4 y; y.x = pk2(o[0], o[1]); y.y = pk2(o[2], o[3]); y.z = pk2(o[4], o[5]); y.w = pk2(o[6], o[7]);
            if (!F.dry) *(u32x4*)(op0 + (size_t)mx * MROWS * 512) = y;
        }
    }
}

__device__ __forceinline__ void phase_norm2(Frame& F, int l) {
    if (!F.dry) convert_expert_weights(F, l);
    __syncthreads();
    LAS float* sw = (LAS float*)F.lds;
    { const float* src = WSP(float, SM_RWE) + (size_t)l * 32 * 1024; for (int i = F.tid; i < 32 * 1024 / 4; i += NTHREADS) ((LAS f32x4*)sw)[i] = ((const f32x4*)src)[i]; }
    LAS float* rbias = sw + 32 * 1024;
    if (F.tid < 32) rbias[F.tid] = INP(I_RE_B)[l * 32 + F.tid]; else if (F.tid < 36) rbias[F.tid] = INP(I_RG_B)[l * 4 + (F.tid - 32)];
    __syncthreads();
    const int gw = F.bid * NWAVES + F.wave, NGW = F.G * NWAVES, lane = F.lane;
    float wv[16]; load_row16(INP(I_NORM_FFN) + (size_t)l * D, lane, wv);
    bf16_t* U = WSP(bf16_t, WS_U);
    const float* rwg = WSP(float, SM_RWG) + (size_t)l * 4 * 1024;
    unsigned* cnt = WSP(unsigned, WS_CTL) + CW_CNT + l * 64;
    LAS unsigned* lcnt = (LAS unsigned*)(F.lds + LDS_TAB);
    if (F.tid < 64) lcnt[F.tid] = 0u;
    __syncthreads();
    for (int g = gw; g < MROWS / 4; g += NGW) {
        const int r0 = 4 * g;
        if (!row_valid(r0)) continue;
        float x[4][16];
#pragma unroll
        for (int i = 0; i < 4; ++i) {
            load_row16(hrow(F, r0 + i), lane, x[i]);
            float ss = 0.f;
#pragma unroll
            for (int j = 0; j < 16; ++j) ss += x[i][j] * x[i][j];
            const float rstd = rsqrtf(wave_sum(ss) * (1.0f / D) + 1e-6f);
#pragma unroll
            for (int j = 0; j < 16; ++j) x[i][j] = x[i][j] * rstd * wv[j];
            if (!F.dry) store_bf16_row16(U + (size_t)(r0 + i) * D, lane, x[i]);
        }
#ifndef NORM2_SKIP
#define NORM2_SKIP 0
#endif
        if (F.dry && (NORM2_SKIP & 4)) continue;
        float lg[4][4];
#pragma unroll
        for (int c = 0; c < 4; ++c) {
            float a0 = 0.f, a1 = 0.f, a2 = 0.f, a3 = 0.f;
#pragma unroll
            for (int j = 0; j < 4; ++j) { const f32x4 w = *((const f32x4*)(rwg + c * 1024) + lane + 64 * j);
#pragma unroll
                for (int e = 0; e < 4; ++e) { a0 += x[0][4 * j + e] * w[e]; a1 += x[1][4 * j + e] * w[e]; a2 += x[2][4 * j + e] * w[e]; a3 += x[3][4 * j + e] * w[e]; } }
            const float bg = rbias[32 + c];
            lg[0][c] = wave_sum(a0) + bg; lg[1][c] = wave_sum(a1) + bg; lg[2][c] = wave_sum(a2) + bg; lg[3][c] = wave_sum(a3) + bg;
        }
#pragma unroll
        for (int i = 0; i < 4; ++i) {
            int gi = 0; float gm = lg[i][0];
#pragma unroll
            for (int c = 1; c < 4; ++c) if (lg[i][c] > gm) { gm = lg[i][c]; gi = c; }
            float gsum = 0.f;
#pragma unroll
            for (int c = 0; c < 4; ++c) gsum += __expf(lg[i][c] - gm);
            const float gval = 1.0f / gsum;
            gi = __builtin_amdgcn_readfirstlane(gi);
            int ea = 0, eb = 0; float la = -3.0e38f, lb = -3.0e38f;
            const LAS float* swg = sw + gi * 8 * 1024;
#pragma unroll 1
            for (int cb = 0; cb < ((F.dry && (NORM2_SKIP & 2)) ? 0 : 8); cb += 4) {
                float a0 = 0.f, a1 = 0.f, a2 = 0.f, a3 = 0.f;
#pragma unroll
                for (int j = 0; j < 4; ++j) { const f32x4 w0 = *((const LAS f32x4*)(swg + (cb + 0) * 1024) + lane + 64 * j), w1 = *((const LAS f32x4*)(swg + (cb + 1) * 1024) + lane + 64 * j), w2 = *((const LAS f32x4*)(swg + (cb + 2) * 1024) + lane + 64 * j), w3 = *((const LAS f32x4*)(swg + (cb + 3) * 1024) + lane + 64 * j);
#pragma unroll
                    for (int e = 0; e < 4; ++e) { const float xv = x[i][4 * j + e]; a0 += xv * w0[e]; a1 += xv * w1[e]; a2 += xv * w2[e]; a3 += xv * w3[e]; } }
                const float e0 = wave_sum(a0) + rbias[gi * 8 + cb], e1 = wave_sum(a1) + rbias[gi * 8 + cb + 1], e2 = wave_sum(a2) + rbias[gi * 8 + cb + 2], e3 = wave_sum(a3) + rbias[gi * 8 + cb + 3];
                const float ev[4] = {e0, e1, e2, e3};
#pragma unroll
                for (int q = 0; q < 4; ++q) { const float el = ev[q]; const int c = cb + q; if (el > la) { lb = la; eb = ea; la = el; ea = c; } else if (el > lb) { lb = el; eb = c; } }
            }
            const float wa = 1.0f / (1.0f + __expf(lb - la)), wb = 1.0f - wa;
            if (lane == 0 && !F.dry) {
                const unsigned e0 = (unsigned)(gi * 8 + ea), e1 = (unsigned)(gi * 8 + eb);
                const unsigned p0 = __hip_atomic_fetch_add(lcnt + e0, 1u, __ATOMIC_RELAXED, __HIP_MEMORY_SCOPE_WORKGROUP), p1 = __hip_atomic_fetch_add(lcnt + e1, 1u, __ATOMIC_RELAXED, __HIP_MEMORY_SCOPE_WORKGROUP);
                unsigned* tok = WSP(unsigned, SM_TOK) + (size_t)(r0 + i) * 8;
                tok[0] = e0; tok[1] = p0; tok[2] = e1; tok[3] = p1; tok[4] = __float_as_uint(gval * wa); tok[5] = __float_as_uint(gval * wb);
            }
        }
    }
    __syncthreads();
    if (F.tid < 32 && !F.dry) lcnt[32 + F.tid] = atomicAdd(cnt + F.tid, lcnt[F.tid]);
    __syncthreads();
    if (!F.dry) for (int g = gw; g < MROWS / 4; g += NGW) { const int r0 = 4 * g; if (!row_valid(r0)) continue;
        if (lane < 4) { unsigned* tok = WSP(unsigned, SM_TOK) + (size_t)(r0 + lane) * 8; tok[1] += lcnt[32 + tok[0]]; tok[3] += lcnt[32 + tok[2]]; } }
}

__device__ __forceinline__ int moe_tables(Frame& F, int l) {
    LAS int* offs = (LAS int*)(F.lds + LDS_TAB); LAS unsigned char* tab = (LAS unsigned char*)(F.lds + LDS_TAB + 384); LAS int* cn = (LAS int*)(F.lds + LDS_TAB + 192);
    const unsigned* cnt = WSP(unsigned, WS_CTL) + CW_CNT + l * 64;
    __syncthreads();
    if (F.tid < 32) cn[F.tid] = (int)__hip_atomic_load(cnt + F.tid, __ATOMIC_RELAXED, __HIP_MEMORY_SCOPE_AGENT);
    __syncthreads();
    if (F.tid == 0) { int acc = 0;
#pragma unroll 1
        for (int e = 0; e < 32; ++e) { offs[e] = acc; acc += ((cn[e] + 255) >> 8) << 8; }
        offs[32] = acc; }
    __syncthreads();
    if (F.tid < 160) { const int row = F.tid << 8; int e = 0;
#pragma unroll 1
        for (int k = 1; k < 32; ++k) if (offs[k] <= row) e = k;
        tab[F.tid] = (unsigned char)e; }
    __syncthreads();
    return offs[32] >> 8;
}

__device__ __forceinline__ void phase_gather(Frame& F, int l) {
    (void)moe_tables(F, l);
    const LAS int* offs = (const LAS int*)(F.lds + LDS_TAB); const LAS int* cn = (const LAS int*)(F.lds + LDS_TAB + 192);
    const int gw = F.bid * NWAVES + F.wave, NGW = F.G * NWAVES, lane = F.lane;
    const bf16_t* U = WSP(bf16_t, WS_U); bf16_t* XG = WSP(bf16_t, WS_XG); float* wrow = WSP(float, SM_WROW);
    for (int idx = gw; idx < NREAL + 16; idx += 2 * NGW) {
        const int idx2 = idx + NGW; const bool has2 = idx2 < NREAL + 16;
        const int r = idx < NREAL ? idx : META_ROW0 + (idx - NREAL), r2 = has2 ? (idx2 < NREAL ? idx2 : META_ROW0 + (idx2 - NREAL)) : r;
        unsigned* tok = WSP(unsigned, SM_TOK) + (size_t)r * 8; unsigned* tok2 = WSP(unsigned, SM_TOK) + (size_t)r2 * 8;
        const u32x4 ta = *(const u32x4*)tok, tb = *(const u32x4*)tok2; const u32x2 wa = *(const u32x2*)(tok + 4), wb = *(const u32x2*)(tok2 + 4);
        const unsigned g0 = (unsigned)offs[ta.x] + ta.y, g1 = (unsigned)offs[ta.z] + ta.w, h0 = (unsigned)offs[tb.x] + tb.y, h1 = (unsigned)offs[tb.z] + tb.w;
        const u32x4* src = (const u32x4*)(U + (size_t)r * D); const u32x4* src2 = (const u32x4*)(U + (size_t)r2 * D);
        const u32x4 a = src[lane], b = src[lane + 64], c = src2[lane], d = src2[lane + 64];
        if (lane == 0) { tok[6] = g0; tok[7] = g1; wrow[g0] = __uint_as_float(wa.x); wrow[g1] = __uint_as_float(wa.y); }
        u32x4* d0 = (u32x4*)(XG + (size_t)g0 * D); u32x4* d1 = (u32x4*)(XG + (size_t)g1 * D);
        d0[lane] = a; d0[lane + 64] = b; d1[lane] = a; d1[lane + 64] = b;
        if (has2) { if (lane == 0) { tok2[6] = h0; tok2[7] = h1; wrow[h0] = __uint_as_float(wb.x); wrow[h1] = __uint_as_float(wb.y); }
            u32x4* e0 = (u32x4*)(XG + (size_t)h0 * D); u32x4* e1 = (u32x4*)(XG + (size_t)h1 * D);
            e0[lane] = c; e0[lane + 64] = d; e1[lane] = c; e1[lane + 64] = d; }
    }
    u32x4 zz = {0u, 0u, 0u, 0u}; asm volatile("" : "+v"(zz));
    for (int i = gw; i < 32 * 256; i += NGW) { const int e = i >> 8, j = i & 255; const int row = offs[e] + cn[e] + j;
        if (row < offs[e + 1]) { u32x4* d = (u32x4*)(XG + (size_t)row * D); d[lane] = zz; d[lane + 64] = zz; if (lane == 0) wrow[row] = 0.f; } }
}

__device__ __forceinline__ void phase_final(Frame& F) {
    const int gw = F.bid * NWAVES + F.wave, NGW = F.G * NWAVES, lane = F.lane;
    float wv[16]; load_row16(INP(I_NORM_FINAL), lane, wv);
    for (int r = gw; r < NREAL; r += 2 * NGW) {
        const int r2 = r + NGW;
        float x[16], y[16]; fetch_h_row(F, 2, r, x); fetch_h_row(F, 2, r2, y);
        float ss = 0.f, s2 = 0.f;
#pragma unroll
        for (int j = 0; j < 16; ++j) { ss += x[j] * x[j]; s2 += y[j] * y[j]; }
        const float rstd = rsqrtf(wave_sum(ss) * (1.0f / D) + 1e-6f), rstd2 = rsqrtf(wave_sum(s2) * (1.0f / D) + 1e-6f);
#pragma unroll
        for (int j = 0; j < 16; ++j) { x[j] = x[j] * rstd * wv[j]; y[j] = y[j] * rstd2 * wv[j]; }
        store_row16(OUTP + (size_t)r * D, lane, x); store_row16(OUTP + (size_t)r2 * D, lane, y);
    }
}
constexpr int PH_PER_LAYER = 14, N_PHASES = 2 + 2 * PH_PER_LAYER;
#ifndef DBG_STOP
#define DBG_STOP 0
#endif
#ifndef DBG_SRC
#define DBG_SRC WS_P
#define DBG_LD LDP
#endif
#ifndef DBG_TA
#define DBG_TA -1
#endif
#ifndef DBG_TQ
#define DBG_TQ 16.0f
#endif
#ifndef DBG_TB
#define DBG_TB -1
#endif
#ifndef DUP_MASK
#define DUP_MASK 0u
#endif
#define DUPN(j) (((DUP_MASK >> (j)) & 1u) ? 2 : 1)
#ifndef MK_ONE_LAUNCH
#define MK_ONE_LAUNCH 1
#endif

template <unsigned PHMASK_T>
__global__ void __launch_bounds__(NTHREADS, 2) hybrid_fwd(Params p) {
    extern __shared__ __attribute__((aligned(16))) unsigned char lds_raw[];
    Frame F;
    F.lds = (LAS unsigned char*)lds_raw; F.tid = threadIdx.x; F.lane = F.tid & 63; F.wave = __builtin_amdgcn_readfirstlane(F.tid >> 6); F.G = gridDim.x; F.bid = blockIdx.x; F.dry = 0;
    F.out = (GAS float*)p.out; F.ws = (GAS unsigned char*)p.ws; F.inp = (const float* const __attribute__((address_space(4)))*)__builtin_amdgcn_kernarg_segment_ptr();
    volatile LAS unsigned* MISC = (volatile LAS unsigned*)(F.lds + LDS_MISC);
    if (F.tid < 128) MISC[F.tid] = 0u;
    __syncthreads();
#if MK_ONE_LAUNCH
    constexpr int lo = 0, hi = N_PHASES;
#else
    const int lo = p.ph_lo, hi = p.ph_hi;
#endif
    if (hi - lo > 1) (void)xcd_barrier_post(WSP(unsigned, WS_CTL) + CW_BAR, MISC + 8);
#define GRID_BARRIER() xcd_barrier(WSP(unsigned, WS_CTL) + CW_BAR, xb_xcc_id(), (volatile LAS unsigned*)(F.lds + LDS_MISC) + 8, F.tid, (unsigned)F.G)
#define EN(j) ((PHMASK_T >> (j)) & 1u)
#define IN(k) (lo <= (k) && (k) < hi)
    if (DBG_TA >= 0 && F.tid == 0) { MISC[16] = (unsigned)__builtin_amdgcn_s_memrealtime(); MISC[17] = 0u; }
#define SEAM(k) do { if (IN(k) && IN((k) + 1)) GRID_BARRIER(); PHASE_FENCE(F); \
    if (DBG_TA >= 0 && F.tid == 0) { const unsigned t_now = (unsigned)__builtin_amdgcn_s_memrealtime(); const int kk = (k) == 0 ? 15 : (((k) - 1) % PH_PER_LAYER); const int kind = (kk >= 6 && kk <= 8) ? 6 : kk; \
        if (kind == DBG_TA) MISC[17] += t_now - MISC[16]; MISC[16] = t_now; } } while (0)
    PHASE_FENCE(F);
    if (EN(15) && IN(0)) phase_pre(F);
    SEAM(0);
    { constexpr int l = 0;
        const int pb = 1 + PH_PER_LAYER * l;
        for (int rep = 0; rep < (l == 0 ? DUPN(0) : 1); ++rep) { if (rep) { GRID_BARRIER(); PHASE_FENCE(F); } if (EN(0) && IN(pb + 0)) phase_norm1(F, l); }
        SEAM(pb + 0);
        for (int rep = 0; rep < DUPN(1); ++rep) { if (rep) { GRID_BARRIER(); PHASE_FENCE(F); }
        if (EN(1) && IN(pb + 1)) {
            pg8::Gemm g{WSP(bf16_t, WS_U), WSP(bf16_t, WS_WMIX), MROWS, LDP, D}; pg8::StaticOrder S; S.init(MROWS, LDP, F.G, F.bid);
            pg8::EpiInProj E{WSP(bf16_t, WS_P), WSP(bf16_t, SM_HALO)};
            pg8::gemm_phase(F.lds, F.tid, g, S, E);
        } }
        SEAM(pb + 1);
        if (EN(2) && IN(pb + 2)) prep_set(F, l, 0, F.G, F.bid);
        SEAM(pb + 2);
        if (EN(3) && IN(pb + 3)) phase_scan(F, l);
        SEAM(pb + 3);
        for (int rep = 0; rep < DUPN(4); ++rep) { if (rep) { GRID_BARRIER(); PHASE_FENCE(F); F.dry = 1; asm volatile("" : "+s"(F.dry)); } if (EN(4) && IN(pb + 4)) phase_hnorm(F, l); F.dry = 0; }
        SEAM(pb + 4);
        for (int rep = 0; rep < DUPN(5); ++rep) { if (rep) { GRID_BARRIER(); PHASE_FENCE(F); }
        if (EN(5) && IN(pb + 5)) {
            pg8::Gemm g{WSP(bf16_t, WS_U), WSP(bf16_t, WS_WGATE), NREAL, 3072, D}; pg8::StaticOrder S; S.init(NREAL, 3072, F.G, F.bid);
            pg8::EpiSigmoid E{WSP(bf16_t, WS_GT), 3072};
            pg8::gemm_phase(F.lds, F.tid, g, S, E);
            meta_gemm<0>(F, WSP(bf16_t, WS_U) + (size_t)META_ROW0 * D, WSP(bf16_t, WS_WGATE), 3072, D, 0);
        } }
        SEAM(pb + 5);
        for (int n = 0; n < 3; ++n) {
            if (EN(6) && IN(pb + 6 + n)) {
                pg8::Gemm g{WSP(bf16_t, WS_O) + (size_t)n * MROWS * 512, WSP(bf16_t, WS_WBT) + (size_t)n * 1024 * 512, NREAL, D, 512}; pg8::StaticOrder S; S.init(NREAL, D, F.G, F.bid);
                pg8::EpiBranch E{WSP(bf16_t, WS_MERGED), WSP(bf16_t, WS_GT), n};
                pg8::gemm_phase(F.lds, F.tid, g, S, E);
                meta_gemm<1>(F, WSP(bf16_t, WS_O) + (size_t)n * MROWS * 512 + (size_t)META_ROW0 * 512, WSP(bf16_t, WS_WBT) + (size_t)n * 1024 * 512, D, 512, n);
            }
            SEAM(pb + 6 + n);
        }
        if (EN(9) && IN(pb + 9)) {
            pg8::Gemm g{WSP(bf16_t, WS_MERGED), WSP(bf16_t, WS_WOT), NREAL, D, D}; pg8::StaticOrder S; S.init(NREAL, D, F.G, F.bid);
            pg8::EpiResidual E{OUTP, WSP(float, WS_HMETA)};
            pg8::gemm_phase(F.lds, F.tid, g, S, E);
            meta_gemm<2>(F, WSP(bf16_t, WS_MERGED) + (size_t)META_ROW0 * D, WSP(bf16_t, WS_WOT), D, D, 0);
        }
        SEAM(pb + 9);
        for (int rep = 0; rep < DUPN(10); ++rep) { if (rep) { GRID_BARRIER(); PHASE_FENCE(F); F.dry = 1; asm volatile("" : "+s"(F.dry)); } if (EN(10) && IN(pb + 10)) phase_norm2(F, l); F.dry = 0; }
        SEAM(pb + 10);
        for (int rep = 0; rep < DUPN(11); ++rep) { if (rep) { GRID_BARRIER(); PHASE_FENCE(F); } if (EN(11) && IN(pb + 11)) phase_gather(F, l); }
        SEAM(pb + 11);
        for (int rep = 0; rep < DUPN(12); ++rep) { if (rep) { GRID_BARRIER(); PHASE_FENCE(F); }
        if (EN(12) && IN(pb + 12)) {
            const int ntiles = moe_tables(F, l);
            pg8::Gemm g{WSP(bf16_t, WS_XG), WSP(bf16_t, WS_W1T), XG_ROWS, 512, D};
            pg8::MoeOrder S{F.G, F.bid, 2, ntiles, (const LAS unsigned char*)(F.lds + LDS_TAB + 384), (size_t)512 * 1024 * 2};
            pg8::EpiMoeUp E{WSP(bf16_t, WS_HG)};
            pg8::gemm_phase(F.lds, F.tid, g, S, E);
        } }
        SEAM(pb + 12);
        for (int rep = 0; rep < DUPN(13); ++rep) { if (rep) { GRID_BARRIER(); PHASE_FENCE(F); }
        if (EN(13) && IN(pb + 13)) {
            const int ntiles = moe_tables(F, l);
            pg8::Gemm g{WSP(bf16_t, WS_HG), WSP(bf16_t, WS_W2T), XG_ROWS, D, 256};
            pg8::MoeOrder S{F.G, F.bid, 4, ntiles, (const LAS unsigned char*)(F.lds + LDS_TAB + 384), (size_t)1024 * 256 * 2};
            pg8::EpiMoeDown E{WSP(bf16_t, WS_Y2), WSP(float, SM_WROW)};
            pg8::gemm_phase(F.lds, F.tid, g, S, E);
        } }
        SEAM(pb + 13);
    }
    { constexpr int l = 1;
        const int pb = 1 + PH_PER_LAYER * l;
        for (int rep = 0; rep < (l == 0 ? DUPN(0) : 1); ++rep) { if (rep) { GRID_BARRIER(); PHASE_FENCE(F); } if (EN(0) && IN(pb + 0)) phase_norm1(F, l); }
        SEAM(pb + 0);
        for (int rep = 0; rep < DUPN(1); ++rep) { if (rep) { GRID_BARRIER(); PHASE_FENCE(F); }
        if (EN(1) && IN(pb + 1)) {
            pg8::Gemm g{WSP(bf16_t, WS_U), WSP(bf16_t, WS_WMIX), MROWS, LDP, D}; pg8::StaticOrder S; S.init(MROWS, LDP, F.G, F.bid);
            pg8::EpiInProj E{WSP(bf16_t, WS_P), WSP(bf16_t, SM_HALO)};
            pg8::gemm_phase(F.lds, F.tid, g, S, E);
        } }
        SEAM(pb + 1);
        if (EN(2) && IN(pb + 2)) prep_set(F, l, 0, F.G, F.bid);
        SEAM(pb + 2);
        if (EN(3) && IN(pb + 3)) phase_scan(F, l);
        SEAM(pb + 3);
        for (int rep = 0; rep < DUPN(4); ++rep) { if (rep) { GRID_BARRIER(); PHASE_FENCE(F); F.dry = 1; asm volatile("" : "+s"(F.dry)); } if (EN(4) && IN(pb + 4)) phase_hnorm(F, l); F.dry = 0; }
        SEAM(pb + 4);
        for (int rep = 0; rep < DUPN(5); ++rep) { if (rep) { GRID_BARRIER(); PHASE_FENCE(F); }
        if (EN(5) && IN(pb + 5)) {
            pg8::Gemm g{WSP(bf16_t, WS_U), WSP(bf16_t, WS_WGATE), NREAL, 3072, D}; pg8::StaticOrder S; S.init(NREAL, 3072, F.G, F.bid);
            pg8::EpiSigmoid E{WSP(bf16_t, WS_GT), 3072};
            pg8::gemm_phase(F.lds, F.tid, g, S, E);
            meta_gemm<0>(F, WSP(bf16_t, WS_U) + (size_t)META_ROW0 * D, WSP(bf16_t, WS_WGATE), 3072, D, 0);
        } }
        SEAM(pb + 5);
        for (int n = 0; n < 3; ++n) {
            if (EN(6) && IN(pb + 6 + n)) {
                pg8::Gemm g{WSP(bf16_t, WS_O) + (size_t)n * MROWS * 512, WSP(bf16_t, WS_WBT) + (size_t)n * 1024 * 512, NREAL, D, 512}; pg8::StaticOrder S; S.init(NREAL, D, F.G, F.bid);
                pg8::EpiBranch E{WSP(bf16_t, WS_MERGED), WSP(bf16_t, WS_GT), n};
                pg8::gemm_phase(F.lds, F.tid, g, S, E);
                meta_gemm<1>(F, WSP(bf16_t, WS_O) + (size_t)n * MROWS * 512 + (size_t)META_ROW0 * 512, WSP(bf16_t, WS_WBT) + (size_t)n * 1024 * 512, D, 512, n);
            }
            SEAM(pb + 6 + n);
        }
        if (EN(9) && IN(pb + 9)) {
            pg8::Gemm g{WSP(bf16_t, WS_MERGED), WSP(bf16_t, WS_WOT), NREAL, D, D}; pg8::StaticOrder S; S.init(NREAL, D, F.G, F.bid);
            pg8::EpiResidual E{OUTP, WSP(float, WS_HMETA)};
            pg8::gemm_phase(F.lds, F.tid, g, S, E);
            meta_gemm<2>(F, WSP(bf16_t, WS_MERGED) + (size_t)META_ROW0 * D, WSP(bf16_t, WS_WOT), D, D, 0);
        }
        SEAM(pb + 9);
        for (int rep = 0; rep < DUPN(10); ++rep) { if (rep) { GRID_BARRIER(); PHASE_FENCE(F); F.dry = 1; asm volatile("" : "+s"(F.dry)); } if (EN(10) && IN(pb + 10)) phase_norm2(F, l); F.dry = 0; }
        SEAM(pb + 10);
        for (int rep = 0; rep < DUPN(11); ++rep) { if (rep) { GRID_BARRIER(); PHASE_FENCE(F); } if (EN(11) && IN(pb + 11)) phase_gather(F, l); }
        SEAM(pb + 11);
        for (int rep = 0; rep < DUPN(12); ++rep) { if (rep) { GRID_BARRIER(); PHASE_FENCE(F); }
        if (EN(12) && IN(pb + 12)) {
            const int ntiles = moe_tables(F, l);
            pg8::Gemm g{WSP(bf16_t, WS_XG), WSP(bf16_t, WS_W1T), XG_ROWS, 512, D};
            pg8::MoeOrder S{F.G, F.bid, 2, ntiles, (const LAS unsigned char*)(F.lds + LDS_TAB + 384), (size_t)512 * 1024 * 2};
            pg8::EpiMoeUp E{WSP(bf16_t, WS_HG)};
            pg8::gemm_phase(F.lds, F.tid, g, S, E);
        } }
        SEAM(pb + 12);
        for (int rep = 0; rep < DUPN(13); ++rep) { if (rep) { GRID_BARRIER(); PHASE_FENCE(F); }
        if (EN(13) && IN(pb + 13)) {
            const int ntiles = moe_tables(F, l);
            pg8::Gemm g{WSP(bf16_t, WS_HG), WSP(bf16_t, WS_W2T), XG_ROWS, D, 256};
            pg8::MoeOrder S{F.G, F.bid, 4, ntiles, (const LAS unsigned char*)(F.lds + LDS_TAB + 384), (size_t)1024 * 256 * 2};
            pg8::EpiMoeDown E{WSP(bf16_t, WS_Y2), WSP(float, SM_WROW)};
            pg8::gemm_phase(F.lds, F.tid, g, S, E);
        } }
        SEAM(pb + 13);
    }
#if DBG_STOP > 0
    if (EN(14) && IN(N_PHASES - 1)) { const int gt = F.bid * NTHREADS + F.tid, NT = F.G * NTHREADS;
#ifdef DBG_LIN
        { const bf16_t* s1 = WSP(bf16_t, DBG_SRC); const bf16_t* s2 = WSP(bf16_t, DBG_SRC2);
          for (size_t i = gt; i < (size_t)NREAL * D; i += NT) F.out[i] = i < (size_t)DBG_N1 ? bf2f(s1[i]) : (i < (size_t)DBG_N1 + DBG_N2 ? bf2f(s2[i - DBG_N1]) : 0.f); }
#else
        if (DBG_LD > 0) { const bf16_t* src = WSP(bf16_t, DBG_SRC); for (size_t i = gt; i < (size_t)NREAL * D; i += NT) { const size_t r = i >> 10, c = i & 1023; F.out[i] = bf2f(src[r * DBG_LD + (c * DBG_LD) / 1024]); } }
#endif
    }
#else
#ifdef DBG_XBAR
    for (int i = 0; i < DBG_XBAR; ++i) { GRID_BARRIER(); PHASE_FENCE(F); }
#endif
    if (EN(14) && IN(N_PHASES - 1)) phase_final(F);
    PROF_SPIN(F);
    if (DBG_TA >= 0) { float* tw = WSP(float, WS_CTL) + 2048; if (F.bid == 0 && F.tid == 0) { tw[0] = (float)MISC[17] * 0.01f; }
        GRID_BARRIER(); PHASE_FENCE(F);
        const float v = floorf(WSP(float, WS_CTL)[2048] * (1.0f / DBG_TQ)) * 0.25f;
        const int gt = F.bid * NTHREADS + F.tid, NT = F.G * NTHREADS;
        for (size_t i = gt; i < (size_t)NREAL * D; i += NT) F.out[i] = v; }
#endif
#undef IN
#undef SEAM
}

#if MK_ONE_LAUNCH
#ifndef KM_ONE
#define KM_ONE 0xffffffffu
#endif
constexpr unsigned KMASK[1] = {KM_ONE};
#else
constexpr unsigned KMASK[3] = {0x0C19u, 0xC004u, 0x3262u};
#endif
template <unsigned M> static bool setup_kernel(int& per_cu) {
    if (hipFuncSetAttribute((const void*)hybrid_fwd<M>, hipFuncAttributeMaxDynamicSharedMemorySize, LDS_BYTES) != hipSuccess) return false;
    if (hipOccupancyMaxActiveBlocksPerMultiprocessor(&per_cu, (const void*)hybrid_fwd<M>, NTHREADS, LDS_BYTES) != hipSuccess) per_cu = 0;
    (void)hipGetLastError();
    return true;
}
static int phase_kind(int k) { if (k == 0) return 15; if (k == N_PHASES - 1) return 14; const int j = (k - 1) % PH_PER_LAYER; return (j >= 6 && j <= 8) ? 6 : j; }
extern "C" void kernel_launch(void* const* d_in, const int* in_sizes, int n_in, void* d_out, int out_size, void* d_ws, size_t ws_size, hipStream_t stream) {
    static int grid = 0;
    if (grid == 0) {
        if (n_in != 24 || in_sizes[0] != NREAL * D || out_size != NREAL * D || ws_size < WS_END) {
            fprintf(stderr, "kernel_launch: unexpected problem (n_in %d, in0 %d, out %d, ws %zu < %zu); nothing launched\n", n_in, n_in > 0 ? in_sizes[0] : -1, out_size, ws_size, (size_t)WS_END); grid = -1; return; }
        int dev = 0, cus = 0, per_cu = 0; bool ok = true;
        if (hipGetDevice(&dev) != hipSuccess || hipDeviceGetAttribute(&cus, hipDeviceAttributeMultiprocessorCount, dev) != hipSuccess) { grid = -1; return; }
#if MK_ONE_LAUNCH
        ok = setup_kernel<KMASK[0]>(per_cu);
#else
        ok = setup_kernel<KMASK[0]>(per_cu) && setup_kernel<KMASK[1]>(per_cu) && setup_kernel<KMASK[2]>(per_cu);
#endif
        if (!ok) { fprintf(stderr, "kernel_launch: hipFuncSetAttribute failed\n"); grid = -1; return; }
        if (per_cu < 1) fprintf(stderr, "kernel_launch: occupancy query says %d\n", per_cu);
        grid = cus;
    }
    if (grid < 0) return;
    if (hipMemsetAsync((char*)d_ws + WS_CTL, 0, CTL_BYTES, stream) != hipSuccess) return;
    Params p{};
    for (int i = 0; i < 24; ++i) p.in[i] = (const float*)d_in[i];
    p.out = (float*)d_out; p.ws = (unsigned char*)d_ws;
#if MK_ONE_LAUNCH
    p.ph_lo = 0; p.ph_hi = N_PHASES;
    hipLaunchKernelGGL(hybrid_fwd<KMASK[0]>, dim3(grid), dim3(NTHREADS), LDS_BYTES, stream, p);
#else
    for (int k = 0; k < N_PHASES; ++k) { if (DBG_STOP > 0 && k >= DBG_STOP && k != N_PHASES - 1) continue; p.ph_lo = k; p.ph_hi = k + 1; const unsigned bit = 1u << phase_kind(k);
        if (KMASK[0] & bit) hipLaunchKernelGGL(hybrid_fwd<KMASK[0]>, dim3(grid), dim3(NTHREADS), LDS_BYTES, stream, p);
        else if (KMASK[1] & bit) hipLaunchKernelGGL(hybrid_fwd<KMASK[1]>, dim3(grid), dim3(NTHREADS), LDS_BYTES, stream, p);
        else hipLaunchKernelGGL(hybrid_fwd<KMASK[2]>, dim3(grid), dim3(NTHREADS), LDS_BYTES, stream, p); }
#endif
}
```

```cpp
#include <hip/hip_runtime.h>
#include <cstdio>
#include <cstdint>

#define LAS __attribute__((address_space(3)))
typedef unsigned short bf16_t;
typedef short bf16x8 __attribute__((ext_vector_type(8)));
typedef float f32x4 __attribute__((ext_vector_type(4)));
typedef float f32x2 __attribute__((ext_vector_type(2)));
typedef unsigned u32x4 __attribute__((ext_vector_type(4)));
typedef unsigned u32x2 __attribute__((ext_vector_type(2)));

constexpr int D = 1024, NREAL = 16384, MROWS = 16640, META_ROW0 = 16384 + 48, META_END = 16384 + 64;
constexpr int NSLOT = 257;
constexpr int LDP = 5632;
constexpr int PC_AQ = 0, PC_AF = 512, PC_AI = 1024, PC_AG = 1536, PC_BQKV = 2048, PC_BG = 3584, PC_CQ = 4096, PC_CK = 4352, PC_CV = 4608, PC_CG = 5120;
constexpr int IN_COLS = 8728;
constexpr int NTHREADS = 512, NWAVES = 8;
constexpr int XG_ROWS = 40960;

constexpr size_t MiB = 1ull << 20;
constexpr size_t WS_CTL = 0, CTL_BYTES = 1 * MiB;
constexpr int CW_BAR = 4096, CW_CNT = 1024;
constexpr size_t SM_SW1 = 1 * MiB;
constexpr size_t SM_RWG = SM_SW1 + 2 * 24 * 1024 * 4;
constexpr size_t SM_RWE = SM_RWG + 2 * 4 * 1024 * 4;
constexpr size_t SM_LAB = SM_RWE + 2 * 32 * 1024 * 4;
constexpr size_t SM_GK = SM_LAB + 2 * 2 * 512 * 4;
constexpr size_t SM_BETA = SM_GK + (size_t)MROWS * 16 * 4;
constexpr size_t SM_LOGA = SM_BETA + (size_t)MROWS * 4 * 4;
constexpr size_t SM_TOK = SM_LOGA + (size_t)MROWS * 4 * 4;
constexpr size_t SM_WROW = SM_TOK + (size_t)MROWS * 8 * 4;
constexpr size_t SM_DECA = SM_WROW + (size_t)XG_ROWS * 4;
constexpr size_t SM_DECC = SM_DECA + 1028 * 128 * 4;
constexpr size_t SM_DECB = SM_DECC + 1028 * 64 * 4;
constexpr size_t SM_HALO = SM_DECB + 8192;
constexpr size_t SM_END = SM_HALO + 260 * 3 * 1536 * 2;
static_assert(SM_END <= 8 * MiB, "small region");
constexpr size_t WS_HMETA = 8 * MiB;
constexpr size_t WS_WMIX = 9 * MiB;
constexpr size_t WS_WGATE = 20 * MiB;
constexpr size_t WS_WBT = 26 * MiB;
constexpr size_t WS_WOT = 29 * MiB;
constexpr size_t WS_O = 31 * MiB;
constexpr size_t O_STRIDE = (size_t)MROWS * 512 * 2;
constexpr size_t WS_W1T = 31 * MiB;
constexpr size_t WS_W2T = 63 * MiB;
constexpr size_t WS_U = 80 * MiB;
constexpr size_t WS_P = 113 * MiB;
constexpr size_t WS_GT = 113 * MiB;
constexpr size_t WS_MERGED = 211 * MiB;
constexpr size_t WS_XG = 113 * MiB;
constexpr size_t WS_HG = 193 * MiB;
constexpr size_t WS_Y2 = 213 * MiB;
constexpr size_t WS_SCA = 294 * MiB;
constexpr size_t WS_QKD = 303 * MiB;
constexpr size_t WS_SCC = 312 * MiB;
constexpr size_t WS_K1TB = 321 * MiB;
constexpr size_t WS_END = 338 * MiB;

constexpr int LDS_BYTES = 163840;
constexpr int LDS_MISC = LDS_BYTES - 512;
constexpr int LDS_TAB = LDS_BYTES - 1536;
constexpr int LDS_SCRATCH = LDS_TAB;

typedef __bf16 bf16x2v __attribute__((ext_vector_type(2)));
__device__ __forceinline__ unsigned pk2(float lo, float hi) { const f32x2 v = {lo, hi}; return __builtin_bit_cast(unsigned, __builtin_convertvector(v, bf16x2v)); }
__device__ __forceinline__ bf16_t f2bf(float f) { return (bf16_t)(pk2(f, 0.f) & 0xffffu); }
__device__ __forceinline__ float bf2f(bf16_t b) { return __uint_as_float(((unsigned)b) << 16); }
__device__ __forceinline__ float bflo(unsigned w) { return __uint_as_float(w << 16); }
__device__ __forceinline__ float bfhi(unsigned w) { return __uint_as_float(w & 0xffff0000u); }
__device__ __forceinline__ float sigmoidf_(float x) { return __builtin_amdgcn_rcpf(1.0f + __expf(-x)); }
__device__ __forceinline__ float siluf_(float x) { return x * __builtin_amdgcn_rcpf(1.0f + __expf(-x)); }
__device__ __forceinline__ float logsigf_(float x) { return fminf(x, 0.f) - __logf(1.0f + __expf(-fabsf(x))); }
__device__ __forceinline__ float softplusf_(float x) { return fmaxf(x, 0.f) + log1pf(__expf(-fabsf(x))); }
__device__ __forceinline__ bool row_valid(int r) { return r < NREAL || (r >= META_ROW0 && r < META_END); }
__device__ __forceinline__ float wave_sum(float v) {
#define DPP_ADD(ctrl, rmask) v += __int_as_float(__builtin_amdgcn_update_dpp(0, __float_as_int(v), (ctrl), (rmask), 0xf, false))
    DPP_ADD(0x111, 0xf); DPP_ADD(0x112, 0xf); DPP_ADD(0x114, 0xf); DPP_ADD(0x118, 0xf);
    DPP_ADD(0x142, 0xa); DPP_ADD(0x143, 0xc);
#undef DPP_ADD
    return __int_as_float(__builtin_amdgcn_readlane(__float_as_int(v), 63));
}
#define LDS_WAIT() asm volatile("s_waitcnt lgkmcnt(0)" ::: "memory")

#define XB_TMO      128
#define XB_XCNT(j)  (256  + 64 * (j))
#define XB_XSUB(j)  (1280 + 64 * (j))
#define XB_XGEN(j)  (2304 + 64 * (j))
#define XB_TOP      3328
#define XB_TOPGEN   3392
#define XCD_BAR_WORDS 3456
#define XB_SPIN_CAP (1u << 18)
__device__ __forceinline__ unsigned xb_ld(unsigned* p)              { return __hip_atomic_load(p, __ATOMIC_RELAXED, __HIP_MEMORY_SCOPE_AGENT); }
__device__ __forceinline__ unsigned xb_add(unsigned* p, unsigned v) { return __hip_atomic_fetch_add(p, v, __ATOMIC_RELAXED, __HIP_MEMORY_SCOPE_AGENT); }
__device__ __forceinline__ unsigned xb_xcc_id() { return (unsigned)__builtin_amdgcn_s_getreg((3 << 11) | 20) & 0xFu; }
#define XB_SPIN(cond, bar) do { unsigned _sp = 0; while (cond) { __builtin_amdgcn_s_sleep(1); \
    if ((++_sp & 255u) == 0u) { if (xb_ld(&(bar)[XB_TMO])) break; if (_sp > XB_SPIN_CAP) { atomicAdd(&(bar)[XB_TMO], 1u); break; } } } } while (0)
struct XcdBarrier { unsigned* bar; unsigned x; volatile LAS unsigned* st; };
__device__ __forceinline__ XcdBarrier xcd_barrier_post(unsigned* bar, volatile LAS unsigned* st) {
    XcdBarrier b; b.bar = bar; b.x = xb_xcc_id(); b.st = st;
    if (threadIdx.x == 0) (void)xb_add(&bar[XB_XCNT(b.x)], 1u);
    return b;
}
__device__ __forceinline__ void xcd_barrier_complete(unsigned* bar, unsigned x, unsigned& nloc, unsigned& nx, const unsigned G) {
    unsigned sum, cnt, mine, sp = 0u;
    for (;;) {
        sum = 0u; cnt = 0u; mine = 0u;
#pragma unroll
        for (unsigned j = 0; j < 16; ++j) { const unsigned c = xb_ld(&bar[XB_XCNT(j)]); sum += c; cnt += (c > 0u) ? 1u : 0u; mine = (j == x) ? c : mine; }
        if (sum == G) break;
        __builtin_amdgcn_s_sleep(1);
        if ((++sp & 255u) == 0u) { if (xb_ld(&bar[XB_TMO])) break; if (sp > XB_SPIN_CAP) { atomicAdd(&bar[XB_TMO], 1u); break; } }
    }
    nloc = mine > 0u ? mine : 1u; nx = cnt > 0u ? cnt : 1u;
}
__device__ __attribute__((noinline)) void xcd_barrier(unsigned* bar_, unsigned x_, volatile LAS unsigned* st_, int tid_, unsigned G_) {
    XcdBarrier b; b.bar = bar_; b.x = x_; b.st = st_;
    asm volatile("s_waitcnt vmcnt(0)" ::: "memory");
    __syncthreads();
    if (tid_ == 0) {
        unsigned* bar = b.bar;
        __builtin_amdgcn_s_waitcnt(0);
        unsigned nloc = b.st[0], nx = b.st[1];
        if (nloc == 0u) { xcd_barrier_complete(bar, b.x, nloc, nx, G_); b.st[0] = nloc; b.st[1] = nx; }
        const unsigned old = xb_add(&bar[XB_XSUB(b.x)], 1u);
        const unsigned gen = old / nloc;
        if (old + 1u == (gen + 1u) * nloc) {
            __builtin_amdgcn_fence(__ATOMIC_RELEASE, "agent");
            asm volatile("s_waitcnt vmcnt(0)" ::: "memory");
            const unsigned og = xb_add(&bar[XB_TOP], 1u);
            const unsigned tg = og / nx;
            if (og + 1u == (tg + 1u) * nx) xb_add(&bar[XB_TOPGEN], 1u);
            else XB_SPIN(xb_ld(&bar[XB_TOPGEN]) == tg, bar);
            __builtin_amdgcn_fence(__ATOMIC_ACQUIRE, "agent");
            xb_add(&bar[XB_XGEN(b.x)], 1u);
            asm volatile("s_waitcnt vmcnt(0)" ::: "memory");
        } else {
            XB_SPIN(xb_ld(&bar[XB_XGEN(b.x)]) == gen, bar);
            __builtin_amdgcn_fence(__ATOMIC_ACQUIRE, "agent");
            asm volatile("s_waitcnt vmcnt(0)" ::: "memory");
        }
    }
    __syncthreads();
}

#ifndef PROF_ON
#define PROF_ON 0
#endif
#if PROF_ON
#define PROF_SLOTS(F) WSP(unsigned, WS_CTL + 524288)
#define PROF_MARK(F, k) do { if ((F).bid == PROF_BID && (F).tid == 0) PROF_SLOTS(F)[k] = (unsigned)__builtin_amdgcn_s_memrealtime(); } while (0)
#if PROF_IN & 1
#define PROF_MARKI(F, k) PROF_MARK(F, k)
#else
#define PROF_MARKI(F, k) do { } while (0)
#endif
#if PROF_IN & 2
#define PROF_MARKG(F, k) PROF_MARK(F, k)
#else
#define PROF_MARKG(F, k) do { } while (0)
#endif
#define PROF_SPIN(F) do { if ((F).bid == PROF_BID && (F).tid == 0) { unsigned qa_ = (PROF_SLOTS(F)[PROF_A1] - PROF_SLOTS(F)[PROF_A0] + 50u) / 100u, qb_ = (PROF_SLOTS(F)[PROF_B1] - PROF_SLOTS(F)[PROF_B0] + 50u) / 100u; \
    qa_ = qa_ > 127u ? 127u : qa_; qb_ = qb_ > 127u ? 127u : qb_; const unsigned d_ = (qa_ + 128u * qb_) * 1600u; const unsigned t0_ = (unsigned)__builtin_amdgcn_s_memrealtime(); \
    while ((unsigned)__builtin_amdgcn_s_memrealtime() - t0_ < d_) __builtin_amdgcn_s_sleep(8); } } while (0)
#else
#define PROF_MARK(F, k) do { } while (0)
#define PROF_MARKI(F, k) do { } while (0)
#define PROF_MARKG(F, k) do { } while (0)
#define PROF_SPIN(F) do { } while (0)
#endif
namespace pg8 {
constexpr int BM = 256, BK = 64, HALF = 128, HTB = HALF * BK * 2, STAGE_BYTES = 8 * HTB, NXCD = 8, WGM = 8;
__host__ __device__ __forceinline__ int lds_byte(int r, int c) { const int st = (r >> 4) * 2 + (c >> 5), rr = r & 15, cc = c & 31, ob = rr * 64 + cc * 2; return st * 1024 + (ob ^ (((ob >> 9) & 1) << 5)); }
__host__ __device__ __forceinline__ void stage_rc(int b, int& R, int& C) { const int st = b / 1024, sb = b % 1024, swz = sb ^ (((sb >> 9) & 1) << 5); R = (st >> 1) * 16 + swz / 64; C = (st & 1) * 32 + (swz % 64) / 2; }
__host__ __device__ __forceinline__ int perm32(int rho) { const int n = rho >> 4, i = rho & 15; return 8 * (i >> 2) + 4 * n + (i & 3); }

struct Unit { int pm, pn, ex; };
struct Gemm { const bf16_t* A; const bf16_t* Bt; int M, N, K; };

struct StaticOrder {
    int nM, nN, nwg, G, c;
    __device__ void init(int M, int N, int G_, int c_) { nM = M / BM; nN = N / BM; nwg = nM * nN; G = G_; c = c_; }
    __device__ bool next(int i, Unit& u) const {
        const long L = (long)i * G + c; if (L >= nwg) return false;
        int wgid = (int)L; { const int q = nwg / NXCD, r = nwg % NXCD, xcd = wgid % NXCD, off = wgid / NXCD; wgid = (xcd < r ? xcd * (q + 1) : r * (q + 1) + (xcd - r) * q) + off; }
        const int nig = WGM * nN, gid = wgid / nig, fm = gid * WGM, gsz = (nM - fm) < WGM ? (nM - fm) : WGM;
        u.pm = fm + ((wgid % nig) % gsz); u.pn = (wgid % nig) / gsz; u.ex = 0; return true;
    }
    __device__ __forceinline__ void ptrs(const Gemm& g, const Unit& u, const char*& a, const char*& b) const {
        const size_t tstep = (size_t)BM * g.K * 2; a = (const char*)g.A + (size_t)u.pm * tstep; b = (const char*)g.Bt + (size_t)u.pn * tstep; }
};
struct MoeOrder {
    int G, c, npn, ntiles; const LAS unsigned char* tab; size_t estride;
    __device__ bool next(int i, Unit& u) const {
        const long L = (long)i * G + c; if (L >= (long)ntiles * npn) return false;
        u.pm = (int)(L / npn); u.pn = (int)(L % npn); u.ex = (int)tab[u.pm]; return true;
    }
    __device__ __forceinline__ void ptrs(const Gemm& g, const Unit& u, const char*& a, const char*& b) const {
        const size_t tstep = (size_t)BM * g.K * 2; a = (const char*)g.A + (size_t)u.pm * tstep; b = (const char*)g.Bt + (size_t)u.ex * estride + (size_t)u.pn * tstep; }
};

template <class Epi, class Sched>
__device__ __forceinline__ void gemm_phase(LAS unsigned char* lds, const int tid, const Gemm g, const Sched& S, const Epi& E) {
    const int wid = __builtin_amdgcn_readfirstlane(tid >> 6), lane = tid & 63, wr = wid >> 2, wc = wid & 3, fr = lane & 15, fq = lane >> 4;
    int K = g.K; asm volatile("" : "+s"(K));
    const int nt = K / BK;
    unsigned voffA[2], voffB[2];
#pragma unroll
    for (int i = 0; i < 2; ++i) { int R, C; stage_rc(tid * 16 + i * 8192, R, C); const int Rb = Epi::PERM ? ((R & ~31) + perm32(R & 31)) : R;
        voffA[i] = (unsigned)(R * K + C) * 2u; voffB[i] = (unsigned)(Rb * K + C) * 2u; }
    const size_t kstep = (size_t)(BK * 2);
    const size_t hstep = (size_t)HALF * K * 2;
    const unsigned ldsw = (unsigned)wid * 1024u;
    const int aoff = lds_byte(wr * 64 + fr, fq * 8), boff = lds_byte(wc * 32 + fr, fq * 8);
#define PG8_SA(b, h) (((b) * 2 + (h)) * HTB)
#define PG8_SB(b, h) ((4 + (b) * 2 + (h)) * HTB)
#define PG8_STAGE(bufoff, gbase, voff) do { _Pragma("unroll") for (int _i = 0; _i < 2; ++_i) \
        __builtin_amdgcn_global_load_lds((const unsigned*)((const char*)(gbase) + (voff)[_i]), (LAS unsigned*)(lds + (bufoff) + ldsw + _i * 8192), 16, 0, 0); } while (0)
#define PG8_LDA(dst, b, h) do { _Pragma("unroll") for (int m = 0; m < 4; ++m) _Pragma("unroll") for (int k = 0; k < 2; ++k) dst[m][k] = *(const LAS bf16x8*)(lds + PG8_SA(b, h) + aoff + m * 2048 + k * 1024); } while (0)
#define PG8_LDB(dst, b, h) do { _Pragma("unroll") for (int n = 0; n < 2; ++n) _Pragma("unroll") for (int k = 0; k < 2; ++k) dst[n][k] = *(const LAS bf16x8*)(lds + PG8_SB(b, h) + boff + n * 2048 + k * 1024); } while (0)
#define PG8_MMA(ai, bj, At, Bt) do { __builtin_amdgcn_s_setprio(1); _Pragma("unroll") for (int m = 0; m < 4; ++m) _Pragma("unroll") for (int n = 0; n < 2; ++n) _Pragma("unroll") for (int k = 0; k < 2; ++k) \
        acc[ai][bj][m][n] = __builtin_amdgcn_mfma_f32_16x16x32_bf16(Bt[n][k], At[m][k], acc[ai][bj][m][n], 0, 0, 0); __builtin_amdgcn_s_setprio(0); } while (0)
#define PG8_WAIT_V(n) asm volatile("s_waitcnt vmcnt(" #n ")" ::: "memory")
#define PG8_WAIT_L(n) asm volatile("s_waitcnt lgkmcnt(" #n ")" ::: "memory")
#define PG8_BAR __builtin_amdgcn_s_barrier()
#define PG8_SCHED __builtin_amdgcn_sched_barrier(0)
    Unit cur, nxt; int ui = 0;
    if (!S.next(0, cur)) return;
    f32x4 acc[2][2][4][2];
#pragma unroll
    for (int a = 0; a < 2; ++a)
#pragma unroll
        for (int b = 0; b < 2; ++b)
#pragma unroll
            for (int m = 0; m < 4; ++m)
#pragma unroll
                for (int n = 0; n < 2; ++n) acc[a][b][m][n] = (f32x4){0.f, 0.f, 0.f, 0.f};
    bf16x8 At[4][2], B0[2][2], B1[2][2];
    const char* cA; const char* cB; S.ptrs(g, cur, cA, cB);
    PG8_STAGE(PG8_SB(0, 0), cB, voffB); PG8_STAGE(PG8_SA(0, 0), cA, voffA); PG8_STAGE(PG8_SB(0, 1), cB + hstep, voffB); PG8_STAGE(PG8_SA(0, 1), cA + hstep, voffA);
    if (wr == 1) PG8_BAR;
    PG8_WAIT_V(4); PG8_BAR;
    PG8_STAGE(PG8_SB(1, 0), cB + kstep, voffB); PG8_STAGE(PG8_SA(1, 0), cA + kstep, voffA); PG8_STAGE(PG8_SB(1, 1), cB + hstep + kstep, voffB);
    PG8_WAIT_V(6); PG8_BAR;
    for (;;) {
        const bool has_next = S.next(ui + 1, nxt);
        const char* nA = cA; const char* nB = cB; if (has_next) S.ptrs(g, nxt, nA, nB);
        for (int t = 0; t < nt; t += 2) {
            const bool last = (t == nt - 2);
            const char* a1 = cA + (size_t)(t + 1) * kstep;
            const char* a2 = last ? nA : cA + (size_t)(t + 2) * kstep; const char* b2 = last ? nB : cB + (size_t)(t + 2) * kstep;
            const char* a3 = a2 + kstep; const char* b3 = b2 + kstep;
            PG8_LDB(B0, 0, 0); PG8_SCHED; PG8_LDA(At, 0, 0); PG8_STAGE(PG8_SA(1, 1), a1 + hstep, voffA);
            PG8_WAIT_L(8); PG8_BAR; PG8_WAIT_L(0); PG8_MMA(0, 0, At, B0); PG8_BAR; PG8_SCHED;
            PG8_LDB(B1, 0, 1); PG8_STAGE(PG8_SB(0, 0), b2, voffB);
            PG8_BAR; PG8_WAIT_L(0); PG8_MMA(0, 1, At, B1); PG8_BAR;
            PG8_LDA(At, 0, 1); PG8_STAGE(PG8_SA(0, 0), a2, voffA);
            PG8_BAR; PG8_WAIT_L(0); PG8_MMA(1, 0, At, B0); PG8_BAR; PG8_SCHED;
            PG8_STAGE(PG8_SB(0, 1), b2 + hstep, voffB);
            PG8_WAIT_V(6); PG8_BAR; PG8_MMA(1, 1, At, B1); PG8_BAR;
            PG8_LDB(B0, 1, 0); PG8_SCHED; PG8_LDA(At, 1, 0); PG8_STAGE(PG8_SA(0, 1), a2 + hstep, voffA);
            PG8_WAIT_L(8); PG8_BAR; PG8_WAIT_L(0); PG8_MMA(0, 0, At, B0); PG8_BAR; PG8_SCHED;
            PG8_LDB(B1, 1, 1); PG8_STAGE(PG8_SB(1, 0), b3, voffB);
            PG8_BAR; PG8_WAIT_L(0); PG8_MMA(0, 1, At, B1); PG8_BAR;
            PG8_LDA(At, 1, 1); PG8_STAGE(PG8_SA(1, 0), a3, voffA);
            PG8_BAR; PG8_WAIT_L(0); PG8_MMA(1, 0, At, B0); PG8_BAR; PG8_SCHED;
            PG8_STAGE(PG8_SB(1, 1), b3 + hstep, voffB);
            PG8_WAIT_V(6); PG8_BAR; PG8_MMA(1, 1, At, B1); PG8_BAR;
        }
        E(acc, cur, wr, wc, fr, fq);
        if (!has_next) break;
#pragma unroll
        for (int a = 0; a < 2; ++a)
#pragma unroll
            for (int b = 0; b < 2; ++b)
#pragma unroll
                for (int m = 0; m < 4; ++m)
#pragma unroll
                    for (int n = 0; n < 2; ++n) acc[a][b][m][n] = (f32x4){0.f, 0.f, 0.f, 0.f};
        cur = nxt; cA = nA; cB = nB; ++ui;
    }
    PG8_WAIT_V(0);
    if (wr == 0) PG8_BAR;
    PG8_BAR;
#undef PG8_SA
#undef PG8_SB
#undef PG8_STAGE
#undef PG8_LDA
#undef PG8_LDB
#undef PG8_MMA
#undef PG8_WAIT_V
#undef PG8_WAIT_L
#undef PG8_BAR
#undef PG8_SCHED
}

#define EPI_PERM_LOOP(...) \
    _Pragma("unroll") for (int ai = 0; ai < 2; ++ai) _Pragma("unroll") for (int m = 0; m < 4; ++m) { const int row = u.pm * BM + ai * HALF + wr * 64 + m * 16 + fr; \
        _Pragma("unroll") for (int bj = 0; bj < 2; ++bj) { const int col0 = u.pn * BM + bj * HALF + wc * 32 + 8 * fq; f32x4 v0 = acc[ai][bj][m][0], v1 = acc[ai][bj][m][1]; __VA_ARGS__ } if (EPI_PIN) __builtin_amdgcn_sched_barrier(0); }

struct EpiInProj {
    static constexpr bool PERM = true, EPI_PIN = true;
    bf16_t* P; bf16_t* halo;
    __device__ __forceinline__ void operator()(const f32x4 (&acc)[2][2][4][2], const Unit& u, int wr, int wc, int fr, int fq) const {
        const bool is_qkv = u.pn >= 8 && u.pn < 14;
        EPI_PERM_LOOP({
            u32x4 w; w.x = pk2(v0[0], v0[1]); w.y = pk2(v0[2], v0[3]); w.z = pk2(v1[0], v1[1]); w.w = pk2(v1[2], v1[3]);
            *(u32x4*)(P + (size_t)row * LDP + col0) = w;
            if (is_qkv && (row & 63) >= 61) *(u32x4*)(halo + ((size_t)(row >> 6) * 3 + ((row & 63) - 61)) * 1536 + (col0 - PC_BQKV)) = w;
        })
    }
};
__device__ __forceinline__ float lfg(float lb, float oml, float x) { return __logf(lb + oml * __builtin_amdgcn_rcpf(1.0f + __expf(-x)) + 1e-30f); }
struct EpiSigmoid {
    static constexpr bool PERM = true, EPI_PIN = true;
    bf16_t* O; int ldc;
    __device__ __forceinline__ void operator()(const f32x4 (&acc)[2][2][4][2], const Unit& u, int wr, int wc, int fr, int fq) const {
        EPI_PERM_LOOP({
            u32x4 w; w.x = pk2(sigmoidf_(v0[0]), sigmoidf_(v0[1])); w.y = pk2(sigmoidf_(v0[2]), sigmoidf_(v0[3])); w.z = pk2(sigmoidf_(v1[0]), sigmoidf_(v1[1])); w.w = pk2(sigmoidf_(v1[2]), sigmoidf_(v1[3]));
            *(u32x4*)(O + (size_t)row * ldc + col0) = w;
        })
    }
};
struct EpiBranch {
    static constexpr bool PERM = true, EPI_PIN = false;
    bf16_t* merged; const bf16_t* gt; int n;
    __device__ __forceinline__ void operator()(const f32x4 (&acc)[2][2][4][2], const Unit& u, int wr, int wc, int fr, int fq) const {
        EPI_PERM_LOOP({
            const u32x4 gw = *(const u32x4*)(gt + (size_t)row * 3072 + n * 1024 + col0);
            float x[8] = {v0[0] * bflo(gw.x), v0[1] * bfhi(gw.x), v0[2] * bflo(gw.y), v0[3] * bfhi(gw.y), v1[0] * bflo(gw.z), v1[1] * bfhi(gw.z), v1[2] * bflo(gw.w), v1[3] * bfhi(gw.w)};
            bf16_t* mp = merged + (size_t)row * 1024 + col0;
            if (n != 0) { const u32x4 o = *(const u32x4*)mp; x[0] += bflo(o.x); x[1] += bfhi(o.x); x[2] += bflo(o.y); x[3] += bfhi(o.y); x[4] += bflo(o.z); x[5] += bfhi(o.z); x[6] += bflo(o.w); x[7] += bfhi(o.w); }
            u32x4 w; w.x = pk2(x[0], x[1]); w.y = pk2(x[2], x[3]); w.z = pk2(x[4], x[5]); w.w = pk2(x[6], x[7]);
            *(u32x4*)mp = w;
        })
    }
};
struct EpiResidual {
    static constexpr bool PERM = false;
    float* hreal; float* hmeta;
    __device__ __forceinline__ void operator()(const f32x4 (&acc)[2][2][4][2], const Unit& u, int wr, int wc, int fr, int fq) const {
#pragma unroll
        for (int ai = 0; ai < 2; ++ai)
#pragma unroll
            for (int m = 0; m < 4; ++m) { const int row = u.pm * BM + ai * HALF + wr * 64 + m * 16 + fr;
                float* rowp = (row < NREAL ? hreal + (size_t)row * D : hmeta + (size_t)(row - NREAL) * D) + u.pn * BM + wc * 32 + 4 * fq;
#pragma unroll
                for (int bj = 0; bj < 2; ++bj)
#pragma unroll
                    for (int n = 0; n < 2; ++n) { f32x4* p = (f32x4*)(rowp + bj * HALF + n * 16); *p = *p + acc[ai][bj][m][n]; } }
    }
};
struct EpiMoeUp {
    static constexpr bool PERM = true, EPI_PIN = true;
    bf16_t* H;
    __device__ __forceinline__ void operator()(const f32x4 (&acc)[2][2][4][2], const Unit& u, int wr, int wc, int fr, int fq) const {
        EPI_PERM_LOOP({
            const int hc = col0 >> 1;
            u32x2 w; w.x = pk2(siluf_(v0[0]) * v1[0], siluf_(v0[1]) * v1[1]); w.y = pk2(siluf_(v0[2]) * v1[2], siluf_(v0[3]) * v1[3]);
            *(u32x2*)(H + (size_t)row * 256 + hc) = w;
        })
    }
};
struct EpiMoeDown {
    static constexpr bool PERM = true, EPI_PIN = false;
    bf16_t* Y; const float* wrow;
    __device__ __forceinline__ void operator()(const f32x4 (&acc)[2][2][4][2], const Unit& u, int wr, int wc, int fr, int fq) const {
        EPI_PERM_LOOP({
            const float s = wrow[row];
            u32x4 w; w.x = pk2(v0[0] * s, v0[1] * s); w.y = pk2(v0[2] * s, v0[3] * s); w.z = pk2(v1[0] * s, v1[1] * s); w.w = pk2(v1[2] * s, v1[3] * s);
            *(u32x4*)(Y + (size_t)row * 1024 + col0) = w;
        })
    }
};
}
#define GAS __attribute__((address_space(1)))
struct Params { const float* in[24]; float* out; unsigned char* ws; int ph_lo, ph_hi; };
struct Frame {
    LAS unsigned char* lds; int tid, lane, wave, G, bid;
    __attribute__((address_space(1))) float* out; __attribute__((address_space(1))) unsigned char* ws; const float* const __attribute__((address_space(4)))* inp; int dry;
};
#define PHASE_FENCE(F) do { asm volatile("" : "+s"((F).ws), "+s"((F).out), "+s"((F).inp), "+v"((F).tid), "+s"((F).bid), "+s"((F).G)); \
    (F).lane = (F).tid & 63; (F).wave = __builtin_amdgcn_readfirstlane((F).tid >> 6); } while (0)
__device__ __forceinline__ const float* inp_ptr(const float* const __attribute__((address_space(4)))* inp, int i) { GAS const float* q = (GAS const float*)inp[i]; asm volatile("" : "+s"(q)); return (const float*)q; }
#define INP(i) inp_ptr(F.inp, (i))
#define WSP(T, off) ((T*)(GAS T*)(F.ws + (off)))
enum { I_X = 0, I_META, I_NORM_MIX, I_W_IN, I_LB, I_HGRN_NORM, I_GDN_CONV, I_GDN_ALOG, I_GDN_DT, I_GDN_NORM, I_GLA_W2, I_GLA_B, I_GLA_NORM, I_W_BRANCH, I_W_OUT, I_NORM_FFN,
       I_RG_W, I_RG_B, I_RE_W, I_RE_B, I_EW_GATE, I_EW_UP, I_EW_DOWN, I_NORM_FINAL };

__device__ __forceinline__ void transpose_item(const float* W, int ldw, int K, int nblk, bf16_t* WT, int row_off, int rowmode, LAS float* scr, int item, int lane) {
    const int kb = item / nblk, nb = item % nblk, k0 = 64 * kb, n0 = 32 * nb;
    { f32x4 v[8]; const int n4 = 4 * (lane & 7);
#pragma unroll
        for (int i = 0; i < 8; ++i) v[i] = *(const f32x4*)(W + (size_t)(k0 + 8 * i + (lane >> 3)) * ldw + n0 + n4);
#pragma unroll
        for (int i = 0; i < 8; ++i) { LAS float* d = scr + (8 * i + (lane >> 3)) * 33 + n4; d[0] = v[i][0]; d[1] = v[i][1]; d[2] = v[i][2]; d[3] = v[i][3]; } }
    LDS_WAIT(); asm volatile("" ::: "memory");
    const int c = lane & 7;
#pragma unroll
    for (int j = 0; j < 4; ++j) { const int n = (lane >> 3) + 8 * j; const LAS float* s = scr + (8 * c) * 33 + n;
        u32x4 o; o.x = pk2(s[0 * 33], s[1 * 33]); o.y = pk2(s[2 * 33], s[3 * 33]); o.z = pk2(s[4 * 33], s[5 * 33]); o.w = pk2(s[6 * 33], s[7 * 33]);
        const int nn = n0 + n; const int wrow = rowmode == 0 ? row_off + nn : row_off + 8 * (nn >> 2) + (nn & 3) + (rowmode == 2 ? 4 : 0);
        *(u32x4*)(WT + (size_t)wrow * K + k0 + 8 * c) = o; }
    LDS_WAIT(); asm volatile("" ::: "memory");
}

__device__ __forceinline__ void phase_pre(Frame& F) {
    const int gt = F.bid * NTHREADS + F.tid, NT = F.G * NTHREADS;
    float* sw1 = WSP(float, SM_SW1); float* rwg = WSP(float, SM_RWG); float* rwe = WSP(float, SM_RWE); float* lab = WSP(float, SM_LAB);
    for (int i = gt; i < 2 * 24 * 1024; i += NT) { const int l = i / (24 * 1024), c = (i / 1024) % 24, k = i % 1024;
        const int col = c < 16 ? 5128 + c : (c < 20 ? 3584 + (c - 16) : 3588 + (c - 20));
        sw1[i] = INP(I_W_IN)[((size_t)l * 1024 + k) * IN_COLS + col]; }
    for (int i = gt; i < 2 * 4 * 1024; i += NT) { const int l = i / (4 * 1024), c = (i / 1024) % 4, k = i % 1024; rwg[i] = INP(I_RG_W)[((size_t)l * 1024 + k) * 4 + c]; }
    for (int i = gt; i < 2 * 32 * 1024; i += NT) { const int l = i / (32 * 1024), c = (i / 1024) % 32, k = i % 1024; rwe[i] = INP(I_RE_W)[((size_t)l * 1024 + k) * 32 + c]; }
    for (int i = gt; i < 2 * 512; i += NT) { const int l = i / 512, c = i % 512; const float l0 = INP(I_LB)[c], l1 = INP(I_LB)[512 + c];
        const float p1 = 1.0f / (1.0f + expf(l0 - l1)); const float lb = l == 0 ? 0.f : p1;
        lab[l * 1024 + c] = lb; lab[l * 1024 + 512 + c] = 1.0f - lb; }
}

__device__ __forceinline__ void convert_layer_weights(Frame& F, int l) {
    LAS float* scr = (LAS float*)(F.lds + F.wave * 16384);
    const int gw = F.bid * NWAVES + F.wave, NGW = F.G * NWAVES;
    const float* win = INP(I_W_IN) + (size_t)l * 1024 * IN_COLS;
    constexpr int I_MIX = 16 * 176, I_GATE = 16 * 96, I_BR = 8 * 32, I_OUT = 16 * 32, NITEMS = I_MIX + I_GATE + 3 * I_BR + I_OUT;
    for (int it = gw; it < NITEMS; it += NGW) {
        int r = it;
        if (r < I_MIX) { const int nb = r % 176, n0 = 32 * nb; const int shift = n0 < 3584 ? 0 : (n0 < 5120 ? 8 : 24);
            transpose_item(win + shift, IN_COLS, 1024, 176, WSP(bf16_t, WS_WMIX), 0, 0, scr, r, F.lane); continue; } r -= I_MIX;
        if (r < I_GATE) { transpose_item(win + 5656, IN_COLS, 1024, 96, WSP(bf16_t, WS_WGATE), 0, 0, scr, r, F.lane); continue; } r -= I_GATE;
        if (r < 3 * I_BR) { const int n = r / I_BR; transpose_item(INP(I_W_BRANCH) + ((size_t)l * 3 + n) * 512 * 1024, 1024, 512, 32, WSP(bf16_t, WS_WBT) + (size_t)n * 1024 * 512, 0, 0, scr, r % I_BR, F.lane); continue; } r -= 3 * I_BR;
        transpose_item(INP(I_W_OUT) + (size_t)l * 1024 * 1024, 1024, 1024, 32, WSP(bf16_t, WS_WOT), 0, 0, scr, r, F.lane);
    }
}
__device__ __forceinline__ void convert_expert_weights(Frame& F, int l) {
    LAS float* scr = (LAS float*)(F.lds + F.wave * 16384);
    const int gw = F.bid * NWAVES + F.wave, NGW = F.G * NWAVES;
    constexpr int I_G = 16 * 8, I_D = 4 * 32, PER = 2 * I_G + I_D;
    for (int it = gw; it < 32 * PER; it += NGW) {
        const int e = it / PER; int r = it % PER;
        bf16_t* w1t = WSP(bf16_t, WS_W1T) + (size_t)e * 512 * 1024; bf16_t* w2t = WSP(bf16_t, WS_W2T) + (size_t)e * 1024 * 256;
        if (r < I_G) { transpose_item(INP(I_EW_GATE) + ((size_t)l * 32 + e) * 1024 * 256, 256, 1024, 8, w1t, 0, 1, scr, r, F.lane); continue; } r -= I_G;
        if (r < I_G) { transpose_item(INP(I_EW_UP) + ((size_t)l * 32 + e) * 1024 * 256, 256, 1024, 8, w1t, 0, 2, scr, r, F.lane); continue; } r -= I_G;
        transpose_item(INP(I_EW_DOWN) + ((size_t)l * 32 + e) * 256 * 1024, 1024, 256, 32, w2t, 0, 0, scr, r, F.lane);
    }
}

#define OUTP ((float*)F.out)
__device__ __forceinline__ float* hrow(Frame& F, int r) { return r < NREAL ? OUTP + (size_t)r * D : WSP(float, WS_HMETA) + (size_t)(r - NREAL) * D; }

__device__ __forceinline__ void load_row16(const float* p, int lane, float (&x)[16]) {
#pragma unroll
    for (int j = 0; j < 4; ++j) { const f32x4 v = *((const f32x4*)p + lane + 64 * j); x[4 * j] = v[0]; x[4 * j + 1] = v[1]; x[4 * j + 2] = v[2]; x[4 * j + 3] = v[3]; }
}
__device__ __forceinline__ void add_bf16_row16(const bf16_t* p, int lane, float (&x)[16]) {
#pragma unroll
    for (int j = 0; j < 4; ++j) { const u32x2 w = *((const u32x2*)p + lane + 64 * j); x[4 * j] += bflo(w.x); x[4 * j + 1] += bfhi(w.x); x[4 * j + 2] += bflo(w.y); x[4 * j + 3] += bfhi(w.y); }
}
__device__ __forceinline__ void store_row16(float* p, int lane, const float (&x)[16]) {
#pragma unroll
    for (int j = 0; j < 4; ++j) *((f32x4*)p + lane + 64 * j) = (f32x4){x[4 * j], x[4 * j + 1], x[4 * j + 2], x[4 * j + 3]};
}
__device__ __forceinline__ void store_bf16_row16(bf16_t* p, int lane, const float (&x)[16]) {
#pragma unroll
    for (int j = 0; j < 4; ++j) { u32x2 w; w.x = pk2(x[4 * j], x[4 * j + 1]); w.y = pk2(x[4 * j + 2], x[4 * j + 3]); *((u32x2*)p + lane + 64 * j) = w; }
}
__device__ __forceinline__ void fetch_h_row(Frame& F, int l, int r, float (&x)[16]) {
    if (l == 0) {
        const float* src = r < NREAL ? INP(I_X) + (size_t)r * D : INP(I_META) + (size_t)(r - META_ROW0) * D;
        load_row16(src, F.lane, x);
    } else {
        load_row16(hrow(F, r), F.lane, x);
        const unsigned* tok = WSP(unsigned, SM_TOK) + (size_t)r * 8;
        const unsigned g0 = tok[6], g1 = tok[7];
        add_bf16_row16(WSP(bf16_t, WS_Y2) + (size_t)g0 * 1024, F.lane, x);
        add_bf16_row16(WSP(bf16_t, WS_Y2) + (size_t)g1 * 1024, F.lane, x);
    }
}

__device__ __forceinline__ void phase_norm1(Frame& F, int l) {
    convert_layer_weights(F, l);
    __syncthreads();
    LAS float* sw = (LAS float*)F.lds;
    { const float* src = WSP(float, SM_SW1) + (size_t)l * 24 * 1024; for (int i = F.tid; i < 24 * 1024 / 4; i += NTHREADS) ((LAS f32x4*)sw)[i] = ((const f32x4*)src)[i]; }
    __syncthreads();
    const int gw = F.bid * NWAVES + F.wave, NGW = F.G * NWAVES, lane = F.lane;
    const float* nw = INP(I_NORM_MIX) + (size_t)l * D;
    float wv[16]; load_row16(nw, lane, wv);
    bf16_t* U = WSP(bf16_t, WS_U);
    const float alog_l = (lane >= 20 && lane < 24) ? INP(I_GDN_ALOG)[l * 4 + (lane - 20)] : 0.f, dt_l = (lane >= 20 && lane < 24) ? INP(I_GDN_DT)[l * 4 + (lane - 20)] : 0.f;
    const float nega_l = -expf(alog_l);
    for (int g = gw; g < MROWS / 4; g += NGW) {
        const int r0 = 4 * g;
        if (!row_valid(r0)) {
            float z[16];
#pragma unroll
            for (int j = 0; j < 16; ++j) z[j] = 0.f;
#pragma unroll
            for (int i = 0; i < 4; ++i) { store_bf16_row16(U + (size_t)(r0 + i) * D, lane, z); if (l == 0) store_row16(hrow(F, r0 + i), lane, z);
                if (lane < 16) WSP(float, SM_GK)[(size_t)(r0 + i) * 16 + lane] = 0.f;
                else if (lane < 20) WSP(float, SM_BETA)[(size_t)(r0 + i) * 4 + (lane - 16)] = 0.f;
                else if (lane < 24) WSP(float, SM_LOGA)[(size_t)(r0 + i) * 4 + (lane - 20)] = 0.f; }
            continue;
        }
        float x[4][16];
#pragma unroll
        for (int i = 0; i < 4; ++i) {
            fetch_h_row(F, l, r0 + i, x[i]);
            store_row16(hrow(F, r0 + i), lane, x[i]);
            float ss = 0.f;
#pragma unroll
            for (int j = 0; j < 16; ++j) ss += x[i][j] * x[i][j];
            const float rstd = rsqrtf(wave_sum(ss) * (1.0f / D) + 1e-6f);
#pragma unroll
            for (int j = 0; j < 16; ++j) x[i][j] = x[i][j] * rstd * wv[j];
            store_bf16_row16(U + (size_t)(r0 + i) * D, lane, x[i]);
        }
        float ov[4] = {0.f, 0.f, 0.f, 0.f};
#pragma unroll 2
        for (int c = 0; c < 24; ++c) {
            float a0 = 0.f, a1 = 0.f, a2 = 0.f, a3 = 0.f;
#pragma unroll
            for (int j = 0; j < 4; ++j) { const f32x4 w = *((const LAS f32x4*)(sw + c * 1024) + lane + 64 * j);
#pragma unroll
                for (int e = 0; e < 4; ++e) { a0 += x[0][4 * j + e] * w[e]; a1 += x[1][4 * j + e] * w[e]; a2 += x[2][4 * j + e] * w[e]; a3 += x[3][4 * j + e] * w[e]; } }
            a0 = wave_sum(a0); a1 = wave_sum(a1); a2 = wave_sum(a2); a3 = wave_sum(a3);
            if (lane == c) { ov[0] = a0; ov[1] = a1; ov[2] = a2; ov[3] = a3; }
        }
        float* GK = WSP(float, SM_GK); float* BETA = WSP(float, SM_BETA); float* LOGA = WSP(float, SM_LOGA);
#pragma unroll
        for (int i = 0; i < 4; ++i) {
            const float v = ov[i]; const int r = r0 + i;
            if (lane < 16) GK[(size_t)r * 16 + lane] = v;
            else if (lane < 20) BETA[(size_t)r * 4 + (lane - 16)] = sigmoidf_(v);
            else if (lane < 24) { const int h = lane - 20; LOGA[(size_t)r * 4 + h] = nega_l * softplusf_(v + dt_l); }
        }
    }
}

__device__ __forceinline__ bf16x8 mk8(u32x4 w) { return __builtin_bit_cast(bf16x8, w); }
__device__ __forceinline__ bf16x8 mk8(u32x2 lo, u32x2 hi) { u32x4 w; w.x = lo.x; w.y = lo.y; w.z = hi.x; w.w = hi.y; return __builtin_bit_cast(bf16x8, w); }
__device__ __forceinline__ bf16x8 pack_acc2(const f32x4& a, const f32x4& b) { u32x4 w; w.x = pk2(a[0], a[1]); w.y = pk2(a[2], a[3]); w.z = pk2(b[0], b[1]); w.w = pk2(b[2], b[3]); return __builtin_bit_cast(bf16x8, w); }
#define MFMA16(a, b, c) __builtin_amdgcn_mfma_f32_16x16x32_bf16((a), (b), (c), 0, 0, 0)

__device__ __forceinline__ int permpos(int k) { const int kk = k & 31; return (k & ~31) + ((kk & 16) ? 8 * ((kk - 16) >> 2) + 4 + (kk & 3) : 8 * (kk >> 2) + (kk & 3)); }
__device__ __forceinline__ float ldbf(GAS const bf16_t* p) { return bf2f(*p); }
#define ROWB(P, row, col) ((GAS const char*)(P) + ((size_t)(row) * LDP + (col)) * 2)
__device__ __forceinline__ float ldrow(GAS const char* rb, unsigned voff) { return bf2f(*(GAS const bf16_t*)(rb + voff)); }
__device__ __forceinline__ unsigned ldrow_u(GAS const char* rb, unsigned voff) { return (unsigned)*(GAS const bf16_t*)(rb + voff); }
__device__ __forceinline__ void strow(GAS const char* rb, unsigned voff, bf16_t v) { *(GAS bf16_t*)(rb + voff) = v; }

template <int DK, bool IS_A>
__device__ __forceinline__ void prep_gla(Frame& F, int l, int ug) {
    constexpr int QP = DK + 8, VP = 136, SUB = 2 * 64 * QP * 2 + 1024 + 4096 + 64 * VP * 2;
    PROF_MARK(F, IS_A ? 7 : 8);
    int tid = F.tid; asm volatile("" : "+v"(tid));
    const int sg = __builtin_amdgcn_readfirstlane(tid >> 8), lt = tid & 255, c = lt & 127, hf = __builtin_amdgcn_readfirstlane(lt >> 7);
    const int unit = 2 * ug + sg, slot = unit >> 2, h = unit & 3, row0 = slot * 64, r0 = row0 + 32 * hf;
    const int qcol = IS_A ? PC_AQ + h * 128 : PC_CQ + h * 64, kcol = IS_A ? PC_AF + h * 128 : PC_CK + h * 64, vcol = IS_A ? PC_AI + h * 128 : PC_CV + h * 128;
    bf16_t* P = WSP(bf16_t, WS_P);
    LAS bf16_t* qt = (LAS bf16_t*)(F.lds + sg * SUB);
    LAS bf16_t* kt = qt + 64 * QP;
    LAS float* tot = (LAS float*)(kt + 64 * QP);
    const bool act = c < DK;
    LAS bf16_t* rv = (LAS bf16_t*)(tot + 256 + 1024);
    { constexpr int PQ = DK / 8, PPR = 2 * PQ + 16;
        for (int idx = lt; idx < 64 * PPR; idx += 256) { const int row = idx / PPR, pc = idx % PPR;
            const int scol = pc < PQ ? qcol + 8 * pc : (pc < 2 * PQ ? kcol + 8 * (pc - PQ) : vcol + 8 * (pc - 2 * PQ));
            LAS bf16_t* dst = pc < PQ ? qt + row * QP + 8 * pc : (pc < 2 * PQ ? kt + row * QP + 8 * (pc - PQ) : rv + row * VP + 8 * (pc - 2 * PQ));
            *(LAS u32x4*)dst = *(const u32x4*)(P + (size_t)(row0 + row) * LDP + scol); } }
    if (!IS_A) { LAS float* gkl = tot + 256;
        ((LAS f32x4*)gkl)[lt] = ((const f32x4*)(WSP(float, SM_GK) + (size_t)row0 * 16))[lt]; }
    __syncthreads();
    float b[32];
    const unsigned vo = (unsigned)c * 2u, vop = (unsigned)permpos(c) * 2u;
    if (act) {
        float run = 0.f;
        if (IS_A) { const float* lab = WSP(float, SM_LAB) + l * 1024 + h * 128 + c; const float la = lab[0], lb = lab[512];
#pragma unroll
            for (int t = 0; t < 32; ++t) { run += pg8::lfg(la, lb, bf2f(kt[(32 * hf + t) * QP + c])); b[t] = run; }
        } else { float w2c[16]; const float* w2 = INP(I_GLA_W2) + (size_t)l * 16 * 256 + h * 64 + c; const float bias = INP(I_GLA_B)[l * 256 + h * 64 + c];
#pragma unroll
            for (int j = 0; j < 16; ++j) w2c[j] = w2[j * 256];
            const LAS float* gk = tot + 256 + 32 * hf * 16;
#pragma unroll
            for (int t = 0; t < 32; ++t) { float s = bias;
#pragma unroll
                for (int j = 0; j < 16; ++j) s += gk[t * 16 + j] * w2c[j];
                run += logsigf_(s) * (1.0f / 16.0f); b[t] = run; }
        }
        tot[hf * 128 + c] = run;
    }
    __syncthreads();
    PROF_MARKI(F, IS_A ? 25 : 15);
    unsigned q1p[16], k1p[16];
    if (act) {
        const float bm = tot[c], bl = bm + tot[128 + c], boff = hf ? bm : 0.f;
        if (hf == 0 && !F.dry) (IS_A ? WSP(float, SM_DECA) + (size_t)unit * 128 : WSP(float, SM_DECC) + (size_t)unit * 64)[c] = __expf(bl);
#pragma unroll
        for (int t2 = 0; t2 < 16; ++t2) { float q1v[2], k1v[2];
#pragma unroll
            for (int u = 0; u < 2; ++u) { const int t = 2 * t2 + u; const float bt = b[t] + boff;
                const float qr = bf2f(qt[(32 * hf + t) * QP + c]), q = IS_A ? siluf_(qr) * 0.08838834764831845f : qr * 0.125f;
                float k;
                if (IS_A) { const float lf = t == 0 ? b[0] : b[t] - b[t - 1]; k = row_valid(r0 + t) ? 1.0f - __expf(lf) : 0.f; } else k = bf2f(kt[(32 * hf + t) * QP + c]);
                q1v[u] = q * __expf(bt); k1v[u] = k * __expf(bl - bt);
                qt[(32 * hf + t) * QP + c] = f2bf(q * __expf(fminf(bt - bm, 80.f))); kt[(32 * hf + t) * QP + c] = f2bf(k * __expf(fminf(bm - bt, 80.f))); }
            q1p[t2] = pk2(q1v[0], q1v[1]); k1p[t2] = pk2(k1v[0], k1v[1]); }
    }
    __syncthreads();
    PROF_MARKI(F, IS_A ? 26 : 16);
    if (act) {
        if (!F.dry) {
#pragma unroll
        for (int t2 = 0; t2 < 16; ++t2) { strow(ROWB(P, r0 + 2 * t2, qcol), vop, (bf16_t)(q1p[t2] & 0xffffu)); strow(ROWB(P, r0 + 2 * t2 + 1, qcol), vop, (bf16_t)(q1p[t2] >> 16)); } }
        bf16_t* kd = (IS_A ? P + (size_t)(row0 + (c >> 1)) * LDP + kcol + (c & 1) * 64 : P + (size_t)(row0 + c) * LDP + kcol) + 32 * hf;
#pragma unroll
        for (int o = 0; o < 4; ++o) if (!F.dry) *(u32x4*)(kd + 8 * o) = (u32x4){k1p[4 * o], k1p[4 * o + 1], k1p[4 * o + 2], k1p[4 * o + 3]};
    }
    { const int ws = (tid >> 6) & 3, lane = tid & 63, fr = lane & 15, fq = lane >> 4;
        bf16_t* sc = (IS_A ? WSP(bf16_t, WS_SCA) : WSP(bf16_t, WS_SCC)) + (size_t)unit * 4096;
#pragma unroll
        for (int jt = 0; jt < 4; ++jt) { const int mt = ws, nt = jt; f32x4 acc = {0.f, 0.f, 0.f, 0.f};
            if (nt <= mt) {
#pragma unroll
                for (int ks = 0; ks < DK / 32; ++ks) { const bf16x8 a = *(const LAS bf16x8*)(qt + (16 * mt + fr) * QP + 32 * ks + 8 * fq), bb = *(const LAS bf16x8*)(kt + (16 * nt + fr) * QP + 32 * ks + 8 * fq); acc = MFMA16(a, bb, acc); } }
#pragma unroll
            for (int r = 0; r < 4; ++r) { const int t = 16 * mt + 4 * fq + r, s = 16 * nt + fr; if (!F.dry) sc[t * 64 + s] = (s <= t) ? f2bf(acc[r]) : (bf16_t)0; } }
    }
    PROF_MARKI(F, IS_A ? 27 : 17);
    { unsigned vp[16];
#pragma unroll
        for (int t2 = 0; t2 < 16; ++t2) { vp[t2] = (unsigned)rv[(32 * hf + 2 * t2) * VP + c] | ((unsigned)rv[(32 * hf + 2 * t2 + 1) * VP + c] << 16); }
        PROF_MARKI(F, IS_A ? 28 : 18);
        bf16_t* vd = P + (size_t)(row0 + (c >> 1)) * LDP + vcol + (c & 1) * 64 + 32 * hf;
#pragma unroll
        for (int o = 0; o < 4; ++o) if (!F.dry) *(u32x4*)(vd + 8 * o) = (u32x4){vp[4 * o], vp[4 * o + 1], vp[4 * o + 2], vp[4 * o + 3]}; }
    __syncthreads();
    PROF_MARK(F, IS_A ? 13 : 14);
}

__device__ __forceinline__ void prep_gdn(Frame& F, int l, int ug) {
    constexpr int NP = 136, SUB = 2 * 64 * NP * 2 + 64 * 68 * 4 + 1024 + 2304;
    PROF_MARK(F, 1);
    int tid = F.tid; asm volatile("" : "+v"(tid));
    const int lane = tid & 63, sg = __builtin_amdgcn_readfirstlane(tid >> 8), lt = tid & 255, unit = 2 * ug + sg, slot = unit >> 2, h = unit & 3, row0 = slot * 64;
    bf16_t* P = WSP(bf16_t, WS_P);
    LAS bf16_t* qs = (LAS bf16_t*)(F.lds + sg * SUB);
    LAS bf16_t* ks = qs + 64 * NP;
    LAS float* AT = (LAS float*)(F.lds + sg * SUB + 2 * 64 * NP * 2);
    LAS float* gs = AT + 64 * 68;
    if (lt < 64) { const int valid_u = 1; (void)valid_u; float g = WSP(float, SM_LOGA)[(size_t)(row0 + lt) * 4 + h];
#pragma unroll
        for (int o = 1; o < 64; o <<= 1) { const float t = __shfl_up(g, o); if (lane >= o) g += t; }
        gs[lt] = g; gs[64 + lt] = WSP(float, SM_BETA)[(size_t)(row0 + lt) * 4 + h];
        if (lt == 63 && !F.dry) WSP(float, SM_DECB)[unit] = __expf(g); }
    const int hslot = slot == 256 ? -1 : ((slot & 63) == 0 ? 256 : slot - 1);
    LAS bf16_t* rvs = (LAS bf16_t*)AT;
    LAS bf16_t* hl = (LAS bf16_t*)(gs + 256);
    for (int idx = lt; idx < 64 * 48; idx += 256) { const int row = idx / 48, pc = idx % 48, comp = pc >> 4, c8 = (pc & 15) * 8;
        const u32x4 v = *(const u32x4*)(P + (size_t)(row0 + row) * LDP + PC_BQKV + comp * 512 + h * 128 + c8);
        *(LAS u32x4*)((comp == 0 ? qs : (comp == 1 ? ks : rvs)) + row * NP + c8) = v; }
    if (lt < 144) { const int rr = lt / 48, pc = lt % 48, comp = pc >> 4, c8 = (pc & 15) * 8; u32x4 v = {0u, 0u, 0u, 0u};
        if (hslot >= 0) v = *(const u32x4*)(WSP(bf16_t, SM_HALO) + ((size_t)hslot * 3 + rr) * 1536 + comp * 512 + h * 128 + c8);
        *(LAS u32x4*)(hl + rr * 384 + comp * 128 + c8) = v; }
    __syncthreads();
    PROF_MARKG(F, 2);
    float col[64];
    {
        const int c = lt & 127;
#pragma unroll
        for (int pass = 0; pass < 2; ++pass) {
            if (pass == 1 && lt >= 128) break;
            const int comp = lt >= 128 ? 1 : (pass == 0 ? 0 : 2), ch = comp * 512 + h * 128 + c;
            const float w0 = INP(I_GDN_CONV)[((size_t)l * 4 + 0) * 1536 + ch], w1 = INP(I_GDN_CONV)[((size_t)l * 4 + 1) * 1536 + ch], w2 = INP(I_GDN_CONV)[((size_t)l * 4 + 2) * 1536 + ch], w3 = INP(I_GDN_CONV)[((size_t)l * 4 + 3) * 1536 + ch];
            LAS bf16_t* src = (comp == 0 ? qs : (comp == 1 ? ks : rvs)) + c;
            float x0 = bf2f(hl[comp * 128 + c]), x1 = bf2f(hl[384 + comp * 128 + c]), x2 = bf2f(hl[768 + comp * 128 + c]);
#pragma unroll
            for (int t = 0; t < 64; ++t) { const float x3 = bf2f(src[t * NP]); const float y = siluf_(w0 * x0 + w1 * x1 + w2 * x2 + w3 * x3); x0 = x1; x1 = x2; x2 = x3;
                if (comp == 0) src[t * NP] = f2bf(y); else { col[t] = y; if (comp == 1) src[t * NP] = f2bf(y); } }
        }
    }
    __syncthreads();
    PROF_MARKG(F, 3);
    const int wv = (tid >> 6) & 3, fr = lane & 15, fq = lane >> 4;
#pragma unroll
    for (int jt = 0; jt < 2; ++jt) { const int which = jt, mt = wv; const LAS bf16_t* ap = which ? qs : ks; f32x4 a4 = {0.f, 0.f, 0.f, 0.f};
#pragma unroll
        for (int k4 = 0; k4 < 4; ++k4) { const bf16x8 a = *(const LAS bf16x8*)(ap + (16 * mt + fr) * NP + 32 * k4 + 8 * fq); a4 = MFMA16(a, a, a4); }
#pragma unroll
        for (int r = 0; r < 4; ++r) if (4 * fq + r == fr) { if (which == 0) gs[128 + 16 * mt + fr] = rsqrtf(a4[r] + 1e-6f); else gs[192 + 16 * mt + fr] = rsqrtf(a4[r] + 1e-6f) * 0.08838834764831845f; } }
    __syncthreads();
    { bf16_t* qkd = WSP(bf16_t, WS_QKD) + (size_t)unit * 4096;
#pragma unroll
        for (int jt = 0; jt < 8; ++jt) { const int tile = wv * 8 + jt, which = tile >> 4, mt = (tile >> 2) & 3, nt = tile & 3;
            const LAS bf16_t* ap = which ? qs : ks; f32x4 a4 = {0.f, 0.f, 0.f, 0.f};
            if (nt <= mt) {
#pragma unroll
                for (int k4 = 0; k4 < 4; ++k4) { const bf16x8 a = *(const LAS bf16x8*)(ap + (16 * mt + fr) * NP + 32 * k4 + 8 * fq), bb = *(const LAS bf16x8*)(ks + (16 * nt + fr) * NP + 32 * k4 + 8 * fq); a4 = MFMA16(a, bb, a4); } }
#pragma unroll
            for (int r = 0; r < 4; ++r) { const int t = 16 * mt + 4 * fq + r, s = 16 * nt + fr; const float dec = __expf(fminf(gs[t] - gs[s], 0.f)) * gs[128 + s];
                if (which) { if (!F.dry) qkd[t * 64 + permpos(s)] = (s <= t) ? f2bf(a4[r] * dec * gs[192 + t]) : (bf16_t)0; }
                else AT[s * 68 + t] = (s < t) ? gs[64 + t] * gs[128 + t] * a4[r] * dec : 0.f; } }
    }
    PROF_MARKG(F, 4);
    if (lt >= 128) { const int d = lt - 128; const float gl = gs[63]; bf16_t* dst = WSP(bf16_t, WS_K1TB) + (size_t)unit * 8192 + d * 64;
#pragma unroll
        for (int o = 0; o < 8; ++o) { const int s0 = 32 * (o >> 2) + 4 * (o & 3); float y[8];
#pragma unroll
            for (int j = 0; j < 8; ++j) { const int s = s0 + (j & 3) + (j >> 2) * 16; y[j] = col[s] * gs[128 + s] * __expf(gl - gs[s]); }
            if (!F.dry) *(u32x4*)(dst + 8 * o) = (u32x4){pk2(y[0], y[1]), pk2(y[2], y[3]), pk2(y[4], y[5]), pk2(y[6], y[7])}; }
    } else { const int pp = permpos(lt);
#pragma unroll 8
        for (int t = 0; t < 64; ++t) if (!F.dry) P[(size_t)(row0 + t) * LDP + PC_BQKV + h * 128 + pp] = f2bf(bf2f(qs[t * NP + lt]) * gs[192 + t] * __expf(gs[t])); }
    __syncthreads();
    PROF_MARKG(F, 5);
#pragma unroll
    for (int i = 0; i < 64; ++i) col[i] *= lt < 128 ? gs[64 + i] : gs[64 + i] * gs[128 + i] * __expf(gs[i]);
#pragma unroll
    for (int j = 0; j < 63; ++j) { const float xj = col[j]; asm volatile("" ::: "memory");
#pragma unroll
        for (int q4 = (j + 1) >> 2; q4 < 16; ++q4) { const f32x4 a = *(const LAS f32x4*)(AT + j * 68 + 4 * q4);
#pragma unroll
            for (int e = 0; e < 4; ++e) if (4 * q4 + e > j) col[4 * q4 + e] -= a[e] * xj; } }
    PROF_MARKG(F, 6);
    int tid2 = F.tid; asm volatile("" : "+v"(tid2)); const int lt2 = tid2 & 255, unit2 = 2 * ug + __builtin_amdgcn_readfirstlane(tid2 >> 8), row02 = (unit2 >> 2) * 64, h2 = unit2 & 3;
    if (lt2 < 128) { bf16_t* dst = P + (size_t)(row02 + (lt2 >> 1)) * LDP + PC_BQKV + 1024 + h2 * 128 + (lt2 & 1) * 64;
#pragma unroll
        for (int o = 0; o < 8; ++o) if (!F.dry) *(u32x4*)(dst + 8 * o) = (u32x4){pk2(col[8 * o], col[8 * o + 1]), pk2(col[8 * o + 2], col[8 * o + 3]), pk2(col[8 * o + 4], col[8 * o + 5]), pk2(col[8 * o + 6], col[8 * o + 7])};
    } else { const int pp = permpos(lt2 - 128);
        if (!F.dry) {
#pragma unroll
        for (int t = 0; t < 64; ++t) strow(ROWB(P, row02 + t, PC_BQKV + 512 + h2 * 128), (unsigned)pp * 2u, f2bf(col[t])); } }
    __syncthreads();
    PROF_MARK(F, 9);
}

__device__ __forceinline__ void prep_set(Frame& F, int l, int set, int nblk, int bidx) {
    const int nsl = set == 0 ? 65 : 64, np = 2 * nsl;
    auto ug_of = [&](int vp) { int j = vp >> 1, slot; if (set == 0) { slot = j == 0 ? 256 : ((j - 1) >> 4) * 64 + ((j - 1) & 15); } else slot = (j >> 4) * 64 + 16 * set + (j & 15); return 2 * slot + (vp & 1); };
    auto first_of = [&](int base) { int r = (bidx - base) % nblk; if (r < 0) r += nblk; return base + r; };
    if (nblk < 2 * np) {
        if (bidx < np) { prep_gdn(F, l, ug_of(bidx)); prep_gla<64, false>(F, l, ug_of(bidx)); }
        else { const int nr = nblk - np; for (int i = bidx - np; i < np; i += nr) prep_gla<128, true>(F, l, ug_of(i)); }
        return; }
    for (int i = first_of(0); i < np; i += nblk) prep_gdn(F, l, ug_of(i));
    for (int i = first_of(np); i < 2 * np; i += nblk) prep_gla<128, true>(F, l, ug_of(i - np));
    for (int i = first_of(2 * np); i < 3 * np; i += nblk) prep_gla<64, false>(F, l, ug_of(i - 2 * np));
}
constexpr int SCAN_BUF = 57344;
template <int MX> struct ScanCfg;
template <> struct ScanCfg<0> { static constexpr int NM = 3, NI = 5; static constexpr int off(int m) { return m == 0 ? 0 : (m == 1 ? 16384 : 32768); } static constexpr int pitch(int m) { return m == 0 ? 256 : 128; } };
template <> struct ScanCfg<1> { static constexpr int NM = 4, NI = 7; static constexpr int off(int m) { return 16384 * m; } static constexpr int pitch(int m) { return m < 2 ? 256 : 128; } };
template <> struct ScanCfg<2> { static constexpr int NM = 3, NI = 3; static constexpr int off(int m) { return 8192 * m; } static constexpr int pitch(int m) { return 128; } };

#define SCAN_GRID_BARRIER() do { xcd_barrier(WSP(unsigned, WS_CTL) + CW_BAR, xb_xcc_id(), (volatile LAS unsigned*)(F.lds + LDS_MISC) + 8, F.tid, (unsigned)F.G); asm volatile("" ::: "memory"); } while (0)
template <int MX>
__device__ __forceinline__ void scan_mixer(Frame& F, int b, int h) {
    typedef ScanCfg<MX> C;
    constexpr int DK = MX == 2 ? 64 : 128, NT = DK / 16, NI = C::NI;
    const int w = F.wave, lane = F.lane, fr = lane & 15, fq = lane >> 4, ecol = 16 * w + fr;
    const char* Pb = (const char*)WSP(bf16_t, WS_P);
    const int qcol = MX == 0 ? PC_AQ + h * 128 : (MX == 1 ? PC_BQKV + h * 128 : PC_CQ + h * 64);
    const int kcol = MX == 0 ? PC_AF + h * 128 : (MX == 1 ? PC_BQKV + 512 + h * 128 : PC_CK + h * 64);
    const int vcol = MX == 0 ? PC_AI + h * 128 : (MX == 1 ? PC_BQKV + 1024 + h * 128 : PC_CV + h * 128);
    const char* SCb = (const char*)(MX == 0 ? WSP(bf16_t, WS_SCA) : (MX == 1 ? WSP(bf16_t, WS_QKD) : WSP(bf16_t, WS_SCC)));
    bf16_t* O = WSP(bf16_t, WS_O) + (size_t)MX * MROWS * 512;
    unsigned voff[NI]; int mi[NI];
#pragma unroll
    for (int i = 0; i < NI; ++i) { const int n = w + 8 * i, o = 1024 * n + 16 * lane; int m = 0;
#pragma unroll
        for (int q = 1; q < C::NM; ++q) if (o >= C::off(q)) m = q;
        int ro = o, pitch = 128;
#pragma unroll
        for (int q = 0; q < C::NM; ++q) if (m == q) { ro = o - C::off(q); pitch = C::pitch(q); }
        const int r = ro / pitch, pos = (ro % pitch) >> 4, pc = pos ^ (pitch == 256 ? (r & 15) : ((r >> 1) & 7));
        const bool packed = (MX == 0 && m == 1);
        const bool inP = (MX == 1) ? (m < 2) : (m < 2);
        voff[i] = (unsigned)(inP ? (packed ? (r >> 1) * (LDP * 2) + (r & 1) * 128 : r * (LDP * 2)) : r * pitch) + 16u * pc; mi[i] = m; }
    const unsigned x256_0 = (unsigned)(((0 | fq) ^ fr) << 4), x256_1 = (unsigned)(((4 | fq) ^ fr) << 4), x256_2 = (unsigned)(((8 | fq) ^ fr) << 4), x256_3 = (unsigned)(((12 | fq) ^ fr) << 4);
    const unsigned x128_0 = (unsigned)(((0 | fq) ^ ((fr >> 1) & 7)) << 4), x128_1 = (unsigned)(((4 | fq) ^ ((fr >> 1) & 7)) << 4);
    const unsigned x256[4] = {x256_0, x256_1, x256_2, x256_3}, x128[2] = {x128_0, x128_1};
#define SC_FRAG(buf, m, rt, kp) (*(const LAS bf16x8*)(F.lds + (buf) + C::off(m) + (16 * (rt) + fr) * C::pitch(m) + (C::pitch(m) == 256 ? x256[kp] : x128[(kp) & 1])))
    auto slot_of = [&](int step) { return step == 0 ? 256 : b * 64 + step - 1; };
    auto issue = [&](int step, int buf) {
        const int slot = slot_of(step), row0 = slot * 64, unit = slot * 4 + h;
        const char* base[4];
        if (MX == 1) { base[0] = Pb + ((size_t)row0 * LDP + kcol) * 2; base[1] = Pb + ((size_t)row0 * LDP + qcol) * 2; base[2] = (const char*)WSP(bf16_t, WS_K1TB) + (size_t)unit * 16384; base[3] = SCb + (size_t)unit * 8192; }
        else { base[0] = Pb + ((size_t)row0 * LDP + qcol) * 2; base[1] = Pb + ((size_t)row0 * LDP + kcol) * 2; base[2] = SCb + (size_t)unit * 8192; base[3] = base[2]; }
#pragma unroll
        for (int i = 0; i < NI; ++i) { const char* bs = mi[i] == 0 ? base[0] : (mi[i] == 1 ? base[1] : (mi[i] == 2 ? base[2] : base[3]));
            __builtin_amdgcn_global_load_lds((const unsigned*)(bs + voff[i]), (LAS unsigned*)(F.lds + buf + 1024 * (w + 8 * i)), 16, 0, 0); }
    };
    auto load_priv = [&](int step, u32x4 (&pv)[2]) {
        const int row0 = slot_of(step) * 64;
        const bf16_t* vt = (const bf16_t*)Pb + (size_t)(row0 + (ecol >> 1)) * LDP + vcol + (ecol & 1) * 64;
        if (MX == 1) { const u32x2 a = *(const u32x2*)(vt + 4 * fq), c = *(const u32x2*)(vt + 16 + 4 * fq), d = *(const u32x2*)(vt + 32 + 4 * fq), e = *(const u32x2*)(vt + 48 + 4 * fq);
            pv[0] = (u32x4){a.x, a.y, c.x, c.y}; pv[1] = (u32x4){d.x, d.y, e.x, e.y}; }
        else { pv[0] = *(const u32x4*)(vt + 8 * fq); pv[1] = *(const u32x4*)(vt + 32 + 8 * fq); }
    };
    f32x4 S[NT];
#pragma unroll
    for (int i = 0; i < NT; ++i) S[i] = (f32x4){0.f, 0.f, 0.f, 0.f};
    u32x4 pcur[2], pnxt[2];
    auto first_of_set = [](int s) { return s == 17 || s == 33 || s == 49; };
    issue(0, 0); load_priv(0, pcur);
    for (int step = 0; step < 65; ++step) {
        const int buf = (step & 1) * SCAN_BUF, slot = slot_of(step), row0 = slot * 64, unit = slot * 4 + h;
        if (first_of_set(step)) { PROF_MARK(F, 20); SCAN_GRID_BARRIER(); PROF_MARK(F, 21); issue(step, buf); load_priv(step, pcur); }
        asm volatile("s_waitcnt vmcnt(0)" ::: "memory");
        __syncthreads();
        if (step + 1 < 65 && !first_of_set(step + 1)) { issue(step + 1, SCAN_BUF - buf); load_priv(step + 1, pnxt); }
        bf16x8 Sb[NT / 2];
#pragma unroll
        for (int kp = 0; kp < NT / 2; ++kp) Sb[kp] = pack_acc2(S[2 * kp], S[2 * kp + 1]);
        if (MX == 1) {
            f32x4 vn[4];
#pragma unroll
            for (int mt = 0; mt < 4; ++mt) { f32x4 acc = {0.f, 0.f, 0.f, 0.f};
#pragma unroll
                for (int kp = 0; kp < 4; ++kp) acc = MFMA16(SC_FRAG(buf, 0, mt, kp), Sb[kp], acc);
                const unsigned u0 = mt == 0 ? pcur[0].x : (mt == 1 ? pcur[0].z : (mt == 2 ? pcur[1].x : pcur[1].z)), u1 = mt == 0 ? pcur[0].y : (mt == 1 ? pcur[0].w : (mt == 2 ? pcur[1].y : pcur[1].w));
                vn[mt] = (f32x4){bflo(u0) - acc[0], bfhi(u0) - acc[1], bflo(u1) - acc[2], bfhi(u1) - acc[3]}; }
            bf16x8 Vb[2]; Vb[0] = pack_acc2(vn[0], vn[1]); Vb[1] = pack_acc2(vn[2], vn[3]);
#pragma unroll
            for (int mt = 0; mt < 4; ++mt) { f32x4 acc = {0.f, 0.f, 0.f, 0.f};
#pragma unroll
                for (int kp = 0; kp < 4; ++kp) acc = MFMA16(SC_FRAG(buf, 1, mt, kp), Sb[kp], acc);
#pragma unroll
                for (int kp = 0; kp < 2; ++kp) acc = MFMA16(SC_FRAG(buf, 3, mt, kp), Vb[kp], acc);
#pragma unroll
                for (int r = 0; r < 4; ++r) O[(size_t)(row0 + 16 * mt + 4 * fq + r) * 512 + h * 128 + ecol] = f2bf(acc[r]); }
            const float a = WSP(float, SM_DECB)[unit];
#pragma unroll
            for (int i = 0; i < 8; ++i) { S[i] = S[i] * a;
#pragma unroll
                for (int kp = 0; kp < 2; ++kp) S[i] = MFMA16(SC_FRAG(buf, 2, i, kp), Vb[kp], S[i]); }
        } else {
            const bf16x8 bv0 = mk8(pcur[0]), bv1 = mk8(pcur[1]);
#pragma unroll
            for (int mt = 0; mt < 4; ++mt) { f32x4 acc = {0.f, 0.f, 0.f, 0.f};
#pragma unroll
                for (int kp = 0; kp < NT / 2; ++kp) acc = MFMA16(SC_FRAG(buf, 0, mt, kp), Sb[kp], acc);
                acc = MFMA16(SC_FRAG(buf, 2, mt, 0), bv0, acc); acc = MFMA16(SC_FRAG(buf, 2, mt, 1), bv1, acc);
#pragma unroll
                for (int r = 0; r < 4; ++r) O[(size_t)(row0 + 16 * mt + 4 * fq + r) * 512 + h * 128 + ecol] = f2bf(acc[r]); }
            const float* dec = (MX == 0 ? WSP(float, SM_DECA) : WSP(float, SM_DECC)) + (size_t)unit * DK;
#pragma unroll
            for (int i = 0; i < NT; ++i) { const f32x4 d4 = *(const f32x4*)(dec + 16 * i + 4 * fq); S[i] = S[i] * d4;
                S[i] = MFMA16(SC_FRAG(buf, 1, i, 0), bv0, S[i]); S[i] = MFMA16(SC_FRAG(buf, 1, i, 1), bv1, S[i]); }
        }
        pcur[0] = pnxt[0]; pcur[1] = pnxt[1];
    }
#undef SC_FRAG
    asm volatile("s_waitcnt vmcnt(0)" ::: "memory");
    __syncthreads();
    PROF_MARK(F, 22);
}
__device__ __forceinline__ void phase_scan(Frame& F, int l) {
#if PROF_ON
    if (F.bid >= 48) { for (int k = 1; k < 4; ++k) { PROF_MARK(F, 10); prep_set(F, l, k, F.G - 48, F.bid - 48); PROF_MARK(F, 11); SCAN_GRID_BARRIER(); PROF_MARK(F, 12); } return; }
#else
    if (F.bid >= 48) { for (int k = 1; k < 4; ++k) { prep_set(F, l, k, F.G - 48, F.bid - 48); SCAN_GRID_BARRIER(); } return; }
#endif
    const int mixer = F.bid >> 4, b = (F.bid >> 2) & 3, h = F.bid & 3;
    if (mixer == 0) scan_mixer<0>(F, b, h);
    else if (mixer == 1) scan_mixer<1>(F, b, h);
    else scan_mixer<2>(F, b, h);
}

template <int KIND>
__device__ __forceinline__ void meta_gemm(Frame& F, const bf16_t* A, const bf16_t* Bt, int N, int K, int n) {
    const int gw = F.bid * NWAVES + F.wave, NGW = F.G * NWAVES, lane = F.lane, fr = lane & 15, fq = lane >> 4;
    for (int tile = gw; tile < N / 16; tile += NGW) {
        const bf16_t* ar = A + (size_t)fr * K + 8 * fq; const bf16_t* br = Bt + (size_t)(16 * tile + fr) * K + 8 * fq;
        f32x4 acc = {0.f, 0.f, 0.f, 0.f};
#pragma unroll 8
        for (int ks = 0; ks < K / 32; ++ks) acc = MFMA16(mk8(*(const u32x4*)(ar + 32 * ks)), mk8(*(const u32x4*)(br + 32 * ks)), acc);
#pragma unroll
        for (int r = 0; r < 4; ++r) { const int row = META_ROW0 + 4 * fq + r, col = 16 * tile + fr;
            if (KIND == 0) WSP(bf16_t, WS_GT)[(size_t)row * 3072 + col] = f2bf(sigmoidf_(acc[r]));
            else if (KIND == 1) { bf16_t* mp = WSP(bf16_t, WS_MERGED) + (size_t)row * 1024 + col; const float g = bf2f(WSP(bf16_t, WS_GT)[(size_t)row * 3072 + n * 1024 + col]);
                *mp = f2bf((n ? bf2f(*mp) : 0.f) + g * acc[r]); }
            else { float* hp = WSP(float, WS_HMETA) + (size_t)(row - NREAL) * D + col; *hp = *hp + acc[r]; } }
    }
}

__device__ __forceinline__ void phase_hnorm(Frame& F, int l) {
    const int gw = F.bid * NWAVES + F.wave, NGW = F.G * NWAVES, lane = F.lane;
    const bf16_t* P = WSP(bf16_t, WS_P);
    LAS float* nws = (LAS float*)F.lds;
    if (F.tid < 384) { const int mxw = F.tid >> 7; const float* src = mxw == 0 ? INP(I_HGRN_NORM) : (mxw == 1 ? INP(I_GDN_NORM) : INP(I_GLA_NORM)); nws[F.tid] = src[(size_t)l * 128 + (F.tid & 127)]; }
    __syncthreads();
    for (int r = gw; r < MROWS; r += NGW) {
        bf16_t* op0 = WSP(bf16_t, WS_O) + (size_t)r * 512 + 8 * lane;
        if (!row_valid(r)) { if (!F.dry) {
#pragma unroll
            for (int mx = 0; mx < 3; ++mx) *(u32x4*)(op0 + (size_t)mx * MROWS * 512) = (u32x4){0u, 0u, 0u, 0u}; } continue; }
        u32x4 ow[3], gv[3];
#pragma unroll
        for (int mx = 0; mx < 3; ++mx) { ow[mx] = *(const u32x4*)(op0 + (size_t)mx * MROWS * 512); gv[mx] = *(const u32x4*)(P + (size_t)r * LDP + (mx == 0 ? PC_AG : (mx == 1 ? PC_BG : PC_CG)) + 8 * lane); }
#pragma unroll
        for (int mx = 0; mx < 3; ++mx) {
            const LAS float* nw = nws + mx * 128 + (8 * lane & 127);
            float o[8] = {bflo(ow[mx].x), bfhi(ow[mx].x), bflo(ow[mx].y), bfhi(ow[mx].y), bflo(ow[mx].z), bfhi(ow[mx].z), bflo(ow[mx].w), bfhi(ow[mx].w)};
            const float g[8] = {siluf_(bflo(gv[mx].x)), siluf_(bfhi(gv[mx].x)), siluf_(bflo(gv[mx].y)), siluf_(bfhi(gv[mx].y)), siluf_(bflo(gv[mx].z)), siluf_(bfhi(gv[mx].z)), siluf_(bflo(gv[mx].w)), siluf_(bfhi(gv[mx].w))};
            float ss = 0.f;
#pragma unroll
            for (int j = 0; j < 8; ++j) ss += o[j] * o[j];
            ss += __shfl_xor(ss, 1); ss += __shfl_xor(ss, 2); ss += __shfl_xor(ss, 4); ss += __shfl_xor(ss, 8);
            const float rstd = rsqrtf(ss * (1.0f / 128.0f) + 1e-6f);
            const f32x4 n0 = *(const LAS f32x4*)nw, n1 = *(const LAS f32x4*)(nw + 4);
            const float nv[8] = {n0[0], n0[1], n0[2], n0[3], n1[0], n1[1], n1[2], n1[3]};
#pragma unroll
            for (int j = 0; j < 8; ++j) o[j] = o[j] * rstd * nv[j] * g[j];
            u32x4 y; y.x = pk2(o[0], o[1]); y.y = pk2(o[2], o[3]); y.z = pk2(o[4], o[5]); y.w = pk2(o[6], o[7]);
            if (!F.dry) *(u32x4*)(op0 + (size_t)mx * MROWS * 512) = y;
        }
    }
}

__device__ __forceinline__ void phase_norm2(Frame& F, int l) {
    if (!F.dry) convert_expert_weights(F, l);
    __syncthreads();
    LAS float* sw = (LAS float*)F.lds;
    { const float* src = WSP(float, SM_RWE) + (size_t)l * 32 * 1024; for (int i = F.tid; i < 32 * 1024 / 4; i += NTHREADS) ((LAS f32x4*)sw)[i] = ((const f32x4*)src)[i]; }
    LAS float* rbias = sw + 32 * 1024;
    if (F.tid < 32) rbias[F.tid] = INP(I_RE_B)[l * 32 + F.tid]; else if (F.tid < 36) rbias[F.tid] = INP(I_RG_B)[l * 4 + (F.tid - 32)];
    __syncthreads();
    const int gw = F.bid * NWAVES + F.wave, NGW = F.G * NWAVES, lane = F.lane;
    float wv[16]; load_row16(INP(I_NORM_FFN) + (size_t)l * D, lane, wv);
    bf16_t* U = WSP(bf16_t, WS_U);
    const float* rwg = WSP(float, SM_RWG) + (size_t)l * 4 * 1024;
    unsigned* cnt = WSP(unsigned, WS_CTL) + CW_CNT + l * 64;
    LAS unsigned* lcnt = (LAS unsigned*)(F.lds + LDS_TAB);
    if (F.tid < 64) lcnt[F.tid] = 0u;
    __syncthreads();
    for (int g = gw; g < MROWS / 4; g += NGW) {
        const int r0 = 4 * g;
        if (!row_valid(r0)) continue;
        float x[4][16];
#pragma unroll
        for (int i = 0; i < 4; ++i) {
            load_row16(hrow(F, r0 + i), lane, x[i]);
            float ss = 0.f;
#pragma unroll
            for (int j = 0; j < 16; ++j) ss += x[i][j] * x[i][j];
            const float rstd = rsqrtf(wave_sum(ss) * (1.0f / D) + 1e-6f);
#pragma unroll
            for (int j = 0; j < 16; ++j) x[i][j] = x[i][j] * rstd * wv[j];
            if (!F.dry) store_bf16_row16(U + (size_t)(r0 + i) * D, lane, x[i]);
        }
#ifndef NORM2_SKIP
#define NORM2_SKIP 0
#endif
        if (F.dry && (NORM2_SKIP & 4)) continue;
        float lg[4][4];
#pragma unroll
        for (int c = 0; c < 4; ++c) {
            float a0 = 0.f, a1 = 0.f, a2 = 0.f, a3 = 0.f;
#pragma unroll
            for (int j = 0; j < 4; ++j) { const f32x4 w = *((const f32x4*)(rwg + c * 1024) + lane + 64 * j);
#pragma unroll
                for (int e = 0; e < 4; ++e) { a0 += x[0][4 * j + e] * w[e]; a1 += x[1][4 * j + e] * w[e]; a2 += x[2][4 * j + e] * w[e]; a3 += x[3][4 * j + e] * w[e]; } }
            const float bg = rbias[32 + c];
            lg[0][c] = wave_sum(a0) + bg; lg[1][c] = wave_sum(a1) + bg; lg[2][c] = wave_sum(a2) + bg; lg[3][c] = wave_sum(a3) + bg;
        }
#pragma unroll
        for (int i = 0; i < 4; ++i) {
            int gi = 0; float gm = lg[i][0];
#pragma unroll
            for (int c = 1; c < 4; ++c) if (lg[i][c] > gm) { gm = lg[i][c]; gi = c; }
            float gsum = 0.f;
#pragma unroll
            for (int c = 0; c < 4; ++c) gsum += __expf(lg[i][c] - gm);
            const float gval = 1.0f / gsum;
            gi = __builtin_amdgcn_readfirstlane(gi);
            int ea = 0, eb = 0; float la = -3.0e38f, lb = -3.0e38f;
            const LAS float* swg = sw + gi * 8 * 1024;
#pragma unroll 1
            for (int cb = 0; cb < ((F.dry && (NORM2_SKIP & 2)) ? 0 : 8); cb += 4) {
                float a0 = 0.f, a1 = 0.f, a2 = 0.f, a3 = 0.f;
#pragma unroll
                for (int j = 0; j < 4; ++j) { const f32x4 w0 = *((const LAS f32x4*)(swg + (cb + 0) * 1024) + lane + 64 * j), w1 = *((const LAS f32x4*)(swg + (cb + 1) * 1024) + lane + 64 * j), w2 = *((const LAS f32x4*)(swg + (cb + 2) * 1024) + lane + 64 * j), w3 = *((const LAS f32x4*)(swg + (cb + 3) * 1024) + lane + 64 * j);
#pragma unroll
                    for (int e = 0; e < 4; ++e) { const float xv = x[i][4 * j + e]; a0 += xv * w0[e]; a1 += xv * w1[e]; a2 += xv * w2[e]; a3 += xv * w3[e]; } }
                const float e0 = wave_sum(a0) + rbias[gi * 8 + cb], e1 = wave_sum(a1) + rbias[gi * 8 + cb + 1], e2 = wave_sum(a2) + rbias[gi * 8 + cb + 2], e3 = wave_sum(a3) + rbias[gi * 8 + cb + 3];
                const float ev[4] = {e0, e1, e2, e3};
#pragma unroll
                for (int q = 0; q < 4; ++q) { const float el = ev[q]; const int c = cb + q; if (el > la) { lb = la; eb = ea; la = el; ea = c; } else if (el > lb) { lb = el; eb = c; } }
            }
            const float wa = 1.0f / (1.0f + __expf(lb - la)), wb = 1.0f - wa;
            if (lane == 0 && !F.dry) {
                const unsigned e0 = (unsigned)(gi * 8 + ea), e1 = (unsigned)(gi * 8 + eb);
                const unsigned p0 = __hip_atomic_fetch_add(lcnt + e0, 1u, __ATOMIC_RELAXED, __HIP_MEMORY_SCOPE_WORKGROUP), p1 = __hip_atomic_fetch_add(lcnt + e1, 1u, __ATOMIC_RELAXED, __HIP_MEMORY_SCOPE_WORKGROUP);
                unsigned* tok = WSP(unsigned, SM_TOK) + (size_t)(r0 + i) * 8;
                tok[0] = e0; tok[1] = p0; tok[2] = e1; tok[3] = p1; tok[4] = __float_as_uint(gval * wa); tok[5] = __float_as_uint(gval * wb);
            }
        }
    }
    __syncthreads();
    if (F.tid < 32 && !F.dry) lcnt[32 + F.tid] = atomicAdd(cnt + F.tid, lcnt[F.tid]);
    __syncthreads();
    if (!F.dry) for (int g = gw; g < MROWS / 4; g += NGW) { const int r0 = 4 * g; if (!row_valid(r0)) continue;
        if (lane < 4) { unsigned* tok = WSP(unsigned, SM_TOK) + (size_t)(r0 + lane) * 8; tok[1] += lcnt[32 + tok[0]]; tok[3] += lcnt[32 + tok[2]]; } }
}

__device__ __forceinline__ int moe_tables(Frame& F, int l) {
    LAS int* offs = (LAS int*)(F.lds + LDS_TAB); LAS unsigned char* tab = (LAS unsigned char*)(F.lds + LDS_TAB + 384); LAS int* cn = (LAS int*)(F.lds + LDS_TAB + 192);
    const unsigned* cnt = WSP(unsigned, WS_CTL) + CW_CNT + l * 64;
    __syncthreads();
    if (F.tid < 32) cn[F.tid] = (int)__hip_atomic_load(cnt + F.tid, __ATOMIC_RELAXED, __HIP_MEMORY_SCOPE_AGENT);
    __syncthreads();
    if (F.tid == 0) { int acc = 0;
#pragma unroll 1
        for (int e = 0; e < 32; ++e) { offs[e] = acc; acc += ((cn[e] + 255) >> 8) << 8; }
        offs[32] = acc; }
    __syncthreads();
    if (F.tid < 160) { const int row = F.tid << 8; int e = 0;
#pragma unroll 1
        for (int k = 1; k < 32; ++k) if (offs[k] <= row) e = k;
        tab[F.tid] = (unsigned char)e; }
    __syncthreads();
    return offs[32] >> 8;
}

__device__ __forceinline__ void phase_gather(Frame& F, int l) {
    (void)moe_tables(F, l);
    const LAS int* offs = (const LAS int*)(F.lds + LDS_TAB); const LAS int* cn = (const LAS int*)(F.lds + LDS_TAB + 192);
    const int gw = F.bid * NWAVES + F.wave, NGW = F.G * NWAVES, lane = F.lane;
    const bf16_t* U = WSP(bf16_t, WS_U); bf16_t* XG = WSP(bf16_t, WS_XG); float* wrow = WSP(float, SM_WROW);
    for (int idx = gw; idx < NREAL + 16; idx += 2 * NGW) {
        const int idx2 = idx + NGW; const bool has2 = idx2 < NREAL + 16;
        const int r = idx < NREAL ? idx : META_ROW0 + (idx - NREAL), r2 = has2 ? (idx2 < NREAL ? idx2 : META_ROW0 + (idx2 - NREAL)) : r;
        unsigned* tok = WSP(unsigned, SM_TOK) + (size_t)r * 8; unsigned* tok2 = WSP(unsigned, SM_TOK) + (size_t)r2 * 8;
        const u32x4 ta = *(const u32x4*)tok, tb = *(const u32x4*)tok2; const u32x2 wa = *(const u32x2*)(tok + 4), wb = *(const u32x2*)(tok2 + 4);
        const unsigned g0 = (unsigned)offs[ta.x] + ta.y, g1 = (unsigned)offs[ta.z] + ta.w, h0 = (unsigned)offs[tb.x] + tb.y, h1 = (unsigned)offs[tb.z] + tb.w;
        const u32x4* src = (const u32x4*)(U + (size_t)r * D); const u32x4* src2 = (const u32x4*)(U + (size_t)r2 * D);
        const u32x4 a = src[lane], b = src[lane + 64], c = src2[lane], d = src2[lane + 64];
        if (lane == 0) { tok[6] = g0; tok[7] = g1; wrow[g0] = __uint_as_float(wa.x); wrow[g1] = __uint_as_float(wa.y); }
        u32x4* d0 = (u32x4*)(XG + (size_t)g0 * D); u32x4* d1 = (u32x4*)(XG + (size_t)g1 * D);
        d0[lane] = a; d0[lane + 64] = b; d1[lane] = a; d1[lane + 64] = b;
        if (has2) { if (lane == 0) { tok2[6] = h0; tok2[7] = h1; wrow[h0] = __uint_as_float(wb.x); wrow[h1] = __uint_as_float(wb.y); }
            u32x4* e0 = (u32x4*)(XG + (size_t)h0 * D); u32x4* e1 = (u32x4*)(XG + (size_t)h1 * D);
            e0[lane] = c; e0[lane + 64] = d; e1[lane] = c; e1[lane + 64] = d; }
    }
    u32x4 zz = {0u, 0u, 0u, 0u}; asm volatile("" : "+v"(zz));
    for (int i = gw; i < 32 * 256; i += NGW) { const int e = i >> 8, j = i & 255; const int row = offs[e] + cn[e] + j;
        if (row < offs[e + 1]) { u32x4* d = (u32x4*)(XG + (size_t)row * D); d[lane] = zz; d[lane + 64] = zz; if (lane == 0) wrow[row] = 0.f; } }
}

__device__ __forceinline__ void phase_final(Frame& F) {
    const int gw = F.bid * NWAVES + F.wave, NGW = F.G * NWAVES, lane = F.lane;
    float wv[16]; load_row16(INP(I_NORM_FINAL), lane, wv);
    for (int r = gw; r < NREAL; r += 2 * NGW) {
        const int r2 = r + NGW;
        float x[16], y[16]; fetch_h_row(F, 2, r, x); fetch_h_row(F, 2, r2, y);
        float ss = 0.f, s2 = 0.f;
#pragma unroll
        for (int j = 0; j < 16; ++j) { ss += x[j] * x[j]; s2 += y[j] * y[j]; }
        const float rstd = rsqrtf(wave_sum(ss) * (1.0f / D) + 1e-6f), rstd2 = rsqrtf(wave_sum(s2) * (1.0f / D) + 1e-6f);
#pragma unroll
        for (int j = 0; j < 16; ++j) { x[j] = x[j] * rstd * wv[j]; y[j] = y[j] * rstd2 * wv[j]; }
        store_row16(OUTP + (size_t)r * D, lane, x); store_row16(OUTP + (size_t)r2 * D, lane, y);
    }
}
constexpr int PH_PER_LAYER = 14, N_PHASES = 2 + 2 * PH_PER_LAYER;
#ifndef DBG_STOP
#define DBG_STOP 0
#endif
#ifndef DBG_SRC
#define DBG_SRC WS_P
#define DBG_LD LDP
#endif
#ifndef DBG_TA
#define DBG_TA -1
#endif
#ifndef DBG_TQ
#define DBG_TQ 16.0f
#endif
#ifndef DBG_TB
#define DBG_TB -1
#endif
#ifndef DUP_MASK
#define DUP_MASK 0u
#endif
#define DUPN(j) (((DUP_MASK >> (j)) & 1u) ? 2 : 1)
#ifndef MK_ONE_LAUNCH
#define MK_ONE_LAUNCH 1
#endif

template <unsigned PHMASK_T>
__global__ void __launch_bounds__(NTHREADS, 2) hybrid_fwd(Params p) {
    extern __shared__ __attribute__((aligned(16))) unsigned char lds_raw[];
    Frame F;
    F.lds = (LAS unsigned char*)lds_raw; F.tid = threadIdx.x; F.lane = F.tid & 63; F.wave = __builtin_amdgcn_readfirstlane(F.tid >> 6); F.G = gridDim.x; F.bid = blockIdx.x; F.dry = 0;
    F.out = (GAS float*)p.out; F.ws = (GAS unsigned char*)p.ws; F.inp = (const float* const __attribute__((address_space(4)))*)__builtin_amdgcn_kernarg_segment_ptr();
    volatile LAS unsigned* MISC = (volatile LAS unsigned*)(F.lds + LDS_MISC);
    if (F.tid < 128) MISC[F.tid] = 0u;
    __syncthreads();
#if MK_ONE_LAUNCH
    constexpr int lo = 0, hi = N_PHASES;
#else
    const int lo = p.ph_lo, hi = p.ph_hi;
#endif
    if (hi - lo > 1) (void)xcd_barrier_post(WSP(unsigned, WS_CTL) + CW_BAR, MISC + 8);
#define GRID_BARRIER() xcd_barrier(WSP(unsigned, WS_CTL) + CW_BAR, xb_xcc_id(), (volatile LAS unsigned*)(F.lds + LDS_MISC) + 8, F.tid, (unsigned)F.G)
#define EN(j) ((PHMASK_T >> (j)) & 1u)
#define IN(k) (lo <= (k) && (k) < hi)
    if (DBG_TA >= 0 && F.tid == 0) { MISC[16] = (unsigned)__builtin_amdgcn_s_memrealtime(); MISC[17] = 0u; }
#define SEAM(k) do { if (IN(k) && IN((k) + 1)) GRID_BARRIER(); PHASE_FENCE(F); \
    if (DBG_TA >= 0 && F.tid == 0) { const unsigned t_now = (unsigned)__builtin_amdgcn_s_memrealtime(); const int kk = (k) == 0 ? 15 : (((k) - 1) % PH_PER_LAYER); const int kind = (kk >= 6 && kk <= 8) ? 6 : kk; \
        if (kind == DBG_TA) MISC[17] += t_now - MISC[16]; MISC[16] = t_now; } } while (0)
    PHASE_FENCE(F);
    if (EN(15) && IN(0)) phase_pre(F);
    SEAM(0);
    { constexpr int l = 0;
        const int pb = 1 + PH_PER_LAYER * l;
        for (int rep = 0; rep < (l == 0 ? DUPN(0) : 1); ++rep) { if (rep) { GRID_BARRIER(); PHASE_FENCE(F); } if (EN(0) && IN(pb + 0)) phase_norm1(F, l); }
        SEAM(pb + 0);
        for (int rep = 0; rep < DUPN(1); ++rep) { if (rep) { GRID_BARRIER(); PHASE_FENCE(F); }
        if (EN(1) && IN(pb + 1)) {
            pg8::Gemm g{WSP(bf16_t, WS_U), WSP(bf16_t, WS_WMIX), MROWS, LDP, D}; pg8::StaticOrder S; S.init(MROWS, LDP, F.G, F.bid);
            pg8::EpiInProj E{WSP(bf16_t, WS_P), WSP(bf16_t, SM_HALO)};
            pg8::gemm_phase(F.lds, F.tid, g, S, E);
        } }
        SEAM(pb + 1);
        if (EN(2) && IN(pb + 2)) prep_set(F, l, 0, F.G, F.bid);
        SEAM(pb + 2);
        if (EN(3) && IN(pb + 3)) phase_scan(F, l);
        SEAM(pb + 3);
        for (int rep = 0; rep < DUPN(4); ++rep) { if (rep) { GRID_BARRIER(); PHASE_FENCE(F); F.dry = 1; asm volatile("" : "+s"(F.dry)); } if (EN(4) && IN(pb + 4)) phase_hnorm(F, l); F.dry = 0; }
        SEAM(pb + 4);
        for (int rep = 0; rep < DUPN(5); ++rep) { if (rep) { GRID_BARRIER(); PHASE_FENCE(F); }
        if (EN(5) && IN(pb + 5)) {
            pg8::Gemm g{WSP(bf16_t, WS_U), WSP(bf16_t, WS_WGATE), NREAL, 3072, D}; pg8::StaticOrder S; S.init(NREAL, 3072, F.G, F.bid);
            pg8::EpiSigmoid E{WSP(bf16_t, WS_GT), 3072};
            pg8::gemm_phase(F.lds, F.tid, g, S, E);
            meta_gemm<0>(F, WSP(bf16_t, WS_U) + (size_t)META_ROW0 * D, WSP(bf16_t, WS_WGATE), 3072, D, 0);
        } }
        SEAM(pb + 5);
        for (int n = 0; n < 3; ++n) {
            if (EN(6) && IN(pb + 6 + n)) {
                pg8::Gemm g{WSP(bf16_t, WS_O) + (size_t)n * MROWS * 512, WSP(bf16_t, WS_WBT) + (size_t)n * 1024 * 512, NREAL, D, 512}; pg8::StaticOrder S; S.init(NREAL, D, F.G, F.bid);
                pg8::EpiBranch E{WSP(bf16_t, WS_MERGED), WSP(bf16_t, WS_GT), n};
                pg8::gemm_phase(F.lds, F.tid, g, S, E);
                meta_gemm<1>(F, WSP(bf16_t, WS_O) + (size_t)n * MROWS * 512 + (size_t)META_ROW0 * 512, WSP(bf16_t, WS_WBT) + (size_t)n * 1024 * 512, D, 512, n);
            }
            SEAM(pb + 6 + n);
        }
        if (EN(9) && IN(pb + 9)) {
            pg8::Gemm g{WSP(bf16_t, WS_MERGED), WSP(bf16_t, WS_WOT), NREAL, D, D}; pg8::StaticOrder S; S.init(NREAL, D, F.G, F.bid);
            pg8::EpiResidual E{OUTP, WSP(float, WS_HMETA)};
            pg8::gemm_phase(F.lds, F.tid, g, S, E);
            meta_gemm<2>(F, WSP(bf16_t, WS_MERGED) + (size_t)META_ROW0 * D, WSP(bf16_t, WS_WOT), D, D, 0);
        }
        SEAM(pb + 9);
        for (int rep = 0; rep < DUPN(10); ++rep) { if (rep) { GRID_BARRIER(); PHASE_FENCE(F); F.dry = 1; asm volatile("" : "+s"(F.dry)); } if (EN(10) && IN(pb + 10)) phase_norm2(F, l); F.dry = 0; }
        SEAM(pb + 10);
        for (int rep = 0; rep < DUPN(11); ++rep) { if (rep) { GRID_BARRIER(); PHASE_FENCE(F); } if (EN(11) && IN(pb + 11)) phase_gather(F, l); }
        SEAM(pb + 11);
        for (int rep = 0; rep < DUPN(12); ++rep) { if (rep) { GRID_BARRIER(); PHASE_FENCE(F); }
        if (EN(12) && IN(pb + 12)) {
            const int ntiles = moe_tables(F, l);
            pg8::Gemm g{WSP(bf16_t, WS_XG), WSP(bf16_t, WS_W1T), XG_ROWS, 512, D};
            pg8::MoeOrder S{F.G, F.bid, 2, ntiles, (const LAS unsigned char*)(F.lds + LDS_TAB + 384), (size_t)512 * 1024 * 2};
            pg8::EpiMoeUp E{WSP(bf16_t, WS_HG)};
            pg8::gemm_phase(F.lds, F.tid, g, S, E);
        } }
        SEAM(pb + 12);
        for (int rep = 0; rep < DUPN(13); ++rep) { if (rep) { GRID_BARRIER(); PHASE_FENCE(F); }
        if (EN(13) && IN(pb + 13)) {
            const int ntiles = moe_tables(F, l);
            pg8::Gemm g{WSP(bf16_t, WS_HG), WSP(bf16_t, WS_W2T), XG_ROWS, D, 256};
            pg8::MoeOrder S{F.G, F.bid, 4, ntiles, (const LAS unsigned char*)(F.lds + LDS_TAB + 384), (size_t)1024 * 256 * 2};
            pg8::EpiMoeDown E{WSP(bf16_t, WS_Y2), WSP(float, SM_WROW)};
            pg8::gemm_phase(F.lds, F.tid, g, S, E);
        } }
        SEAM(pb + 13);
    }
    { constexpr int l = 1;
        const int pb = 1 + PH_PER_LAYER * l;
        for (int rep = 0; rep < (l == 0 ? DUPN(0) : 1); ++rep) { if (rep) { GRID_BARRIER(); PHASE_FENCE(F); } if (EN(0) && IN(pb + 0)) phase_norm1(F, l); }
        SEAM(pb + 0);
        for (int rep = 0; rep < DUPN(1); ++rep) { if (rep) { GRID_BARRIER(); PHASE_FENCE(F); }
        if (EN(1) && IN(pb + 1)) {
            pg8::Gemm g{WSP(bf16_t, WS_U), WSP(bf16_t, WS_WMIX), MROWS, LDP, D}; pg8::StaticOrder S; S.init(MROWS, LDP, F.G, F.bid);
            pg8::EpiInProj E{WSP(bf16_t, WS_P), WSP(bf16_t, SM_HALO)};
            pg8::gemm_phase(F.lds, F.tid, g, S, E);
        } }
        SEAM(pb + 1);
        if (EN(2) && IN(pb + 2)) prep_set(F, l, 0, F.G, F.bid);
        SEAM(pb + 2);
        if (EN(3) && IN(pb + 3)) phase_scan(F, l);
        SEAM(pb + 3);
        for (int rep = 0; rep < DUPN(4); ++rep) { if (rep) { GRID_BARRIER(); PHASE_FENCE(F); F.dry = 1; asm volatile("" : "+s"(F.dry)); } if (EN(4) && IN(pb + 4)) phase_hnorm(F, l); F.dry = 0; }
        SEAM(pb + 4);
        for (int rep = 0; rep < DUPN(5); ++rep) { if (rep) { GRID_BARRIER(); PHASE_FENCE(F); }
        if (EN(5) && IN(pb + 5)) {
            pg8::Gemm g{WSP(bf16_t, WS_U), WSP(bf16_t, WS_WGATE), NREAL, 3072, D}; pg8::StaticOrder S; S.init(NREAL, 3072, F.G, F.bid);
            pg8::EpiSigmoid E{WSP(bf16_t, WS_GT), 3072};
            pg8::gemm_phase(F.lds, F.tid, g, S, E);
            meta_gemm<0>(F, WSP(bf16_t, WS_U) + (size_t)META_ROW0 * D, WSP(bf16_t, WS_WGATE), 3072, D, 0);
        } }
        SEAM(pb + 5);
        for (int n = 0; n < 3; ++n) {
            if (EN(6) && IN(pb + 6 + n)) {
                pg8::Gemm g{WSP(bf16_t, WS_O) + (size_t)n * MROWS * 512, WSP(bf16_t, WS_WBT) + (size_t)n * 1024 * 512, NREAL, D, 512}; pg8::StaticOrder S; S.init(NREAL, D, F.G, F.bid);
                pg8::EpiBranch E{WSP(bf16_t, WS_MERGED), WSP(bf16_t, WS_GT), n};
                pg8::gemm_phase(F.lds, F.tid, g, S, E);
                meta_gemm<1>(F, WSP(bf16_t, WS_O) + (size_t)n * MROWS * 512 + (size_t)META_ROW0 * 512, WSP(bf16_t, WS_WBT) + (size_t)n * 1024 * 512, D, 512, n);
            }
            SEAM(pb + 6 + n);
        }
        if (EN(9) && IN(pb + 9)) {
            pg8::Gemm g{WSP(bf16_t, WS_MERGED), WSP(bf16_t, WS_WOT), NREAL, D, D}; pg8::StaticOrder S; S.init(NREAL, D, F.G, F.bid);
            pg8::EpiResidual E{OUTP, WSP(float, WS_HMETA)};
            pg8::gemm_phase(F.lds, F.tid, g, S, E);
            meta_gemm<2>(F, WSP(bf16_t, WS_MERGED) + (size_t)META_ROW0 * D, WSP(bf16_t, WS_WOT), D, D, 0);
        }
        SEAM(pb + 9);
        for (int rep = 0; rep < DUPN(10); ++rep) { if (rep) { GRID_BARRIER(); PHASE_FENCE(F); F.dry = 1; asm volatile("" : "+s"(F.dry)); } if (EN(10) && IN(pb + 10)) phase_norm2(F, l); F.dry = 0; }
        SEAM(pb + 10);
        for (int rep = 0; rep < DUPN(11); ++rep) { if (rep) { GRID_BARRIER(); PHASE_FENCE(F); } if (EN(11) && IN(pb + 11)) phase_gather(F, l); }
        SEAM(pb + 11);
        for (int rep = 0; rep < DUPN(12); ++rep) { if (rep) { GRID_BARRIER(); PHASE_FENCE(F); }
        if (EN(12) && IN(pb + 12)) {
            const int ntiles = moe_tables(F, l);
            pg8::Gemm g{WSP(bf16_t, WS_XG), WSP(bf16_t, WS_W1T), XG_ROWS, 512, D};
            pg8::MoeOrder S{F.G, F.bid, 2, ntiles, (const LAS unsigned char*)(F.lds + LDS_TAB + 384), (size_t)512 * 1024 * 2};
            pg8::EpiMoeUp E{WSP(bf16_t, WS_HG)};
            pg8::gemm_phase(F.lds, F.tid, g, S, E);
        } }
        SEAM(pb + 12);
        for (int rep = 0; rep < DUPN(13); ++rep) { if (rep) { GRID_BARRIER(); PHASE_FENCE(F); }
        if (EN(13) && IN(pb + 13)) {
            const int ntiles = moe_tables(F, l);
            pg8::Gemm g{WSP(bf16_t, WS_HG), WSP(bf16_t, WS_W2T), XG_ROWS, D, 256};
            pg8::MoeOrder S{F.G, F.bid, 4, ntiles, (const LAS unsigned char*)(F.lds + LDS_TAB + 384), (size_t)1024 * 256 * 2};
            pg8::EpiMoeDown E{WSP(bf16_t, WS_Y2), WSP(float, SM_WROW)};
            pg8::gemm_phase(F.lds, F.tid, g, S, E);
        } }
        SEAM(pb + 13);
    }
#if DBG_STOP > 0
    if (EN(14) && IN(N_PHASES - 1)) { const int gt = F.bid * NTHREADS + F.tid, NT = F.G * NTHREADS;
#ifdef DBG_LIN
        { const bf16_t* s1 = WSP(bf16_t, DBG_SRC); const bf16_t* s2 = WSP(bf16_t, DBG_SRC2);
          for (size_t i = gt; i < (size_t)NREAL * D; i += NT) F.out[i] = i < (size_t)DBG_N1 ? bf2f(s1[i]) : (i < (size_t)DBG_N1 + DBG_N2 ? bf2f(s2[i - DBG_N1]) : 0.f); }
#else
        if (DBG_LD > 0) { const bf16_t* src = WSP(bf16_t, DBG_SRC); for (size_t i = gt; i < (size_t)NREAL * D; i += NT) { const size_t r = i >> 10, c = i & 1023; F.out[i] = bf2f(src[r * DBG_LD + (c * DBG_LD) / 1024]); } }
#endif
    }
#else
#ifdef DBG_XBAR
    for (int i = 0; i < DBG_XBAR; ++i) { GRID_BARRIER(); PHASE_FENCE(F); }
#endif
    if (EN(14) && IN(N_PHASES - 1)) phase_final(F);
    PROF_SPIN(F);
    if (DBG_TA >= 0) { float* tw = WSP(float, WS_CTL) + 2048; if (F.bid == 0 && F.tid == 0) { tw[0] = (float)MISC[17] * 0.01f; }
        GRID_BARRIER(); PHASE_FENCE(F);
        const float v = floorf(WSP(float, WS_CTL)[2048] * (1.0f / DBG_TQ)) * 0.25f;
        const int gt = F.bid * NTHREADS + F.tid, NT = F.G * NTHREADS;
        for (size_t i = gt; i < (size_t)NREAL * D; i += NT) F.out[i] = v; }
#endif
#undef IN
#undef SEAM
}

#if MK_ONE_LAUNCH
#ifndef KM_ONE
#define KM_ONE 0xffffffffu
#endif
constexpr unsigned KMASK[1] = {KM_ONE};
#else
constexpr unsigned KMASK[3] = {0x0C19u, 0xC004u, 0x3262u};
#endif
template <unsigned M> static bool setup_kernel(int& per_cu) {
    if (hipFuncSetAttribute((const void*)hybrid_fwd<M>, hipFuncAttributeMaxDynamicSharedMemorySize, LDS_BYTES) != hipSuccess) return false;
    if (hipOccupancyMaxActiveBlocksPerMultiprocessor(&per_cu, (const void*)hybrid_fwd<M>, NTHREADS, LDS_BYTES) != hipSuccess) per_cu = 0;
    (void)hipGetLastError();
    return true;
}
static int phase_kind(int k) { if (k == 0) return 15; if (k == N_PHASES - 1) return 14; const int j = (k - 1) % PH_PER_LAYER; return (j >= 6 && j <= 8) ? 6 : j; }
extern "C" void kernel_launch(void* const* d_in, const int* in_sizes, int n_in, void* d_out, int out_size, void* d_ws, size_t ws_size, hipStream_t stream) {
    static int grid = 0;
    if (grid == 0) {
        if (n_in != 24 || in_sizes[0] != NREAL * D || out_size != NREAL * D || ws_size < WS_END) {
            fprintf(stderr, "kernel_launch: unexpected problem (n_in %d, in0 %d, out %d, ws %zu < %zu); nothing launched\n", n_in, n_in > 0 ? in_sizes[0] : -1, out_size, ws_size, (size_t)WS_END); grid = -1; return; }
        int dev = 0, cus = 0, per_cu = 0; bool ok = true;
        if (hipGetDevice(&dev) != hipSuccess || hipDeviceGetAttribute(&cus, hipDeviceAttributeMultiprocessorCount, dev) != hipSuccess) { grid = -1; return; }
#if MK_ONE_LAUNCH
        ok = setup_kernel<KMASK[0]>(per_cu);
#else
        ok = setup_kernel<KMASK[0]>(per_cu) && setup_kernel<KMASK[1]>(per_cu) && setup_kernel<KMASK[2]>(per_cu);
#endif
        if (!ok) { fprintf(stderr, "kernel_launch: hipFuncSetAttribute failed\n"); grid = -1; return; }
        if (per_cu < 1) fprintf(stderr, "kernel_launch: occupancy query says %d\n", per_cu);
        grid = cus;
    }
    if (grid < 0) return;
    if (hipMemsetAsync((char*)d_ws + WS_CTL, 0, CTL_BYTES, stream) != hipSuccess) return;
    Params p{};
    for (int i = 0; i < 24; ++i) p.in[i] = (const float*)d_in[i];
    p.out = (float*)d_out; p.ws = (unsigned char*)d_ws;
#if MK_ONE_LAUNCH
    p.ph_lo = 0; p.ph_hi = N_PHASES;
    hipLaunchKernelGGL(hybrid_fwd<KMASK[0]>, dim3(grid), dim3(NTHREADS), LDS_BYTES, stream, p);
#else
    for (int k = 0; k < N_PHASES; ++k) { if (DBG_STOP > 0 && k >= DBG_STOP && k != N_PHASES - 1) continue; p.ph_lo = k; p.ph_hi = k + 1; const unsigned bit = 1u << phase_kind(k);
        if (KMASK[0] & bit) hipLaunchKernelGGL(hybrid_fwd<KMASK[0]>, dim3(grid), dim3(NTHREADS), LDS_BYTES, stream, p);
        else if (KMASK[1] & bit) hipLaunchKernelGGL(hybrid_fwd<KMASK[1]>, dim3(grid), dim3(NTHREADS), LDS_BYTES, stream, p);
        else hipLaunchKernelGGL(hybrid_fwd<KMASK[2]>, dim3(grid), dim3(NTHREADS), LDS_BYTES, stream, p); }
#endif
}
```

```cpp
#include <hip/hip_runtime.h>
#include <cstdio>
#include <cstdint>

#define LAS __attribute__((address_space(3)))
typedef unsigned short bf16_t;
typedef short bf16x8 __attribute__((ext_vector_type(8)));
typedef float f32x4 __attribute__((ext_vector_type(4)));
typedef float f32x2 __attribute__((ext_vector_type(2)));
typedef unsigned u32x4 __attribute__((ext_vector_type(4)));
typedef unsigned u32x2 __attribute__((ext_vector_type(2)));

constexpr int D = 1024, NREAL = 16384, MROWS = 16640, META_ROW0 = 16384 + 48, META_END = 16384 + 64;
constexpr int NSLOT = 257;
constexpr int LDP = 5632;
constexpr int PC_AQ = 0, PC_AF = 512, PC_AI = 1024, PC_AG = 1536, PC_BQKV = 2048, PC_BG = 3584, PC_CQ = 4096, PC_CK = 4352, PC_CV = 4608, PC_CG = 5120;
constexpr int IN_COLS = 8728;
constexpr int NTHREADS = 512, NWAVES = 8;
constexpr int XG_ROWS = 40960;

constexpr size_t MiB = 1ull << 20;
constexpr size_t WS_CTL = 0, CTL_BYTES = 1 * MiB;
constexpr int CW_BAR = 4096, CW_CNT = 1024;
constexpr size_t SM_SW1 = 1 * MiB;
constexpr size_t SM_RWG = SM_SW1 + 2 * 24 * 1024 * 4;
constexpr size_t SM_RWE = SM_RWG + 2 * 4 * 1024 * 4;
constexpr size_t SM_LAB = SM_RWE + 2 * 32 * 1024 * 4;
constexpr size_t SM_GK = SM_LAB + 2 * 2 * 512 * 4;
constexpr size_t SM_BETA = SM_GK + (size_t)MROWS * 16 * 4;
constexpr size_t SM_LOGA = SM_BETA + (size_t)MROWS * 4 * 4;
constexpr size_t SM_TOK = SM_LOGA + (size_t)MROWS * 4 * 4;
constexpr size_t SM_WROW = SM_TOK + (size_t)MROWS * 8 * 4;
constexpr size_t SM_DECA = SM_WROW + (size_t)XG_ROWS * 4;
constexpr size_t SM_DECC = SM_DECA + 1028 * 128 * 4;
constexpr size_t SM_DECB = SM_DECC + 1028 * 64 * 4;
constexpr size_t SM_HALO = SM_DECB + 8192;
constexpr size_t SM_END = SM_HALO + 260 * 3 * 1536 * 2;
static_assert(SM_END <= 8 * MiB, "small region");
constexpr size_t WS_HMETA = 8 * MiB;
constexpr size_t WS_WMIX = 9 * MiB;
constexpr size_t WS_WGATE = 20 * MiB;
constexpr size_t WS_WBT = 26 * MiB;
constexpr size_t WS_WOT = 29 * MiB;
constexpr size_t WS_O = 31 * MiB;
constexpr size_t O_STRIDE = (size_t)MROWS * 512 * 2;
constexpr size_t WS_W1T = 31 * MiB;
constexpr size_t WS_W2T = 63 * MiB;
constexpr size_t WS_U = 80 * MiB;
constexpr size_t WS_P = 113 * MiB;
constexpr size_t WS_GT = 113 * MiB;
constexpr size_t WS_MERGED = 211 * MiB;
constexpr size_t WS_XG = 113 * MiB;
constexpr size_t WS_HG = 193 * MiB;
constexpr size_t WS_Y2 = 213 * MiB;
constexpr size_t WS_SCA = 294 * MiB;
constexpr size_t WS_QKD = 303 * MiB;
constexpr size_t WS_SCC = 312 * MiB;
constexpr size_t WS_K1TB = 321 * MiB;
constexpr size_t WS_END = 338 * MiB;

constexpr int LDS_BYTES = 163840;
constexpr int LDS_MISC = LDS_BYTES - 512;
constexpr int LDS_TAB = LDS_BYTES - 1536;
constexpr int LDS_SCRATCH = LDS_TAB;

typedef __bf16 bf16x2v __attribute__((ext_vector_type(2)));
__device__ __forceinline__ unsigned pk2(float lo, float hi) { const f32x2 v = {lo, hi}; return __builtin_bit_cast(unsigned, __builtin_convertvector(v, bf16x2v)); }
__device__ __forceinline__ bf16_t f2bf(float f) { return (bf16_t)(pk2(f, 0.f) & 0xffffu); }
__device__ __forceinline__ float bf2f(bf16_t b) { return __uint_as_float(((unsigned)b) << 16); }
__device__ __forceinline__ float bflo(unsigned w) { return __uint_as_float(w << 16); }
__device__ __forceinline__ float bfhi(unsigned w) { return __uint_as_float(w & 0xffff0000u); }
__device__ __forceinline__ float sigmoidf_(float x) { return __builtin_amdgcn_rcpf(1.0f + __expf(-x)); }
__device__ __forceinline__ float siluf_(float x) { return x * __builtin_amdgcn_rcpf(1.0f + __expf(-x)); }
__device__ __forceinline__ float logsigf_(float x) { return fminf(x, 0.f) - __logf(1.0f + __expf(-fabsf(x))); }
__device__ __forceinline__ float softplusf_(float x) { return fmaxf(x, 0.f) + log1pf(__expf(-fabsf(x))); }
__device__ __forceinline__ bool row_valid(int r) { return r < NREAL || (r >= META_ROW0 && r < META_END); }
__device__ __forceinline__ float wave_sum(float v) {
#define DPP_ADD(ctrl, rmask) v += __int_as_float(__builtin_amdgcn_update_dpp(0, __float_as_int(v), (ctrl), (rmask), 0xf, false))
    DPP_ADD(0x111, 0xf); DPP_ADD(0x112, 0xf); DPP_ADD(0x114, 0xf); DPP_ADD(0x118, 0xf);
    DPP_ADD(0x142, 0xa); DPP_ADD(0x143, 0xc);
#undef DPP_ADD
    return __int_as_float(__builtin_amdgcn_readlane(__float_as_int(v), 63));
}
#define LDS_WAIT() asm volatile("s_waitcnt lgkmcnt(0)" ::: "memory")

#define XB_TMO      128
#define XB_XCNT(j)  (256  + 64 * (j))
#define XB_XSUB(j)  (1280 + 64 * (j))
#define XB_XGEN(j)  (2304 + 64 * (j))
#define XB_TOP      3328
#define XB_TOPGEN   3392
#define XCD_BAR_WORDS 3456
#define XB_SPIN_CAP (1u << 18)
__device__ __forceinline__ unsigned xb_ld(unsigned* p)              { return __hip_atomic_load(p, __ATOMIC_RELAXED, __HIP_MEMORY_SCOPE_AGENT); }
__device__ __forceinline__ unsigned xb_add(unsigned* p, unsigned v) { return __hip_atomic_fetch_add(p, v, __ATOMIC_RELAXED, __HIP_MEMORY_SCOPE_AGENT); }
__device__ __forceinline__ unsigned xb_xcc_id() { return (unsigned)__builtin_amdgcn_s_getreg((3 << 11) | 20) & 0xFu; }
#define XB_SPIN(cond, bar) do { unsigned _sp = 0; while (cond) { __builtin_amdgcn_s_sleep(1); \
    if ((++_sp & 255u) == 0u) { if (xb_ld(&(bar)[XB_TMO])) break; if (_sp > XB_SPIN_CAP) { atomicAdd(&(bar)[XB_TMO], 1u); break; } } } } while (0)
struct XcdBarrier { unsigned* bar; unsigned x; volatile LAS unsigned* st; };
__device__ __forceinline__ XcdBarrier xcd_barrier_post(unsigned* bar, volatile LAS unsigned* st) {
    XcdBarrier b; b.bar = bar; b.x = xb_xcc_id(); b.st = st;
    if (threadIdx.x == 0) (void)xb_add(&bar[XB_XCNT(b.x)], 1u);
    return b;
}
__device__ __forceinline__ void xcd_barrier_complete(unsigned* bar, unsigned x, unsigned& nloc, unsigned& nx, const unsigned G) {
    unsigned sum, cnt, mine, sp = 0u;
    for (;;) {
        sum = 0u; cnt = 0u; mine = 0u;
#pragma unroll
        for (unsigned j = 0; j < 16; ++j) { const unsigned c = xb_ld(&bar[XB_XCNT(j)]); sum += c; cnt += (c > 0u) ? 1u : 0u; mine = (j == x) ? c : mine; }
        if (sum == G) break;
        __builtin_amdgcn_s_sleep(1);
        if ((++sp & 255u) == 0u) { if (xb_ld(&bar[XB_TMO])) break; if (sp > XB_SPIN_CAP) { atomicAdd(&bar[XB_TMO], 1u); break; } }
    }
    nloc = mine > 0u ? mine : 1u; nx = cnt > 0u ? cnt : 1u;
}
__device__ __attribute__((noinline)) void xcd_barrier(unsigned* bar_, unsigned x_, volatile LAS unsigned* st_, int tid_, unsigned G_) {
    XcdBarrier b; b.bar = bar_; b.x = x_; b.st = st_;
    asm volatile("s_waitcnt vmcnt(0)" ::: "memory");
    __syncthreads();
    if (tid_ == 0) {
        unsigned* bar = b.bar;
        __builtin_amdgcn_s_waitcnt(0);
        unsigned nloc = b.st[0], nx = b.st[1];
        if (nloc == 0u) { xcd_barrier_complete(bar, b.x, nloc, nx, G_); b.st[0] = nloc; b.st[1] = nx; }
        const unsigned old = xb_add(&bar[XB_XSUB(b.x)], 1u);
        const unsigned gen = old / nloc;
        if (old + 1u == (gen + 1u) * nloc) {
            __builtin_amdgcn_fence(__ATOMIC_RELEASE, "agent");
            asm volatile("s_waitcnt vmcnt(0)" ::: "memory");
            const unsigned og = xb_add(&bar[XB_TOP], 1u);
            const unsigned tg = og / nx;
            if (og + 1u == (tg + 1u) * nx) xb_add(&bar[XB_TOPGEN], 1u);
            else XB_SPIN(xb_ld(&bar[XB_TOPGEN]) == tg, bar);
            __builtin_amdgcn_fence(__ATOMIC_ACQUIRE, "agent");
            xb_add(&bar[XB_XGEN(b.x)], 1u);
            asm volatile("s_waitcnt vmcnt(0)" ::: "memory");
        } else {
            XB_SPIN(xb_ld(&bar[XB_XGEN(b.x)]) == gen, bar);
            __builtin_amdgcn_fence(__ATOMIC_ACQUIRE, "agent");
            asm volatile("s_waitcnt vmcnt(0)" ::: "memory");
        }
    }
    __syncthreads();
}

#ifndef PROF_ON
#define PROF_ON 0
#endif
#if PROF_ON
#define PROF_SLOTS(F) WSP(unsigned, WS_CTL + 524288)
__device__ __forceinline__ unsigned prof_now() { unsigned long long t; asm volatile("s_memrealtime %0\n\ts_waitcnt lgkmcnt(0)" : "=s"(t) :: "memory"); return (unsigned)t; }
#define PROF_MARK(F, k) do { const unsigned now_ = prof_now(); if ((F).bid == PROF_BID && (F).tid == 0) PROF_SLOTS(F)[k] = now_; asm volatile("" ::: "memory"); } while (0)
#if PROF_IN & 1
#define PROF_MARKI(F, k) PROF_MARK(F, k)
#else
#define PROF_MARKI(F, k) do { } while (0)
#endif
#if PROF_IN & 2
#define PROF_MARKG(F, k) do { if ((PROF_GMASK >> (k)) & 1) PROF_MARK(F, k); } while (0)
#else
#define PROF_MARKG(F, k) do { } while (0)
#endif
#define PROF_SPIN(F) do { if ((F).bid == PROF_BID && (F).tid == 0) { unsigned qa_ = (PROF_SLOTS(F)[PROF_A1] - PROF_SLOTS(F)[PROF_A0] + 50u) / 100u, qb_ = (PROF_SLOTS(F)[PROF_B1] - PROF_SLOTS(F)[PROF_B0] + 50u) / 100u; \
    qa_ = qa_ > 127u ? 127u : qa_; qb_ = qb_ > 127u ? 127u : qb_; const unsigned d_ = (qa_ + 128u * qb_) * 1600u; const unsigned t0_ = (unsigned)__builtin_amdgcn_s_memrealtime(); \
    while ((unsigned)__builtin_amdgcn_s_memrealtime() - t0_ < d_) __builtin_amdgcn_s_sleep(8); } } while (0)
#else
#define PROF_MARK(F, k) do { } while (0)
#define PROF_MARKI(F, k) do { } while (0)
#define PROF_MARKG(F, k) do { } while (0)
#define PROF_SPIN(F) do { } while (0)
#endif
namespace pg8 {
constexpr int BM = 256, BK = 64, HALF = 128, HTB = HALF * BK * 2, STAGE_BYTES = 8 * HTB, NXCD = 8, WGM = 8;
__host__ __device__ __forceinline__ int lds_byte(int r, int c) { const int st = (r >> 4) * 2 + (c >> 5), rr = r & 15, cc = c & 31, ob = rr * 64 + cc * 2; return st * 1024 + (ob ^ (((ob >> 9) & 1) << 5)); }
__host__ __device__ __forceinline__ void stage_rc(int b, int& R, int& C) { const int st = b / 1024, sb = b % 1024, swz = sb ^ (((sb >> 9) & 1) << 5); R = (st >> 1) * 16 + swz / 64; C = (st & 1) * 32 + (swz % 64) / 2; }
__host__ __device__ __forceinline__ int perm32(int rho) { const int n = rho >> 4, i = rho & 15; return 8 * (i >> 2) + 4 * n + (i & 3); }

struct Unit { int pm, pn, ex; };
struct Gemm { const bf16_t* A; const bf16_t* Bt; int M, N, K; };

struct StaticOrder {
    int nM, nN, nwg, G, c;
    __device__ void init(int M, int N, int G_, int c_) { nM = M / BM; nN = N / BM; nwg = nM * nN; G = G_; c = c_; }
    __device__ bool next(int i, Unit& u) const {
        const long L = (long)i * G + c; if (L >= nwg) return false;
        int wgid = (int)L; { const int q = nwg / NXCD, r = nwg % NXCD, xcd = wgid % NXCD, off = wgid / NXCD; wgid = (xcd < r ? xcd * (q + 1) : r * (q + 1) + (xcd - r) * q) + off; }
        const int nig = WGM * nN, gid = wgid / nig, fm = gid * WGM, gsz = (nM - fm) < WGM ? (nM - fm) : WGM;
        u.pm = fm + ((wgid % nig) % gsz); u.pn = (wgid % nig) / gsz; u.ex = 0; return true;
    }
    __device__ __forceinline__ void ptrs(const Gemm& g, const Unit& u, const char*& a, const char*& b) const {
        const size_t tstep = (size_t)BM * g.K * 2; a = (const char*)g.A + (size_t)u.pm * tstep; b = (const char*)g.Bt + (size_t)u.pn * tstep; }
};
struct MoeOrder {
    int G, c, npn, ntiles; const LAS unsigned char* tab; size_t estride;
    __device__ bool next(int i, Unit& u) const {
        const long L = (long)i * G + c; if (L >= (long)ntiles * npn) return false;
        u.pm = (int)(L / npn); u.pn = (int)(L % npn); u.ex = (int)tab[u.pm]; return true;
    }
    __device__ __forceinline__ void ptrs(const Gemm& g, const Unit& u, const char*& a, const char*& b) const {
        const size_t tstep = (size_t)BM * g.K * 2; a = (const char*)g.A + (size_t)u.pm * tstep; b = (const char*)g.Bt + (size_t)u.ex * estride + (size_t)u.pn * tstep; }
};

template <class Epi, class Sched>
__device__ __forceinline__ void gemm_phase(LAS unsigned char* lds, const int tid, const Gemm g, const Sched& S, const Epi& E) {
    const int wid = __builtin_amdgcn_readfirstlane(tid >> 6), lane = tid & 63, wr = wid >> 2, wc = wid & 3, fr = lane & 15, fq = lane >> 4;
    int K = g.K; asm volatile("" : "+s"(K));
    const int nt = K / BK;
    unsigned voffA[2], voffB[2];
#pragma unroll
    for (int i = 0; i < 2; ++i) { int R, C; stage_rc(tid * 16 + i * 8192, R, C); const int Rb = Epi::PERM ? ((R & ~31) + perm32(R & 31)) : R;
        voffA[i] = (unsigned)(R * K + C) * 2u; voffB[i] = (unsigned)(Rb * K + C) * 2u; }
    const size_t kstep = (size_t)(BK * 2);
    const size_t hstep = (size_t)HALF * K * 2;
    const unsigned ldsw = (unsigned)wid * 1024u;
    const int aoff = lds_byte(wr * 64 + fr, fq * 8), boff = lds_byte(wc * 32 + fr, fq * 8);
#define PG8_SA(b, h) (((b) * 2 + (h)) * HTB)
#define PG8_SB(b, h) ((4 + (b) * 2 + (h)) * HTB)
#define PG8_STAGE(bufoff, gbase, voff) do { _Pragma("unroll") for (int _i = 0; _i < 2; ++_i) \
        __builtin_amdgcn_global_load_lds((const unsigned*)((const char*)(gbase) + (voff)[_i]), (LAS unsigned*)(lds + (bufoff) + ldsw + _i * 8192), 16, 0, 0); } while (0)
#define PG8_LDA(dst, b, h) do { _Pragma("unroll") for (int m = 0; m < 4; ++m) _Pragma("unroll") for (int k = 0; k < 2; ++k) dst[m][k] = *(const LAS bf16x8*)(lds + PG8_SA(b, h) + aoff + m * 2048 + k * 1024); } while (0)
#define PG8_LDB(dst, b, h) do { _Pragma("unroll") for (int n = 0; n < 2; ++n) _Pragma("unroll") for (int k = 0; k < 2; ++k) dst[n][k] = *(const LAS bf16x8*)(lds + PG8_SB(b, h) + boff + n * 2048 + k * 1024); } while (0)
#define PG8_MMA(ai, bj, At, Bt) do { __builtin_amdgcn_s_setprio(1); _Pragma("unroll") for (int m = 0; m < 4; ++m) _Pragma("unroll") for (int n = 0; n < 2; ++n) _Pragma("unroll") for (int k = 0; k < 2; ++k) \
        acc[ai][bj][m][n] = __builtin_amdgcn_mfma_f32_16x16x32_bf16(Bt[n][k], At[m][k], acc[ai][bj][m][n], 0, 0, 0); __builtin_amdgcn_s_setprio(0); } while (0)
#define PG8_WAIT_V(n) asm volatile("s_waitcnt vmcnt(" #n ")" ::: "memory")
#define PG8_WAIT_L(n) asm volatile("s_waitcnt lgkmcnt(" #n ")" ::: "memory")
#define PG8_BAR __builtin_amdgcn_s_barrier()
#define PG8_SCHED __builtin_amdgcn_sched_barrier(0)
    Unit cur, nxt; int ui = 0;
    if (!S.next(0, cur)) return;
    f32x4 acc[2][2][4][2];
#pragma unroll
    for (int a = 0; a < 2; ++a)
#pragma unroll
        for (int b = 0; b < 2; ++b)
#pragma unroll
            for (int m = 0; m < 4; ++m)
#pragma unroll
                for (int n = 0; n < 2; ++n) acc[a][b][m][n] = (f32x4){0.f, 0.f, 0.f, 0.f};
    bf16x8 At[4][2], B0[2][2], B1[2][2];
    const char* cA; const char* cB; S.ptrs(g, cur, cA, cB);
    PG8_STAGE(PG8_SB(0, 0), cB, voffB); PG8_STAGE(PG8_SA(0, 0), cA, voffA); PG8_STAGE(PG8_SB(0, 1), cB + hstep, voffB); PG8_STAGE(PG8_SA(0, 1), cA + hstep, voffA);
    if (wr == 1) PG8_BAR;
    PG8_WAIT_V(4); PG8_BAR;
    PG8_STAGE(PG8_SB(1, 0), cB + kstep, voffB); PG8_STAGE(PG8_SA(1, 0), cA + kstep, voffA); PG8_STAGE(PG8_SB(1, 1), cB + hstep + kstep, voffB);
    PG8_WAIT_V(6); PG8_BAR;
    for (;;) {
        const bool has_next = S.next(ui + 1, nxt);
        const char* nA = cA; const char* nB = cB; if (has_next) S.ptrs(g, nxt, nA, nB);
        for (int t = 0; t < nt; t += 2) {
            const bool last = (t == nt - 2);
            const char* a1 = cA + (size_t)(t + 1) * kstep;
            const char* a2 = last ? nA : cA + (size_t)(t + 2) * kstep; const char* b2 = last ? nB : cB + (size_t)(t + 2) * kstep;
            const char* a3 = a2 + kstep; const char* b3 = b2 + kstep;
            PG8_LDB(B0, 0, 0); PG8_SCHED; PG8_LDA(At, 0, 0); PG8_STAGE(PG8_SA(1, 1), a1 + hstep, voffA);
            PG8_WAIT_L(8); PG8_BAR; PG8_WAIT_L(0); PG8_MMA(0, 0, At, B0); PG8_BAR; PG8_SCHED;
            PG8_LDB(B1, 0, 1); PG8_STAGE(PG8_SB(0, 0), b2, voffB);
            PG8_BAR; PG8_WAIT_L(0); PG8_MMA(0, 1, At, B1); PG8_BAR;
            PG8_LDA(At, 0, 1); PG8_STAGE(PG8_SA(0, 0), a2, voffA);
            PG8_BAR; PG8_WAIT_L(0); PG8_MMA(1, 0, At, B0); PG8_BAR; PG8_SCHED;
            PG8_STAGE(PG8_SB(0, 1), b2 + hstep, voffB);
            PG8_WAIT_V(6); PG8_BAR; PG8_MMA(1, 1, At, B1); PG8_BAR;
            PG8_LDB(B0, 1, 0); PG8_SCHED; PG8_LDA(At, 1, 0); PG8_STAGE(PG8_SA(0, 1), a2 + hstep, voffA);
            PG8_WAIT_L(8); PG8_BAR; PG8_WAIT_L(0); PG8_MMA(0, 0, At, B0); PG8_BAR; PG8_SCHED;
            PG8_LDB(B1, 1, 1); PG8_STAGE(PG8_SB(1, 0), b3, voffB);
            PG8_BAR; PG8_WAIT_L(0); PG8_MMA(0, 1, At, B1); PG8_BAR;
            PG8_LDA(At, 1, 1); PG8_STAGE(PG8_SA(1, 0), a3, voffA);
            PG8_BAR; PG8_WAIT_L(0); PG8_MMA(1, 0, At, B0); PG8_BAR; PG8_SCHED;
            PG8_STAGE(PG8_SB(1, 1), b3 + hstep, voffB);
            PG8_WAIT_V(6); PG8_BAR; PG8_MMA(1, 1, At, B1); PG8_BAR;
        }
        E(acc, cur, wr, wc, fr, fq);
        if (!has_next) break;
#pragma unroll
        for (int a = 0; a < 2; ++a)
#pragma unroll
            for (int b = 0; b < 2; ++b)
#pragma unroll
                for (int m = 0; m < 4; ++m)
#pragma unroll
                    for (int n = 0; n < 2; ++n) acc[a][b][m][n] = (f32x4){0.f, 0.f, 0.f, 0.f};
        cur = nxt; cA = nA; cB = nB; ++ui;
    }
    PG8_WAIT_V(0);
    if (wr == 0) PG8_BAR;
    PG8_BAR;
#undef PG8_SA
#undef PG8_SB
#undef PG8_STAGE
#undef PG8_LDA
#undef PG8_LDB
#undef PG8_MMA
#undef PG8_WAIT_V
#undef PG8_WAIT_L
#undef PG8_BAR
#undef PG8_SCHED
}

#define EPI_PERM_LOOP(...) \
    _Pragma("unroll") for (int ai = 0; ai < 2; ++ai) _Pragma("unroll") for (int m = 0; m < 4; ++m) { const int row = u.pm * BM + ai * HALF + wr * 64 + m * 16 + fr; \
        _Pragma("unroll") for (int bj = 0; bj < 2; ++bj) { const int col0 = u.pn * BM + bj * HALF + wc * 32 + 8 * fq; f32x4 v0 = acc[ai][bj][m][0], v1 = acc[ai][bj][m][1]; __VA_ARGS__ } if (EPI_PIN) __builtin_amdgcn_sched_barrier(0); }

struct EpiInProj {
    static constexpr bool PERM = true, EPI_PIN = true;
    bf16_t* P; bf16_t* halo;
    __device__ __forceinline__ void operator()(const f32x4 (&acc)[2][2][4][2], const Unit& u, int wr, int wc, int fr, int fq) const {
        const bool is_qkv = u.pn >= 8 && u.pn < 14;
        EPI_PERM_LOOP({
            u32x4 w; w.x = pk2(v0[0], v0[1]); w.y = pk2(v0[2], v0[3]); w.z = pk2(v1[0], v1[1]); w.w = pk2(v1[2], v1[3]);
            *(u32x4*)(P + (size_t)row * LDP + col0) = w;
            if (is_qkv && (row & 63) >= 61) *(u32x4*)(halo + ((size_t)(row >> 6) * 3 + ((row & 63) - 61)) * 1536 + (col0 - PC_BQKV)) = w;
        })
    }
};
__device__ __forceinline__ float lfg(float lb, float oml, float x) { return __logf(lb + oml * __builtin_amdgcn_rcpf(1.0f + __expf(-x)) + 1e-30f); }
struct EpiSigmoid {
    static constexpr bool PERM = true, EPI_PIN = true;
    bf16_t* O; int ldc;
    __device__ __forceinline__ void operator()(const f32x4 (&acc)[2][2][4][2], const Unit& u, int wr, int wc, int fr, int fq) const {
        EPI_PERM_LOOP({
            u32x4 w; w.x = pk2(sigmoidf_(v0[0]), sigmoidf_(v0[1])); w.y = pk2(sigmoidf_(v0[2]), sigmoidf_(v0[3])); w.z = pk2(sigmoidf_(v1[0]), sigmoidf_(v1[1])); w.w = pk2(sigmoidf_(v1[2]), sigmoidf_(v1[3]));
            *(u32x4*)(O + (size_t)row * ldc + col0) = w;
        })
    }
};
struct EpiBranch {
    static constexpr bool PERM = true, EPI_PIN = false;
    bf16_t* merged; const bf16_t* gt; int n;
    __device__ __forceinline__ void operator()(const f32x4 (&acc)[2][2][4][2], const Unit& u, int wr, int wc, int fr, int fq) const {
        EPI_PERM_LOOP({
            const u32x4 gw = *(const u32x4*)(gt + (size_t)row * 3072 + n * 1024 + col0);
            float x[8] = {v0[0] * bflo(gw.x), v0[1] * bfhi(gw.x), v0[2] * bflo(gw.y), v0[3] * bfhi(gw.y), v1[0] * bflo(gw.z), v1[1] * bfhi(gw.z), v1[2] * bflo(gw.w), v1[3] * bfhi(gw.w)};
            bf16_t* mp = merged + (size_t)row * 1024 + col0;
            if (n != 0) { const u32x4 o = *(const u32x4*)mp; x[0] += bflo(o.x); x[1] += bfhi(o.x); x[2] += bflo(o.y); x[3] += bfhi(o.y); x[4] += bflo(o.z); x[5] += bfhi(o.z); x[6] += bflo(o.w); x[7] += bfhi(o.w); }
            u32x4 w; w.x = pk2(x[0], x[1]); w.y = pk2(x[2], x[3]); w.z = pk2(x[4], x[5]); w.w = pk2(x[6], x[7]);
            *(u32x4*)mp = w;
        })
    }
};
struct EpiResidual {
    static constexpr bool PERM = false;
    float* hreal; float* hmeta;
    __device__ __forceinline__ void operator()(const f32x4 (&acc)[2][2][4][2], const Unit& u, int wr, int wc, int fr, int fq) const {
#pragma unroll
        for (int ai = 0; ai < 2; ++ai)
#pragma unroll
            for (int m = 0; m < 4; ++m) { const int row = u.pm * BM + ai * HALF + wr * 64 + m * 16 + fr;
                float* rowp = (row < NREAL ? hreal + (size_t)row * D : hmeta + (size_t)(row - NREAL) * D) + u.pn * BM + wc * 32 + 4 * fq;
#pragma unroll
                for (int bj = 0; bj < 2; ++bj)
#pragma unroll
                    for (int n = 0; n < 2; ++n) { f32x4* p = (f32x4*)(rowp + bj * HALF + n * 16); *p = *p + acc[ai][bj][m][n]; } }
    }
};
struct EpiMoeUp {
    static constexpr bool PERM = true, EPI_PIN = true;
    bf16_t* H;
    __device__ __forceinline__ void operator()(const f32x4 (&acc)[2][2][4][2], const Unit& u, int wr, int wc, int fr, int fq) const {
        EPI_PERM_LOOP({
            const int hc = col0 >> 1;
            u32x2 w; w.x = pk2(siluf_(v0[0]) * v1[0], siluf_(v0[1]) * v1[1]); w.y = pk2(siluf_(v0[2]) * v1[2], siluf_(v0[3]) * v1[3]);
            *(u32x2*)(H + (size_t)row * 256 + hc) = w;
        })
    }
};
struct EpiMoeDown {
    static constexpr bool PERM = true, EPI_PIN = false;
    bf16_t* Y; const float* wrow;
    __device__ __forceinline__ void operator()(const f32x4 (&acc)[2][2][4][2], const Unit& u, int wr, int wc, int fr, int fq) const {
        EPI_PERM_LOOP({
            const float s = wrow[row];
            u32x4 w; w.x = pk2(v0[0] * s, v0[1] * s); w.y = pk2(v0[2] * s, v0[3] * s); w.z = pk2(v1[0] * s, v1[1] * s); w.w = pk2(v1[2] * s, v1[3] * s);
            *(u32x4*)(Y + (size_t)row * 1024 + col0) = w;
        })
    }
};
}
#define GAS __attribute__((address_space(1)))
struct Params { const float* in[24]; float* out; unsigned char* ws; int ph_lo, ph_hi; };
struct Frame {
    LAS unsigned char* lds; int tid, lane, wave, G, bid;
    __attribute__((address_space(1))) float* out; __attribute__((address_space(1))) unsigned char* ws; const float* const __attribute__((address_space(4)))* inp; int dry;
};
#define PHASE_FENCE(F) do { asm volatile("" : "+s"((F).ws), "+s"((F).out), "+s"((F).inp), "+v"((F).tid), "+s"((F).bid), "+s"((F).G)); \
    (F).lane = (F).tid & 63; (F).wave = __builtin_amdgcn_readfirstlane((F).tid >> 6); } while (0)
__device__ __forceinline__ const float* inp_ptr(const float* const __attribute__((address_space(4)))* inp, int i) { GAS const float* q = (GAS const float*)inp[i]; asm volatile("" : "+s"(q)); return (const float*)q; }
#define INP(i) inp_ptr(F.inp, (i))
#define WSP(T, off) ((T*)(GAS T*)(F.ws + (off)))
enum { I_X = 0, I_META, I_NORM_MIX, I_W_IN, I_LB, I_HGRN_NORM, I_GDN_CONV, I_GDN_ALOG, I_GDN_DT, I_GDN_NORM, I_GLA_W2, I_GLA_B, I_GLA_NORM, I_W_BRANCH, I_W_OUT, I_NORM_FFN,
       I_RG_W, I_RG_B, I_RE_W, I_RE_B, I_EW_GATE, I_EW_UP, I_EW_DOWN, I_NORM_FINAL };

__device__ __forceinline__ void transpose_item(const float* W, int ldw, int K, int nblk, bf16_t* WT, int row_off, int rowmode, LAS float* scr, int item, int lane) {
    const int kb = item / nblk, nb = item % nblk, k0 = 64 * kb, n0 = 32 * nb;
    { f32x4 v[8]; const int n4 = 4 * (lane & 7);
#pragma unroll
        for (int i = 0; i < 8; ++i) v[i] = *(const f32x4*)(W + (size_t)(k0 + 8 * i + (lane >> 3)) * ldw + n0 + n4);
#pragma unroll
        for (int i = 0; i < 8; ++i) { LAS float* d = scr + (8 * i + (lane >> 3)) * 33 + n4; d[0] = v[i][0]; d[1] = v[i][1]; d[2] = v[i][2]; d[3] = v[i][3]; } }
    LDS_WAIT(); asm volatile("" ::: "memory");
    const int c = lane & 7;
#pragma unroll
    for (int j = 0; j < 4; ++j) { const int n = (lane >> 3) + 8 * j; const LAS float* s = scr + (8 * c) * 33 + n;
        u32x4 o; o.x = pk2(s[0 * 33], s[1 * 33]); o.y = pk2(s[2 * 33], s[3 * 33]); o.z = pk2(s[4 * 33], s[5 * 33]); o.w = pk2(s[6 * 33], s[7 * 33]);
        const int nn = n0 + n; const int wrow = rowmode == 0 ? row_off + nn : row_off + 8 * (nn >> 2) + (nn & 3) + (rowmode == 2 ? 4 : 0);
        *(u32x4*)(WT + (size_t)wrow * K + k0 + 8 * c) = o; }
    LDS_WAIT(); asm volatile("" ::: "memory");
}

__device__ __forceinline__ void phase_pre(Frame& F) {
    const int gt = F.bid * NTHREADS + F.tid, NT = F.G * NTHREADS;
    float* sw1 = WSP(float, SM_SW1); float* rwg = WSP(float, SM_RWG); float* rwe = WSP(float, SM_RWE); float* lab = WSP(float, SM_LAB);
    for (int i = gt; i < 2 * 24 * 1024; i += NT) { const int l = i / (24 * 1024), c = (i / 1024) % 24, k = i % 1024;
        const int col = c < 16 ? 5128 + c : (c < 20 ? 3584 + (c - 16) : 3588 + (c - 20));
        sw1[i] = INP(I_W_IN)[((size_t)l * 1024 + k) * IN_COLS + col]; }
    for (int i = gt; i < 2 * 4 * 1024; i += NT) { const int l = i / (4 * 1024), c = (i / 1024) % 4, k = i % 1024; rwg[i] = INP(I_RG_W)[((size_t)l * 1024 + k) * 4 + c]; }
    for (int i = gt; i < 2 * 32 * 1024; i += NT) { const int l = i / (32 * 1024), c = (i / 1024) % 32, k = i % 1024; rwe[i] = INP(I_RE_W)[((size_t)l * 1024 + k) * 32 + c]; }
    for (int i = gt; i < 2 * 512; i += NT) { const int l = i / 512, c = i % 512; const float l0 = INP(I_LB)[c], l1 = INP(I_LB)[512 + c];
        const float p1 = 1.0f / (1.0f + expf(l0 - l1)); const float lb = l == 0 ? 0.f : p1;
        lab[l * 1024 + c] = lb; lab[l * 1024 + 512 + c] = 1.0f - lb; }
}

__device__ __forceinline__ void convert_layer_weights(Frame& F, int l) {
    LAS float* scr = (LAS float*)(F.lds + F.wave * 16384);
    const int gw = F.bid * NWAVES + F.wave, NGW = F.G * NWAVES;
    const float* win = INP(I_W_IN) + (size_t)l * 1024 * IN_COLS;
    constexpr int I_MIX = 16 * 176, I_GATE = 16 * 96, I_BR = 8 * 32, I_OUT = 16 * 32, NITEMS = I_MIX + I_GATE + 3 * I_BR + I_OUT;
    for (int it = gw; it < NITEMS; it += NGW) {
        int r = it;
        if (r < I_MIX) { const int nb = r % 176, n0 = 32 * nb; const int shift = n0 < 3584 ? 0 : (n0 < 5120 ? 8 : 24);
            transpose_item(win + shift, IN_COLS, 1024, 176, WSP(bf16_t, WS_WMIX), 0, 0, scr, r, F.lane); continue; } r -= I_MIX;
        if (r < I_GATE) { transpose_item(win + 5656, IN_COLS, 1024, 96, WSP(bf16_t, WS_WGATE), 0, 0, scr, r, F.lane); continue; } r -= I_GATE;
        if (r < 3 * I_BR) { const int n = r / I_BR; transpose_item(INP(I_W_BRANCH) + ((size_t)l * 3 + n) * 512 * 1024, 1024, 512, 32, WSP(bf16_t, WS_WBT) + (size_t)n * 1024 * 512, 0, 0, scr, r % I_BR, F.lane); continue; } r -= 3 * I_BR;
        transpose_item(INP(I_W_OUT) + (size_t)l * 1024 * 1024, 1024, 1024, 32, WSP(bf16_t, WS_WOT), 0, 0, scr, r, F.lane);
    }
}
__device__ __forceinline__ void convert_expert_weights(Frame& F, int l) {
    LAS float* scr = (LAS float*)(F.lds + F.wave * 16384);
    const int gw = F.bid * NWAVES + F.wave, NGW = F.G * NWAVES;
    constexpr int I_G = 16 * 8, I_D = 4 * 32, PER = 2 * I_G + I_D;
    for (int it = gw; it < 32 * PER; it += NGW) {
        const int e = it / PER; int r = it % PER;
        bf16_t* w1t = WSP(bf16_t, WS_W1T) + (size_t)e * 512 * 1024; bf16_t* w2t = WSP(bf16_t, WS_W2T) + (size_t)e * 1024 * 256;
        if (r < I_G) { transpose_item(INP(I_EW_GATE) + ((size_t)l * 32 + e) * 1024 * 256, 256, 1024, 8, w1t, 0, 1, scr, r, F.lane); continue; } r -= I_G;
        if (r < I_G) { transpose_item(INP(I_EW_UP) + ((size_t)l * 32 + e) * 1024 * 256, 256, 1024, 8, w1t, 0, 2, scr, r, F.lane); continue; } r -= I_G;
        transpose_item(INP(I_EW_DOWN) + ((size_t)l * 32 + e) * 256 * 1024, 1024, 256, 32, w2t, 0, 0, scr, r, F.lane);
    }
}

#define OUTP ((float*)F.out)
__device__ __forceinline__ float* hrow(Frame& F, int r) { return r < NREAL ? OUTP + (size_t)r * D : WSP(float, WS_HMETA) + (size_t)(r - NREAL) * D; }

__device__ __forceinline__ void load_row16(const float* p, int lane, float (&x)[16]) {
#pragma unroll
    for (int j = 0; j < 4; ++j) { const f32x4 v = *((const f32x4*)p + lane + 64 * j); x[4 * j] = v[0]; x[4 * j + 1] = v[1]; x[4 * j + 2] = v[2]; x[4 * j + 3] = v[3]; }
}
__device__ __forceinline__ void add_bf16_row16(const bf16_t* p, int lane, float (&x)[16]) {
#pragma unroll
    for (int j = 0; j < 4; ++j) { const u32x2 w = *((const u32x2*)p + lane + 64 * j); x[4 * j] += bflo(w.x); x[4 * j + 1] += bfhi(w.x); x[4 * j + 2] += bflo(w.y); x[4 * j + 3] += bfhi(w.y); }
}
__device__ __forceinline__ void store_row16(float* p, int lane, const float (&x)[16]) {
#pragma unroll
    for (int j = 0; j < 4; ++j) *((f32x4*)p + lane + 64 * j) = (f32x4){x[4 * j], x[4 * j + 1], x[4 * j + 2], x[4 * j + 3]};
}
__device__ __forceinline__ void store_bf16_row16(bf16_t* p, int lane, const float (&x)[16]) {
#pragma unroll
    for (int j = 0; j < 4; ++j) { u32x2 w; w.x = pk2(x[4 * j], x[4 * j + 1]); w.y = pk2(x[4 * j + 2], x[4 * j + 3]); *((u32x2*)p + lane + 64 * j) = w; }
}
__device__ __forceinline__ void fetch_h_row(Frame& F, int l, int r, float (&x)[16]) {
    if (l == 0) {
        const float* src = r < NREAL ? INP(I_X) + (size_t)r * D : INP(I_META) + (size_t)(r - META_ROW0) * D;
        load_row16(src, F.lane, x);
    } else {
        load_row16(hrow(F, r), F.lane, x);
        const unsigned* tok = WSP(unsigned, SM_TOK) + (size_t)r * 8;
        const unsigned g0 = tok[6], g1 = tok[7];
        add_bf16_row16(WSP(bf16_t, WS_Y2) + (size_t)g0 * 1024, F.lane, x);
        add_bf16_row16(WSP(bf16_t, WS_Y2) + (size_t)g1 * 1024, F.lane, x);
    }
}

__device__ __forceinline__ void phase_norm1(Frame& F, int l) {
    convert_layer_weights(F, l);
    __syncthreads();
    LAS float* sw = (LAS float*)F.lds;
    { const float* src = WSP(float, SM_SW1) + (size_t)l * 24 * 1024; for (int i = F.tid; i < 24 * 1024 / 4; i += NTHREADS) ((LAS f32x4*)sw)[i] = ((const f32x4*)src)[i]; }
    __syncthreads();
    const int gw = F.bid * NWAVES + F.wave, NGW = F.G * NWAVES, lane = F.lane;
    const float* nw = INP(I_NORM_MIX) + (size_t)l * D;
    float wv[16]; load_row16(nw, lane, wv);
    bf16_t* U = WSP(bf16_t, WS_U);
    const float alog_l = (lane >= 20 && lane < 24) ? INP(I_GDN_ALOG)[l * 4 + (lane - 20)] : 0.f, dt_l = (lane >= 20 && lane < 24) ? INP(I_GDN_DT)[l * 4 + (lane - 20)] : 0.f;
    const float nega_l = -expf(alog_l);
    for (int g = gw; g < MROWS / 4; g += NGW) {
        const int r0 = 4 * g;
        if (!row_valid(r0)) {
            float z[16];
#pragma unroll
            for (int j = 0; j < 16; ++j) z[j] = 0.f;
#pragma unroll
            for (int i = 0; i < 4; ++i) { store_bf16_row16(U + (size_t)(r0 + i) * D, lane, z); if (l == 0) store_row16(hrow(F, r0 + i), lane, z);
                if (lane < 16) WSP(float, SM_GK)[(size_t)(r0 + i) * 16 + lane] = 0.f;
                else if (lane < 20) WSP(float, SM_BETA)[(size_t)(r0 + i) * 4 + (lane - 16)] = 0.f;
                else if (lane < 24) WSP(float, SM_LOGA)[(size_t)(r0 + i) * 4 + (lane - 20)] = 0.f; }
            continue;
        }
        float x[4][16];
#pragma unroll
        for (int i = 0; i < 4; ++i) {
            fetch_h_row(F, l, r0 + i, x[i]);
            store_row16(hrow(F, r0 + i), lane, x[i]);
            float ss = 0.f;
#pragma unroll
            for (int j = 0; j < 16; ++j) ss += x[i][j] * x[i][j];
            const float rstd = rsqrtf(wave_sum(ss) * (1.0f / D) + 1e-6f);
#pragma unroll
            for (int j = 0; j < 16; ++j) x[i][j] = x[i][j] * rstd * wv[j];
            store_bf16_row16(U + (size_t)(r0 + i) * D, lane, x[i]);
        }
        float ov[4] = {0.f, 0.f, 0.f, 0.f};
#pragma unroll 2
        for (int c = 0; c < 24; ++c) {
            float a0 = 0.f, a1 = 0.f, a2 = 0.f, a3 = 0.f;
#pragma unroll
            for (int j = 0; j < 4; ++j) { const f32x4 w = *((const LAS f32x4*)(sw + c * 1024) + lane + 64 * j);
#pragma unroll
                for (int e = 0; e < 4; ++e) { a0 += x[0][4 * j + e] * w[e]; a1 += x[1][4 * j + e] * w[e]; a2 += x[2][4 * j + e] * w[e]; a3 += x[3][4 * j + e] * w[e]; } }
            a0 = wave_sum(a0); a1 = wave_sum(a1); a2 = wave_sum(a2); a3 = wave_sum(a3);
            if (lane == c) { ov[0] = a0; ov[1] = a1; ov[2] = a2; ov[3] = a3; }
        }
        float* GK = WSP(float, SM_GK); float* BETA = WSP(float, SM_BETA); float* LOGA = WSP(float, SM_LOGA);
#pragma unroll
        for (int i = 0; i < 4; ++i) {
            const float v = ov[i]; const int r = r0 + i;
            if (lane < 16) GK[(size_t)r * 16 + lane] = v;
            else if (lane < 20) BETA[(size_t)r * 4 + (lane - 16)] = sigmoidf_(v);
            else if (lane < 24) { const int h = lane - 20; LOGA[(size_t)r * 4 + h] = nega_l * softplusf_(v + dt_l); }
        }
    }
}

__device__ __forceinline__ bf16x8 mk8(u32x4 w) { return __builtin_bit_cast(bf16x8, w); }
__device__ __forceinline__ bf16x8 mk8(u32x2 lo, u32x2 hi) { u32x4 w; w.x = lo.x; w.y = lo.y; w.z = hi.x; w.w = hi.y; return __builtin_bit_cast(bf16x8, w); }
__device__ __forceinline__ bf16x8 pack_acc2(const f32x4& a, const f32x4& b) { u32x4 w; w.x = pk2(a[0], a[1]); w.y = pk2(a[2], a[3]); w.z = pk2(b[0], b[1]); w.w = pk2(b[2], b[3]); return __builtin_bit_cast(bf16x8, w); }
#define MFMA16(a, b, c) __builtin_amdgcn_mfma_f32_16x16x32_bf16((a), (b), (c), 0, 0, 0)

__device__ __forceinline__ int permpos(int k) { const int kk = k & 31; return (k & ~31) + ((kk & 16) ? 8 * ((kk - 16) >> 2) + 4 + (kk & 3) : 8 * (kk >> 2) + (kk & 3)); }
__device__ __forceinline__ float ldbf(GAS const bf16_t* p) { return bf2f(*p); }
#define ROWB(P, row, col) ((GAS const char*)(P) + ((size_t)(row) * LDP + (col)) * 2)
__device__ __forceinline__ float ldrow(GAS const char* rb, unsigned voff) { return bf2f(*(GAS const bf16_t*)(rb + voff)); }
__device__ __forceinline__ unsigned ldrow_u(GAS const char* rb, unsigned voff) { return (unsigned)*(GAS const bf16_t*)(rb + voff); }
__device__ __forceinline__ void strow(GAS const char* rb, unsigned voff, bf16_t v) { *(GAS bf16_t*)(rb + voff) = v; }

template <int DK, bool IS_A>
__device__ __forceinline__ void prep_gla(Frame& F, int l, int ug) {
    constexpr int QP = DK + 8, VP = 136, SUB = 2 * 64 * QP * 2 + 1024 + 4096 + 64 * VP * 2;
    PROF_MARK(F, IS_A ? 7 : 8);
    int tid = F.tid; asm volatile("" : "+v"(tid));
    const int sg = __builtin_amdgcn_readfirstlane(tid >> 8), lt = tid & 255, c = lt & 127, hf = __builtin_amdgcn_readfirstlane(lt >> 7);
    const int unit = 2 * ug + sg, slot = unit >> 2, h = unit & 3, row0 = slot * 64, r0 = row0 + 32 * hf;
    const int qcol = IS_A ? PC_AQ + h * 128 : PC_CQ + h * 64, kcol = IS_A ? PC_AF + h * 128 : PC_CK + h * 64, vcol = IS_A ? PC_AI + h * 128 : PC_CV + h * 128;
    bf16_t* P = WSP(bf16_t, WS_P);
    LAS bf16_t* qt = (LAS bf16_t*)(F.lds + sg * SUB);
    LAS bf16_t* kt = qt + 64 * QP;
    LAS float* tot = (LAS float*)(kt + 64 * QP);
    const bool act = c < DK;
    LAS bf16_t* rv = (LAS bf16_t*)(tot + 256 + 1024);
    float w2c[16], bias = 0.f;
    if (!IS_A && c < DK) { const float* w2 = INP(I_GLA_W2) + (size_t)l * 16 * 256 + h * 64 + c; bias = INP(I_GLA_B)[l * 256 + h * 64 + c];
#pragma unroll
        for (int j = 0; j < 16; ++j) w2c[j] = w2[j * 256]; }
    { constexpr int PQ = DK / 8, PPR = 2 * PQ + 16;
        for (int idx = lt; idx < 64 * PPR; idx += 256) { const int row = idx / PPR, pc = idx % PPR;
            const int scol = pc < PQ ? qcol + 8 * pc : (pc < 2 * PQ ? kcol + 8 * (pc - PQ) : vcol + 8 * (pc - 2 * PQ));
            LAS bf16_t* dst = pc < PQ ? qt + row * QP + 8 * pc : (pc < 2 * PQ ? kt + row * QP + 8 * (pc - PQ) : rv + row * VP + 8 * (pc - 2 * PQ));
            *(LAS u32x4*)dst = *(const u32x4*)(P + (size_t)(row0 + row) * LDP + scol); } }
    if (!IS_A) { LAS float* gkl = tot + 256;
        ((LAS f32x4*)gkl)[lt] = ((const f32x4*)(WSP(float, SM_GK) + (size_t)row0 * 16))[lt]; }
    __syncthreads();
    PROF_MARKI(F, IS_A ? 29 : 19);
    float b[32];
    const unsigned vo = (unsigned)c * 2u, vop = (unsigned)permpos(c) * 2u;
    if (act) {
        float run = 0.f;
        if (IS_A) { const float* lab = WSP(float, SM_LAB) + l * 1024 + h * 128 + c; const float la = lab[0], lb = lab[512];
#pragma unroll
            for (int t = 0; t < 32; ++t) { run += pg8::lfg(la, lb, bf2f(kt[(32 * hf + t) * QP + c])); b[t] = run; }
        } else {
            const LAS f32x4* gk = (const LAS f32x4*)(tot + 256 + 32 * hf * 16);
#pragma unroll
            for (int tb = 0; tb < 32; tb += 4) { f32x4 g[16];
#pragma unroll
                for (int i = 0; i < 16; ++i) g[i] = gk[tb * 4 + i];
                asm volatile("" ::: "memory");
#pragma unroll
                for (int u = 0; u < 4; ++u) { float s = bias;
#pragma unroll
                    for (int j = 0; j < 16; ++j) s += g[4 * u + (j >> 2)][j & 3] * w2c[j];
                    run += logsigf_(s) * (1.0f / 16.0f); b[tb + u] = run; } }
        }
        tot[hf * 128 + c] = run;
    }
    __syncthreads();
    PROF_MARKI(F, IS_A ? 25 : 15);
    unsigned q1p[16], k1p[16];
    if (act) {
        const float bm = tot[c], bl = bm + tot[128 + c], boff = hf ? bm : 0.f;
        if (hf == 0 && !F.dry) (IS_A ? WSP(float, SM_DECA) + (size_t)unit * 128 : WSP(float, SM_DECC) + (size_t)unit * 64)[c] = __expf(bl);
#pragma unroll
        for (int t2 = 0; t2 < 16; ++t2) { float q1v[2], k1v[2];
#pragma unroll
            for (int u = 0; u < 2; ++u) { const int t = 2 * t2 + u; const float bt = b[t] + boff;
                const float qr = bf2f(qt[(32 * hf + t) * QP + c]), q = IS_A ? siluf_(qr) * 0.08838834764831845f : qr * 0.125f;
                float k;
                if (IS_A) { const float lf = t == 0 ? b[0] : b[t] - b[t - 1]; k = row_valid(r0 + t) ? 1.0f - __expf(lf) : 0.f; } else k = bf2f(kt[(32 * hf + t) * QP + c]);
                q1v[u] = q * __expf(bt); k1v[u] = k * __expf(bl - bt);
                qt[(32 * hf + t) * QP + c] = f2bf(q * __expf(fminf(bt - bm, 80.f))); kt[(32 * hf + t) * QP + c] = f2bf(k * __expf(fminf(bm - bt, 80.f))); }
            q1p[t2] = pk2(q1v[0], q1v[1]); k1p[t2] = pk2(k1v[0], k1v[1]); }
    }
    __syncthreads();
    PROF_MARKI(F, IS_A ? 26 : 16);
    if (act) {
        if (!F.dry) {
#pragma unroll
        for (int t2 = 0; t2 < 16; ++t2) { strow(ROWB(P, r0 + 2 * t2, qcol), vop, (bf16_t)(q1p[t2] & 0xffffu)); strow(ROWB(P, r0 + 2 * t2 + 1, qcol), vop, (bf16_t)(q1p[t2] >> 16)); } }
        bf16_t* kd = (IS_A ? P + (size_t)(row0 + (c >> 1)) * LDP + kcol + (c & 1) * 64 : P + (size_t)(row0 + c) * LDP + kcol) + 32 * hf;
#pragma unroll
        for (int o = 0; o < 4; ++o) if (!F.dry) *(u32x4*)(kd + 8 * o) = (u32x4){k1p[4 * o], k1p[4 * o + 1], k1p[4 * o + 2], k1p[4 * o + 3]};
    }
    { const int ws = (tid >> 6) & 3, lane = tid & 63, fr = lane & 15, fq = lane >> 4;
        bf16_t* sc = (IS_A ? WSP(bf16_t, WS_SCA) : WSP(bf16_t, WS_SCC)) + (size_t)unit * 4096;
#pragma unroll
        for (int jt = 0; jt < 4; ++jt) { const int mt = ws, nt = jt; f32x4 acc = {0.f, 0.f, 0.f, 0.f};
            if (nt <= mt) {
#pragma unroll
                for (int ks = 0; ks < DK / 32; ++ks) { const bf16x8 a = *(const LAS bf16x8*)(qt + (16 * mt + fr) * QP + 32 * ks + 8 * fq), bb = *(const LAS bf16x8*)(kt + (16 * nt + fr) * QP + 32 * ks + 8 * fq); acc = MFMA16(a, bb, acc); } }
#pragma unroll
            for (int r = 0; r < 4; ++r) { const int t = 16 * mt + 4 * fq + r, s = 16 * nt + fr; if (!F.dry) sc[t * 64 + s] = (s <= t) ? f2bf(acc[r]) : (bf16_t)0; } }
    }
    PROF_MARKI(F, IS_A ? 27 : 17);
    { unsigned vp[16];
#pragma unroll
        for (int t2 = 0; t2 < 16; ++t2) { vp[t2] = (unsigned)rv[(32 * hf + 2 * t2) * VP + c] | ((unsigned)rv[(32 * hf + 2 * t2 + 1) * VP + c] << 16); }
        PROF_MARKI(F, IS_A ? 28 : 18);
        bf16_t* vd = P + (size_t)(row0 + (c >> 1)) * LDP + vcol + (c & 1) * 64 + 32 * hf;
#pragma unroll
        for (int o = 0; o < 4; ++o) if (!F.dry) *(u32x4*)(vd + 8 * o) = (u32x4){vp[4 * o], vp[4 * o + 1], vp[4 * o + 2], vp[4 * o + 3]}; }
    __syncthreads();
    PROF_MARK(F, IS_A ? 13 : 14);
}

__device__ __forceinline__ void prep_gdn(Frame& F, int l, int ug) {
    constexpr int NP = 136, SUB = 2 * 64 * NP * 2 + 64 * 68 * 4 + 1024 + 2304;
    PROF_MARK(F, 1);
    int tid = F.tid; asm volatile("" : "+v"(tid));
    const int lane = tid & 63, sg = __builtin_amdgcn_readfirstlane(tid >> 8), lt = tid & 255, unit = 2 * ug + sg, slot = unit >> 2, h = unit & 3, row0 = slot * 64;
    bf16_t* P = WSP(bf16_t, WS_P);
    LAS bf16_t* qs = (LAS bf16_t*)(F.lds + sg * SUB);
    LAS bf16_t* ks = qs + 64 * NP;
    LAS float* AT = (LAS float*)(F.lds + sg * SUB + 2 * 64 * NP * 2);
    LAS float* gs = AT + 64 * 68;
    if (lt < 64) { const int valid_u = 1; (void)valid_u; float g = WSP(float, SM_LOGA)[(size_t)(row0 + lt) * 4 + h];
#pragma unroll
        for (int o = 1; o < 64; o <<= 1) { const float t = __shfl_up(g, o); if (lane >= o) g += t; }
        gs[lt] = g; gs[64 + lt] = WSP(float, SM_BETA)[(size_t)(row0 + lt) * 4 + h];
        if (lt == 63 && !F.dry) WSP(float, SM_DECB)[unit] = __expf(g); }
    const int hslot = slot == 256 ? -1 : ((slot & 63) == 0 ? 256 : slot - 1);
    LAS bf16_t* rvs = (LAS bf16_t*)AT;
    LAS bf16_t* hl = (LAS bf16_t*)(gs + 256);
    for (int idx = lt; idx < 64 * 48; idx += 256) { const int row = idx / 48, pc = idx % 48, comp = pc >> 4, c8 = (pc & 15) * 8;
        const u32x4 v = *(const u32x4*)(P + (size_t)(row0 + row) * LDP + PC_BQKV + comp * 512 + h * 128 + c8);
        *(LAS u32x4*)((comp == 0 ? qs : (comp == 1 ? ks : rvs)) + row * NP + c8) = v; }
    if (lt < 144) { const int rr = lt / 48, pc = lt % 48, comp = pc >> 4, c8 = (pc & 15) * 8; u32x4 v = {0u, 0u, 0u, 0u};
        if (hslot >= 0) v = *(const u32x4*)(WSP(bf16_t, SM_HALO) + ((size_t)hslot * 3 + rr) * 1536 + comp * 512 + h * 128 + c8);
        *(LAS u32x4*)(hl + rr * 384 + comp * 128 + c8) = v; }
    __syncthreads();
    PROF_MARKG(F, 2);
    float col[64];
    {
        const int c = lt & 127;
#pragma unroll
        for (int pass = 0; pass < 2; ++pass) {
            if (pass == 1 && lt >= 128) break;
            const int comp = lt >= 128 ? 1 : (pass == 0 ? 0 : 2), ch = comp * 512 + h * 128 + c;
            const float w0 = INP(I_GDN_CONV)[((size_t)l * 4 + 0) * 1536 + ch], w1 = INP(I_GDN_CONV)[((size_t)l * 4 + 1) * 1536 + ch], w2 = INP(I_GDN_CONV)[((size_t)l * 4 + 2) * 1536 + ch], w3 = INP(I_GDN_CONV)[((size_t)l * 4 + 3) * 1536 + ch];
            LAS bf16_t* src = (comp == 0 ? qs : (comp == 1 ? ks : rvs)) + c;
            float x0 = bf2f(hl[comp * 128 + c]), x1 = bf2f(hl[384 + comp * 128 + c]), x2 = bf2f(hl[768 + comp * 128 + c]);
#pragma unroll
            for (int t = 0; t < 64; ++t) { const float x3 = bf2f(src[t * NP]); const float y = siluf_(w0 * x0 + w1 * x1 + w2 * x2 + w3 * x3); x0 = x1; x1 = x2; x2 = x3;
                if (comp == 0) src[t * NP] = f2bf(y); else { col[t] = y; if (comp == 1) src[t * NP] = f2bf(y); } }
        }
    }
    __syncthreads();
    PROF_MARKG(F, 3);
    const int wv = (tid >> 6) & 3, fr = lane & 15, fq = lane >> 4;
#pragma unroll
    for (int jt = 0; jt < 2; ++jt) { const int which = jt, mt = wv; const LAS bf16_t* ap = which ? qs : ks; f32x4 a4 = {0.f, 0.f, 0.f, 0.f};
#pragma unroll
        for (int k4 = 0; k4 < 4; ++k4) { const bf16x8 a = *(const LAS bf16x8*)(ap + (16 * mt + fr) * NP + 32 * k4 + 8 * fq); a4 = MFMA16(a, a, a4); }
#pragma unroll
        for (int r = 0; r < 4; ++r) if (4 * fq + r == fr) { if (which == 0) gs[128 + 16 * mt + fr] = rsqrtf(a4[r] + 1e-6f); else gs[192 + 16 * mt + fr] = rsqrtf(a4[r] + 1e-6f) * 0.08838834764831845f; } }
    __syncthreads();
    { bf16_t* qkd = WSP(bf16_t, WS_QKD) + (size_t)unit * 4096;
#pragma unroll
        for (int jt = 0; jt < 8; ++jt) { const int tile = wv * 8 + jt, which = tile >> 4, mt = (tile >> 2) & 3, nt = tile & 3;
            const LAS bf16_t* ap = which ? qs : ks; f32x4 a4 = {0.f, 0.f, 0.f, 0.f};
            if (nt <= mt) {
#pragma unroll
                for (int k4 = 0; k4 < 4; ++k4) { const bf16x8 a = *(const LAS bf16x8*)(ap + (16 * mt + fr) * NP + 32 * k4 + 8 * fq), bb = *(const LAS bf16x8*)(ks + (16 * nt + fr) * NP + 32 * k4 + 8 * fq); a4 = MFMA16(a, bb, a4); } }
#pragma unroll
            for (int r = 0; r < 4; ++r) { const int t = 16 * mt + 4 * fq + r, s = 16 * nt + fr; const float dec = __expf(fminf(gs[t] - gs[s], 0.f)) * gs[128 + s];
                if (which) { if (!F.dry) qkd[t * 64 + permpos(s)] = (s <= t) ? f2bf(a4[r] * dec * gs[192 + t]) : (bf16_t)0; }
                else AT[s * 68 + t] = (s < t) ? gs[64 + t] * gs[128 + t] * a4[r] * dec : 0.f; } }
    }
    PROF_MARKG(F, 4);
    if (lt >= 128) { const int d = lt - 128; const float gl = gs[63]; bf16_t* dst = WSP(bf16_t, WS_K1TB) + (size_t)unit * 8192 + d * 64;
#pragma unroll
        for (int o = 0; o < 8; ++o) { const int s0 = 32 * (o >> 2) + 4 * (o & 3); float y[8];
#pragma unroll
            for (int j = 0; j < 8; ++j) { const int s = s0 + (j & 3) + (j >> 2) * 16; y[j] = col[s] * gs[128 + s] * __expf(gl - gs[s]); }
            if (!F.dry) *(u32x4*)(dst + 8 * o) = (u32x4){pk2(y[0], y[1]), pk2(y[2], y[3]), pk2(y[4], y[5]), pk2(y[6], y[7])}; }
    } else { const int pp = permpos(lt);
#pragma unroll 8
        for (int t = 0; t < 64; ++t) if (!F.dry) P[(size_t)(row0 + t) * LDP + PC_BQKV + h * 128 + pp] = f2bf(bf2f(qs[t * NP + lt]) * gs[192 + t] * __expf(gs[t])); }
    __syncthreads();
    PROF_MARKG(F, 5);
#pragma unroll
    for (int i = 0; i < 64; ++i) col[i] *= lt < 128 ? gs[64 + i] : gs[64 + i] * gs[128 + i] * __expf(gs[i]);
#pragma unroll
    for (int j = 0; j < 63; ++j) { const float xj = col[j]; asm volatile("" ::: "memory");
#pragma unroll
        for (int q4 = (j + 1) >> 2; q4 < 16; ++q4) { const f32x4 a = *(const LAS f32x4*)(AT + j * 68 + 4 * q4);
#pragma unroll
            for (int e = 0; e < 4; ++e) if (4 * q4 + e > j) col[4 * q4 + e] -= a[e] * xj; } }
    PROF_MARKG(F, 6);
    int tid2 = F.tid; asm volatile("" : "+v"(tid2)); const int lt2 = tid2 & 255, unit2 = 2 * ug + __builtin_amdgcn_readfirstlane(tid2 >> 8), row02 = (unit2 >> 2) * 64, h2 = unit2 & 3;
    if (lt2 < 128) { bf16_t* dst = P + (size_t)(row02 + (lt2 >> 1)) * LDP + PC_BQKV + 1024 + h2 * 128 + (lt2 & 1) * 64;
#pragma unroll
        for (int o = 0; o < 8; ++o) if (!F.dry) *(u32x4*)(dst + 8 * o) = (u32x4){pk2(col[8 * o], col[8 * o + 1]), pk2(col[8 * o + 2], col[8 * o + 3]), pk2(col[8 * o + 4], col[8 * o + 5]), pk2(col[8 * o + 6], col[8 * o + 7])};
    } else { const int pp = permpos(lt2 - 128);
        if (!F.dry) {
#pragma unroll
        for (int t = 0; t < 64; ++t) strow(ROWB(P, row02 + t, PC_BQKV + 512 + h2 * 128), (unsigned)pp * 2u, f2bf(col[t])); } }
    __syncthreads();
    PROF_MARK(F, 9);
}

constexpr int SETC = 13, NSETS = 65 / SETC;
static_assert(SETC * NSETS == 65, "sets must tile the 65 scan steps");
__device__ __forceinline__ void prep_set(Frame& F, int l, int set, int nblk, int bidx) {
    const int nsl = set == 0 ? 1 + 4 * (SETC - 1) : 4 * SETC, np = 2 * nsl;
    auto ug_of = [&](int vp) { const int j = vp >> 1; int slot;
        if (set == 0) slot = j == 0 ? 256 : ((j - 1) / (SETC - 1)) * 64 + (j - 1) % (SETC - 1);
        else slot = (j / SETC) * 64 + SETC * set - 1 + j % SETC;
        return 2 * slot + (vp & 1); };
    int i = bidx, stride = nblk;
    if (nblk >= 2 * np - 16) { if (bidx < np) stride = 3 * np; else stride = nblk - np; }
    for (; i < np; i += stride) prep_gdn(F, l, ug_of(i));
    for (; i < 2 * np; i += stride) prep_gla<128, true>(F, l, ug_of(i - np));
    for (; i < 3 * np; i += stride) prep_gla<64, false>(F, l, ug_of(i - 2 * np));
}
constexpr int SCAN_BUF = 57344;
template <int MX> struct ScanCfg;
template <> struct ScanCfg<0> { static constexpr int NM = 3, NI = 5; static constexpr int off(int m) { return m == 0 ? 0 : (m == 1 ? 16384 : 32768); } static constexpr int pitch(int m) { return m == 0 ? 256 : 128; } };
template <> struct ScanCfg<1> { static constexpr int NM = 4, NI = 7; static constexpr int off(int m) { return 16384 * m; } static constexpr int pitch(int m) { return m < 2 ? 256 : 128; } };
template <> struct ScanCfg<2> { static constexpr int NM = 3, NI = 3; static constexpr int off(int m) { return 8192 * m; } static constexpr int pitch(int m) { return 128; } };

#define SCAN_GRID_BARRIER() do { xcd_barrier(WSP(unsigned, WS_CTL) + CW_BAR, xb_xcc_id(), (volatile LAS unsigned*)(F.lds + LDS_MISC) + 8, F.tid, (unsigned)F.G); asm volatile("" ::: "memory"); } while (0)
template <int MX>
__device__ __forceinline__ void scan_mixer(Frame& F, int b, int h) {
    typedef ScanCfg<MX> C;
    constexpr int DK = MX == 2 ? 64 : 128, NT = DK / 16, NI = C::NI;
    const int w = F.wave, lane = F.lane, fr = lane & 15, fq = lane >> 4, ecol = 16 * w + fr;
    const char* Pb = (const char*)WSP(bf16_t, WS_P);
    const int qcol = MX == 0 ? PC_AQ + h * 128 : (MX == 1 ? PC_BQKV + h * 128 : PC_CQ + h * 64);
    const int kcol = MX == 0 ? PC_AF + h * 128 : (MX == 1 ? PC_BQKV + 512 + h * 128 : PC_CK + h * 64);
    const int vcol = MX == 0 ? PC_AI + h * 128 : (MX == 1 ? PC_BQKV + 1024 + h * 128 : PC_CV + h * 128);
    const char* SCb = (const char*)(MX == 0 ? WSP(bf16_t, WS_SCA) : (MX == 1 ? WSP(bf16_t, WS_QKD) : WSP(bf16_t, WS_SCC)));
    bf16_t* O = WSP(bf16_t, WS_O) + (size_t)MX * MROWS * 512;
    unsigned voff[NI]; int mi[NI];
#pragma unroll
    for (int i = 0; i < NI; ++i) { const int n = w + 8 * i, o = 1024 * n + 16 * lane; int m = 0;
#pragma unroll
        for (int q = 1; q < C::NM; ++q) if (o >= C::off(q)) m = q;
        int ro = o, pitch = 128;
#pragma unroll
        for (int q = 0; q < C::NM; ++q) if (m == q) { ro = o - C::off(q); pitch = C::pitch(q); }
        const int r = ro / pitch, pos = (ro % pitch) >> 4, pc = pos ^ (pitch == 256 ? (r & 15) : ((r >> 1) & 7));
        const bool packed = (MX == 0 && m == 1);
        const bool inP = (MX == 1) ? (m < 2) : (m < 2);
        voff[i] = (unsigned)(inP ? (packed ? (r >> 1) * (LDP * 2) + (r & 1) * 128 : r * (LDP * 2)) : r * pitch) + 16u * pc; mi[i] = m; }
    const unsigned x256_0 = (unsigned)(((0 | fq) ^ fr) << 4), x256_1 = (unsigned)(((4 | fq) ^ fr) << 4), x256_2 = (unsigned)(((8 | fq) ^ fr) << 4), x256_3 = (unsigned)(((12 | fq) ^ fr) << 4);
    const unsigned x128_0 = (unsigned)(((0 | fq) ^ ((fr >> 1) & 7)) << 4), x128_1 = (unsigned)(((4 | fq) ^ ((fr >> 1) & 7)) << 4);
    const unsigned x256[4] = {x256_0, x256_1, x256_2, x256_3}, x128[2] = {x128_0, x128_1};
#define SC_FRAG(buf, m, rt, kp) (*(const LAS bf16x8*)(F.lds + (buf) + C::off(m) + (16 * (rt) + fr) * C::pitch(m) + (C::pitch(m) == 256 ? x256[kp] : x128[(kp) & 1])))
    auto slot_of = [&](int step) { return step == 0 ? 256 : b * 64 + step - 1; };
    auto issue = [&](int step, int buf) {
        const int slot = slot_of(step), row0 = slot * 64, unit = slot * 4 + h;
        const char* base[4];
        if (MX == 1) { base[0] = Pb + ((size_t)row0 * LDP + kcol) * 2; base[1] = Pb + ((size_t)row0 * LDP + qcol) * 2; base[2] = (const char*)WSP(bf16_t, WS_K1TB) + (size_t)unit * 16384; base[3] = SCb + (size_t)unit * 8192; }
        else { base[0] = Pb + ((size_t)row0 * LDP + qcol) * 2; base[1] = Pb + ((size_t)row0 * LDP + kcol) * 2; base[2] = SCb + (size_t)unit * 8192; base[3] = base[2]; }
#pragma unroll
        for (int i = 0; i < NI; ++i) { const char* bs = mi[i] == 0 ? base[0] : (mi[i] == 1 ? base[1] : (mi[i] == 2 ? base[2] : base[3]));
            __builtin_amdgcn_global_load_lds((const unsigned*)(bs + voff[i]), (LAS unsigned*)(F.lds + buf + 1024 * (w + 8 * i)), 16, 0, 0); }
    };
    auto load_priv = [&](int step, u32x4 (&pv)[2]) {
        const int row0 = slot_of(step) * 64;
        const bf16_t* vt = (const bf16_t*)Pb + (size_t)(row0 + (ecol >> 1)) * LDP + vcol + (ecol & 1) * 64;
        if (MX == 1) { const u32x2 a = *(const u32x2*)(vt + 4 * fq), c = *(const u32x2*)(vt + 16 + 4 * fq), d = *(const u32x2*)(vt + 32 + 4 * fq), e = *(const u32x2*)(vt + 48 + 4 * fq);
            pv[0] = (u32x4){a.x, a.y, c.x, c.y}; pv[1] = (u32x4){d.x, d.y, e.x, e.y}; }
        else { pv[0] = *(const u32x4*)(vt + 8 * fq); pv[1] = *(const u32x4*)(vt + 32 + 8 * fq); }
    };
    f32x4 S[NT];
#pragma unroll
    for (int i = 0; i < NT; ++i) S[i] = (f32x4){0.f, 0.f, 0.f, 0.f};
    u32x4 pcur[2], pnxt[2];
    auto first_of_set = [](int s) { return s > 0 && s % SETC == 0; };
    issue(0, 0); load_priv(0, pcur);
    for (int step = 0; step < 65; ++step) {
        const int buf = (step & 1) * SCAN_BUF, slot = slot_of(step), row0 = slot * 64, unit = slot * 4 + h;
        if (first_of_set(step)) { PROF_MARK(F, 20); SCAN_GRID_BARRIER(); PROF_MARK(F, 21); issue(step, buf); load_priv(step, pcur); }
        asm volatile("s_waitcnt vmcnt(0)" ::: "memory");
        __syncthreads();
        if (step + 1 < 65 && !first_of_set(step + 1)) { issue(step + 1, SCAN_BUF - buf); load_priv(step + 1, pnxt); }
        bf16x8 Sb[NT / 2];
#pragma unroll
        for (int kp = 0; kp < NT / 2; ++kp) Sb[kp] = pack_acc2(S[2 * kp], S[2 * kp + 1]);
        if (MX == 1) {
            f32x4 vn[4];
#pragma unroll
            for (int mt = 0; mt < 4; ++mt) { f32x4 acc = {0.f, 0.f, 0.f, 0.f};
#pragma unroll
                for (int kp = 0; kp < 4; ++kp) acc = MFMA16(SC_FRAG(buf, 0, mt, kp), Sb[kp], acc);
                const unsigned u0 = mt == 0 ? pcur[0].x : (mt == 1 ? pcur[0].z : (mt == 2 ? pcur[1].x : pcur[1].z)), u1 = mt == 0 ? pcur[0].y : (mt == 1 ? pcur[0].w : (mt == 2 ? pcur[1].y : pcur[1].w));
                vn[mt] = (f32x4){bflo(u0) - acc[0], bfhi(u0) - acc[1], bflo(u1) - acc[2], bfhi(u1) - acc[3]}; }
            bf16x8 Vb[2]; Vb[0] = pack_acc2(vn[0], vn[1]); Vb[1] = pack_acc2(vn[2], vn[3]);
#pragma unroll
            for (int mt = 0; mt < 4; ++mt) { f32x4 acc = {0.f, 0.f, 0.f, 0.f};
#pragma unroll
                for (int kp = 0; kp < 4; ++kp) acc = MFMA16(SC_FRAG(buf, 1, mt, kp), Sb[kp], acc);
#pragma unroll
                for (int kp = 0; kp < 2; ++kp) acc = MFMA16(SC_FRAG(buf, 3, mt, kp), Vb[kp], acc);
#pragma unroll
                for (int r = 0; r < 4; ++r) O[(size_t)(row0 + 16 * mt + 4 * fq + r) * 512 + h * 128 + ecol] = f2bf(acc[r]); }
            const float a = WSP(float, SM_DECB)[unit];
#pragma unroll
            for (int i = 0; i < 8; ++i) { S[i] = S[i] * a;
#pragma unroll
                for (int kp = 0; kp < 2; ++kp) S[i] = MFMA16(SC_FRAG(buf, 2, i, kp), Vb[kp], S[i]); }
        } else {
            const bf16x8 bv0 = mk8(pcur[0]), bv1 = mk8(pcur[1]);
#pragma unroll
            for (int mt = 0; mt < 4; ++mt) { f32x4 acc = {0.f, 0.f, 0.f, 0.f};
#pragma unroll
                for (int kp = 0; kp < NT / 2; ++kp) acc = MFMA16(SC_FRAG(buf, 0, mt, kp), Sb[kp], acc);
                acc = MFMA16(SC_FRAG(buf, 2, mt, 0), bv0, acc); acc = MFMA16(SC_FRAG(buf, 2, mt, 1), bv1, acc);
#pragma unroll
                for (int r = 0; r < 4; ++r) O[(size_t)(row0 + 16 * mt + 4 * fq + r) * 512 + h * 128 + ecol] = f2bf(acc[r]); }
            const float* dec = (MX == 0 ? WSP(float, SM_DECA) : WSP(float, SM_DECC)) + (size_t)unit * DK;
#pragma unroll
            for (int i = 0; i < NT; ++i) { const f32x4 d4 = *(const f32x4*)(dec + 16 * i + 4 * fq); S[i] = S[i] * d4;
                S[i] = MFMA16(SC_FRAG(buf, 1, i, 0), bv0, S[i]); S[i] = MFMA16(SC_FRAG(buf, 1, i, 1), bv1, S[i]); }
        }
        pcur[0] = pnxt[0]; pcur[1] = pnxt[1];
    }
#undef SC_FRAG
    asm volatile("s_waitcnt vmcnt(0)" ::: "memory");
    __syncthreads();
    PROF_MARK(F, 22);
}
__device__ __forceinline__ void phase_scan(Frame& F, int l) {
#if PROF_ON
    if (F.bid >= 48) { for (int k = 1; k < NSETS; ++k) { PROF_MARK(F, 10); prep_set(F, l, k, F.G - 48, F.bid - 48); PROF_MARK(F, 11); SCAN_GRID_BARRIER(); PROF_MARK(F, 12); } return; }
#else
    if (F.bid >= 48) { for (int k = 1; k < NSETS; ++k) { prep_set(F, l, k, F.G - 48, F.bid - 48); SCAN_GRID_BARRIER(); } return; }
#endif
    const int mixer = F.bid >> 4, b = (F.bid >> 2) & 3, h = F.bid & 3;
    if (mixer == 0) scan_mixer<0>(F, b, h);
    else if (mixer == 1) scan_mixer<1>(F, b, h);
    else scan_mixer<2>(F, b, h);
}

template <int KIND>
__device__ __forceinline__ void meta_gemm(Frame& F, const bf16_t* A, const bf16_t* Bt, int N, int K, int n) {
    const int gw = F.bid * NWAVES + F.wave, NGW = F.G * NWAVES, lane = F.lane, fr = lane & 15, fq = lane >> 4;
    for (int tile = gw; tile < N / 16; tile += NGW) {
        const bf16_t* ar = A + (size_t)fr * K + 8 * fq; const bf16_t* br = Bt + (size_t)(16 * tile + fr) * K + 8 * fq;
        f32x4 acc = {0.f, 0.f, 0.f, 0.f};
#pragma unroll 8
        for (int ks = 0; ks < K / 32; ++ks) acc = MFMA16(mk8(*(const u32x4*)(ar + 32 * ks)), mk8(*(const u32x4*)(br + 32 * ks)), acc);
#pragma unroll
        for (int r = 0; r < 4; ++r) { const int row = META_ROW0 + 4 * fq + r, col = 16 * tile + fr;
            if (KIND == 0) WSP(bf16_t, WS_GT)[(size_t)row * 3072 + col] = f2bf(sigmoidf_(acc[r]));
            else if (KIND == 1) { bf16_t* mp = WSP(bf16_t, WS_MERGED) + (size_t)row * 1024 + col; const float g = bf2f(WSP(bf16_t, WS_GT)[(size_t)row * 3072 + n * 1024 + col]);
                *mp = f2bf((n ? bf2f(*mp) : 0.f) + g * acc[r]); }
            else { float* hp = WSP(float, WS_HMETA) + (size_t)(row - NREAL) * D + col; *hp = *hp + acc[r]; } }
    }
}

__device__ __forceinline__ void phase_hnorm(Frame& F, int l) {
    const int gw = F.bid * NWAVES + F.wave, NGW = F.G * NWAVES, lane = F.lane;
    const bf16_t* P = WSP(bf16_t, WS_P);
    LAS float* nws = (LAS float*)F.lds;
    if (F.tid < 384) { const int mxw = F.tid >> 7; const float* src = mxw == 0 ? INP(I_HGRN_NORM) : (mxw == 1 ? INP(I_GDN_NORM) : INP(I_GLA_NORM)); nws[F.tid] = src[(size_t)l * 128 + (F.tid & 127)]; }
    __syncthreads();
    for (int r = gw; r < MROWS; r += NGW) {
        bf16_t* op0 = WSP(bf16_t, WS_O) + (size_t)r * 512 + 8 * lane;
        if (!row_valid(r)) { if (!F.dry) {
#pragma unroll
            for (int mx = 0; mx < 3; ++mx) *(u32x4*)(op0 + (size_t)mx * MROWS * 512) = (u32x4){0u, 0u, 0u, 0u}; } continue; }
        u32x4 ow[3], gv[3];
#pragma unroll
        for (int mx = 0; mx < 3; ++mx) { ow[mx] = *(const u32x4*)(op0 + (size_t)mx * MROWS * 512); gv[mx] = *(const u32x4*)(P + (size_t)r * LDP + (mx == 0 ? PC_AG : (mx == 1 ? PC_BG : PC_CG)) + 8 * lane); }
#pragma unroll
        for (int mx = 0; mx < 3; ++mx) {
            const LAS float* nw = nws + mx * 128 + (8 * lane & 127);
            float o[8] = {bflo(ow[mx].x), bfhi(ow[mx].x), bflo(ow[mx].y), bfhi(ow[mx].y), bflo(ow[mx].z), bfhi(ow[mx].z), bflo(ow[mx].w), bfhi(ow[mx].w)};
            const float g[8] = {siluf_(bflo(gv[mx].x)), siluf_(bfhi(gv[mx].x)), siluf_(bflo(gv[mx].y)), siluf_(bfhi(gv[mx].y)), siluf_(bflo(gv[mx].z)), siluf_(bfhi(gv[mx].z)), siluf_(bflo(gv[mx].w)), siluf_(bfhi(gv[mx].w))};
            float ss = 0.f;
#pragma unroll
            for (int j = 0; j < 8; ++j) ss += o[j] * o[j];
            ss += __shfl_xor(ss, 1); ss += __shfl_xor(ss, 2); ss += __shfl_xor(ss, 4); ss += __shfl_xor(ss, 8);
            const float rstd = rsqrtf(ss * (1.0f / 128.0f) + 1e-6f);
            const f32x4 n0 = *(const LAS f32x4*)nw, n1 = *(const LAS f32x4*)(nw + 4);
            const float nv[8] = {n0[0], n0[1], n0[2], n0[3], n1[0], n1[1], n1[2], n1[3]};
#pragma unroll
            for (int j = 0; j < 8; ++j) o[j] = o[j] * rstd * nv[j] * g[j];
            u32x4 y; y.x = pk2(o[0], o[1]); y.y = pk2(o[2], o[3]); y.z = pk2(o[4], o[5]); y.w = pk2(o[6], o[7]);
            if (!F.dry) *(u32x4*)(op0 + (size_t)mx * MROWS * 512) = y;
        }
    }
}

__device__ __forceinline__ void phase_norm2(Frame& F, int l) {
    if (!F.dry) convert_expert_weights(F, l);
    __syncthreads();
    LAS float* sw = (LAS float*)F.lds;
    { const float* src = WSP(float, SM_RWE) + (size_t)l * 32 * 1024; for (int i = F.tid; i < 32 * 1024 / 4; i += NTHREADS) ((LAS f32x4*)sw)[i] = ((const f32x4*)src)[i]; }
    LAS float* rbias = sw + 32 * 1024;
    if (F.tid < 32) rbias[F.tid] = INP(I_RE_B)[l * 32 + F.tid]; else if (F.tid < 36) rbias[F.tid] = INP(I_RG_B)[l * 4 + (F.tid - 32)];
    __syncthreads();
    const int gw = F.bid * NWAVES + F.wave, NGW = F.G * NWAVES, lane = F.lane;
    float wv[16]; load_row16(INP(I_NORM_FFN) + (size_t)l * D, lane, wv);
    bf16_t* U = WSP(bf16_t, WS_U);
    const float* rwg = WSP(float, SM_RWG) + (size_t)l * 4 * 1024;
    unsigned* cnt = WSP(unsigned, WS_CTL) + CW_CNT + l * 64;
    LAS unsigned* lcnt = (LAS unsigned*)(F.lds + LDS_TAB);
    if (F.tid < 64) lcnt[F.tid] = 0u;
    __syncthreads();
    for (int g = gw; g < MROWS / 4; g += NGW) {
        const int r0 = 4 * g;
        if (!row_valid(r0)) continue;
        float x[4][16];
#pragma unroll
        for (int i = 0; i < 4; ++i) {
            load_row16(hrow(F, r0 + i), lane, x[i]);
            float ss = 0.f;
#pragma unroll
            for (int j = 0; j < 16; ++j) ss += x[i][j] * x[i][j];
            const float rstd = rsqrtf(wave_sum(ss) * (1.0f / D) + 1e-6f);
#pragma unroll
            for (int j = 0; j < 16; ++j) x[i][j] = x[i][j] * rstd * wv[j];
            if (!F.dry) store_bf16_row16(U + (size_t)(r0 + i) * D, lane, x[i]);
        }
#ifndef NORM2_SKIP
#define NORM2_SKIP 0
#endif
        if (F.dry && (NORM2_SKIP & 4)) continue;
        float lg[4][4];
#pragma unroll
        for (int c = 0; c < 4; ++c) {
            float a0 = 0.f, a1 = 0.f, a2 = 0.f, a3 = 0.f;
#pragma unroll
            for (int j = 0; j < 4; ++j) { const f32x4 w = *((const f32x4*)(rwg + c * 1024) + lane + 64 * j);
#pragma unroll
                for (int e = 0; e < 4; ++e) { a0 += x[0][4 * j + e] * w[e]; a1 += x[1][4 * j + e] * w[e]; a2 += x[2][4 * j + e] * w[e]; a3 += x[3][4 * j + e] * w[e]; } }
            const float bg = rbias[32 + c];
            lg[0][c] = wave_sum(a0) + bg; lg[1][c] = wave_sum(a1) + bg; lg[2][c] = wave_sum(a2) + bg; lg[3][c] = wave_sum(a3) + bg;
        }
#pragma unroll
        for (int i = 0; i < 4; ++i) {
            int gi = 0; float gm = lg[i][0];
#pragma unroll
            for (int c = 1; c < 4; ++c) if (lg[i][c] > gm) { gm = lg[i][c]; gi = c; }
            float gsum = 0.f;
#pragma unroll
            for (int c = 0; c < 4; ++c) gsum += __expf(lg[i][c] - gm);
            const float gval = 1.0f / gsum;
            gi = __builtin_amdgcn_readfirstlane(gi);
            int ea = 0, eb = 0; float la = -3.0e38f, lb = -3.0e38f;
            const LAS float* swg = sw + gi * 8 * 1024;
#pragma unroll 1
            for (int cb = 0; cb < ((F.dry && (NORM2_SKIP & 2)) ? 0 : 8); cb += 4) {
                float a0 = 0.f, a1 = 0.f, a2 = 0.f, a3 = 0.f;
#pragma unroll
                for (int j = 0; j < 4; ++j) { const f32x4 w0 = *((const LAS f32x4*)(swg + (cb + 0) * 1024) + lane + 64 * j), w1 = *((const LAS f32x4*)(swg + (cb + 1) * 1024) + lane + 64 * j), w2 = *((const LAS f32x4*)(swg + (cb + 2) * 1024) + lane + 64 * j), w3 = *((const LAS f32x4*)(swg + (cb + 3) * 1024) + lane + 64 * j);
#pragma unroll
                    for (int e = 0; e < 4; ++e) { const float xv = x[i][4 * j + e]; a0 += xv * w0[e]; a1 += xv * w1[e]; a2 += xv * w2[e]; a3 += xv * w3[e]; } }
                const float e0 = wave_sum(a0) + rbias[gi * 8 + cb], e1 = wave_sum(a1) + rbias[gi * 8 + cb + 1], e2 = wave_sum(a2) + rbias[gi * 8 + cb + 2], e3 = wave_sum(a3) + rbias[gi * 8 + cb + 3];
                const float ev[4] = {e0, e1, e2, e3};
#pragma unroll
                for (int q = 0; q < 4; ++q) { const float el = ev[q]; const int c = cb + q; if (el > la) { lb = la; eb = ea; la = el; ea = c; } else if (el > lb) { lb = el; eb = c; } }
            }
            const float wa = 1.0f / (1.0f + __expf(lb - la)), wb = 1.0f - wa;
            if (lane == 0 && !F.dry) {
                const unsigned e0 = (unsigned)(gi * 8 + ea), e1 = (unsigned)(gi * 8 + eb);
                const unsigned p0 = __hip_atomic_fetch_add(lcnt + e0, 1u, __ATOMIC_RELAXED, __HIP_MEMORY_SCOPE_WORKGROUP), p1 = __hip_atomic_fetch_add(lcnt + e1, 1u, __ATOMIC_RELAXED, __HIP_MEMORY_SCOPE_WORKGROUP);
                unsigned* tok = WSP(unsigned, SM_TOK) + (size_t)(r0 + i) * 8;
                tok[0] = e0; tok[1] = p0; tok[2] = e1; tok[3] = p1; tok[4] = __float_as_uint(gval * wa); tok[5] = __float_as_uint(gval * wb);
            }
        }
    }
    __syncthreads();
    if (F.tid < 32 && !F.dry) lcnt[32 + F.tid] = atomicAdd(cnt + F.tid, lcnt[F.tid]);
    __syncthreads();
    if (!F.dry) for (int g = gw; g < MROWS / 4; g += NGW) { const int r0 = 4 * g; if (!row_valid(r0)) continue;
        if (lane < 4) { unsigned* tok = WSP(unsigned, SM_TOK) + (size_t)(r0 + lane) * 8; tok[1] += lcnt[32 + tok[0]]; tok[3] += lcnt[32 + tok[2]]; } }
}

__device__ __forceinline__ int moe_tables(Frame& F, int l) {
    LAS int* offs = (LAS int*)(F.lds + LDS_TAB); LAS unsigned char* tab = (LAS unsigned char*)(F.lds + LDS_TAB + 384); LAS int* cn = (LAS int*)(F.lds + LDS_TAB + 192);
    const unsigned* cnt = WSP(unsigned, WS_CTL) + CW_CNT + l * 64;
    __syncthreads();
    if (F.tid < 32) cn[F.tid] = (int)__hip_atomic_load(cnt + F.tid, __ATOMIC_RELAXED, __HIP_MEMORY_SCOPE_AGENT);
    __syncthreads();
    if (F.tid == 0) { int acc = 0;
#pragma unroll 1
        for (int e = 0; e < 32; ++e) { offs[e] = acc; acc += ((cn[e] + 255) >> 8) << 8; }
        offs[32] = acc; }
    __syncthreads();
    if (F.tid < 160) { const int row = F.tid << 8; int e = 0;
#pragma unroll 1
        for (int k = 1; k < 32; ++k) if (offs[k] <= row) e = k;
        tab[F.tid] = (unsigned char)e; }
    __syncthreads();
    return offs[32] >> 8;
}

__device__ __forceinline__ void phase_gather(Frame& F, int l) {
    (void)moe_tables(F, l);
    const LAS int* offs = (const LAS int*)(F.lds + LDS_TAB); const LAS int* cn = (const LAS int*)(F.lds + LDS_TAB + 192);
    const int gw = F.bid * NWAVES + F.wave, NGW = F.G * NWAVES, lane = F.lane;
    const bf16_t* U = WSP(bf16_t, WS_U); bf16_t* XG = WSP(bf16_t, WS_XG); float* wrow = WSP(float, SM_WROW);
    for (int idx = gw; idx < NREAL + 16; idx += 2 * NGW) {
        const int idx2 = idx + NGW; const bool has2 = idx2 < NREAL + 16;
        const int r = idx < NREAL ? idx : META_ROW0 + (idx - NREAL), r2 = has2 ? (idx2 < NREAL ? idx2 : META_ROW0 + (idx2 - NREAL)) : r;
        unsigned* tok = WSP(unsigned, SM_TOK) + (size_t)r * 8; unsigned* tok2 = WSP(unsigned, SM_TOK) + (size_t)r2 * 8;
        const u32x4 ta = *(const u32x4*)tok, tb = *(const u32x4*)tok2; const u32x2 wa = *(const u32x2*)(tok + 4), wb = *(const u32x2*)(tok2 + 4);
        const unsigned g0 = (unsigned)offs[ta.x] + ta.y, g1 = (unsigned)offs[ta.z] + ta.w, h0 = (unsigned)offs[tb.x] + tb.y, h1 = (unsigned)offs[tb.z] + tb.w;
        const u32x4* src = (const u32x4*)(U + (size_t)r * D); const u32x4* src2 = (const u32x4*)(U + (size_t)r2 * D);
        const u32x4 a = src[lane], b = src[lane + 64], c = src2[lane], d = src2[lane + 64];
        if (lane == 0) { tok[6] = g0; tok[7] = g1; wrow[g0] = __uint_as_float(wa.x); wrow[g1] = __uint_as_float(wa.y); }
        u32x4* d0 = (u32x4*)(XG + (size_t)g0 * D); u32x4* d1 = (u32x4*)(XG + (size_t)g1 * D);
        d0[lane] = a; d0[lane + 64] = b; d1[lane] = a; d1[lane + 64] = b;
        if (has2) { if (lane == 0) { tok2[6] = h0; tok2[7] = h1; wrow[h0] = __uint_as_float(wb.x); wrow[h1] = __uint_as_float(wb.y); }
            u32x4* e0 = (u32x4*)(XG + (size_t)h0 * D); u32x4* e1 = (u32x4*)(XG + (size_t)h1 * D);
            e0[lane] = c; e0[lane + 64] = d; e1[lane] = c; e1[lane + 64] = d; }
    }
    u32x4 zz = {0u, 0u, 0u, 0u}; asm volatile("" : "+v"(zz));
    for (int i = gw; i < 32 * 256; i += NGW) { const int e = i >> 8, j = i & 255; const int row = offs[e] + cn[e] + j;
        if (row < offs[e + 1]) { u32x4* d = (u32x4*)(XG + (size_t)row * D); d[lane] = zz; d[lane + 64] = zz; if (lane == 0) wrow[row] = 0.f; } }
}

__device__ __forceinline__ void phase_final(Frame& F) {
    const int gw = F.bid * NWAVES + F.wave, NGW = F.G * NWAVES, lane = F.lane;
    float wv[16]; load_row16(INP(I_NORM_FINAL), lane, wv);
    for (int r = gw; r < NREAL; r += 2 * NGW) {
        const int r2 = r + NGW;
        float x[16], y[16]; fetch_h_row(F, 2, r, x); fetch_h_row(F, 2, r2, y);
        float ss = 0.f, s2 = 0.f;
#pragma unroll
        for (int j = 0; j < 16; ++j) { ss += x[j] * x[j]; s2 += y[j] * y[j]; }
        const float rstd = rsqrtf(wave_sum(ss) * (1.0f / D) + 1e-6f), rstd2 = rsqrtf(wave_sum(s2) * (1.0f / D) + 1e-6f);
#pragma unroll
        for (int j = 0; j < 16; ++j) { x[j] = x[j] * rstd * wv[j]; y[j] = y[j] * rstd2 * wv[j]; }
        store_row16(OUTP + (size_t)r * D, lane, x); store_row16(OUTP + (size_t)r2 * D, lane, y);
    }
}
constexpr int PH_PER_LAYER = 14, N_PHASES = 2 + 2 * PH_PER_LAYER;
#ifndef DBG_STOP
#define DBG_STOP 0
#endif
#ifndef DBG_SRC
#define DBG_SRC WS_P
#define DBG_LD LDP
#endif
#ifndef DBG_TA
#define DBG_TA -1
#endif
#ifndef DBG_TQ
#define DBG_TQ 16.0f
#endif
#ifndef DBG_TB
#define DBG_TB -1
#endif
#ifndef DUP_MASK
#define DUP_MASK 0u
#endif
#define DUPN(j) (((DUP_MASK >> (j)) & 1u) ? 2 : 1)
#ifndef MK_ONE_LAUNCH
#define MK_ONE_LAUNCH 1
#endif

template <unsigned PHMASK_T>
__global__ void __launch_bounds__(NTHREADS, 2) hybrid_fwd(Params p) {
    extern __shared__ __attribute__((aligned(16))) unsigned char lds_raw[];
    Frame F;
    F.lds = (LAS unsigned char*)lds_raw; F.tid = threadIdx.x; F.lane = F.tid & 63; F.wave = __builtin_amdgcn_readfirstlane(F.tid >> 6); F.G = gridDim.x; F.bid = blockIdx.x; F.dry = 0;
    F.out = (GAS float*)p.out; F.ws = (GAS unsigned char*)p.ws; F.inp = (const float* const __attribute__((address_space(4)))*)__builtin_amdgcn_kernarg_segment_ptr();
    volatile LAS unsigned* MISC = (volatile LAS unsigned*)(F.lds + LDS_MISC);
    if (F.tid < 128) MISC[F.tid] = 0u;
    __syncthreads();
#if MK_ONE_LAUNCH
    constexpr int lo = 0, hi = N_PHASES;
#else
    const int lo = p.ph_lo, hi = p.ph_hi;
#endif
    if (hi - lo > 1) (void)xcd_barrier_post(WSP(unsigned, WS_CTL) + CW_BAR, MISC + 8);
#define GRID_BARRIER() xcd_barrier(WSP(unsigned, WS_CTL) + CW_BAR, xb_xcc_id(), (volatile LAS unsigned*)(F.lds + LDS_MISC) + 8, F.tid, (unsigned)F.G)
#define EN(j) ((PHMASK_T >> (j)) & 1u)
#define IN(k) (lo <= (k) && (k) < hi)
    if (DBG_TA >= 0 && F.tid == 0) { MISC[16] = (unsigned)__builtin_amdgcn_s_memrealtime(); MISC[17] = 0u; }
#define SEAM(k) do { if (IN(k) && IN((k) + 1)) GRID_BARRIER(); PHASE_FENCE(F); \
    if (DBG_TA >= 0 && F.tid == 0) { const unsigned t_now = (unsigned)__builtin_amdgcn_s_memrealtime(); const int kk = (k) == 0 ? 15 : (((k) - 1) % PH_PER_LAYER); const int kind = (kk >= 6 && kk <= 8) ? 6 : kk; \
        if (kind == DBG_TA) MISC[17] += t_now - MISC[16]; MISC[16] = t_now; } } while (0)
    PHASE_FENCE(F);
    if (EN(15) && IN(0)) phase_pre(F);
    SEAM(0);
    { constexpr int l = 0;
        const int pb = 1 + PH_PER_LAYER * l;
        for (int rep = 0; rep < (l == 0 ? DUPN(0) : 1); ++rep) { if (rep) { GRID_BARRIER(); PHASE_FENCE(F); } if (EN(0) && IN(pb + 0)) phase_norm1(F, l); }
        SEAM(pb + 0);
        for (int rep = 0; rep < DUPN(1); ++rep) { if (rep) { GRID_BARRIER(); PHASE_FENCE(F); }
        if (EN(1) && IN(pb + 1)) {
            pg8::Gemm g{WSP(bf16_t, WS_U), WSP(bf16_t, WS_WMIX), MROWS, LDP, D}; pg8::StaticOrder S; S.init(MROWS, LDP, F.G, F.bid);
            pg8::EpiInProj E{WSP(bf16_t, WS_P), WSP(bf16_t, SM_HALO)};
            pg8::gemm_phase(F.lds, F.tid, g, S, E);
        } }
        SEAM(pb + 1);
        if (EN(2) && IN(pb + 2)) prep_set(F, l, 0, F.G, F.bid);
        SEAM(pb + 2);
        if (EN(3) && IN(pb + 3)) phase_scan(F, l);
        SEAM(pb + 3);
        for (int rep = 0; rep < DUPN(4); ++rep) { if (rep) { GRID_BARRIER(); PHASE_FENCE(F); F.dry = 1; asm volatile("" : "+s"(F.dry)); } if (EN(4) && IN(pb + 4)) phase_hnorm(F, l); F.dry = 0; }
        SEAM(pb + 4);
        for (int rep = 0; rep < DUPN(5); ++rep) { if (rep) { GRID_BARRIER(); PHASE_FENCE(F); }
        if (EN(5) && IN(pb + 5)) {
            pg8::Gemm g{WSP(bf16_t, WS_U), WSP(bf16_t, WS_WGATE), NREAL, 3072, D}; pg8::StaticOrder S; S.init(NREAL, 3072, F.G, F.bid);
            pg8::EpiSigmoid E{WSP(bf16_t, WS_GT), 3072};
            pg8::gemm_phase(F.lds, F.tid, g, S, E);
            meta_gemm<0>(F, WSP(bf16_t, WS_U) + (size_t)META_ROW0 * D, WSP(bf16_t, WS_WGATE), 3072, D, 0);
        } }
        SEAM(pb + 5);
        for (int n = 0; n < 3; ++n) {
            if (EN(6) && IN(pb + 6 + n)) {
                pg8::Gemm g{WSP(bf16_t, WS_O) + (size_t)n * MROWS * 512, WSP(bf16_t, WS_WBT) + (size_t)n * 1024 * 512, NREAL, D, 512}; pg8::StaticOrder S; S.init(NREAL, D, F.G, F.bid);
                pg8::EpiBranch E{WSP(bf16_t, WS_MERGED), WSP(bf16_t, WS_GT), n};
                pg8::gemm_phase(F.lds, F.tid, g, S, E);
                meta_gemm<1>(F, WSP(bf16_t, WS_O) + (size_t)n * MROWS * 512 + (size_t)META_ROW0 * 512, WSP(bf16_t, WS_WBT) + (size_t)n * 1024 * 512, D, 512, n);
            }
            SEAM(pb + 6 + n);
        }
        if (EN(9) && IN(pb + 9)) {
            pg8::Gemm g{WSP(bf16_t, WS_MERGED), WSP(bf16_t, WS_WOT), NREAL, D, D}; pg8::StaticOrder S; S.init(NREAL, D, F.G, F.bid);
            pg8::EpiResidual E{OUTP, WSP(float, WS_HMETA)};
            pg8::gemm_phase(F.lds, F.tid, g, S, E);
            meta_gemm<2>(F, WSP(bf16_t, WS_MERGED) + (size_t)META_ROW0 * D, WSP(bf16_t, WS_WOT), D, D, 0);
        }
        SEAM(pb + 9);
        for (int rep = 0; rep < DUPN(10); ++rep) { if (rep) { GRID_BARRIER(); PHASE_FENCE(F); F.dry = 1; asm volatile("" : "+s"(F.dry)); } if (EN(10) && IN(pb + 10)) phase_norm2(F, l); F.dry = 0; }
        SEAM(pb + 10);
        for (int rep = 0; rep < DUPN(11); ++rep) { if (rep) { GRID_BARRIER(); PHASE_FENCE(F); } if (EN(11) && IN(pb + 11)) phase_gather(F, l); }
        SEAM(pb + 11);
        for (int rep = 0; rep < DUPN(12); ++rep) { if (rep) { GRID_BARRIER(); PHASE_FENCE(F); }
        if (EN(12) && IN(pb + 12)) {
            const int ntiles = moe_tables(F, l);
            pg8::Gemm g{WSP(bf16_t, WS_XG), WSP(bf16_t, WS_W1T), XG_ROWS, 512, D};
            pg8::MoeOrder S{F.G, F.bid, 2, ntiles, (const LAS unsigned char*)(F.lds + LDS_TAB + 384), (size_t)512 * 1024 * 2};
            pg8::EpiMoeUp E{WSP(bf16_t, WS_HG)};
            pg8::gemm_phase(F.lds, F.tid, g, S, E);
        } }
        SEAM(pb + 12);
        for (int rep = 0; rep < DUPN(13); ++rep) { if (rep) { GRID_BARRIER(); PHASE_FENCE(F); }
        if (EN(13) && IN(pb + 13)) {
            const int ntiles = moe_tables(F, l);
            pg8::Gemm g{WSP(bf16_t, WS_HG), WSP(bf16_t, WS_W2T), XG_ROWS, D, 256};
            pg8::MoeOrder S{F.G, F.bid, 4, ntiles, (const LAS unsigned char*)(F.lds + LDS_TAB + 384), (size_t)1024 * 256 * 2};
            pg8::EpiMoeDown E{WSP(bf16_t, WS_Y2), WSP(float, SM_WROW)};
            pg8::gemm_phase(F.lds, F.tid, g, S, E);
        } }
        SEAM(pb + 13);
    }
    { constexpr int l = 1;
        const int pb = 1 + PH_PER_LAYER * l;
        for (int rep = 0; rep < (l == 0 ? DUPN(0) : 1); ++rep) { if (rep) { GRID_BARRIER(); PHASE_FENCE(F); } if (EN(0) && IN(pb + 0)) phase_norm1(F, l); }
        SEAM(pb + 0);
        for (int rep = 0; rep < DUPN(1); ++rep) { if (rep) { GRID_BARRIER(); PHASE_FENCE(F); }
        if (EN(1) && IN(pb + 1)) {
            pg8::Gemm g{WSP(bf16_t, WS_U), WSP(bf16_t, WS_WMIX), MROWS, LDP, D}; pg8::StaticOrder S; S.init(MROWS, LDP, F.G, F.bid);
            pg8::EpiInProj E{WSP(bf16_t, WS_P), WSP(bf16_t, SM_HALO)};
            pg8::gemm_phase(F.lds, F.tid, g, S, E);
        } }
        SEAM(pb + 1);
        if (EN(2) && IN(pb + 2)) prep_set(F, l, 0, F.G, F.bid);
        SEAM(pb + 2);
        if (EN(3) && IN(pb + 3)) phase_scan(F, l);
        SEAM(pb + 3);
        for (int rep = 0; rep < DUPN(4); ++rep) { if (rep) { GRID_BARRIER(); PHASE_FENCE(F); F.dry = 1; asm volatile("" : "+s"(F.dry)); } if (EN(4) && IN(pb + 4)) phase_hnorm(F, l); F.dry = 0; }
        SEAM(pb + 4);
        for (int rep = 0; rep < DUPN(5); ++rep) { if (rep) { GRID_BARRIER(); PHASE_FENCE(F); }
        if (EN(5) && IN(pb + 5)) {
            pg8::Gemm g{WSP(bf16_t, WS_U), WSP(bf16_t, WS_WGATE), NREAL, 3072, D}; pg8::StaticOrder S; S.init(NREAL, 3072, F.G, F.bid);
            pg8::EpiSigmoid E{WSP(bf16_t, WS_GT), 3072};
            pg8::gemm_phase(F.lds, F.tid, g, S, E);
            meta_gemm<0>(F, WSP(bf16_t, WS_U) + (size_t)META_ROW0 * D, WSP(bf16_t, WS_WGATE), 3072, D, 0);
        } }
        SEAM(pb + 5);
        for (int n = 0; n < 3; ++n) {
            if (EN(6) && IN(pb + 6 + n)) {
                pg8::Gemm g{WSP(bf16_t, WS_O) + (size_t)n * MROWS * 512, WSP(bf16_t, WS_WBT) + (size_t)n * 1024 * 512, NREAL, D, 512}; pg8::StaticOrder S; S.init(NREAL, D, F.G, F.bid);
                pg8::EpiBranch E{WSP(bf16_t, WS_MERGED), WSP(bf16_t, WS_GT), n};
                pg8::gemm_phase(F.lds, F.tid, g, S, E);
                meta_gemm<1>(F, WSP(bf16_t, WS_O) + (size_t)n * MROWS * 512 + (size_t)META_ROW0 * 512, WSP(bf16_t, WS_WBT) + (size_t)n * 1024 * 512, D, 512, n);
            }
            SEAM(pb + 6 + n);
        }
        if (EN(9) && IN(pb + 9)) {
            pg8::Gemm g{WSP(bf16_t, WS_MERGED), WSP(bf16_t, WS_WOT), NREAL, D, D}; pg8::StaticOrder S; S.init(NREAL, D, F.G, F.bid);
            pg8::EpiResidual E{OUTP, WSP(float, WS_HMETA)};
            pg8::gemm_phase(F.lds, F.tid, g, S, E);
            meta_gemm<2>(F, WSP(bf16_t, WS_MERGED) + (size_t)META_ROW0 * D, WSP(bf16_t, WS_WOT), D, D, 0);
        }
        SEAM(pb + 9);
        for (int rep = 0; rep < DUPN(10); ++rep) { if (rep) { GRID_BARRIER(); PHASE_FENCE(F); F.dry = 1; asm volatile("" : "+s"(F.dry)); } if (EN(10) && IN(pb + 10)) phase_norm2(F, l); F.dry = 0; }
        SEAM(pb + 10);
        for (int rep = 0; rep < DUPN(11); ++rep) { if (rep) { GRID_BARRIER(); PHASE_FENCE(F); } if (EN(11) && IN(pb + 11)) phase_gather(F, l); }
        SEAM(pb + 11);
        for (int rep = 0; rep < DUPN(12); ++rep) { if (rep) { GRID_BARRIER(); PHASE_FENCE(F); }
        if (EN(12) && IN(pb + 12)) {
            const int ntiles = moe_tables(F, l);
            pg8::Gemm g{WSP(bf16_t, WS_XG), WSP(bf16_t, WS_W1T), XG_ROWS, 512, D};
            pg8::MoeOrder S{F.G, F.bid, 2, ntiles, (const LAS unsigned char*)(F.lds + LDS_TAB + 384), (size_t)512 * 1024 * 2};
            pg8::EpiMoeUp E{WSP(bf16_t, WS_HG)};
            pg8::gemm_phase(F.lds, F.tid, g, S, E);
        } }
        SEAM(pb + 12);
        for (int rep = 0; rep < DUPN(13); ++rep) { if (rep) { GRID_BARRIER(); PHASE_FENCE(F); }
        if (EN(13) && IN(pb + 13)) {
            const int ntiles = moe_tables(F, l);
            pg8::Gemm g{WSP(bf16_t, WS_HG), WSP(bf16_t, WS_W2T), XG_ROWS, D, 256};
            pg8::MoeOrder S{F.G, F.bid, 4, ntiles, (const LAS unsigned char*)(F.lds + LDS_TAB + 384), (size_t)1024 * 256 * 2};
            pg8::EpiMoeDown E{WSP(bf16_t, WS_Y2), WSP(float, SM_WROW)};
            pg8::gemm_phase(F.lds, F.tid, g, S, E);
        } }
        SEAM(pb + 13);
    }
#if DBG_STOP > 0
    if (EN(14) && IN(N_PHASES - 1)) { const int gt = F.bid * NTHREADS + F.tid, NT = F.G * NTHREADS;
#ifdef DBG_LIN
        { const bf16_t* s1 = WSP(bf16_t, DBG_SRC); const bf16_t* s2 = WSP(bf16_t, DBG_SRC2);
          for (size_t i = gt; i < (size_t)NREAL * D; i += NT) F.out[i] = i < (size_t)DBG_N1 ? bf2f(s1[i]) : (i < (size_t)DBG_N1 + DBG_N2 ? bf2f(s2[i - DBG_N1]) : 0.f); }
#else
        if (DBG_LD > 0) { const bf16_t* src = WSP(bf16_t, DBG_SRC); for (size_t i = gt; i < (size_t)NREAL * D; i += NT) { const size_t r = i >> 10, c = i & 1023; F.out[i] = bf2f(src[r * DBG_LD + (c * DBG_LD) / 1024]); } }
#endif
    }
#else
#ifdef DBG_XBAR
    for (int i = 0; i < DBG_XBAR; ++i) { GRID_BARRIER(); PHASE_FENCE(F); }
#endif
    if (EN(14) && IN(N_PHASES - 1)) phase_final(F);
    PROF_SPIN(F);
    if (DBG_TA >= 0) { float* tw = WSP(float, WS_CTL) + 2048; if (F.bid == 0 && F.tid == 0) { tw[0] = (float)MISC[17] * 0.01f; }
        GRID_BARRIER(); PHASE_FENCE(F);
        const float v = floorf(WSP(float, WS_CTL)[2048] * (1.0f / DBG_TQ)) * 0.25f;
        const int gt = F.bid * NTHREADS + F.tid, NT = F.G * NTHREADS;
        for (size_t i = gt; i < (size_t)NREAL * D; i += NT) F.out[i] = v; }
#endif
#undef IN
#undef SEAM
}

#if MK_ONE_LAUNCH
#ifndef KM_ONE
#define KM_ONE 0xffffffffu
#endif
constexpr unsigned KMASK[1] = {KM_ONE};
#else
constexpr unsigned KMASK[3] = {0x0C19u, 0xC004u, 0x3262u};
#endif
template <unsigned M> static bool setup_kernel(int& per_cu) {
    if (hipFuncSetAttribute((const void*)hybrid_fwd<M>, hipFuncAttributeMaxDynamicSharedMemorySize, LDS_BYTES) != hipSuccess) return false;
    if (hipOccupancyMaxActiveBlocksPerMultiprocessor(&per_cu, (const void*)hybrid_fwd<M>, NTHREADS, LDS_BYTES) != hipSuccess) per_cu = 0;
    (void)hipGetLastError();
    return true;
}
static int phase_kind(int k) { if (k == 0) return 15; if (k == N_PHASES - 1) return 14; const int j = (k - 1) % PH_PER_LAYER; return (j >= 6 && j <= 8) ? 6 : j; }
extern "C" void kernel_launch(void* const* d_in, const int* in_sizes, int n_in, void* d_out, int out_size, void* d_ws, size_t ws_size, hipStream_t stream) {
    static int grid = 0;
    if (grid == 0) {
        if (n_in != 24 || in_sizes[0] != NREAL * D || out_size != NREAL * D || ws_size < WS_END) {
            fprintf(stderr, "kernel_launch: unexpected problem (n_in %d, in0 %d, out %d, ws %zu < %zu); nothing launched\n", n_in, n_in > 0 ? in_sizes[0] : -1, out_size, ws_size, (size_t)WS_END); grid = -1; return; }
        int dev = 0, cus = 0, per_cu = 0; bool ok = true;
        if (hipGetDevice(&dev) != hipSuccess || hipDeviceGetAttribute(&cus, hipDeviceAttributeMultiprocessorCount, dev) != hipSuccess) { grid = -1; return; }
#if MK_ONE_LAUNCH
        ok = setup_kernel<KMASK[0]>(per_cu);
#else
        ok = setup_kernel<KMASK[0]>(per_cu) && setup_kernel<KMASK[1]>(per_cu) && setup_kernel<KMASK[2]>(per_cu);
#endif
        if (!ok) { fprintf(stderr, "kernel_launch: hipFuncSetAttribute failed\n"); grid = -1; return; }
        if (per_cu < 1) fprintf(stderr, "kernel_launch: occupancy query says %d\n", per_cu);
        grid = cus;
    }
    if (grid < 0) return;
    if (hipMemsetAsync((char*)d_ws + WS_CTL, 0, CTL_BYTES, stream) != hipSuccess) return;
    Params p{};
    for (int i = 0; i < 24; ++i) p.in[i] = (const float*)d_in[i];
    p.out = (float*)d_out; p.ws = (unsigned char*)d_ws;
#if MK_ONE_LAUNCH
    p.ph_lo = 0; p.ph_hi = N_PHASES;
    hipLaunchKernelGGL(hybrid_fwd<KMASK[0]>, dim3(grid), dim3(NTHREADS), LDS_BYTES, stream, p);
#else
    for (int k = 0; k < N_PHASES; ++k) { if (DBG_STOP > 0 && k >= DBG_STOP && k != N_PHASES - 1) continue; p.ph_lo = k; p.ph_hi = k + 1; const unsigned bit = 1u << phase_kind(k);
        if (KMASK[0] & bit) hipLaunchKernelGGL(hybrid_fwd<KMASK[0]>, dim3(grid), dim3(NTHREADS), LDS_BYTES, stream, p);
        else if (KMASK[1] & bit) hipLaunchKernelGGL(hybrid_fwd<KMASK[1]>, dim3(grid), dim3(NTHREADS), LDS_BYTES, stream, p);
        else hipLaunchKernelGGL(hybrid_fwd<KMASK[2]>, dim3(grid), dim3(NTHREADS), LDS_BYTES, stream, p); }
#endif
}
```

```cpp
#include <hip/hip_runtime.h>
#include <cstdio>
#include <cstdint>

#define LAS __attribute__((address_space(3)))
typedef unsigned short bf16_t;
typedef short bf16x8 __attribute__((ext_vector_type(8)));
typedef float f32x4 __attribute__((ext_vector_type(4)));
typedef float f32x2 __attribute__((ext_vector_type(2)));
typedef unsigned u32x4 __attribute__((ext_vector_type(4)));
typedef unsigned u32x2 __attribute__((ext_vector_type(2)));

constexpr int D = 1024, NREAL = 16384, MROWS = 16640, META_ROW0 = 16384 + 48, META_END = 16384 + 64;
constexpr int NSLOT = 257;
constexpr int LDP = 5632;
constexpr int PC_AQ = 0, PC_AF = 512, PC_AI = 1024, PC_AG = 1536, PC_BQKV = 2048, PC_BG = 3584, PC_CQ = 4096, PC_CK = 4352, PC_CV = 4608, PC_CG = 5120;
constexpr int IN_COLS = 8728;
constexpr int NTHREADS = 512, NWAVES = 8;
constexpr int XG_ROWS = 40960;

constexpr size_t MiB = 1ull << 20;
constexpr size_t WS_CTL = 0, CTL_BYTES = 1 * MiB;
constexpr int CW_BAR = 4096, CW_CNT = 1024;
constexpr size_t SM_SW1 = 1 * MiB;
constexpr size_t SM_RWG = SM_SW1 + 2 * 24 * 1024 * 4;
constexpr size_t SM_RWE = SM_RWG + 2 * 4 * 1024 * 4;
constexpr size_t SM_LAB = SM_RWE + 2 * 32 * 1024 * 4;
constexpr size_t SM_GK = SM_LAB + 2 * 2 * 512 * 4;
constexpr size_t SM_BETA = SM_GK + (size_t)MROWS * 16 * 4;
constexpr size_t SM_LOGA = SM_BETA + (size_t)MROWS * 4 * 4;
constexpr size_t SM_TOK = SM_LOGA + (size_t)MROWS * 4 * 4;
constexpr size_t SM_WROW = SM_TOK + (size_t)MROWS * 8 * 4;
constexpr size_t SM_DECA = SM_WROW + (size_t)XG_ROWS * 4;
constexpr size_t SM_DECC = SM_DECA + 1028 * 128 * 4;
constexpr size_t SM_DECB = SM_DECC + 1028 * 64 * 4;
constexpr size_t SM_HALO = SM_DECB + 8192;
constexpr size_t SM_END = SM_HALO + 260 * 3 * 1536 * 2;
static_assert(SM_END <= 8 * MiB, "small region");
constexpr size_t WS_HMETA = 8 * MiB;
constexpr size_t WS_WMIX = 9 * MiB;
constexpr size_t WS_WGATE = 20 * MiB;
constexpr size_t WS_WBT = 26 * MiB;
constexpr size_t WS_WOT = 29 * MiB;
constexpr size_t WS_O = 31 * MiB;
constexpr size_t O_STRIDE = (size_t)MROWS * 512 * 2;
constexpr size_t WS_W1T = 31 * MiB;
constexpr size_t WS_W2T = 63 * MiB;
constexpr size_t WS_U = 80 * MiB;
constexpr size_t WS_P = 113 * MiB;
constexpr size_t WS_GT = 113 * MiB;
constexpr size_t WS_MERGED = 211 * MiB;
constexpr size_t WS_XG = 113 * MiB;
constexpr size_t WS_HG = 193 * MiB;
constexpr size_t WS_Y2 = 213 * MiB;
constexpr size_t WS_SCA = 294 * MiB;
constexpr size_t WS_QKD = 303 * MiB;
constexpr size_t WS_SCC = 312 * MiB;
constexpr size_t WS_K1TB = 321 * MiB;
constexpr size_t WS_END = 338 * MiB;

constexpr int LDS_BYTES = 163840;
constexpr int LDS_MISC = LDS_BYTES - 512;
constexpr int LDS_TAB = LDS_BYTES - 1536;
constexpr int LDS_SCRATCH = LDS_TAB;

typedef __bf16 bf16x2v __attribute__((ext_vector_type(2)));
__device__ __forceinline__ unsigned pk2(float lo, float hi) { const f32x2 v = {lo, hi}; return __builtin_bit_cast(unsigned, __builtin_convertvector(v, bf16x2v)); }
__device__ __forceinline__ bf16_t f2bf(float f) { return (bf16_t)(pk2(f, 0.f) & 0xffffu); }
__device__ __forceinline__ float bf2f(bf16_t b) { return __uint_as_float(((unsigned)b) << 16); }
__device__ __forceinline__ float bflo(unsigned w) { return __uint_as_float(w << 16); }
__device__ __forceinline__ float bfhi(unsigned w) { return __uint_as_float(w & 0xffff0000u); }
__device__ __forceinline__ float sigmoidf_(float x) { return __builtin_amdgcn_rcpf(1.0f + __expf(-x)); }
__device__ __forceinline__ float siluf_(float x) { return x * __builtin_amdgcn_rcpf(1.0f + __expf(-x)); }
__device__ __forceinline__ float logsigf_(float x) { return fminf(x, 0.f) - __logf(1.0f + __expf(-fabsf(x))); }
__device__ __forceinline__ float softplusf_(float x) { return fmaxf(x, 0.f) + log1pf(__expf(-fabsf(x))); }
__device__ __forceinline__ bool row_valid(int r) { return r < NREAL || (r >= META_ROW0 && r < META_END); }
__device__ __forceinline__ float wave_sum(float v) {
#define DPP_ADD(ctrl, rmask) v += __int_as_float(__builtin_amdgcn_update_dpp(0, __float_as_int(v), (ctrl), (rmask), 0xf, false))
    DPP_ADD(0x111, 0xf); DPP_ADD(0x112, 0xf); DPP_ADD(0x114, 0xf); DPP_ADD(0x118, 0xf);
    DPP_ADD(0x142, 0xa); DPP_ADD(0x143, 0xc);
#undef DPP_ADD
    return __int_as_float(__builtin_amdgcn_readlane(__float_as_int(v), 63));
}
#define LDS_WAIT() asm volatile("s_waitcnt lgkmcnt(0)" ::: "memory")

#define XB_TMO      128
#define XB_XCNT(j)  (256  + 64 * (j))
#define XB_XSUB(j)  (1280 + 64 * (j))
#define XB_XGEN(j)  (2304 + 64 * (j))
#define XB_TOP      3328
#define XB_TOPGEN   3392
#define XCD_BAR_WORDS 3456
#define XB_SPIN_CAP (1u << 18)
__device__ __forceinline__ unsigned xb_ld(unsigned* p)              { return __hip_atomic_load(p, __ATOMIC_RELAXED, __HIP_MEMORY_SCOPE_AGENT); }
__device__ __forceinline__ unsigned xb_add(unsigned* p, unsigned v) { return __hip_atomic_fetch_add(p, v, __ATOMIC_RELAXED, __HIP_MEMORY_SCOPE_AGENT); }
__device__ __forceinline__ unsigned xb_xcc_id() { return (unsigned)__builtin_amdgcn_s_getreg((3 << 11) | 20) & 0xFu; }
#define XB_SPIN(cond, bar) do { unsigned _sp = 0; while (cond) { __builtin_amdgcn_s_sleep(1); \
    if ((++_sp & 255u) == 0u) { if (xb_ld(&(bar)[XB_TMO])) break; if (_sp > XB_SPIN_CAP) { atomicAdd(&(bar)[XB_TMO], 1u); break; } } } } while (0)
struct XcdBarrier { unsigned* bar; unsigned x; volatile LAS unsigned* st; };
__device__ __forceinline__ XcdBarrier xcd_barrier_post(unsigned* bar, volatile LAS unsigned* st) {
    XcdBarrier b; b.bar = bar; b.x = xb_xcc_id(); b.st = st;
    if (threadIdx.x == 0) (void)xb_add(&bar[XB_XCNT(b.x)], 1u);
    return b;
}
__device__ __forceinline__ void xcd_barrier_complete(unsigned* bar, unsigned x, unsigned& nloc, unsigned& nx, const unsigned G) {
    unsigned sum, cnt, mine, sp = 0u;
    for (;;) {
        sum = 0u; cnt = 0u; mine = 0u;
#pragma unroll
        for (unsigned j = 0; j < 16; ++j) { const unsigned c = xb_ld(&bar[XB_XCNT(j)]); sum += c; cnt += (c > 0u) ? 1u : 0u; mine = (j == x) ? c : mine; }
        if (sum == G) break;
        __builtin_amdgcn_s_sleep(1);
        if ((++sp & 255u) == 0u) { if (xb_ld(&bar[XB_TMO])) break; if (sp > XB_SPIN_CAP) { atomicAdd(&bar[XB_TMO], 1u); break; } }
    }
    nloc = mine > 0u ? mine : 1u; nx = cnt > 0u ? cnt : 1u;
}
__device__ __attribute__((noinline)) void xcd_barrier(unsigned* bar_, unsigned x_, volatile LAS unsigned* st_, int tid_, unsigned G_) {
    XcdBarrier b; b.bar = bar_; b.x = x_; b.st = st_;
    asm volatile("s_waitcnt vmcnt(0)" ::: "memory");
    __syncthreads();
    if (tid_ == 0) {
        unsigned* bar = b.bar;
        __builtin_amdgcn_s_waitcnt(0);
        unsigned nloc = b.st[0], nx = b.st[1];
        if (nloc == 0u) { xcd_barrier_complete(bar, b.x, nloc, nx, G_); b.st[0] = nloc; b.st[1] = nx; }
        const unsigned old = xb_add(&bar[XB_XSUB(b.x)], 1u);
        const unsigned gen = old / nloc;
        if (old + 1u == (gen + 1u) * nloc) {
            __builtin_amdgcn_fence(__ATOMIC_RELEASE, "agent");
            asm volatile("s_waitcnt vmcnt(0)" ::: "memory");
            const unsigned og = xb_add(&bar[XB_TOP], 1u);
            const unsigned tg = og / nx;
            if (og + 1u == (tg + 1u) * nx) xb_add(&bar[XB_TOPGEN], 1u);
            else XB_SPIN(xb_ld(&bar[XB_TOPGEN]) == tg, bar);
            __builtin_amdgcn_fence(__ATOMIC_ACQUIRE, "agent");
            xb_add(&bar[XB_XGEN(b.x)], 1u);
            asm volatile("s_waitcnt vmcnt(0)" ::: "memory");
        } else {
            XB_SPIN(xb_ld(&bar[XB_XGEN(b.x)]) == gen, bar);
            __builtin_amdgcn_fence(__ATOMIC_ACQUIRE, "agent");
            asm volatile("s_waitcnt vmcnt(0)" ::: "memory");
        }
    }
    __syncthreads();
}

#ifndef PROF_ON
#define PROF_ON 0
#endif
#if PROF_ON
#define PROF_SLOTS(F) WSP(unsigned, WS_CTL + 524288)
__device__ __forceinline__ unsigned prof_now() { unsigned long long t; asm volatile("s_memrealtime %0\n\ts_waitcnt lgkmcnt(0)" : "=s"(t) :: "memory"); return (unsigned)t; }
#define PROF_MARK(F, k) do { const unsigned now_ = prof_now(); if ((F).bid == PROF_BID && (F).tid == 0) PROF_SLOTS(F)[k] = now_; asm volatile("" ::: "memory"); } while (0)
#if PROF_IN & 1
#define PROF_MARKI(F, k) PROF_MARK(F, k)
#else
#define PROF_MARKI(F, k) do { } while (0)
#endif
#if PROF_IN & 2
#define PROF_MARKG(F, k) do { if ((PROF_GMASK >> (k)) & 1) PROF_MARK(F, k); } while (0)
#else
#define PROF_MARKG(F, k) do { } while (0)
#endif
#define PROF_SPIN(F) do { if ((F).bid == PROF_BID && (F).tid == 0) { unsigned qa_ = (PROF_SLOTS(F)[PROF_A1] - PROF_SLOTS(F)[PROF_A0] + 50u) / 100u, qb_ = (PROF_SLOTS(F)[PROF_B1] - PROF_SLOTS(F)[PROF_B0] + 50u) / 100u; \
    qa_ = qa_ > 127u ? 127u : qa_; qb_ = qb_ > 127u ? 127u : qb_; const unsigned d_ = (qa_ + 128u * qb_) * 1600u; const unsigned t0_ = (unsigned)__builtin_amdgcn_s_memrealtime(); \
    while ((unsigned)__builtin_amdgcn_s_memrealtime() - t0_ < d_) __builtin_amdgcn_s_sleep(8); } } while (0)
#else
#define PROF_MARK(F, k) do { } while (0)
#define PROF_MARKI(F, k) do { } while (0)
#define PROF_MARKG(F, k) do { } while (0)
#define PROF_SPIN(F) do { } while (0)
#endif
namespace pg8 {
constexpr int BM = 256, BK = 64, HALF = 128, HTB = HALF * BK * 2, STAGE_BYTES = 8 * HTB, NXCD = 8, WGM = 8;
__host__ __device__ __forceinline__ int lds_byte(int r, int c) { const int st = (r >> 4) * 2 + (c >> 5), rr = r & 15, cc = c & 31, ob = rr * 64 + cc * 2; return st * 1024 + (ob ^ (((ob >> 9) & 1) << 5)); }
__host__ __device__ __forceinline__ void stage_rc(int b, int& R, int& C) { const int st = b / 1024, sb = b % 1024, swz = sb ^ (((sb >> 9) & 1) << 5); R = (st >> 1) * 16 + swz / 64; C = (st & 1) * 32 + (swz % 64) / 2; }
__host__ __device__ __forceinline__ int perm32(int rho) { const int n = rho >> 4, i = rho & 15; return 8 * (i >> 2) + 4 * n + (i & 3); }

struct Unit { int pm, pn, ex; };
struct Gemm { const bf16_t* A; const bf16_t* Bt; int M, N, K; };

struct StaticOrder {
    int nM, nN, nwg, G, c;
    __device__ void init(int M, int N, int G_, int c_) { nM = M / BM; nN = N / BM; nwg = nM * nN; G = G_; c = c_; }
    __device__ bool next(int i, Unit& u) const {
        const long L = (long)i * G + c; if (L >= nwg) return false;
        int wgid = (int)L; { const int q = nwg / NXCD, r = nwg % NXCD, xcd = wgid % NXCD, off = wgid / NXCD; wgid = (xcd < r ? xcd * (q + 1) : r * (q + 1) + (xcd - r) * q) + off; }
        const int nig = WGM * nN, gid = wgid / nig, fm = gid * WGM, gsz = (nM - fm) < WGM ? (nM - fm) : WGM;
        u.pm = fm + ((wgid % nig) % gsz); u.pn = (wgid % nig) / gsz; u.ex = 0; return true;
    }
    __device__ __forceinline__ void ptrs(const Gemm& g, const Unit& u, const char*& a, const char*& b) const {
        const size_t tstep = (size_t)BM * g.K * 2; a = (const char*)g.A + (size_t)u.pm * tstep; b = (const char*)g.Bt + (size_t)u.pn * tstep; }
};
struct MoeOrder {
    int G, c, npn, ntiles; const LAS unsigned char* tab; size_t estride;
    __device__ bool next(int i, Unit& u) const {
        const long L = (long)i * G + c; if (L >= (long)ntiles * npn) return false;
        u.pm = (int)(L / npn); u.pn = (int)(L % npn); u.ex = (int)tab[u.pm]; return true;
    }
    __device__ __forceinline__ void ptrs(const Gemm& g, const Unit& u, const char*& a, const char*& b) const {
        const size_t tstep = (size_t)BM * g.K * 2; a = (const char*)g.A + (size_t)u.pm * tstep; b = (const char*)g.Bt + (size_t)u.ex * estride + (size_t)u.pn * tstep; }
};

template <class Epi, class Sched>
__device__ __forceinline__ void gemm_phase(LAS unsigned char* lds, const int tid, const Gemm g, const Sched& S, const Epi& E) {
    const int wid = __builtin_amdgcn_readfirstlane(tid >> 6), lane = tid & 63, wr = wid >> 2, wc = wid & 3, fr = lane & 15, fq = lane >> 4;
    int K = g.K; asm volatile("" : "+s"(K));
    const int nt = K / BK;
    unsigned voffA[2], voffB[2];
#pragma unroll
    for (int i = 0; i < 2; ++i) { int R, C; stage_rc(tid * 16 + i * 8192, R, C); const int Rb = Epi::PERM ? ((R & ~31) + perm32(R & 31)) : R;
        voffA[i] = (unsigned)(R * K + C) * 2u; voffB[i] = (unsigned)(Rb * K + C) * 2u; }
    const size_t kstep = (size_t)(BK * 2);
    const size_t hstep = (size_t)HALF * K * 2;
    const unsigned ldsw = (unsigned)wid * 1024u;
    const int aoff = lds_byte(wr * 64 + fr, fq * 8), boff = lds_byte(wc * 32 + fr, fq * 8);
#define PG8_SA(b, h) (((b) * 2 + (h)) * HTB)
#define PG8_SB(b, h) ((4 + (b) * 2 + (h)) * HTB)
#define PG8_STAGE(bufoff, gbase, voff) do { _Pragma("unroll") for (int _i = 0; _i < 2; ++_i) \
        __builtin_amdgcn_global_load_lds((const unsigned*)((const char*)(gbase) + (voff)[_i]), (LAS unsigned*)(lds + (bufoff) + ldsw + _i * 8192), 16, 0, 0); } while (0)
#define PG8_LDA(dst, b, h) do { _Pragma("unroll") for (int m = 0; m < 4; ++m) _Pragma("unroll") for (int k = 0; k < 2; ++k) dst[m][k] = *(const LAS bf16x8*)(lds + PG8_SA(b, h) + aoff + m * 2048 + k * 1024); } while (0)
#define PG8_LDB(dst, b, h) do { _Pragma("unroll") for (int n = 0; n < 2; ++n) _Pragma("unroll") for (int k = 0; k < 2; ++k) dst[n][k] = *(const LAS bf16x8*)(lds + PG8_SB(b, h) + boff + n * 2048 + k * 1024); } while (0)
#define PG8_MMA(ai, bj, At, Bt) do { __builtin_amdgcn_s_setprio(1); _Pragma("unroll") for (int m = 0; m < 4; ++m) _Pragma("unroll") for (int n = 0; n < 2; ++n) _Pragma("unroll") for (int k = 0; k < 2; ++k) \
        acc[ai][bj][m][n] = __builtin_amdgcn_mfma_f32_16x16x32_bf16(Bt[n][k], At[m][k], acc[ai][bj][m][n], 0, 0, 0); __builtin_amdgcn_s_setprio(0); } while (0)
#define PG8_WAIT_V(n) asm volatile("s_waitcnt vmcnt(" #n ")" ::: "memory")
#define PG8_WAIT_L(n) asm volatile("s_waitcnt lgkmcnt(" #n ")" ::: "memory")
#define PG8_BAR __builtin_amdgcn_s_barrier()
#define PG8_SCHED __builtin_amdgcn_sched_barrier(0)
    Unit cur, nxt; int ui = 0;
    if (!S.next(0, cur)) return;
    f32x4 acc[2][2][4][2];
#pragma unroll
    for (int a = 0; a < 2; ++a)
#pragma unroll
        for (int b = 0; b < 2; ++b)
#pragma unroll
            for (int m = 0; m < 4; ++m)
#pragma unroll
                for (int n = 0; n < 2; ++n) acc[a][b][m][n] = (f32x4){0.f, 0.f, 0.f, 0.f};
    bf16x8 At[4][2], B0[2][2], B1[2][2];
    const char* cA; const char* cB; S.ptrs(g, cur, cA, cB);
    PG8_STAGE(PG8_SB(0, 0), cB, voffB); PG8_STAGE(PG8_SA(0, 0), cA, voffA); PG8_STAGE(PG8_SB(0, 1), cB + hstep, voffB); PG8_STAGE(PG8_SA(0, 1), cA + hstep, voffA);
    if (wr == 1) PG8_BAR;
    PG8_WAIT_V(4); PG8_BAR;
    PG8_STAGE(PG8_SB(1, 0), cB + kstep, voffB); PG8_STAGE(PG8_SA(1, 0), cA + kstep, voffA); PG8_STAGE(PG8_SB(1, 1), cB + hstep + kstep, voffB);
    PG8_WAIT_V(6); PG8_BAR;
    for (;;) {
        const bool has_next = S.next(ui + 1, nxt);
        const char* nA = cA; const char* nB = cB; if (has_next) S.ptrs(g, nxt, nA, nB);
        for (int t = 0; t < nt; t += 2) {
            const bool last = (t == nt - 2);
            const char* a1 = cA + (size_t)(t + 1) * kstep;
            const char* a2 = last ? nA : cA + (size_t)(t + 2) * kstep; const char* b2 = last ? nB : cB + (size_t)(t + 2) * kstep;
            const char* a3 = a2 + kstep; const char* b3 = b2 + kstep;
            PG8_LDB(B0, 0, 0); PG8_SCHED; PG8_LDA(At, 0, 0); PG8_STAGE(PG8_SA(1, 1), a1 + hstep, voffA);
            PG8_WAIT_L(8); PG8_BAR; PG8_WAIT_L(0); PG8_MMA(0, 0, At, B0); PG8_BAR; PG8_SCHED;
            PG8_LDB(B1, 0, 1); PG8_STAGE(PG8_SB(0, 0), b2, voffB);
            PG8_BAR; PG8_WAIT_L(0); PG8_MMA(0, 1, At, B1); PG8_BAR;
            PG8_LDA(At, 0, 1); PG8_STAGE(PG8_SA(0, 0), a2, voffA);
            PG8_BAR; PG8_WAIT_L(0); PG8_MMA(1, 0, At, B0); PG8_BAR; PG8_SCHED;
            PG8_STAGE(PG8_SB(0, 1), b2 + hstep, voffB);
            PG8_WAIT_V(6); PG8_BAR; PG8_MMA(1, 1, At, B1); PG8_BAR;
            PG8_LDB(B0, 1, 0); PG8_SCHED; PG8_LDA(At, 1, 0); PG8_STAGE(PG8_SA(0, 1), a2 + hstep, voffA);
            PG8_WAIT_L(8); PG8_BAR; PG8_WAIT_L(0); PG8_MMA(0, 0, At, B0); PG8_BAR; PG8_SCHED;
            PG8_LDB(B1, 1, 1); PG8_STAGE(PG8_SB(1, 0), b3, voffB);
            PG8_BAR; PG8_WAIT_L(0); PG8_MMA(0, 1, At, B1); PG8_BAR;
            PG8_LDA(At, 1, 1); PG8_STAGE(PG8_SA(1, 0), a3, voffA);
            PG8_BAR; PG8_WAIT_L(0); PG8_MMA(1, 0, At, B0); PG8_BAR; PG8_SCHED;
            PG8_STAGE(PG8_SB(1, 1), b3 + hstep, voffB);
            PG8_WAIT_V(6); PG8_BAR; PG8_MMA(1, 1, At, B1); PG8_BAR;
        }
        E(acc, cur, wr, wc, fr, fq);
        if (!has_next) break;
#pragma unroll
        for (int a = 0; a < 2; ++a)
#pragma unroll
            for (int b = 0; b < 2; ++b)
#pragma unroll
                for (int m = 0; m < 4; ++m)
#pragma unroll
                    for (int n = 0; n < 2; ++n) acc[a][b][m][n] = (f32x4){0.f, 0.f, 0.f, 0.f};
        cur = nxt; cA = nA; cB = nB; ++ui;
    }
    PG8_WAIT_V(0);
    if (wr == 0) PG8_BAR;
    PG8_BAR;
#undef PG8_SA
#undef PG8_SB
#undef PG8_STAGE
#undef PG8_LDA
#undef PG8_LDB
#undef PG8_MMA
#undef PG8_WAIT_V
#undef PG8_WAIT_L
#undef PG8_BAR
#undef PG8_SCHED
}

#define EPI_PERM_LOOP(...) \
    _Pragma("unroll") for (int ai = 0; ai < 2; ++ai) _Pragma("unroll") for (int m = 0; m < 4; ++m) { const int row = u.pm * BM + ai * HALF + wr * 64 + m * 16 + fr; \
        _Pragma("unroll") for (int bj = 0; bj < 2; ++bj) { const int col0 = u.pn * BM + bj * HALF + wc * 32 + 8 * fq; f32x4 v0 = acc[ai][bj][m][0], v1 = acc[ai][bj][m][1]; __VA_ARGS__ } if (EPI_PIN) __builtin_amdgcn_sched_barrier(0); }

struct EpiInProj {
    static constexpr bool PERM = true, EPI_PIN = true;
    bf16_t* P; bf16_t* halo;
    __device__ __forceinline__ void operator()(const f32x4 (&acc)[2][2][4][2], const Unit& u, int wr, int wc, int fr, int fq) const {
        const bool is_qkv = u.pn >= 8 && u.pn < 14;
        EPI_PERM_LOOP({
            u32x4 w; w.x = pk2(v0[0], v0[1]); w.y = pk2(v0[2], v0[3]); w.z = pk2(v1[0], v1[1]); w.w = pk2(v1[2], v1[3]);
            *(u32x4*)(P + (size_t)row * LDP + col0) = w;
            if (is_qkv && (row & 63) >= 61) *(u32x4*)(halo + ((size_t)(row >> 6) * 3 + ((row & 63) - 61)) * 1536 + (col0 - PC_BQKV)) = w;
        })
    }
};
__device__ __forceinline__ float lfg(float lb, float oml, float x) { return __logf(lb + oml * __builtin_amdgcn_rcpf(1.0f + __expf(-x)) + 1e-30f); }
struct EpiSigmoid {
    static constexpr bool PERM = true, EPI_PIN = true;
    bf16_t* O; int ldc;
    __device__ __forceinline__ void operator()(const f32x4 (&acc)[2][2][4][2], const Unit& u, int wr, int wc, int fr, int fq) const {
        EPI_PERM_LOOP({
            u32x4 w; w.x = pk2(sigmoidf_(v0[0]), sigmoidf_(v0[1])); w.y = pk2(sigmoidf_(v0[2]), sigmoidf_(v0[3])); w.z = pk2(sigmoidf_(v1[0]), sigmoidf_(v1[1])); w.w = pk2(sigmoidf_(v1[2]), sigmoidf_(v1[3]));
            *(u32x4*)(O + (size_t)row * ldc + col0) = w;
        })
    }
};
struct EpiBranch {
    static constexpr bool PERM = true, EPI_PIN = false;
    bf16_t* merged; const bf16_t* gt; int n;
    __device__ __forceinline__ void operator()(const f32x4 (&acc)[2][2][4][2], const Unit& u, int wr, int wc, int fr, int fq) const {
        EPI_PERM_LOOP({
            const u32x4 gw = *(const u32x4*)(gt + (size_t)row * 3072 + n * 1024 + col0);
            float x[8] = {v0[0] * bflo(gw.x), v0[1] * bfhi(gw.x), v0[2] * bflo(gw.y), v0[3] * bfhi(gw.y), v1[0] * bflo(gw.z), v1[1] * bfhi(gw.z), v1[2] * bflo(gw.w), v1[3] * bfhi(gw.w)};
            bf16_t* mp = merged + (size_t)row * 1024 + col0;
            if (n != 0) { const u32x4 o = *(const u32x4*)mp; x[0] += bflo(o.x); x[1] += bfhi(o.x); x[2] += bflo(o.y); x[3] += bfhi(o.y); x[4] += bflo(o.z); x[5] += bfhi(o.z); x[6] += bflo(o.w); x[7] += bfhi(o.w); }
            u32x4 w; w.x = pk2(x[0], x[1]); w.y = pk2(x[2], x[3]); w.z = pk2(x[4], x[5]); w.w = pk2(x[6], x[7]);
            *(u32x4*)mp = w;
        })
    }
};
struct EpiResidual {
    static constexpr bool PERM = false;
    float* hreal; float* hmeta;
    __device__ __forceinline__ void operator()(const f32x4 (&acc)[2][2][4][2], const Unit& u, int wr, int wc, int fr, int fq) const {
#pragma unroll
        for (int ai = 0; ai < 2; ++ai)
#pragma unroll
            for (int m = 0; m < 4; ++m) { const int row = u.pm * BM + ai * HALF + wr * 64 + m * 16 + fr;
                float* rowp = (row < NREAL ? hreal + (size_t)row * D : hmeta + (size_t)(row - NREAL) * D) + u.pn * BM + wc * 32 + 4 * fq;
#pragma unroll
                for (int bj = 0; bj < 2; ++bj)
#pragma unroll
                    for (int n = 0; n < 2; ++n) { f32x4* p = (f32x4*)(rowp + bj * HALF + n * 16); *p = *p + acc[ai][bj][m][n]; } }
    }
};
struct EpiMoeUp {
    static constexpr bool PERM = true, EPI_PIN = true;
    bf16_t* H;
    __device__ __forceinline__ void operator()(const f32x4 (&acc)[2][2][4][2], const Unit& u, int wr, int wc, int fr, int fq) const {
        EPI_PERM_LOOP({
            const int hc = col0 >> 1;
            u32x2 w; w.x = pk2(siluf_(v0[0]) * v1[0], siluf_(v0[1]) * v1[1]); w.y = pk2(siluf_(v0[2]) * v1[2], siluf_(v0[3]) * v1[3]);
            *(u32x2*)(H + (size_t)row * 256 + hc) = w;
        })
    }
};
struct EpiMoeDown {
    static constexpr bool PERM = true, EPI_PIN = false;
    bf16_t* Y; const float* wrow;
    __device__ __forceinline__ void operator()(const f32x4 (&acc)[2][2][4][2], const Unit& u, int wr, int wc, int fr, int fq) const {
        EPI_PERM_LOOP({
            const float s = wrow[row];
            u32x4 w; w.x = pk2(v0[0] * s, v0[1] * s); w.y = pk2(v0[2] * s, v0[3] * s); w.z = pk2(v1[0] * s, v1[1] * s); w.w = pk2(v1[2] * s, v1[3] * s);
            *(u32x4*)(Y + (size_t)row * 1024 + col0) = w;
        })
    }
};
}
#define GAS __attribute__((address_space(1)))
struct Params { const float* in[24]; float* out; unsigned char* ws; int ph_lo, ph_hi; };
struct Frame {
    LAS unsigned char* lds; int tid, lane, wave, G, bid;
    __attribute__((address_space(1))) float* out; __attribute__((address_space(1))) unsigned char* ws; const float* const __attribute__((address_space(4)))* inp; int dry;
};
#define PHASE_FENCE(F) do { asm volatile("" : "+s"((F).ws), "+s"((F).out), "+s"((F).inp), "+v"((F).tid), "+s"((F).bid), "+s"((F).G)); \
    (F).lane = (F).tid & 63; (F).wave = __builtin_amdgcn_readfirstlane((F).tid >> 6); } while (0)
__device__ __forceinline__ const float* inp_ptr(const float* const __attribute__((address_space(4)))* inp, int i) { GAS const float* q = (GAS const float*)inp[i]; asm volatile("" : "+s"(q)); return (const float*)q; }
#define INP(i) inp_ptr(F.inp, (i))
#define WSP(T, off) ((T*)(GAS T*)(F.ws + (off)))
enum { I_X = 0, I_META, I_NORM_MIX, I_W_IN, I_LB, I_HGRN_NORM, I_GDN_CONV, I_GDN_ALOG, I_GDN_DT, I_GDN_NORM, I_GLA_W2, I_GLA_B, I_GLA_NORM, I_W_BRANCH, I_W_OUT, I_NORM_FFN,
       I_RG_W, I_RG_B, I_RE_W, I_RE_B, I_EW_GATE, I_EW_UP, I_EW_DOWN, I_NORM_FINAL };

__device__ __forceinline__ void transpose_item(const float* W, int ldw, int K, int nblk, bf16_t* WT, int row_off, int rowmode, LAS float* scr, int item, int lane) {
    const int kb = item / nblk, nb = item % nblk, k0 = 64 * kb, n0 = 32 * nb;
    { f32x4 v[8]; const int n4 = 4 * (lane & 7);
#pragma unroll
        for (int i = 0; i < 8; ++i) v[i] = *(const f32x4*)(W + (size_t)(k0 + 8 * i + (lane >> 3)) * ldw + n0 + n4);
#pragma unroll
        for (int i = 0; i < 8; ++i) { LAS float* d = scr + (8 * i + (lane >> 3)) * 33 + n4; d[0] = v[i][0]; d[1] = v[i][1]; d[2] = v[i][2]; d[3] = v[i][3]; } }
    LDS_WAIT(); asm volatile("" ::: "memory");
    const int c = lane & 7;
#pragma unroll
    for (int j = 0; j < 4; ++j) { const int n = (lane >> 3) + 8 * j; const LAS float* s = scr + (8 * c) * 33 + n;
        u32x4 o; o.x = pk2(s[0 * 33], s[1 * 33]); o.y = pk2(s[2 * 33], s[3 * 33]); o.z = pk2(s[4 * 33], s[5 * 33]); o.w = pk2(s[6 * 33], s[7 * 33]);
        const int nn = n0 + n; const int wrow = rowmode == 0 ? row_off + nn : row_off + 8 * (nn >> 2) + (nn & 3) + (rowmode == 2 ? 4 : 0);
        *(u32x4*)(WT + (size_t)wrow * K + k0 + 8 * c) = o; }
    LDS_WAIT(); asm volatile("" ::: "memory");
}

__device__ __forceinline__ void phase_pre(Frame& F) {
    const int gt = F.bid * NTHREADS + F.tid, NT = F.G * NTHREADS;
    float* sw1 = WSP(float, SM_SW1); float* rwg = WSP(float, SM_RWG); float* rwe = WSP(float, SM_RWE); float* lab = WSP(float, SM_LAB);
    for (int i = gt; i < 2 * 24 * 1024; i += NT) { const int l = i / (24 * 1024), c = (i / 1024) % 24, k = i % 1024;
        const int col = c < 16 ? 5128 + c : (c < 20 ? 3584 + (c - 16) : 3588 + (c - 20));
        sw1[i] = INP(I_W_IN)[((size_t)l * 1024 + k) * IN_COLS + col]; }
    for (int i = gt; i < 2 * 4 * 1024; i += NT) { const int l = i / (4 * 1024), c = (i / 1024) % 4, k = i % 1024; rwg[i] = INP(I_RG_W)[((size_t)l * 1024 + k) * 4 + c]; }
    for (int i = gt; i < 2 * 32 * 1024; i += NT) { const int l = i / (32 * 1024), c = (i / 1024) % 32, k = i % 1024; rwe[i] = INP(I_RE_W)[((size_t)l * 1024 + k) * 32 + c]; }
    for (int i = gt; i < 2 * 512; i += NT) { const int l = i / 512, c = i % 512; const float l0 = INP(I_LB)[c], l1 = INP(I_LB)[512 + c];
        const float p1 = 1.0f / (1.0f + expf(l0 - l1)); const float lb = l == 0 ? 0.f : p1;
        lab[l * 1024 + c] = lb; lab[l * 1024 + 512 + c] = 1.0f - lb; }
}

__device__ __forceinline__ void convert_layer_weights(Frame& F, int l) {
    LAS float* scr = (LAS float*)(F.lds + F.wave * 16384);
    const int gw = F.bid * NWAVES + F.wave, NGW = F.G * NWAVES;
    const float* win = INP(I_W_IN) + (size_t)l * 1024 * IN_COLS;
    constexpr int I_MIX = 16 * 176, I_GATE = 16 * 96, I_BR = 8 * 32, I_OUT = 16 * 32, NITEMS = I_MIX + I_GATE + 3 * I_BR + I_OUT;
    for (int it = gw; it < NITEMS; it += NGW) {
        int r = it;
        if (r < I_MIX) { const int nb = r % 176, n0 = 32 * nb; const int shift = n0 < 3584 ? 0 : (n0 < 5120 ? 8 : 24);
            transpose_item(win + shift, IN_COLS, 1024, 176, WSP(bf16_t, WS_WMIX), 0, 0, scr, r, F.lane); continue; } r -= I_MIX;
        if (r < I_GATE) { transpose_item(win + 5656, IN_COLS, 1024, 96, WSP(bf16_t, WS_WGATE), 0, 0, scr, r, F.lane); continue; } r -= I_GATE;
        if (r < 3 * I_BR) { const int n = r / I_BR; transpose_item(INP(I_W_BRANCH) + ((size_t)l * 3 + n) * 512 * 1024, 1024, 512, 32, WSP(bf16_t, WS_WBT) + (size_t)n * 1024 * 512, 0, 0, scr, r % I_BR, F.lane); continue; } r -= 3 * I_BR;
        transpose_item(INP(I_W_OUT) + (size_t)l * 1024 * 1024, 1024, 1024, 32, WSP(bf16_t, WS_WOT), 0, 0, scr, r, F.lane);
    }
}
__device__ __forceinline__ void convert_expert_weights(Frame& F, int l) {
    LAS float* scr = (LAS float*)(F.lds + F.wave * 16384);
    const int gw = F.bid * NWAVES + F.wave, NGW = F.G * NWAVES;
    constexpr int I_G = 16 * 8, I_D = 4 * 32, PER = 2 * I_G + I_D;
    for (int it = gw; it < 32 * PER; it += NGW) {
        const int e = it / PER; int r = it % PER;
        bf16_t* w1t = WSP(bf16_t, WS_W1T) + (size_t)e * 512 * 1024; bf16_t* w2t = WSP(bf16_t, WS_W2T) + (size_t)e * 1024 * 256;
        if (r < I_G) { transpose_item(INP(I_EW_GATE) + ((size_t)l * 32 + e) * 1024 * 256, 256, 1024, 8, w1t, 0, 1, scr, r, F.lane); continue; } r -= I_G;
        if (r < I_G) { transpose_item(INP(I_EW_UP) + ((size_t)l * 32 + e) * 1024 * 256, 256, 1024, 8, w1t, 0, 2, scr, r, F.lane); continue; } r -= I_G;
        transpose_item(INP(I_EW_DOWN) + ((size_t)l * 32 + e) * 256 * 1024, 1024, 256, 32, w2t, 0, 0, scr, r, F.lane);
    }
}

#define OUTP ((float*)F.out)
__device__ __forceinline__ float* hrow(Frame& F, int r) { return r < NREAL ? OUTP + (size_t)r * D : WSP(float, WS_HMETA) + (size_t)(r - NREAL) * D; }

__device__ __forceinline__ void load_row16(const float* p, int lane, float (&x)[16]) {
#pragma unroll
    for (int j = 0; j < 4; ++j) { const f32x4 v = *((const f32x4*)p + lane + 64 * j); x[4 * j] = v[0]; x[4 * j + 1] = v[1]; x[4 * j + 2] = v[2]; x[4 * j + 3] = v[3]; }
}
__device__ __forceinline__ void add_bf16_row16(const bf16_t* p, int lane, float (&x)[16]) {
#pragma unroll
    for (int j = 0; j < 4; ++j) { const u32x2 w = *((const u32x2*)p + lane + 64 * j); x[4 * j] += bflo(w.x); x[4 * j + 1] += bfhi(w.x); x[4 * j + 2] += bflo(w.y); x[4 * j + 3] += bfhi(w.y); }
}
__device__ __forceinline__ void store_row16(float* p, int lane, const float (&x)[16]) {
#pragma unroll
    for (int j = 0; j < 4; ++j) *((f32x4*)p + lane + 64 * j) = (f32x4){x[4 * j], x[4 * j + 1], x[4 * j + 2], x[4 * j + 3]};
}
__device__ __forceinline__ void store_bf16_row16(bf16_t* p, int lane, const float (&x)[16]) {
#pragma unroll
    for (int j = 0; j < 4; ++j) { u32x2 w; w.x = pk2(x[4 * j], x[4 * j + 1]); w.y = pk2(x[4 * j + 2], x[4 * j + 3]); *((u32x2*)p + lane + 64 * j) = w; }
}
__device__ __forceinline__ void fetch_h_row(Frame& F, int l, int r, float (&x)[16]) {
    if (l == 0) {
        const float* src = r < NREAL ? INP(I_X) + (size_t)r * D : INP(I_META) + (size_t)(r - META_ROW0) * D;
        load_row16(src, F.lane, x);
    } else {
        load_row16(hrow(F, r), F.lane, x);
        const unsigned* tok = WSP(unsigned, SM_TOK) + (size_t)r * 8;
        const unsigned g0 = tok[6], g1 = tok[7];
        add_bf16_row16(WSP(bf16_t, WS_Y2) + (size_t)g0 * 1024, F.lane, x);
        add_bf16_row16(WSP(bf16_t, WS_Y2) + (size_t)g1 * 1024, F.lane, x);
    }
}

__device__ __forceinline__ void phase_norm1(Frame& F, int l) {
    convert_layer_weights(F, l);
    __syncthreads();
    LAS float* sw = (LAS float*)F.lds;
    { const float* src = WSP(float, SM_SW1) + (size_t)l * 24 * 1024; for (int i = F.tid; i < 24 * 1024 / 4; i += NTHREADS) ((LAS f32x4*)sw)[i] = ((const f32x4*)src)[i]; }
    __syncthreads();
    const int gw = F.bid * NWAVES + F.wave, NGW = F.G * NWAVES, lane = F.lane;
    const float* nw = INP(I_NORM_MIX) + (size_t)l * D;
    float wv[16]; load_row16(nw, lane, wv);
    bf16_t* U = WSP(bf16_t, WS_U);
    const float alog_l = (lane >= 20 && lane < 24) ? INP(I_GDN_ALOG)[l * 4 + (lane - 20)] : 0.f, dt_l = (lane >= 20 && lane < 24) ? INP(I_GDN_DT)[l * 4 + (lane - 20)] : 0.f;
    const float nega_l = -expf(alog_l);
    for (int g = gw; g < MROWS / 4; g += NGW) {
        const int r0 = 4 * g;
        if (!row_valid(r0)) {
            float z[16];
#pragma unroll
            for (int j = 0; j < 16; ++j) z[j] = 0.f;
#pragma unroll
            for (int i = 0; i < 4; ++i) { store_bf16_row16(U + (size_t)(r0 + i) * D, lane, z); if (l == 0) store_row16(hrow(F, r0 + i), lane, z);
                if (lane < 16) WSP(float, SM_GK)[(size_t)(r0 + i) * 16 + lane] = 0.f;
                else if (lane < 20) WSP(float, SM_BETA)[(size_t)(r0 + i) * 4 + (lane - 16)] = 0.f;
                else if (lane < 24) WSP(float, SM_LOGA)[(size_t)(r0 + i) * 4 + (lane - 20)] = 0.f; }
            continue;
        }
        float x[4][16];
#pragma unroll
        for (int i = 0; i < 4; ++i) {
            fetch_h_row(F, l, r0 + i, x[i]);
            store_row16(hrow(F, r0 + i), lane, x[i]);
            float ss = 0.f;
#pragma unroll
            for (int j = 0; j < 16; ++j) ss += x[i][j] * x[i][j];
            const float rstd = rsqrtf(wave_sum(ss) * (1.0f / D) + 1e-6f);
#pragma unroll
            for (int j = 0; j < 16; ++j) x[i][j] = x[i][j] * rstd * wv[j];
            store_bf16_row16(U + (size_t)(r0 + i) * D, lane, x[i]);
        }
        float ov[4] = {0.f, 0.f, 0.f, 0.f};
#pragma unroll 2
        for (int c = 0; c < 24; ++c) {
            float a0 = 0.f, a1 = 0.f, a2 = 0.f, a3 = 0.f;
#pragma unroll
            for (int j = 0; j < 4; ++j) { const f32x4 w = *((const LAS f32x4*)(sw + c * 1024) + lane + 64 * j);
#pragma unroll
                for (int e = 0; e < 4; ++e) { a0 += x[0][4 * j + e] * w[e]; a1 += x[1][4 * j + e] * w[e]; a2 += x[2][4 * j + e] * w[e]; a3 += x[3][4 * j + e] * w[e]; } }
            a0 = wave_sum(a0); a1 = wave_sum(a1); a2 = wave_sum(a2); a3 = wave_sum(a3);
            if (lane == c) { ov[0] = a0; ov[1] = a1; ov[2] = a2; ov[3] = a3; }
        }
        float* GK = WSP(float, SM_GK); float* BETA = WSP(float, SM_BETA); float* LOGA = WSP(float, SM_LOGA);
#pragma unroll
        for (int i = 0; i < 4; ++i) {
            const float v = ov[i]; const int r = r0 + i;
            if (lane < 16) GK[(size_t)r * 16 + lane] = v;
            else if (lane < 20) BETA[(size_t)r * 4 + (lane - 16)] = sigmoidf_(v);
            else if (lane < 24) { const int h = lane - 20; LOGA[(size_t)r * 4 + h] = nega_l * softplusf_(v + dt_l); }
        }
    }
}

__device__ __forceinline__ bf16x8 mk8(u32x4 w) { return __builtin_bit_cast(bf16x8, w); }
__device__ __forceinline__ bf16x8 mk8(u32x2 lo, u32x2 hi) { u32x4 w; w.x = lo.x; w.y = lo.y; w.z = hi.x; w.w = hi.y; return __builtin_bit_cast(bf16x8, w); }
__device__ __forceinline__ bf16x8 pack_acc2(const f32x4& a, const f32x4& b) { u32x4 w; w.x = pk2(a[0], a[1]); w.y = pk2(a[2], a[3]); w.z = pk2(b[0], b[1]); w.w = pk2(b[2], b[3]); return __builtin_bit_cast(bf16x8, w); }
#define MFMA16(a, b, c) __builtin_amdgcn_mfma_f32_16x16x32_bf16((a), (b), (c), 0, 0, 0)

__device__ __forceinline__ int permpos(int k) { const int kk = k & 31; return (k & ~31) + ((kk & 16) ? 8 * ((kk - 16) >> 2) + 4 + (kk & 3) : 8 * (kk >> 2) + (kk & 3)); }
__device__ __forceinline__ float ldbf(GAS const bf16_t* p) { return bf2f(*p); }
#define ROWB(P, row, col) ((GAS const char*)(P) + ((size_t)(row) * LDP + (col)) * 2)
__device__ __forceinline__ float ldrow(GAS const char* rb, unsigned voff) { return bf2f(*(GAS const bf16_t*)(rb + voff)); }
__device__ __forceinline__ unsigned ldrow_u(GAS const char* rb, unsigned voff) { return (unsigned)*(GAS const bf16_t*)(rb + voff); }
__device__ __forceinline__ void strow(GAS const char* rb, unsigned voff, bf16_t v) { *(GAS bf16_t*)(rb + voff) = v; }

template <int DK, bool IS_A>
__device__ __forceinline__ void prep_gla(Frame& F, int l, int ug) {
    constexpr int QP = DK + 8, VP = 136, SUB = 2 * 64 * QP * 2 + 1024 + 4096 + 64 * VP * 2;
    PROF_MARK(F, IS_A ? 7 : 8);
    int tid = F.tid; asm volatile("" : "+v"(tid));
    const int sg = __builtin_amdgcn_readfirstlane(tid >> 8), lt = tid & 255, c = lt & 127, hf = __builtin_amdgcn_readfirstlane(lt >> 7);
    const int unit = 2 * ug + sg, slot = unit >> 2, h = unit & 3, row0 = slot * 64, r0 = row0 + 32 * hf;
    const int qcol = IS_A ? PC_AQ + h * 128 : PC_CQ + h * 64, kcol = IS_A ? PC_AF + h * 128 : PC_CK + h * 64, vcol = IS_A ? PC_AI + h * 128 : PC_CV + h * 128;
    bf16_t* P = WSP(bf16_t, WS_P);
    LAS bf16_t* qt = (LAS bf16_t*)(F.lds + sg * SUB);
    LAS bf16_t* kt = qt + 64 * QP;
    LAS float* tot = (LAS float*)(kt + 64 * QP);
    const bool act = c < DK;
    LAS bf16_t* rv = (LAS bf16_t*)(tot + 256 + 1024);
    float w2c[16], bias = 0.f;
    if (!IS_A && c < DK) { const float* w2 = INP(I_GLA_W2) + (size_t)l * 16 * 256 + h * 64 + c; bias = INP(I_GLA_B)[l * 256 + h * 64 + c];
#pragma unroll
        for (int j = 0; j < 16; ++j) w2c[j] = w2[j * 256]; }
    { constexpr int PQ = DK / 8, PPR = 2 * PQ + 16;
        for (int idx = lt; idx < 64 * PPR; idx += 256) { const int row = idx / PPR, pc = idx % PPR;
            const int scol = pc < PQ ? qcol + 8 * pc : (pc < 2 * PQ ? kcol + 8 * (pc - PQ) : vcol + 8 * (pc - 2 * PQ));
            LAS bf16_t* dst = pc < PQ ? qt + row * QP + 8 * pc : (pc < 2 * PQ ? kt + row * QP + 8 * (pc - PQ) : rv + row * VP + 8 * (pc - 2 * PQ));
            *(LAS u32x4*)dst = *(const u32x4*)(P + (size_t)(row0 + row) * LDP + scol); } }
    if (!IS_A) { LAS float* gkl = tot + 256;
        ((LAS f32x4*)gkl)[lt] = ((const f32x4*)(WSP(float, SM_GK) + (size_t)row0 * 16))[lt]; }
    __syncthreads();
    PROF_MARKI(F, IS_A ? 29 : 19);
    float b[32];
    const unsigned vo = (unsigned)c * 2u, vop = (unsigned)permpos(c) * 2u;
    if (act) {
        float run = 0.f;
        if (IS_A) { const float* lab = WSP(float, SM_LAB) + l * 1024 + h * 128 + c; const float la = lab[0], lb = lab[512];
#pragma unroll
            for (int t = 0; t < 32; ++t) { run += pg8::lfg(la, lb, bf2f(kt[(32 * hf + t) * QP + c])); b[t] = run; }
        } else {
            const LAS f32x4* gk = (const LAS f32x4*)(tot + 256 + 32 * hf * 16);
#pragma unroll
            for (int tb = 0; tb < 32; tb += 4) { f32x4 g[16];
#pragma unroll
                for (int i = 0; i < 16; ++i) g[i] = gk[tb * 4 + i];
                asm volatile("" ::: "memory");
#pragma unroll
                for (int u = 0; u < 4; ++u) { float s = bias;
#pragma unroll
                    for (int j = 0; j < 16; ++j) s += g[4 * u + (j >> 2)][j & 3] * w2c[j];
                    run += logsigf_(s) * (1.0f / 16.0f); b[tb + u] = run; } }
        }
        tot[hf * 128 + c] = run;
    }
    __syncthreads();
    PROF_MARKI(F, IS_A ? 25 : 15);
    unsigned q1p[16], k1p[16];
    if (act) {
        const float bm = tot[c], bl = bm + tot[128 + c], boff = hf ? bm : 0.f;
        if (hf == 0 && !F.dry) (IS_A ? WSP(float, SM_DECA) + (size_t)unit * 128 : WSP(float, SM_DECC) + (size_t)unit * 64)[c] = __expf(bl);
#pragma unroll
        for (int t2 = 0; t2 < 16; ++t2) { float q1v[2], k1v[2];
#pragma unroll
            for (int u = 0; u < 2; ++u) { const int t = 2 * t2 + u; const float bt = b[t] + boff;
                const float qr = bf2f(qt[(32 * hf + t) * QP + c]), q = IS_A ? siluf_(qr) * 0.08838834764831845f : qr * 0.125f;
                float k;
                if (IS_A) { const float lf = t == 0 ? b[0] : b[t] - b[t - 1]; k = row_valid(r0 + t) ? 1.0f - __expf(lf) : 0.f; } else k = bf2f(kt[(32 * hf + t) * QP + c]);
                q1v[u] = q * __expf(bt); k1v[u] = k * __expf(bl - bt);
                qt[(32 * hf + t) * QP + c] = f2bf(q * __expf(fminf(bt - bm, 80.f))); kt[(32 * hf + t) * QP + c] = f2bf(k * __expf(fminf(bm - bt, 80.f))); }
            q1p[t2] = pk2(q1v[0], q1v[1]); k1p[t2] = pk2(k1v[0], k1v[1]); }
    }
    __syncthreads();
    PROF_MARKI(F, IS_A ? 26 : 16);
    if (act) {
        if (!F.dry) {
#pragma unroll
        for (int t2 = 0; t2 < 16; ++t2) { strow(ROWB(P, r0 + 2 * t2, qcol), vop, (bf16_t)(q1p[t2] & 0xffffu)); strow(ROWB(P, r0 + 2 * t2 + 1, qcol), vop, (bf16_t)(q1p[t2] >> 16)); } }
        bf16_t* kd = (IS_A ? P + (size_t)(row0 + (c >> 1)) * LDP + kcol + (c & 1) * 64 : P + (size_t)(row0 + c) * LDP + kcol) + 32 * hf;
#pragma unroll
        for (int o = 0; o < 4; ++o) if (!F.dry) *(u32x4*)(kd + 8 * o) = (u32x4){k1p[4 * o], k1p[4 * o + 1], k1p[4 * o + 2], k1p[4 * o + 3]};
    }
    { const int ws = (tid >> 6) & 3, lane = tid & 63, fr = lane & 15, fq = lane >> 4;
        bf16_t* sc = (IS_A ? WSP(bf16_t, WS_SCA) : WSP(bf16_t, WS_SCC)) + (size_t)unit * 4096;
#pragma unroll
        for (int jt = 0; jt < 4; ++jt) { const int mt = ws, nt = jt; f32x4 acc = {0.f, 0.f, 0.f, 0.f};
            if (nt <= mt) {
#pragma unroll
                for (int ks = 0; ks < DK / 32; ++ks) { const bf16x8 a = *(const LAS bf16x8*)(qt + (16 * mt + fr) * QP + 32 * ks + 8 * fq), bb = *(const LAS bf16x8*)(kt + (16 * nt + fr) * QP + 32 * ks + 8 * fq); acc = MFMA16(a, bb, acc); } }
#pragma unroll
            for (int r = 0; r < 4; ++r) { const int t = 16 * mt + 4 * fq + r, s = 16 * nt + fr; if (!F.dry) sc[t * 64 + s] = (s <= t) ? f2bf(acc[r]) : (bf16_t)0; } }
    }
    PROF_MARKI(F, IS_A ? 27 : 17);
    { unsigned vp[16];
#pragma unroll
        for (int t2 = 0; t2 < 16; ++t2) { vp[t2] = (unsigned)rv[(32 * hf + 2 * t2) * VP + c] | ((unsigned)rv[(32 * hf + 2 * t2 + 1) * VP + c] << 16); }
        PROF_MARKI(F, IS_A ? 28 : 18);
        bf16_t* vd = P + (size_t)(row0 + (c >> 1)) * LDP + vcol + (c & 1) * 64 + 32 * hf;
#pragma unroll
        for (int o = 0; o < 4; ++o) if (!F.dry) *(u32x4*)(vd + 8 * o) = (u32x4){vp[4 * o], vp[4 * o + 1], vp[4 * o + 2], vp[4 * o + 3]}; }
    __syncthreads();
    PROF_MARK(F, IS_A ? 13 : 14);
}

__device__ __forceinline__ void prep_gdn(Frame& F, int l, int ug) {
    constexpr int NP = 136, SUB = 2 * 64 * NP * 2 + 64 * 68 * 4 + 1024 + 2304;
    PROF_MARK(F, 1);
    int tid = F.tid; asm volatile("" : "+v"(tid));
    const int lane = tid & 63, sg = __builtin_amdgcn_readfirstlane(tid >> 8), lt = tid & 255, unit = 2 * ug + sg, slot = unit >> 2, h = unit & 3, row0 = slot * 64;
    bf16_t* P = WSP(bf16_t, WS_P);
    LAS bf16_t* qs = (LAS bf16_t*)(F.lds + sg * SUB);
    LAS bf16_t* ks = qs + 64 * NP;
    LAS float* AT = (LAS float*)(F.lds + sg * SUB + 2 * 64 * NP * 2);
    LAS float* gs = AT + 64 * 68;
    if (lt < 64) { const int valid_u = 1; (void)valid_u; float g = WSP(float, SM_LOGA)[(size_t)(row0 + lt) * 4 + h];
#pragma unroll
        for (int o = 1; o < 64; o <<= 1) { const float t = __shfl_up(g, o); if (lane >= o) g += t; }
        gs[lt] = g; gs[64 + lt] = WSP(float, SM_BETA)[(size_t)(row0 + lt) * 4 + h];
        if (lt == 63 && !F.dry) WSP(float, SM_DECB)[unit] = __expf(g); }
    const int hslot = slot == 256 ? -1 : ((slot & 63) == 0 ? 256 : slot - 1);
    LAS bf16_t* rvs = (LAS bf16_t*)AT;
    LAS bf16_t* hl = (LAS bf16_t*)(gs + 256);
    for (int idx = lt; idx < 64 * 48; idx += 256) { const int row = idx / 48, pc = idx % 48, comp = pc >> 4, c8 = (pc & 15) * 8;
        const u32x4 v = *(const u32x4*)(P + (size_t)(row0 + row) * LDP + PC_BQKV + comp * 512 + h * 128 + c8);
        *(LAS u32x4*)((comp == 0 ? qs : (comp == 1 ? ks : rvs)) + row * NP + c8) = v; }
    if (lt < 144) { const int rr = lt / 48, pc = lt % 48, comp = pc >> 4, c8 = (pc & 15) * 8; u32x4 v = {0u, 0u, 0u, 0u};
        if (hslot >= 0) v = *(const u32x4*)(WSP(bf16_t, SM_HALO) + ((size_t)hslot * 3 + rr) * 1536 + comp * 512 + h * 128 + c8);
        *(LAS u32x4*)(hl + rr * 384 + comp * 128 + c8) = v; }
    __syncthreads();
    PROF_MARKG(F, 2);
    float col[64];
    {
        const int c = lt & 127;
#pragma unroll
        for (int pass = 0; pass < 2; ++pass) {
            if (pass == 1 && lt >= 128) break;
            const int comp = lt >= 128 ? 1 : (pass == 0 ? 0 : 2), ch = comp * 512 + h * 128 + c;
            const float w0 = INP(I_GDN_CONV)[((size_t)l * 4 + 0) * 1536 + ch], w1 = INP(I_GDN_CONV)[((size_t)l * 4 + 1) * 1536 + ch], w2 = INP(I_GDN_CONV)[((size_t)l * 4 + 2) * 1536 + ch], w3 = INP(I_GDN_CONV)[((size_t)l * 4 + 3) * 1536 + ch];
            LAS bf16_t* src = (comp == 0 ? qs : (comp == 1 ? ks : rvs)) + c;
            float x0 = bf2f(hl[comp * 128 + c]), x1 = bf2f(hl[384 + comp * 128 + c]), x2 = bf2f(hl[768 + comp * 128 + c]);
#pragma unroll
            for (int t = 0; t < 64; ++t) { const float x3 = bf2f(src[t * NP]); const float y = siluf_(w0 * x0 + w1 * x1 + w2 * x2 + w3 * x3); x0 = x1; x1 = x2; x2 = x3;
                if (comp == 0) src[t * NP] = f2bf(y); else { col[t] = y; if (comp == 1) src[t * NP] = f2bf(y); } }
        }
    }
    __syncthreads();
    PROF_MARKG(F, 3);
    const int wv = (tid >> 6) & 3, fr = lane & 15, fq = lane >> 4;
#pragma unroll
    for (int jt = 0; jt < 2; ++jt) { const int which = jt, mt = wv; const LAS bf16_t* ap = which ? qs : ks; f32x4 a4 = {0.f, 0.f, 0.f, 0.f};
#pragma unroll
        for (int k4 = 0; k4 < 4; ++k4) { const bf16x8 a = *(const LAS bf16x8*)(ap + (16 * mt + fr) * NP + 32 * k4 + 8 * fq); a4 = MFMA16(a, a, a4); }
#pragma unroll
        for (int r = 0; r < 4; ++r) if (4 * fq + r == fr) { if (which == 0) gs[128 + 16 * mt + fr] = rsqrtf(a4[r] + 1e-6f); else gs[192 + 16 * mt + fr] = rsqrtf(a4[r] + 1e-6f) * 0.08838834764831845f; } }
    __syncthreads();
    { bf16_t* qkd = WSP(bf16_t, WS_QKD) + (size_t)unit * 4096;
#pragma unroll
        for (int jt = 0; jt < 8; ++jt) { const int tile = wv * 8 + jt, which = tile >> 4, mt = (tile >> 2) & 3, nt = tile & 3;
            const LAS bf16_t* ap = which ? qs : ks; f32x4 a4 = {0.f, 0.f, 0.f, 0.f};
            if (nt <= mt) {
#pragma unroll
                for (int k4 = 0; k4 < 4; ++k4) { const bf16x8 a = *(const LAS bf16x8*)(ap + (16 * mt + fr) * NP + 32 * k4 + 8 * fq), bb = *(const LAS bf16x8*)(ks + (16 * nt + fr) * NP + 32 * k4 + 8 * fq); a4 = MFMA16(a, bb, a4); } }
#pragma unroll
            for (int r = 0; r < 4; ++r) { const int t = 16 * mt + 4 * fq + r, s = 16 * nt + fr; const float dec = __expf(fminf(gs[t] - gs[s], 0.f)) * gs[128 + s];
                if (which) { if (!F.dry) qkd[t * 64 + permpos(s)] = (s <= t) ? f2bf(a4[r] * dec * gs[192 + t]) : (bf16_t)0; }
                else AT[s * 68 + t] = (s < t) ? gs[64 + t] * gs[128 + t] * a4[r] * dec : 0.f; } }
    }
    PROF_MARKG(F, 4);
    if (lt >= 128) { const int d = lt - 128; const float gl = gs[63]; bf16_t* dst = WSP(bf16_t, WS_K1TB) + (size_t)unit * 8192 + d * 64;
#pragma unroll
        for (int o = 0; o < 8; ++o) { const int s0 = 32 * (o >> 2) + 4 * (o & 3); float y[8];
#pragma unroll
            for (int j = 0; j < 8; ++j) { const int s = s0 + (j & 3) + (j >> 2) * 16; y[j] = col[s] * gs[128 + s] * __expf(gl - gs[s]); }
            if (!F.dry) *(u32x4*)(dst + 8 * o) = (u32x4){pk2(y[0], y[1]), pk2(y[2], y[3]), pk2(y[4], y[5]), pk2(y[6], y[7])}; }
    } else { const int pp = permpos(lt);
#pragma unroll 8
        for (int t = 0; t < 64; ++t) if (!F.dry) P[(size_t)(row0 + t) * LDP + PC_BQKV + h * 128 + pp] = f2bf(bf2f(qs[t * NP + lt]) * gs[192 + t] * __expf(gs[t])); }
    __syncthreads();
    PROF_MARKG(F, 5);
#pragma unroll
    for (int i = 0; i < 64; ++i) col[i] *= lt < 128 ? gs[64 + i] : gs[64 + i] * gs[128 + i] * __expf(gs[i]);
#pragma unroll
    for (int j = 0; j < 63; ++j) { const float xj = col[j]; asm volatile("" ::: "memory");
#pragma unroll
        for (int q4 = (j + 1) >> 2; q4 < 16; ++q4) { const f32x4 a = *(const LAS f32x4*)(AT + j * 68 + 4 * q4);
#pragma unroll
            for (int e = 0; e < 4; ++e) if (4 * q4 + e > j) col[4 * q4 + e] -= a[e] * xj; } }
    PROF_MARKG(F, 6);
    int tid2 = F.tid; asm volatile("" : "+v"(tid2)); const int lt2 = tid2 & 255, unit2 = 2 * ug + __builtin_amdgcn_readfirstlane(tid2 >> 8), row02 = (unit2 >> 2) * 64, h2 = unit2 & 3;
    if (lt2 < 128) { bf16_t* dst = P + (size_t)(row02 + (lt2 >> 1)) * LDP + PC_BQKV + 1024 + h2 * 128 + (lt2 & 1) * 64;
#pragma unroll
        for (int o = 0; o < 8; ++o) if (!F.dry) *(u32x4*)(dst + 8 * o) = (u32x4){pk2(col[8 * o], col[8 * o + 1]), pk2(col[8 * o + 2], col[8 * o + 3]), pk2(col[8 * o + 4], col[8 * o + 5]), pk2(col[8 * o + 6], col[8 * o + 7])};
    } else { const int pp = permpos(lt2 - 128);
        if (!F.dry) {
#pragma unroll
        for (int t = 0; t < 64; ++t) strow(ROWB(P, row02 + t, PC_BQKV + 512 + h2 * 128), (unsigned)pp * 2u, f2bf(col[t])); } }
    __syncthreads();
    PROF_MARK(F, 9);
}

constexpr int SETC = 13, NSETS = 65 / SETC;
static_assert(SETC * NSETS == 65, "sets must tile the 65 scan steps");
__device__ __forceinline__ void prep_set(Frame& F, int l, int set, int nblk, int bidx) {
    const int nsl = set == 0 ? 1 + 4 * (SETC - 1) : 4 * SETC, np = 2 * nsl;
    auto ug_of = [&](int vp) { const int j = vp >> 1; int slot;
        if (set == 0) slot = j == 0 ? 256 : ((j - 1) / (SETC - 1)) * 64 + (j - 1) % (SETC - 1);
        else slot = (j / SETC) * 64 + SETC * set - 1 + j % SETC;
        return 2 * slot + (vp & 1); };
    int i = bidx, stride = nblk;
    if (nblk >= 2 * np - 16) { if (bidx < np) stride = 3 * np; else stride = nblk - np; }
    for (; i < np; i += stride) prep_gdn(F, l, ug_of(i));
    for (; i < 2 * np; i += stride) prep_gla<128, true>(F, l, ug_of(i - np));
    for (; i < 3 * np; i += stride) prep_gla<64, false>(F, l, ug_of(i - 2 * np));
}
constexpr int SCAN_BUF = 57344;
template <int MX> struct ScanCfg;
template <> struct ScanCfg<0> { static constexpr int NM = 3, NI = 5; static constexpr int off(int m) { return m == 0 ? 0 : (m == 1 ? 16384 : 32768); } static constexpr int pitch(int m) { return m == 0 ? 256 : 128; } };
template <> struct ScanCfg<1> { static constexpr int NM = 4, NI = 7; static constexpr int off(int m) { return 16384 * m; } static constexpr int pitch(int m) { return m < 2 ? 256 : 128; } };
template <> struct ScanCfg<2> { static constexpr int NM = 3, NI = 3; static constexpr int off(int m) { return 8192 * m; } static constexpr int pitch(int m) { return 128; } };

#define SET_CNT(l, k) (WSP(unsigned, WS_CTL) + 8192 + (l) * 8 + (k))
#define XPREP(x) (WSP(unsigned, WS_CTL) + 8192 + 64 + (x))
#define SET_XCNT(l, k, x) (WSP(unsigned, WS_CTL) + 8192 + 128 + ((l) * 8 + (k)) * 16 + (x))
#define SET_SIGNAL(l, k) do { asm volatile("s_waitcnt vmcnt(0)" ::: "memory"); __syncthreads(); \
    if (F.tid == 0) { const unsigned x_ = xb_xcc_id(), np_ = xb_ld(XPREP(x_)); const unsigned old_ = xb_add(SET_XCNT(l, k, x_), 1u); \
        if (old_ + 1u == np_) { __builtin_amdgcn_fence(__ATOMIC_RELEASE, "agent"); asm volatile("s_waitcnt vmcnt(0)" ::: "memory"); (void)xb_add(SET_CNT(l, k), 1u); } } } while (0)
#define SET_WAIT(l, k) do { asm volatile("s_waitcnt vmcnt(0)" ::: "memory"); __syncthreads(); \
    if (F.tid == 0) { unsigned* bar_ = WSP(unsigned, WS_CTL) + CW_BAR; unsigned need_ = 0u; for (unsigned x_ = 0; x_ < 16u; ++x_) need_ += xb_ld(XPREP(x_)) > 0u ? 1u : 0u; \
        XB_SPIN(xb_ld(SET_CNT(l, k)) < need_, bar_); \
        __builtin_amdgcn_fence(__ATOMIC_ACQUIRE, "agent"); asm volatile("s_waitcnt vmcnt(0)" ::: "memory"); } \
    __syncthreads(); asm volatile("" ::: "memory"); } while (0)
#define SCAN_GRID_BARRIER() do { xcd_barrier(WSP(unsigned, WS_CTL) + CW_BAR, xb_xcc_id(), (volatile LAS unsigned*)(F.lds + LDS_MISC) + 8, F.tid, (unsigned)F.G); asm volatile("" ::: "memory"); } while (0)
template <int MX>
__device__ __forceinline__ void scan_mixer(Frame& F, int l, int b, int h) {
    typedef ScanCfg<MX> C;
    constexpr int DK = MX == 2 ? 64 : 128, NT = DK / 16, NI = C::NI;
    const int w = F.wave, lane = F.lane, fr = lane & 15, fq = lane >> 4, ecol = 16 * w + fr;
    const char* Pb = (const char*)WSP(bf16_t, WS_P);
    const int qcol = MX == 0 ? PC_AQ + h * 128 : (MX == 1 ? PC_BQKV + h * 128 : PC_CQ + h * 64);
    const int kcol = MX == 0 ? PC_AF + h * 128 : (MX == 1 ? PC_BQKV + 512 + h * 128 : PC_CK + h * 64);
    const int vcol = MX == 0 ? PC_AI + h * 128 : (MX == 1 ? PC_BQKV + 1024 + h * 128 : PC_CV + h * 128);
    const char* SCb = (const char*)(MX == 0 ? WSP(bf16_t, WS_SCA) : (MX == 1 ? WSP(bf16_t, WS_QKD) : WSP(bf16_t, WS_SCC)));
    bf16_t* O = WSP(bf16_t, WS_O) + (size_t)MX * MROWS * 512;
    unsigned voff[NI]; int mi[NI];
#pragma unroll
    for (int i = 0; i < NI; ++i) { const int n = w + 8 * i, o = 1024 * n + 16 * lane; int m = 0;
#pragma unroll
        for (int q = 1; q < C::NM; ++q) if (o >= C::off(q)) m = q;
        int ro = o, pitch = 128;
#pragma unroll
        for (int q = 0; q < C::NM; ++q) if (m == q) { ro = o - C::off(q); pitch = C::pitch(q); }
        const int r = ro / pitch, pos = (ro % pitch) >> 4, pc = pos ^ (pitch == 256 ? (r & 15) : ((r >> 1) & 7));
        const bool packed = (MX == 0 && m == 1);
        const bool inP = (MX == 1) ? (m < 2) : (m < 2);
        voff[i] = (unsigned)(inP ? (packed ? (r >> 1) * (LDP * 2) + (r & 1) * 128 : r * (LDP * 2)) : r * pitch) + 16u * pc; mi[i] = m; }
    const unsigned x256_0 = (unsigned)(((0 | fq) ^ fr) << 4), x256_1 = (unsigned)(((4 | fq) ^ fr) << 4), x256_2 = (unsigned)(((8 | fq) ^ fr) << 4), x256_3 = (unsigned)(((12 | fq) ^ fr) << 4);
    const unsigned x128_0 = (unsigned)(((0 | fq) ^ ((fr >> 1) & 7)) << 4), x128_1 = (unsigned)(((4 | fq) ^ ((fr >> 1) & 7)) << 4);
    const unsigned x256[4] = {x256_0, x256_1, x256_2, x256_3}, x128[2] = {x128_0, x128_1};
#define SC_FRAG(buf, m, rt, kp) (*(const LAS bf16x8*)(F.lds + (buf) + C::off(m) + (16 * (rt) + fr) * C::pitch(m) + (C::pitch(m) == 256 ? x256[kp] : x128[(kp) & 1])))
    auto slot_of = [&](int step) { return step == 0 ? 256 : b * 64 + step - 1; };
    auto issue = [&](int step, int buf) {
        const int slot = slot_of(step), row0 = slot * 64, unit = slot * 4 + h;
        const char* base[4];
        if (MX == 1) { base[0] = Pb + ((size_t)row0 * LDP + kcol) * 2; base[1] = Pb + ((size_t)row0 * LDP + qcol) * 2; base[2] = (const char*)WSP(bf16_t, WS_K1TB) + (size_t)unit * 16384; base[3] = SCb + (size_t)unit * 8192; }
        else { base[0] = Pb + ((size_t)row0 * LDP + qcol) * 2; base[1] = Pb + ((size_t)row0 * LDP + kcol) * 2; base[2] = SCb + (size_t)unit * 8192; base[3] = base[2]; }
#pragma unroll
        for (int i = 0; i < NI; ++i) { const char* bs = mi[i] == 0 ? base[0] : (mi[i] == 1 ? base[1] : (mi[i] == 2 ? base[2] : base[3]));
            __builtin_amdgcn_global_load_lds((const unsigned*)(bs + voff[i]), (LAS unsigned*)(F.lds + buf + 1024 * (w + 8 * i)), 16, 0, 0); }
    };
    auto load_priv = [&](int step, u32x4 (&pv)[2]) {
        const int row0 = slot_of(step) * 64;
        const bf16_t* vt = (const bf16_t*)Pb + (size_t)(row0 + (ecol >> 1)) * LDP + vcol + (ecol & 1) * 64;
        if (MX == 1) { const u32x2 a = *(const u32x2*)(vt + 4 * fq), c = *(const u32x2*)(vt + 16 + 4 * fq), d = *(const u32x2*)(vt + 32 + 4 * fq), e = *(const u32x2*)(vt + 48 + 4 * fq);
            pv[0] = (u32x4){a.x, a.y, c.x, c.y}; pv[1] = (u32x4){d.x, d.y, e.x, e.y}; }
        else { pv[0] = *(const u32x4*)(vt + 8 * fq); pv[1] = *(const u32x4*)(vt + 32 + 8 * fq); }
    };
    f32x4 S[NT];
#pragma unroll
    for (int i = 0; i < NT; ++i) S[i] = (f32x4){0.f, 0.f, 0.f, 0.f};
    u32x4 pcur[2], pnxt[2];
    auto first_of_set = [](int s) { return s > 0 && s % SETC == 0; };
    issue(0, 0); load_priv(0, pcur);
    for (int step = 0; step < 65; ++step) {
        const int buf = (step & 1) * SCAN_BUF, slot = slot_of(step), row0 = slot * 64, unit = slot * 4 + h;
        if (first_of_set(step)) { PROF_MARK(F, 20); SET_WAIT(l, step / SETC); PROF_MARK(F, 21); issue(step, buf); load_priv(step, pcur); }
        asm volatile("s_waitcnt vmcnt(0)" ::: "memory");
        __syncthreads();
        if (step + 1 < 65 && !first_of_set(step + 1)) { issue(step + 1, SCAN_BUF - buf); load_priv(step + 1, pnxt); }
        bf16x8 Sb[NT / 2];
#pragma unroll
        for (int kp = 0; kp < NT / 2; ++kp) Sb[kp] = pack_acc2(S[2 * kp], S[2 * kp + 1]);
        if (MX == 1) {
            f32x4 vn[4];
#pragma unroll
            for (int mt = 0; mt < 4; ++mt) { f32x4 acc = {0.f, 0.f, 0.f, 0.f};
#pragma unroll
                for (int kp = 0; kp < 4; ++kp) acc = MFMA16(SC_FRAG(buf, 0, mt, kp), Sb[kp], acc);
                const unsigned u0 = mt == 0 ? pcur[0].x : (mt == 1 ? pcur[0].z : (mt == 2 ? pcur[1].x : pcur[1].z)), u1 = mt == 0 ? pcur[0].y : (mt == 1 ? pcur[0].w : (mt == 2 ? pcur[1].y : pcur[1].w));
                vn[mt] = (f32x4){bflo(u0) - acc[0], bfhi(u0) - acc[1], bflo(u1) - acc[2], bfhi(u1) - acc[3]}; }
            bf16x8 Vb[2]; Vb[0] = pack_acc2(vn[0], vn[1]); Vb[1] = pack_acc2(vn[2], vn[3]);
#pragma unroll
            for (int mt = 0; mt < 4; ++mt) { f32x4 acc = {0.f, 0.f, 0.f, 0.f};
#pragma unroll
                for (int kp = 0; kp < 4; ++kp) acc = MFMA16(SC_FRAG(buf, 1, mt, kp), Sb[kp], acc);
#pragma unroll
                for (int kp = 0; kp < 2; ++kp) acc = MFMA16(SC_FRAG(buf, 3, mt, kp), Vb[kp], acc);
#pragma unroll
                for (int r = 0; r < 4; ++r) O[(size_t)(row0 + 16 * mt + 4 * fq + r) * 512 + h * 128 + ecol] = f2bf(acc[r]); }
            const float a = WSP(float, SM_DECB)[unit];
#pragma unroll
            for (int i = 0; i < 8; ++i) { S[i] = S[i] * a;
#pragma unroll
                for (int kp = 0; kp < 2; ++kp) S[i] = MFMA16(SC_FRAG(buf, 2, i, kp), Vb[kp], S[i]); }
        } else {
            const bf16x8 bv0 = mk8(pcur[0]), bv1 = mk8(pcur[1]);
#pragma unroll
            for (int mt = 0; mt < 4; ++mt) { f32x4 acc = {0.f, 0.f, 0.f, 0.f};
#pragma unroll
                for (int kp = 0; kp < NT / 2; ++kp) acc = MFMA16(SC_FRAG(buf, 0, mt, kp), Sb[kp], acc);
                acc = MFMA16(SC_FRAG(buf, 2, mt, 0), bv0, acc); acc = MFMA16(SC_FRAG(buf, 2, mt, 1), bv1, acc);
#pragma unroll
                for (int r = 0; r < 4; ++r) O[(size_t)(row0 + 16 * mt + 4 * fq + r) * 512 + h * 128 + ecol] = f2bf(acc[r]); }
            const float* dec = (MX == 0 ? WSP(float, SM_DECA) : WSP(float, SM_DECC)) + (size_t)unit * DK;
#pragma unroll
            for (int i = 0; i < NT; ++i) { const f32x4 d4 = *(const f32x4*)(dec + 16 * i + 4 * fq); S[i] = S[i] * d4;
                S[i] = MFMA16(SC_FRAG(buf, 1, i, 0), bv0, S[i]); S[i] = MFMA16(SC_FRAG(buf, 1, i, 1), bv1, S[i]); }
        }
        pcur[0] = pnxt[0]; pcur[1] = pnxt[1];
    }
#undef SC_FRAG
    asm volatile("s_waitcnt vmcnt(0)" ::: "memory");
    __syncthreads();
    PROF_MARK(F, 22);
}
__device__ __forceinline__ void phase_scan(Frame& F, int l) {
    if (F.bid >= 48) { for (int k = 1; k < NSETS; ++k) { PROF_MARK(F, 10); prep_set(F, l, k, F.G - 48, F.bid - 48); PROF_MARK(F, 11); SET_SIGNAL(l, k); } return; }
    const int mixer = F.bid >> 4, b = (F.bid >> 2) & 3, h = F.bid & 3;
    if (mixer == 0) scan_mixer<0>(F, l, b, h);
    else if (mixer == 1) scan_mixer<1>(F, l, b, h);
    else scan_mixer<2>(F, l, b, h);
}

template <int KIND>
__device__ __forceinline__ void meta_gemm(Frame& F, const bf16_t* A, const bf16_t* Bt, int N, int K, int n) {
    const int gw = F.bid * NWAVES + F.wave, NGW = F.G * NWAVES, lane = F.lane, fr = lane & 15, fq = lane >> 4;
    for (int tile = gw; tile < N / 16; tile += NGW) {
        const bf16_t* ar = A + (size_t)fr * K + 8 * fq; const bf16_t* br = Bt + (size_t)(16 * tile + fr) * K + 8 * fq;
        f32x4 acc = {0.f, 0.f, 0.f, 0.f};
#pragma unroll 8
        for (int ks = 0; ks < K / 32; ++ks) acc = MFMA16(mk8(*(const u32x4*)(ar + 32 * ks)), mk8(*(const u32x4*)(br + 32 * ks)), acc);
#pragma unroll
        for (int r = 0; r < 4; ++r) { const int row = META_ROW0 + 4 * fq + r, col = 16 * tile + fr;
            if (KIND == 0) WSP(bf16_t, WS_GT)[(size_t)row * 3072 + col] = f2bf(sigmoidf_(acc[r]));
            else if (KIND == 1) { bf16_t* mp = WSP(bf16_t, WS_MERGED) + (size_t)row * 1024 + col; const float g = bf2f(WSP(bf16_t, WS_GT)[(size_t)row * 3072 + n * 1024 + col]);
                *mp = f2bf((n ? bf2f(*mp) : 0.f) + g * acc[r]); }
            else { float* hp = WSP(float, WS_HMETA) + (size_t)(row - NREAL) * D + col; *hp = *hp + acc[r]; } }
    }
}

__device__ __forceinline__ void phase_hnorm(Frame& F, int l) {
    const int gw = F.bid * NWAVES + F.wave, NGW = F.G * NWAVES, lane = F.lane;
    const bf16_t* P = WSP(bf16_t, WS_P);
    LAS float* nws = (LAS float*)F.lds;
    if (F.tid < 384) { const int mxw = F.tid >> 7; const float* src = mxw == 0 ? INP(I_HGRN_NORM) : (mxw == 1 ? INP(I_GDN_NORM) : INP(I_GLA_NORM)); nws[F.tid] = src[(size_t)l * 128 + (F.tid & 127)]; }
    __syncthreads();
    for (int r = gw; r < MROWS; r += NGW) {
        bf16_t* op0 = WSP(bf16_t, WS_O) + (size_t)r * 512 + 8 * lane;
        if (!row_valid(r)) { if (!F.dry) {
#pragma unroll
            for (int mx = 0; mx < 3; ++mx) *(u32x4*)(op0 + (size_t)mx * MROWS * 512) = (u32x4){0u, 0u, 0u, 0u}; } continue; }
        u32x4 ow[3], gv[3];
#pragma unroll
        for (int mx = 0; mx < 3; ++mx) { ow[mx] = *(const u32x4*)(op0 + (size_t)mx * MROWS * 512); gv[mx] = *(const u32x4*)(P + (size_t)r * LDP + (mx == 0 ? PC_AG : (mx == 1 ? PC_BG : PC_CG)) + 8 * lane); }
#pragma unroll
        for (int mx = 0; mx < 3; ++mx) {
            const LAS float* nw = nws + mx * 128 + (8 * lane & 127);
            float o[8] = {bflo(ow[mx].x), bfhi(ow[mx].x), bflo(ow[mx].y), bfhi(ow[mx].y), bflo(ow[mx].z), bfhi(ow[mx].z), bflo(ow[mx].w), bfhi(ow[mx].w)};
            const float g[8] = {siluf_(bflo(gv[mx].x)), siluf_(bfhi(gv[mx].x)), siluf_(bflo(gv[mx].y)), siluf_(bfhi(gv[mx].y)), siluf_(bflo(gv[mx].z)), siluf_(bfhi(gv[mx].z)), siluf_(bflo(gv[mx].w)), siluf_(bfhi(gv[mx].w))};
            float ss = 0.f;
#pragma unroll
            for (int j = 0; j < 8; ++j) ss += o[j] * o[j];
            ss += __shfl_xor(ss, 1); ss += __shfl_xor(ss, 2); ss += __shfl_xor(ss, 4); ss += __shfl_xor(ss, 8);
            const float rstd = rsqrtf(ss * (1.0f / 128.0f) + 1e-6f);
            const f32x4 n0 = *(const LAS f32x4*)nw, n1 = *(const LAS f32x4*)(nw + 4);
            const float nv[8] = {n0[0], n0[1], n0[2], n0[3], n1[0], n1[1], n1[2], n1[3]};
#pragma unroll
            for (int j = 0; j < 8; ++j) o[j] = o[j] * rstd * nv[j] * g[j];
            u32x4 y; y.x = pk2(o[0], o[1]); y.y = pk2(o[2], o[3]); y.z = pk2(o[4], o[5]); y.w = pk2(o[6], o[7]);
            if (!F.dry) *(u32x4*)(op0 + (size_t)mx * MROWS * 512) = y;
        }
    }
}

__device__ __forceinline__ void phase_norm2(Frame& F, int l) {
    if (!F.dry) convert_expert_weights(F, l);
    __syncthreads();
    LAS float* sw = (LAS float*)F.lds;
    { const float* src = WSP(float, SM_RWE) + (size_t)l * 32 * 1024; for (int i = F.tid; i < 32 * 1024 / 4; i += NTHREADS) ((LAS f32x4*)sw)[i] = ((const f32x4*)src)[i]; }
    LAS float* rbias = sw + 32 * 1024;
    if (F.tid < 32) rbias[F.tid] = INP(I_RE_B)[l * 32 + F.tid]; else if (F.tid < 36) rbias[F.tid] = INP(I_RG_B)[l * 4 + (F.tid - 32)];
    __syncthreads();
    const int gw = F.bid * NWAVES + F.wave, NGW = F.G * NWAVES, lane = F.lane;
    float wv[16]; load_row16(INP(I_NORM_FFN) + (size_t)l * D, lane, wv);
    bf16_t* U = WSP(bf16_t, WS_U);
    const float* rwg = WSP(float, SM_RWG) + (size_t)l * 4 * 1024;
    unsigned* cnt = WSP(unsigned, WS_CTL) + CW_CNT + l * 64;
    LAS unsigned* lcnt = (LAS unsigned*)(F.lds + LDS_TAB);
    if (F.tid < 64) lcnt[F.tid] = 0u;
    __syncthreads();
    for (int g = gw; g < MROWS / 4; g += NGW) {
        const int r0 = 4 * g;
        if (!row_valid(r0)) continue;
        float x[4][16];
#pragma unroll
        for (int i = 0; i < 4; ++i) {
            load_row16(hrow(F, r0 + i), lane, x[i]);
            float ss = 0.f;
#pragma unroll
            for (int j = 0; j < 16; ++j) ss += x[i][j] * x[i][j];
            const float rstd = rsqrtf(wave_sum(ss) * (1.0f / D) + 1e-6f);
#pragma unroll
            for (int j = 0; j < 16; ++j) x[i][j] = x[i][j] * rstd * wv[j];
            if (!F.dry) store_bf16_row16(U + (size_t)(r0 + i) * D, lane, x[i]);
        }
#ifndef NORM2_SKIP
#define NORM2_SKIP 0
#endif
        if (F.dry && (NORM2_SKIP & 4)) continue;
        float lg[4][4];
#pragma unroll
        for (int c = 0; c < 4; ++c) {
            float a0 = 0.f, a1 = 0.f, a2 = 0.f, a3 = 0.f;
#pragma unroll
            for (int j = 0; j < 4; ++j) { const f32x4 w = *((const f32x4*)(rwg + c * 1024) + lane + 64 * j);
#pragma unroll
                for (int e = 0; e < 4; ++e) { a0 += x[0][4 * j + e] * w[e]; a1 += x[1][4 * j + e] * w[e]; a2 += x[2][4 * j + e] * w[e]; a3 += x[3][4 * j + e] * w[e]; } }
            const float bg = rbias[32 + c];
            lg[0][c] = wave_sum(a0) + bg; lg[1][c] = wave_sum(a1) + bg; lg[2][c] = wave_sum(a2) + bg; lg[3][c] = wave_sum(a3) + bg;
        }
#pragma unroll
        for (int i = 0; i < 4; ++i) {
            int gi = 0; float gm = lg[i][0];
#pragma unroll
            for (int c = 1; c < 4; ++c) if (lg[i][c] > gm) { gm = lg[i][c]; gi = c; }
            float gsum = 0.f;
#pragma unroll
            for (int c = 0; c < 4; ++c) gsum += __expf(lg[i][c] - gm);
            const float gval = 1.0f / gsum;
            gi = __builtin_amdgcn_readfirstlane(gi);
            int ea = 0, eb = 0; float la = -3.0e38f, lb = -3.0e38f;
            const LAS float* swg = sw + gi * 8 * 1024;
#pragma unroll 1
            for (int cb = 0; cb < ((F.dry && (NORM2_SKIP & 2)) ? 0 : 8); cb += 4) {
                float a0 = 0.f, a1 = 0.f, a2 = 0.f, a3 = 0.f;
#pragma unroll
                for (int j = 0; j < 4; ++j) { const f32x4 w0 = *((const LAS f32x4*)(swg + (cb + 0) * 1024) + lane + 64 * j), w1 = *((const LAS f32x4*)(swg + (cb + 1) * 1024) + lane + 64 * j), w2 = *((const LAS f32x4*)(swg + (cb + 2) * 1024) + lane + 64 * j), w3 = *((const LAS f32x4*)(swg + (cb + 3) * 1024) + lane + 64 * j);
#pragma unroll
                    for (int e = 0; e < 4; ++e) { const float xv = x[i][4 * j + e]; a0 += xv * w0[e]; a1 += xv * w1[e]; a2 += xv * w2[e]; a3 += xv * w3[e]; } }
                const float e0 = wave_sum(a0) + rbias[gi * 8 + cb], e1 = wave_sum(a1) + rbias[gi * 8 + cb + 1], e2 = wave_sum(a2) + rbias[gi * 8 + cb + 2], e3 = wave_sum(a3) + rbias[gi * 8 + cb + 3];
                const float ev[4] = {e0, e1, e2, e3};
#pragma unroll
                for (int q = 0; q < 4; ++q) { const float el = ev[q]; const int c = cb + q; if (el > la) { lb = la; eb = ea; la = el; ea = c; } else if (el > lb) { lb = el; eb = c; } }
            }
            const float wa = 1.0f / (1.0f + __expf(lb - la)), wb = 1.0f - wa;
            if (lane == 0 && !F.dry) {
                const unsigned e0 = (unsigned)(gi * 8 + ea), e1 = (unsigned)(gi * 8 + eb);
                const unsigned p0 = __hip_atomic_fetch_add(lcnt + e0, 1u, __ATOMIC_RELAXED, __HIP_MEMORY_SCOPE_WORKGROUP), p1 = __hip_atomic_fetch_add(lcnt + e1, 1u, __ATOMIC_RELAXED, __HIP_MEMORY_SCOPE_WORKGROUP);
                unsigned* tok = WSP(unsigned, SM_TOK) + (size_t)(r0 + i) * 8;
                tok[0] = e0; tok[1] = p0; tok[2] = e1; tok[3] = p1; tok[4] = __float_as_uint(gval * wa); tok[5] = __float_as_uint(gval * wb);
            }
        }
    }
    __syncthreads();
    if (F.tid < 32 && !F.dry) lcnt[32 + F.tid] = atomicAdd(cnt + F.tid, lcnt[F.tid]);
    __syncthreads();
    if (!F.dry) for (int g = gw; g < MROWS / 4; g += NGW) { const int r0 = 4 * g; if (!row_valid(r0)) continue;
        if (lane < 4) { unsigned* tok = WSP(unsigned, SM_TOK) + (size_t)(r0 + lane) * 8; tok[1] += lcnt[32 + tok[0]]; tok[3] += lcnt[32 + tok[2]]; } }
}

__device__ __forceinline__ int moe_tables(Frame& F, int l) {
    LAS int* offs = (LAS int*)(F.lds + LDS_TAB); LAS unsigned char* tab = (LAS unsigned char*)(F.lds + LDS_TAB + 384); LAS int* cn = (LAS int*)(F.lds + LDS_TAB + 192);
    const unsigned* cnt = WSP(unsigned, WS_CTL) + CW_CNT + l * 64;
    __syncthreads();
    if (F.tid < 32) cn[F.tid] = (int)__hip_atomic_load(cnt + F.tid, __ATOMIC_RELAXED, __HIP_MEMORY_SCOPE_AGENT);
    __syncthreads();
    if (F.tid == 0) { int acc = 0;
#pragma unroll 1
        for (int e = 0; e < 32; ++e) { offs[e] = acc; acc += ((cn[e] + 255) >> 8) << 8; }
        offs[32] = acc; }
    __syncthreads();
    if (F.tid < 160) { const int row = F.tid << 8; int e = 0;
#pragma unroll 1
        for (int k = 1; k < 32; ++k) if (offs[k] <= row) e = k;
        tab[F.tid] = (unsigned char)e; }
    __syncthreads();
    return offs[32] >> 8;
}

__device__ __forceinline__ void phase_gather(Frame& F, int l) {
    (void)moe_tables(F, l);
    const LAS int* offs = (const LAS int*)(F.lds + LDS_TAB); const LAS int* cn = (const LAS int*)(F.lds + LDS_TAB + 192);
    const int gw = F.bid * NWAVES + F.wave, NGW = F.G * NWAVES, lane = F.lane;
    const bf16_t* U = WSP(bf16_t, WS_U); bf16_t* XG = WSP(bf16_t, WS_XG); float* wrow = WSP(float, SM_WROW);
    for (int idx = gw; idx < NREAL + 16; idx += 2 * NGW) {
        const int idx2 = idx + NGW; const bool has2 = idx2 < NREAL + 16;
        const int r = idx < NREAL ? idx : META_ROW0 + (idx - NREAL), r2 = has2 ? (idx2 < NREAL ? idx2 : META_ROW0 + (idx2 - NREAL)) : r;
        unsigned* tok = WSP(unsigned, SM_TOK) + (size_t)r * 8; unsigned* tok2 = WSP(unsigned, SM_TOK) + (size_t)r2 * 8;
        const u32x4 ta = *(const u32x4*)tok, tb = *(const u32x4*)tok2; const u32x2 wa = *(const u32x2*)(tok + 4), wb = *(const u32x2*)(tok2 + 4);
        const unsigned g0 = (unsigned)offs[ta.x] + ta.y, g1 = (unsigned)offs[ta.z] + ta.w, h0 = (unsigned)offs[tb.x] + tb.y, h1 = (unsigned)offs[tb.z] + tb.w;
        const u32x4* src = (const u32x4*)(U + (size_t)r * D); const u32x4* src2 = (const u32x4*)(U + (size_t)r2 * D);
        const u32x4 a = src[lane], b = src[lane + 64], c = src2[lane], d = src2[lane + 64];
        if (lane == 0) { tok[6] = g0; tok[7] = g1; wrow[g0] = __uint_as_float(wa.x); wrow[g1] = __uint_as_float(wa.y); }
        u32x4* d0 = (u32x4*)(XG + (size_t)g0 * D); u32x4* d1 = (u32x4*)(XG + (size_t)g1 * D);
        d0[lane] = a; d0[lane + 64] = b; d1[lane] = a; d1[lane + 64] = b;
        if (has2) { if (lane == 0) { tok2[6] = h0; tok2[7] = h1; wrow[h0] = __uint_as_float(wb.x); wrow[h1] = __uint_as_float(wb.y); }
            u32x4* e0 = (u32x4*)(XG + (size_t)h0 * D); u32x4* e1 = (u32x4*)(XG + (size_t)h1 * D);
            e0[lane] = c; e0[lane + 64] = d; e1[lane] = c; e1[lane + 64] = d; }
    }
    u32x4 zz = {0u, 0u, 0u, 0u}; asm volatile("" : "+v"(zz));
    for (int i = gw; i < 32 * 256; i += NGW) { const int e = i >> 8, j = i & 255; const int row = offs[e] + cn[e] + j;
        if (row < offs[e + 1]) { u32x4* d = (u32x4*)(XG + (size_t)row * D); d[lane] = zz; d[lane + 64] = zz; if (lane == 0) wrow[row] = 0.f; } }
}

__device__ __forceinline__ void phase_final(Frame& F) {
    const int gw = F.bid * NWAVES + F.wave, NGW = F.G * NWAVES, lane = F.lane;
    float wv[16]; load_row16(INP(I_NORM_FINAL), lane, wv);
    for (int r = gw; r < NREAL; r += 2 * NGW) {
        const int r2 = r + NGW;
        float x[16], y[16]; fetch_h_row(F, 2, r, x); fetch_h_row(F, 2, r2, y);
        float ss = 0.f, s2 = 0.f;
#pragma unroll
        for (int j = 0; j < 16; ++j) { ss += x[j] * x[j]; s2 += y[j] * y[j]; }
        const float rstd = rsqrtf(wave_sum(ss) * (1.0f / D) + 1e-6f), rstd2 = rsqrtf(wave_sum(s2) * (1.0f / D) + 1e-6f);
#pragma unroll
        for (int j = 0; j < 16; ++j) { x[j] = x[j] * rstd * wv[j]; y[j] = y[j] * rstd2 * wv[j]; }
        store_row16(OUTP + (size_t)r * D, lane, x); store_row16(OUTP + (size_t)r2 * D, lane, y);
    }
}
constexpr int PH_PER_LAYER = 14, N_PHASES = 2 + 2 * PH_PER_LAYER;
#ifndef DBG_STOP
#define DBG_STOP 0
#endif
#ifndef DBG_SRC
#define DBG_SRC WS_P
#define DBG_LD LDP
#endif
#ifndef DBG_TA
#define DBG_TA -1
#endif
#ifndef DBG_TQ
#define DBG_TQ 16.0f
#endif
#ifndef DBG_TB
#define DBG_TB -1
#endif
#ifndef DUP_MASK
#define DUP_MASK 0u
#endif
#define DUPN(j) (((DUP_MASK >> (j)) & 1u) ? 2 : 1)
#ifndef MK_ONE_LAUNCH
#define MK_ONE_LAUNCH 1
#endif

template <unsigned PHMASK_T>
__global__ void __launch_bounds__(NTHREADS, 2) hybrid_fwd(Params p) {
    extern __shared__ __attribute__((aligned(16))) unsigned char lds_raw[];
    Frame F;
    F.lds = (LAS unsigned char*)lds_raw; F.tid = threadIdx.x; F.lane = F.tid & 63; F.wave = __builtin_amdgcn_readfirstlane(F.tid >> 6); F.G = gridDim.x; F.bid = blockIdx.x; F.dry = 0;
    F.out = (GAS float*)p.out; F.ws = (GAS unsigned char*)p.ws; F.inp = (const float* const __attribute__((address_space(4)))*)__builtin_amdgcn_kernarg_segment_ptr();
    volatile LAS unsigned* MISC = (volatile LAS unsigned*)(F.lds + LDS_MISC);
    if (F.tid < 128) MISC[F.tid] = 0u;
    if (F.bid >= 48 && F.tid == 0) (void)xb_add(WSP(unsigned, WS_CTL) + 8192 + 64 + xb_xcc_id(), 1u);
    __syncthreads();
#if MK_ONE_LAUNCH
    constexpr int lo = 0, hi = N_PHASES;
#else
    const int lo = p.ph_lo, hi = p.ph_hi;
#endif
    if (hi - lo > 1) (void)xcd_barrier_post(WSP(unsigned, WS_CTL) + CW_BAR, MISC + 8);
#define GRID_BARRIER() xcd_barrier(WSP(unsigned, WS_CTL) + CW_BAR, xb_xcc_id(), (volatile LAS unsigned*)(F.lds + LDS_MISC) + 8, F.tid, (unsigned)F.G)
#define EN(j) ((PHMASK_T >> (j)) & 1u)
#define IN(k) (lo <= (k) && (k) < hi)
    if (DBG_TA >= 0 && F.tid == 0) { MISC[16] = (unsigned)__builtin_amdgcn_s_memrealtime(); MISC[17] = 0u; }
#define SEAM(k) do { if (IN(k) && IN((k) + 1)) GRID_BARRIER(); PHASE_FENCE(F); \
    if (DBG_TA >= 0 && F.tid == 0) { const unsigned t_now = (unsigned)__builtin_amdgcn_s_memrealtime(); const int kk = (k) == 0 ? 15 : (((k) - 1) % PH_PER_LAYER); const int kind = (kk >= 6 && kk <= 8) ? 6 : kk; \
        if (kind == DBG_TA) MISC[17] += t_now - MISC[16]; MISC[16] = t_now; } } while (0)
    PHASE_FENCE(F);
    if (EN(15) && IN(0)) phase_pre(F);
    SEAM(0);
    { constexpr int l = 0;
        const int pb = 1 + PH_PER_LAYER * l;
        for (int rep = 0; rep < (l == 0 ? DUPN(0) : 1); ++rep) { if (rep) { GRID_BARRIER(); PHASE_FENCE(F); } if (EN(0) && IN(pb + 0)) phase_norm1(F, l); }
        SEAM(pb + 0);
        for (int rep = 0; rep < DUPN(1); ++rep) { if (rep) { GRID_BARRIER(); PHASE_FENCE(F); }
        if (EN(1) && IN(pb + 1)) {
            pg8::Gemm g{WSP(bf16_t, WS_U), WSP(bf16_t, WS_WMIX), MROWS, LDP, D}; pg8::StaticOrder S; S.init(MROWS, LDP, F.G, F.bid);
            pg8::EpiInProj E{WSP(bf16_t, WS_P), WSP(bf16_t, SM_HALO)};
            pg8::gemm_phase(F.lds, F.tid, g, S, E);
        } }
        SEAM(pb + 1);
        if (EN(2) && IN(pb + 2)) prep_set(F, l, 0, F.G, F.bid);
        SEAM(pb + 2);
        if (EN(3) && IN(pb + 3)) phase_scan(F, l);
        SEAM(pb + 3);
        for (int rep = 0; rep < DUPN(4); ++rep) { if (rep) { GRID_BARRIER(); PHASE_FENCE(F); F.dry = 1; asm volatile("" : "+s"(F.dry)); } if (EN(4) && IN(pb + 4)) phase_hnorm(F, l); F.dry = 0; }
        SEAM(pb + 4);
        for (int rep = 0; rep < DUPN(5); ++rep) { if (rep) { GRID_BARRIER(); PHASE_FENCE(F); }
        if (EN(5) && IN(pb + 5)) {
            pg8::Gemm g{WSP(bf16_t, WS_U), WSP(bf16_t, WS_WGATE), NREAL, 3072, D}; pg8::StaticOrder S; S.init(NREAL, 3072, F.G, F.bid);
            pg8::EpiSigmoid E{WSP(bf16_t, WS_GT), 3072};
            pg8::gemm_phase(F.lds, F.tid, g, S, E);
            meta_gemm<0>(F, WSP(bf16_t, WS_U) + (size_t)META_ROW0 * D, WSP(bf16_t, WS_WGATE), 3072, D, 0);
        } }
        SEAM(pb + 5);
        for (int n = 0; n < 3; ++n) {
            if (EN(6) && IN(pb + 6 + n)) {
                pg8::Gemm g{WSP(bf16_t, WS_O) + (size_t)n * MROWS * 512, WSP(bf16_t, WS_WBT) + (size_t)n * 1024 * 512, NREAL, D, 512}; pg8::StaticOrder S; S.init(NREAL, D, F.G, F.bid);
                pg8::EpiBranch E{WSP(bf16_t, WS_MERGED), WSP(bf16_t, WS_GT), n};
                pg8::gemm_phase(F.lds, F.tid, g, S, E);
                meta_gemm<1>(F, WSP(bf16_t, WS_O) + (size_t)n * MROWS * 512 + (size_t)META_ROW0 * 512, WSP(bf16_t, WS_WBT) + (size_t)n * 1024 * 512, D, 512, n);
            }
            SEAM(pb + 6 + n);
        }
        if (EN(9) && IN(pb + 9)) {
            pg8::Gemm g{WSP(bf16_t, WS_MERGED), WSP(bf16_t, WS_WOT), NREAL, D, D}; pg8::StaticOrder S; S.init(NREAL, D, F.G, F.bid);
            pg8::EpiResidual E{OUTP, WSP(float, WS_HMETA)};
            pg8::gemm_phase(F.lds, F.tid, g, S, E);
            meta_gemm<2>(F, WSP(bf16_t, WS_MERGED) + (size_t)META_ROW0 * D, WSP(bf16_t, WS_WOT), D, D, 0);
        }
        SEAM(pb + 9);
        for (int rep = 0; rep < DUPN(10); ++rep) { if (rep) { GRID_BARRIER(); PHASE_FENCE(F); F.dry = 1; asm volatile("" : "+s"(F.dry)); } if (EN(10) && IN(pb + 10)) phase_norm2(F, l); F.dry = 0; }
        SEAM(pb + 10);
        for (int rep = 0; rep < DUPN(11); ++rep) { if (rep) { GRID_BARRIER(); PHASE_FENCE(F); } if (EN(11) && IN(pb + 11)) phase_gather(F, l); }
        SEAM(pb + 11);
        for (int rep = 0; rep < DUPN(12); ++rep) { if (rep) { GRID_BARRIER(); PHASE_FENCE(F); }
        if (EN(12) && IN(pb + 12)) {
            const int ntiles = moe_tables(F, l);
            pg8::Gemm g{WSP(bf16_t, WS_XG), WSP(bf16_t, WS_W1T), XG_ROWS, 512, D};
            pg8::MoeOrder S{F.G, F.bid, 2, ntiles, (const LAS unsigned char*)(F.lds + LDS_TAB + 384), (size_t)512 * 1024 * 2};
            pg8::EpiMoeUp E{WSP(bf16_t, WS_HG)};
            pg8::gemm_phase(F.lds, F.tid, g, S, E);
        } }
        SEAM(pb + 12);
        for (int rep = 0; rep < DUPN(13); ++rep) { if (rep) { GRID_BARRIER(); PHASE_FENCE(F); }
        if (EN(13) && IN(pb + 13)) {
            const int ntiles = moe_tables(F, l);
            pg8::Gemm g{WSP(bf16_t, WS_HG), WSP(bf16_t, WS_W2T), XG_ROWS, D, 256};
            pg8::MoeOrder S{F.G, F.bid, 4, ntiles, (const LAS unsigned char*)(F.lds + LDS_TAB + 384), (size_t)1024 * 256 * 2};
            pg8::EpiMoeDown E{WSP(bf16_t, WS_Y2), WSP(float, SM_WROW)};
            pg8::gemm_phase(F.lds, F.tid, g, S, E);
        } }
        SEAM(pb + 13);
    }
    { constexpr int l = 1;
        const int pb = 1 + PH_PER_LAYER * l;
        for (int rep = 0; rep < (l == 0 ? DUPN(0) : 1); ++rep) { if (rep) { GRID_BARRIER(); PHASE_FENCE(F); } if (EN(0) && IN(pb + 0)) phase_norm1(F, l); }
        SEAM(pb + 0);
        for (int rep = 0; rep < DUPN(1); ++rep) { if (rep) { GRID_BARRIER(); PHASE_FENCE(F); }
        if (EN(1) && IN(pb + 1)) {
            pg8::Gemm g{WSP(bf16_t, WS_U), WSP(bf16_t, WS_WMIX), MROWS, LDP, D}; pg8::StaticOrder S; S.init(MROWS, LDP, F.G, F.bid);
            pg8::EpiInProj E{WSP(bf16_t, WS_P), WSP(bf16_t, SM_HALO)};
            pg8::gemm_phase(F.lds, F.tid, g, S, E);
        } }
        SEAM(pb + 1);
        if (EN(2) && IN(pb + 2)) prep_set(F, l, 0, F.G, F.bid);
        SEAM(pb + 2);
        if (EN(3) && IN(pb + 3)) phase_scan(F, l);
        SEAM(pb + 3);
        for (int rep = 0; rep < DUPN(4); ++rep) { if (rep) { GRID_BARRIER(); PHASE_FENCE(F); F.dry = 1; asm volatile("" : "+s"(F.dry)); } if (EN(4) && IN(pb + 4)) phase_hnorm(F, l); F.dry = 0; }
        SEAM(pb + 4);
        for (int rep = 0; rep < DUPN(5); ++rep) { if (rep) { GRID_BARRIER(); PHASE_FENCE(F); }
        if (EN(5) && IN(pb + 5)) {
            pg8::Gemm g{WSP(bf16_t, WS_U), WSP(bf16_t, WS_WGATE), NREAL, 3072, D}; pg8::StaticOrder S; S.init(NREAL, 3072, F.G, F.bid);
            pg8::EpiSigmoid E{WSP(bf16_t, WS_GT), 3072};
            pg8::gemm_phase(F.lds, F.tid, g, S, E);
            meta_gemm<0>(F, WSP(bf16_t, WS_U) + (size_t)META_ROW0 * D, WSP(bf16_t, WS_WGATE), 3072, D, 0);
        } }
        SEAM(pb + 5);
        for (int n = 0; n < 3; ++n) {
            if (EN(6) && IN(pb + 6 + n)) {
                pg8::Gemm g{WSP(bf16_t, WS_O) + (size_t)n * MROWS * 512, WSP(bf16_t, WS_WBT) + (size_t)n * 1024 * 512, NREAL, D, 512}; pg8::StaticOrder S; S.init(NREAL, D, F.G, F.bid);
                pg8::EpiBranch E{WSP(bf16_t, WS_MERGED), WSP(bf16_t, WS_GT), n};
                pg8::gemm_phase(F.lds, F.tid, g, S, E);
                meta_gemm<1>(F, WSP(bf16_t, WS_O) + (size_t)n * MROWS * 512 + (size_t)META_ROW0 * 512, WSP(bf16_t, WS_WBT) + (size_t)n * 1024 * 512, D, 512, n);
            }
            SEAM(pb + 6 + n);
        }
        if (EN(9) && IN(pb + 9)) {
            pg8::Gemm g{WSP(bf16_t, WS_MERGED), WSP(bf16_t, WS_WOT), NREAL, D, D}; pg8::StaticOrder S; S.init(NREAL, D, F.G, F.bid);
            pg8::EpiResidual E{OUTP, WSP(float, WS_HMETA)};
            pg8::gemm_phase(F.lds, F.tid, g, S, E);
            meta_gemm<2>(F, WSP(bf16_t, WS_MERGED) + (size_t)META_ROW0 * D, WSP(bf16_t, WS_WOT), D, D, 0);
        }
        SEAM(pb + 9);
        for (int rep = 0; rep < DUPN(10); ++rep) { if (rep) { GRID_BARRIER(); PHASE_FENCE(F); F.dry = 1; asm volatile("" : "+s"(F.dry)); } if (EN(10) && IN(pb + 10)) phase_norm2(F, l); F.dry = 0; }
        SEAM(pb + 10);
        for (int rep = 0; rep < DUPN(11); ++rep) { if (rep) { GRID_BARRIER(); PHASE_FENCE(F); } if (EN(11) && IN(pb + 11)) phase_gather(F, l); }
        SEAM(pb + 11);
        for (int rep = 0; rep < DUPN(12); ++rep) { if (rep) { GRID_BARRIER(); PHASE_FENCE(F); }
        if (EN(12) && IN(pb + 12)) {
            const int ntiles = moe_tables(F, l);
            pg8::Gemm g{WSP(bf16_t, WS_XG), WSP(bf16_t, WS_W1T), XG_ROWS, 512, D};
            pg8::MoeOrder S{F.G, F.bid, 2, ntiles, (const LAS unsigned char*)(F.lds + LDS_TAB + 384), (size_t)512 * 1024 * 2};
            pg8::EpiMoeUp E{WSP(bf16_t, WS_HG)};
            pg8::gemm_phase(F.lds, F.tid, g, S, E);
        } }
        SEAM(pb + 12);
        for (int rep = 0; rep < DUPN(13); ++rep) { if (rep) { GRID_BARRIER(); PHASE_FENCE(F); }
        if (EN(13) && IN(pb + 13)) {
            const int ntiles = moe_tables(F, l);
            pg8::Gemm g{WSP(bf16_t, WS_HG), WSP(bf16_t, WS_W2T), XG_ROWS, D, 256};
            pg8::MoeOrder S{F.G, F.bid, 4, ntiles, (const LAS unsigned char*)(F.lds + LDS_TAB + 384), (size_t)1024 * 256 * 2};
            pg8::EpiMoeDown E{WSP(bf16_t, WS_Y2), WSP(float, SM_WROW)};
            pg8::gemm_phase(F.lds, F.tid, g, S, E);
        } }
        SEAM(pb + 13);
    }
#if DBG_STOP > 0
    if (EN(14) && IN(N_PHASES - 1)) { const int gt = F.bid * NTHREADS + F.tid, NT = F.G * NTHREADS;
#ifdef DBG_LIN
        { const bf16_t* s1 = WSP(bf16_t, DBG_SRC); const bf16_t* s2 = WSP(bf16_t, DBG_SRC2);
          for (size_t i = gt; i < (size_t)NREAL * D; i += NT) F.out[i] = i < (size_t)DBG_N1 ? bf2f(s1[i]) : (i < (size_t)DBG_N1 + DBG_N2 ? bf2f(s2[i - DBG_N1]) : 0.f); }
#else
        if (DBG_LD > 0) { const bf16_t* src = WSP(bf16_t, DBG_SRC); for (size_t i = gt; i < (size_t)NREAL * D; i += NT) { const size_t r = i >> 10, c = i & 1023; F.out[i] = bf2f(src[r * DBG_LD + (c * DBG_LD) / 1024]); } }
#endif
    }
#else
#ifdef DBG_XBAR
    for (int i = 0; i < DBG_XBAR; ++i) { GRID_BARRIER(); PHASE_FENCE(F); }
#endif
    if (EN(14) && IN(N_PHASES - 1)) phase_final(F);
    PROF_SPIN(F);
    if (DBG_TA >= 0) { float* tw = WSP(float, WS_CTL) + 2048; if (F.bid == 0 && F.tid == 0) { tw[0] = (float)MISC[17] * 0.01f; }
        GRID_BARRIER(); PHASE_FENCE(F);
        const float v = floorf(WSP(float, WS_CTL)[2048] * (1.0f / DBG_TQ)) * 0.25f;
        const int gt = F.bid * NTHREADS + F.tid, NT = F.G * NTHREADS;
        for (size_t i = gt; i < (size_t)NREAL * D; i += NT) F.out[i] = v; }
#endif
#undef IN
#undef SEAM
}

#if MK_ONE_LAUNCH
#ifndef KM_ONE
#define KM_ONE 0xffffffffu
#endif
constexpr unsigned KMASK[1] = {KM_ONE};
#else
constexpr unsigned KMASK[3] = {0x0C19u, 0xC004u, 0x3262u};
#endif
template <unsigned M> static bool setup_kernel(int& per_cu) {
    if (hipFuncSetAttribute((const void*)hybrid_fwd<M>, hipFuncAttributeMaxDynamicSharedMemorySize, LDS_BYTES) != hipSuccess) return false;
    if (hipOccupancyMaxActiveBlocksPerMultiprocessor(&per_cu, (const void*)hybrid_fwd<M>, NTHREADS, LDS_BYTES) != hipSuccess) per_cu = 0;
    (void)hipGetLastError();
    return true;
}
static int phase_kind(int k) { if (k == 0) return 15; if (k == N_PHASES - 1) return 14; const int j = (k - 1) % PH_PER_LAYER; return (j >= 6 && j <= 8) ? 6 : j; }
extern "C" void kernel_launch(void* const* d_in, const int* in_sizes, int n_in, void* d_out, int out_size, void* d_ws, size_t ws_size, hipStream_t stream) {
    static int grid = 0;
    if (grid == 0) {
        if (n_in != 24 || in_sizes[0] != NREAL * D || out_size != NREAL * D || ws_size < WS_END) {
            fprintf(stderr, "kernel_launch: unexpected problem (n_in %d, in0 %d, out %d, ws %zu < %zu); nothing launched\n", n_in, n_in > 0 ? in_sizes[0] : -1, out_size, ws_size, (size_t)WS_END); grid = -1; return; }
        int dev = 0, cus = 0, per_cu = 0; bool ok = true;
        if (hipGetDevice(&dev) != hipSuccess || hipDeviceGetAttribute(&cus, hipDeviceAttributeMultiprocessorCount, dev) != hipSuccess) { grid = -1; return; }
#if MK_ONE_LAUNCH
        ok = setup_kernel<KMASK[0]>(per_cu);
#else
        ok = setup_kernel<KMASK[0]>(per_cu) && setup_kernel<KMASK[1]>(per_cu) && setup_kernel<KMASK[2]>(per_cu);
#endif
        if (!ok) { fprintf(stderr, "kernel_launch: hipFuncSetAttribute failed\n"); grid = -1; return; }
        if (per_cu < 1) fprintf(stderr, "kernel_launch: occupancy query says %d\n", per_cu);
        grid = cus;
    }
    if (grid < 0) return;
    if (hipMemsetAsync((char*)d_ws + WS_CTL, 0, CTL_BYTES, stream) != hipSuccess) return;
    Params p{};
    for (int i = 0; i < 24; ++i) p.in[i] = (const float*)d_in[i];
    p.out = (float*)d_out; p.ws = (unsigned char*)d_ws;
#if MK_ONE_LAUNCH
    p.ph_lo = 0; p.ph_hi = N_PHASES;
    hipLaunchKernelGGL(hybrid_fwd<KMASK[0]>, dim3(grid), dim3(NTHREADS), LDS_BYTES, stream, p);
#else
    for (int k = 0; k < N_PHASES; ++k) { if (DBG_STOP > 0 && k >= DBG_STOP && k != N_PHASES - 1) continue; p.ph_lo = k; p.ph_hi = k + 1; const unsigned bit = 1u << phase_kind(k);
        if (KMASK[0] & bit) hipLaunchKernelGGL(hybrid_fwd<KMASK[0]>, dim3(grid), dim3(NTHREADS), LDS_BYTES, stream, p);
        else if (KMASK[1] & bit) hipLaunchKernelGGL(hybrid_fwd<KMASK[1]>, dim3(grid), dim3(NTHREADS), LDS_BYTES, stream, p);
        else hipLaunchKernelGGL(hybrid_fwd<KMASK[2]>, dim3(grid), dim3(NTHREADS), LDS_BYTES, stream, p); }
#endif
}
```

```cpp
#include <hip/hip_runtime.h>
#include <cstdio>
#include <cstdint>

#define LAS __attribute__((address_space(3)))
typedef unsigned short bf16_t;
typedef short bf16x8 __attribute__((ext_vector_type(8)));
typedef float f32x4 __attribute__((ext_vector_type(4)));
typedef float f32x2 __attribute__((ext_vector_type(2)));
typedef unsigned u32x4 __attribute__((ext_vector_type(4)));
typedef unsigned u32x2 __attribute__((ext_vector_type(2)));

constexpr int D = 1024, NREAL = 16384, MROWS = 16640, META_ROW0 = 16384 + 48, META_END = 16384 + 64;
constexpr int NSLOT = 257;
constexpr int LDP = 5632;
constexpr int PC_AQ = 0, PC_AF = 512, PC_AI = 1024, PC_AG = 1536, PC_BQKV = 2048, PC_BG = 3584, PC_CQ = 4096, PC_CK = 4352, PC_CV = 4608, PC_CG = 5120;
constexpr int IN_COLS = 8728;
constexpr int NTHREADS = 512, NWAVES = 8;
constexpr int XG_ROWS = 40960;

constexpr size_t MiB = 1ull << 20;
constexpr size_t WS_CTL = 0, CTL_BYTES = 1 * MiB;
constexpr int CW_BAR = 4096, CW_CNT = 1024;
constexpr size_t SM_SW1 = 1 * MiB;
constexpr size_t SM_RWG = SM_SW1 + 2 * 24 * 1024 * 4;
constexpr size_t SM_RWE = SM_RWG + 2 * 4 * 1024 * 4;
constexpr size_t SM_LAB = SM_RWE + 2 * 32 * 1024 * 4;
constexpr size_t SM_GK = SM_LAB + 2 * 2 * 512 * 4;
constexpr size_t SM_BETA = SM_GK + (size_t)MROWS * 16 * 4;
constexpr size_t SM_LOGA = SM_BETA + (size_t)MROWS * 4 * 4;
constexpr size_t SM_TOK = SM_LOGA + (size_t)MROWS * 4 * 4;
constexpr size_t SM_WROW = SM_TOK + (size_t)MROWS * 8 * 4;
constexpr size_t SM_DECA = SM_WROW + (size_t)XG_ROWS * 4;
constexpr size_t SM_DECC = SM_DECA + 1028 * 128 * 4;
constexpr size_t SM_DECB = SM_DECC + 1028 * 64 * 4;
constexpr size_t SM_HALO = SM_DECB + 8192;
constexpr size_t SM_END = SM_HALO + 260 * 3 * 1536 * 2;
static_assert(SM_END <= 8 * MiB, "small region");
constexpr size_t WS_HMETA = 8 * MiB;
constexpr size_t WS_WMIX = 9 * MiB;
constexpr size_t WS_WGATE = 20 * MiB;
constexpr size_t WS_WBT = 26 * MiB;
constexpr size_t WS_WOT = 29 * MiB;
constexpr size_t WS_O = 31 * MiB;
constexpr size_t O_STRIDE = (size_t)MROWS * 512 * 2;
constexpr size_t WS_W1T = 31 * MiB;
constexpr size_t WS_W2T = 63 * MiB;
constexpr size_t WS_U = 80 * MiB;
constexpr size_t WS_P = 113 * MiB;
constexpr size_t WS_GT = 113 * MiB;
constexpr size_t WS_MERGED = 211 * MiB;
constexpr size_t WS_XG = 113 * MiB;
constexpr size_t WS_HG = 193 * MiB;
constexpr size_t WS_Y2 = 213 * MiB;
constexpr size_t WS_SCA = 294 * MiB;
constexpr size_t WS_QKD = 303 * MiB;
constexpr size_t WS_SCC = 312 * MiB;
constexpr size_t WS_K1TB = 321 * MiB;
constexpr size_t WS_END = 338 * MiB;

constexpr int LDS_BYTES = 163840;
constexpr int LDS_MISC = LDS_BYTES - 512;
constexpr int LDS_TAB = LDS_BYTES - 1536;
constexpr int LDS_SCRATCH = LDS_TAB;

typedef __bf16 bf16x2v __attribute__((ext_vector_type(2)));
__device__ __forceinline__ unsigned pk2(float lo, float hi) { const f32x2 v = {lo, hi}; return __builtin_bit_cast(unsigned, __builtin_convertvector(v, bf16x2v)); }
__device__ __forceinline__ bf16_t f2bf(float f) { return (bf16_t)(pk2(f, 0.f) & 0xffffu); }
__device__ __forceinline__ float bf2f(bf16_t b) { return __uint_as_float(((unsigned)b) << 16); }
__device__ __forceinline__ float bflo(unsigned w) { return __uint_as_float(w << 16); }
__device__ __forceinline__ float bfhi(unsigned w) { return __uint_as_float(w & 0xffff0000u); }
__device__ __forceinline__ float sigmoidf_(float x) { return __builtin_amdgcn_rcpf(1.0f + __expf(-x)); }
__device__ __forceinline__ float siluf_(float x) { return x * __builtin_amdgcn_rcpf(1.0f + __expf(-x)); }
__device__ __forceinline__ float logsigf_(float x) { return fminf(x, 0.f) - __logf(1.0f + __expf(-fabsf(x))); }
__device__ __forceinline__ float softplusf_(float x) { return fmaxf(x, 0.f) + log1pf(__expf(-fabsf(x))); }
__device__ __forceinline__ bool row_valid(int r) { return r < NREAL || (r >= META_ROW0 && r < META_END); }
__device__ __forceinline__ float wave_sum(float v) {
#define DPP_ADD(ctrl, rmask) v += __int_as_float(__builtin_amdgcn_update_dpp(0, __float_as_int(v), (ctrl), (rmask), 0xf, false))
    DPP_ADD(0x111, 0xf); DPP_ADD(0x112, 0xf); DPP_ADD(0x114, 0xf); DPP_ADD(0x118, 0xf);
    DPP_ADD(0x142, 0xa); DPP_ADD(0x143, 0xc);
#undef DPP_ADD
    return __int_as_float(__builtin_amdgcn_readlane(__float_as_int(v), 63));
}
#define LDS_WAIT() asm volatile("s_waitcnt lgkmcnt(0)" ::: "memory")

#define XB_TMO      128
#define XB_XCNT(j)  (256  + 64 * (j))
#define XB_XSUB(j)  (1280 + 64 * (j))
#define XB_XGEN(j)  (2304 + 64 * (j))
#define XB_TOP      3328
#define XB_TOPGEN   3392
#define XCD_BAR_WORDS 3456
#define XB_SPIN_CAP (1u << 18)
__device__ __forceinline__ unsigned xb_ld(unsigned* p)              { return __hip_atomic_load(p, __ATOMIC_RELAXED, __HIP_MEMORY_SCOPE_AGENT); }
__device__ __forceinline__ unsigned xb_add(unsigned* p, unsigned v) { return __hip_atomic_fetch_add(p, v, __ATOMIC_RELAXED, __HIP_MEMORY_SCOPE_AGENT); }
__device__ __forceinline__ unsigned xb_xcc_id() { return (unsigned)__builtin_amdgcn_s_getreg((3 << 11) | 20) & 0xFu; }
#define XB_SPIN(cond, bar) do { unsigned _sp = 0; while (cond) { __builtin_amdgcn_s_sleep(1); \
    if ((++_sp & 255u) == 0u) { if (xb_ld(&(bar)[XB_TMO])) break; if (_sp > XB_SPIN_CAP) { atomicAdd(&(bar)[XB_TMO], 1u); break; } } } } while (0)
struct XcdBarrier { unsigned* bar; unsigned x; volatile LAS unsigned* st; };
__device__ __forceinline__ XcdBarrier xcd_barrier_post(unsigned* bar, volatile LAS unsigned* st) {
    XcdBarrier b; b.bar = bar; b.x = xb_xcc_id(); b.st = st;
    if (threadIdx.x == 0) (void)xb_add(&bar[XB_XCNT(b.x)], 1u);
    return b;
}
__device__ __forceinline__ void xcd_barrier_complete(unsigned* bar, unsigned x, unsigned& nloc, unsigned& nx, const unsigned G) {
    unsigned sum, cnt, mine, sp = 0u;
    for (;;) {
        sum = 0u; cnt = 0u; mine = 0u;
#pragma unroll
        for (unsigned j = 0; j < 16; ++j) { const unsigned c = xb_ld(&bar[XB_XCNT(j)]); sum += c; cnt += (c > 0u) ? 1u : 0u; mine = (j == x) ? c : mine; }
        if (sum == G) break;
        __builtin_amdgcn_s_sleep(1);
        if ((++sp & 255u) == 0u) { if (xb_ld(&bar[XB_TMO])) break; if (sp > XB_SPIN_CAP) { atomicAdd(&bar[XB_TMO], 1u); break; } }
    }
    nloc = mine > 0u ? mine : 1u; nx = cnt > 0u ? cnt : 1u;
}
__device__ __attribute__((noinline)) void xcd_barrier(unsigned* bar_, unsigned x_, volatile LAS unsigned* st_, int tid_, unsigned G_) {
    XcdBarrier b; b.bar = bar_; b.x = x_; b.st = st_;
    asm volatile("s_waitcnt vmcnt(0)" ::: "memory");
    __syncthreads();
    if (tid_ == 0) {
        unsigned* bar = b.bar;
        __builtin_amdgcn_s_waitcnt(0);
        unsigned nloc = b.st[0], nx = b.st[1];
        if (nloc == 0u) { xcd_barrier_complete(bar, b.x, nloc, nx, G_); b.st[0] = nloc; b.st[1] = nx; }
        const unsigned old = xb_add(&bar[XB_XSUB(b.x)], 1u);
        const unsigned gen = old / nloc;
        if (old + 1u == (gen + 1u) * nloc) {
            __builtin_amdgcn_fence(__ATOMIC_RELEASE, "agent");
            asm volatile("s_waitcnt vmcnt(0)" ::: "memory");
            const unsigned og = xb_add(&bar[XB_TOP], 1u);
            const unsigned tg = og / nx;
            if (og + 1u == (tg + 1u) * nx) xb_add(&bar[XB_TOPGEN], 1u);
            else XB_SPIN(xb_ld(&bar[XB_TOPGEN]) == tg, bar);
            __builtin_amdgcn_fence(__ATOMIC_ACQUIRE, "agent");
            xb_add(&bar[XB_XGEN(b.x)], 1u);
            asm volatile("s_waitcnt vmcnt(0)" ::: "memory");
        } else {
            XB_SPIN(xb_ld(&bar[XB_XGEN(b.x)]) == gen, bar);
            __builtin_amdgcn_fence(__ATOMIC_ACQUIRE, "agent");
            asm volatile("s_waitcnt vmcnt(0)" ::: "memory");
        }
    }
    __syncthreads();
}

#ifndef PROF_ON
#define PROF_ON 0
#endif
#if PROF_ON
#define PROF_SLOTS(F) WSP(unsigned, WS_CTL + 524288)
__device__ __forceinline__ unsigned prof_now() { unsigned long long t; asm volatile("s_memrealtime %0\n\ts_waitcnt lgkmcnt(0)" : "=s"(t) :: "memory"); return (unsigned)t; }
#define PROF_MARK(F, k) do { const unsigned now_ = prof_now(); if ((F).bid == PROF_BID && (F).tid == 0) PROF_SLOTS(F)[k] = now_; asm volatile("" ::: "memory"); } while (0)
#if PROF_IN & 1
#define PROF_MARKI(F, k) PROF_MARK(F, k)
#else
#define PROF_MARKI(F, k) do { } while (0)
#endif
#if PROF_IN & 2
#define PROF_MARKG(F, k) do { if ((PROF_GMASK >> (k)) & 1) PROF_MARK(F, k); } while (0)
#else
#define PROF_MARKG(F, k) do { } while (0)
#endif
#define PROF_SPIN(F) do { if ((F).bid == PROF_BID && (F).tid == 0) { unsigned qa_ = (PROF_SLOTS(F)[PROF_A1] - PROF_SLOTS(F)[PROF_A0] + 50u) / 100u, qb_ = (PROF_SLOTS(F)[PROF_B1] - PROF_SLOTS(F)[PROF_B0] + 50u) / 100u; \
    qa_ = qa_ > 127u ? 127u : qa_; qb_ = qb_ > 127u ? 127u : qb_; const unsigned d_ = (qa_ + 128u * qb_) * 1600u; const unsigned t0_ = (unsigned)__builtin_amdgcn_s_memrealtime(); \
    while ((unsigned)__builtin_amdgcn_s_memrealtime() - t0_ < d_) __builtin_amdgcn_s_sleep(8); } } while (0)
#else
#define PROF_MARK(F, k) do { } while (0)
#define PROF_MARKI(F, k) do { } while (0)
#define PROF_MARKG(F, k) do { } while (0)
#define PROF_SPIN(F) do { } while (0)
#endif
namespace pg8 {
constexpr int BM = 256, BK = 64, HALF = 128, HTB = HALF * BK * 2, STAGE_BYTES = 8 * HTB, NXCD = 8, WGM = 8;
__host__ __device__ __forceinline__ int lds_byte(int r, int c) { const int st = (r >> 4) * 2 + (c >> 5), rr = r & 15, cc = c & 31, ob = rr * 64 + cc * 2; return st * 1024 + (ob ^ (((ob >> 9) & 1) << 5)); }
__host__ __device__ __forceinline__ void stage_rc(int b, int& R, int& C) { const int st = b / 1024, sb = b % 1024, swz = sb ^ (((sb >> 9) & 1) << 5); R = (st >> 1) * 16 + swz / 64; C = (st & 1) * 32 + (swz % 64) / 2; }
__host__ __device__ __forceinline__ int perm32(int rho) { const int n = rho >> 4, i = rho & 15; return 8 * (i >> 2) + 4 * n + (i & 3); }

struct Unit { int pm, pn, ex; };
struct Gemm { const bf16_t* A; const bf16_t* Bt; int M, N, K; };

struct StaticOrder {
    int nM, nN, nwg, G, c;
    __device__ void init(int M, int N, int G_, int c_) { nM = M / BM; nN = N / BM; nwg = nM * nN; G = G_; c = c_; }
    __device__ bool next(int i, Unit& u) const {
        const long L = (long)i * G + c; if (L >= nwg) return false;
        int wgid = (int)L; { const int q = nwg / NXCD, r = nwg % NXCD, xcd = wgid % NXCD, off = wgid / NXCD; wgid = (xcd < r ? xcd * (q + 1) : r * (q + 1) + (xcd - r) * q) + off; }
        const int nig = WGM * nN, gid = wgid / nig, fm = gid * WGM, gsz = (nM - fm) < WGM ? (nM - fm) : WGM;
        u.pm = fm + ((wgid % nig) % gsz); u.pn = (wgid % nig) / gsz; u.ex = 0; return true;
    }
    __device__ __forceinline__ void ptrs(const Gemm& g, const Unit& u, const char*& a, const char*& b) const {
        const size_t tstep = (size_t)BM * g.K * 2; a = (const char*)g.A + (size_t)u.pm * tstep; b = (const char*)g.Bt + (size_t)u.pn * tstep; }
};
struct MoeOrder {
    int G, c, npn, ntiles; const LAS unsigned char* tab; size_t estride;
    __device__ bool next(int i, Unit& u) const {
        const long L = (long)i * G + c; if (L >= (long)ntiles * npn) return false;
        u.pm = (int)(L / npn); u.pn = (int)(L % npn); u.ex = (int)tab[u.pm]; return true;
    }
    __device__ __forceinline__ void ptrs(const Gemm& g, const Unit& u, const char*& a, const char*& b) const {
        const size_t tstep = (size_t)BM * g.K * 2; a = (const char*)g.A + (size_t)u.pm * tstep; b = (const char*)g.Bt + (size_t)u.ex * estride + (size_t)u.pn * tstep; }
};

template <class Epi, class Sched>
__device__ __forceinline__ void gemm_phase(LAS unsigned char* lds, const int tid, const Gemm g, const Sched& S, const Epi& E) {
    const int wid = __builtin_amdgcn_readfirstlane(tid >> 6), lane = tid & 63, wr = wid >> 2, wc = wid & 3, fr = lane & 15, fq = lane >> 4;
    int K = g.K; asm volatile("" : "+s"(K));
    const int nt = K / BK;
    unsigned voffA[2], voffB[2];
#pragma unroll
    for (int i = 0; i < 2; ++i) { int R, C; stage_rc(tid * 16 + i * 8192, R, C); const int Rb = Epi::PERM ? ((R & ~31) + perm32(R & 31)) : R;
        voffA[i] = (unsigned)(R * K + C) * 2u; voffB[i] = (unsigned)(Rb * K + C) * 2u; }
    const size_t kstep = (size_t)(BK * 2);
    const size_t hstep = (size_t)HALF * K * 2;
    const unsigned ldsw = (unsigned)wid * 1024u;
    const int aoff = lds_byte(wr * 64 + fr, fq * 8), boff = lds_byte(wc * 32 + fr, fq * 8);
#define PG8_SA(b, h) (((b) * 2 + (h)) * HTB)
#define PG8_SB(b, h) ((4 + (b) * 2 + (h)) * HTB)
#define PG8_STAGE(bufoff, gbase, voff) do { _Pragma("unroll") for (int _i = 0; _i < 2; ++_i) \
        __builtin_amdgcn_global_load_lds((const unsigned*)((const char*)(gbase) + (voff)[_i]), (LAS unsigned*)(lds + (bufoff) + ldsw + _i * 8192), 16, 0, 0); } while (0)
#define PG8_LDA(dst, b, h) do { _Pragma("unroll") for (int m = 0; m < 4; ++m) _Pragma("unroll") for (int k = 0; k < 2; ++k) dst[m][k] = *(const LAS bf16x8*)(lds + PG8_SA(b, h) + aoff + m * 2048 + k * 1024); } while (0)
#define PG8_LDB(dst, b, h) do { _Pragma("unroll") for (int n = 0; n < 2; ++n) _Pragma("unroll") for (int k = 0; k < 2; ++k) dst[n][k] = *(const LAS bf16x8*)(lds + PG8_SB(b, h) + boff + n * 2048 + k * 1024); } while (0)
#define PG8_MMA(ai, bj, At, Bt) do { __builtin_amdgcn_s_setprio(1); _Pragma("unroll") for (int m = 0; m < 4; ++m) _Pragma("unroll") for (int n = 0; n < 2; ++n) _Pragma("unroll") for (int k = 0; k < 2; ++k) \
        acc[ai][bj][m][n] = __builtin_amdgcn_mfma_f32_16x16x32_bf16(Bt[n][k], At[m][k], acc[ai][bj][m][n], 0, 0, 0); __builtin_amdgcn_s_setprio(0); } while (0)
#define PG8_WAIT_V(n) asm volatile("s_waitcnt vmcnt(" #n ")" ::: "memory")
#define PG8_WAIT_L(n) asm volatile("s_waitcnt lgkmcnt(" #n ")" ::: "memory")
#define PG8_BAR __builtin_amdgcn_s_barrier()
#define PG8_SCHED __builtin_amdgcn_sched_barrier(0)
    Unit cur, nxt; int ui = 0;
    if (!S.next(0, cur)) return;
    f32x4 acc[2][2][4][2];
#pragma unroll
    for (int a = 0; a < 2; ++a)
#pragma unroll
        for (int b = 0; b < 2; ++b)
#pragma unroll
            for (int m = 0; m < 4; ++m)
#pragma unroll
                for (int n = 0; n < 2; ++n) acc[a][b][m][n] = (f32x4){0.f, 0.f, 0.f, 0.f};
    bf16x8 At[4][2], B0[2][2], B1[2][2];
    const char* cA; const char* cB; S.ptrs(g, cur, cA, cB);
    PG8_STAGE(PG8_SB(0, 0), cB, voffB); PG8_STAGE(PG8_SA(0, 0), cA, voffA); PG8_STAGE(PG8_SB(0, 1), cB + hstep, voffB); PG8_STAGE(PG8_SA(0, 1), cA + hstep, voffA);
    if (wr == 1) PG8_BAR;
    PG8_WAIT_V(4); PG8_BAR;
    PG8_STAGE(PG8_SB(1, 0), cB + kstep, voffB); PG8_STAGE(PG8_SA(1, 0), cA + kstep, voffA); PG8_STAGE(PG8_SB(1, 1), cB + hstep + kstep, voffB);
    PG8_WAIT_V(6); PG8_BAR;
    for (;;) {
        const bool has_next = S.next(ui + 1, nxt);
        const char* nA = cA; const char* nB = cB; if (has_next) S.ptrs(g, nxt, nA, nB);
        for (int t = 0; t < nt; t += 2) {
            const bool last = (t == nt - 2);
            const char* a1 = cA + (size_t)(t + 1) * kstep;
            const char* a2 = last ? nA : cA + (size_t)(t + 2) * kstep; const char* b2 = last ? nB : cB + (size_t)(t + 2) * kstep;
            const char* a3 = a2 + kstep; const char* b3 = b2 + kstep;
            PG8_LDB(B0, 0, 0); PG8_SCHED; PG8_LDA(At, 0, 0); PG8_STAGE(PG8_SA(1, 1), a1 + hstep, voffA);
            PG8_WAIT_L(8); PG8_BAR; PG8_WAIT_L(0); PG8_MMA(0, 0, At, B0); PG8_BAR; PG8_SCHED;
            PG8_LDB(B1, 0, 1); PG8_STAGE(PG8_SB(0, 0), b2, voffB);
            PG8_BAR; PG8_WAIT_L(0); PG8_MMA(0, 1, At, B1); PG8_BAR;
            PG8_LDA(At, 0, 1); PG8_STAGE(PG8_SA(0, 0), a2, voffA);
            PG8_BAR; PG8_WAIT_L(0); PG8_MMA(1, 0, At, B0); PG8_BAR; PG8_SCHED;
            PG8_STAGE(PG8_SB(0, 1), b2 + hstep, voffB);
            PG8_WAIT_V(6); PG8_BAR; PG8_MMA(1, 1, At, B1); PG8_BAR;
            PG8_LDB(B0, 1, 0); PG8_SCHED; PG8_LDA(At, 1, 0); PG8_STAGE(PG8_SA(0, 1), a2 + hstep, voffA);
            PG8_WAIT_L(8); PG8_BAR; PG8_WAIT_L(0); PG8_MMA(0, 0, At, B0); PG8_BAR; PG8_SCHED;
            PG8_LDB(B1, 1, 1); PG8_STAGE(PG8_SB(1, 0), b3, voffB);
            PG8_BAR; PG8_WAIT_L(0); PG8_MMA(0, 1, At, B1); PG8_BAR;
            PG8_LDA(At, 1, 1); PG8_STAGE(PG8_SA(1, 0), a3, voffA);
            PG8_BAR; PG8_WAIT_L(0); PG8_MMA(1, 0, At, B0); PG8_BAR; PG8_SCHED;
            PG8_STAGE(PG8_SB(1, 1), b3 + hstep, voffB);
            PG8_WAIT_V(6); PG8_BAR; PG8_MMA(1, 1, At, B1); PG8_BAR;
        }
        E(acc, cur, wr, wc, fr, fq);
        if (!has_next) break;
#pragma unroll
        for (int a = 0; a < 2; ++a)
#pragma unroll
            for (int b = 0; b < 2; ++b)
#pragma unroll
                for (int m = 0; m < 4; ++m)
#pragma unroll
                    for (int n = 0; n < 2; ++n) acc[a][b][m][n] = (f32x4){0.f, 0.f, 0.f, 0.f};
        cur = nxt; cA = nA; cB = nB; ++ui;
    }
    PG8_WAIT_V(0);
    if (wr == 0) PG8_BAR;
    PG8_BAR;
#undef PG8_SA
#undef PG8_SB
#undef PG8_STAGE
#undef PG8_LDA
#undef PG8_LDB
#undef PG8_MMA
#undef PG8_WAIT_V
#undef PG8_WAIT_L
#undef PG8_BAR
#undef PG8_SCHED
}

#define EPI_PERM_LOOP(...) \
    _Pragma("unroll") for (int ai = 0; ai < 2; ++ai) _Pragma("unroll") for (int m = 0; m < 4; ++m) { const int row = u.pm * BM + ai * HALF + wr * 64 + m * 16 + fr; \
        _Pragma("unroll") for (int bj = 0; bj < 2; ++bj) { const int col0 = u.pn * BM + bj * HALF + wc * 32 + 8 * fq; f32x4 v0 = acc[ai][bj][m][0], v1 = acc[ai][bj][m][1]; __VA_ARGS__ } if (EPI_PIN) __builtin_amdgcn_sched_barrier(0); }

struct EpiInProj {
    static constexpr bool PERM = true, EPI_PIN = true;
    bf16_t* P; bf16_t* halo;
    __device__ __forceinline__ void operator()(const f32x4 (&acc)[2][2][4][2], const Unit& u, int wr, int wc, int fr, int fq) const {
        const bool is_qkv = u.pn >= 8 && u.pn < 14;
        EPI_PERM_LOOP({
            u32x4 w; w.x = pk2(v0[0], v0[1]); w.y = pk2(v0[2], v0[3]); w.z = pk2(v1[0], v1[1]); w.w = pk2(v1[2], v1[3]);
            *(u32x4*)(P + (size_t)row * LDP + col0) = w;
            if (is_qkv && (row & 63) >= 61) *(u32x4*)(halo + ((size_t)(row >> 6) * 3 + ((row & 63) - 61)) * 1536 + (col0 - PC_BQKV)) = w;
        })
    }
};
__device__ __forceinline__ float lfg(float lb, float oml, float x) { return __logf(lb + oml * __builtin_amdgcn_rcpf(1.0f + __expf(-x)) + 1e-30f); }
struct EpiSigmoid {
    static constexpr bool PERM = true, EPI_PIN = true;
    bf16_t* O; int ldc;
    __device__ __forceinline__ void operator()(const f32x4 (&acc)[2][2][4][2], const Unit& u, int wr, int wc, int fr, int fq) const {
        EPI_PERM_LOOP({
            u32x4 w; w.x = pk2(sigmoidf_(v0[0]), sigmoidf_(v0[1])); w.y = pk2(sigmoidf_(v0[2]), sigmoidf_(v0[3])); w.z = pk2(sigmoidf_(v1[0]), sigmoidf_(v1[1])); w.w = pk2(sigmoidf_(v1[2]), sigmoidf_(v1[3]));
            *(u32x4*)(O + (size_t)row * ldc + col0) = w;
        })
    }
};
struct EpiBranch {
    static constexpr bool PERM = true, EPI_PIN = false;
    bf16_t* merged; const bf16_t* gt; int n;
    __device__ __forceinline__ void operator()(const f32x4 (&acc)[2][2][4][2], const Unit& u, int wr, int wc, int fr, int fq) const {
        EPI_PERM_LOOP({
            const u32x4 gw = *(const u32x4*)(gt + (size_t)row * 3072 + n * 1024 + col0);
            float x[8] = {v0[0] * bflo(gw.x), v0[1] * bfhi(gw.x), v0[2] * bflo(gw.y), v0[3] * bfhi(gw.y), v1[0] * bflo(gw.z), v1[1] * bfhi(gw.z), v1[2] * bflo(gw.w), v1[3] * bfhi(gw.w)};
            bf16_t* mp = merged + (size_t)row * 1024 + col0;
            if (n != 0) { const u32x4 o = *(const u32x4*)mp; x[0] += bflo(o.x); x[1] += bfhi(o.x); x[2] += bflo(o.y); x[3] += bfhi(o.y); x[4] += bflo(o.z); x[5] += bfhi(o.z); x[6] += bflo(o.w); x[7] += bfhi(o.w); }
            u32x4 w; w.x = pk2(x[0], x[1]); w.y = pk2(x[2], x[3]); w.z = pk2(x[4], x[5]); w.w = pk2(x[6], x[7]);
            *(u32x4*)mp = w;
        })
    }
};
struct EpiResidual {
    static constexpr bool PERM = false;
    float* hreal; float* hmeta;
    __device__ __forceinline__ void operator()(const f32x4 (&acc)[2][2][4][2], const Unit& u, int wr, int wc, int fr, int fq) const {
#pragma unroll
        for (int ai = 0; ai < 2; ++ai)
#pragma unroll
            for (int m = 0; m < 4; ++m) { const int row = u.pm * BM + ai * HALF + wr * 64 + m * 16 + fr;
                float* rowp = (row < NREAL ? hreal + (size_t)row * D : hmeta + (size_t)(row - NREAL) * D) + u.pn * BM + wc * 32 + 4 * fq;
#pragma unroll
                for (int bj = 0; bj < 2; ++bj)
#pragma unroll
                    for (int n = 0; n < 2; ++n) { f32x4* p = (f32x4*)(rowp + bj * HALF + n * 16); *p = *p + acc[ai][bj][m][n]; } }
    }
};
struct EpiMoeUp {
    static constexpr bool PERM = true, EPI_PIN = true;
    bf16_t* H;
    __device__ __forceinline__ void operator()(const f32x4 (&acc)[2][2][4][2], const Unit& u, int wr, int wc, int fr, int fq) const {
        EPI_PERM_LOOP({
            const int hc = col0 >> 1;
            u32x2 w; w.x = pk2(siluf_(v0[0]) * v1[0], siluf_(v0[1]) * v1[1]); w.y = pk2(siluf_(v0[2]) * v1[2], siluf_(v0[3]) * v1[3]);
            *(u32x2*)(H + (size_t)row * 256 + hc) = w;
        })
    }
};
struct EpiMoeDown {
    static constexpr bool PERM = true, EPI_PIN = false;
    bf16_t* Y; const float* wrow;
    __device__ __forceinline__ void operator()(const f32x4 (&acc)[2][2][4][2], const Unit& u, int wr, int wc, int fr, int fq) const {
        EPI_PERM_LOOP({
            const float s = wrow[row];
            u32x4 w; w.x = pk2(v0[0] * s, v0[1] * s); w.y = pk2(v0[2] * s, v0[3] * s); w.z = pk2(v1[0] * s, v1[1] * s); w.w = pk2(v1[2] * s, v1[3] * s);
            *(u32x4*)(Y + (size_t)row * 1024 + col0) = w;
        })
    }
};
}
#define GAS __attribute__((address_space(1)))
struct Params { const float* in[24]; float* out; unsigned char* ws; int ph_lo, ph_hi; };
struct Frame {
    LAS unsigned char* lds; int tid, lane, wave, G, bid;
    __attribute__((address_space(1))) float* out; __attribute__((address_space(1))) unsigned char* ws; const float* const __attribute__((address_space(4)))* inp; int dry;
};
#define PHASE_FENCE(F) do { asm volatile("" : "+s"((F).ws), "+s"((F).out), "+s"((F).inp), "+v"((F).tid), "+s"((F).bid), "+s"((F).G)); \
    (F).lane = (F).tid & 63; (F).wave = __builtin_amdgcn_readfirstlane((F).tid >> 6); } while (0)
__device__ __forceinline__ const float* inp_ptr(const float* const __attribute__((address_space(4)))* inp, int i) { GAS const float* q = (GAS const float*)inp[i]; asm volatile("" : "+s"(q)); return (const float*)q; }
#define INP(i) inp_ptr(F.inp, (i))
#define WSP(T, off) ((T*)(GAS T*)(F.ws + (off)))
enum { I_X = 0, I_META, I_NORM_MIX, I_W_IN, I_LB, I_HGRN_NORM, I_GDN_CONV, I_GDN_ALOG, I_GDN_DT, I_GDN_NORM, I_GLA_W2, I_GLA_B, I_GLA_NORM, I_W_BRANCH, I_W_OUT, I_NORM_FFN,
       I_RG_W, I_RG_B, I_RE_W, I_RE_B, I_EW_GATE, I_EW_UP, I_EW_DOWN, I_NORM_FINAL };

struct TItem { const float* W; bf16_t* WT; int ldw, K, nblk, rowmode, item; };
__device__ __forceinline__ void titem_load(const TItem& t, int lane, f32x4 (&v)[8]) {
    const int kb = t.item / t.nblk, nb = t.item % t.nblk, k0 = 64 * kb, n0 = 32 * nb, n4 = 4 * (lane & 7);
#pragma unroll
    for (int i = 0; i < 8; ++i) v[i] = *(const f32x4*)(t.W + (size_t)(k0 + 8 * i + (lane >> 3)) * t.ldw + n0 + n4);
}
__device__ __forceinline__ void titem_finish(const TItem& t, int lane, const f32x4 (&v)[8], LAS float* scr) {
    const int kb = t.item / t.nblk, nb = t.item % t.nblk, k0 = 64 * kb, n0 = 32 * nb, n4 = 4 * (lane & 7);
#pragma unroll
    for (int i = 0; i < 8; ++i) { LAS float* d = scr + (8 * i + (lane >> 3)) * 33 + n4; d[0] = v[i][0]; d[1] = v[i][1]; d[2] = v[i][2]; d[3] = v[i][3]; }
    LDS_WAIT(); asm volatile("" ::: "memory");
    const int c = lane & 7;
#pragma unroll
    for (int j = 0; j < 4; ++j) { const int n = (lane >> 3) + 8 * j; const LAS float* s = scr + (8 * c) * 33 + n;
        u32x4 o; o.x = pk2(s[0 * 33], s[1 * 33]); o.y = pk2(s[2 * 33], s[3 * 33]); o.z = pk2(s[4 * 33], s[5 * 33]); o.w = pk2(s[6 * 33], s[7 * 33]);
        const int nn = n0 + n; const int wrow = t.rowmode == 0 ? nn : 8 * (nn >> 2) + (nn & 3) + (t.rowmode == 2 ? 4 : 0);
        *(u32x4*)(t.WT + (size_t)wrow * t.K + k0 + 8 * c) = o; }
    LDS_WAIT(); asm volatile("" ::: "memory");
}
#define CONVERT_LOOP(NITEMS, RESOLVE) do { LAS float* scr = (LAS float*)(F.lds + F.wave * 17408); const int gw = F.bid * NWAVES + F.wave, NGW = F.G * NWAVES; \
    for (int it = gw; it < (NITEMS); it += 2 * NGW) { const bool two = it + NGW < (NITEMS); TItem ta = RESOLVE(it), tb = RESOLVE(two ? it + NGW : it); f32x4 va[8], vb[8]; \
        titem_load(ta, F.lane, va); if (two) titem_load(tb, F.lane, vb); \
        titem_finish(ta, F.lane, va, scr); if (two) titem_finish(tb, F.lane, vb, scr + 64 * 33 + 32); } } while (0)

__device__ __forceinline__ void phase_pre(Frame& F) {
    const int gt = F.bid * NTHREADS + F.tid, NT = F.G * NTHREADS;
    float* sw1 = WSP(float, SM_SW1); float* rwg = WSP(float, SM_RWG); float* rwe = WSP(float, SM_RWE); float* lab = WSP(float, SM_LAB);
    for (int i = gt; i < 2 * 24 * 1024; i += NT) { const int l = i / (24 * 1024), c = (i / 1024) % 24, k = i % 1024;
        const int col = c < 16 ? 5128 + c : (c < 20 ? 3584 + (c - 16) : 3588 + (c - 20));
        sw1[i] = INP(I_W_IN)[((size_t)l * 1024 + k) * IN_COLS + col]; }
    for (int i = gt; i < 2 * 4 * 1024; i += NT) { const int l = i / (4 * 1024), c = (i / 1024) % 4, k = i % 1024; rwg[i] = INP(I_RG_W)[((size_t)l * 1024 + k) * 4 + c]; }
    for (int i = gt; i < 2 * 32 * 1024; i += NT) { const int l = i / (32 * 1024), c = (i / 1024) % 32, k = i % 1024; rwe[i] = INP(I_RE_W)[((size_t)l * 1024 + k) * 32 + c]; }
    for (int i = gt; i < 2 * 512; i += NT) { const int l = i / 512, c = i % 512; const float l0 = INP(I_LB)[c], l1 = INP(I_LB)[512 + c];
        const float p1 = 1.0f / (1.0f + expf(l0 - l1)); const float lb = l == 0 ? 0.f : p1;
        lab[l * 1024 + c] = lb; lab[l * 1024 + 512 + c] = 1.0f - lb; }
}

__device__ __forceinline__ void convert_layer_weights(Frame& F, int l) {
    const float* win = INP(I_W_IN) + (size_t)l * 1024 * IN_COLS;
    constexpr int I_MIX = 16 * 176, I_GATE = 16 * 96, I_BR = 8 * 32, I_OUT = 16 * 32, NITEMS = I_MIX + I_GATE + 3 * I_BR + I_OUT;
    auto resolve = [&](int it) { int r = it; TItem t;
        if (r < I_MIX) { const int nb = r % 176, n0 = 32 * nb; const int shift = n0 < 3584 ? 0 : (n0 < 5120 ? 8 : 24);
            t = TItem{win + shift, WSP(bf16_t, WS_WMIX), IN_COLS, 1024, 176, 0, r}; return t; } r -= I_MIX;
        if (r < I_GATE) { t = TItem{win + 5656, WSP(bf16_t, WS_WGATE), IN_COLS, 1024, 96, 0, r}; return t; } r -= I_GATE;
        if (r < 3 * I_BR) { const int n = r / I_BR; t = TItem{INP(I_W_BRANCH) + ((size_t)l * 3 + n) * 512 * 1024, WSP(bf16_t, WS_WBT) + (size_t)n * 1024 * 512, 1024, 512, 32, 0, r % I_BR}; return t; } r -= 3 * I_BR;
        t = TItem{INP(I_W_OUT) + (size_t)l * 1024 * 1024, WSP(bf16_t, WS_WOT), 1024, 1024, 32, 0, r}; return t; };
    CONVERT_LOOP(NITEMS, resolve);
}
__device__ __forceinline__ void convert_expert_weights(Frame& F, int l) {
    constexpr int I_G = 16 * 8, I_D = 4 * 32, PER = 2 * I_G + I_D;
    auto resolve = [&](int it) { const int e = it / PER; int r = it % PER; TItem t;
        bf16_t* w1t = WSP(bf16_t, WS_W1T) + (size_t)e * 512 * 1024; bf16_t* w2t = WSP(bf16_t, WS_W2T) + (size_t)e * 1024 * 256;
        if (r < I_G) { t = TItem{INP(I_EW_GATE) + ((size_t)l * 32 + e) * 1024 * 256, w1t, 256, 1024, 8, 1, r}; return t; } r -= I_G;
        if (r < I_G) { t = TItem{INP(I_EW_UP) + ((size_t)l * 32 + e) * 1024 * 256, w1t, 256, 1024, 8, 2, r}; return t; } r -= I_G;
        t = TItem{INP(I_EW_DOWN) + ((size_t)l * 32 + e) * 256 * 1024, w2t, 1024, 256, 32, 0, r}; return t; };
    CONVERT_LOOP(32 * PER, resolve);
}

#define OUTP ((float*)F.out)
__device__ __forceinline__ float* hrow(Frame& F, int r) { return r < NREAL ? OUTP + (size_t)r * D : WSP(float, WS_HMETA) + (size_t)(r - NREAL) * D; }

__device__ __forceinline__ void load_row16(const float* p, int lane, float (&x)[16]) {
#pragma unroll
    for (int j = 0; j < 4; ++j) { const f32x4 v = *((const f32x4*)p + lane + 64 * j); x[4 * j] = v[0]; x[4 * j + 1] = v[1]; x[4 * j + 2] = v[2]; x[4 * j + 3] = v[3]; }
}
__device__ __forceinline__ void add_bf16_row16(const bf16_t* p, int lane, float (&x)[16]) {
#pragma unroll
    for (int j = 0; j < 4; ++j) { const u32x2 w = *((const u32x2*)p + lane + 64 * j); x[4 * j] += bflo(w.x); x[4 * j + 1] += bfhi(w.x); x[4 * j + 2] += bflo(w.y); x[4 * j + 3] += bfhi(w.y); }
}
__device__ __forceinline__ void store_row16(float* p, int lane, const float (&x)[16]) {
#pragma unroll
    for (int j = 0; j < 4; ++j) *((f32x4*)p + lane + 64 * j) = (f32x4){x[4 * j], x[4 * j + 1], x[4 * j + 2], x[4 * j + 3]};
}
__device__ __forceinline__ void store_bf16_row16(bf16_t* p, int lane, const float (&x)[16]) {
#pragma unroll
    for (int j = 0; j < 4; ++j) { u32x2 w; w.x = pk2(x[4 * j], x[4 * j + 1]); w.y = pk2(x[4 * j + 2], x[4 * j + 3]); *((u32x2*)p + lane + 64 * j) = w; }
}
__device__ __forceinline__ void fetch_h_row(Frame& F, int l, int r, float (&x)[16]) {
    if (l == 0) {
        const float* src = r < NREAL ? INP(I_X) + (size_t)r * D : INP(I_META) + (size_t)(r - META_ROW0) * D;
        load_row16(src, F.lane, x);
    } else {
        load_row16(hrow(F, r), F.lane, x);
        const unsigned* tok = WSP(unsigned, SM_TOK) + (size_t)r * 8;
        const unsigned g0 = tok[6], g1 = tok[7];
        add_bf16_row16(WSP(bf16_t, WS_Y2) + (size_t)g0 * 1024, F.lane, x);
        add_bf16_row16(WSP(bf16_t, WS_Y2) + (size_t)g1 * 1024, F.lane, x);
    }
}

template <int N> struct IntC { static constexpr int value = N; };
__device__ __forceinline__ void phase_norm1(Frame& F, int l) {
    PROF_MARK(F, 40);
    convert_layer_weights(F, l);
    __syncthreads();
    PROF_MARK(F, 41);
    LAS float* sw = (LAS float*)F.lds;
    { const float* src = WSP(float, SM_SW1) + (size_t)l * 24 * 1024; for (int i = F.tid; i < 24 * 1024 / 4; i += NTHREADS) ((LAS f32x4*)sw)[i] = ((const f32x4*)src)[i]; }
    __syncthreads();
    const int gw = F.bid * NWAVES + F.wave, NGW = F.G * NWAVES, lane = F.lane;
    const float* nw = INP(I_NORM_MIX) + (size_t)l * D;
    float wv[16]; load_row16(nw, lane, wv);
    bf16_t* U = WSP(bf16_t, WS_U);
    const float alog_l = (lane >= 20 && lane < 24) ? INP(I_GDN_ALOG)[l * 4 + (lane - 20)] : 0.f, dt_l = (lane >= 20 && lane < 24) ? INP(I_GDN_DT)[l * 4 + (lane - 20)] : 0.f;
    const float nega_l = -expf(alog_l);
    float* GK = WSP(float, SM_GK); float* BETA = WSP(float, SM_BETA); float* LOGA = WSP(float, SM_LOGA);
    auto body = [&](auto NRc, const int r0) {
        constexpr int NR = decltype(NRc)::value;
        float x[NR][16];
#pragma unroll
        for (int i = 0; i < NR; ++i) {
            fetch_h_row(F, l, r0 + i, x[i]);
            store_row16(hrow(F, r0 + i), lane, x[i]);
            float ss = 0.f;
#pragma unroll
            for (int j = 0; j < 16; ++j) ss += x[i][j] * x[i][j];
            const float rstd = rsqrtf(wave_sum(ss) * (1.0f / D) + 1e-6f);
#pragma unroll
            for (int j = 0; j < 16; ++j) x[i][j] = x[i][j] * rstd * wv[j];
            store_bf16_row16(U + (size_t)(r0 + i) * D, lane, x[i]);
        }
        float ov[NR];
#pragma unroll
        for (int i = 0; i < NR; ++i) ov[i] = 0.f;
#pragma unroll 2
        for (int c = 0; c < 24; ++c) {
            float a[NR];
#pragma unroll
            for (int i = 0; i < NR; ++i) a[i] = 0.f;
#pragma unroll
            for (int j = 0; j < 4; ++j) { const f32x4 w = *((const LAS f32x4*)(sw + c * 1024) + lane + 64 * j);
#pragma unroll
                for (int e = 0; e < 4; ++e) {
#pragma unroll
                    for (int i = 0; i < NR; ++i) a[i] += x[i][4 * j + e] * w[e]; } }
#pragma unroll
            for (int i = 0; i < NR; ++i) { a[i] = wave_sum(a[i]); if (lane == c) ov[i] = a[i]; }
        }
#pragma unroll
        for (int i = 0; i < NR; ++i) {
            const float v = ov[i]; const int r = r0 + i;
            if (lane < 16) GK[(size_t)r * 16 + lane] = v;
            else if (lane < 20) BETA[(size_t)r * 4 + (lane - 16)] = sigmoidf_(v);
            else if (lane < 24) { const int h = lane - 20; LOGA[(size_t)r * 4 + h] = nega_l * softplusf_(v + dt_l); }
        }
    };
    for (int g = gw; g < NREAL / 4; g += NGW) body(IntC<4>{}, 4 * g);
    if (gw >= NGW - 16) body(IntC<1>{}, META_ROW0 + (NGW - 1 - gw));
    for (int r = NREAL + gw; r < MROWS; r += NGW) {
        if (row_valid(r)) continue;
        float z[16];
#pragma unroll
        for (int j = 0; j < 16; ++j) z[j] = 0.f;
        store_bf16_row16(U + (size_t)r * D, lane, z); if (l == 0) store_row16(hrow(F, r), lane, z);
        if (lane < 16) GK[(size_t)r * 16 + lane] = 0.f;
        else if (lane < 20) BETA[(size_t)r * 4 + (lane - 16)] = 0.f;
        else if (lane < 24) LOGA[(size_t)r * 4 + (lane - 20)] = 0.f;
    }
}

__device__ __forceinline__ bf16x8 mk8(u32x4 w) { return __builtin_bit_cast(bf16x8, w); }
__device__ __forceinline__ bf16x8 mk8(u32x2 lo, u32x2 hi) { u32x4 w; w.x = lo.x; w.y = lo.y; w.z = hi.x; w.w = hi.y; return __builtin_bit_cast(bf16x8, w); }
__device__ __forceinline__ bf16x8 pack_acc2(const f32x4& a, const f32x4& b) { u32x4 w; w.x = pk2(a[0], a[1]); w.y = pk2(a[2], a[3]); w.z = pk2(b[0], b[1]); w.w = pk2(b[2], b[3]); return __builtin_bit_cast(bf16x8, w); }
#define MFMA16(a, b, c) __builtin_amdgcn_mfma_f32_16x16x32_bf16((a), (b), (c), 0, 0, 0)

__device__ __forceinline__ int permpos(int k) { const int kk = k & 31; return (k & ~31) + ((kk & 16) ? 8 * ((kk - 16) >> 2) + 4 + (kk & 3) : 8 * (kk >> 2) + (kk & 3)); }
__device__ __forceinline__ float ldbf(GAS const bf16_t* p) { return bf2f(*p); }
#define ROWB(P, row, col) ((GAS const char*)(P) + ((size_t)(row) * LDP + (col)) * 2)
__device__ __forceinline__ float ldrow(GAS const char* rb, unsigned voff) { return bf2f(*(GAS const bf16_t*)(rb + voff)); }
__device__ __forceinline__ unsigned ldrow_u(GAS const char* rb, unsigned voff) { return (unsigned)*(GAS const bf16_t*)(rb + voff); }
__device__ __forceinline__ void strow(GAS const char* rb, unsigned voff, bf16_t v) { *(GAS bf16_t*)(rb + voff) = v; }

template <int DK, bool IS_A>
__device__ __forceinline__ void prep_gla(Frame& F, int l, int ug) {
    constexpr int QP = DK + 8, VP = 136, SUB = 2 * 64 * QP * 2 + 1024 + 4096 + 64 * VP * 2;
    PROF_MARK(F, IS_A ? 7 : 8);
    int tid = F.tid; asm volatile("" : "+v"(tid));
    const int sg = __builtin_amdgcn_readfirstlane(tid >> 8), lt = tid & 255, c = lt & 127, hf = __builtin_amdgcn_readfirstlane(lt >> 7);
    const int unit = 2 * ug + sg, slot = unit >> 2, h = unit & 3, row0 = slot * 64, r0 = row0 + 32 * hf;
    const int qcol = IS_A ? PC_AQ + h * 128 : PC_CQ + h * 64, kcol = IS_A ? PC_AF + h * 128 : PC_CK + h * 64, vcol = IS_A ? PC_AI + h * 128 : PC_CV + h * 128;
    bf16_t* P = WSP(bf16_t, WS_P);
    LAS bf16_t* qt = (LAS bf16_t*)(F.lds + sg * SUB);
    LAS bf16_t* kt = qt + 64 * QP;
    LAS float* tot = (LAS float*)(kt + 64 * QP);
    const bool act = c < DK;
    LAS bf16_t* rv = (LAS bf16_t*)(tot + 256 + 1024);
    float w2c[16], bias = 0.f;
    if (!IS_A && c < DK) { const float* w2 = INP(I_GLA_W2) + (size_t)l * 16 * 256 + h * 64 + c; bias = INP(I_GLA_B)[l * 256 + h * 64 + c];
#pragma unroll
        for (int j = 0; j < 16; ++j) w2c[j] = w2[j * 256]; }
    { constexpr int PQ = DK / 8, PPR = 2 * PQ + 16;
        for (int idx = lt; idx < 64 * PPR; idx += 256) { const int row = idx / PPR, pc = idx % PPR;
            const int scol = pc < PQ ? qcol + 8 * pc : (pc < 2 * PQ ? kcol + 8 * (pc - PQ) : vcol + 8 * (pc - 2 * PQ));
            LAS bf16_t* dst = pc < PQ ? qt + row * QP + 8 * pc : (pc < 2 * PQ ? kt + row * QP + 8 * (pc - PQ) : rv + row * VP + 8 * (pc - 2 * PQ));
            *(LAS u32x4*)dst = *(const u32x4*)(P + (size_t)(row0 + row) * LDP + scol); } }
    if (!IS_A) { LAS float* gkl = tot + 256;
        ((LAS f32x4*)gkl)[lt] = ((const f32x4*)(WSP(float, SM_GK) + (size_t)row0 * 16))[lt]; }
    __syncthreads();
    PROF_MARKI(F, IS_A ? 29 : 19);
    float b[32];
    const unsigned vo = (unsigned)c * 2u, vop = (unsigned)permpos(c) * 2u;
    if (act) {
        float run = 0.f;
        if (IS_A) { const float* lab = WSP(float, SM_LAB) + l * 1024 + h * 128 + c; const float la = lab[0], lb = lab[512];
#pragma unroll
            for (int t = 0; t < 32; ++t) { run += pg8::lfg(la, lb, bf2f(kt[(32 * hf + t) * QP + c])); b[t] = run; }
        } else {
            const LAS f32x4* gk = (const LAS f32x4*)(tot + 256 + 32 * hf * 16);
#pragma unroll
            for (int tb = 0; tb < 32; tb += 4) { f32x4 g[16];
#pragma unroll
                for (int i = 0; i < 16; ++i) g[i] = gk[tb * 4 + i];
                asm volatile("" ::: "memory");
#pragma unroll
                for (int u = 0; u < 4; ++u) { float s = bias;
#pragma unroll
                    for (int j = 0; j < 16; ++j) s += g[4 * u + (j >> 2)][j & 3] * w2c[j];
                    run += logsigf_(s) * (1.0f / 16.0f); b[tb + u] = run; } }
        }
        tot[hf * 128 + c] = run;
    }
    __syncthreads();
    PROF_MARKI(F, IS_A ? 25 : 15);
    unsigned q1p[16], k1p[16];
    if (act) {
        const float bm = tot[c], bl = bm + tot[128 + c], boff = hf ? bm : 0.f;
        if (hf == 0 && !F.dry) (IS_A ? WSP(float, SM_DECA) + (size_t)unit * 128 : WSP(float, SM_DECC) + (size_t)unit * 64)[c] = __expf(bl);
#pragma unroll
        for (int t2 = 0; t2 < 16; ++t2) { float q1v[2], k1v[2];
#pragma unroll
            for (int u = 0; u < 2; ++u) { const int t = 2 * t2 + u; const float bt = b[t] + boff;
                const float qr = bf2f(qt[(32 * hf + t) * QP + c]), q = IS_A ? siluf_(qr) * 0.08838834764831845f : qr * 0.125f;
                float k;
                if (IS_A) { const float lf = t == 0 ? b[0] : b[t] - b[t - 1]; k = row_valid(r0 + t) ? 1.0f - __expf(lf) : 0.f; } else k = bf2f(kt[(32 * hf + t) * QP + c]);
                q1v[u] = q * __expf(bt); k1v[u] = k * __expf(bl - bt);
                qt[(32 * hf + t) * QP + c] = f2bf(q * __expf(fminf(bt - bm, 80.f))); kt[(32 * hf + t) * QP + c] = f2bf(k * __expf(fminf(bm - bt, 80.f))); }
            q1p[t2] = pk2(q1v[0], q1v[1]); k1p[t2] = pk2(k1v[0], k1v[1]); }
    }
    __syncthreads();
    PROF_MARKI(F, IS_A ? 26 : 16);
    if (act) {
        if (!F.dry) {
#pragma unroll
        for (int t2 = 0; t2 < 16; ++t2) { strow(ROWB(P, r0 + 2 * t2, qcol), vop, (bf16_t)(q1p[t2] & 0xffffu)); strow(ROWB(P, r0 + 2 * t2 + 1, qcol), vop, (bf16_t)(q1p[t2] >> 16)); } }
        bf16_t* kd = (IS_A ? P + (size_t)(row0 + (c >> 1)) * LDP + kcol + (c & 1) * 64 : P + (size_t)(row0 + c) * LDP + kcol) + 32 * hf;
#pragma unroll
        for (int o = 0; o < 4; ++o) if (!F.dry) *(u32x4*)(kd + 8 * o) = (u32x4){k1p[4 * o], k1p[4 * o + 1], k1p[4 * o + 2], k1p[4 * o + 3]};
    }
    { const int ws = (tid >> 6) & 3, lane = tid & 63, fr = lane & 15, fq = lane >> 4;
        bf16_t* sc = (IS_A ? WSP(bf16_t, WS_SCA) : WSP(bf16_t, WS_SCC)) + (size_t)unit * 4096;
#pragma unroll
        for (int jt = 0; jt < 4; ++jt) { const int mt = ws, nt = jt; f32x4 acc = {0.f, 0.f, 0.f, 0.f};
            if (nt <= mt) {
#pragma unroll
                for (int ks = 0; ks < DK / 32; ++ks) { const bf16x8 a = *(const LAS bf16x8*)(qt + (16 * mt + fr) * QP + 32 * ks + 8 * fq), bb = *(const LAS bf16x8*)(kt + (16 * nt + fr) * QP + 32 * ks + 8 * fq); acc = MFMA16(a, bb, acc); } }
#pragma unroll
            for (int r = 0; r < 4; ++r) { const int t = 16 * mt + 4 * fq + r, s = 16 * nt + fr; if (!F.dry) sc[t * 64 + s] = (s <= t) ? f2bf(acc[r]) : (bf16_t)0; } }
    }
    PROF_MARKI(F, IS_A ? 27 : 17);
    { unsigned vp[16];
#pragma unroll
        for (int t2 = 0; t2 < 16; ++t2) { vp[t2] = (unsigned)rv[(32 * hf + 2 * t2) * VP + c] | ((unsigned)rv[(32 * hf + 2 * t2 + 1) * VP + c] << 16); }
        PROF_MARKI(F, IS_A ? 28 : 18);
        bf16_t* vd = P + (size_t)(row0 + (c >> 1)) * LDP + vcol + (c & 1) * 64 + 32 * hf;
#pragma unroll
        for (int o = 0; o < 4; ++o) if (!F.dry) *(u32x4*)(vd + 8 * o) = (u32x4){vp[4 * o], vp[4 * o + 1], vp[4 * o + 2], vp[4 * o + 3]}; }
    __syncthreads();
    PROF_MARK(F, IS_A ? 13 : 14);
}

typedef float f32x2v __attribute__((ext_vector_type(2)));
__device__ __forceinline__ void prep_gdn(Frame& F, int l, int ug) {
    constexpr int NP = 136, SUB = 2 * 64 * NP * 2 + 64 * 68 * 4 + 1024 + 2304;
    PROF_MARK(F, 1);
    int tid = F.tid; asm volatile("" : "+v"(tid));
    const int lane = tid & 63, sg = __builtin_amdgcn_readfirstlane(tid >> 8), lt = tid & 255, unit = 2 * ug + sg, slot = unit >> 2, h = unit & 3, row0 = slot * 64;
    bf16_t* P = WSP(bf16_t, WS_P);
    LAS bf16_t* qs = (LAS bf16_t*)(F.lds + sg * SUB);
    LAS bf16_t* ks = qs + 64 * NP;
    LAS float* AT = (LAS float*)(F.lds + sg * SUB + 2 * 64 * NP * 2);
    LAS float* gs = AT + 64 * 68;
    if (lt < 64) { const int valid_u = 1; (void)valid_u; float g = WSP(float, SM_LOGA)[(size_t)(row0 + lt) * 4 + h];
#pragma unroll
        for (int o = 1; o < 64; o <<= 1) { const float t = __shfl_up(g, o); if (lane >= o) g += t; }
        gs[lt] = g; gs[64 + lt] = WSP(float, SM_BETA)[(size_t)(row0 + lt) * 4 + h];
        if (lt == 63 && !F.dry) WSP(float, SM_DECB)[unit] = __expf(g); }
    const int hslot = slot == 256 ? -1 : ((slot & 63) == 0 ? 256 : slot - 1);
    LAS bf16_t* rvs = (LAS bf16_t*)AT;
    LAS bf16_t* hl = (LAS bf16_t*)(gs + 256);
    for (int idx = lt; idx < 64 * 48; idx += 256) { const int row = idx / 48, pc = idx % 48, comp = pc >> 4, c8 = (pc & 15) * 8;
        const u32x4 v = *(const u32x4*)(P + (size_t)(row0 + row) * LDP + PC_BQKV + comp * 512 + h * 128 + c8);
        *(LAS u32x4*)((comp == 0 ? qs : (comp == 1 ? ks : rvs)) + row * NP + c8) = v; }
    if (lt < 144) { const int rr = lt / 48, pc = lt % 48, comp = pc >> 4, c8 = (pc & 15) * 8; u32x4 v = {0u, 0u, 0u, 0u};
        if (hslot >= 0) v = *(const u32x4*)(WSP(bf16_t, SM_HALO) + ((size_t)hslot * 3 + rr) * 1536 + comp * 512 + h * 128 + c8);
        *(LAS u32x4*)(hl + rr * 384 + comp * 128 + c8) = v; }
    __syncthreads();
    PROF_MARKG(F, 2);
    float col[64];
    {
        const int c = lt & 127;
#pragma unroll
        for (int pass = 0; pass < 2; ++pass) {
            if (pass == 1 && lt >= 128) break;
            const int comp = lt >= 128 ? 1 : (pass == 0 ? 0 : 2), ch = comp * 512 + h * 128 + c;
            const float w0 = INP(I_GDN_CONV)[((size_t)l * 4 + 0) * 1536 + ch], w1 = INP(I_GDN_CONV)[((size_t)l * 4 + 1) * 1536 + ch], w2 = INP(I_GDN_CONV)[((size_t)l * 4 + 2) * 1536 + ch], w3 = INP(I_GDN_CONV)[((size_t)l * 4 + 3) * 1536 + ch];
            LAS bf16_t* src = (comp == 0 ? qs : (comp == 1 ? ks : rvs)) + c;
            float x0 = bf2f(hl[comp * 128 + c]), x1 = bf2f(hl[384 + comp * 128 + c]), x2 = bf2f(hl[768 + comp * 128 + c]);
#pragma unroll
            for (int t = 0; t < 64; ++t) { const float x3 = bf2f(src[t * NP]); const float y = siluf_(w0 * x0 + w1 * x1 + w2 * x2 + w3 * x3); x0 = x1; x1 = x2; x2 = x3;
                if (comp == 0) src[t * NP] = f2bf(y); else { col[t] = y; if (comp == 1) src[t * NP] = f2bf(y); } }
        }
    }
    __syncthreads();
    PROF_MARKG(F, 3);
    const int wv = (tid >> 6) & 3, fr = lane & 15, fq = lane >> 4;
#pragma unroll
    for (int jt = 0; jt < 2; ++jt) { const int which = jt, mt = wv; const LAS bf16_t* ap = which ? qs : ks; f32x4 a4 = {0.f, 0.f, 0.f, 0.f};
#pragma unroll
        for (int k4 = 0; k4 < 4; ++k4) { const bf16x8 a = *(const LAS bf16x8*)(ap + (16 * mt + fr) * NP + 32 * k4 + 8 * fq); a4 = MFMA16(a, a, a4); }
#pragma unroll
        for (int r = 0; r < 4; ++r) if (4 * fq + r == fr) { if (which == 0) gs[128 + 16 * mt + fr] = rsqrtf(a4[r] + 1e-6f); else gs[192 + 16 * mt + fr] = rsqrtf(a4[r] + 1e-6f) * 0.08838834764831845f; } }
    __syncthreads();
    { bf16_t* qkd = WSP(bf16_t, WS_QKD) + (size_t)unit * 4096;
#pragma unroll
        for (int jt = 0; jt < 8; ++jt) { const int tile = wv * 8 + jt, which = tile >> 4, mt = (tile >> 2) & 3, nt = tile & 3;
            const LAS bf16_t* ap = which ? qs : ks; f32x4 a4 = {0.f, 0.f, 0.f, 0.f};
            if (nt <= mt) {
#pragma unroll
                for (int k4 = 0; k4 < 4; ++k4) { const bf16x8 a = *(const LAS bf16x8*)(ap + (16 * mt + fr) * NP + 32 * k4 + 8 * fq), bb = *(const LAS bf16x8*)(ks + (16 * nt + fr) * NP + 32 * k4 + 8 * fq); a4 = MFMA16(a, bb, a4); } }
#pragma unroll
            for (int r = 0; r < 4; ++r) { const int t = 16 * mt + 4 * fq + r, s = 16 * nt + fr; const float dec = __expf(fminf(gs[t] - gs[s], 0.f)) * gs[128 + s];
                if (which) { if (!F.dry) qkd[t * 64 + permpos(s)] = (s <= t) ? f2bf(a4[r] * dec * gs[192 + t]) : (bf16_t)0; }
                else AT[s * 68 + t] = (s < t) ? gs[64 + t] * gs[128 + t] * a4[r] * dec : 0.f; } }
    }
    PROF_MARKG(F, 4);
    if (lt >= 128) { const int d = lt - 128; const float gl = gs[63]; bf16_t* dst = WSP(bf16_t, WS_K1TB) + (size_t)unit * 8192 + d * 64;
#pragma unroll
        for (int o = 0; o < 8; ++o) { const int s0 = 32 * (o >> 2) + 4 * (o & 3); float y[8];
#pragma unroll
            for (int j = 0; j < 8; ++j) { const int s = s0 + (j & 3) + (j >> 2) * 16; y[j] = col[s] * gs[128 + s] * __expf(gl - gs[s]); }
            if (!F.dry) *(u32x4*)(dst + 8 * o) = (u32x4){pk2(y[0], y[1]), pk2(y[2], y[3]), pk2(y[4], y[5]), pk2(y[6], y[7])}; }
    } else { const int pp = permpos(lt);
#pragma unroll 8
        for (int t = 0; t < 64; ++t) if (!F.dry) P[(size_t)(row0 + t) * LDP + PC_BQKV + h * 128 + pp] = f2bf(bf2f(qs[t * NP + lt]) * gs[192 + t] * __expf(gs[t])); }
    __syncthreads();
    PROF_MARKG(F, 5);
#pragma unroll
    for (int i = 0; i < 64; ++i) col[i] *= lt < 128 ? gs[64 + i] : gs[64 + i] * gs[128 + i] * __expf(gs[i]);
    { f32x4 cur[16], nxt[16];
#pragma unroll
        for (int q4 = 0; q4 < 16; ++q4) cur[q4] = *(const LAS f32x4*)(AT + 4 * q4);
#pragma unroll
        for (int j = 0; j < 63; ++j) { const float xj = col[j]; const f32x2v nx = {-xj, -xj};
            if (j + 1 < 63) {
#pragma unroll
                for (int q4 = (j + 2) >> 2; q4 < 16; ++q4) nxt[q4] = *(const LAS f32x4*)(AT + (j + 1) * 68 + 4 * q4); }
            asm volatile("" ::: "memory");
#pragma unroll
            for (int q4 = (j + 1) >> 2; q4 < 16; ++q4) {
#pragma unroll
                for (int p = 0; p < 2; ++p) { const int i0 = 4 * q4 + 2 * p;
                    if (i0 > j) { f32x2v c = {col[i0], col[i0 + 1]}; const f32x2v a = {cur[q4][2 * p], cur[q4][2 * p + 1]}; c = c + a * nx; col[i0] = c.x; col[i0 + 1] = c.y; }
                    else if (i0 + 1 > j) col[i0 + 1] -= cur[q4][2 * p + 1] * xj; } }
#pragma unroll
            for (int q4 = (j + 2) >> 2; q4 < 16; ++q4) cur[q4] = nxt[q4]; } }
    PROF_MARKG(F, 6);
    int tid2 = F.tid; asm volatile("" : "+v"(tid2)); const int lt2 = tid2 & 255, unit2 = 2 * ug + __builtin_amdgcn_readfirstlane(tid2 >> 8), row02 = (unit2 >> 2) * 64, h2 = unit2 & 3;
    if (lt2 < 128) { bf16_t* dst = P + (size_t)(row02 + (lt2 >> 1)) * LDP + PC_BQKV + 1024 + h2 * 128 + (lt2 & 1) * 64;
#pragma unroll
        for (int o = 0; o < 8; ++o) if (!F.dry) *(u32x4*)(dst + 8 * o) = (u32x4){pk2(col[8 * o], col[8 * o + 1]), pk2(col[8 * o + 2], col[8 * o + 3]), pk2(col[8 * o + 4], col[8 * o + 5]), pk2(col[8 * o + 6], col[8 * o + 7])};
    } else { const int pp = permpos(lt2 - 128);
        if (!F.dry) {
#pragma unroll
        for (int t = 0; t < 64; ++t) strow(ROWB(P, row02 + t, PC_BQKV + 512 + h2 * 128), (unsigned)pp * 2u, f2bf(col[t])); } }
    __syncthreads();
    PROF_MARK(F, 9);
}

constexpr int SETC = 13, NSETS = 65 / SETC;
static_assert(SETC * NSETS == 65, "sets must tile the 65 scan steps");
__device__ __forceinline__ void prep_set(Frame& F, int l, int set, int nblk, int bidx) {
    const int nsl = set == 0 ? 1 + 4 * (SETC - 1) : 4 * SETC, np = 2 * nsl;
    auto ug_of = [&](int vp) { const int j = vp >> 1; int slot;
        if (set == 0) slot = j == 0 ? 256 : ((j - 1) / (SETC - 1)) * 64 + (j - 1) % (SETC - 1);
        else slot = (j / SETC) * 64 + SETC * set - 1 + j % SETC;
        return 2 * slot + (vp & 1); };
    int i = bidx, stride = nblk;
    if (nblk >= 2 * np - 16) { if (bidx < np) stride = 3 * np; else stride = nblk - np; }
    for (; i < np; i += stride) prep_gdn(F, l, ug_of(i));
    for (; i < 2 * np; i += stride) prep_gla<128, true>(F, l, ug_of(i - np));
    for (; i < 3 * np; i += stride) prep_gla<64, false>(F, l, ug_of(i - 2 * np));
}
constexpr int SCAN_BUF = 57344;
template <int MX> struct ScanCfg;
template <> struct ScanCfg<0> { static constexpr int NM = 3, NI = 5; static constexpr int off(int m) { return m == 0 ? 0 : (m == 1 ? 16384 : 32768); } static constexpr int pitch(int m) { return m == 0 ? 256 : 128; } };
template <> struct ScanCfg<1> { static constexpr int NM = 4, NI = 7; static constexpr int off(int m) { return 16384 * m; } static constexpr int pitch(int m) { return m < 2 ? 256 : 128; } };
template <> struct ScanCfg<2> { static constexpr int NM = 3, NI = 3; static constexpr int off(int m) { return 8192 * m; } static constexpr int pitch(int m) { return 128; } };

#define SET_CNT(l, k) (WSP(unsigned, WS_CTL) + 8192 + (l) * 8 + (k))
#define XPREP(x) (WSP(unsigned, WS_CTL) + 8192 + 64 + (x))
#define SET_XCNT(l, k, x) (WSP(unsigned, WS_CTL) + 8192 + 128 + ((l) * 8 + (k)) * 16 + (x))
#define SET_SIGNAL(l, k) do { asm volatile("s_waitcnt vmcnt(0)" ::: "memory"); __syncthreads(); \
    if (F.tid == 0) { const unsigned x_ = xb_xcc_id(), np_ = xb_ld(XPREP(x_)); const unsigned old_ = xb_add(SET_XCNT(l, k, x_), 1u); \
        if (old_ + 1u == np_) { __builtin_amdgcn_fence(__ATOMIC_RELEASE, "agent"); asm volatile("s_waitcnt vmcnt(0)" ::: "memory"); (void)xb_add(SET_CNT(l, k), 1u); } } } while (0)
#define SET_WAIT(l, k) do { asm volatile("s_waitcnt vmcnt(0)" ::: "memory"); __syncthreads(); \
    if (F.tid == 0) { unsigned* bar_ = WSP(unsigned, WS_CTL) + CW_BAR; unsigned need_ = 0u; for (unsigned x_ = 0; x_ < 16u; ++x_) need_ += xb_ld(XPREP(x_)) > 0u ? 1u : 0u; \
        XB_SPIN(xb_ld(SET_CNT(l, k)) < need_, bar_); \
        __builtin_amdgcn_fence(__ATOMIC_ACQUIRE, "agent"); asm volatile("s_waitcnt vmcnt(0)" ::: "memory"); } \
    __syncthreads(); asm volatile("" ::: "memory"); } while (0)
#define SCAN_GRID_BARRIER() do { xcd_barrier(WSP(unsigned, WS_CTL) + CW_BAR, xb_xcc_id(), (volatile LAS unsigned*)(F.lds + LDS_MISC) + 8, F.tid, (unsigned)F.G); asm volatile("" ::: "memory"); } while (0)
template <int MX>
__device__ __forceinline__ void scan_mixer(Frame& F, int l, int b, int h) {
    typedef ScanCfg<MX> C;
    constexpr int DK = MX == 2 ? 64 : 128, NT = DK / 16, NI = C::NI;
    const int w = F.wave, lane = F.lane, fr = lane & 15, fq = lane >> 4, ecol = 16 * w + fr;
    const char* Pb = (const char*)WSP(bf16_t, WS_P);
    const int qcol = MX == 0 ? PC_AQ + h * 128 : (MX == 1 ? PC_BQKV + h * 128 : PC_CQ + h * 64);
    const int kcol = MX == 0 ? PC_AF + h * 128 : (MX == 1 ? PC_BQKV + 512 + h * 128 : PC_CK + h * 64);
    const int vcol = MX == 0 ? PC_AI + h * 128 : (MX == 1 ? PC_BQKV + 1024 + h * 128 : PC_CV + h * 128);
    const char* SCb = (const char*)(MX == 0 ? WSP(bf16_t, WS_SCA) : (MX == 1 ? WSP(bf16_t, WS_QKD) : WSP(bf16_t, WS_SCC)));
    bf16_t* O = WSP(bf16_t, WS_O) + (size_t)MX * MROWS * 512;
    unsigned voff[NI]; int mi[NI];
#pragma unroll
    for (int i = 0; i < NI; ++i) { const int n = w + 8 * i, o = 1024 * n + 16 * lane; int m = 0;
#pragma unroll
        for (int q = 1; q < C::NM; ++q) if (o >= C::off(q)) m = q;
        int ro = o, pitch = 128;
#pragma unroll
        for (int q = 0; q < C::NM; ++q) if (m == q) { ro = o - C::off(q); pitch = C::pitch(q); }
        const int r = ro / pitch, pos = (ro % pitch) >> 4, pc = pos ^ (pitch == 256 ? (r & 15) : ((r >> 1) & 7));
        const bool packed = (MX == 0 && m == 1);
        const bool inP = (MX == 1) ? (m < 2) : (m < 2);
        voff[i] = (unsigned)(inP ? (packed ? (r >> 1) * (LDP * 2) + (r & 1) * 128 : r * (LDP * 2)) : r * pitch) + 16u * pc; mi[i] = m; }
    const unsigned x256_0 = (unsigned)(((0 | fq) ^ fr) << 4), x256_1 = (unsigned)(((4 | fq) ^ fr) << 4), x256_2 = (unsigned)(((8 | fq) ^ fr) << 4), x256_3 = (unsigned)(((12 | fq) ^ fr) << 4);
    const unsigned x128_0 = (unsigned)(((0 | fq) ^ ((fr >> 1) & 7)) << 4), x128_1 = (unsigned)(((4 | fq) ^ ((fr >> 1) & 7)) << 4);
    const unsigned x256[4] = {x256_0, x256_1, x256_2, x256_3}, x128[2] = {x128_0, x128_1};
#define SC_FRAG(buf, m, rt, kp) (*(const LAS bf16x8*)(F.lds + (buf) + C::off(m) + (16 * (rt) + fr) * C::pitch(m) + (C::pitch(m) == 256 ? x256[kp] : x128[(kp) & 1])))
    auto slot_of = [&](int step) { return step == 0 ? 256 : b * 64 + step - 1; };
    auto issue = [&](int step, int buf) {
        const int slot = slot_of(step), row0 = slot * 64, unit = slot * 4 + h;
        const char* base[4];
        if (MX == 1) { base[0] = Pb + ((size_t)row0 * LDP + kcol) * 2; base[1] = Pb + ((size_t)row0 * LDP + qcol) * 2; base[2] = (const char*)WSP(bf16_t, WS_K1TB) + (size_t)unit * 16384; base[3] = SCb + (size_t)unit * 8192; }
        else { base[0] = Pb + ((size_t)row0 * LDP + qcol) * 2; base[1] = Pb + ((size_t)row0 * LDP + kcol) * 2; base[2] = SCb + (size_t)unit * 8192; base[3] = base[2]; }
#pragma unroll
        for (int i = 0; i < NI; ++i) { const char* bs = mi[i] == 0 ? base[0] : (mi[i] == 1 ? base[1] : (mi[i] == 2 ? base[2] : base[3]));
            __builtin_amdgcn_global_load_lds((const unsigned*)(bs + voff[i]), (LAS unsigned*)(F.lds + buf + 1024 * (w + 8 * i)), 16, 0, 0); }
    };
    auto load_priv = [&](int step, u32x4 (&pv)[2]) {
        const int row0 = slot_of(step) * 64;
        const bf16_t* vt = (const bf16_t*)Pb + (size_t)(row0 + (ecol >> 1)) * LDP + vcol + (ecol & 1) * 64;
        if (MX == 1) { const u32x2 a = *(const u32x2*)(vt + 4 * fq), c = *(const u32x2*)(vt + 16 + 4 * fq), d = *(const u32x2*)(vt + 32 + 4 * fq), e = *(const u32x2*)(vt + 48 + 4 * fq);
            pv[0] = (u32x4){a.x, a.y, c.x, c.y}; pv[1] = (u32x4){d.x, d.y, e.x, e.y}; }
        else { pv[0] = *(const u32x4*)(vt + 8 * fq); pv[1] = *(const u32x4*)(vt + 32 + 8 * fq); }
    };
    f32x4 S[NT];
#pragma unroll
    for (int i = 0; i < NT; ++i) S[i] = (f32x4){0.f, 0.f, 0.f, 0.f};
    u32x4 pcur[2], pnxt[2];
    auto first_of_set = [](int s) { return s % SETC == 0; };
    for (int step = 0; step < 65; ++step) {
        const int buf = (step & 1) * SCAN_BUF, slot = slot_of(step), row0 = slot * 64, unit = slot * 4 + h;
        if (first_of_set(step)) { PROF_MARK(F, 20); SET_WAIT(l, step / SETC); PROF_MARK(F, 21); issue(step, buf); load_priv(step, pcur); }
        asm volatile("s_waitcnt vmcnt(0)" ::: "memory");
        __syncthreads();
        if (step + 1 < 65 && !first_of_set(step + 1)) { issue(step + 1, SCAN_BUF - buf); load_priv(step + 1, pnxt); }
        bf16x8 Sb[NT / 2];
#pragma unroll
        for (int kp = 0; kp < NT / 2; ++kp) Sb[kp] = pack_acc2(S[2 * kp], S[2 * kp + 1]);
        if (MX == 1) {
            f32x4 vn[4];
#pragma unroll
            for (int mt = 0; mt < 4; ++mt) { f32x4 acc = {0.f, 0.f, 0.f, 0.f};
#pragma unroll
                for (int kp = 0; kp < 4; ++kp) acc = MFMA16(SC_FRAG(buf, 0, mt, kp), Sb[kp], acc);
                const unsigned u0 = mt == 0 ? pcur[0].x : (mt == 1 ? pcur[0].z : (mt == 2 ? pcur[1].x : pcur[1].z)), u1 = mt == 0 ? pcur[0].y : (mt == 1 ? pcur[0].w : (mt == 2 ? pcur[1].y : pcur[1].w));
                vn[mt] = (f32x4){bflo(u0) - acc[0], bfhi(u0) - acc[1], bflo(u1) - acc[2], bfhi(u1) - acc[3]}; }
            bf16x8 Vb[2]; Vb[0] = pack_acc2(vn[0], vn[1]); Vb[1] = pack_acc2(vn[2], vn[3]);
#pragma unroll
            for (int mt = 0; mt < 4; ++mt) { f32x4 acc = {0.f, 0.f, 0.f, 0.f};
#pragma unroll
                for (int kp = 0; kp < 4; ++kp) acc = MFMA16(SC_FRAG(buf, 1, mt, kp), Sb[kp], acc);
#pragma unroll
                for (int kp = 0; kp < 2; ++kp) acc = MFMA16(SC_FRAG(buf, 3, mt, kp), Vb[kp], acc);
#pragma unroll
                for (int r = 0; r < 4; ++r) O[(size_t)(row0 + 16 * mt + 4 * fq + r) * 512 + h * 128 + ecol] = f2bf(acc[r]); }
            const float a = WSP(float, SM_DECB)[unit];
#pragma unroll
            for (int i = 0; i < 8; ++i) { S[i] = S[i] * a;
#pragma unroll
                for (int kp = 0; kp < 2; ++kp) S[i] = MFMA16(SC_FRAG(buf, 2, i, kp), Vb[kp], S[i]); }
        } else {
            const bf16x8 bv0 = mk8(pcur[0]), bv1 = mk8(pcur[1]);
#pragma unroll
            for (int mt = 0; mt < 4; ++mt) { f32x4 acc = {0.f, 0.f, 0.f, 0.f};
#pragma unroll
                for (int kp = 0; kp < NT / 2; ++kp) acc = MFMA16(SC_FRAG(buf, 0, mt, kp), Sb[kp], acc);
                acc = MFMA16(SC_FRAG(buf, 2, mt, 0), bv0, acc); acc = MFMA16(SC_FRAG(buf, 2, mt, 1), bv1, acc);
#pragma unroll
                for (int r = 0; r < 4; ++r) O[(size_t)(row0 + 16 * mt + 4 * fq + r) * 512 + h * 128 + ecol] = f2bf(acc[r]); }
            const float* dec = (MX == 0 ? WSP(float, SM_DECA) : WSP(float, SM_DECC)) + (size_t)unit * DK;
#pragma unroll
            for (int i = 0; i < NT; ++i) { const f32x4 d4 = *(const f32x4*)(dec + 16 * i + 4 * fq); S[i] = S[i] * d4;
                S[i] = MFMA16(SC_FRAG(buf, 1, i, 0), bv0, S[i]); S[i] = MFMA16(SC_FRAG(buf, 1, i, 1), bv1, S[i]); }
        }
        pcur[0] = pnxt[0]; pcur[1] = pnxt[1];
    }
#undef SC_FRAG
    asm volatile("s_waitcnt vmcnt(0)" ::: "memory");
    __syncthreads();
    PROF_MARK(F, 22);
}
__device__ __forceinline__ void phase_scan(Frame& F, int l) {
    if (F.bid >= 48) { for (int k = 0; k < NSETS; ++k) { PROF_MARK(F, 10); prep_set(F, l, k, F.G - 48, F.bid - 48); PROF_MARK(F, 11); SET_SIGNAL(l, k); } return; }
    const int mixer = F.bid >> 4, b = (F.bid >> 2) & 3, h = F.bid & 3;
    if (mixer == 0) scan_mixer<0>(F, l, b, h);
    else if (mixer == 1) scan_mixer<1>(F, l, b, h);
    else scan_mixer<2>(F, l, b, h);
}

template <int KIND>
__device__ __forceinline__ void meta_gemm(Frame& F, const bf16_t* A, const bf16_t* Bt, int N, int K, int n) {
    const int gw = F.bid * NWAVES + F.wave, NGW = F.G * NWAVES, lane = F.lane, fr = lane & 15, fq = lane >> 4;
    for (int tile = gw; tile < N / 16; tile += NGW) {
        const bf16_t* ar = A + (size_t)fr * K + 8 * fq; const bf16_t* br = Bt + (size_t)(16 * tile + fr) * K + 8 * fq;
        f32x4 acc = {0.f, 0.f, 0.f, 0.f};
#pragma unroll 8
        for (int ks = 0; ks < K / 32; ++ks) acc = MFMA16(mk8(*(const u32x4*)(ar + 32 * ks)), mk8(*(const u32x4*)(br + 32 * ks)), acc);
#pragma unroll
        for (int r = 0; r < 4; ++r) { const int row = META_ROW0 + 4 * fq + r, col = 16 * tile + fr;
            if (KIND == 0) WSP(bf16_t, WS_GT)[(size_t)row * 3072 + col] = f2bf(sigmoidf_(acc[r]));
            else if (KIND == 1) { bf16_t* mp = WSP(bf16_t, WS_MERGED) + (size_t)row * 1024 + col; const float g = bf2f(WSP(bf16_t, WS_GT)[(size_t)row * 3072 + n * 1024 + col]);
                *mp = f2bf((n ? bf2f(*mp) : 0.f) + g * acc[r]); }
            else { float* hp = WSP(float, WS_HMETA) + (size_t)(row - NREAL) * D + col; *hp = *hp + acc[r]; } }
    }
}

__device__ __forceinline__ void phase_hnorm(Frame& F, int l) {
    const int gw = F.bid * NWAVES + F.wave, NGW = F.G * NWAVES, lane = F.lane;
    const bf16_t* P = WSP(bf16_t, WS_P);
    LAS float* nws = (LAS float*)F.lds;
    if (F.tid < 384) { const int mxw = F.tid >> 7; const float* src = mxw == 0 ? INP(I_HGRN_NORM) : (mxw == 1 ? INP(I_GDN_NORM) : INP(I_GLA_NORM)); nws[F.tid] = src[(size_t)l * 128 + (F.tid & 127)]; }
    __syncthreads();
    for (int r = gw; r < MROWS; r += NGW) {
        bf16_t* op0 = WSP(bf16_t, WS_O) + (size_t)r * 512 + 8 * lane;
        if (!row_valid(r)) { if (!F.dry) {
#pragma unroll
            for (int mx = 0; mx < 3; ++mx) *(u32x4*)(op0 + (size_t)mx * MROWS * 512) = (u32x4){0u, 0u, 0u, 0u}; } continue; }
        u32x4 ow[3], gv[3];
#pragma unroll
        for (int mx = 0; mx < 3; ++mx) { ow[mx] = *(const u32x4*)(op0 + (size_t)mx * MROWS * 512); gv[mx] = *(const u32x4*)(P + (size_t)r * LDP + (mx == 0 ? PC_AG : (mx == 1 ? PC_BG : PC_CG)) + 8 * lane); }
#pragma unroll
        for (int mx = 0; mx < 3; ++mx) {
            const LAS float* nw = nws + mx * 128 + (8 * lane & 127);
            float o[8] = {bflo(ow[mx].x), bfhi(ow[mx].x), bflo(ow[mx].y), bfhi(ow[mx].y), bflo(ow[mx].z), bfhi(ow[mx].z), bflo(ow[mx].w), bfhi(ow[mx].w)};
            const float g[8] = {siluf_(bflo(gv[mx].x)), siluf_(bfhi(gv[mx].x)), siluf_(bflo(gv[mx].y)), siluf_(bfhi(gv[mx].y)), siluf_(bflo(gv[mx].z)), siluf_(bfhi(gv[mx].z)), siluf_(bflo(gv[mx].w)), siluf_(bfhi(gv[mx].w))};
            float ss = 0.f;
#pragma unroll
            for (int j = 0; j < 8; ++j) ss += o[j] * o[j];
            ss += __shfl_xor(ss, 1); ss += __shfl_xor(ss, 2); ss += __shfl_xor(ss, 4); ss += __shfl_xor(ss, 8);
            const float rstd = rsqrtf(ss * (1.0f / 128.0f) + 1e-6f);
            const f32x4 n0 = *(const LAS f32x4*)nw, n1 = *(const LAS f32x4*)(nw + 4);
            const float nv[8] = {n0[0], n0[1], n0[2], n0[3], n1[0], n1[1], n1[2], n1[3]};
#pragma unroll
            for (int j = 0; j < 8; ++j) o[j] = o[j] * rstd * nv[j] * g[j];
            u32x4 y; y.x = pk2(o[0], o[1]); y.y = pk2(o[2], o[3]); y.z = pk2(o[4], o[5]); y.w = pk2(o[6], o[7]);
            if (!F.dry) *(u32x4*)(op0 + (size_t)mx * MROWS * 512) = y;
        }
    }
}

__device__ __forceinline__ void phase_norm2(Frame& F, int l) {
    PROF_MARK(F, 43);
    if (!F.dry) convert_expert_weights(F, l);
    __syncthreads();
    PROF_MARK(F, 44);
    LAS float* sw = (LAS float*)F.lds;
    { const float* src = WSP(float, SM_RWE) + (size_t)l * 32 * 1024; for (int i = F.tid; i < 32 * 1024 / 4; i += NTHREADS) ((LAS f32x4*)sw)[i] = ((const f32x4*)src)[i]; }
    LAS float* rbias = sw + 32 * 1024;
    if (F.tid < 32) rbias[F.tid] = INP(I_RE_B)[l * 32 + F.tid]; else if (F.tid < 36) rbias[F.tid] = INP(I_RG_B)[l * 4 + (F.tid - 32)];
    __syncthreads();
    const int gw = F.bid * NWAVES + F.wave, NGW = F.G * NWAVES, lane = F.lane;
    float wv[16]; load_row16(INP(I_NORM_FFN) + (size_t)l * D, lane, wv);
    bf16_t* U = WSP(bf16_t, WS_U);
    const float* rwg = WSP(float, SM_RWG) + (size_t)l * 4 * 1024;
    unsigned* cnt = WSP(unsigned, WS_CTL) + CW_CNT + l * 64;
    LAS unsigned* lcnt = (LAS unsigned*)(F.lds + LDS_TAB);
    if (F.tid < 64) lcnt[F.tid] = 0u;
    __syncthreads();
    auto body = [&](auto NRc, const int r0) {
        constexpr int NR = decltype(NRc)::value;
        float x[NR][16];
#pragma unroll
        for (int i = 0; i < NR; ++i) {
            load_row16(hrow(F, r0 + i), lane, x[i]);
            float ss = 0.f;
#pragma unroll
            for (int j = 0; j < 16; ++j) ss += x[i][j] * x[i][j];
            const float rstd = rsqrtf(wave_sum(ss) * (1.0f / D) + 1e-6f);
#pragma unroll
            for (int j = 0; j < 16; ++j) x[i][j] = x[i][j] * rstd * wv[j];
            if (!F.dry) store_bf16_row16(U + (size_t)(r0 + i) * D, lane, x[i]);
        }
        float lg[NR][4];
#pragma unroll
        for (int c = 0; c < 4; ++c) {
            float a[NR];
#pragma unroll
            for (int i = 0; i < NR; ++i) a[i] = 0.f;
#pragma unroll
            for (int j = 0; j < 4; ++j) { const f32x4 w = *((const f32x4*)(rwg + c * 1024) + lane + 64 * j);
#pragma unroll
                for (int e = 0; e < 4; ++e) {
#pragma unroll
                    for (int i = 0; i < NR; ++i) a[i] += x[i][4 * j + e] * w[e]; } }
            const float bg = rbias[32 + c];
#pragma unroll
            for (int i = 0; i < NR; ++i) lg[i][c] = wave_sum(a[i]) + bg;
        }
#pragma unroll
        for (int i = 0; i < NR; ++i) {
            int gi = 0; float gm = lg[i][0];
#pragma unroll
            for (int c = 1; c < 4; ++c) if (lg[i][c] > gm) { gm = lg[i][c]; gi = c; }
            float gsum = 0.f;
#pragma unroll
            for (int c = 0; c < 4; ++c) gsum += __expf(lg[i][c] - gm);
            const float gval = 1.0f / gsum;
            gi = __builtin_amdgcn_readfirstlane(gi);
            int ea = 0, eb = 0; float la = -3.0e38f, lb = -3.0e38f;
            const LAS float* swg = sw + gi * 8 * 1024;
#pragma unroll 1
            for (int cb = 0; cb < 8; cb += 4) {
                float a0 = 0.f, a1 = 0.f, a2 = 0.f, a3 = 0.f;
#pragma unroll
                for (int j = 0; j < 4; ++j) { const f32x4 w0 = *((const LAS f32x4*)(swg + (cb + 0) * 1024) + lane + 64 * j), w1 = *((const LAS f32x4*)(swg + (cb + 1) * 1024) + lane + 64 * j), w2 = *((const LAS f32x4*)(swg + (cb + 2) * 1024) + lane + 64 * j), w3 = *((const LAS f32x4*)(swg + (cb + 3) * 1024) + lane + 64 * j);
#pragma unroll
                    for (int e = 0; e < 4; ++e) { const float xv = x[i][4 * j + e]; a0 += xv * w0[e]; a1 += xv * w1[e]; a2 += xv * w2[e]; a3 += xv * w3[e]; } }
                const float e0 = wave_sum(a0) + rbias[gi * 8 + cb], e1 = wave_sum(a1) + rbias[gi * 8 + cb + 1], e2 = wave_sum(a2) + rbias[gi * 8 + cb + 2], e3 = wave_sum(a3) + rbias[gi * 8 + cb + 3];
                const float ev[4] = {e0, e1, e2, e3};
#pragma unroll
                for (int q = 0; q < 4; ++q) { const float el = ev[q]; const int c = cb + q; if (el > la) { lb = la; eb = ea; la = el; ea = c; } else if (el > lb) { lb = el; eb = c; } }
            }
            const float wa = 1.0f / (1.0f + __expf(lb - la)), wb = 1.0f - wa;
            if (lane == 0 && !F.dry) {
                const unsigned e0 = (unsigned)(gi * 8 + ea), e1 = (unsigned)(gi * 8 + eb);
                const unsigned p0 = __hip_atomic_fetch_add(lcnt + e0, 1u, __ATOMIC_RELAXED, __HIP_MEMORY_SCOPE_WORKGROUP), p1 = __hip_atomic_fetch_add(lcnt + e1, 1u, __ATOMIC_RELAXED, __HIP_MEMORY_SCOPE_WORKGROUP);
                unsigned* tok = WSP(unsigned, SM_TOK) + (size_t)(r0 + i) * 8;
                tok[0] = e0; tok[1] = p0; tok[2] = e1; tok[3] = p1; tok[4] = __float_as_uint(gval * wa); tok[5] = __float_as_uint(gval * wb);
            }
        }
    };
    for (int g = gw; g < NREAL / 4; g += NGW) body(IntC<4>{}, 4 * g);
    if (gw >= NGW - 16) body(IntC<1>{}, META_ROW0 + (NGW - 1 - gw));
    __syncthreads();
    if (F.tid < 32 && !F.dry) lcnt[32 + F.tid] = atomicAdd(cnt + F.tid, lcnt[F.tid]);
    __syncthreads();
    if (!F.dry) { for (int g = gw; g < NREAL / 4; g += NGW) { const int r0 = 4 * g;
            if (lane < 4) { unsigned* tok = WSP(unsigned, SM_TOK) + (size_t)(r0 + lane) * 8; tok[1] += lcnt[32 + tok[0]]; tok[3] += lcnt[32 + tok[2]]; } }
        if (gw >= NGW - 16 && lane == 0) { unsigned* tok = WSP(unsigned, SM_TOK) + (size_t)(META_ROW0 + (NGW - 1 - gw)) * 8; tok[1] += lcnt[32 + tok[0]]; tok[3] += lcnt[32 + tok[2]]; } }
}

__device__ __forceinline__ int moe_tables(Frame& F, int l) {
    LAS int* offs = (LAS int*)(F.lds + LDS_TAB); LAS unsigned char* tab = (LAS unsigned char*)(F.lds + LDS_TAB + 384); LAS int* cn = (LAS int*)(F.lds + LDS_TAB + 192);
    const unsigned* cnt = WSP(unsigned, WS_CTL) + CW_CNT + l * 64;
    __syncthreads();
    if (F.tid < 32) cn[F.tid] = (int)__hip_atomic_load(cnt + F.tid, __ATOMIC_RELAXED, __HIP_MEMORY_SCOPE_AGENT);
    __syncthreads();
    if (F.tid == 0) { int acc = 0;
#pragma unroll 1
        for (int e = 0; e < 32; ++e) { offs[e] = acc; acc += ((cn[e] + 255) >> 8) << 8; }
        offs[32] = acc; }
    __syncthreads();
    if (F.tid < 160) { const int row = F.tid << 8; int e = 0;
#pragma unroll 1
        for (int k = 1; k < 32; ++k) if (offs[k] <= row) e = k;
        tab[F.tid] = (unsigned char)e; }
    __syncthreads();
    return offs[32] >> 8;
}

__device__ __forceinline__ void phase_gather(Frame& F, int l) {
    (void)moe_tables(F, l);
    const LAS int* offs = (const LAS int*)(F.lds + LDS_TAB); const LAS int* cn = (const LAS int*)(F.lds + LDS_TAB + 192);
    const int gw = F.bid * NWAVES + F.wave, NGW = F.G * NWAVES, lane = F.lane;
    const bf16_t* U = WSP(bf16_t, WS_U); bf16_t* XG = WSP(bf16_t, WS_XG); float* wrow = WSP(float, SM_WROW);
    for (int idx = gw; idx < NREAL + 16; idx += 2 * NGW) {
        const int idx2 = idx + NGW; const bool has2 = idx2 < NREAL + 16;
        const int r = idx < NREAL ? idx : META_ROW0 + (idx - NREAL), r2 = has2 ? (idx2 < NREAL ? idx2 : META_ROW0 + (idx2 - NREAL)) : r;
        unsigned* tok = WSP(unsigned, SM_TOK) + (size_t)r * 8; unsigned* tok2 = WSP(unsigned, SM_TOK) + (size_t)r2 * 8;
        const u32x4 ta = *(const u32x4*)tok, tb = *(const u32x4*)tok2; const u32x2 wa = *(const u32x2*)(tok + 4), wb = *(const u32x2*)(tok2 + 4);
        const unsigned g0 = (unsigned)offs[ta.x] + ta.y, g1 = (unsigned)offs[ta.z] + ta.w, h0 = (unsigned)offs[tb.x] + tb.y, h1 = (unsigned)offs[tb.z] + tb.w;
        const u32x4* src = (const u32x4*)(U + (size_t)r * D); const u32x4* src2 = (const u32x4*)(U + (size_t)r2 * D);
        const u32x4 a = src[lane], b = src[lane + 64], c = src2[lane], d = src2[lane + 64];
        if (lane == 0) { tok[6] = g0; tok[7] = g1; wrow[g0] = __uint_as_float(wa.x); wrow[g1] = __uint_as_float(wa.y); }
        u32x4* d0 = (u32x4*)(XG + (size_t)g0 * D); u32x4* d1 = (u32x4*)(XG + (size_t)g1 * D);
        d0[lane] = a; d0[lane + 64] = b; d1[lane] = a; d1[lane + 64] = b;
        if (has2) { if (lane == 0) { tok2[6] = h0; tok2[7] = h1; wrow[h0] = __uint_as_float(wb.x); wrow[h1] = __uint_as_float(wb.y); }
            u32x4* e0 = (u32x4*)(XG + (size_t)h0 * D); u32x4* e1 = (u32x4*)(XG + (size_t)h1 * D);
            e0[lane] = c; e0[lane + 64] = d; e1[lane] = c; e1[lane + 64] = d; }
    }
    u32x4 zz = {0u, 0u, 0u, 0u}; asm volatile("" : "+v"(zz));
    for (int i = gw; i < 32 * 256; i += NGW) { const int e = i >> 8, j = i & 255; const int row = offs[e] + cn[e] + j;
        if (row < offs[e + 1]) { u32x4* d = (u32x4*)(XG + (size_t)row * D); d[lane] = zz; d[lane + 64] = zz; if (lane == 0) wrow[row] = 0.f; } }
}

__device__ __forceinline__ void phase_final(Frame& F) {
    const int gw = F.bid * NWAVES + F.wave, NGW = F.G * NWAVES, lane = F.lane;
    float wv[16]; load_row16(INP(I_NORM_FINAL), lane, wv);
    for (int r = gw; r < NREAL; r += 2 * NGW) {
        const int r2 = r + NGW;
        float x[16], y[16]; fetch_h_row(F, 2, r, x); fetch_h_row(F, 2, r2, y);
        float ss = 0.f, s2 = 0.f;
#pragma unroll
        for (int j = 0; j < 16; ++j) { ss += x[j] * x[j]; s2 += y[j] * y[j]; }
        const float rstd = rsqrtf(wave_sum(ss) * (1.0f / D) + 1e-6f), rstd2 = rsqrtf(wave_sum(s2) * (1.0f / D) + 1e-6f);
#pragma unroll
        for (int j = 0; j < 16; ++j) { x[j] = x[j] * rstd * wv[j]; y[j] = y[j] * rstd2 * wv[j]; }
        store_row16(OUTP + (size_t)r * D, lane, x); store_row16(OUTP + (size_t)r2 * D, lane, y);
    }
}
constexpr int PH_PER_LAYER = 14, N_PHASES = 2 + 2 * PH_PER_LAYER;
#ifndef DBG_STOP
#define DBG_STOP 0
#endif
#ifndef DBG_SRC
#define DBG_SRC WS_P
#define DBG_LD LDP
#endif
#ifndef DBG_TA
#define DBG_TA -1
#endif
#ifndef DBG_TQ
#define DBG_TQ 16.0f
#endif
#ifndef DBG_TB
#define DBG_TB -1
#endif
#ifndef DUP_MASK
#define DUP_MASK 0u
#endif
#define DUPN(j) (((DUP_MASK >> (j)) & 1u) ? 2 : 1)
#ifndef MK_ONE_LAUNCH
#define MK_ONE_LAUNCH 1
#endif

template <unsigned PHMASK_T>
__global__ void __launch_bounds__(NTHREADS, 2) hybrid_fwd(Params p) {
    extern __shared__ __attribute__((aligned(16))) unsigned char lds_raw[];
    Frame F;
    F.lds = (LAS unsigned char*)lds_raw; F.tid = threadIdx.x; F.lane = F.tid & 63; F.wave = __builtin_amdgcn_readfirstlane(F.tid >> 6); F.G = gridDim.x; F.bid = blockIdx.x; F.dry = 0;
    F.out = (GAS float*)p.out; F.ws = (GAS unsigned char*)p.ws; F.inp = (const float* const __attribute__((address_space(4)))*)__builtin_amdgcn_kernarg_segment_ptr();
    volatile LAS unsigned* MISC = (volatile LAS unsigned*)(F.lds + LDS_MISC);
    if (F.tid < 128) MISC[F.tid] = 0u;
    if (F.bid >= 48 && F.tid == 0) (void)xb_add(WSP(unsigned, WS_CTL) + 8192 + 64 + xb_xcc_id(), 1u);
    __syncthreads();
#if MK_ONE_LAUNCH
    constexpr int lo = 0, hi = N_PHASES;
#else
    const int lo = p.ph_lo, hi = p.ph_hi;
#endif
    if (hi - lo > 1) (void)xcd_barrier_post(WSP(unsigned, WS_CTL) + CW_BAR, MISC + 8);
#define GRID_BARRIER() xcd_barrier(WSP(unsigned, WS_CTL) + CW_BAR, xb_xcc_id(), (volatile LAS unsigned*)(F.lds + LDS_MISC) + 8, F.tid, (unsigned)F.G)
#define EN(j) ((PHMASK_T >> (j)) & 1u)
#define IN(k) (lo <= (k) && (k) < hi)
    if (DBG_TA >= 0 && F.tid == 0) { MISC[16] = (unsigned)__builtin_amdgcn_s_memrealtime(); MISC[17] = 0u; }
#define SEAM(k) do { if (IN(k) && IN((k) + 1)) GRID_BARRIER(); PHASE_FENCE(F); \
    if (DBG_TA >= 0 && F.tid == 0) { const unsigned t_now = (unsigned)__builtin_amdgcn_s_memrealtime(); const int kk = (k) == 0 ? 15 : (((k) - 1) % PH_PER_LAYER); const int kind = (kk >= 6 && kk <= 8) ? 6 : kk; \
        if (kind == DBG_TA) MISC[17] += t_now - MISC[16]; MISC[16] = t_now; } } while (0)
    PHASE_FENCE(F);
    if (EN(15) && IN(0)) phase_pre(F);
    SEAM(0);
    { constexpr int l = 0;
        const int pb = 1 + PH_PER_LAYER * l;
        for (int rep = 0; rep < (l == 0 ? DUPN(0) : 1); ++rep) { if (rep) { GRID_BARRIER(); PHASE_FENCE(F); } if (EN(0) && IN(pb + 0)) phase_norm1(F, l); }
        PROF_MARK(F, 42);
        SEAM(pb + 0);
        for (int rep = 0; rep < DUPN(1); ++rep) { if (rep) { GRID_BARRIER(); PHASE_FENCE(F); }
        if (EN(1) && IN(pb + 1)) {
            pg8::Gemm g{WSP(bf16_t, WS_U), WSP(bf16_t, WS_WMIX), MROWS, LDP, D}; pg8::StaticOrder S; S.init(MROWS, LDP, F.G, F.bid);
            pg8::EpiInProj E{WSP(bf16_t, WS_P), WSP(bf16_t, SM_HALO)};
            pg8::gemm_phase(F.lds, F.tid, g, S, E);
        } }
        SEAM(pb + 1);
        PHASE_FENCE(F);
        if (EN(3) && IN(pb + 3)) phase_scan(F, l);
        SEAM(pb + 3);
        for (int rep = 0; rep < DUPN(4); ++rep) { if (rep) { GRID_BARRIER(); PHASE_FENCE(F); F.dry = 1; asm volatile("" : "+s"(F.dry)); } if (EN(4) && IN(pb + 4)) phase_hnorm(F, l); F.dry = 0; }
        SEAM(pb + 4);
        for (int rep = 0; rep < DUPN(5); ++rep) { if (rep) { GRID_BARRIER(); PHASE_FENCE(F); }
        if (EN(5) && IN(pb + 5)) {
            pg8::Gemm g{WSP(bf16_t, WS_U), WSP(bf16_t, WS_WGATE), NREAL, 3072, D}; pg8::StaticOrder S; S.init(NREAL, 3072, F.G, F.bid);
            pg8::EpiSigmoid E{WSP(bf16_t, WS_GT), 3072};
            pg8::gemm_phase(F.lds, F.tid, g, S, E);
            meta_gemm<0>(F, WSP(bf16_t, WS_U) + (size_t)META_ROW0 * D, WSP(bf16_t, WS_WGATE), 3072, D, 0);
        } }
        SEAM(pb + 5);
        for (int n = 0; n < 3; ++n) {
            if (EN(6) && IN(pb + 6 + n)) {
                pg8::Gemm g{WSP(bf16_t, WS_O) + (size_t)n * MROWS * 512, WSP(bf16_t, WS_WBT) + (size_t)n * 1024 * 512, NREAL, D, 512}; pg8::StaticOrder S; S.init(NREAL, D, F.G, F.bid);
                pg8::EpiBranch E{WSP(bf16_t, WS_MERGED), WSP(bf16_t, WS_GT), n};
                pg8::gemm_phase(F.lds, F.tid, g, S, E);
                meta_gemm<1>(F, WSP(bf16_t, WS_O) + (size_t)n * MROWS * 512 + (size_t)META_ROW0 * 512, WSP(bf16_t, WS_WBT) + (size_t)n * 1024 * 512, D, 512, n);
            }
            SEAM(pb + 6 + n);
        }
        if (EN(9) && IN(pb + 9)) {
            pg8::Gemm g{WSP(bf16_t, WS_MERGED), WSP(bf16_t, WS_WOT), NREAL, D, D}; pg8::StaticOrder S; S.init(NREAL, D, F.G, F.bid);
            pg8::EpiResidual E{OUTP, WSP(float, WS_HMETA)};
            pg8::gemm_phase(F.lds, F.tid, g, S, E);
            meta_gemm<2>(F, WSP(bf16_t, WS_MERGED) + (size_t)META_ROW0 * D, WSP(bf16_t, WS_WOT), D, D, 0);
        }
        SEAM(pb + 9);
        for (int rep = 0; rep < DUPN(10); ++rep) { if (rep) { GRID_BARRIER(); PHASE_FENCE(F); F.dry = 1; asm volatile("" : "+s"(F.dry)); } if (EN(10) && IN(pb + 10)) phase_norm2(F, l); F.dry = 0; }
        PROF_MARK(F, 45);
        SEAM(pb + 10);
        for (int rep = 0; rep < DUPN(11); ++rep) { if (rep) { GRID_BARRIER(); PHASE_FENCE(F); } if (EN(11) && IN(pb + 11)) phase_gather(F, l); }
        SEAM(pb + 11);
        for (int rep = 0; rep < DUPN(12); ++rep) { if (rep) { GRID_BARRIER(); PHASE_FENCE(F); }
        if (EN(12) && IN(pb + 12)) {
            const int ntiles = moe_tables(F, l);
            pg8::Gemm g{WSP(bf16_t, WS_XG), WSP(bf16_t, WS_W1T), XG_ROWS, 512, D};
            pg8::MoeOrder S{F.G, F.bid, 2, ntiles, (const LAS unsigned char*)(F.lds + LDS_TAB + 384), (size_t)512 * 1024 * 2};
            pg8::EpiMoeUp E{WSP(bf16_t, WS_HG)};
            pg8::gemm_phase(F.lds, F.tid, g, S, E);
        } }
        SEAM(pb + 12);
        for (int rep = 0; rep < DUPN(13); ++rep) { if (rep) { GRID_BARRIER(); PHASE_FENCE(F); }
        if (EN(13) && IN(pb + 13)) {
            const int ntiles = moe_tables(F, l);
            pg8::Gemm g{WSP(bf16_t, WS_HG), WSP(bf16_t, WS_W2T), XG_ROWS, D, 256};
            pg8::MoeOrder S{F.G, F.bid, 4, ntiles, (const LAS unsigned char*)(F.lds + LDS_TAB + 384), (size_t)1024 * 256 * 2};
            pg8::EpiMoeDown E{WSP(bf16_t, WS_Y2), WSP(float, SM_WROW)};
            pg8::gemm_phase(F.lds, F.tid, g, S, E);
        } }
        SEAM(pb + 13);
    }
    { constexpr int l = 1;
        const int pb = 1 + PH_PER_LAYER * l;
        for (int rep = 0; rep < (l == 0 ? DUPN(0) : 1); ++rep) { if (rep) { GRID_BARRIER(); PHASE_FENCE(F); } if (EN(0) && IN(pb + 0)) phase_norm1(F, l); }
        PROF_MARK(F, 42);
        SEAM(pb + 0);
        for (int rep = 0; rep < DUPN(1); ++rep) { if (rep) { GRID_BARRIER(); PHASE_FENCE(F); }
        if (EN(1) && IN(pb + 1)) {
            pg8::Gemm g{WSP(bf16_t, WS_U), WSP(bf16_t, WS_WMIX), MROWS, LDP, D}; pg8::StaticOrder S; S.init(MROWS, LDP, F.G, F.bid);
            pg8::EpiInProj E{WSP(bf16_t, WS_P), WSP(bf16_t, SM_HALO)};
            pg8::gemm_phase(F.lds, F.tid, g, S, E);
        } }
        SEAM(pb + 1);
        PHASE_FENCE(F);
        if (EN(3) && IN(pb + 3)) phase_scan(F, l);
        SEAM(pb + 3);
        for (int rep = 0; rep < DUPN(4); ++rep) { if (rep) { GRID_BARRIER(); PHASE_FENCE(F); F.dry = 1; asm volatile("" : "+s"(F.dry)); } if (EN(4) && IN(pb + 4)) phase_hnorm(F, l); F.dry = 0; }
        SEAM(pb + 4);
        for (int rep = 0; rep < DUPN(5); ++rep) { if (rep) { GRID_BARRIER(); PHASE_FENCE(F); }
        if (EN(5) && IN(pb + 5)) {
            pg8::Gemm g{WSP(bf16_t, WS_U), WSP(bf16_t, WS_WGATE), NREAL, 3072, D}; pg8::StaticOrder S; S.init(NREAL, 3072, F.G, F.bid);
            pg8::EpiSigmoid E{WSP(bf16_t, WS_GT), 3072};
            pg8::gemm_phase(F.lds, F.tid, g, S, E);
            meta_gemm<0>(F, WSP(bf16_t, WS_U) + (size_t)META_ROW0 * D, WSP(bf16_t, WS_WGATE), 3072, D, 0);
        } }
        SEAM(pb + 5);
        for (int n = 0; n < 3; ++n) {
            if (EN(6) && IN(pb + 6 + n)) {
                pg8::Gemm g{WSP(bf16_t, WS_O) + (size_t)n * MROWS * 512, WSP(bf16_t, WS_WBT) + (size_t)n * 1024 * 512, NREAL, D, 512}; pg8::StaticOrder S; S.init(NREAL, D, F.G, F.bid);
                pg8::EpiBranch E{WSP(bf16_t, WS_MERGED), WSP(bf16_t, WS_GT), n};
                pg8::gemm_phase(F.lds, F.tid, g, S, E);
                meta_gemm<1>(F, WSP(bf16_t, WS_O) + (size_t)n * MROWS * 512 + (size_t)META_ROW0 * 512, WSP(bf16_t, WS_WBT) + (size_t)n * 1024 * 512, D, 512, n);
            }
            SEAM(pb + 6 + n);
        }
        if (EN(9) && IN(pb + 9)) {
            pg8::Gemm g{WSP(bf16_t, WS_MERGED), WSP(bf16_t, WS_WOT), NREAL, D, D}; pg8::StaticOrder S; S.init(NREAL, D, F.G, F.bid);
            pg8::EpiResidual E{OUTP, WSP(float, WS_HMETA)};
            pg8::gemm_phase(F.lds, F.tid, g, S, E);
            meta_gemm<2>(F, WSP(bf16_t, WS_MERGED) + (size_t)META_ROW0 * D, WSP(bf16_t, WS_WOT), D, D, 0);
        }
        SEAM(pb + 9);
        for (int rep = 0; rep < DUPN(10); ++rep) { if (rep) { GRID_BARRIER(); PHASE_FENCE(F); F.dry = 1; asm volatile("" : "+s"(F.dry)); } if (EN(10) && IN(pb + 10)) phase_norm2(F, l); F.dry = 0; }
        PROF_MARK(F, 45);
        SEAM(pb + 10);
        for (int rep = 0; rep < DUPN(11); ++rep) { if (rep) { GRID_BARRIER(); PHASE_FENCE(F); } if (EN(11) && IN(pb + 11)) phase_gather(F, l); }
        SEAM(pb + 11);
        for (int rep = 0; rep < DUPN(12); ++rep) { if (rep) { GRID_BARRIER(); PHASE_FENCE(F); }
        if (EN(12) && IN(pb + 12)) {
            const int ntiles = moe_tables(F, l);
            pg8::Gemm g{WSP(bf16_t, WS_XG), WSP(bf16_t, WS_W1T), XG_ROWS, 512, D};
            pg8::MoeOrder S{F.G, F.bid, 2, ntiles, (const LAS unsigned char*)(F.lds + LDS_TAB + 384), (size_t)512 * 1024 * 2};
            pg8::EpiMoeUp E{WSP(bf16_t, WS_HG)};
            pg8::gemm_phase(F.lds, F.tid, g, S, E);
        } }
        SEAM(pb + 12);
        for (int rep = 0; rep < DUPN(13); ++rep) { if (rep) { GRID_BARRIER(); PHASE_FENCE(F); }
        if (EN(13) && IN(pb + 13)) {
            const int ntiles = moe_tables(F, l);
            pg8::Gemm g{WSP(bf16_t, WS_HG), WSP(bf16_t, WS_W2T), XG_ROWS, D, 256};
            pg8::MoeOrder S{F.G, F.bid, 4, ntiles, (const LAS unsigned char*)(F.lds + LDS_TAB + 384), (size_t)1024 * 256 * 2};
            pg8::EpiMoeDown E{WSP(bf16_t, WS_Y2), WSP(float, SM_WROW)};
            pg8::gemm_phase(F.lds, F.tid, g, S, E);
        } }
        SEAM(pb + 13);
    }
#if DBG_STOP > 0
    if (EN(14) && IN(N_PHASES - 1)) { const int gt = F.bid * NTHREADS + F.tid, NT = F.G * NTHREADS;
#ifdef DBG_LIN
        { const bf16_t* s1 = WSP(bf16_t, DBG_SRC); const bf16_t* s2 = WSP(bf16_t, DBG_SRC2);
          for (size_t i = gt; i < (size_t)NREAL * D; i += NT) F.out[i] = i < (size_t)DBG_N1 ? bf2f(s1[i]) : (i < (size_t)DBG_N1 + DBG_N2 ? bf2f(s2[i - DBG_N1]) : 0.f); }
#else
        if (DBG_LD > 0) { const bf16_t* src = WSP(bf16_t, DBG_SRC); for (size_t i = gt; i < (size_t)NREAL * D; i += NT) { const size_t r = i >> 10, c = i & 1023; F.out[i] = bf2f(src[r * DBG_LD + (c * DBG_LD) / 1024]); } }
#endif
    }
#else
#ifdef DBG_XBAR
    for (int i = 0; i < DBG_XBAR; ++i) { GRID_BARRIER(); PHASE_FENCE(F); }
#endif
    if (EN(14) && IN(N_PHASES - 1)) phase_final(F);
    PROF_SPIN(F);
    if (DBG_TA >= 0) { float* tw = WSP(float, WS_CTL) + 2048; if (F.bid == 0 && F.tid == 0) { tw[0] = (float)MISC[17] * 0.01f; }
        GRID_BARRIER(); PHASE_FENCE(F);
        const float v = floorf(WSP(float, WS_CTL)[2048] * (1.0f / DBG_TQ)) * 0.25f;
        const int gt = F.bid * NTHREADS + F.tid, NT = F.G * NTHREADS;
        for (size_t i = gt; i < (size_t)NREAL * D; i += NT) F.out[i] = v; }
#endif
#undef IN
#undef SEAM
}

#if MK_ONE_LAUNCH
#ifndef KM_ONE
#define KM_ONE 0xffffffffu
#endif
constexpr unsigned KMASK[1] = {KM_ONE};
#else
constexpr unsigned KMASK[3] = {0x0C19u, 0xC004u, 0x3262u};
#endif
template <unsigned M> static bool setup_kernel(int& per_cu) {
    if (hipFuncSetAttribute((const void*)hybrid_fwd<M>, hipFuncAttributeMaxDynamicSharedMemorySize, LDS_BYTES) != hipSuccess) return false;
    if (hipOccupancyMaxActiveBlocksPerMultiprocessor(&per_cu, (const void*)hybrid_fwd<M>, NTHREADS, LDS_BYTES) != hipSuccess) per_cu = 0;
    (void)hipGetLastError();
    return true;
}
static int phase_kind(int k) { if (k == 0) return 15; if (k == N_PHASES - 1) return 14; const int j = (k - 1) % PH_PER_LAYER; return (j >= 6 && j <= 8) ? 6 : j; }
extern "C" void kernel_launch(void* const* d_in, const int* in_sizes, int n_in, void* d_out, int out_size, void* d_ws, size_t ws_size, hipStream_t stream) {
    static int grid = 0;
    if (grid == 0) {
        if (n_in != 24 || in_sizes[0] != NREAL * D || out_size != NREAL * D || ws_size < WS_END) {
            fprintf(stderr, "kernel_launch: unexpected problem (n_in %d, in0 %d, out %d, ws %zu < %zu); nothing launched\n", n_in, n_in > 0 ? in_sizes[0] : -1, out_size, ws_size, (size_t)WS_END); grid = -1; return; }
        int dev = 0, cus = 0, per_cu = 0; bool ok = true;
        if (hipGetDevice(&dev) != hipSuccess || hipDeviceGetAttribute(&cus, hipDeviceAttributeMultiprocessorCount, dev) != hipSuccess) { grid = -1; return; }
#if MK_ONE_LAUNCH
        ok = setup_kernel<KMASK[0]>(per_cu);
#else
        ok = setup_kernel<KMASK[0]>(per_cu) && setup_kernel<KMASK[1]>(per_cu) && setup_kernel<KMASK[2]>(per_cu);
#endif
        if (!ok) { fprintf(stderr, "kernel_launch: hipFuncSetAttribute failed\n"); grid = -1; return; }
        if (per_cu < 1) fprintf(stderr, "kernel_launch: occupancy query says %d\n", per_cu);
        grid = cus;
    }
    if (grid < 0) return;
    if (hipMemsetAsync((char*)d_ws + WS_CTL, 0, CTL_BYTES, stream) != hipSuccess) return;
    Params p{};
    for (int i = 0; i < 24; ++i) p.in[i] = (const float*)d_in[i];
    p.out = (float*)d_out; p.ws = (unsigned char*)d_ws;
#if MK_ONE_LAUNCH
    p.ph_lo = 0; p.ph_hi = N_PHASES;
    hipLaunchKernelGGL(hybrid_fwd<KMASK[0]>, dim3(grid), dim3(NTHREADS), LDS_BYTES, stream, p);
#else
    for (int k = 0; k < N_PHASES; ++k) { if (DBG_STOP > 0 && k >= DBG_STOP && k != N_PHASES - 1) continue; p.ph_lo = k; p.ph_hi = k + 1; const unsigned bit = 1u << phase_kind(k);
        if (KMASK[0] & bit) hipLaunchKernelGGL(hybrid_fwd<KMASK[0]>, dim3(grid), dim3(NTHREADS), LDS_BYTES, stream, p);
        else if (KMASK[1] & bit) hipLaunchKernelGGL(hybrid_fwd<KMASK[1]>, dim3(grid), dim3(NTHREADS), LDS_BYTES, stream, p);
        else hipLaunchKernelGGL(hybrid_fwd<KMASK[2]>, dim3(grid), dim3(NTHREADS), LDS_BYTES, stream, p); }
#endif
}
```

```cpp
#include <hip/hip_runtime.h>
#include <cstdio>
#include <cstdint>

#define LAS __attribute__((address_space(3)))
typedef unsigned short bf16_t;
typedef short bf16x8 __attribute__((ext_vector_type(8)));
typedef float f32x4 __attribute__((ext_vector_type(4)));
typedef float f32x2 __attribute__((ext_vector_type(2)));
typedef unsigned u32x4 __attribute__((ext_vector_type(4)));
typedef unsigned u32x2 __attribute__((ext_vector_type(2)));

constexpr int D = 1024, NREAL = 16384, MROWS = 16640, META_ROW0 = 16384 + 48, META_END = 16384 + 64;
constexpr int NSLOT = 257;
constexpr int LDP = 5632;
constexpr int PC_AQ = 0, PC_AF = 512, PC_AI = 1024, PC_AG = 1536, PC_BQKV = 2048, PC_BG = 3584, PC_CQ = 4096, PC_CK = 4352, PC_CV = 4608, PC_CG = 5120;
constexpr int IN_COLS = 8728;
constexpr int NTHREADS = 512, NWAVES = 8;
constexpr int XG_ROWS = 40960;

constexpr size_t MiB = 1ull << 20;
constexpr size_t WS_CTL = 0, CTL_BYTES = 1 * MiB;
constexpr int CW_BAR = 4096, CW_CNT = 1024;
constexpr size_t SM_SW1 = 1 * MiB;
constexpr size_t SM_RWG = SM_SW1 + 2 * 24 * 1024 * 4;
constexpr size_t SM_RWE = SM_RWG + 2 * 4 * 1024 * 4;
constexpr size_t SM_LAB = SM_RWE + 2 * 32 * 1024 * 4;
constexpr size_t SM_GK = SM_LAB + 2 * 2 * 512 * 4;
constexpr size_t SM_BETA = SM_GK + (size_t)MROWS * 16 * 4;
constexpr size_t SM_LOGA = SM_BETA + (size_t)MROWS * 4 * 4;
constexpr size_t SM_TOK = SM_LOGA + (size_t)MROWS * 4 * 4;
constexpr size_t SM_WROW = SM_TOK + (size_t)MROWS * 8 * 4;
constexpr size_t SM_DECA = SM_WROW + (size_t)XG_ROWS * 4;
constexpr size_t SM_DECC = SM_DECA + 1028 * 128 * 4;
constexpr size_t SM_DECB = SM_DECC + 1028 * 64 * 4;
constexpr size_t SM_HALO = SM_DECB + 8192;
constexpr size_t SM_END = SM_HALO + 260 * 3 * 1536 * 2;
static_assert(SM_END <= 8 * MiB, "small region");
constexpr size_t WS_HMETA = 8 * MiB;
constexpr size_t WS_WMIX = 9 * MiB;
constexpr size_t WS_WGATE = 20 * MiB;
constexpr size_t WS_WBT = 26 * MiB;
constexpr size_t WS_WOT = 29 * MiB;
constexpr size_t WS_O = 31 * MiB;
constexpr size_t O_STRIDE = (size_t)MROWS * 512 * 2;
constexpr size_t WS_W1T = 31 * MiB;
constexpr size_t WS_W2T = 63 * MiB;
constexpr size_t WS_U = 80 * MiB;
constexpr size_t WS_P = 113 * MiB;
constexpr size_t WS_GT = 113 * MiB;
constexpr size_t WS_MERGED = 211 * MiB;
constexpr size_t WS_XG = 113 * MiB;
constexpr size_t WS_HG = 193 * MiB;
constexpr size_t WS_Y2 = 213 * MiB;
constexpr size_t WS_SCA = 294 * MiB;
constexpr size_t WS_QKD = 303 * MiB;
constexpr size_t WS_SCC = 312 * MiB;
constexpr size_t WS_K1TB = 321 * MiB;
constexpr size_t WS_END = 338 * MiB;

constexpr int LDS_BYTES = 163840;
constexpr int LDS_MISC = LDS_BYTES - 512;
constexpr int LDS_TAB = LDS_BYTES - 1536;
constexpr int LDS_SCRATCH = LDS_TAB;

typedef __bf16 bf16x2v __attribute__((ext_vector_type(2)));
__device__ __forceinline__ unsigned pk2(float lo, float hi) { const f32x2 v = {lo, hi}; return __builtin_bit_cast(unsigned, __builtin_convertvector(v, bf16x2v)); }
__device__ __forceinline__ bf16_t f2bf(float f) { return (bf16_t)(pk2(f, 0.f) & 0xffffu); }
__device__ __forceinline__ float bf2f(bf16_t b) { return __uint_as_float(((unsigned)b) << 16); }
__device__ __forceinline__ float bflo(unsigned w) { return __uint_as_float(w << 16); }
__device__ __forceinline__ float bfhi(unsigned w) { return __uint_as_float(w & 0xffff0000u); }
__device__ __forceinline__ float sigmoidf_(float x) { return __builtin_amdgcn_rcpf(1.0f + __expf(-x)); }
__device__ __forceinline__ float siluf_(float x) { return x * __builtin_amdgcn_rcpf(1.0f + __expf(-x)); }
__device__ __forceinline__ float logsigf_(float x) { return fminf(x, 0.f) - __logf(1.0f + __expf(-fabsf(x))); }
__device__ __forceinline__ float softplusf_(float x) { return fmaxf(x, 0.f) + log1pf(__expf(-fabsf(x))); }
__device__ __forceinline__ bool row_valid(int r) { return r < NREAL || (r >= META_ROW0 && r < META_END); }
__device__ __forceinline__ float wave_sum(float v) {
#define DPP_ADD(ctrl, rmask) v += __int_as_float(__builtin_amdgcn_update_dpp(0, __float_as_int(v), (ctrl), (rmask), 0xf, false))
    DPP_ADD(0x111, 0xf); DPP_ADD(0x112, 0xf); DPP_ADD(0x114, 0xf); DPP_ADD(0x118, 0xf);
    DPP_ADD(0x142, 0xa); DPP_ADD(0x143, 0xc);
#undef DPP_ADD
    return __int_as_float(__builtin_amdgcn_readlane(__float_as_int(v), 63));
}
#define LDS_WAIT() asm volatile("s_waitcnt lgkmcnt(0)" ::: "memory")

#define XB_TMO      128
#define XB_XCNT(j)  (256  + 64 * (j))
#define XB_XSUB(j)  (1280 + 64 * (j))
#define XB_XGEN(j)  (2304 + 64 * (j))
#define XB_TOP      3328
#define XB_TOPGEN   3392
#define XCD_BAR_WORDS 3456
#define XB_SPIN_CAP (1u << 18)
__device__ __forceinline__ unsigned xb_ld(unsigned* p)              { return __hip_atomic_load(p, __ATOMIC_RELAXED, __HIP_MEMORY_SCOPE_AGENT); }
__device__ __forceinline__ unsigned xb_add(unsigned* p, unsigned v) { return __hip_atomic_fetch_add(p, v, __ATOMIC_RELAXED, __HIP_MEMORY_SCOPE_AGENT); }
__device__ __forceinline__ unsigned xb_xcc_id() { return (unsigned)__builtin_amdgcn_s_getreg((3 << 11) | 20) & 0xFu; }
#define XB_SPIN(cond, bar) do { unsigned _sp = 0; while (cond) { __builtin_amdgcn_s_sleep(1); \
    if ((++_sp & 255u) == 0u) { if (xb_ld(&(bar)[XB_TMO])) break; if (_sp > XB_SPIN_CAP) { atomicAdd(&(bar)[XB_TMO], 1u); break; } } } } while (0)
struct XcdBarrier { unsigned* bar; unsigned x; volatile LAS unsigned* st; };
__device__ __forceinline__ XcdBarrier xcd_barrier_post(unsigned* bar, volatile LAS unsigned* st) {
    XcdBarrier b; b.bar = bar; b.x = xb_xcc_id(); b.st = st;
    if (threadIdx.x == 0) (void)xb_add(&bar[XB_XCNT(b.x)], 1u);
    return b;
}
__device__ __forceinline__ void xcd_barrier_complete(unsigned* bar, unsigned x, unsigned& nloc, unsigned& nx, const unsigned G) {
    unsigned sum, cnt, mine, sp = 0u;
    for (;;) {
        sum = 0u; cnt = 0u; mine = 0u;
#pragma unroll
        for (unsigned j = 0; j < 16; ++j) { const unsigned c = xb_ld(&bar[XB_XCNT(j)]); sum += c; cnt += (c > 0u) ? 1u : 0u; mine = (j == x) ? c : mine; }
        if (sum == G) break;
        __builtin_amdgcn_s_sleep(1);
        if ((++sp & 255u) == 0u) { if (xb_ld(&bar[XB_TMO])) break; if (sp > XB_SPIN_CAP) { atomicAdd(&bar[XB_TMO], 1u); break; } }
    }
    nloc = mine > 0u ? mine : 1u; nx = cnt > 0u ? cnt : 1u;
}
__device__ __attribute__((noinline)) void xcd_barrier(unsigned* bar_, unsigned x_, volatile LAS unsigned* st_, int tid_, unsigned G_) {
    XcdBarrier b; b.bar = bar_; b.x = x_; b.st = st_;
    asm volatile("s_waitcnt vmcnt(0)" ::: "memory");
    __syncthreads();
    if (tid_ == 0) {
        unsigned* bar = b.bar;
        __builtin_amdgcn_s_waitcnt(0);
        unsigned nloc = b.st[0], nx = b.st[1];
        if (nloc == 0u) { xcd_barrier_complete(bar, b.x, nloc, nx, G_); b.st[0] = nloc; b.st[1] = nx; }
        const unsigned old = xb_add(&bar[XB_XSUB(b.x)], 1u);
        const unsigned gen = old / nloc;
        if (old + 1u == (gen + 1u) * nloc) {
            __builtin_amdgcn_fence(__ATOMIC_RELEASE, "agent");
            asm volatile("s_waitcnt vmcnt(0)" ::: "memory");
            const unsigned og = xb_add(&bar[XB_TOP], 1u);
            const unsigned tg = og / nx;
            if (og + 1u == (tg + 1u) * nx) xb_add(&bar[XB_TOPGEN], 1u);
            else XB_SPIN(xb_ld(&bar[XB_TOPGEN]) == tg, bar);
            __builtin_amdgcn_fence(__ATOMIC_ACQUIRE, "agent");
            xb_add(&bar[XB_XGEN(b.x)], 1u);
            asm volatile("s_waitcnt vmcnt(0)" ::: "memory");
        } else {
            XB_SPIN(xb_ld(&bar[XB_XGEN(b.x)]) == gen, bar);
            __builtin_amdgcn_fence(__ATOMIC_ACQUIRE, "agent");
            asm volatile("s_waitcnt vmcnt(0)" ::: "memory");
        }
    }
    __syncthreads();
}

#ifndef PROF_ON
#define PROF_ON 0
#endif
#if PROF_ON
#define PROF_SLOTS(F) WSP(unsigned, WS_CTL + 524288)
__device__ __forceinline__ unsigned prof_now() { unsigned long long t; asm volatile("s_memrealtime %0\n\ts_waitcnt lgkmcnt(0)" : "=s"(t) :: "memory"); return (unsigned)t; }
#define PROF_MARK(F, k) do { const unsigned now_ = prof_now(); if ((F).bid == PROF_BID && (F).tid == 0) PROF_SLOTS(F)[k] = now_; asm volatile("" ::: "memory"); } while (0)
#if PROF_IN & 1
#define PROF_MARKI(F, k) PROF_MARK(F, k)
#else
#define PROF_MARKI(F, k) do { } while (0)
#endif
#if PROF_IN & 2
#define PROF_MARKG(F, k) do { if ((PROF_GMASK >> (k)) & 1) PROF_MARK(F, k); } while (0)
#else
#define PROF_MARKG(F, k) do { } while (0)
#endif
#define PROF_SPIN(F) do { if ((F).bid == PROF_BID && (F).tid == 0) { unsigned qa_ = (PROF_SLOTS(F)[PROF_A1] - PROF_SLOTS(F)[PROF_A0] + 50u) / 100u, qb_ = (PROF_SLOTS(F)[PROF_B1] - PROF_SLOTS(F)[PROF_B0] + 50u) / 100u; \
    qa_ = qa_ > 127u ? 127u : qa_; qb_ = qb_ > 127u ? 127u : qb_; const unsigned d_ = (qa_ + 128u * qb_) * 1600u; const unsigned t0_ = (unsigned)__builtin_amdgcn_s_memrealtime(); \
    while ((unsigned)__builtin_amdgcn_s_memrealtime() - t0_ < d_) __builtin_amdgcn_s_sleep(8); } } while (0)
#else
#define PROF_MARK(F, k) do { } while (0)
#define PROF_MARKI(F, k) do { } while (0)
#define PROF_MARKG(F, k) do { } while (0)
#define PROF_SPIN(F) do { } while (0)
#endif
namespace pg8 {
constexpr int BM = 256, BK = 64, HALF = 128, HTB = HALF * BK * 2, STAGE_BYTES = 8 * HTB, NXCD = 8, WGM = 8;
__host__ __device__ __forceinline__ int lds_byte(int r, int c) { const int st = (r >> 4) * 2 + (c >> 5), rr = r & 15, cc = c & 31, ob = rr * 64 + cc * 2; return st * 1024 + (ob ^ (((ob >> 9) & 1) << 5)); }
__host__ __device__ __forceinline__ void stage_rc(int b, int& R, int& C) { const int st = b / 1024, sb = b % 1024, swz = sb ^ (((sb >> 9) & 1) << 5); R = (st >> 1) * 16 + swz / 64; C = (st & 1) * 32 + (swz % 64) / 2; }
__host__ __device__ __forceinline__ int perm32(int rho) { const int n = rho >> 4, i = rho & 15; return 8 * (i >> 2) + 4 * n + (i & 3); }

struct Unit { int pm, pn, ex; };
struct Gemm { const bf16_t* A; const bf16_t* Bt; int M, N, K; };

struct StaticOrder {
    int nM, nN, nwg, G, c;
    __device__ void init(int M, int N, int G_, int c_) { nM = M / BM; nN = N / BM; nwg = nM * nN; G = G_; c = c_; }
    __device__ bool next(int i, Unit& u) const {
        const long L = (long)i * G + c; if (L >= nwg) return false;
        int wgid = (int)L; { const int q = nwg / NXCD, r = nwg % NXCD, xcd = wgid % NXCD, off = wgid / NXCD; wgid = (xcd < r ? xcd * (q + 1) : r * (q + 1) + (xcd - r) * q) + off; }
        const int nig = WGM * nN, gid = wgid / nig, fm = gid * WGM, gsz = (nM - fm) < WGM ? (nM - fm) : WGM;
        u.pm = fm + ((wgid % nig) % gsz); u.pn = (wgid % nig) / gsz; u.ex = 0; return true;
    }
    __device__ __forceinline__ void ptrs(const Gemm& g, const Unit& u, const char*& a, const char*& b) const {
        const size_t tstep = (size_t)BM * g.K * 2; a = (const char*)g.A + (size_t)u.pm * tstep; b = (const char*)g.Bt + (size_t)u.pn * tstep; }
};
struct BranchOrder {
    int nM, nN, nwg, G, c; size_t astride, bstride;
    __device__ void init(int M, int N, int G_, int c_, size_t as, size_t bs) { nM = M / BM; nN = N / BM; nwg = nM * nN; G = G_; c = c_; astride = as; bstride = bs; }
    __device__ bool next(int i, Unit& u) const {
        const int t = i / 3, m = i - 3 * t;
        const long L = (long)t * G + c; if (L >= nwg) return false;
        int wgid = (int)L; { const int q = nwg / NXCD, r = nwg % NXCD, xcd = wgid % NXCD, off = wgid / NXCD; wgid = (xcd < r ? xcd * (q + 1) : r * (q + 1) + (xcd - r) * q) + off; }
        const int nig = WGM * nN, gid = wgid / nig, fm = gid * WGM, gsz = (nM - fm) < WGM ? (nM - fm) : WGM;
        u.pm = fm + ((wgid % nig) % gsz); u.pn = (wgid % nig) / gsz; u.ex = m; return true;
    }
    __device__ __forceinline__ void ptrs(const Gemm& g, const Unit& u, const char*& a, const char*& b) const {
        const size_t tstep = (size_t)BM * g.K * 2; a = (const char*)g.A + (size_t)u.ex * astride + (size_t)u.pm * tstep; b = (const char*)g.Bt + (size_t)u.ex * bstride + (size_t)u.pn * tstep; }
};
struct MoeOrder {
    int G, c, npn, ntiles; const LAS unsigned char* tab; size_t estride;
    __device__ bool next(int i, Unit& u) const {
        const long L = (long)i * G + c; if (L >= (long)ntiles * npn) return false;
        u.pm = (int)(L / npn); u.pn = (int)(L % npn); u.ex = (int)tab[u.pm]; return true;
    }
    __device__ __forceinline__ void ptrs(const Gemm& g, const Unit& u, const char*& a, const char*& b) const {
        const size_t tstep = (size_t)BM * g.K * 2; a = (const char*)g.A + (size_t)u.pm * tstep; b = (const char*)g.Bt + (size_t)u.ex * estride + (size_t)u.pn * tstep; }
};

template <class Epi, class Sched>
__device__ __forceinline__ void gemm_phase(LAS unsigned char* lds, const int tid, const Gemm g, const Sched& S, const Epi& E) {
    const int wid = __builtin_amdgcn_readfirstlane(tid >> 6), lane = tid & 63, wr = wid >> 2, wc = wid & 3, fr = lane & 15, fq = lane >> 4;
    int K = g.K; asm volatile("" : "+s"(K));
    const int nt = K / BK;
    unsigned voffA[2], voffB[2];
#pragma unroll
    for (int i = 0; i < 2; ++i) { int R, C; stage_rc(tid * 16 + i * 8192, R, C); const int Rb = Epi::PERM ? ((R & ~31) + perm32(R & 31)) : R;
        voffA[i] = (unsigned)(R * K + C) * 2u; voffB[i] = (unsigned)(Rb * K + C) * 2u; }
    const size_t kstep = (size_t)(BK * 2);
    const size_t hstep = (size_t)HALF * K * 2;
    const unsigned ldsw = (unsigned)wid * 1024u;
    const int aoff = lds_byte(wr * 64 + fr, fq * 8), boff = lds_byte(wc * 32 + fr, fq * 8);
#define PG8_SA(b, h) (((b) * 2 + (h)) * HTB)
#define PG8_SB(b, h) ((4 + (b) * 2 + (h)) * HTB)
#define PG8_STAGE(bufoff, gbase, voff) do { _Pragma("unroll") for (int _i = 0; _i < 2; ++_i) \
        __builtin_amdgcn_global_load_lds((const unsigned*)((const char*)(gbase) + (voff)[_i]), (LAS unsigned*)(lds + (bufoff) + ldsw + _i * 8192), 16, 0, 0); } while (0)
#define PG8_LDA(dst, b, h) do { _Pragma("unroll") for (int m = 0; m < 4; ++m) _Pragma("unroll") for (int k = 0; k < 2; ++k) dst[m][k] = *(const LAS bf16x8*)(lds + PG8_SA(b, h) + aoff + m * 2048 + k * 1024); } while (0)
#define PG8_LDB(dst, b, h) do { _Pragma("unroll") for (int n = 0; n < 2; ++n) _Pragma("unroll") for (int k = 0; k < 2; ++k) dst[n][k] = *(const LAS bf16x8*)(lds + PG8_SB(b, h) + boff + n * 2048 + k * 1024); } while (0)
#define PG8_MMA(ai, bj, At, Bt) do { __builtin_amdgcn_s_setprio(1); _Pragma("unroll") for (int m = 0; m < 4; ++m) _Pragma("unroll") for (int n = 0; n < 2; ++n) _Pragma("unroll") for (int k = 0; k < 2; ++k) \
        acc[ai][bj][m][n] = __builtin_amdgcn_mfma_f32_16x16x32_bf16(Bt[n][k], At[m][k], acc[ai][bj][m][n], 0, 0, 0); __builtin_amdgcn_s_setprio(0); } while (0)
#define PG8_WAIT_V(n) asm volatile("s_waitcnt vmcnt(" #n ")" ::: "memory")
#define PG8_WAIT_L(n) asm volatile("s_waitcnt lgkmcnt(" #n ")" ::: "memory")
#define PG8_BAR __builtin_amdgcn_s_barrier()
#define PG8_SCHED __builtin_amdgcn_sched_barrier(0)
    Unit cur, nxt; int ui = 0;
    if (!S.next(0, cur)) return;
    f32x4 acc[2][2][4][2];
#pragma unroll
    for (int a = 0; a < 2; ++a)
#pragma unroll
        for (int b = 0; b < 2; ++b)
#pragma unroll
            for (int m = 0; m < 4; ++m)
#pragma unroll
                for (int n = 0; n < 2; ++n) acc[a][b][m][n] = (f32x4){0.f, 0.f, 0.f, 0.f};
    bf16x8 At[4][2], B0[2][2], B1[2][2];
    const char* cA; const char* cB; S.ptrs(g, cur, cA, cB);
    PG8_STAGE(PG8_SB(0, 0), cB, voffB); PG8_STAGE(PG8_SA(0, 0), cA, voffA); PG8_STAGE(PG8_SB(0, 1), cB + hstep, voffB); PG8_STAGE(PG8_SA(0, 1), cA + hstep, voffA);
    if (wr == 1) PG8_BAR;
    PG8_WAIT_V(4); PG8_BAR;
    PG8_STAGE(PG8_SB(1, 0), cB + kstep, voffB); PG8_STAGE(PG8_SA(1, 0), cA + kstep, voffA); PG8_STAGE(PG8_SB(1, 1), cB + hstep + kstep, voffB);
    PG8_WAIT_V(6); PG8_BAR;
    for (;;) {
        const bool has_next = S.next(ui + 1, nxt);
        const char* nA = cA; const char* nB = cB; if (has_next) S.ptrs(g, nxt, nA, nB);
        for (int t = 0; t < nt; t += 2) {
            const bool last = (t == nt - 2);
            const char* a1 = cA + (size_t)(t + 1) * kstep;
            const char* a2 = last ? nA : cA + (size_t)(t + 2) * kstep; const char* b2 = last ? nB : cB + (size_t)(t + 2) * kstep;
            const char* a3 = a2 + kstep; const char* b3 = b2 + kstep;
            PG8_LDB(B0, 0, 0); PG8_SCHED; PG8_LDA(At, 0, 0); PG8_STAGE(PG8_SA(1, 1), a1 + hstep, voffA);
            PG8_WAIT_L(8); PG8_BAR; PG8_WAIT_L(0); PG8_MMA(0, 0, At, B0); PG8_BAR; PG8_SCHED;
            PG8_LDB(B1, 0, 1); PG8_STAGE(PG8_SB(0, 0), b2, voffB);
            PG8_BAR; PG8_WAIT_L(0); PG8_MMA(0, 1, At, B1); PG8_BAR;
            PG8_LDA(At, 0, 1); PG8_STAGE(PG8_SA(0, 0), a2, voffA);
            PG8_BAR; PG8_WAIT_L(0); PG8_MMA(1, 0, At, B0); PG8_BAR; PG8_SCHED;
            PG8_STAGE(PG8_SB(0, 1), b2 + hstep, voffB);
            PG8_WAIT_V(6); PG8_BAR; PG8_MMA(1, 1, At, B1); PG8_BAR;
            PG8_LDB(B0, 1, 0); PG8_SCHED; PG8_LDA(At, 1, 0); PG8_STAGE(PG8_SA(0, 1), a2 + hstep, voffA);
            PG8_WAIT_L(8); PG8_BAR; PG8_WAIT_L(0); PG8_MMA(0, 0, At, B0); PG8_BAR; PG8_SCHED;
            PG8_LDB(B1, 1, 1); PG8_STAGE(PG8_SB(1, 0), b3, voffB);
            PG8_BAR; PG8_WAIT_L(0); PG8_MMA(0, 1, At, B1); PG8_BAR;
            PG8_LDA(At, 1, 1); PG8_STAGE(PG8_SA(1, 0), a3, voffA);
            PG8_BAR; PG8_WAIT_L(0); PG8_MMA(1, 0, At, B0); PG8_BAR; PG8_SCHED;
            PG8_STAGE(PG8_SB(1, 1), b3 + hstep, voffB);
            PG8_WAIT_V(6); PG8_BAR; PG8_MMA(1, 1, At, B1); PG8_BAR;
        }
        E(acc, cur, wr, wc, fr, fq);
        if (!has_next) break;
#pragma unroll
        for (int a = 0; a < 2; ++a)
#pragma unroll
            for (int b = 0; b < 2; ++b)
#pragma unroll
                for (int m = 0; m < 4; ++m)
#pragma unroll
                    for (int n = 0; n < 2; ++n) acc[a][b][m][n] = (f32x4){0.f, 0.f, 0.f, 0.f};
        cur = nxt; cA = nA; cB = nB; ++ui;
    }
    PG8_WAIT_V(0);
    if (wr == 0) PG8_BAR;
    PG8_BAR;
#undef PG8_SA
#undef PG8_SB
#undef PG8_STAGE
#undef PG8_LDA
#undef PG8_LDB
#undef PG8_MMA
#undef PG8_WAIT_V
#undef PG8_WAIT_L
#undef PG8_BAR
#undef PG8_SCHED
}

#define EPI_PERM_LOOP(...) \
    _Pragma("unroll") for (int ai = 0; ai < 2; ++ai) _Pragma("unroll") for (int m = 0; m < 4; ++m) { const int row = u.pm * BM + ai * HALF + wr * 64 + m * 16 + fr; \
        _Pragma("unroll") for (int bj = 0; bj < 2; ++bj) { const int col0 = u.pn * BM + bj * HALF + wc * 32 + 8 * fq; f32x4 v0 = acc[ai][bj][m][0], v1 = acc[ai][bj][m][1]; __VA_ARGS__ } if (EPI_PIN) __builtin_amdgcn_sched_barrier(0); }

struct EpiInProj {
    static constexpr bool PERM = true, EPI_PIN = true;
    bf16_t* P; bf16_t* halo;
    __device__ __forceinline__ void operator()(const f32x4 (&acc)[2][2][4][2], const Unit& u, int wr, int wc, int fr, int fq) const {
        const bool is_qkv = u.pn >= 8 && u.pn < 14;
        EPI_PERM_LOOP({
            u32x4 w; w.x = pk2(v0[0], v0[1]); w.y = pk2(v0[2], v0[3]); w.z = pk2(v1[0], v1[1]); w.w = pk2(v1[2], v1[3]);
            *(u32x4*)(P + (size_t)row * LDP + col0) = w;
            if (is_qkv && (row & 63) >= 61) *(u32x4*)(halo + ((size_t)(row >> 6) * 3 + ((row & 63) - 61)) * 1536 + (col0 - PC_BQKV)) = w;
        })
    }
};
__device__ __forceinline__ float lfg(float lb, float oml, float x) { return __logf(lb + oml * __builtin_amdgcn_rcpf(1.0f + __expf(-x)) + 1e-30f); }
struct EpiSigmoid {
    static constexpr bool PERM = true, EPI_PIN = true;
    bf16_t* O; int ldc;
    __device__ __forceinline__ void operator()(const f32x4 (&acc)[2][2][4][2], const Unit& u, int wr, int wc, int fr, int fq) const {
        EPI_PERM_LOOP({
            u32x4 w; w.x = pk2(sigmoidf_(v0[0]), sigmoidf_(v0[1])); w.y = pk2(sigmoidf_(v0[2]), sigmoidf_(v0[3])); w.z = pk2(sigmoidf_(v1[0]), sigmoidf_(v1[1])); w.w = pk2(sigmoidf_(v1[2]), sigmoidf_(v1[3]));
            *(u32x4*)(O + (size_t)row * ldc + col0) = w;
        })
    }
};
struct EpiBranch {
    static constexpr bool PERM = true, EPI_PIN = false;
    bf16_t* merged; const bf16_t* gt;
    __device__ __forceinline__ void operator()(const f32x4 (&acc)[2][2][4][2], const Unit& u, int wr, int wc, int fr, int fq) const {
        const int n = u.ex;
        EPI_PERM_LOOP({
            const u32x4 gw = *(const u32x4*)(gt + (size_t)row * 3072 + n * 1024 + col0);
            float x[8] = {v0[0] * bflo(gw.x), v0[1] * bfhi(gw.x), v0[2] * bflo(gw.y), v0[3] * bfhi(gw.y), v1[0] * bflo(gw.z), v1[1] * bfhi(gw.z), v1[2] * bflo(gw.w), v1[3] * bfhi(gw.w)};
            bf16_t* mp = merged + (size_t)row * 1024 + col0;
            if (n != 0) { const u32x4 o = *(const u32x4*)mp; x[0] += bflo(o.x); x[1] += bfhi(o.x); x[2] += bflo(o.y); x[3] += bfhi(o.y); x[4] += bflo(o.z); x[5] += bfhi(o.z); x[6] += bflo(o.w); x[7] += bfhi(o.w); }
            u32x4 w; w.x = pk2(x[0], x[1]); w.y = pk2(x[2], x[3]); w.z = pk2(x[4], x[5]); w.w = pk2(x[6], x[7]);
            *(u32x4*)mp = w;
        })
    }
};
struct EpiResidual {
    static constexpr bool PERM = false;
    float* hreal; float* hmeta;
    __device__ __forceinline__ void operator()(const f32x4 (&acc)[2][2][4][2], const Unit& u, int wr, int wc, int fr, int fq) const {
#pragma unroll
        for (int ai = 0; ai < 2; ++ai)
#pragma unroll
            for (int m = 0; m < 4; ++m) { const int row = u.pm * BM + ai * HALF + wr * 64 + m * 16 + fr;
                float* rowp = (row < NREAL ? hreal + (size_t)row * D : hmeta + (size_t)(row - NREAL) * D) + u.pn * BM + wc * 32 + 4 * fq;
#pragma unroll
                for (int bj = 0; bj < 2; ++bj)
#pragma unroll
                    for (int n = 0; n < 2; ++n) { f32x4* p = (f32x4*)(rowp + bj * HALF + n * 16); *p = *p + acc[ai][bj][m][n]; } }
    }
};
struct EpiMoeUp {
    static constexpr bool PERM = true, EPI_PIN = true;
    bf16_t* H;
    __device__ __forceinline__ void operator()(const f32x4 (&acc)[2][2][4][2], const Unit& u, int wr, int wc, int fr, int fq) const {
        EPI_PERM_LOOP({
            const int hc = col0 >> 1;
            u32x2 w; w.x = pk2(siluf_(v0[0]) * v1[0], siluf_(v0[1]) * v1[1]); w.y = pk2(siluf_(v0[2]) * v1[2], siluf_(v0[3]) * v1[3]);
            *(u32x2*)(H + (size_t)row * 256 + hc) = w;
        })
    }
};
struct EpiMoeDown {
    static constexpr bool PERM = true, EPI_PIN = false;
    bf16_t* Y; const float* wrow;
    __device__ __forceinline__ void operator()(const f32x4 (&acc)[2][2][4][2], const Unit& u, int wr, int wc, int fr, int fq) const {
        EPI_PERM_LOOP({
            const float s = wrow[row];
            u32x4 w; w.x = pk2(v0[0] * s, v0[1] * s); w.y = pk2(v0[2] * s, v0[3] * s); w.z = pk2(v1[0] * s, v1[1] * s); w.w = pk2(v1[2] * s, v1[3] * s);
            *(u32x4*)(Y + (size_t)row * 1024 + col0) = w;
        })
    }
};
}
#define GAS __attribute__((address_space(1)))
struct Params { const float* in[24]; float* out; unsigned char* ws; int ph_lo, ph_hi; };
struct Frame {
    LAS unsigned char* lds; int tid, lane, wave, G, bid;
    __attribute__((address_space(1))) float* out; __attribute__((address_space(1))) unsigned char* ws; const float* const __attribute__((address_space(4)))* inp; int dry;
};
#define PHASE_FENCE(F) do { asm volatile("" : "+s"((F).ws), "+s"((F).out), "+s"((F).inp), "+v"((F).tid), "+s"((F).bid), "+s"((F).G)); \
    (F).lane = (F).tid & 63; (F).wave = __builtin_amdgcn_readfirstlane((F).tid >> 6); } while (0)
__device__ __forceinline__ const float* inp_ptr(const float* const __attribute__((address_space(4)))* inp, int i) { GAS const float* q = (GAS const float*)inp[i]; asm volatile("" : "+s"(q)); return (const float*)q; }
#define INP(i) inp_ptr(F.inp, (i))
#define WSP(T, off) ((T*)(GAS T*)(F.ws + (off)))
enum { I_X = 0, I_META, I_NORM_MIX, I_W_IN, I_LB, I_HGRN_NORM, I_GDN_CONV, I_GDN_ALOG, I_GDN_DT, I_GDN_NORM, I_GLA_W2, I_GLA_B, I_GLA_NORM, I_W_BRANCH, I_W_OUT, I_NORM_FFN,
       I_RG_W, I_RG_B, I_RE_W, I_RE_B, I_EW_GATE, I_EW_UP, I_EW_DOWN, I_NORM_FINAL };

struct TItem { const float* W; bf16_t* WT; int ldw, K, nblk, rowmode, item; };
__device__ __forceinline__ void titem_load(const TItem& t, int lane, f32x4 (&v)[8]) {
    const int kb = t.item / t.nblk, nb = t.item % t.nblk, k0 = 64 * kb, n0 = 32 * nb, n4 = 4 * (lane & 7);
#pragma unroll
    for (int i = 0; i < 8; ++i) v[i] = *(const f32x4*)(t.W + (size_t)(k0 + 8 * i + (lane >> 3)) * t.ldw + n0 + n4);
}
__device__ __forceinline__ void titem_finish(const TItem& t, int lane, const f32x4 (&v)[8], LAS float* scr) {
    const int kb = t.item / t.nblk, nb = t.item % t.nblk, k0 = 64 * kb, n0 = 32 * nb, n4 = 4 * (lane & 7);
#pragma unroll
    for (int i = 0; i < 8; ++i) { LAS float* d = scr + (8 * i + (lane >> 3)) * 33 + n4; d[0] = v[i][0]; d[1] = v[i][1]; d[2] = v[i][2]; d[3] = v[i][3]; }
    LDS_WAIT(); asm volatile("" ::: "memory");
    const int c = lane & 7;
#pragma unroll
    for (int j = 0; j < 4; ++j) { const int n = (lane >> 3) + 8 * j; const LAS float* s = scr + (8 * c) * 33 + n;
        u32x4 o; o.x = pk2(s[0 * 33], s[1 * 33]); o.y = pk2(s[2 * 33], s[3 * 33]); o.z = pk2(s[4 * 33], s[5 * 33]); o.w = pk2(s[6 * 33], s[7 * 33]);
        const int nn = n0 + n; const int wrow = t.rowmode == 0 ? nn : 8 * (nn >> 2) + (nn & 3) + (t.rowmode == 2 ? 4 : 0);
        *(u32x4*)(t.WT + (size_t)wrow * t.K + k0 + 8 * c) = o; }
    LDS_WAIT(); asm volatile("" ::: "memory");
}
#define CONVERT_LOOP(NITEMS, RESOLVE) do { LAS float* scr = (LAS float*)(F.lds + F.wave * 17408); const int gw = F.bid * NWAVES + F.wave, NGW = F.G * NWAVES; \
    for (int it = gw; it < (NITEMS); it += 2 * NGW) { const bool two = it + NGW < (NITEMS); TItem ta = RESOLVE(it), tb = RESOLVE(two ? it + NGW : it); f32x4 va[8], vb[8]; \
        titem_load(ta, F.lane, va); if (two) titem_load(tb, F.lane, vb); \
        titem_finish(ta, F.lane, va, scr); if (two) titem_finish(tb, F.lane, vb, scr + 64 * 33 + 32); } } while (0)

__device__ __forceinline__ void phase_pre(Frame& F) {
    const int gt = F.bid * NTHREADS + F.tid, NT = F.G * NTHREADS;
    float* sw1 = WSP(float, SM_SW1); float* rwg = WSP(float, SM_RWG); float* rwe = WSP(float, SM_RWE); float* lab = WSP(float, SM_LAB);
    for (int i = gt; i < 2 * 24 * 1024; i += NT) { const int l = i / (24 * 1024), c = (i / 1024) % 24, k = i % 1024;
        const int col = c < 16 ? 5128 + c : (c < 20 ? 3584 + (c - 16) : 3588 + (c - 20));
        sw1[i] = INP(I_W_IN)[((size_t)l * 1024 + k) * IN_COLS + col]; }
    for (int i = gt; i < 2 * 4 * 1024; i += NT) { const int l = i / (4 * 1024), c = (i / 1024) % 4, k = i % 1024; rwg[i] = INP(I_RG_W)[((size_t)l * 1024 + k) * 4 + c]; }
    for (int i = gt; i < 2 * 32 * 1024; i += NT) { const int l = i / (32 * 1024), c = (i / 1024) % 32, k = i % 1024; rwe[i] = INP(I_RE_W)[((size_t)l * 1024 + k) * 32 + c]; }
    for (int i = gt; i < 2 * 512; i += NT) { const int l = i / 512, c = i % 512; const float l0 = INP(I_LB)[c], l1 = INP(I_LB)[512 + c];
        const float p1 = 1.0f / (1.0f + expf(l0 - l1)); const float lb = l == 0 ? 0.f : p1;
        lab[l * 1024 + c] = lb; lab[l * 1024 + 512 + c] = 1.0f - lb; }
}

__device__ __forceinline__ void convert_layer_weights(Frame& F, int l) {
    const float* win = INP(I_W_IN) + (size_t)l * 1024 * IN_COLS;
    constexpr int I_MIX = 16 * 176, I_GATE = 16 * 96, I_BR = 8 * 32, I_OUT = 16 * 32, NITEMS = I_MIX + I_GATE + 3 * I_BR + I_OUT;
    auto resolve = [&](int it) { int r = it; TItem t;
        if (r < I_MIX) { const int nb = r % 176, n0 = 32 * nb; const int shift = n0 < 3584 ? 0 : (n0 < 5120 ? 8 : 24);
            t = TItem{win + shift, WSP(bf16_t, WS_WMIX), IN_COLS, 1024, 176, 0, r}; return t; } r -= I_MIX;
        if (r < I_GATE) { t = TItem{win + 5656, WSP(bf16_t, WS_WGATE), IN_COLS, 1024, 96, 0, r}; return t; } r -= I_GATE;
        if (r < 3 * I_BR) { const int n = r / I_BR; t = TItem{INP(I_W_BRANCH) + ((size_t)l * 3 + n) * 512 * 1024, WSP(bf16_t, WS_WBT) + (size_t)n * 1024 * 512, 1024, 512, 32, 0, r % I_BR}; return t; } r -= 3 * I_BR;
        t = TItem{INP(I_W_OUT) + (size_t)l * 1024 * 1024, WSP(bf16_t, WS_WOT), 1024, 1024, 32, 0, r}; return t; };
    CONVERT_LOOP(NITEMS, resolve);
}
__device__ __forceinline__ void convert_expert_weights(Frame& F, int l) {
    constexpr int I_G = 16 * 8, I_D = 4 * 32, PER = 2 * I_G + I_D;
    auto resolve = [&](int it) { const int e = it / PER; int r = it % PER; TItem t;
        bf16_t* w1t = WSP(bf16_t, WS_W1T) + (size_t)e * 512 * 1024; bf16_t* w2t = WSP(bf16_t, WS_W2T) + (size_t)e * 1024 * 256;
        if (r < I_G) { t = TItem{INP(I_EW_GATE) + ((size_t)l * 32 + e) * 1024 * 256, w1t, 256, 1024, 8, 1, r}; return t; } r -= I_G;
        if (r < I_G) { t = TItem{INP(I_EW_UP) + ((size_t)l * 32 + e) * 1024 * 256, w1t, 256, 1024, 8, 2, r}; return t; } r -= I_G;
        t = TItem{INP(I_EW_DOWN) + ((size_t)l * 32 + e) * 256 * 1024, w2t, 1024, 256, 32, 0, r}; return t; };
    CONVERT_LOOP(32 * PER, resolve);
}

#define OUTP ((float*)F.out)
__device__ __forceinline__ float* hrow(Frame& F, int r) { return r < NREAL ? OUTP + (size_t)r * D : WSP(float, WS_HMETA) + (size_t)(r - NREAL) * D; }

__device__ __forceinline__ void load_row16(const float* p, int lane, float (&x)[16]) {
#pragma unroll
    for (int j = 0; j < 4; ++j) { const f32x4 v = *((const f32x4*)p + lane + 64 * j); x[4 * j] = v[0]; x[4 * j + 1] = v[1]; x[4 * j + 2] = v[2]; x[4 * j + 3] = v[3]; }
}
__device__ __forceinline__ void add_bf16_row16(const bf16_t* p, int lane, float (&x)[16]) {
#pragma unroll
    for (int j = 0; j < 4; ++j) { const u32x2 w = *((const u32x2*)p + lane + 64 * j); x[4 * j] += bflo(w.x); x[4 * j + 1] += bfhi(w.x); x[4 * j + 2] += bflo(w.y); x[4 * j + 3] += bfhi(w.y); }
}
__device__ __forceinline__ void store_row16(float* p, int lane, const float (&x)[16]) {
#pragma unroll
    for (int j = 0; j < 4; ++j) *((f32x4*)p + lane + 64 * j) = (f32x4){x[4 * j], x[4 * j + 1], x[4 * j + 2], x[4 * j + 3]};
}
__device__ __forceinline__ void store_bf16_row16(bf16_t* p, int lane, const float (&x)[16]) {
#pragma unroll
    for (int j = 0; j < 4; ++j) { u32x2 w; w.x = pk2(x[4 * j], x[4 * j + 1]); w.y = pk2(x[4 * j + 2], x[4 * j + 3]); *((u32x2*)p + lane + 64 * j) = w; }
}
__device__ __forceinline__ void fetch_h_row(Frame& F, int l, int r, float (&x)[16]) {
    if (l == 0) {
        const float* src = r < NREAL ? INP(I_X) + (size_t)r * D : INP(I_META) + (size_t)(r - META_ROW0) * D;
        load_row16(src, F.lane, x);
    } else {
        load_row16(hrow(F, r), F.lane, x);
        const unsigned* tok = WSP(unsigned, SM_TOK) + (size_t)r * 8;
        const unsigned g0 = tok[6], g1 = tok[7];
        add_bf16_row16(WSP(bf16_t, WS_Y2) + (size_t)g0 * 1024, F.lane, x);
        add_bf16_row16(WSP(bf16_t, WS_Y2) + (size_t)g1 * 1024, F.lane, x);
    }
}

template <int N> struct IntC { static constexpr int value = N; };
__device__ __forceinline__ void phase_norm1(Frame& F, int l) {
    PROF_MARK(F, 40);
    convert_layer_weights(F, l);
    __syncthreads();
    PROF_MARK(F, 41);
    LAS float* sw = (LAS float*)F.lds;
    { const float* src = WSP(float, SM_SW1) + (size_t)l * 24 * 1024; for (int i = F.tid; i < 24 * 1024 / 4; i += NTHREADS) ((LAS f32x4*)sw)[i] = ((const f32x4*)src)[i]; }
    __syncthreads();
    const int gw = F.bid * NWAVES + F.wave, NGW = F.G * NWAVES, lane = F.lane;
    const float* nw = INP(I_NORM_MIX) + (size_t)l * D;
    float wv[16]; load_row16(nw, lane, wv);
    bf16_t* U = WSP(bf16_t, WS_U);
    const float alog_l = (lane >= 20 && lane < 24) ? INP(I_GDN_ALOG)[l * 4 + (lane - 20)] : 0.f, dt_l = (lane >= 20 && lane < 24) ? INP(I_GDN_DT)[l * 4 + (lane - 20)] : 0.f;
    const float nega_l = -expf(alog_l);
    float* GK = WSP(float, SM_GK); float* BETA = WSP(float, SM_BETA); float* LOGA = WSP(float, SM_LOGA);
    auto body = [&](auto NRc, const int r0) {
        constexpr int NR = decltype(NRc)::value;
        float x[NR][16];
#pragma unroll
        for (int i = 0; i < NR; ++i) {
            fetch_h_row(F, l, r0 + i, x[i]);
            store_row16(hrow(F, r0 + i), lane, x[i]);
            float ss = 0.f;
#pragma unroll
            for (int j = 0; j < 16; ++j) ss += x[i][j] * x[i][j];
            const float rstd = rsqrtf(wave_sum(ss) * (1.0f / D) + 1e-6f);
#pragma unroll
            for (int j = 0; j < 16; ++j) x[i][j] = x[i][j] * rstd * wv[j];
            store_bf16_row16(U + (size_t)(r0 + i) * D, lane, x[i]);
        }
        float ov[NR];
#pragma unroll
        for (int i = 0; i < NR; ++i) ov[i] = 0.f;
#pragma unroll 2
        for (int c = 0; c < 24; ++c) {
            float a[NR];
#pragma unroll
            for (int i = 0; i < NR; ++i) a[i] = 0.f;
#pragma unroll
            for (int j = 0; j < 4; ++j) { const f32x4 w = *((const LAS f32x4*)(sw + c * 1024) + lane + 64 * j);
#pragma unroll
                for (int e = 0; e < 4; ++e) {
#pragma unroll
                    for (int i = 0; i < NR; ++i) a[i] += x[i][4 * j + e] * w[e]; } }
#pragma unroll
            for (int i = 0; i < NR; ++i) { a[i] = wave_sum(a[i]); if (lane == c) ov[i] = a[i]; }
        }
#pragma unroll
        for (int i = 0; i < NR; ++i) {
            const float v = ov[i]; const int r = r0 + i;
            if (lane < 16) GK[(size_t)r * 16 + lane] = v;
            else if (lane < 20) BETA[(size_t)r * 4 + (lane - 16)] = sigmoidf_(v);
            else if (lane < 24) { const int h = lane - 20; LOGA[(size_t)r * 4 + h] = nega_l * softplusf_(v + dt_l); }
        }
    };
    for (int g = gw; g < NREAL / 4; g += NGW) body(IntC<4>{}, 4 * g);
    if (gw >= NGW - 16) body(IntC<1>{}, META_ROW0 + (NGW - 1 - gw));
    for (int r = NREAL + gw; r < MROWS; r += NGW) {
        if (row_valid(r)) continue;
        float z[16];
#pragma unroll
        for (int j = 0; j < 16; ++j) z[j] = 0.f;
        store_bf16_row16(U + (size_t)r * D, lane, z); if (l == 0) store_row16(hrow(F, r), lane, z);
        if (lane < 16) GK[(size_t)r * 16 + lane] = 0.f;
        else if (lane < 20) BETA[(size_t)r * 4 + (lane - 16)] = 0.f;
        else if (lane < 24) LOGA[(size_t)r * 4 + (lane - 20)] = 0.f;
    }
}

__device__ __forceinline__ bf16x8 mk8(u32x4 w) { return __builtin_bit_cast(bf16x8, w); }
__device__ __forceinline__ bf16x8 mk8(u32x2 lo, u32x2 hi) { u32x4 w; w.x = lo.x; w.y = lo.y; w.z = hi.x; w.w = hi.y; return __builtin_bit_cast(bf16x8, w); }
__device__ __forceinline__ bf16x8 pack_acc2(const f32x4& a, const f32x4& b) { u32x4 w; w.x = pk2(a[0], a[1]); w.y = pk2(a[2], a[3]); w.z = pk2(b[0], b[1]); w.w = pk2(b[2], b[3]); return __builtin_bit_cast(bf16x8, w); }
#define MFMA16(a, b, c) __builtin_amdgcn_mfma_f32_16x16x32_bf16((a), (b), (c), 0, 0, 0)

__device__ __forceinline__ int permpos(int k) { const int kk = k & 31; return (k & ~31) + ((kk & 16) ? 8 * ((kk - 16) >> 2) + 4 + (kk & 3) : 8 * (kk >> 2) + (kk & 3)); }
__device__ __forceinline__ float ldbf(GAS const bf16_t* p) { return bf2f(*p); }
#define ROWB(P, row, col) ((GAS const char*)(P) + ((size_t)(row) * LDP + (col)) * 2)
__device__ __forceinline__ float ldrow(GAS const char* rb, unsigned voff) { return bf2f(*(GAS const bf16_t*)(rb + voff)); }
__device__ __forceinline__ unsigned ldrow_u(GAS const char* rb, unsigned voff) { return (unsigned)*(GAS const bf16_t*)(rb + voff); }
__device__ __forceinline__ void strow(GAS const char* rb, unsigned voff, bf16_t v) { *(GAS bf16_t*)(rb + voff) = v; }

template <int DK, bool IS_A>
__device__ __forceinline__ void prep_gla(Frame& F, int l, int ug) {
    constexpr int QP = DK + 8, VP = 136, SUB = 2 * 64 * QP * 2 + 1024 + 4096 + 64 * VP * 2;
    PROF_MARK(F, IS_A ? 7 : 8);
    int tid = F.tid; asm volatile("" : "+v"(tid));
    const int sg = __builtin_amdgcn_readfirstlane(tid >> 8), lt = tid & 255, c = lt & 127, hf = __builtin_amdgcn_readfirstlane(lt >> 7);
    const int unit = 2 * ug + sg, slot = unit >> 2, h = unit & 3, row0 = slot * 64, r0 = row0 + 32 * hf;
    const int qcol = IS_A ? PC_AQ + h * 128 : PC_CQ + h * 64, kcol = IS_A ? PC_AF + h * 128 : PC_CK + h * 64, vcol = IS_A ? PC_AI + h * 128 : PC_CV + h * 128;
    bf16_t* P = WSP(bf16_t, WS_P);
    LAS bf16_t* qt = (LAS bf16_t*)(F.lds + sg * SUB);
    LAS bf16_t* kt = qt + 64 * QP;
    LAS float* tot = (LAS float*)(kt + 64 * QP);
    const bool act = c < DK;
    LAS bf16_t* rv = (LAS bf16_t*)(tot + 256 + 1024);
    float w2c[16], bias = 0.f;
    if (!IS_A && c < DK) { const float* w2 = INP(I_GLA_W2) + (size_t)l * 16 * 256 + h * 64 + c; bias = INP(I_GLA_B)[l * 256 + h * 64 + c];
#pragma unroll
        for (int j = 0; j < 16; ++j) w2c[j] = w2[j * 256]; }
    { constexpr int PQ = DK / 8, PPR = 2 * PQ + 16;
        for (int idx = lt; idx < 64 * PPR; idx += 256) { const int row = idx / PPR, pc = idx % PPR;
            const int scol = pc < PQ ? qcol + 8 * pc : (pc < 2 * PQ ? kcol + 8 * (pc - PQ) : vcol + 8 * (pc - 2 * PQ));
            LAS bf16_t* dst = pc < PQ ? qt + row * QP + 8 * pc : (pc < 2 * PQ ? kt + row * QP + 8 * (pc - PQ) : rv + row * VP + 8 * (pc - 2 * PQ));
            *(LAS u32x4*)dst = *(const u32x4*)(P + (size_t)(row0 + row) * LDP + scol); } }
    if (!IS_A) { LAS float* gkl = tot + 256;
        ((LAS f32x4*)gkl)[lt] = ((const f32x4*)(WSP(float, SM_GK) + (size_t)row0 * 16))[lt]; }
    __syncthreads();
    PROF_MARKI(F, IS_A ? 29 : 19);
    float b[32];
    const unsigned vo = (unsigned)c * 2u, vop = (unsigned)permpos(c) * 2u;
    if (act) {
        float run = 0.f;
        if (IS_A) { const float* lab = WSP(float, SM_LAB) + l * 1024 + h * 128 + c; const float la = lab[0], lb = lab[512];
#pragma unroll
            for (int t = 0; t < 32; ++t) { run += pg8::lfg(la, lb, bf2f(kt[(32 * hf + t) * QP + c])); b[t] = run; }
        } else {
            const LAS f32x4* gk = (const LAS f32x4*)(tot + 256 + 32 * hf * 16);
#pragma unroll
            for (int tb = 0; tb < 32; tb += 4) { f32x4 g[16];
#pragma unroll
                for (int i = 0; i < 16; ++i) g[i] = gk[tb * 4 + i];
                asm volatile("" ::: "memory");
#pragma unroll
                for (int u = 0; u < 4; ++u) { float s = bias;
#pragma unroll
                    for (int j = 0; j < 16; ++j) s += g[4 * u + (j >> 2)][j & 3] * w2c[j];
                    run += logsigf_(s) * (1.0f / 16.0f); b[tb + u] = run; } }
        }
        tot[hf * 128 + c] = run;
    }
    __syncthreads();
    PROF_MARKI(F, IS_A ? 25 : 15);
    unsigned q1p[16], k1p[16];
    if (act) {
        const float bm = tot[c], bl = bm + tot[128 + c], boff = hf ? bm : 0.f;
        if (hf == 0 && !F.dry) (IS_A ? WSP(float, SM_DECA) + (size_t)unit * 128 : WSP(float, SM_DECC) + (size_t)unit * 64)[c] = __expf(bl);
#pragma unroll
        for (int t2 = 0; t2 < 16; ++t2) { float q1v[2], k1v[2];
#pragma unroll
            for (int u = 0; u < 2; ++u) { const int t = 2 * t2 + u; const float bt = b[t] + boff;
                const float qr = bf2f(qt[(32 * hf + t) * QP + c]), q = IS_A ? siluf_(qr) * 0.08838834764831845f : qr * 0.125f;
                float k;
                if (IS_A) { const float lf = t == 0 ? b[0] : b[t] - b[t - 1]; k = row_valid(r0 + t) ? 1.0f - __expf(lf) : 0.f; } else k = bf2f(kt[(32 * hf + t) * QP + c]);
                q1v[u] = q * __expf(bt); k1v[u] = k * __expf(bl - bt);
                qt[(32 * hf + t) * QP + c] = f2bf(q * __expf(fminf(bt - bm, 80.f))); kt[(32 * hf + t) * QP + c] = f2bf(k * __expf(fminf(bm - bt, 80.f))); }
            q1p[t2] = pk2(q1v[0], q1v[1]); k1p[t2] = pk2(k1v[0], k1v[1]); }
    }
    __syncthreads();
    PROF_MARKI(F, IS_A ? 26 : 16);
    if (act) {
        if (!F.dry) {
#pragma unroll
        for (int t2 = 0; t2 < 16; ++t2) { strow(ROWB(P, r0 + 2 * t2, qcol), vop, (bf16_t)(q1p[t2] & 0xffffu)); strow(ROWB(P, r0 + 2 * t2 + 1, qcol), vop, (bf16_t)(q1p[t2] >> 16)); } }
        bf16_t* kd = (IS_A ? P + (size_t)(row0 + (c >> 1)) * LDP + kcol + (c & 1) * 64 : P + (size_t)(row0 + c) * LDP + kcol) + 32 * hf;
#pragma unroll
        for (int o = 0; o < 4; ++o) if (!F.dry) *(u32x4*)(kd + 8 * o) = (u32x4){k1p[4 * o], k1p[4 * o + 1], k1p[4 * o + 2], k1p[4 * o + 3]};
    }
    { const int ws = (tid >> 6) & 3, lane = tid & 63, fr = lane & 15, fq = lane >> 4;
        bf16_t* sc = (IS_A ? WSP(bf16_t, WS_SCA) : WSP(bf16_t, WS_SCC)) + (size_t)unit * 4096;
#pragma unroll
        for (int jt = 0; jt < 4; ++jt) { const int mt = ws, nt = jt; f32x4 acc = {0.f, 0.f, 0.f, 0.f};
            if (nt <= mt) {
#pragma unroll
                for (int ks = 0; ks < DK / 32; ++ks) { const bf16x8 a = *(const LAS bf16x8*)(qt + (16 * mt + fr) * QP + 32 * ks + 8 * fq), bb = *(const LAS bf16x8*)(kt + (16 * nt + fr) * QP + 32 * ks + 8 * fq); acc = MFMA16(a, bb, acc); } }
#pragma unroll
            for (int r = 0; r < 4; ++r) { const int t = 16 * mt + 4 * fq + r, s = 16 * nt + fr; if (!F.dry) sc[t * 64 + s] = (s <= t) ? f2bf(acc[r]) : (bf16_t)0; } }
    }
    PROF_MARKI(F, IS_A ? 27 : 17);
    { unsigned vp[16];
#pragma unroll
        for (int t2 = 0; t2 < 16; ++t2) { vp[t2] = (unsigned)rv[(32 * hf + 2 * t2) * VP + c] | ((unsigned)rv[(32 * hf + 2 * t2 + 1) * VP + c] << 16); }
        PROF_MARKI(F, IS_A ? 28 : 18);
        bf16_t* vd = P + (size_t)(row0 + (c >> 1)) * LDP + vcol + (c & 1) * 64 + 32 * hf;
#pragma unroll
        for (int o = 0; o < 4; ++o) if (!F.dry) *(u32x4*)(vd + 8 * o) = (u32x4){vp[4 * o], vp[4 * o + 1], vp[4 * o + 2], vp[4 * o + 3]}; }
    __syncthreads();
    PROF_MARK(F, IS_A ? 13 : 14);
}

typedef float f32x2v __attribute__((ext_vector_type(2)));
__device__ __forceinline__ void prep_gdn(Frame& F, int l, int ug) {
    constexpr int NP = 136, SUB = 2 * 64 * NP * 2 + 64 * 68 * 4 + 1024 + 2304;
    PROF_MARK(F, 1);
    int tid = F.tid; asm volatile("" : "+v"(tid));
    const int lane = tid & 63, sg = __builtin_amdgcn_readfirstlane(tid >> 8), lt = tid & 255, unit = 2 * ug + sg, slot = unit >> 2, h = unit & 3, row0 = slot * 64;
    bf16_t* P = WSP(bf16_t, WS_P);
    LAS bf16_t* qs = (LAS bf16_t*)(F.lds + sg * SUB);
    LAS bf16_t* ks = qs + 64 * NP;
    LAS float* AT = (LAS float*)(F.lds + sg * SUB + 2 * 64 * NP * 2);
    LAS float* gs = AT + 64 * 68;
    if (lt < 64) { const int valid_u = 1; (void)valid_u; float g = WSP(float, SM_LOGA)[(size_t)(row0 + lt) * 4 + h];
#pragma unroll
        for (int o = 1; o < 64; o <<= 1) { const float t = __shfl_up(g, o); if (lane >= o) g += t; }
        gs[lt] = g; gs[64 + lt] = WSP(float, SM_BETA)[(size_t)(row0 + lt) * 4 + h];
        if (lt == 63 && !F.dry) WSP(float, SM_DECB)[unit] = __expf(g); }
    const int hslot = slot == 256 ? -1 : ((slot & 63) == 0 ? 256 : slot - 1);
    LAS bf16_t* rvs = (LAS bf16_t*)AT;
    LAS bf16_t* hl = (LAS bf16_t*)(gs + 256);
    for (int idx = lt; idx < 64 * 48; idx += 256) { const int row = idx / 48, pc = idx % 48, comp = pc >> 4, c8 = (pc & 15) * 8;
        const u32x4 v = *(const u32x4*)(P + (size_t)(row0 + row) * LDP + PC_BQKV + comp * 512 + h * 128 + c8);
        *(LAS u32x4*)((comp == 0 ? qs : (comp == 1 ? ks : rvs)) + row * NP + c8) = v; }
    if (lt < 144) { const int rr = lt / 48, pc = lt % 48, comp = pc >> 4, c8 = (pc & 15) * 8; u32x4 v = {0u, 0u, 0u, 0u};
        if (hslot >= 0) v = *(const u32x4*)(WSP(bf16_t, SM_HALO) + ((size_t)hslot * 3 + rr) * 1536 + comp * 512 + h * 128 + c8);
        *(LAS u32x4*)(hl + rr * 384 + comp * 128 + c8) = v; }
    __syncthreads();
    PROF_MARKG(F, 2);
    float col[64];
    {
        const int c = lt & 127;
#pragma unroll
        for (int pass = 0; pass < 2; ++pass) {
            if (pass == 1 && lt >= 128) break;
            const int comp = lt >= 128 ? 1 : (pass == 0 ? 0 : 2), ch = comp * 512 + h * 128 + c;
            const float w0 = INP(I_GDN_CONV)[((size_t)l * 4 + 0) * 1536 + ch], w1 = INP(I_GDN_CONV)[((size_t)l * 4 + 1) * 1536 + ch], w2 = INP(I_GDN_CONV)[((size_t)l * 4 + 2) * 1536 + ch], w3 = INP(I_GDN_CONV)[((size_t)l * 4 + 3) * 1536 + ch];
            LAS bf16_t* src = (comp == 0 ? qs : (comp == 1 ? ks : rvs)) + c;
            float x0 = bf2f(hl[comp * 128 + c]), x1 = bf2f(hl[384 + comp * 128 + c]), x2 = bf2f(hl[768 + comp * 128 + c]);
#pragma unroll
            for (int t = 0; t < 64; ++t) { const float x3 = bf2f(src[t * NP]); const float y = siluf_(w0 * x0 + w1 * x1 + w2 * x2 + w3 * x3); x0 = x1; x1 = x2; x2 = x3;
                if (comp == 0) src[t * NP] = f2bf(y); else { col[t] = y; if (comp == 1) src[t * NP] = f2bf(y); } }
        }
    }
    __syncthreads();
    PROF_MARKG(F, 3);
    const int wv = (tid >> 6) & 3, fr = lane & 15, fq = lane >> 4;
#pragma unroll
    for (int jt = 0; jt < 2; ++jt) { const int which = jt, mt = wv; const LAS bf16_t* ap = which ? qs : ks; f32x4 a4 = {0.f, 0.f, 0.f, 0.f};
#pragma unroll
        for (int k4 = 0; k4 < 4; ++k4) { const bf16x8 a = *(const LAS bf16x8*)(ap + (16 * mt + fr) * NP + 32 * k4 + 8 * fq); a4 = MFMA16(a, a, a4); }
#pragma unroll
        for (int r = 0; r < 4; ++r) if (4 * fq + r == fr) { if (which == 0) gs[128 + 16 * mt + fr] = rsqrtf(a4[r] + 1e-6f); else gs[192 + 16 * mt + fr] = rsqrtf(a4[r] + 1e-6f) * 0.08838834764831845f; } }
    __syncthreads();
    { bf16_t* qkd = WSP(bf16_t, WS_QKD) + (size_t)unit * 4096;
#pragma unroll
        for (int jt = 0; jt < 8; ++jt) { const int tile = wv * 8 + jt, which = tile >> 4, mt = (tile >> 2) & 3, nt = tile & 3;
            const LAS bf16_t* ap = which ? qs : ks; f32x4 a4 = {0.f, 0.f, 0.f, 0.f};
            if (nt <= mt) {
#pragma unroll
                for (int k4 = 0; k4 < 4; ++k4) { const bf16x8 a = *(const LAS bf16x8*)(ap + (16 * mt + fr) * NP + 32 * k4 + 8 * fq), bb = *(const LAS bf16x8*)(ks + (16 * nt + fr) * NP + 32 * k4 + 8 * fq); a4 = MFMA16(a, bb, a4); } }
#pragma unroll
            for (int r = 0; r < 4; ++r) { const int t = 16 * mt + 4 * fq + r, s = 16 * nt + fr; const float dec = __expf(fminf(gs[t] - gs[s], 0.f)) * gs[128 + s];
                if (which) { if (!F.dry) qkd[t * 64 + permpos(s)] = (s <= t) ? f2bf(a4[r] * dec * gs[192 + t]) : (bf16_t)0; }
                else AT[s * 68 + t] = (s < t) ? gs[64 + t] * gs[128 + t] * a4[r] * dec : 0.f; } }
    }
    PROF_MARKG(F, 4);
    if (lt >= 128) { const int d = lt - 128; const float gl = gs[63]; bf16_t* dst = WSP(bf16_t, WS_K1TB) + (size_t)unit * 8192 + d * 64;
#pragma unroll
        for (int o = 0; o < 8; ++o) { const int s0 = 32 * (o >> 2) + 4 * (o & 3); float y[8];
#pragma unroll
            for (int j = 0; j < 8; ++j) { const int s = s0 + (j & 3) + (j >> 2) * 16; y[j] = col[s] * gs[128 + s] * __expf(gl - gs[s]); }
            if (!F.dry) *(u32x4*)(dst + 8 * o) = (u32x4){pk2(y[0], y[1]), pk2(y[2], y[3]), pk2(y[4], y[5]), pk2(y[6], y[7])}; }
    } else { const int pp = permpos(lt);
#pragma unroll 8
        for (int t = 0; t < 64; ++t) if (!F.dry) P[(size_t)(row0 + t) * LDP + PC_BQKV + h * 128 + pp] = f2bf(bf2f(qs[t * NP + lt]) * gs[192 + t] * __expf(gs[t])); }
    __syncthreads();
    PROF_MARKG(F, 5);
#pragma unroll
    for (int i = 0; i < 64; ++i) col[i] *= lt < 128 ? gs[64 + i] : gs[64 + i] * gs[128 + i] * __expf(gs[i]);
    { f32x4 cur[16], nxt[16];
#pragma unroll
        for (int q4 = 0; q4 < 16; ++q4) cur[q4] = *(const LAS f32x4*)(AT + 4 * q4);
#pragma unroll
        for (int j = 0; j < 63; ++j) { const float xj = col[j]; const f32x2v nx = {-xj, -xj};
            if (j + 1 < 63) {
#pragma unroll
                for (int q4 = (j + 2) >> 2; q4 < 16; ++q4) nxt[q4] = *(const LAS f32x4*)(AT + (j + 1) * 68 + 4 * q4); }
            asm volatile("" ::: "memory");
#pragma unroll
            for (int q4 = (j + 1) >> 2; q4 < 16; ++q4) {
#pragma unroll
                for (int p = 0; p < 2; ++p) { const int i0 = 4 * q4 + 2 * p;
                    if (i0 > j) { f32x2v c = {col[i0], col[i0 + 1]}; const f32x2v a = {cur[q4][2 * p], cur[q4][2 * p + 1]}; c = c + a * nx; col[i0] = c.x; col[i0 + 1] = c.y; }
                    else if (i0 + 1 > j) col[i0 + 1] -= cur[q4][2 * p + 1] * xj; } }
#pragma unroll
            for (int q4 = (j + 2) >> 2; q4 < 16; ++q4) cur[q4] = nxt[q4]; } }
    PROF_MARKG(F, 6);
    int tid2 = F.tid; asm volatile("" : "+v"(tid2)); const int lt2 = tid2 & 255, unit2 = 2 * ug + __builtin_amdgcn_readfirstlane(tid2 >> 8), row02 = (unit2 >> 2) * 64, h2 = unit2 & 3;
    if (lt2 < 128) { bf16_t* dst = P + (size_t)(row02 + (lt2 >> 1)) * LDP + PC_BQKV + 1024 + h2 * 128 + (lt2 & 1) * 64;
#pragma unroll
        for (int o = 0; o < 8; ++o) if (!F.dry) *(u32x4*)(dst + 8 * o) = (u32x4){pk2(col[8 * o], col[8 * o + 1]), pk2(col[8 * o + 2], col[8 * o + 3]), pk2(col[8 * o + 4], col[8 * o + 5]), pk2(col[8 * o + 6], col[8 * o + 7])};
    } else { const int pp = permpos(lt2 - 128);
        if (!F.dry) {
#pragma unroll
        for (int t = 0; t < 64; ++t) strow(ROWB(P, row02 + t, PC_BQKV + 512 + h2 * 128), (unsigned)pp * 2u, f2bf(col[t])); } }
    __syncthreads();
    PROF_MARK(F, 9);
}

constexpr int SETC = 13, NSETS = 65 / SETC;
static_assert(SETC * NSETS == 65, "sets must tile the 65 scan steps");
__device__ __forceinline__ void prep_set(Frame& F, int l, int set, int nblk, int bidx) {
    const int nsl = set == 0 ? 1 + 4 * (SETC - 1) : 4 * SETC, np = 2 * nsl;
    auto ug_of = [&](int vp) { const int j = vp >> 1; int slot;
        if (set == 0) slot = j == 0 ? 256 : ((j - 1) / (SETC - 1)) * 64 + (j - 1) % (SETC - 1);
        else slot = (j / SETC) * 64 + SETC * set - 1 + j % SETC;
        return 2 * slot + (vp & 1); };
    int i = bidx, stride = nblk;
    if (nblk >= 2 * np - 16) { if (bidx < np) stride = 3 * np; else stride = nblk - np; }
    for (; i < np; i += stride) prep_gdn(F, l, ug_of(i));
    for (; i < 2 * np; i += stride) prep_gla<128, true>(F, l, ug_of(i - np));
    for (; i < 3 * np; i += stride) prep_gla<64, false>(F, l, ug_of(i - 2 * np));
}
constexpr int SCAN_BUF = 57344;
template <int MX> struct ScanCfg;
template <> struct ScanCfg<0> { static constexpr int NM = 3, NI = 5; static constexpr int off(int m) { return m == 0 ? 0 : (m == 1 ? 16384 : 32768); } static constexpr int pitch(int m) { return m == 0 ? 256 : 128; } };
template <> struct ScanCfg<1> { static constexpr int NM = 4, NI = 7; static constexpr int off(int m) { return 16384 * m; } static constexpr int pitch(int m) { return m < 2 ? 256 : 128; } };
template <> struct ScanCfg<2> { static constexpr int NM = 3, NI = 3; static constexpr int off(int m) { return 8192 * m; } static constexpr int pitch(int m) { return 128; } };

#define SET_CNT(l, k) (WSP(unsigned, WS_CTL) + 8192 + (l) * 8 + (k))
#define XPREP(x) (WSP(unsigned, WS_CTL) + 8192 + 64 + (x))
#define SET_XCNT(l, k, x) (WSP(unsigned, WS_CTL) + 8192 + 128 + ((l) * 8 + (k)) * 16 + (x))
#define SET_SIGNAL(l, k) do { asm volatile("s_waitcnt vmcnt(0)" ::: "memory"); __syncthreads(); \
    if (F.tid == 0) { const unsigned x_ = xb_xcc_id(), np_ = xb_ld(XPREP(x_)); const unsigned old_ = xb_add(SET_XCNT(l, k, x_), 1u); \
        if (old_ + 1u == np_) { __builtin_amdgcn_fence(__ATOMIC_RELEASE, "agent"); asm volatile("s_waitcnt vmcnt(0)" ::: "memory"); (void)xb_add(SET_CNT(l, k), 1u); } } } while (0)
#define SET_WAIT(l, k) do { asm volatile("s_waitcnt vmcnt(0)" ::: "memory"); __syncthreads(); \
    if (F.tid == 0) { unsigned* bar_ = WSP(unsigned, WS_CTL) + CW_BAR; unsigned need_ = 0u; for (unsigned x_ = 0; x_ < 16u; ++x_) need_ += xb_ld(XPREP(x_)) > 0u ? 1u : 0u; \
        XB_SPIN(xb_ld(SET_CNT(l, k)) < need_, bar_); \
        __builtin_amdgcn_fence(__ATOMIC_ACQUIRE, "agent"); asm volatile("s_waitcnt vmcnt(0)" ::: "memory"); } \
    __syncthreads(); asm volatile("" ::: "memory"); } while (0)
#define SCAN_GRID_BARRIER() do { xcd_barrier(WSP(unsigned, WS_CTL) + CW_BAR, xb_xcc_id(), (volatile LAS unsigned*)(F.lds + LDS_MISC) + 8, F.tid, (unsigned)F.G); asm volatile("" ::: "memory"); } while (0)
template <int MX>
__device__ __forceinline__ void scan_mixer(Frame& F, int l, int b, int h) {
    typedef ScanCfg<MX> C;
    constexpr int DK = MX == 2 ? 64 : 128, NT = DK / 16, NI = C::NI;
    const int w = F.wave, lane = F.lane, fr = lane & 15, fq = lane >> 4, ecol = 16 * w + fr;
    const char* Pb = (const char*)WSP(bf16_t, WS_P);
    const int qcol = MX == 0 ? PC_AQ + h * 128 : (MX == 1 ? PC_BQKV + h * 128 : PC_CQ + h * 64);
    const int kcol = MX == 0 ? PC_AF + h * 128 : (MX == 1 ? PC_BQKV + 512 + h * 128 : PC_CK + h * 64);
    const int vcol = MX == 0 ? PC_AI + h * 128 : (MX == 1 ? PC_BQKV + 1024 + h * 128 : PC_CV + h * 128);
    const char* SCb = (const char*)(MX == 0 ? WSP(bf16_t, WS_SCA) : (MX == 1 ? WSP(bf16_t, WS_QKD) : WSP(bf16_t, WS_SCC)));
    bf16_t* O = WSP(bf16_t, WS_O) + (size_t)MX * MROWS * 512;
    unsigned voff[NI]; int mi[NI];
#pragma unroll
    for (int i = 0; i < NI; ++i) { const int n = w + 8 * i, o = 1024 * n + 16 * lane; int m = 0;
#pragma unroll
        for (int q = 1; q < C::NM; ++q) if (o >= C::off(q)) m = q;
        int ro = o, pitch = 128;
#pragma unroll
        for (int q = 0; q < C::NM; ++q) if (m == q) { ro = o - C::off(q); pitch = C::pitch(q); }
        const int r = ro / pitch, pos = (ro % pitch) >> 4, pc = pos ^ (pitch == 256 ? (r & 15) : ((r >> 1) & 7));
        const bool packed = (MX == 0 && m == 1);
        const bool inP = (MX == 1) ? (m < 2) : (m < 2);
        voff[i] = (unsigned)(inP ? (packed ? (r >> 1) * (LDP * 2) + (r & 1) * 128 : r * (LDP * 2)) : r * pitch) + 16u * pc; mi[i] = m; }
    const unsigned x256_0 = (unsigned)(((0 | fq) ^ fr) << 4), x256_1 = (unsigned)(((4 | fq) ^ fr) << 4), x256_2 = (unsigned)(((8 | fq) ^ fr) << 4), x256_3 = (unsigned)(((12 | fq) ^ fr) << 4);
    const unsigned x128_0 = (unsigned)(((0 | fq) ^ ((fr >> 1) & 7)) << 4), x128_1 = (unsigned)(((4 | fq) ^ ((fr >> 1) & 7)) << 4);
    const unsigned x256[4] = {x256_0, x256_1, x256_2, x256_3}, x128[2] = {x128_0, x128_1};
#define SC_FRAG(buf, m, rt, kp) (*(const LAS bf16x8*)(F.lds + (buf) + C::off(m) + (16 * (rt) + fr) * C::pitch(m) + (C::pitch(m) == 256 ? x256[kp] : x128[(kp) & 1])))
    auto slot_of = [&](int step) { return step == 0 ? 256 : b * 64 + step - 1; };
    auto issue = [&](int step, int buf) {
        const int slot = slot_of(step), row0 = slot * 64, unit = slot * 4 + h;
        const char* base[4];
        if (MX == 1) { base[0] = Pb + ((size_t)row0 * LDP + kcol) * 2; base[1] = Pb + ((size_t)row0 * LDP + qcol) * 2; base[2] = (const char*)WSP(bf16_t, WS_K1TB) + (size_t)unit * 16384; base[3] = SCb + (size_t)unit * 8192; }
        else { base[0] = Pb + ((size_t)row0 * LDP + qcol) * 2; base[1] = Pb + ((size_t)row0 * LDP + kcol) * 2; base[2] = SCb + (size_t)unit * 8192; base[3] = base[2]; }
#pragma unroll
        for (int i = 0; i < NI; ++i) { const char* bs = mi[i] == 0 ? base[0] : (mi[i] == 1 ? base[1] : (mi[i] == 2 ? base[2] : base[3]));
            __builtin_amdgcn_global_load_lds((const unsigned*)(bs + voff[i]), (LAS unsigned*)(F.lds + buf + 1024 * (w + 8 * i)), 16, 0, 0); }
    };
    auto load_priv = [&](int step, u32x4 (&pv)[2]) {
        const int row0 = slot_of(step) * 64;
        const bf16_t* vt = (const bf16_t*)Pb + (size_t)(row0 + (ecol >> 1)) * LDP + vcol + (ecol & 1) * 64;
        if (MX == 1) { const u32x2 a = *(const u32x2*)(vt + 4 * fq), c = *(const u32x2*)(vt + 16 + 4 * fq), d = *(const u32x2*)(vt + 32 + 4 * fq), e = *(const u32x2*)(vt + 48 + 4 * fq);
            pv[0] = (u32x4){a.x, a.y, c.x, c.y}; pv[1] = (u32x4){d.x, d.y, e.x, e.y}; }
        else { pv[0] = *(const u32x4*)(vt + 8 * fq); pv[1] = *(const u32x4*)(vt + 32 + 8 * fq); }
    };
    f32x4 S[NT];
#pragma unroll
    for (int i = 0; i < NT; ++i) S[i] = (f32x4){0.f, 0.f, 0.f, 0.f};
    u32x4 pcur[2], pnxt[2];
    auto first_of_set = [](int s) { return s % SETC == 0; };
    for (int step = 0; step < 65; ++step) {
        const int buf = (step & 1) * SCAN_BUF, slot = slot_of(step), row0 = slot * 64, unit = slot * 4 + h;
        if (first_of_set(step)) { PROF_MARK(F, 20); SET_WAIT(l, step / SETC); PROF_MARK(F, 21); issue(step, buf); load_priv(step, pcur); }
        asm volatile("s_waitcnt vmcnt(0)" ::: "memory");
        __syncthreads();
        if (step + 1 < 65 && !first_of_set(step + 1)) { issue(step + 1, SCAN_BUF - buf); load_priv(step + 1, pnxt); }
        bf16x8 Sb[NT / 2];
#pragma unroll
        for (int kp = 0; kp < NT / 2; ++kp) Sb[kp] = pack_acc2(S[2 * kp], S[2 * kp + 1]);
        if (MX == 1) {
            f32x4 vn[4];
#pragma unroll
            for (int mt = 0; mt < 4; ++mt) { f32x4 acc = {0.f, 0.f, 0.f, 0.f};
#pragma unroll
                for (int kp = 0; kp < 4; ++kp) acc = MFMA16(SC_FRAG(buf, 0, mt, kp), Sb[kp], acc);
                const unsigned u0 = mt == 0 ? pcur[0].x : (mt == 1 ? pcur[0].z : (mt == 2 ? pcur[1].x : pcur[1].z)), u1 = mt == 0 ? pcur[0].y : (mt == 1 ? pcur[0].w : (mt == 2 ? pcur[1].y : pcur[1].w));
                vn[mt] = (f32x4){bflo(u0) - acc[0], bfhi(u0) - acc[1], bflo(u1) - acc[2], bfhi(u1) - acc[3]}; }
            bf16x8 Vb[2]; Vb[0] = pack_acc2(vn[0], vn[1]); Vb[1] = pack_acc2(vn[2], vn[3]);
#pragma unroll
            for (int mt = 0; mt < 4; ++mt) { f32x4 acc = {0.f, 0.f, 0.f, 0.f};
#pragma unroll
                for (int kp = 0; kp < 4; ++kp) acc = MFMA16(SC_FRAG(buf, 1, mt, kp), Sb[kp], acc);
#pragma unroll
                for (int kp = 0; kp < 2; ++kp) acc = MFMA16(SC_FRAG(buf, 3, mt, kp), Vb[kp], acc);
#pragma unroll
                for (int r = 0; r < 4; ++r) O[(size_t)(row0 + 16 * mt + 4 * fq + r) * 512 + h * 128 + ecol] = f2bf(acc[r]); }
            const float a = WSP(float, SM_DECB)[unit];
#pragma unroll
            for (int i = 0; i < 8; ++i) { S[i] = S[i] * a;
#pragma unroll
                for (int kp = 0; kp < 2; ++kp) S[i] = MFMA16(SC_FRAG(buf, 2, i, kp), Vb[kp], S[i]); }
        } else {
            const bf16x8 bv0 = mk8(pcur[0]), bv1 = mk8(pcur[1]);
#pragma unroll
            for (int mt = 0; mt < 4; ++mt) { f32x4 acc = {0.f, 0.f, 0.f, 0.f};
#pragma unroll
                for (int kp = 0; kp < NT / 2; ++kp) acc = MFMA16(SC_FRAG(buf, 0, mt, kp), Sb[kp], acc);
                acc = MFMA16(SC_FRAG(buf, 2, mt, 0), bv0, acc); acc = MFMA16(SC_FRAG(buf, 2, mt, 1), bv1, acc);
#pragma unroll
                for (int r = 0; r < 4; ++r) O[(size_t)(row0 + 16 * mt + 4 * fq + r) * 512 + h * 128 + ecol] = f2bf(acc[r]); }
            const float* dec = (MX == 0 ? WSP(float, SM_DECA) : WSP(float, SM_DECC)) + (size_t)unit * DK;
#pragma unroll
            for (int i = 0; i < NT; ++i) { const f32x4 d4 = *(const f32x4*)(dec + 16 * i + 4 * fq); S[i] = S[i] * d4;
                S[i] = MFMA16(SC_FRAG(buf, 1, i, 0), bv0, S[i]); S[i] = MFMA16(SC_FRAG(buf, 1, i, 1), bv1, S[i]); }
        }
        pcur[0] = pnxt[0]; pcur[1] = pnxt[1];
    }
#undef SC_FRAG
    asm volatile("s_waitcnt vmcnt(0)" ::: "memory");
    __syncthreads();
    PROF_MARK(F, 22);
}
__device__ __forceinline__ void phase_scan(Frame& F, int l) {
    if (F.bid >= 48) { for (int k = 0; k < NSETS; ++k) { PROF_MARK(F, 10); prep_set(F, l, k, F.G - 48, F.bid - 48); PROF_MARK(F, 11); SET_SIGNAL(l, k); } return; }
    const int mixer = F.bid >> 4, b = (F.bid >> 2) & 3, h = F.bid & 3;
    if (mixer == 0) scan_mixer<0>(F, l, b, h);
    else if (mixer == 1) scan_mixer<1>(F, l, b, h);
    else scan_mixer<2>(F, l, b, h);
}

template <int KIND>
__device__ __forceinline__ void meta_gemm(Frame& F, const bf16_t* A, const bf16_t* Bt, int N, int K, int n) {
    const int gw = F.bid * NWAVES + F.wave, NGW = F.G * NWAVES, lane = F.lane, fr = lane & 15, fq = lane >> 4;
    for (int tile = gw; tile < N / 16; tile += NGW) {
        const bf16_t* ar = A + (size_t)fr * K + 8 * fq; const bf16_t* br = Bt + (size_t)(16 * tile + fr) * K + 8 * fq;
        f32x4 acc = {0.f, 0.f, 0.f, 0.f};
#pragma unroll 8
        for (int ks = 0; ks < K / 32; ++ks) acc = MFMA16(mk8(*(const u32x4*)(ar + 32 * ks)), mk8(*(const u32x4*)(br + 32 * ks)), acc);
#pragma unroll
        for (int r = 0; r < 4; ++r) { const int row = META_ROW0 + 4 * fq + r, col = 16 * tile + fr;
            if (KIND == 0) WSP(bf16_t, WS_GT)[(size_t)row * 3072 + col] = f2bf(sigmoidf_(acc[r]));
            else if (KIND == 1) { bf16_t* mp = WSP(bf16_t, WS_MERGED) + (size_t)row * 1024 + col; const float g = bf2f(WSP(bf16_t, WS_GT)[(size_t)row * 3072 + n * 1024 + col]);
                *mp = f2bf((n ? bf2f(*mp) : 0.f) + g * acc[r]); }
            else { float* hp = WSP(float, WS_HMETA) + (size_t)(row - NREAL) * D + col; *hp = *hp + acc[r]; } }
    }
}

__device__ __forceinline__ void phase_hnorm(Frame& F, int l) {
    const int gw = F.bid * NWAVES + F.wave, NGW = F.G * NWAVES, lane = F.lane;
    const bf16_t* P = WSP(bf16_t, WS_P);
    LAS float* nws = (LAS float*)F.lds;
    if (F.tid < 384) { const int mxw = F.tid >> 7; const float* src = mxw == 0 ? INP(I_HGRN_NORM) : (mxw == 1 ? INP(I_GDN_NORM) : INP(I_GLA_NORM)); nws[F.tid] = src[(size_t)l * 128 + (F.tid & 127)]; }
    __syncthreads();
    for (int r = gw; r < MROWS; r += NGW) {
        bf16_t* op0 = WSP(bf16_t, WS_O) + (size_t)r * 512 + 8 * lane;
        if (!row_valid(r)) { if (!F.dry) {
#pragma unroll
            for (int mx = 0; mx < 3; ++mx) *(u32x4*)(op0 + (size_t)mx * MROWS * 512) = (u32x4){0u, 0u, 0u, 0u}; } continue; }
        u32x4 ow[3], gv[3];
#pragma unroll
        for (int mx = 0; mx < 3; ++mx) { ow[mx] = *(const u32x4*)(op0 + (size_t)mx * MROWS * 512); gv[mx] = *(const u32x4*)(P + (size_t)r * LDP + (mx == 0 ? PC_AG : (mx == 1 ? PC_BG : PC_CG)) + 8 * lane); }
#pragma unroll
        for (int mx = 0; mx < 3; ++mx) {
            const LAS float* nw = nws + mx * 128 + (8 * lane & 127);
            float o[8] = {bflo(ow[mx].x), bfhi(ow[mx].x), bflo(ow[mx].y), bfhi(ow[mx].y), bflo(ow[mx].z), bfhi(ow[mx].z), bflo(ow[mx].w), bfhi(ow[mx].w)};
            const float g[8] = {siluf_(bflo(gv[mx].x)), siluf_(bfhi(gv[mx].x)), siluf_(bflo(gv[mx].y)), siluf_(bfhi(gv[mx].y)), siluf_(bflo(gv[mx].z)), siluf_(bfhi(gv[mx].z)), siluf_(bflo(gv[mx].w)), siluf_(bfhi(gv[mx].w))};
            float ss = 0.f;
#pragma unroll
            for (int j = 0; j < 8; ++j) ss += o[j] * o[j];
            ss += __shfl_xor(ss, 1); ss += __shfl_xor(ss, 2); ss += __shfl_xor(ss, 4); ss += __shfl_xor(ss, 8);
            const float rstd = rsqrtf(ss * (1.0f / 128.0f) + 1e-6f);
            const f32x4 n0 = *(const LAS f32x4*)nw, n1 = *(const LAS f32x4*)(nw + 4);
            const float nv[8] = {n0[0], n0[1], n0[2], n0[3], n1[0], n1[1], n1[2], n1[3]};
#pragma unroll
            for (int j = 0; j < 8; ++j) o[j] = o[j] * rstd * nv[j] * g[j];
            u32x4 y; y.x = pk2(o[0], o[1]); y.y = pk2(o[2], o[3]); y.z = pk2(o[4], o[5]); y.w = pk2(o[6], o[7]);
            if (!F.dry) *(u32x4*)(op0 + (size_t)mx * MROWS * 512) = y;
        }
    }
}

__device__ __forceinline__ void phase_norm2(Frame& F, int l) {
    PROF_MARK(F, 43);
    if (!F.dry) convert_expert_weights(F, l);
    __syncthreads();
    PROF_MARK(F, 44);
    LAS float* sw = (LAS float*)F.lds;
    { const float* src = WSP(float, SM_RWE) + (size_t)l * 32 * 1024; for (int i = F.tid; i < 32 * 1024 / 4; i += NTHREADS) ((LAS f32x4*)sw)[i] = ((const f32x4*)src)[i]; }
    LAS float* rbias = sw + 32 * 1024;
    if (F.tid < 32) rbias[F.tid] = INP(I_RE_B)[l * 32 + F.tid]; else if (F.tid < 36) rbias[F.tid] = INP(I_RG_B)[l * 4 + (F.tid - 32)];
    __syncthreads();
    const int gw = F.bid * NWAVES + F.wave, NGW = F.G * NWAVES, lane = F.lane;
    float wv[16]; load_row16(INP(I_NORM_FFN) + (size_t)l * D, lane, wv);
    bf16_t* U = WSP(bf16_t, WS_U);
    const float* rwg = WSP(float, SM_RWG) + (size_t)l * 4 * 1024;
    unsigned* cnt = WSP(unsigned, WS_CTL) + CW_CNT + l * 64;
    LAS unsigned* lcnt = (LAS unsigned*)(F.lds + LDS_TAB);
    if (F.tid < 64) lcnt[F.tid] = 0u;
    __syncthreads();
    auto body = [&](auto NRc, const int r0) {
        constexpr int NR = decltype(NRc)::value;
        float x[NR][16];
#pragma unroll
        for (int i = 0; i < NR; ++i) {
            load_row16(hrow(F, r0 + i), lane, x[i]);
            float ss = 0.f;
#pragma unroll
            for (int j = 0; j < 16; ++j) ss += x[i][j] * x[i][j];
            const float rstd = rsqrtf(wave_sum(ss) * (1.0f / D) + 1e-6f);
#pragma unroll
            for (int j = 0; j < 16; ++j) x[i][j] = x[i][j] * rstd * wv[j];
            if (!F.dry) store_bf16_row16(U + (size_t)(r0 + i) * D, lane, x[i]);
        }
        float lg[NR][4];
#pragma unroll
        for (int c = 0; c < 4; ++c) {
            float a[NR];
#pragma unroll
            for (int i = 0; i < NR; ++i) a[i] = 0.f;
#pragma unroll
            for (int j = 0; j < 4; ++j) { const f32x4 w = *((const f32x4*)(rwg + c * 1024) + lane + 64 * j);
#pragma unroll
                for (int e = 0; e < 4; ++e) {
#pragma unroll
                    for (int i = 0; i < NR; ++i) a[i] += x[i][4 * j + e] * w[e]; } }
            const float bg = rbias[32 + c];
#pragma unroll
            for (int i = 0; i < NR; ++i) lg[i][c] = wave_sum(a[i]) + bg;
        }
#pragma unroll
        for (int i = 0; i < NR; ++i) {
            int gi = 0; float gm = lg[i][0];
#pragma unroll
            for (int c = 1; c < 4; ++c) if (lg[i][c] > gm) { gm = lg[i][c]; gi = c; }
            float gsum = 0.f;
#pragma unroll
            for (int c = 0; c < 4; ++c) gsum += __expf(lg[i][c] - gm);
            const float gval = 1.0f / gsum;
            gi = __builtin_amdgcn_readfirstlane(gi);
            int ea = 0, eb = 0; float la = -3.0e38f, lb = -3.0e38f;
            const LAS float* swg = sw + gi * 8 * 1024;
#pragma unroll 1
            for (int cb = 0; cb < 8; cb += 4) {
                float a0 = 0.f, a1 = 0.f, a2 = 0.f, a3 = 0.f;
#pragma unroll
                for (int j = 0; j < 4; ++j) { const f32x4 w0 = *((const LAS f32x4*)(swg + (cb + 0) * 1024) + lane + 64 * j), w1 = *((const LAS f32x4*)(swg + (cb + 1) * 1024) + lane + 64 * j), w2 = *((const LAS f32x4*)(swg + (cb + 2) * 1024) + lane + 64 * j), w3 = *((const LAS f32x4*)(swg + (cb + 3) * 1024) + lane + 64 * j);
#pragma unroll
                    for (int e = 0; e < 4; ++e) { const float xv = x[i][4 * j + e]; a0 += xv * w0[e]; a1 += xv * w1[e]; a2 += xv * w2[e]; a3 += xv * w3[e]; } }
                const float e0 = wave_sum(a0) + rbias[gi * 8 + cb], e1 = wave_sum(a1) + rbias[gi * 8 + cb + 1], e2 = wave_sum(a2) + rbias[gi * 8 + cb + 2], e3 = wave_sum(a3) + rbias[gi * 8 + cb + 3];
                const float ev[4] = {e0, e1, e2, e3};
#pragma unroll
                for (int q = 0; q < 4; ++q) { const float el = ev[q]; const int c = cb + q; if (el > la) { lb = la; eb = ea; la = el; ea = c; } else if (el > lb) { lb = el; eb = c; } }
            }
            const float wa = 1.0f / (1.0f + __expf(lb - la)), wb = 1.0f - wa;
            if (lane == 0 && !F.dry) {
                const unsigned e0 = (unsigned)(gi * 8 + ea), e1 = (unsigned)(gi * 8 + eb);
                const unsigned p0 = __hip_atomic_fetch_add(lcnt + e0, 1u, __ATOMIC_RELAXED, __HIP_MEMORY_SCOPE_WORKGROUP), p1 = __hip_atomic_fetch_add(lcnt + e1, 1u, __ATOMIC_RELAXED, __HIP_MEMORY_SCOPE_WORKGROUP);
                unsigned* tok = WSP(unsigned, SM_TOK) + (size_t)(r0 + i) * 8;
                tok[0] = e0; tok[1] = p0; tok[2] = e1; tok[3] = p1; tok[4] = __float_as_uint(gval * wa); tok[5] = __float_as_uint(gval * wb);
            }
        }
    };
    for (int g = gw; g < NREAL / 4; g += NGW) body(IntC<4>{}, 4 * g);
    if (gw >= NGW - 16) body(IntC<1>{}, META_ROW0 + (NGW - 1 - gw));
    __syncthreads();
    if (F.tid < 32 && !F.dry) lcnt[32 + F.tid] = atomicAdd(cnt + F.tid, lcnt[F.tid]);
    __syncthreads();
    if (!F.dry) { for (int g = gw; g < NREAL / 4; g += NGW) { const int r0 = 4 * g;
            if (lane < 4) { unsigned* tok = WSP(unsigned, SM_TOK) + (size_t)(r0 + lane) * 8; tok[1] += lcnt[32 + tok[0]]; tok[3] += lcnt[32 + tok[2]]; } }
        if (gw >= NGW - 16 && lane == 0) { unsigned* tok = WSP(unsigned, SM_TOK) + (size_t)(META_ROW0 + (NGW - 1 - gw)) * 8; tok[1] += lcnt[32 + tok[0]]; tok[3] += lcnt[32 + tok[2]]; } }
}

__device__ __forceinline__ int moe_tables(Frame& F, int l) {
    LAS int* offs = (LAS int*)(F.lds + LDS_TAB); LAS unsigned char* tab = (LAS unsigned char*)(F.lds + LDS_TAB + 384); LAS int* cn = (LAS int*)(F.lds + LDS_TAB + 192);
    const unsigned* cnt = WSP(unsigned, WS_CTL) + CW_CNT + l * 64;
    __syncthreads();
    if (F.tid < 32) cn[F.tid] = (int)__hip_atomic_load(cnt + F.tid, __ATOMIC_RELAXED, __HIP_MEMORY_SCOPE_AGENT);
    __syncthreads();
    if (F.tid == 0) { int acc = 0;
#pragma unroll 1
        for (int e = 0; e < 32; ++e) { offs[e] = acc; acc += ((cn[e] + 255) >> 8) << 8; }
        offs[32] = acc; }
    __syncthreads();
    if (F.tid < 160) { const int row = F.tid << 8; int e = 0;
#pragma unroll 1
        for (int k = 1; k < 32; ++k) if (offs[k] <= row) e = k;
        tab[F.tid] = (unsigned char)e; }
    __syncthreads();
    return offs[32] >> 8;
}

__device__ __forceinline__ void phase_gather(Frame& F, int l) {
    (void)moe_tables(F, l);
    const LAS int* offs = (const LAS int*)(F.lds + LDS_TAB); const LAS int* cn = (const LAS int*)(F.lds + LDS_TAB + 192);
    const int gw = F.bid * NWAVES + F.wave, NGW = F.G * NWAVES, lane = F.lane;
    const bf16_t* U = WSP(bf16_t, WS_U); bf16_t* XG = WSP(bf16_t, WS_XG); float* wrow = WSP(float, SM_WROW);
    for (int idx = gw; idx < NREAL + 16; idx += 2 * NGW) {
        const int idx2 = idx + NGW; const bool has2 = idx2 < NREAL + 16;
        const int r = idx < NREAL ? idx : META_ROW0 + (idx - NREAL), r2 = has2 ? (idx2 < NREAL ? idx2 : META_ROW0 + (idx2 - NREAL)) : r;
        unsigned* tok = WSP(unsigned, SM_TOK) + (size_t)r * 8; unsigned* tok2 = WSP(unsigned, SM_TOK) + (size_t)r2 * 8;
        const u32x4 ta = *(const u32x4*)tok, tb = *(const u32x4*)tok2; const u32x2 wa = *(const u32x2*)(tok + 4), wb = *(const u32x2*)(tok2 + 4);
        const unsigned g0 = (unsigned)offs[ta.x] + ta.y, g1 = (unsigned)offs[ta.z] + ta.w, h0 = (unsigned)offs[tb.x] + tb.y, h1 = (unsigned)offs[tb.z] + tb.w;
        const u32x4* src = (const u32x4*)(U + (size_t)r * D); const u32x4* src2 = (const u32x4*)(U + (size_t)r2 * D);
        const u32x4 a = src[lane], b = src[lane + 64], c = src2[lane], d = src2[lane + 64];
        if (lane == 0) { tok[6] = g0; tok[7] = g1; wrow[g0] = __uint_as_float(wa.x); wrow[g1] = __uint_as_float(wa.y); }
        u32x4* d0 = (u32x4*)(XG + (size_t)g0 * D); u32x4* d1 = (u32x4*)(XG + (size_t)g1 * D);
        d0[lane] = a; d0[lane + 64] = b; d1[lane] = a; d1[lane + 64] = b;
        if (has2) { if (lane == 0) { tok2[6] = h0; tok2[7] = h1; wrow[h0] = __uint_as_float(wb.x); wrow[h1] = __uint_as_float(wb.y); }
            u32x4* e0 = (u32x4*)(XG + (size_t)h0 * D); u32x4* e1 = (u32x4*)(XG + (size_t)h1 * D);
            e0[lane] = c; e0[lane + 64] = d; e1[lane] = c; e1[lane + 64] = d; }
    }
    u32x4 zz = {0u, 0u, 0u, 0u}; asm volatile("" : "+v"(zz));
    for (int i = gw; i < 32 * 256; i += NGW) { const int e = i >> 8, j = i & 255; const int row = offs[e] + cn[e] + j;
        if (row < offs[e + 1]) { u32x4* d = (u32x4*)(XG + (size_t)row * D); d[lane] = zz; d[lane + 64] = zz; if (lane == 0) wrow[row] = 0.f; } }
}

__device__ __forceinline__ void phase_final(Frame& F) {
    const int gw = F.bid * NWAVES + F.wave, NGW = F.G * NWAVES, lane = F.lane;
    float wv[16]; load_row16(INP(I_NORM_FINAL), lane, wv);
    for (int r = gw; r < NREAL; r += 2 * NGW) {
        const int r2 = r + NGW;
        float x[16], y[16]; fetch_h_row(F, 2, r, x); fetch_h_row(F, 2, r2, y);
        float ss = 0.f, s2 = 0.f;
#pragma unroll
        for (int j = 0; j < 16; ++j) { ss += x[j] * x[j]; s2 += y[j] * y[j]; }
        const float rstd = rsqrtf(wave_sum(ss) * (1.0f / D) + 1e-6f), rstd2 = rsqrtf(wave_sum(s2) * (1.0f / D) + 1e-6f);
#pragma unroll
        for (int j = 0; j < 16; ++j) { x[j] = x[j] * rstd * wv[j]; y[j] = y[j] * rstd2 * wv[j]; }
        store_row16(OUTP + (size_t)r * D, lane, x); store_row16(OUTP + (size_t)r2 * D, lane, y);
    }
}
constexpr int PH_PER_LAYER = 14, N_PHASES = 2 + 2 * PH_PER_LAYER;
#ifndef DBG_STOP
#define DBG_STOP 0
#endif
#ifndef DBG_SRC
#define DBG_SRC WS_P
#define DBG_LD LDP
#endif
#ifndef DBG_TA
#define DBG_TA -1
#endif
#ifndef DBG_TQ
#define DBG_TQ 16.0f
#endif
#ifndef DBG_TB
#define DBG_TB -1
#endif
#ifndef DUP_MASK
#define DUP_MASK 0u
#endif
#define DUPN(j) (((DUP_MASK >> (j)) & 1u) ? 2 : 1)
#ifndef MK_ONE_LAUNCH
#define MK_ONE_LAUNCH 1
#endif

template <unsigned PHMASK_T>
__global__ void __launch_bounds__(NTHREADS, 2) hybrid_fwd(Params p) {
    extern __shared__ __attribute__((aligned(16))) unsigned char lds_raw[];
    Frame F;
    F.lds = (LAS unsigned char*)lds_raw; F.tid = threadIdx.x; F.lane = F.tid & 63; F.wave = __builtin_amdgcn_readfirstlane(F.tid >> 6); F.G = gridDim.x; F.bid = blockIdx.x; F.dry = 0;
    F.out = (GAS float*)p.out; F.ws = (GAS unsigned char*)p.ws; F.inp = (const float* const __attribute__((address_space(4)))*)__builtin_amdgcn_kernarg_segment_ptr();
    volatile LAS unsigned* MISC = (volatile LAS unsigned*)(F.lds + LDS_MISC);
    if (F.tid < 128) MISC[F.tid] = 0u;
    if (F.bid >= 48 && F.tid == 0) (void)xb_add(WSP(unsigned, WS_CTL) + 8192 + 64 + xb_xcc_id(), 1u);
    __syncthreads();
#if MK_ONE_LAUNCH
    constexpr int lo = 0, hi = N_PHASES;
#else
    const int lo = p.ph_lo, hi = p.ph_hi;
#endif
    if (hi - lo > 1) (void)xcd_barrier_post(WSP(unsigned, WS_CTL) + CW_BAR, MISC + 8);
#define GRID_BARRIER() xcd_barrier(WSP(unsigned, WS_CTL) + CW_BAR, xb_xcc_id(), (volatile LAS unsigned*)(F.lds + LDS_MISC) + 8, F.tid, (unsigned)F.G)
#define EN(j) ((PHMASK_T >> (j)) & 1u)
#define IN(k) (lo <= (k) && (k) < hi)
    if (DBG_TA >= 0 && F.tid == 0) { MISC[16] = (unsigned)__builtin_amdgcn_s_memrealtime(); MISC[17] = 0u; }
#define SEAM(k) do { if (IN(k) && IN((k) + 1)) GRID_BARRIER(); PHASE_FENCE(F); \
    if (DBG_TA >= 0 && F.tid == 0) { const unsigned t_now = (unsigned)__builtin_amdgcn_s_memrealtime(); const int kk = (k) == 0 ? 15 : (((k) - 1) % PH_PER_LAYER); const int kind = (kk >= 6 && kk <= 8) ? 6 : kk; \
        if (kind == DBG_TA) MISC[17] += t_now - MISC[16]; MISC[16] = t_now; } } while (0)
    PHASE_FENCE(F);
    if (EN(15) && IN(0)) phase_pre(F);
    SEAM(0);
    { constexpr int l = 0;
        const int pb = 1 + PH_PER_LAYER * l;
        for (int rep = 0; rep < (l == 0 ? DUPN(0) : 1); ++rep) { if (rep) { GRID_BARRIER(); PHASE_FENCE(F); } if (EN(0) && IN(pb + 0)) phase_norm1(F, l); }
        PROF_MARK(F, 42);
        SEAM(pb + 0);
        for (int rep = 0; rep < DUPN(1); ++rep) { if (rep) { GRID_BARRIER(); PHASE_FENCE(F); }
        if (EN(1) && IN(pb + 1)) {
            pg8::Gemm g{WSP(bf16_t, WS_U), WSP(bf16_t, WS_WMIX), MROWS, LDP, D}; pg8::StaticOrder S; S.init(MROWS, LDP, F.G, F.bid);
            pg8::EpiInProj E{WSP(bf16_t, WS_P), WSP(bf16_t, SM_HALO)};
            pg8::gemm_phase(F.lds, F.tid, g, S, E);
        } }
        SEAM(pb + 1);
        PHASE_FENCE(F);
        if (EN(3) && IN(pb + 3)) phase_scan(F, l);
        SEAM(pb + 3);
        for (int rep = 0; rep < DUPN(4); ++rep) { if (rep) { GRID_BARRIER(); PHASE_FENCE(F); F.dry = 1; asm volatile("" : "+s"(F.dry)); } if (EN(4) && IN(pb + 4)) phase_hnorm(F, l); F.dry = 0; }
        SEAM(pb + 4);
        for (int rep = 0; rep < DUPN(5); ++rep) { if (rep) { GRID_BARRIER(); PHASE_FENCE(F); }
        if (EN(5) && IN(pb + 5)) {
            pg8::Gemm g{WSP(bf16_t, WS_U), WSP(bf16_t, WS_WGATE), NREAL, 3072, D}; pg8::StaticOrder S; S.init(NREAL, 3072, F.G, F.bid);
            pg8::EpiSigmoid E{WSP(bf16_t, WS_GT), 3072};
            pg8::gemm_phase(F.lds, F.tid, g, S, E);
            meta_gemm<0>(F, WSP(bf16_t, WS_U) + (size_t)META_ROW0 * D, WSP(bf16_t, WS_WGATE), 3072, D, 0);
        } }
        SEAM(pb + 5);
        if (EN(6) && IN(pb + 6)) {
            pg8::Gemm g{WSP(bf16_t, WS_O), WSP(bf16_t, WS_WBT), NREAL, D, 512}; pg8::BranchOrder S; S.init(NREAL, D, F.G, F.bid, (size_t)MROWS * 512 * 2, (size_t)1024 * 512 * 2);
            pg8::EpiBranch E{WSP(bf16_t, WS_MERGED), WSP(bf16_t, WS_GT)};
            pg8::gemm_phase(F.lds, F.tid, g, S, E);
            for (int n = 0; n < 3; ++n) meta_gemm<1>(F, WSP(bf16_t, WS_O) + (size_t)n * MROWS * 512 + (size_t)META_ROW0 * 512, WSP(bf16_t, WS_WBT) + (size_t)n * 1024 * 512, D, 512, n);
        }
        SEAM(pb + 8);
        if (EN(9) && IN(pb + 9)) {
            pg8::Gemm g{WSP(bf16_t, WS_MERGED), WSP(bf16_t, WS_WOT), NREAL, D, D}; pg8::StaticOrder S; S.init(NREAL, D, F.G, F.bid);
            pg8::EpiResidual E{OUTP, WSP(float, WS_HMETA)};
            pg8::gemm_phase(F.lds, F.tid, g, S, E);
            meta_gemm<2>(F, WSP(bf16_t, WS_MERGED) + (size_t)META_ROW0 * D, WSP(bf16_t, WS_WOT), D, D, 0);
        }
        SEAM(pb + 9);
        for (int rep = 0; rep < DUPN(10); ++rep) { if (rep) { GRID_BARRIER(); PHASE_FENCE(F); F.dry = 1; asm volatile("" : "+s"(F.dry)); } if (EN(10) && IN(pb + 10)) phase_norm2(F, l); F.dry = 0; }
        PROF_MARK(F, 45);
        SEAM(pb + 10);
        for (int rep = 0; rep < DUPN(11); ++rep) { if (rep) { GRID_BARRIER(); PHASE_FENCE(F); } if (EN(11) && IN(pb + 11)) phase_gather(F, l); }
        SEAM(pb + 11);
        for (int rep = 0; rep < DUPN(12); ++rep) { if (rep) { GRID_BARRIER(); PHASE_FENCE(F); }
        if (EN(12) && IN(pb + 12)) {
            const int ntiles = moe_tables(F, l);
            pg8::Gemm g{WSP(bf16_t, WS_XG), WSP(bf16_t, WS_W1T), XG_ROWS, 512, D};
            pg8::MoeOrder S{F.G, F.bid, 2, ntiles, (const LAS unsigned char*)(F.lds + LDS_TAB + 384), (size_t)512 * 1024 * 2};
            pg8::EpiMoeUp E{WSP(bf16_t, WS_HG)};
            pg8::gemm_phase(F.lds, F.tid, g, S, E);
        } }
        SEAM(pb + 12);
        for (int rep = 0; rep < DUPN(13); ++rep) { if (rep) { GRID_BARRIER(); PHASE_FENCE(F); }
        if (EN(13) && IN(pb + 13)) {
            const int ntiles = moe_tables(F, l);
            pg8::Gemm g{WSP(bf16_t, WS_HG), WSP(bf16_t, WS_W2T), XG_ROWS, D, 256};
            pg8::MoeOrder S{F.G, F.bid, 4, ntiles, (const LAS unsigned char*)(F.lds + LDS_TAB + 384), (size_t)1024 * 256 * 2};
            pg8::EpiMoeDown E{WSP(bf16_t, WS_Y2), WSP(float, SM_WROW)};
            pg8::gemm_phase(F.lds, F.tid, g, S, E);
        } }
        SEAM(pb + 13);
    }
    { constexpr int l = 1;
        const int pb = 1 + PH_PER_LAYER * l;
        for (int rep = 0; rep < (l == 0 ? DUPN(0) : 1); ++rep) { if (rep) { GRID_BARRIER(); PHASE_FENCE(F); } if (EN(0) && IN(pb + 0)) phase_norm1(F, l); }
        PROF_MARK(F, 42);
        SEAM(pb + 0);
        for (int rep = 0; rep < DUPN(1); ++rep) { if (rep) { GRID_BARRIER(); PHASE_FENCE(F); }
        if (EN(1) && IN(pb + 1)) {
            pg8::Gemm g{WSP(bf16_t, WS_U), WSP(bf16_t, WS_WMIX), MROWS, LDP, D}; pg8::StaticOrder S; S.init(MROWS, LDP, F.G, F.bid);
            pg8::EpiInProj E{WSP(bf16_t, WS_P), WSP(bf16_t, SM_HALO)};
            pg8::gemm_phase(F.lds, F.tid, g, S, E);
        } }
        SEAM(pb + 1);
        PHASE_FENCE(F);
        if (EN(3) && IN(pb + 3)) phase_scan(F, l);
        SEAM(pb + 3);
        for (int rep = 0; rep < DUPN(4); ++rep) { if (rep) { GRID_BARRIER(); PHASE_FENCE(F); F.dry = 1; asm volatile("" : "+s"(F.dry)); } if (EN(4) && IN(pb + 4)) phase_hnorm(F, l); F.dry = 0; }
        SEAM(pb + 4);
        for (int rep = 0; rep < DUPN(5); ++rep) { if (rep) { GRID_BARRIER(); PHASE_FENCE(F); }
        if (EN(5) && IN(pb + 5)) {
            pg8::Gemm g{WSP(bf16_t, WS_U), WSP(bf16_t, WS_WGATE), NREAL, 3072, D}; pg8::StaticOrder S; S.init(NREAL, 3072, F.G, F.bid);
            pg8::EpiSigmoid E{WSP(bf16_t, WS_GT), 3072};
            pg8::gemm_phase(F.lds, F.tid, g, S, E);
            meta_gemm<0>(F, WSP(bf16_t, WS_U) + (size_t)META_ROW0 * D, WSP(bf16_t, WS_WGATE), 3072, D, 0);
        } }
        SEAM(pb + 5);
        if (EN(6) && IN(pb + 6)) {
            pg8::Gemm g{WSP(bf16_t, WS_O), WSP(bf16_t, WS_WBT), NREAL, D, 512}; pg8::BranchOrder S; S.init(NREAL, D, F.G, F.bid, (size_t)MROWS * 512 * 2, (size_t)1024 * 512 * 2);
            pg8::EpiBranch E{WSP(bf16_t, WS_MERGED), WSP(bf16_t, WS_GT)};
            pg8::gemm_phase(F.lds, F.tid, g, S, E);
            for (int n = 0; n < 3; ++n) meta_gemm<1>(F, WSP(bf16_t, WS_O) + (size_t)n * MROWS * 512 + (size_t)META_ROW0 * 512, WSP(bf16_t, WS_WBT) + (size_t)n * 1024 * 512, D, 512, n);
        }
        SEAM(pb + 8);
        if (EN(9) && IN(pb + 9)) {
            pg8::Gemm g{WSP(bf16_t, WS_MERGED), WSP(bf16_t, WS_WOT), NREAL, D, D}; pg8::StaticOrder S; S.init(NREAL, D, F.G, F.bid);
            pg8::EpiResidual E{OUTP, WSP(float, WS_HMETA)};
            pg8::gemm_phase(F.lds, F.tid, g, S, E);
            meta_gemm<2>(F, WSP(bf16_t, WS_MERGED) + (size_t)META_ROW0 * D, WSP(bf16_t, WS_WOT), D, D, 0);
        }
        SEAM(pb + 9);
        for (int rep = 0; rep < DUPN(10); ++rep) { if (rep) { GRID_BARRIER(); PHASE_FENCE(F); F.dry = 1; asm volatile("" : "+s"(F.dry)); } if (EN(10) && IN(pb + 10)) phase_norm2(F, l); F.dry = 0; }
        PROF_MARK(F, 45);
        SEAM(pb + 10);
        for (int rep = 0; rep < DUPN(11); ++rep) { if (rep) { GRID_BARRIER(); PHASE_FENCE(F); } if (EN(11) && IN(pb + 11)) phase_gather(F, l); }
        SEAM(pb + 11);
        for (int rep = 0; rep < DUPN(12); ++rep) { if (rep) { GRID_BARRIER(); PHASE_FENCE(F); }
        if (EN(12) && IN(pb + 12)) {
            const int ntiles = moe_tables(F, l);
            pg8::Gemm g{WSP(bf16_t, WS_XG), WSP(bf16_t, WS_W1T), XG_ROWS, 512, D};
            pg8::MoeOrder S{F.G, F.bid, 2, ntiles, (const LAS unsigned char*)(F.lds + LDS_TAB + 384), (size_t)512 * 1024 * 2};
            pg8::EpiMoeUp E{WSP(bf16_t, WS_HG)};
            pg8::gemm_phase(F.lds, F.tid, g, S, E);
        } }
        SEAM(pb + 12);
        for (int rep = 0; rep < DUPN(13); ++rep) { if (rep) { GRID_BARRIER(); PHASE_FENCE(F); }
        if (EN(13) && IN(pb + 13)) {
            const int ntiles = moe_tables(F, l);
            pg8::Gemm g{WSP(bf16_t, WS_HG), WSP(bf16_t, WS_W2T), XG_ROWS, D, 256};
            pg8::MoeOrder S{F.G, F.bid, 4, ntiles, (const LAS unsigned char*)(F.lds + LDS_TAB + 384), (size_t)1024 * 256 * 2};
            pg8::EpiMoeDown E{WSP(bf16_t, WS_Y2), WSP(float, SM_WROW)};
            pg8::gemm_phase(F.lds, F.tid, g, S, E);
        } }
        SEAM(pb + 13);
    }
#if DBG_STOP > 0
    if (EN(14) && IN(N_PHASES - 1)) { const int gt = F.bid * NTHREADS + F.tid, NT = F.G * NTHREADS;
#ifdef DBG_LIN
        { const bf16_t* s1 = WSP(bf16_t, DBG_SRC); const bf16_t* s2 = WSP(bf16_t, DBG_SRC2);
          for (size_t i = gt; i < (size_t)NREAL * D; i += NT) F.out[i] = i < (size_t)DBG_N1 ? bf2f(s1[i]) : (i < (size_t)DBG_N1 + DBG_N2 ? bf2f(s2[i - DBG_N1]) : 0.f); }
#else
        if (DBG_LD > 0) { const bf16_t* src = WSP(bf16_t, DBG_SRC); for (size_t i = gt; i < (size_t)NREAL * D; i += NT) { const size_t r = i >> 10, c = i & 1023; F.out[i] = bf2f(src[r * DBG_LD + (c * DBG_LD) / 1024]); } }
#endif
    }
#else
#ifdef DBG_XBAR
    for (int i = 0; i < DBG_XBAR; ++i) { GRID_BARRIER(); PHASE_FENCE(F); }
#endif
    if (EN(14) && IN(N_PHASES - 1)) phase_final(F);
    PROF_SPIN(F);
    if (DBG_TA >= 0) { float* tw = WSP(float, WS_CTL) + 2048; if (F.bid == 0 && F.tid == 0) { tw[0] = (float)MISC[17] * 0.01f; }
        GRID_BARRIER(); PHASE_FENCE(F);
        const float v = floorf(WSP(float, WS_CTL)[2048] * (1.0f / DBG_TQ)) * 0.25f;
        const int gt = F.bid * NTHREADS + F.tid, NT = F.G * NTHREADS;
        for (size_t i = gt; i < (size_t)NREAL * D; i += NT) F.out[i] = v; }
#endif
#undef IN
#undef SEAM
}

#if MK_ONE_LAUNCH
#ifndef KM_ONE
#define KM_ONE 0xffffffffu
#endif
constexpr unsigned KMASK[1] = {KM_ONE};
#else
constexpr unsigned KMASK[3] = {0x0C19u, 0xC004u, 0x3262u};
#endif
template <unsigned M> static bool setup_kernel(int& per_cu) {
    if (hipFuncSetAttribute((const void*)hybrid_fwd<M>, hipFuncAttributeMaxDynamicSharedMemorySize, LDS_BYTES) != hipSuccess) return false;
    if (hipOccupancyMaxActiveBlocksPerMultiprocessor(&per_cu, (const void*)hybrid_fwd<M>, NTHREADS, LDS_BYTES) != hipSuccess) per_cu = 0;
    (void)hipGetLastError();
    return true;
}
static int phase_kind(int k) { if (k == 0) return 15; if (k == N_PHASES - 1) return 14; const int j = (k - 1) % PH_PER_LAYER; return (j >= 6 && j <= 8) ? 6 : j; }
extern "C" void kernel_launch(void* const* d_in, const int* in_sizes, int n_in, void* d_out, int out_size, void* d_ws, size_t ws_size, hipStream_t stream) {
    static int grid = 0;
    if (grid == 0) {
        if (n_in != 24 || in_sizes[0] != NREAL * D || out_size != NREAL * D || ws_size < WS_END) {
            fprintf(stderr, "kernel_launch: unexpected problem (n_in %d, in0 %d, out %d, ws %zu < %zu); nothing launched\n", n_in, n_in > 0 ? in_sizes[0] : -1, out_size, ws_size, (size_t)WS_END); grid = -1; return; }
        int dev = 0, cus = 0, per_cu = 0; bool ok = true;
        if (hipGetDevice(&dev) != hipSuccess || hipDeviceGetAttribute(&cus, hipDeviceAttributeMultiprocessorCount, dev) != hipSuccess) { grid = -1; return; }
#if MK_ONE_LAUNCH
        ok = setup_kernel<KMASK[0]>(per_cu);
#else
        ok = setup_kernel<KMASK[0]>(per_cu) && setup_kernel<KMASK[1]>(per_cu) && setup_kernel<KMASK[2]>(per_cu);
#endif
        if (!ok) { fprintf(stderr, "kernel_launch: hipFuncSetAttribute failed\n"); grid = -1; return; }
        if (per_cu < 1) fprintf(stderr, "kernel_launch: occupancy query says %d\n", per_cu);
        grid = cus;
    }
    if (grid < 0) return;
    if (hipMemsetAsync((char*)d_ws + WS_CTL, 0, CTL_BYTES, stream) != hipSuccess) return;
    Params p{};
    for (int i = 0; i < 24; ++i) p.in[i] = (const float*)d_in[i];
    p.out = (float*)d_out; p.ws = (unsigned char*)d_ws;
#if MK_ONE_LAUNCH
    p.ph_lo = 0; p.ph_hi = N_PHASES;
    hipLaunchKernelGGL(hybrid_fwd<KMASK[0]>, dim3(grid), dim3(NTHREADS), LDS_BYTES, stream, p);
#else
    for (int k = 0; k < N_PHASES; ++k) { if (DBG_STOP > 0 && k >= DBG_STOP && k != N_PHASES - 1) continue; p.ph_lo = k; p.ph_hi = k + 1; const unsigned bit = 1u << phase_kind(k);
        if (KMASK[0] & bit) hipLaunchKernelGGL(hybrid_fwd<KMASK[0]>, dim3(grid), dim3(NTHREADS), LDS_BYTES, stream, p);
        else if (KMASK[1] & bit) hipLaunchKernelGGL(hybrid_fwd<KMASK[1]>, dim3(grid), dim3(NTHREADS), LDS_BYTES, stream, p);
        else hipLaunchKernelGGL(hybrid_fwd<KMASK[2]>, dim3(grid), dim3(NTHREADS), LDS_BYTES, stream, p); }
#endif
}
```

```cpp
#include <hip/hip_runtime.h>
#include <cstdio>
#include <cstdint>

#define LAS __attribute__((address_space(3)))
typedef unsigned short bf16_t;
typedef short bf16x8 __attribute__((ext_vector_type(8)));
typedef float f32x4 __attribute__((ext_vector_type(4)));
typedef float f32x2 __attribute__((ext_vector_type(2)));
typedef unsigned u32x4 __attribute__((ext_vector_type(4)));
typedef unsigned u32x2 __attribute__((ext_vector_type(2)));

constexpr int D = 1024, NREAL = 16384, MROWS = 16640, META_ROW0 = 16384 + 48, META_END = 16384 + 64;
constexpr int NSLOT = 257;
constexpr int LDP = 5632;
constexpr int PC_AQ = 0, PC_AF = 512, PC_AI = 1024, PC_AG = 1536, PC_BQKV = 2048, PC_BG = 3584, PC_CQ = 4096, PC_CK = 4352, PC_CV = 4608, PC_CG = 5120;
constexpr int IN_COLS = 8728;
constexpr int NTHREADS = 512, NWAVES = 8;
constexpr int XG_ROWS = 40960;

constexpr size_t MiB = 1ull << 20;
constexpr size_t WS_CTL = 0, CTL_BYTES = 1 * MiB;
constexpr int CW_BAR = 4096, CW_CNT = 1024;
constexpr size_t SM_SW1 = 1 * MiB;
constexpr size_t SM_RWG = SM_SW1 + 2 * 24 * 1024 * 4;
constexpr size_t SM_RWE = SM_RWG + 2 * 4 * 1024 * 4;
constexpr size_t SM_LAB = SM_RWE + 2 * 32 * 1024 * 4;
constexpr size_t SM_GK = SM_LAB + 2 * 2 * 512 * 4;
constexpr size_t SM_BETA = SM_GK + (size_t)MROWS * 16 * 4;
constexpr size_t SM_LOGA = SM_BETA + (size_t)MROWS * 4 * 4;
constexpr size_t SM_TOK = SM_LOGA + (size_t)MROWS * 4 * 4;
constexpr size_t SM_WROW = SM_TOK + (size_t)MROWS * 8 * 4;
constexpr size_t SM_DECA = SM_WROW + (size_t)XG_ROWS * 4;
constexpr size_t SM_DECC = SM_DECA + 1028 * 128 * 4;
constexpr size_t SM_DECB = SM_DECC + 1028 * 64 * 4;
constexpr size_t SM_HALO = SM_DECB + 8192;
constexpr size_t SM_END = SM_HALO + 260 * 3 * 1536 * 2;
static_assert(SM_END <= 8 * MiB, "small region");
constexpr size_t WS_HMETA = 8 * MiB;
constexpr size_t WS_WMIX = 9 * MiB;
constexpr size_t WS_WGATE = 20 * MiB;
constexpr size_t WS_WBT = 26 * MiB;
constexpr size_t WS_WOT = 29 * MiB;
constexpr size_t WS_O = 31 * MiB;
constexpr size_t O_STRIDE = (size_t)MROWS * 512 * 2;
constexpr size_t WS_W1T = 31 * MiB;
constexpr size_t WS_W2T = 63 * MiB;
constexpr size_t WS_U = 80 * MiB;
constexpr size_t WS_P = 113 * MiB;
constexpr size_t WS_GT = 113 * MiB;
constexpr size_t WS_MERGED = 211 * MiB;
constexpr size_t WS_XG = 113 * MiB;
constexpr size_t WS_HG = 193 * MiB;
constexpr size_t WS_Y2 = 213 * MiB;
constexpr size_t WS_SCA = 294 * MiB;
constexpr size_t WS_QKD = 303 * MiB;
constexpr size_t WS_SCC = 312 * MiB;
constexpr size_t WS_K1TB = 321 * MiB;
constexpr size_t WS_END = 338 * MiB;

constexpr int LDS_BYTES = 163840;
constexpr int LDS_MISC = LDS_BYTES - 512;
constexpr int LDS_TAB = LDS_BYTES - 1536;
constexpr int LDS_SCRATCH = LDS_TAB;

typedef __bf16 bf16x2v __attribute__((ext_vector_type(2)));
__device__ __forceinline__ unsigned pk2(float lo, float hi) { const f32x2 v = {lo, hi}; return __builtin_bit_cast(unsigned, __builtin_convertvector(v, bf16x2v)); }
__device__ __forceinline__ bf16_t f2bf(float f) { return (bf16_t)(pk2(f, 0.f) & 0xffffu); }
__device__ __forceinline__ float bf2f(bf16_t b) { return __uint_as_float(((unsigned)b) << 16); }
__device__ __forceinline__ float bflo(unsigned w) { return __uint_as_float(w << 16); }
__device__ __forceinline__ float bfhi(unsigned w) { return __uint_as_float(w & 0xffff0000u); }
__device__ __forceinline__ float sigmoidf_(float x) { return __builtin_amdgcn_rcpf(1.0f + __expf(-x)); }
__device__ __forceinline__ float siluf_(float x) { return x * __builtin_amdgcn_rcpf(1.0f + __expf(-x)); }
__device__ __forceinline__ float logsigf_(float x) { return fminf(x, 0.f) - __logf(1.0f + __expf(-fabsf(x))); }
__device__ __forceinline__ float softplusf_(float x) { return fmaxf(x, 0.f) + log1pf(__expf(-fabsf(x))); }
__device__ __forceinline__ bool row_valid(int r) { return r < NREAL || (r >= META_ROW0 && r < META_END); }
__device__ __forceinline__ float wave_sum(float v) {
#define DPP_ADD(ctrl, rmask) v += __int_as_float(__builtin_amdgcn_update_dpp(0, __float_as_int(v), (ctrl), (rmask), 0xf, false))
    DPP_ADD(0x111, 0xf); DPP_ADD(0x112, 0xf); DPP_ADD(0x114, 0xf); DPP_ADD(0x118, 0xf);
    DPP_ADD(0x142, 0xa); DPP_ADD(0x143, 0xc);
#undef DPP_ADD
    return __int_as_float(__builtin_amdgcn_readlane(__float_as_int(v), 63));
}
#define LDS_WAIT() asm volatile("s_waitcnt lgkmcnt(0)" ::: "memory")

#define XB_TMO      128
#define XB_XCNT(j)  (256  + 64 * (j))
#define XB_XSUB(j)  (1280 + 64 * (j))
#define XB_XGEN(j)  (2304 + 64 * (j))
#define XB_TOP      3328
#define XB_TOPGEN   3392
#define XCD_BAR_WORDS 3456
#define XB_SPIN_CAP (1u << 18)
__device__ __forceinline__ unsigned xb_ld(unsigned* p)              { return __hip_atomic_load(p, __ATOMIC_RELAXED, __HIP_MEMORY_SCOPE_AGENT); }
__device__ __forceinline__ unsigned xb_add(unsigned* p, unsigned v) { return __hip_atomic_fetch_add(p, v, __ATOMIC_RELAXED, __HIP_MEMORY_SCOPE_AGENT); }
__device__ __forceinline__ unsigned xb_xcc_id() { return (unsigned)__builtin_amdgcn_s_getreg((3 << 11) | 20) & 0xFu; }
#define XB_SPIN(cond, bar) do { unsigned _sp = 0; while (cond) { __builtin_amdgcn_s_sleep(1); \
    if ((++_sp & 255u) == 0u) { if (xb_ld(&(bar)[XB_TMO])) break; if (_sp > XB_SPIN_CAP) { atomicAdd(&(bar)[XB_TMO], 1u); break; } } } } while (0)
struct XcdBarrier { unsigned* bar; unsigned x; volatile LAS unsigned* st; };
__device__ __forceinline__ XcdBarrier xcd_barrier_post(unsigned* bar, volatile LAS unsigned* st) {
    XcdBarrier b; b.bar = bar; b.x = xb_xcc_id(); b.st = st;
    if (threadIdx.x == 0) (void)xb_add(&bar[XB_XCNT(b.x)], 1u);
    return b;
}
__device__ __forceinline__ void xcd_barrier_complete(unsigned* bar, unsigned x, unsigned& nloc, unsigned& nx, const unsigned G) {
    unsigned sum, cnt, mine, sp = 0u;
    for (;;) {
        sum = 0u; cnt = 0u; mine = 0u;
#pragma unroll
        for (unsigned j = 0; j < 16; ++j) { const unsigned c = xb_ld(&bar[XB_XCNT(j)]); sum += c; cnt += (c > 0u) ? 1u : 0u; mine = (j == x) ? c : mine; }
        if (sum == G) break;
        __builtin_amdgcn_s_sleep(1);
        if ((++sp & 255u) == 0u) { if (xb_ld(&bar[XB_TMO])) break; if (sp > XB_SPIN_CAP) { atomicAdd(&bar[XB_TMO], 1u); break; } }
    }
    nloc = mine > 0u ? mine : 1u; nx = cnt > 0u ? cnt : 1u;
}
__device__ __attribute__((noinline)) void xcd_barrier(unsigned* bar_, unsigned x_, volatile LAS unsigned* st_, int tid_, unsigned G_) {
    XcdBarrier b; b.bar = bar_; b.x = x_; b.st = st_;
    asm volatile("s_waitcnt vmcnt(0)" ::: "memory");
    __syncthreads();
    if (tid_ == 0) {
        unsigned* bar = b.bar;
        __builtin_amdgcn_s_waitcnt(0);
        unsigned nloc = b.st[0], nx = b.st[1];
        if (nloc == 0u) { xcd_barrier_complete(bar, b.x, nloc, nx, G_); b.st[0] = nloc; b.st[1] = nx; }
        const unsigned old = xb_add(&bar[XB_XSUB(b.x)], 1u);
        const unsigned gen = old / nloc;
        if (old + 1u == (gen + 1u) * nloc) {
            __builtin_amdgcn_fence(__ATOMIC_RELEASE, "agent");
            asm volatile("s_waitcnt vmcnt(0)" ::: "memory");
            const unsigned og = xb_add(&bar[XB_TOP], 1u);
            const unsigned tg = og / nx;
            if (og + 1u == (tg + 1u) * nx) xb_add(&bar[XB_TOPGEN], 1u);
            else XB_SPIN(xb_ld(&bar[XB_TOPGEN]) == tg, bar);
            __builtin_amdgcn_fence(__ATOMIC_ACQUIRE, "agent");
            xb_add(&bar[XB_XGEN(b.x)], 1u);
            asm volatile("s_waitcnt vmcnt(0)" ::: "memory");
        } else {
            XB_SPIN(xb_ld(&bar[XB_XGEN(b.x)]) == gen, bar);
            __builtin_amdgcn_fence(__ATOMIC_ACQUIRE, "agent");
            asm volatile("s_waitcnt vmcnt(0)" ::: "memory");
        }
    }
    __syncthreads();
}

#ifndef PROF_ON
#define PROF_ON 0
#endif
#if PROF_ON
#ifndef PROF_UNIT
#define PROF_UNIT 100u
#endif
#define PROF_SLOTS(F) WSP(unsigned, WS_CTL + 524288)
__device__ __forceinline__ unsigned prof_now() { unsigned long long t; asm volatile("s_memrealtime %0\n\ts_waitcnt lgkmcnt(0)" : "=s"(t) :: "memory"); return (unsigned)t; }
#define PROF_MARK(F, k) do { const unsigned now_ = prof_now(); if ((F).bid == PROF_BID && (F).tid == 0) PROF_SLOTS(F)[k] = now_; asm volatile("" ::: "memory"); } while (0)
#if PROF_IN & 1
#define PROF_MARKI(F, k) PROF_MARK(F, k)
#else
#define PROF_MARKI(F, k) do { } while (0)
#endif
#if PROF_IN & 2
#define PROF_MARKG(F, k) do { if ((PROF_GMASK >> (k)) & 1) PROF_MARK(F, k); } while (0)
#else
#define PROF_MARKG(F, k) do { } while (0)
#endif
#define PROF_SPIN(F) do { if ((F).bid == PROF_BID && (F).tid == 0) { unsigned qa_ = (PROF_SLOTS(F)[PROF_A1] - PROF_SLOTS(F)[PROF_A0] + PROF_UNIT / 2) / PROF_UNIT, qb_ = (PROF_SLOTS(F)[PROF_B1] - PROF_SLOTS(F)[PROF_B0] + PROF_UNIT / 2) / PROF_UNIT; \
    qa_ = qa_ > 127u ? 127u : qa_; qb_ = qb_ > 127u ? 127u : qb_; const unsigned d_ = (qa_ + 128u * qb_) * 1600u; const unsigned t0_ = (unsigned)__builtin_amdgcn_s_memrealtime(); \
    while ((unsigned)__builtin_amdgcn_s_memrealtime() - t0_ < d_) __builtin_amdgcn_s_sleep(8); } } while (0)
#else
#define PROF_MARK(F, k) do { } while (0)
#define PROF_MARKI(F, k) do { } while (0)
#define PROF_MARKG(F, k) do { } while (0)
#define PROF_SPIN(F) do { } while (0)
#endif
namespace pg8 {
constexpr int BM = 256, BK = 64, HALF = 128, HTB = HALF * BK * 2, STAGE_BYTES = 8 * HTB, NXCD = 8, WGM = 8;
__host__ __device__ __forceinline__ int lds_byte(int r, int c) { const int st = (r >> 4) * 2 + (c >> 5), rr = r & 15, cc = c & 31, ob = rr * 64 + cc * 2; return st * 1024 + (ob ^ (((ob >> 9) & 1) << 5)); }
__host__ __device__ __forceinline__ void stage_rc(int b, int& R, int& C) { const int st = b / 1024, sb = b % 1024, swz = sb ^ (((sb >> 9) & 1) << 5); R = (st >> 1) * 16 + swz / 64; C = (st & 1) * 32 + (swz % 64) / 2; }
__host__ __device__ __forceinline__ int perm32(int rho) { const int n = rho >> 4, i = rho & 15; return 8 * (i >> 2) + 4 * n + (i & 3); }

struct Unit { int pm, pn, ex; };
struct Gemm { const bf16_t* A; const bf16_t* Bt; int M, N, K; };

struct StaticOrder {
    int nM, nN, nwg, G, c;
    __device__ void init(int M, int N, int G_, int c_) { nM = M / BM; nN = N / BM; nwg = nM * nN; G = G_; c = c_; }
    __device__ bool next(int i, Unit& u) const {
        const long L = (long)i * G + c; if (L >= nwg) return false;
        int wgid = (int)L; { const int q = nwg / NXCD, r = nwg % NXCD, xcd = wgid % NXCD, off = wgid / NXCD; wgid = (xcd < r ? xcd * (q + 1) : r * (q + 1) + (xcd - r) * q) + off; }
        const int nig = WGM * nN, gid = wgid / nig, fm = gid * WGM, gsz = (nM - fm) < WGM ? (nM - fm) : WGM;
        u.pm = fm + ((wgid % nig) % gsz); u.pn = (wgid % nig) / gsz; u.ex = 0; return true;
    }
    __device__ __forceinline__ void ptrs(const Gemm& g, const Unit& u, const char*& a, const char*& b) const {
        const size_t tstep = (size_t)BM * g.K * 2; a = (const char*)g.A + (size_t)u.pm * tstep; b = (const char*)g.Bt + (size_t)u.pn * tstep; }
};
struct BranchOrder {
    int nM, nN, nwg, G, c; size_t astride, bstride;
    __device__ void init(int M, int N, int G_, int c_, size_t as, size_t bs) { nM = M / BM; nN = N / BM; nwg = nM * nN; G = G_; c = c_; astride = as; bstride = bs; }
    __device__ bool next(int i, Unit& u) const {
        const int t = i / 3, m = i - 3 * t;
        const long L = (long)t * G + c; if (L >= nwg) return false;
        int wgid = (int)L; { const int q = nwg / NXCD, r = nwg % NXCD, xcd = wgid % NXCD, off = wgid / NXCD; wgid = (xcd < r ? xcd * (q + 1) : r * (q + 1) + (xcd - r) * q) + off; }
        const int nig = WGM * nN, gid = wgid / nig, fm = gid * WGM, gsz = (nM - fm) < WGM ? (nM - fm) : WGM;
        u.pm = fm + ((wgid % nig) % gsz); u.pn = (wgid % nig) / gsz; u.ex = m; return true;
    }
    __device__ __forceinline__ void ptrs(const Gemm& g, const Unit& u, const char*& a, const char*& b) const {
        const size_t tstep = (size_t)BM * g.K * 2; a = (const char*)g.A + (size_t)u.ex * astride + (size_t)u.pm * tstep; b = (const char*)g.Bt + (size_t)u.ex * bstride + (size_t)u.pn * tstep; }
};
struct MoeOrder {
    int G, c, npn, ntiles; const LAS unsigned char* tab; size_t estride;
    __device__ bool next(int i, Unit& u) const {
        const long L = (long)i * G + c; if (L >= (long)ntiles * npn) return false;
        u.pm = (int)(L / npn); u.pn = (int)(L % npn); u.ex = (int)tab[u.pm]; return true;
    }
    __device__ __forceinline__ void ptrs(const Gemm& g, const Unit& u, const char*& a, const char*& b) const {
        const size_t tstep = (size_t)BM * g.K * 2; a = (const char*)g.A + (size_t)u.pm * tstep; b = (const char*)g.Bt + (size_t)u.ex * estride + (size_t)u.pn * tstep; }
};

template <class Epi, class Sched>
__device__ __forceinline__ void gemm_phase(LAS unsigned char* lds, const int tid, const Gemm g, const Sched& S, const Epi& E) {
    const int wid = __builtin_amdgcn_readfirstlane(tid >> 6), lane = tid & 63, wr = wid >> 2, wc = wid & 3, fr = lane & 15, fq = lane >> 4;
    int K = g.K; asm volatile("" : "+s"(K));
    const int nt = K / BK;
    unsigned voffA[2], voffB[2];
#pragma unroll
    for (int i = 0; i < 2; ++i) { int R, C; stage_rc(tid * 16 + i * 8192, R, C); const int Rb = Epi::PERM ? ((R & ~31) + perm32(R & 31)) : R;
        voffA[i] = (unsigned)(R * K + C) * 2u; voffB[i] = (unsigned)(Rb * K + C) * 2u; }
    const size_t kstep = (size_t)(BK * 2);
    const size_t hstep = (size_t)HALF * K * 2;
    const unsigned ldsw = (unsigned)wid * 1024u;
    const int aoff = lds_byte(wr * 64 + fr, fq * 8), boff = lds_byte(wc * 32 + fr, fq * 8);
#define PG8_SA(b, h) (((b) * 2 + (h)) * HTB)
#define PG8_SB(b, h) ((4 + (b) * 2 + (h)) * HTB)
#define PG8_STAGE(bufoff, gbase, voff) do { _Pragma("unroll") for (int _i = 0; _i < 2; ++_i) \
        __builtin_amdgcn_global_load_lds((const unsigned*)((const char*)(gbase) + (voff)[_i]), (LAS unsigned*)(lds + (bufoff) + ldsw + _i * 8192), 16, 0, 0); } while (0)
#define PG8_LDA(dst, b, h) do { _Pragma("unroll") for (int m = 0; m < 4; ++m) _Pragma("unroll") for (int k = 0; k < 2; ++k) dst[m][k] = *(const LAS bf16x8*)(lds + PG8_SA(b, h) + aoff + m * 2048 + k * 1024); } while (0)
#define PG8_LDB(dst, b, h) do { _Pragma("unroll") for (int n = 0; n < 2; ++n) _Pragma("unroll") for (int k = 0; k < 2; ++k) dst[n][k] = *(const LAS bf16x8*)(lds + PG8_SB(b, h) + boff + n * 2048 + k * 1024); } while (0)
#define PG8_MMA(ai, bj, At, Bt) do { __builtin_amdgcn_s_setprio(1); _Pragma("unroll") for (int m = 0; m < 4; ++m) _Pragma("unroll") for (int n = 0; n < 2; ++n) _Pragma("unroll") for (int k = 0; k < 2; ++k) \
        acc[ai][bj][m][n] = __builtin_amdgcn_mfma_f32_16x16x32_bf16(Bt[n][k], At[m][k], acc[ai][bj][m][n], 0, 0, 0); __builtin_amdgcn_s_setprio(0); } while (0)
#define PG8_WAIT_V(n) asm volatile("s_waitcnt vmcnt(" #n ")" ::: "memory")
#define PG8_WAIT_L(n) asm volatile("s_waitcnt lgkmcnt(" #n ")" ::: "memory")
#define PG8_BAR __builtin_amdgcn_s_barrier()
#define PG8_SCHED __builtin_amdgcn_sched_barrier(0)
    Unit cur, nxt; int ui = 0;
    if (!S.next(0, cur)) return;
    f32x4 acc[2][2][4][2];
#pragma unroll
    for (int a = 0; a < 2; ++a)
#pragma unroll
        for (int b = 0; b < 2; ++b)
#pragma unroll
            for (int m = 0; m < 4; ++m)
#pragma unroll
                for (int n = 0; n < 2; ++n) acc[a][b][m][n] = (f32x4){0.f, 0.f, 0.f, 0.f};
    bf16x8 At[4][2], B0[2][2], B1[2][2];
    const char* cA; const char* cB; S.ptrs(g, cur, cA, cB);
    PG8_STAGE(PG8_SB(0, 0), cB, voffB); PG8_STAGE(PG8_SA(0, 0), cA, voffA); PG8_STAGE(PG8_SB(0, 1), cB + hstep, voffB); PG8_STAGE(PG8_SA(0, 1), cA + hstep, voffA);
    if (wr == 1) PG8_BAR;
    PG8_WAIT_V(4); PG8_BAR;
    PG8_STAGE(PG8_SB(1, 0), cB + kstep, voffB); PG8_STAGE(PG8_SA(1, 0), cA + kstep, voffA); PG8_STAGE(PG8_SB(1, 1), cB + hstep + kstep, voffB);
    PG8_WAIT_V(6); PG8_BAR;
    for (;;) {
        const bool has_next = S.next(ui + 1, nxt);
        const char* nA = cA; const char* nB = cB; if (has_next) S.ptrs(g, nxt, nA, nB);
        for (int t = 0; t < nt; t += 2) {
            const bool last = (t == nt - 2);
            const char* a1 = cA + (size_t)(t + 1) * kstep;
            const char* a2 = last ? nA : cA + (size_t)(t + 2) * kstep; const char* b2 = last ? nB : cB + (size_t)(t + 2) * kstep;
            const char* a3 = a2 + kstep; const char* b3 = b2 + kstep;
            PG8_LDB(B0, 0, 0); PG8_SCHED; PG8_LDA(At, 0, 0); PG8_STAGE(PG8_SA(1, 1), a1 + hstep, voffA);
            PG8_WAIT_L(8); PG8_BAR; PG8_WAIT_L(0); PG8_MMA(0, 0, At, B0); PG8_BAR; PG8_SCHED;
            PG8_LDB(B1, 0, 1); PG8_STAGE(PG8_SB(0, 0), b2, voffB);
            PG8_BAR; PG8_WAIT_L(0); PG8_MMA(0, 1, At, B1); PG8_BAR;
            PG8_LDA(At, 0, 1); PG8_STAGE(PG8_SA(0, 0), a2, voffA);
            PG8_BAR; PG8_WAIT_L(0); PG8_MMA(1, 0, At, B0); PG8_BAR; PG8_SCHED;
            PG8_STAGE(PG8_SB(0, 1), b2 + hstep, voffB);
            PG8_WAIT_V(6); PG8_BAR; PG8_MMA(1, 1, At, B1); PG8_BAR;
            PG8_LDB(B0, 1, 0); PG8_SCHED; PG8_LDA(At, 1, 0); PG8_STAGE(PG8_SA(0, 1), a2 + hstep, voffA);
            PG8_WAIT_L(8); PG8_BAR; PG8_WAIT_L(0); PG8_MMA(0, 0, At, B0); PG8_BAR; PG8_SCHED;
            PG8_LDB(B1, 1, 1); PG8_STAGE(PG8_SB(1, 0), b3, voffB);
            PG8_BAR; PG8_WAIT_L(0); PG8_MMA(0, 1, At, B1); PG8_BAR;
            PG8_LDA(At, 1, 1); PG8_STAGE(PG8_SA(1, 0), a3, voffA);
            PG8_BAR; PG8_WAIT_L(0); PG8_MMA(1, 0, At, B0); PG8_BAR; PG8_SCHED;
            PG8_STAGE(PG8_SB(1, 1), b3 + hstep, voffB);
            PG8_WAIT_V(6); PG8_BAR; PG8_MMA(1, 1, At, B1); PG8_BAR;
        }
        E(acc, cur, wr, wc, fr, fq);
        if (!has_next) break;
#pragma unroll
        for (int a = 0; a < 2; ++a)
#pragma unroll
            for (int b = 0; b < 2; ++b)
#pragma unroll
                for (int m = 0; m < 4; ++m)
#pragma unroll
                    for (int n = 0; n < 2; ++n) acc[a][b][m][n] = (f32x4){0.f, 0.f, 0.f, 0.f};
        cur = nxt; cA = nA; cB = nB; ++ui;
    }
    PG8_WAIT_V(0);
    if (wr == 0) PG8_BAR;
    PG8_BAR;
#undef PG8_SA
#undef PG8_SB
#undef PG8_STAGE
#undef PG8_LDA
#undef PG8_LDB
#undef PG8_MMA
#undef PG8_WAIT_V
#undef PG8_WAIT_L
#undef PG8_BAR
#undef PG8_SCHED
}

#define EPI_PERM_LOOP(...) \
    _Pragma("unroll") for (int ai = 0; ai < 2; ++ai) _Pragma("unroll") for (int m = 0; m < 4; ++m) { const int row = u.pm * BM + ai * HALF + wr * 64 + m * 16 + fr; \
        _Pragma("unroll") for (int bj = 0; bj < 2; ++bj) { const int col0 = u.pn * BM + bj * HALF + wc * 32 + 8 * fq; f32x4 v0 = acc[ai][bj][m][0], v1 = acc[ai][bj][m][1]; __VA_ARGS__ } if (EPI_PIN) __builtin_amdgcn_sched_barrier(0); }

struct EpiInProj {
    static constexpr bool PERM = true, EPI_PIN = true;
    bf16_t* P; bf16_t* halo;
    __device__ __forceinline__ void operator()(const f32x4 (&acc)[2][2][4][2], const Unit& u, int wr, int wc, int fr, int fq) const {
        const bool is_qkv = u.pn >= 8 && u.pn < 14;
        EPI_PERM_LOOP({
            u32x4 w; w.x = pk2(v0[0], v0[1]); w.y = pk2(v0[2], v0[3]); w.z = pk2(v1[0], v1[1]); w.w = pk2(v1[2], v1[3]);
            *(u32x4*)(P + (size_t)row * LDP + col0) = w;
            if (is_qkv && (row & 63) >= 61) *(u32x4*)(halo + ((size_t)(row >> 6) * 3 + ((row & 63) - 61)) * 1536 + (col0 - PC_BQKV)) = w;
        })
    }
};
__device__ __forceinline__ float lfg(float lb, float oml, float x) { return __logf(lb + oml * __builtin_amdgcn_rcpf(1.0f + __expf(-x)) + 1e-30f); }
struct EpiSigmoid {
    static constexpr bool PERM = true, EPI_PIN = true;
    bf16_t* O; int ldc;
    __device__ __forceinline__ void operator()(const f32x4 (&acc)[2][2][4][2], const Unit& u, int wr, int wc, int fr, int fq) const {
        EPI_PERM_LOOP({
            u32x4 w; w.x = pk2(sigmoidf_(v0[0]), sigmoidf_(v0[1])); w.y = pk2(sigmoidf_(v0[2]), sigmoidf_(v0[3])); w.z = pk2(sigmoidf_(v1[0]), sigmoidf_(v1[1])); w.w = pk2(sigmoidf_(v1[2]), sigmoidf_(v1[3]));
            *(u32x4*)(O + (size_t)row * ldc + col0) = w;
        })
    }
};
struct EpiBranch {
    static constexpr bool PERM = true, EPI_PIN = false;
    bf16_t* merged; const bf16_t* gt;
    __device__ __forceinline__ void operator()(const f32x4 (&acc)[2][2][4][2], const Unit& u, int wr, int wc, int fr, int fq) const {
        const int n = u.ex;
        EPI_PERM_LOOP({
            const u32x4 gw = *(const u32x4*)(gt + (size_t)row * 3072 + n * 1024 + col0);
            float x[8] = {v0[0] * bflo(gw.x), v0[1] * bfhi(gw.x), v0[2] * bflo(gw.y), v0[3] * bfhi(gw.y), v1[0] * bflo(gw.z), v1[1] * bfhi(gw.z), v1[2] * bflo(gw.w), v1[3] * bfhi(gw.w)};
            bf16_t* mp = merged + (size_t)row * 1024 + col0;
            if (n != 0) { const u32x4 o = *(const u32x4*)mp; x[0] += bflo(o.x); x[1] += bfhi(o.x); x[2] += bflo(o.y); x[3] += bfhi(o.y); x[4] += bflo(o.z); x[5] += bfhi(o.z); x[6] += bflo(o.w); x[7] += bfhi(o.w); }
            u32x4 w; w.x = pk2(x[0], x[1]); w.y = pk2(x[2], x[3]); w.z = pk2(x[4], x[5]); w.w = pk2(x[6], x[7]);
            *(u32x4*)mp = w;
        })
    }
};
struct EpiResidual {
    static constexpr bool PERM = false;
    float* hreal; float* hmeta;
    __device__ __forceinline__ void operator()(const f32x4 (&acc)[2][2][4][2], const Unit& u, int wr, int wc, int fr, int fq) const {
#pragma unroll
        for (int ai = 0; ai < 2; ++ai)
#pragma unroll
            for (int m = 0; m < 4; ++m) { const int row = u.pm * BM + ai * HALF + wr * 64 + m * 16 + fr;
                float* rowp = (row < NREAL ? hreal + (size_t)row * D : hmeta + (size_t)(row - NREAL) * D) + u.pn * BM + wc * 32 + 4 * fq;
#pragma unroll
                for (int bj = 0; bj < 2; ++bj)
#pragma unroll
                    for (int n = 0; n < 2; ++n) { f32x4* p = (f32x4*)(rowp + bj * HALF + n * 16); *p = *p + acc[ai][bj][m][n]; } }
    }
};
struct EpiMoeUp {
    static constexpr bool PERM = true, EPI_PIN = true;
    bf16_t* H;
    __device__ __forceinline__ void operator()(const f32x4 (&acc)[2][2][4][2], const Unit& u, int wr, int wc, int fr, int fq) const {
        EPI_PERM_LOOP({
            const int hc = col0 >> 1;
            u32x2 w; w.x = pk2(siluf_(v0[0]) * v1[0], siluf_(v0[1]) * v1[1]); w.y = pk2(siluf_(v0[2]) * v1[2], siluf_(v0[3]) * v1[3]);
            *(u32x2*)(H + (size_t)row * 256 + hc) = w;
        })
    }
};
struct EpiMoeDown {
    static constexpr bool PERM = true, EPI_PIN = false;
    bf16_t* Y; const float* wrow;
    __device__ __forceinline__ void operator()(const f32x4 (&acc)[2][2][4][2], const Unit& u, int wr, int wc, int fr, int fq) const {
        EPI_PERM_LOOP({
            const float s = wrow[row];
            u32x4 w; w.x = pk2(v0[0] * s, v0[1] * s); w.y = pk2(v0[2] * s, v0[3] * s); w.z = pk2(v1[0] * s, v1[1] * s); w.w = pk2(v1[2] * s, v1[3] * s);
            *(u32x4*)(Y + (size_t)row * 1024 + col0) = w;
        })
    }
};
}
#define GAS __attribute__((address_space(1)))
struct Params { const float* in[24]; float* out; unsigned char* ws; int ph_lo, ph_hi; };
struct Frame {
    LAS unsigned char* lds; int tid, lane, wave, G, bid;
    __attribute__((address_space(1))) float* out; __attribute__((address_space(1))) unsigned char* ws; const float* const __attribute__((address_space(4)))* inp; int dry;
};
#define PHASE_FENCE(F) do { asm volatile("" : "+s"((F).ws), "+s"((F).out), "+s"((F).inp), "+v"((F).tid), "+s"((F).bid), "+s"((F).G)); \
    (F).lane = (F).tid & 63; (F).wave = __builtin_amdgcn_readfirstlane((F).tid >> 6); } while (0)
__device__ __forceinline__ const float* inp_ptr(const float* const __attribute__((address_space(4)))* inp, int i) { GAS const float* q = (GAS const float*)inp[i]; asm volatile("" : "+s"(q)); return (const float*)q; }
#define INP(i) inp_ptr(F.inp, (i))
#define WSP(T, off) ((T*)(GAS T*)(F.ws + (off)))
enum { I_X = 0, I_META, I_NORM_MIX, I_W_IN, I_LB, I_HGRN_NORM, I_GDN_CONV, I_GDN_ALOG, I_GDN_DT, I_GDN_NORM, I_GLA_W2, I_GLA_B, I_GLA_NORM, I_W_BRANCH, I_W_OUT, I_NORM_FFN,
       I_RG_W, I_RG_B, I_RE_W, I_RE_B, I_EW_GATE, I_EW_UP, I_EW_DOWN, I_NORM_FINAL };

struct TItem { const float* W; bf16_t* WT; int ldw, K, nblk, rowmode, item; };
__device__ __forceinline__ void titem_load(const TItem& t, int lane, f32x4 (&v)[8]) {
    const int kb = t.item / t.nblk, nb = t.item % t.nblk, k0 = 64 * kb, n0 = 32 * nb, n4 = 4 * (lane & 7);
#pragma unroll
    for (int i = 0; i < 8; ++i) v[i] = *(const f32x4*)(t.W + (size_t)(k0 + 8 * i + (lane >> 3)) * t.ldw + n0 + n4);
}
__device__ __forceinline__ void titem_finish(const TItem& t, int lane, const f32x4 (&v)[8], LAS float* scr) {
    const int kb = t.item / t.nblk, nb = t.item % t.nblk, k0 = 64 * kb, n0 = 32 * nb, n4 = 4 * (lane & 7);
#pragma unroll
    for (int i = 0; i < 8; ++i) { LAS float* d = scr + (8 * i + (lane >> 3)) * 33 + n4; d[0] = v[i][0]; d[1] = v[i][1]; d[2] = v[i][2]; d[3] = v[i][3]; }
    LDS_WAIT(); asm volatile("" ::: "memory");
    const int c = lane & 7;
#pragma unroll
    for (int j = 0; j < 4; ++j) { const int n = (lane >> 3) + 8 * j; const LAS float* s = scr + (8 * c) * 33 + n;
        u32x4 o; o.x = pk2(s[0 * 33], s[1 * 33]); o.y = pk2(s[2 * 33], s[3 * 33]); o.z = pk2(s[4 * 33], s[5 * 33]); o.w = pk2(s[6 * 33], s[7 * 33]);
        const int nn = n0 + n; const int wrow = t.rowmode == 0 ? nn : 8 * (nn >> 2) + (nn & 3) + (t.rowmode == 2 ? 4 : 0);
        *(u32x4*)(t.WT + (size_t)wrow * t.K + k0 + 8 * c) = o; }
    LDS_WAIT(); asm volatile("" ::: "memory");
}
#define CONVERT_LOOP(NITEMS, RESOLVE) do { LAS float* scr = (LAS float*)(F.lds + F.wave * 17408); const int gw = F.bid * NWAVES + F.wave, NGW = F.G * NWAVES; \
    for (int it = gw; it < (NITEMS); it += 2 * NGW) { const bool two = it + NGW < (NITEMS); TItem ta = RESOLVE(it), tb = RESOLVE(two ? it + NGW : it); f32x4 va[8], vb[8]; \
        titem_load(ta, F.lane, va); if (two) titem_load(tb, F.lane, vb); \
        titem_finish(ta, F.lane, va, scr); if (two) titem_finish(tb, F.lane, vb, scr + 64 * 33 + 32); } } while (0)

__device__ __forceinline__ void phase_pre(Frame& F) {
    const int gt = F.bid * NTHREADS + F.tid, NT = F.G * NTHREADS;
    float* sw1 = WSP(float, SM_SW1); float* rwg = WSP(float, SM_RWG); float* rwe = WSP(float, SM_RWE); float* lab = WSP(float, SM_LAB);
    for (int i = gt; i < 2 * 24 * 1024; i += NT) { const int l = i / (24 * 1024), c = (i / 1024) % 24, k = i % 1024;
        const int col = c < 16 ? 5128 + c : (c < 20 ? 3584 + (c - 16) : 3588 + (c - 20));
        sw1[i] = INP(I_W_IN)[((size_t)l * 1024 + k) * IN_COLS + col]; }
    for (int i = gt; i < 2 * 4 * 1024; i += NT) { const int l = i / (4 * 1024), c = (i / 1024) % 4, k = i % 1024; rwg[i] = INP(I_RG_W)[((size_t)l * 1024 + k) * 4 + c]; }
    for (int i = gt; i < 2 * 32 * 1024; i += NT) { const int l = i / (32 * 1024), c = (i / 1024) % 32, k = i % 1024; rwe[i] = INP(I_RE_W)[((size_t)l * 1024 + k) * 32 + c]; }
    for (int i = gt; i < 2 * 512; i += NT) { const int l = i / 512, c = i % 512; const float l0 = INP(I_LB)[c], l1 = INP(I_LB)[512 + c];
        const float p1 = 1.0f / (1.0f + expf(l0 - l1)); const float lb = l == 0 ? 0.f : p1;
        lab[l * 1024 + c] = lb; lab[l * 1024 + 512 + c] = 1.0f - lb; }
}

__device__ __forceinline__ void convert_layer_weights(Frame& F, int l) {
    const float* win = INP(I_W_IN) + (size_t)l * 1024 * IN_COLS;
    constexpr int I_MIX = 16 * 176, I_GATE = 16 * 96, I_BR = 8 * 32, I_OUT = 16 * 32, NITEMS = I_MIX + I_GATE + 3 * I_BR + I_OUT;
    auto resolve = [&](int it) { int r = it; TItem t;
        if (r < I_MIX) { const int nb = r % 176, n0 = 32 * nb; const int shift = n0 < 3584 ? 0 : (n0 < 5120 ? 8 : 24);
            t = TItem{win + shift, WSP(bf16_t, WS_WMIX), IN_COLS, 1024, 176, 0, r}; return t; } r -= I_MIX;
        if (r < I_GATE) { t = TItem{win + 5656, WSP(bf16_t, WS_WGATE), IN_COLS, 1024, 96, 0, r}; return t; } r -= I_GATE;
        if (r < 3 * I_BR) { const int n = r / I_BR; t = TItem{INP(I_W_BRANCH) + ((size_t)l * 3 + n) * 512 * 1024, WSP(bf16_t, WS_WBT) + (size_t)n * 1024 * 512, 1024, 512, 32, 0, r % I_BR}; return t; } r -= 3 * I_BR;
        t = TItem{INP(I_W_OUT) + (size_t)l * 1024 * 1024, WSP(bf16_t, WS_WOT), 1024, 1024, 32, 0, r}; return t; };
    CONVERT_LOOP(NITEMS, resolve);
}
__device__ __forceinline__ void convert_expert_weights(Frame& F, int l) {
    constexpr int I_G = 16 * 8, I_D = 4 * 32, PER = 2 * I_G + I_D;
    auto resolve = [&](int it) { const int e = it / PER; int r = it % PER; TItem t;
        bf16_t* w1t = WSP(bf16_t, WS_W1T) + (size_t)e * 512 * 1024; bf16_t* w2t = WSP(bf16_t, WS_W2T) + (size_t)e * 1024 * 256;
        if (r < I_G) { t = TItem{INP(I_EW_GATE) + ((size_t)l * 32 + e) * 1024 * 256, w1t, 256, 1024, 8, 1, r}; return t; } r -= I_G;
        if (r < I_G) { t = TItem{INP(I_EW_UP) + ((size_t)l * 32 + e) * 1024 * 256, w1t, 256, 1024, 8, 2, r}; return t; } r -= I_G;
        t = TItem{INP(I_EW_DOWN) + ((size_t)l * 32 + e) * 256 * 1024, w2t, 1024, 256, 32, 0, r}; return t; };
    CONVERT_LOOP(32 * PER, resolve);
}

#define OUTP ((float*)F.out)
__device__ __forceinline__ float* hrow(Frame& F, int r) { return r < NREAL ? OUTP + (size_t)r * D : WSP(float, WS_HMETA) + (size_t)(r - NREAL) * D; }

__device__ __forceinline__ void load_row16(const float* p, int lane, float (&x)[16]) {
#pragma unroll
    for (int j = 0; j < 4; ++j) { const f32x4 v = *((const f32x4*)p + lane + 64 * j); x[4 * j] = v[0]; x[4 * j + 1] = v[1]; x[4 * j + 2] = v[2]; x[4 * j + 3] = v[3]; }
}
__device__ __forceinline__ void add_bf16_row16(const bf16_t* p, int lane, float (&x)[16]) {
#pragma unroll
    for (int j = 0; j < 4; ++j) { const u32x2 w = *((const u32x2*)p + lane + 64 * j); x[4 * j] += bflo(w.x); x[4 * j + 1] += bfhi(w.x); x[4 * j + 2] += bflo(w.y); x[4 * j + 3] += bfhi(w.y); }
}
__device__ __forceinline__ void store_row16(float* p, int lane, const float (&x)[16]) {
#pragma unroll
    for (int j = 0; j < 4; ++j) *((f32x4*)p + lane + 64 * j) = (f32x4){x[4 * j], x[4 * j + 1], x[4 * j + 2], x[4 * j + 3]};
}
__device__ __forceinline__ void store_bf16_row16(bf16_t* p, int lane, const float (&x)[16]) {
#pragma unroll
    for (int j = 0; j < 4; ++j) { u32x2 w; w.x = pk2(x[4 * j], x[4 * j + 1]); w.y = pk2(x[4 * j + 2], x[4 * j + 3]); *((u32x2*)p + lane + 64 * j) = w; }
}
__device__ __forceinline__ void fetch_h_row(Frame& F, int l, int r, float (&x)[16]) {
    if (l == 0) {
        const float* src = r < NREAL ? INP(I_X) + (size_t)r * D : INP(I_META) + (size_t)(r - META_ROW0) * D;
        load_row16(src, F.lane, x);
    } else {
        load_row16(hrow(F, r), F.lane, x);
        const unsigned* tok = WSP(unsigned, SM_TOK) + (size_t)r * 8;
        const unsigned g0 = tok[6], g1 = tok[7];
        add_bf16_row16(WSP(bf16_t, WS_Y2) + (size_t)g0 * 1024, F.lane, x);
        add_bf16_row16(WSP(bf16_t, WS_Y2) + (size_t)g1 * 1024, F.lane, x);
    }
}

template <int N> struct IntC { static constexpr int value = N; };
__device__ __forceinline__ void phase_norm1(Frame& F, int l) {
    PROF_MARK(F, 40);
    convert_layer_weights(F, l);
    __syncthreads();
    PROF_MARK(F, 41);
    LAS float* sw = (LAS float*)F.lds;
    { const float* src = WSP(float, SM_SW1) + (size_t)l * 24 * 1024; for (int i = F.tid; i < 24 * 1024 / 4; i += NTHREADS) ((LAS f32x4*)sw)[i] = ((const f32x4*)src)[i]; }
    __syncthreads();
    const int gw = F.bid * NWAVES + F.wave, NGW = F.G * NWAVES, lane = F.lane;
    const float* nw = INP(I_NORM_MIX) + (size_t)l * D;
    float wv[16]; load_row16(nw, lane, wv);
    bf16_t* U = WSP(bf16_t, WS_U);
    const float alog_l = (lane >= 20 && lane < 24) ? INP(I_GDN_ALOG)[l * 4 + (lane - 20)] : 0.f, dt_l = (lane >= 20 && lane < 24) ? INP(I_GDN_DT)[l * 4 + (lane - 20)] : 0.f;
    const float nega_l = -expf(alog_l);
    float* GK = WSP(float, SM_GK); float* BETA = WSP(float, SM_BETA); float* LOGA = WSP(float, SM_LOGA);
    auto body = [&](auto NRc, const int r0) {
        constexpr int NR = decltype(NRc)::value;
        float x[NR][16];
#pragma unroll
        for (int i = 0; i < NR; ++i) {
            fetch_h_row(F, l, r0 + i, x[i]);
            store_row16(hrow(F, r0 + i), lane, x[i]);
            float ss = 0.f;
#pragma unroll
            for (int j = 0; j < 16; ++j) ss += x[i][j] * x[i][j];
            const float rstd = rsqrtf(wave_sum(ss) * (1.0f / D) + 1e-6f);
#pragma unroll
            for (int j = 0; j < 16; ++j) x[i][j] = x[i][j] * rstd * wv[j];
            store_bf16_row16(U + (size_t)(r0 + i) * D, lane, x[i]);
        }
        float ov[NR];
#pragma unroll
        for (int i = 0; i < NR; ++i) ov[i] = 0.f;
#pragma unroll 3
        for (int c = 0; c < 24; ++c) {
            float a[NR];
#pragma unroll
            for (int i = 0; i < NR; ++i) a[i] = 0.f;
#pragma unroll
            for (int j = 0; j < 4; ++j) { const f32x4 w = *((const LAS f32x4*)(sw + c * 1024) + lane + 64 * j);
#pragma unroll
                for (int e = 0; e < 4; ++e) {
#pragma unroll
                    for (int i = 0; i < NR; ++i) a[i] += x[i][4 * j + e] * w[e]; } }
#pragma unroll
            for (int i = 0; i < NR; ++i) { a[i] = wave_sum(a[i]); if (lane == c) ov[i] = a[i]; }
        }
#pragma unroll
        for (int i = 0; i < NR; ++i) {
            const float v = ov[i]; const int r = r0 + i;
            if (lane < 16) GK[(size_t)r * 16 + lane] = v;
            else if (lane < 20) BETA[(size_t)r * 4 + (lane - 16)] = sigmoidf_(v);
            else if (lane < 24) { const int h = lane - 20; LOGA[(size_t)r * 4 + h] = nega_l * softplusf_(v + dt_l); }
        }
    };
    for (int g = gw; g < NREAL / 4; g += NGW) body(IntC<4>{}, 4 * g);
    if (gw >= NGW - 16) body(IntC<1>{}, META_ROW0 + (NGW - 1 - gw));
    for (int r = NREAL + gw; r < MROWS; r += NGW) {
        if (row_valid(r)) continue;
        float z[16];
#pragma unroll
        for (int j = 0; j < 16; ++j) z[j] = 0.f;
        store_bf16_row16(U + (size_t)r * D, lane, z); if (l == 0) store_row16(hrow(F, r), lane, z);
        if (lane < 16) GK[(size_t)r * 16 + lane] = 0.f;
        else if (lane < 20) BETA[(size_t)r * 4 + (lane - 16)] = 0.f;
        else if (lane < 24) LOGA[(size_t)r * 4 + (lane - 20)] = 0.f;
    }
}

__device__ __forceinline__ bf16x8 mk8(u32x4 w) { return __builtin_bit_cast(bf16x8, w); }
__device__ __forceinline__ bf16x8 mk8(u32x2 lo, u32x2 hi) { u32x4 w; w.x = lo.x; w.y = lo.y; w.z = hi.x; w.w = hi.y; return __builtin_bit_cast(bf16x8, w); }
__device__ __forceinline__ bf16x8 pack_acc2(const f32x4& a, const f32x4& b) { u32x4 w; w.x = pk2(a[0], a[1]); w.y = pk2(a[2], a[3]); w.z = pk2(b[0], b[1]); w.w = pk2(b[2], b[3]); return __builtin_bit_cast(bf16x8, w); }
#define MFMA16(a, b, c) __builtin_amdgcn_mfma_f32_16x16x32_bf16((a), (b), (c), 0, 0, 0)

__device__ __forceinline__ int permpos(int k) { const int kk = k & 31; return (k & ~31) + ((kk & 16) ? 8 * ((kk - 16) >> 2) + 4 + (kk & 3) : 8 * (kk >> 2) + (kk & 3)); }
__device__ __forceinline__ float ldbf(GAS const bf16_t* p) { return bf2f(*p); }
#define ROWB(P, row, col) ((GAS const char*)(P) + ((size_t)(row) * LDP + (col)) * 2)
__device__ __forceinline__ float ldrow(GAS const char* rb, unsigned voff) { return bf2f(*(GAS const bf16_t*)(rb + voff)); }
__device__ __forceinline__ unsigned ldrow_u(GAS const char* rb, unsigned voff) { return (unsigned)*(GAS const bf16_t*)(rb + voff); }
__device__ __forceinline__ void strow(GAS const char* rb, unsigned voff, bf16_t v) { *(GAS bf16_t*)(rb + voff) = v; }

template <int DK> struct GlaPre { u32x4 t[(2 * (DK / 8) + 16) / 4]; f32x4 gk; };
template <int DK> __device__ __forceinline__ void gla_clear(GlaPre<DK>& p) {
#pragma unroll
    for (int n = 0; n < (2 * (DK / 8) + 16) / 4; ++n) p.t[n] = (u32x4){0u, 0u, 0u, 0u};
    p.gk = (f32x4){0.f, 0.f, 0.f, 0.f}; }
template <int DK, bool IS_A>
__device__ __forceinline__ void gla_issue(Frame& F, int ug, GlaPre<DK>& p) {
    int tid = F.tid; asm volatile("" : "+v"(tid));
    const int sg = __builtin_amdgcn_readfirstlane(tid >> 8), lt = tid & 255, unit = 2 * ug + sg, slot = unit >> 2, h = unit & 3, row0 = slot * 64;
    const int qcol = IS_A ? PC_AQ + h * 128 : PC_CQ + h * 64, kcol = IS_A ? PC_AF + h * 128 : PC_CK + h * 64, vcol = IS_A ? PC_AI + h * 128 : PC_CV + h * 128;
    const bf16_t* P = WSP(bf16_t, WS_P);
    constexpr int PQ = DK / 8, PPR = 2 * PQ + 16;
#pragma unroll
    for (int n = 0; n < PPR / 4; ++n) { const int idx = lt + 256 * n, row = idx / PPR, pc = idx % PPR;
        const int scol = pc < PQ ? qcol + 8 * pc : (pc < 2 * PQ ? kcol + 8 * (pc - PQ) : vcol + 8 * (pc - 2 * PQ));
        p.t[n] = *(const u32x4*)(P + (size_t)(row0 + row) * LDP + scol); }
    p.gk = (f32x4){0.f, 0.f, 0.f, 0.f};
    if (!IS_A) p.gk = ((const f32x4*)(WSP(float, SM_GK) + (size_t)row0 * 16))[lt];
    asm volatile("" ::: "memory");
}
template <int DK, bool IS_A, typename Hook>
__device__ __forceinline__ void prep_gla(Frame& F, int l, int ug, GlaPre<DK>& pre, Hook hook) {
    constexpr int QP = DK + 8, VP = 136, SUB = 2 * 64 * QP * 2 + 1024 + 4096 + 64 * VP * 2;
    PROF_MARK(F, IS_A ? 7 : 8);
    int tid = F.tid; asm volatile("" : "+v"(tid));
    const int sg = __builtin_amdgcn_readfirstlane(tid >> 8), lt = tid & 255, c = lt & 127, hf = __builtin_amdgcn_readfirstlane(lt >> 7);
    const int unit = 2 * ug + sg, slot = unit >> 2, h = unit & 3, row0 = slot * 64, r0 = row0 + 32 * hf;
    const int qcol = IS_A ? PC_AQ + h * 128 : PC_CQ + h * 64, kcol = IS_A ? PC_AF + h * 128 : PC_CK + h * 64, vcol = IS_A ? PC_AI + h * 128 : PC_CV + h * 128;
    bf16_t* P = WSP(bf16_t, WS_P);
    LAS bf16_t* qt = (LAS bf16_t*)(F.lds + sg * SUB);
    LAS bf16_t* kt = qt + 64 * QP;
    LAS float* tot = (LAS float*)(kt + 64 * QP);
    const bool act = c < DK;
    LAS bf16_t* rv = (LAS bf16_t*)(tot + 256 + 1024);
    float w2c[16], bias = 0.f;
    if (!IS_A && c < DK) { const float* w2 = INP(I_GLA_W2) + (size_t)l * 16 * 256 + h * 64 + c; bias = INP(I_GLA_B)[l * 256 + h * 64 + c];
#pragma unroll
        for (int j = 0; j < 16; ++j) w2c[j] = w2[j * 256]; }
    { constexpr int PQ = DK / 8, PPR = 2 * PQ + 16;
#pragma unroll
        for (int n = 0; n < PPR / 4; ++n) { const int idx = lt + 256 * n, row = idx / PPR, pc = idx % PPR;
            LAS bf16_t* dst = pc < PQ ? qt + row * QP + 8 * pc : (pc < 2 * PQ ? kt + row * QP + 8 * (pc - PQ) : rv + row * VP + 8 * (pc - 2 * PQ));
            *(LAS u32x4*)dst = pre.t[n]; } }
    if (!IS_A) { LAS float* gkl = tot + 256;
        ((LAS f32x4*)gkl)[lt] = pre.gk; }
    __syncthreads();
    PROF_MARKI(F, IS_A ? 29 : 19);
    float b[32];
    const unsigned vo = (unsigned)c * 2u, vop = (unsigned)permpos(c) * 2u;
    if (act) {
        float run = 0.f;
        if (IS_A) { const float* lab = WSP(float, SM_LAB) + l * 1024 + h * 128 + c; const float la = lab[0], lb = lab[512];
#pragma unroll
            for (int t = 0; t < 32; ++t) { run += pg8::lfg(la, lb, bf2f(kt[(32 * hf + t) * QP + c])); b[t] = run; }
        } else {
            const LAS f32x4* gk = (const LAS f32x4*)(tot + 256 + 32 * hf * 16);
#pragma unroll
            for (int tb = 0; tb < 32; tb += 4) { f32x4 g[16];
#pragma unroll
                for (int i = 0; i < 16; ++i) g[i] = gk[tb * 4 + i];
                asm volatile("" ::: "memory");
#pragma unroll
                for (int u = 0; u < 4; ++u) { float s = bias;
#pragma unroll
                    for (int j = 0; j < 16; ++j) s += g[4 * u + (j >> 2)][j & 3] * w2c[j];
                    run += logsigf_(s) * (1.0f / 16.0f); b[tb + u] = run; } }
        }
        tot[hf * 128 + c] = run;
    }
    __syncthreads();
    PROF_MARKI(F, IS_A ? 25 : 15);
    unsigned q1p[16], k1p[16];
    if (act) {
        const float bm = tot[c], bl = bm + tot[128 + c], boff = hf ? bm : 0.f;
        if (hf == 0 && !F.dry) (IS_A ? WSP(float, SM_DECA) + (size_t)unit * 128 : WSP(float, SM_DECC) + (size_t)unit * 64)[c] = __expf(bl);
#pragma unroll
        for (int t2 = 0; t2 < 16; ++t2) { float q1v[2], k1v[2];
#pragma unroll
            for (int u = 0; u < 2; ++u) { const int t = 2 * t2 + u; const float bt = b[t] + boff;
                const float qr = bf2f(qt[(32 * hf + t) * QP + c]), q = IS_A ? siluf_(qr) * 0.08838834764831845f : qr * 0.125f;
                float k;
                if (IS_A) { const float lf = t == 0 ? b[0] : b[t] - b[t - 1]; k = row_valid(r0 + t) ? 1.0f - __expf(lf) : 0.f; } else k = bf2f(kt[(32 * hf + t) * QP + c]);
                q1v[u] = q * __expf(bt); k1v[u] = k * __expf(bl - bt);
                qt[(32 * hf + t) * QP + c] = f2bf(q * __expf(fminf(bt - bm, 80.f))); kt[(32 * hf + t) * QP + c] = f2bf(k * __expf(fminf(bm - bt, 80.f))); }
            q1p[t2] = pk2(q1v[0], q1v[1]); k1p[t2] = pk2(k1v[0], k1v[1]); }
    }
    __syncthreads();
    PROF_MARKI(F, IS_A ? 26 : 16);
    if (act) {
        if (!F.dry) {
#pragma unroll
        for (int t2 = 0; t2 < 16; ++t2) { strow(ROWB(P, r0 + 2 * t2, qcol), vop, (bf16_t)(q1p[t2] & 0xffffu)); strow(ROWB(P, r0 + 2 * t2 + 1, qcol), vop, (bf16_t)(q1p[t2] >> 16)); } }
        bf16_t* kd = (IS_A ? P + (size_t)(row0 + (c >> 1)) * LDP + kcol + (c & 1) * 64 : P + (size_t)(row0 + c) * LDP + kcol) + 32 * hf;
#pragma unroll
        for (int o = 0; o < 4; ++o) if (!F.dry) *(u32x4*)(kd + 8 * o) = (u32x4){k1p[4 * o], k1p[4 * o + 1], k1p[4 * o + 2], k1p[4 * o + 3]};
    }
    asm volatile("" ::: "memory");
    hook();
    { const int ws = (tid >> 6) & 3, lane = tid & 63, fr = lane & 15, fq = lane >> 4;
        bf16_t* sc = (IS_A ? WSP(bf16_t, WS_SCA) : WSP(bf16_t, WS_SCC)) + (size_t)unit * 4096;
#pragma unroll
        for (int jt = 0; jt < 4; ++jt) { const int mt = ws, nt = jt; f32x4 acc = {0.f, 0.f, 0.f, 0.f};
            if (nt <= mt) {
#pragma unroll
                for (int ks = 0; ks < DK / 32; ++ks) { const bf16x8 a = *(const LAS bf16x8*)(qt + (16 * mt + fr) * QP + 32 * ks + 8 * fq), bb = *(const LAS bf16x8*)(kt + (16 * nt + fr) * QP + 32 * ks + 8 * fq); acc = MFMA16(a, bb, acc); } }
#pragma unroll
            for (int r = 0; r < 4; ++r) { const int t = 16 * mt + 4 * fq + r, s = 16 * nt + fr; if (!F.dry) sc[t * 64 + s] = (s <= t) ? f2bf(acc[r]) : (bf16_t)0; } }
    }
    PROF_MARKI(F, IS_A ? 27 : 17);
    { unsigned vp[16];
#pragma unroll
        for (int t2 = 0; t2 < 16; ++t2) { vp[t2] = (unsigned)rv[(32 * hf + 2 * t2) * VP + c] | ((unsigned)rv[(32 * hf + 2 * t2 + 1) * VP + c] << 16); }
        PROF_MARKI(F, IS_A ? 28 : 18);
        bf16_t* vd = P + (size_t)(row0 + (c >> 1)) * LDP + vcol + (c & 1) * 64 + 32 * hf;
#pragma unroll
        for (int o = 0; o < 4; ++o) if (!F.dry) *(u32x4*)(vd + 8 * o) = (u32x4){vp[4 * o], vp[4 * o + 1], vp[4 * o + 2], vp[4 * o + 3]}; }
    __syncthreads();
    PROF_MARK(F, IS_A ? 13 : 14);
}

typedef float f32x2v __attribute__((ext_vector_type(2)));
struct GdnPre { u32x4 t[12]; u32x4 h; };
__device__ __forceinline__ void gdn_issue(Frame& F, int ug, GdnPre& p) {
    int tid = F.tid; asm volatile("" : "+v"(tid));
    const int sg = __builtin_amdgcn_readfirstlane(tid >> 8), lt = tid & 255, unit = 2 * ug + sg, slot = unit >> 2, h = unit & 3, row0 = slot * 64;
    const bf16_t* P = WSP(bf16_t, WS_P);
    const int hslot = slot == 256 ? -1 : ((slot & 63) == 0 ? 256 : slot - 1);
#pragma unroll
    for (int n = 0; n < 12; ++n) { const int idx = lt + 256 * n, row = idx / 48, pc = idx % 48, comp = pc >> 4, c8 = (pc & 15) * 8;
        p.t[n] = *(const u32x4*)(P + (size_t)(row0 + row) * LDP + PC_BQKV + comp * 512 + h * 128 + c8); }
    p.h = (u32x4){0u, 0u, 0u, 0u};
    if (lt < 144 && hslot >= 0) { const int rr = lt / 48, pc = lt % 48, comp = pc >> 4, c8 = (pc & 15) * 8;
        p.h = *(const u32x4*)(WSP(bf16_t, SM_HALO) + ((size_t)hslot * 3 + rr) * 1536 + comp * 512 + h * 128 + c8); }
    asm volatile("" ::: "memory");
}
__device__ __forceinline__ void gdn_clear(GdnPre& p) {
#pragma unroll
    for (int n = 0; n < 12; ++n) p.t[n] = (u32x4){0u, 0u, 0u, 0u};
    p.h = (u32x4){0u, 0u, 0u, 0u}; }
template <typename Hook>
__device__ __forceinline__ void prep_gdn(Frame& F, int l, int ug, GdnPre& pre, Hook hook) {
    constexpr int NP = 136, SUB = 2 * 64 * NP * 2 + 64 * 68 * 4 + 1024 + 2304;
    PROF_MARK(F, 1);
    int tid = F.tid; asm volatile("" : "+v"(tid));
    const int lane = tid & 63, sg = __builtin_amdgcn_readfirstlane(tid >> 8), lt = tid & 255, unit = 2 * ug + sg, slot = unit >> 2, h = unit & 3, row0 = slot * 64;
    bf16_t* P = WSP(bf16_t, WS_P);
    LAS bf16_t* qs = (LAS bf16_t*)(F.lds + sg * SUB);
    LAS bf16_t* ks = qs + 64 * NP;
    LAS float* AT = (LAS float*)(F.lds + sg * SUB + 2 * 64 * NP * 2);
    LAS float* gs = AT + 64 * 68;
    if (lt < 64) { const int valid_u = 1; (void)valid_u; float g = WSP(float, SM_LOGA)[(size_t)(row0 + lt) * 4 + h];
#pragma unroll
        for (int o = 1; o < 64; o <<= 1) { const float t = __shfl_up(g, o); if (lane >= o) g += t; }
        gs[lt] = g; gs[64 + lt] = WSP(float, SM_BETA)[(size_t)(row0 + lt) * 4 + h];
        if (lt == 63 && !F.dry) WSP(float, SM_DECB)[unit] = __expf(g); }
    LAS bf16_t* rvs = (LAS bf16_t*)AT;
    LAS bf16_t* hl = (LAS bf16_t*)(gs + 256);
#pragma unroll
    for (int n = 0; n < 12; ++n) { const int idx = lt + 256 * n, row = idx / 48, pc = idx % 48, comp = pc >> 4, c8 = (pc & 15) * 8;
        *(LAS u32x4*)((comp == 0 ? qs : (comp == 1 ? ks : rvs)) + row * NP + c8) = pre.t[n]; }
    if (lt < 144) { const int rr = lt / 48, pc = lt % 48, comp = pc >> 4, c8 = (pc & 15) * 8; *(LAS u32x4*)(hl + rr * 384 + comp * 128 + c8) = pre.h; }
    __syncthreads();
    PROF_MARKG(F, 2);
    float col[64];
    {
        const int c = lt & 127;
#pragma unroll
        for (int pass = 0; pass < 2; ++pass) {
            if (pass == 1 && lt >= 128) break;
            const int comp = lt >= 128 ? 1 : (pass == 0 ? 0 : 2), ch = comp * 512 + h * 128 + c;
            const float w0 = INP(I_GDN_CONV)[((size_t)l * 4 + 0) * 1536 + ch], w1 = INP(I_GDN_CONV)[((size_t)l * 4 + 1) * 1536 + ch], w2 = INP(I_GDN_CONV)[((size_t)l * 4 + 2) * 1536 + ch], w3 = INP(I_GDN_CONV)[((size_t)l * 4 + 3) * 1536 + ch];
            LAS bf16_t* src = (comp == 0 ? qs : (comp == 1 ? ks : rvs)) + c;
            float x0 = bf2f(hl[comp * 128 + c]), x1 = bf2f(hl[384 + comp * 128 + c]), x2 = bf2f(hl[768 + comp * 128 + c]);
#pragma unroll
            for (int t = 0; t < 64; ++t) { const float x3 = bf2f(src[t * NP]); const float y = siluf_(w0 * x0 + w1 * x1 + w2 * x2 + w3 * x3); x0 = x1; x1 = x2; x2 = x3;
                if (comp == 0) src[t * NP] = f2bf(y); else { col[t] = y; if (comp == 1) src[t * NP] = f2bf(y); } }
        }
    }
    __syncthreads();
    PROF_MARKG(F, 3);
    const int wv = (tid >> 6) & 3, fr = lane & 15, fq = lane >> 4;
#pragma unroll
    for (int jt = 0; jt < 2; ++jt) { const int which = jt, mt = wv; const LAS bf16_t* ap = which ? qs : ks; f32x4 a4 = {0.f, 0.f, 0.f, 0.f};
#pragma unroll
        for (int k4 = 0; k4 < 4; ++k4) { const bf16x8 a = *(const LAS bf16x8*)(ap + (16 * mt + fr) * NP + 32 * k4 + 8 * fq); a4 = MFMA16(a, a, a4); }
#pragma unroll
        for (int r = 0; r < 4; ++r) if (4 * fq + r == fr) { if (which == 0) gs[128 + 16 * mt + fr] = rsqrtf(a4[r] + 1e-6f); else gs[192 + 16 * mt + fr] = rsqrtf(a4[r] + 1e-6f) * 0.08838834764831845f; } }
    __syncthreads();
    { bf16_t* qkd = WSP(bf16_t, WS_QKD) + (size_t)unit * 4096;
#pragma unroll
        for (int jt = 0; jt < 8; ++jt) { const int tile = wv * 8 + jt, which = tile >> 4, mt = (tile >> 2) & 3, nt = tile & 3;
            const LAS bf16_t* ap = which ? qs : ks; f32x4 a4 = {0.f, 0.f, 0.f, 0.f};
            if (nt <= mt) {
#pragma unroll
                for (int k4 = 0; k4 < 4; ++k4) { const bf16x8 a = *(const LAS bf16x8*)(ap + (16 * mt + fr) * NP + 32 * k4 + 8 * fq), bb = *(const LAS bf16x8*)(ks + (16 * nt + fr) * NP + 32 * k4 + 8 * fq); a4 = MFMA16(a, bb, a4); } }
#pragma unroll
            for (int r = 0; r < 4; ++r) { const int t = 16 * mt + 4 * fq + r, s = 16 * nt + fr; const float dec = __expf(fminf(gs[t] - gs[s], 0.f)) * gs[128 + s];
                if (which) { if (!F.dry) qkd[t * 64 + permpos(s)] = (s <= t) ? f2bf(a4[r] * dec * gs[192 + t]) : (bf16_t)0; }
                else AT[s * 68 + t] = (s < t) ? gs[64 + t] * gs[128 + t] * a4[r] * dec : 0.f; } }
    }
    PROF_MARKG(F, 4);
    if (lt >= 128) { const int d = lt - 128; const float gl = gs[63]; bf16_t* dst = WSP(bf16_t, WS_K1TB) + (size_t)unit * 8192 + d * 64;
#pragma unroll
        for (int o = 0; o < 8; ++o) { const int s0 = 32 * (o >> 2) + 4 * (o & 3); float y[8];
#pragma unroll
            for (int j = 0; j < 8; ++j) { const int s = s0 + (j & 3) + (j >> 2) * 16; y[j] = col[s] * gs[128 + s] * __expf(gl - gs[s]); }
            if (!F.dry) *(u32x4*)(dst + 8 * o) = (u32x4){pk2(y[0], y[1]), pk2(y[2], y[3]), pk2(y[4], y[5]), pk2(y[6], y[7])}; }
    } else { const int pp = permpos(lt);
#pragma unroll 8
        for (int t = 0; t < 64; ++t) if (!F.dry) P[(size_t)(row0 + t) * LDP + PC_BQKV + h * 128 + pp] = f2bf(bf2f(qs[t * NP + lt]) * gs[192 + t] * __expf(gs[t])); }
    __syncthreads();
    PROF_MARKG(F, 5);
#pragma unroll
    for (int i = 0; i < 64; ++i) col[i] *= lt < 128 ? gs[64 + i] : gs[64 + i] * gs[128 + i] * __expf(gs[i]);
    { f32x4 cur[16], nxt[16];
#pragma unroll
        for (int q4 = 0; q4 < 16; ++q4) cur[q4] = *(const LAS f32x4*)(AT + 4 * q4);
#pragma unroll
        for (int j = 0; j < 63; ++j) { const float xj = col[j]; const f32x2v nx = {-xj, -xj};
            if (j + 1 < 63) {
#pragma unroll
                for (int q4 = (j + 2) >> 2; q4 < 16; ++q4) nxt[q4] = *(const LAS f32x4*)(AT + (j + 1) * 68 + 4 * q4); }
            asm volatile("" ::: "memory");
#pragma unroll
            for (int q4 = (j + 1) >> 2; q4 < 16; ++q4) {
#pragma unroll
                for (int p = 0; p < 2; ++p) { const int i0 = 4 * q4 + 2 * p;
                    if (i0 > j) { f32x2v c = {col[i0], col[i0 + 1]}; const f32x2v a = {cur[q4][2 * p], cur[q4][2 * p + 1]}; c = c + a * nx; col[i0] = c.x; col[i0 + 1] = c.y; }
                    else if (i0 + 1 > j) col[i0 + 1] -= cur[q4][2 * p + 1] * xj; } }
#pragma unroll
            for (int q4 = (j + 2) >> 2; q4 < 16; ++q4) cur[q4] = nxt[q4]; } }
    PROF_MARKG(F, 6);
    int tid2 = F.tid; asm volatile("" : "+v"(tid2)); const int lt2 = tid2 & 255, unit2 = 2 * ug + __builtin_amdgcn_readfirstlane(tid2 >> 8), row02 = (unit2 >> 2) * 64, h2 = unit2 & 3;
    if (lt2 < 128) { bf16_t* dst = P + (size_t)(row02 + (lt2 >> 1)) * LDP + PC_BQKV + 1024 + h2 * 128 + (lt2 & 1) * 64;
#pragma unroll
        for (int o = 0; o < 8; ++o) if (!F.dry) *(u32x4*)(dst + 8 * o) = (u32x4){pk2(col[8 * o], col[8 * o + 1]), pk2(col[8 * o + 2], col[8 * o + 3]), pk2(col[8 * o + 4], col[8 * o + 5]), pk2(col[8 * o + 6], col[8 * o + 7])};
    } else { const int pp = permpos(lt2 - 128);
        if (!F.dry) {
#pragma unroll
        for (int t = 0; t < 64; ++t) strow(ROWB(P, row02 + t, PC_BQKV + 512 + h2 * 128), (unsigned)pp * 2u, f2bf(col[t])); } }
    asm volatile("" ::: "memory");
    hook();
    __syncthreads();
    PROF_MARK(F, 9);
}

constexpr int SETC = 13, NSETS = 65 / SETC;
static_assert(SETC * NSETS == 65, "sets must tile the 65 scan steps");
__device__ __forceinline__ int set_np(int set) { return 2 * (set == 0 ? 1 + 4 * (SETC - 1) : 4 * SETC); }
__device__ __forceinline__ int set_ug(int set, int vp) { const int j = vp >> 1; int slot;
    if (set == 0) slot = j == 0 ? 256 : ((j - 1) / (SETC - 1)) * 64 + (j - 1) % (SETC - 1);
    else slot = (j / SETC) * 64 + SETC * set - 1 + j % SETC;
    return 2 * slot + (vp & 1); }
constexpr int SCAN_BUF = 57344;
template <int MX> struct ScanCfg;
template <> struct ScanCfg<0> { static constexpr int NM = 3, NI = 5; static constexpr int off(int m) { return m == 0 ? 0 : (m == 1 ? 16384 : 32768); } static constexpr int pitch(int m) { return m == 0 ? 256 : 128; } };
template <> struct ScanCfg<1> { static constexpr int NM = 4, NI = 7; static constexpr int off(int m) { return 16384 * m; } static constexpr int pitch(int m) { return m < 2 ? 256 : 128; } };
template <> struct ScanCfg<2> { static constexpr int NM = 3, NI = 3; static constexpr int off(int m) { return 8192 * m; } static constexpr int pitch(int m) { return 128; } };

#define SET_CNT(l, k) (WSP(unsigned, WS_CTL) + 8192 + (l) * 8 + (k))
#define XPREP(x) (WSP(unsigned, WS_CTL) + 8192 + 64 + (x))
#define SET_XCNT(l, k, x) (WSP(unsigned, WS_CTL) + 8192 + 128 + ((l) * 8 + (k)) * 16 + (x))
#define SET_SIGNAL(l, k, NYOUNG) do { asm volatile("s_waitcnt vmcnt(" #NYOUNG ")" ::: "memory"); __syncthreads(); \
    if (F.tid == 0) { const unsigned x_ = xb_xcc_id(), np_ = xb_ld(XPREP(x_)); const unsigned old_ = xb_add(SET_XCNT(l, k, x_), 1u); \
        if (old_ + 1u == np_) { __builtin_amdgcn_fence(__ATOMIC_RELEASE, "agent"); asm volatile("s_waitcnt vmcnt(0)" ::: "memory"); (void)xb_add(SET_CNT(l, k), 1u); } } } while (0)
#define SET_WAIT(l, k) do { asm volatile("s_waitcnt vmcnt(0)" ::: "memory"); __syncthreads(); \
    if (F.tid == 0) { unsigned* bar_ = WSP(unsigned, WS_CTL) + CW_BAR; unsigned need_ = 0u; for (unsigned x_ = 0; x_ < 16u; ++x_) need_ += xb_ld(XPREP(x_)) > 0u ? 1u : 0u; \
        XB_SPIN(xb_ld(SET_CNT(l, k)) < need_, bar_); \
        __builtin_amdgcn_fence(__ATOMIC_ACQUIRE, "agent"); asm volatile("s_waitcnt vmcnt(0)" ::: "memory"); } \
    __syncthreads(); asm volatile("" ::: "memory"); } while (0)
#define SCAN_GRID_BARRIER() do { xcd_barrier(WSP(unsigned, WS_CTL) + CW_BAR, xb_xcc_id(), (volatile LAS unsigned*)(F.lds + LDS_MISC) + 8, F.tid, (unsigned)F.G); asm volatile("" ::: "memory"); } while (0)
template <int MX>
__device__ __forceinline__ void scan_mixer(Frame& F, int l, int b, int h) {
    typedef ScanCfg<MX> C;
    constexpr int DK = MX == 2 ? 64 : 128, NT = DK / 16, NI = C::NI;
    const int w = F.wave, lane = F.lane, fr = lane & 15, fq = lane >> 4, ecol = 16 * w + fr;
    const char* Pb = (const char*)WSP(bf16_t, WS_P);
    const int qcol = MX == 0 ? PC_AQ + h * 128 : (MX == 1 ? PC_BQKV + h * 128 : PC_CQ + h * 64);
    const int kcol = MX == 0 ? PC_AF + h * 128 : (MX == 1 ? PC_BQKV + 512 + h * 128 : PC_CK + h * 64);
    const int vcol = MX == 0 ? PC_AI + h * 128 : (MX == 1 ? PC_BQKV + 1024 + h * 128 : PC_CV + h * 128);
    const char* SCb = (const char*)(MX == 0 ? WSP(bf16_t, WS_SCA) : (MX == 1 ? WSP(bf16_t, WS_QKD) : WSP(bf16_t, WS_SCC)));
    bf16_t* O = WSP(bf16_t, WS_O) + (size_t)MX * MROWS * 512;
    unsigned voff[NI]; int mi[NI];
#pragma unroll
    for (int i = 0; i < NI; ++i) { const int n = w + 8 * i, o = 1024 * n + 16 * lane; int m = 0;
#pragma unroll
        for (int q = 1; q < C::NM; ++q) if (o >= C::off(q)) m = q;
        int ro = o, pitch = 128;
#pragma unroll
        for (int q = 0; q < C::NM; ++q) if (m == q) { ro = o - C::off(q); pitch = C::pitch(q); }
        const int r = ro / pitch, pos = (ro % pitch) >> 4, pc = pos ^ (pitch == 256 ? (r & 15) : ((r >> 1) & 7));
        const bool packed = (MX == 0 && m == 1);
        const bool inP = (MX == 1) ? (m < 2) : (m < 2);
        voff[i] = (unsigned)(inP ? (packed ? (r >> 1) * (LDP * 2) + (r & 1) * 128 : r * (LDP * 2)) : r * pitch) + 16u * pc; mi[i] = m; }
    const unsigned x256_0 = (unsigned)(((0 | fq) ^ fr) << 4), x256_1 = (unsigned)(((4 | fq) ^ fr) << 4), x256_2 = (unsigned)(((8 | fq) ^ fr) << 4), x256_3 = (unsigned)(((12 | fq) ^ fr) << 4);
    const unsigned x128_0 = (unsigned)(((0 | fq) ^ ((fr >> 1) & 7)) << 4), x128_1 = (unsigned)(((4 | fq) ^ ((fr >> 1) & 7)) << 4);
    const unsigned x256[4] = {x256_0, x256_1, x256_2, x256_3}, x128[2] = {x128_0, x128_1};
#define SC_FRAG(buf, m, rt, kp) (*(const LAS bf16x8*)(F.lds + (buf) + C::off(m) + (16 * (rt) + fr) * C::pitch(m) + (C::pitch(m) == 256 ? x256[kp] : x128[(kp) & 1])))
    auto slot_of = [&](int step) { return step == 0 ? 256 : b * 64 + step - 1; };
    auto issue = [&](int step, int buf) {
        const int slot = slot_of(step), row0 = slot * 64, unit = slot * 4 + h;
        const char* base[4];
        if (MX == 1) { base[0] = Pb + ((size_t)row0 * LDP + kcol) * 2; base[1] = Pb + ((size_t)row0 * LDP + qcol) * 2; base[2] = (const char*)WSP(bf16_t, WS_K1TB) + (size_t)unit * 16384; base[3] = SCb + (size_t)unit * 8192; }
        else { base[0] = Pb + ((size_t)row0 * LDP + qcol) * 2; base[1] = Pb + ((size_t)row0 * LDP + kcol) * 2; base[2] = SCb + (size_t)unit * 8192; base[3] = base[2]; }
#pragma unroll
        for (int i = 0; i < NI; ++i) { const char* bs = mi[i] == 0 ? base[0] : (mi[i] == 1 ? base[1] : (mi[i] == 2 ? base[2] : base[3]));
            __builtin_amdgcn_global_load_lds((const unsigned*)(bs + voff[i]), (LAS unsigned*)(F.lds + buf + 1024 * (w + 8 * i)), 16, 0, 0); }
    };
    auto load_priv = [&](int step, u32x4 (&pv)[2]) {
        const int row0 = slot_of(step) * 64;
        const bf16_t* vt = (const bf16_t*)Pb + (size_t)(row0 + (ecol >> 1)) * LDP + vcol + (ecol & 1) * 64;
        if (MX == 1) { const u32x2 a = *(const u32x2*)(vt + 4 * fq), c = *(const u32x2*)(vt + 16 + 4 * fq), d = *(const u32x2*)(vt + 32 + 4 * fq), e = *(const u32x2*)(vt + 48 + 4 * fq);
            pv[0] = (u32x4){a.x, a.y, c.x, c.y}; pv[1] = (u32x4){d.x, d.y, e.x, e.y}; }
        else { pv[0] = *(const u32x4*)(vt + 8 * fq); pv[1] = *(const u32x4*)(vt + 32 + 8 * fq); }
    };
    f32x4 S[NT];
#pragma unroll
    for (int i = 0; i < NT; ++i) S[i] = (f32x4){0.f, 0.f, 0.f, 0.f};
    u32x4 pcur[2], pnxt[2];
    auto first_of_set = [](int s) { return s % SETC == 0; };
    bool pre_ok = false;
    unsigned need_sets = 0u; for (unsigned x_ = 0; x_ < 16u; ++x_) need_sets += xb_ld(XPREP(x_)) > 0u ? 1u : 0u;
    for (int step = 0; step < 65; ++step) {
        const int buf = (step & 1) * SCAN_BUF, slot = slot_of(step), row0 = slot * 64, unit = slot * 4 + h;
        if (first_of_set(step)) { if (!pre_ok) { PROF_MARK(F, 20); SET_WAIT(l, step / SETC); PROF_MARK(F, 21); issue(step, buf); load_priv(step, pcur); } pre_ok = false; }
        asm volatile("s_waitcnt vmcnt(0)" ::: "memory");
        __syncthreads();
        if (step + 1 < 65) {
            if (!first_of_set(step + 1)) { issue(step + 1, SCAN_BUF - buf); load_priv(step + 1, pnxt); }
            else {
                volatile LAS unsigned* flag = (volatile LAS unsigned*)(F.lds + LDS_MISC) + 12;
                if (F.tid == 0) { const unsigned ok = xb_ld(SET_CNT(l, (step + 1) / SETC)) >= need_sets ? 1u : 0u;
                    if (ok) { __builtin_amdgcn_fence(__ATOMIC_ACQUIRE, "agent"); asm volatile("s_waitcnt vmcnt(0)" ::: "memory"); }
                    flag[0] = ok; }
                __syncthreads();
                pre_ok = flag[0] != 0u;
                if (pre_ok) { issue(step + 1, SCAN_BUF - buf); load_priv(step + 1, pnxt); } } }
        bf16x8 Sb[NT / 2];
#pragma unroll
        for (int kp = 0; kp < NT / 2; ++kp) Sb[kp] = pack_acc2(S[2 * kp], S[2 * kp + 1]);
        bf16x8 fa[8], fb[8]; f32x4 o[4];
#define LD8(dst, m, rbase, nk) _Pragma("unroll") for (int j = 0; j < 8; ++j) dst[j] = SC_FRAG(buf, m, (rbase) + j / (nk), j % (nk))
#define PIN() __builtin_amdgcn_sched_barrier(0)
        if (MX == 1) {
            const float a = WSP(float, SM_DECB)[unit];
            f32x4 vn[4];
            LD8(fa, 0, 0, 4); LD8(fb, 0, 2, 4); PIN();
#pragma unroll
            for (int mt = 0; mt < 2; ++mt) { f32x4 acc = {0.f, 0.f, 0.f, 0.f};
#pragma unroll
                for (int kp = 0; kp < 4; ++kp) acc = MFMA16(fa[4 * mt + kp], Sb[kp], acc);
                vn[mt] = acc; }
            PIN(); LD8(fa, 1, 0, 4); PIN();
#pragma unroll
            for (int mt = 0; mt < 2; ++mt) { f32x4 acc = {0.f, 0.f, 0.f, 0.f};
#pragma unroll
                for (int kp = 0; kp < 4; ++kp) acc = MFMA16(fb[4 * mt + kp], Sb[kp], acc);
                vn[2 + mt] = acc; }
#pragma unroll
            for (int mt = 0; mt < 4; ++mt) {
                const unsigned u0 = mt == 0 ? pcur[0].x : (mt == 1 ? pcur[0].z : (mt == 2 ? pcur[1].x : pcur[1].z)), u1 = mt == 0 ? pcur[0].y : (mt == 1 ? pcur[0].w : (mt == 2 ? pcur[1].y : pcur[1].w));
                vn[mt] = (f32x4){bflo(u0) - vn[mt][0], bfhi(u0) - vn[mt][1], bflo(u1) - vn[mt][2], bfhi(u1) - vn[mt][3]}; }
            bf16x8 Vb[2]; Vb[0] = pack_acc2(vn[0], vn[1]); Vb[1] = pack_acc2(vn[2], vn[3]);
            PIN(); LD8(fb, 1, 2, 4); PIN();
#pragma unroll
            for (int mt = 0; mt < 2; ++mt) { f32x4 acc = {0.f, 0.f, 0.f, 0.f};
#pragma unroll
                for (int kp = 0; kp < 4; ++kp) acc = MFMA16(fa[4 * mt + kp], Sb[kp], acc);
                o[mt] = acc; }
            PIN(); LD8(fa, 3, 0, 2); PIN();
#pragma unroll
            for (int mt = 0; mt < 2; ++mt) { f32x4 acc = {0.f, 0.f, 0.f, 0.f};
#pragma unroll
                for (int kp = 0; kp < 4; ++kp) acc = MFMA16(fb[4 * mt + kp], Sb[kp], acc);
                o[2 + mt] = acc; }
            PIN(); LD8(fb, 2, 0, 2); PIN();
#pragma unroll
            for (int mt = 0; mt < 4; ++mt) { o[mt] = MFMA16(fa[2 * mt], Vb[0], o[mt]); o[mt] = MFMA16(fa[2 * mt + 1], Vb[1], o[mt]); }
            PIN(); LD8(fa, 2, 4, 2); PIN();
#pragma unroll
            for (int mt = 0; mt < 4; ++mt)
#pragma unroll
                for (int r = 0; r < 4; ++r) O[(size_t)(row0 + 16 * mt + 4 * fq + r) * 512 + h * 128 + ecol] = f2bf(o[mt][r]);
#pragma unroll
            for (int i = 0; i < 4; ++i) { S[i] = S[i] * a; S[i] = MFMA16(fb[2 * i], Vb[0], S[i]); S[i] = MFMA16(fb[2 * i + 1], Vb[1], S[i]); }
#pragma unroll
            for (int i = 0; i < 4; ++i) { S[4 + i] = S[4 + i] * a; S[4 + i] = MFMA16(fa[2 * i], Vb[0], S[4 + i]); S[4 + i] = MFMA16(fa[2 * i + 1], Vb[1], S[4 + i]); }
        } else {
            const bf16x8 bv0 = mk8(pcur[0]), bv1 = mk8(pcur[1]);
            const float* dec = (MX == 0 ? WSP(float, SM_DECA) : WSP(float, SM_DECC)) + (size_t)unit * DK;
            f32x4 dv[NT];
#pragma unroll
            for (int i = 0; i < NT; ++i) dv[i] = *(const f32x4*)(dec + 16 * i + 4 * fq);
            if (MX == 0) {
                LD8(fa, 0, 0, 4); LD8(fb, 0, 2, 4); PIN();
#pragma unroll
                for (int mt = 0; mt < 2; ++mt) { f32x4 acc = {0.f, 0.f, 0.f, 0.f};
#pragma unroll
                    for (int kp = 0; kp < 4; ++kp) acc = MFMA16(fa[4 * mt + kp], Sb[kp], acc);
                    o[mt] = acc; }
                PIN(); LD8(fa, 2, 0, 2); PIN();
#pragma unroll
                for (int mt = 0; mt < 2; ++mt) { f32x4 acc = {0.f, 0.f, 0.f, 0.f};
#pragma unroll
                    for (int kp = 0; kp < 4; ++kp) acc = MFMA16(fb[4 * mt + kp], Sb[kp], acc);
                    o[2 + mt] = acc; }
                PIN(); LD8(fb, 1, 0, 2); PIN();
            } else {
                LD8(fa, 0, 0, 2); LD8(fb, 2, 0, 2); PIN();
#pragma unroll
                for (int mt = 0; mt < 4; ++mt) { f32x4 acc = {0.f, 0.f, 0.f, 0.f}; acc = MFMA16(fa[2 * mt], Sb[0], acc); acc = MFMA16(fa[2 * mt + 1], Sb[1], acc); o[mt] = acc; }
                PIN(); LD8(fa, 1, 0, 2); PIN();
            }
#pragma unroll
            for (int mt = 0; mt < 4; ++mt) { o[mt] = MFMA16((MX == 0 ? fa : fb)[2 * mt], bv0, o[mt]); o[mt] = MFMA16((MX == 0 ? fa : fb)[2 * mt + 1], bv1, o[mt]); }
            if (MX == 0) { PIN(); LD8(fa, 1, 4, 2); PIN(); }
#pragma unroll
            for (int mt = 0; mt < 4; ++mt)
#pragma unroll
                for (int r = 0; r < 4; ++r) O[(size_t)(row0 + 16 * mt + 4 * fq + r) * 512 + h * 128 + ecol] = f2bf(o[mt][r]);
#pragma unroll
            for (int i = 0; i < 4; ++i) { S[i] = S[i] * dv[i]; S[i] = MFMA16((MX == 0 ? fb : fa)[2 * i], bv0, S[i]); S[i] = MFMA16((MX == 0 ? fb : fa)[2 * i + 1], bv1, S[i]); }
            if (MX == 0) {
#pragma unroll
                for (int i = 0; i < 4; ++i) { S[(4 + i) % NT] = S[(4 + i) % NT] * dv[(4 + i) % NT]; S[(4 + i) % NT] = MFMA16(fa[2 * i], bv0, S[(4 + i) % NT]); S[(4 + i) % NT] = MFMA16(fa[2 * i + 1], bv1, S[(4 + i) % NT]); } }
        }
#undef LD8
#undef PIN
        pcur[0] = pnxt[0]; pcur[1] = pnxt[1];
    }
#undef SC_FRAG
    asm volatile("s_waitcnt vmcnt(0)" ::: "memory");
    __syncthreads();
    PROF_MARK(F, 22);
}
__device__ __forceinline__ void phase_scan(Frame& F, int l) {
    PROF_MARK(F, 30);
    if (F.bid >= 48) {
        const int bidx = F.bid - 48, half = bidx >= set_np(1) ? 1 : 0, idx = bidx - half * set_np(1);
        GdnPre gp; GlaPre<128> ap; GlaPre<64> cp; gdn_clear(gp); gla_clear(ap); gla_clear(cp);
        auto has = [&](int k) { return k < NSETS && idx < set_np(k); };
        auto req_g = [&](int k) { if (has(k)) gdn_issue(F, set_ug(k, idx), gp); else gdn_clear(gp); };
        auto req_c = [&](int k) { if (has(k)) gla_issue<64, false>(F, set_ug(k, idx), cp); else gla_clear(cp); };
        auto req_a = [&](int k) { if (has(k)) gla_issue<128, true>(F, set_ug(k, idx), ap); else gla_clear(ap); };
        auto run_g = [&](int k, auto hook) { if (has(k)) prep_gdn(F, l, set_ug(k, idx), gp, hook); else hook(); };
        auto run_c = [&](int k, auto hook) { if (has(k)) prep_gla<64, false>(F, l, set_ug(k, idx), cp, hook); else hook(); };
        auto run_a = [&](int k, auto hook) { if (has(k)) prep_gla<128, true>(F, l, set_ug(k, idx), ap, hook); else hook(); };
        auto signal_after_g = [&](int k) { if (has(k) && has(k + 1)) SET_SIGNAL(l, k, 9); else SET_SIGNAL(l, k, 0); };
        if (half == 0) {
            req_g(0);
            for (int k = 0; k < NSETS; k += 2) { PROF_MARK(F, 10);
                run_g(k, [&]() { req_c(k + 1); }); PROF_MARK(F, 11); signal_after_g(k); PROF_MARK(F, 12);
                if (k + 1 < NSETS) { run_c(k + 1, [&]() { req_a(k + 1); }); run_a(k + 1, [&]() { req_g(k + 2); }); SET_SIGNAL(l, k + 1, 0); } }
        } else {
            req_c(0);
            for (int k = 0; k < NSETS; k += 2) { PROF_MARK(F, 10);
                run_c(k, [&]() { req_a(k); }); run_a(k, [&]() { req_g(k + 1); }); PROF_MARK(F, 11); SET_SIGNAL(l, k, 0); PROF_MARK(F, 12);
                if (k + 1 < NSETS) { run_g(k + 1, [&]() { req_c(k + 2); }); signal_after_g(k + 1); } }
        }
        return; }
    const int mixer = F.bid >> 4, b = (F.bid >> 2) & 3, h = F.bid & 3;
    if (mixer == 0) scan_mixer<0>(F, l, b, h);
    else if (mixer == 1) scan_mixer<1>(F, l, b, h);
    else scan_mixer<2>(F, l, b, h);
}

template <int KIND>
__device__ __forceinline__ void meta_gemm(Frame& F, const bf16_t* A, const bf16_t* Bt, int N, int K, int n) {
    const int gw = F.bid * NWAVES + F.wave, NGW = F.G * NWAVES, lane = F.lane, fr = lane & 15, fq = lane >> 4;
    for (int tile = gw; tile < N / 16; tile += NGW) {
        const bf16_t* ar = A + (size_t)fr * K + 8 * fq; const bf16_t* br = Bt + (size_t)(16 * tile + fr) * K + 8 * fq;
        f32x4 acc = {0.f, 0.f, 0.f, 0.f};
#pragma unroll 8
        for (int ks = 0; ks < K / 32; ++ks) acc = MFMA16(mk8(*(const u32x4*)(ar + 32 * ks)), mk8(*(const u32x4*)(br + 32 * ks)), acc);
#pragma unroll
        for (int r = 0; r < 4; ++r) { const int row = META_ROW0 + 4 * fq + r, col = 16 * tile + fr;
            if (KIND == 0) WSP(bf16_t, WS_GT)[(size_t)row * 3072 + col] = f2bf(sigmoidf_(acc[r]));
            else if (KIND == 1) { bf16_t* mp = WSP(bf16_t, WS_MERGED) + (size_t)row * 1024 + col; const float g = bf2f(WSP(bf16_t, WS_GT)[(size_t)row * 3072 + n * 1024 + col]);
                *mp = f2bf((n ? bf2f(*mp) : 0.f) + g * acc[r]); }
            else { float* hp = WSP(float, WS_HMETA) + (size_t)(row - NREAL) * D + col; *hp = *hp + acc[r]; } }
    }
}

__device__ __forceinline__ void phase_hnorm(Frame& F, int l) {
    const int gw = F.bid * NWAVES + F.wave, NGW = F.G * NWAVES, lane = F.lane;
    const bf16_t* P = WSP(bf16_t, WS_P);
    LAS float* nws = (LAS float*)F.lds;
    if (F.tid < 384) { const int mxw = F.tid >> 7; const float* src = mxw == 0 ? INP(I_HGRN_NORM) : (mxw == 1 ? INP(I_GDN_NORM) : INP(I_GLA_NORM)); nws[F.tid] = src[(size_t)l * 128 + (F.tid & 127)]; }
    __syncthreads();
    for (int r = gw; r < MROWS; r += NGW) {
        bf16_t* op0 = WSP(bf16_t, WS_O) + (size_t)r * 512 + 8 * lane;
        if (!row_valid(r)) { if (!F.dry) {
#pragma unroll
            for (int mx = 0; mx < 3; ++mx) *(u32x4*)(op0 + (size_t)mx * MROWS * 512) = (u32x4){0u, 0u, 0u, 0u}; } continue; }
        u32x4 ow[3], gv[3];
#pragma unroll
        for (int mx = 0; mx < 3; ++mx) { ow[mx] = *(const u32x4*)(op0 + (size_t)mx * MROWS * 512); gv[mx] = *(const u32x4*)(P + (size_t)r * LDP + (mx == 0 ? PC_AG : (mx == 1 ? PC_BG : PC_CG)) + 8 * lane); }
#pragma unroll
        for (int mx = 0; mx < 3; ++mx) {
            const LAS float* nw = nws + mx * 128 + (8 * lane & 127);
            float o[8] = {bflo(ow[mx].x), bfhi(ow[mx].x), bflo(ow[mx].y), bfhi(ow[mx].y), bflo(ow[mx].z), bfhi(ow[mx].z), bflo(ow[mx].w), bfhi(ow[mx].w)};
            const float g[8] = {siluf_(bflo(gv[mx].x)), siluf_(bfhi(gv[mx].x)), siluf_(bflo(gv[mx].y)), siluf_(bfhi(gv[mx].y)), siluf_(bflo(gv[mx].z)), siluf_(bfhi(gv[mx].z)), siluf_(bflo(gv[mx].w)), siluf_(bfhi(gv[mx].w))};
            float ss = 0.f;
#pragma unroll
            for (int j = 0; j < 8; ++j) ss += o[j] * o[j];
            ss += __shfl_xor(ss, 1); ss += __shfl_xor(ss, 2); ss += __shfl_xor(ss, 4); ss += __shfl_xor(ss, 8);
            const float rstd = rsqrtf(ss * (1.0f / 128.0f) + 1e-6f);
            const f32x4 n0 = *(const LAS f32x4*)nw, n1 = *(const LAS f32x4*)(nw + 4);
            const float nv[8] = {n0[0], n0[1], n0[2], n0[3], n1[0], n1[1], n1[2], n1[3]};
#pragma unroll
            for (int j = 0; j < 8; ++j) o[j] = o[j] * rstd * nv[j] * g[j];
            u32x4 y; y.x = pk2(o[0], o[1]); y.y = pk2(o[2], o[3]); y.z = pk2(o[4], o[5]); y.w = pk2(o[6], o[7]);
            if (!F.dry) *(u32x4*)(op0 + (size_t)mx * MROWS * 512) = y;
        }
    }
}

__device__ __forceinline__ void phase_norm2(Frame& F, int l) {
    PROF_MARK(F, 43);
    if (!F.dry) convert_expert_weights(F, l);
    __syncthreads();
    PROF_MARK(F, 44);
    LAS float* sw = (LAS float*)F.lds;
    { const float* src = WSP(float, SM_RWE) + (size_t)l * 32 * 1024; for (int i = F.tid; i < 32 * 1024 / 4; i += NTHREADS) ((LAS f32x4*)sw)[i] = ((const f32x4*)src)[i]; }
    LAS float* rbias = sw + 32 * 1024;
    if (F.tid < 32) rbias[F.tid] = INP(I_RE_B)[l * 32 + F.tid]; else if (F.tid < 36) rbias[F.tid] = INP(I_RG_B)[l * 4 + (F.tid - 32)];
    __syncthreads();
    const int gw = F.bid * NWAVES + F.wave, NGW = F.G * NWAVES, lane = F.lane;
    float wv[16]; load_row16(INP(I_NORM_FFN) + (size_t)l * D, lane, wv);
    bf16_t* U = WSP(bf16_t, WS_U);
    const float* rwg = WSP(float, SM_RWG) + (size_t)l * 4 * 1024;
    unsigned* cnt = WSP(unsigned, WS_CTL) + CW_CNT + l * 64;
    LAS unsigned* lcnt = (LAS unsigned*)(F.lds + LDS_TAB);
    if (F.tid < 64) lcnt[F.tid] = 0u;
    __syncthreads();
    auto body = [&](auto NRc, const int r0) {
        constexpr int NR = decltype(NRc)::value;
        float x[NR][16];
#pragma unroll
        for (int i = 0; i < NR; ++i) {
            load_row16(hrow(F, r0 + i), lane, x[i]);
            float ss = 0.f;
#pragma unroll
            for (int j = 0; j < 16; ++j) ss += x[i][j] * x[i][j];
            const float rstd = rsqrtf(wave_sum(ss) * (1.0f / D) + 1e-6f);
#pragma unroll
            for (int j = 0; j < 16; ++j) x[i][j] = x[i][j] * rstd * wv[j];
            if (!F.dry) store_bf16_row16(U + (size_t)(r0 + i) * D, lane, x[i]);
        }
        float lg[NR][4];
#pragma unroll
        for (int c = 0; c < 4; ++c) {
            float a[NR];
#pragma unroll
            for (int i = 0; i < NR; ++i) a[i] = 0.f;
#pragma unroll
            for (int j = 0; j < 4; ++j) { const f32x4 w = *((const f32x4*)(rwg + c * 1024) + lane + 64 * j);
#pragma unroll
                for (int e = 0; e < 4; ++e) {
#pragma unroll
                    for (int i = 0; i < NR; ++i) a[i] += x[i][4 * j + e] * w[e]; } }
            const float bg = rbias[32 + c];
#pragma unroll
            for (int i = 0; i < NR; ++i) lg[i][c] = wave_sum(a[i]) + bg;
        }
#pragma unroll
        for (int i = 0; i < NR; ++i) {
            int gi = 0; float gm = lg[i][0];
#pragma unroll
            for (int c = 1; c < 4; ++c) if (lg[i][c] > gm) { gm = lg[i][c]; gi = c; }
            float gsum = 0.f;
#pragma unroll
            for (int c = 0; c < 4; ++c) gsum += __expf(lg[i][c] - gm);
            const float gval = 1.0f / gsum;
            gi = __builtin_amdgcn_readfirstlane(gi);
            int ea = 0, eb = 0; float la = -3.0e38f, lb = -3.0e38f;
            const LAS float* swg = sw + gi * 8 * 1024;
#pragma unroll 1
            for (int cb = 0; cb < 8; cb += 4) {
                float a0 = 0.f, a1 = 0.f, a2 = 0.f, a3 = 0.f;
#pragma unroll
                for (int j = 0; j < 4; ++j) { const f32x4 w0 = *((const LAS f32x4*)(swg + (cb + 0) * 1024) + lane + 64 * j), w1 = *((const LAS f32x4*)(swg + (cb + 1) * 1024) + lane + 64 * j), w2 = *((const LAS f32x4*)(swg + (cb + 2) * 1024) + lane + 64 * j), w3 = *((const LAS f32x4*)(swg + (cb + 3) * 1024) + lane + 64 * j);
#pragma unroll
                    for (int e = 0; e < 4; ++e) { const float xv = x[i][4 * j + e]; a0 += xv * w0[e]; a1 += xv * w1[e]; a2 += xv * w2[e]; a3 += xv * w3[e]; } }
                const float e0 = wave_sum(a0) + rbias[gi * 8 + cb], e1 = wave_sum(a1) + rbias[gi * 8 + cb + 1], e2 = wave_sum(a2) + rbias[gi * 8 + cb + 2], e3 = wave_sum(a3) + rbias[gi * 8 + cb + 3];
                const float ev[4] = {e0, e1, e2, e3};
#pragma unroll
                for (int q = 0; q < 4; ++q) { const float el = ev[q]; const int c = cb + q; if (el > la) { lb = la; eb = ea; la = el; ea = c; } else if (el > lb) { lb = el; eb = c; } }
            }
            const float wa = 1.0f / (1.0f + __expf(lb - la)), wb = 1.0f - wa;
            if (lane == 0 && !F.dry) {
                const unsigned e0 = (unsigned)(gi * 8 + ea), e1 = (unsigned)(gi * 8 + eb);
                const unsigned p0 = __hip_atomic_fetch_add(lcnt + e0, 1u, __ATOMIC_RELAXED, __HIP_MEMORY_SCOPE_WORKGROUP), p1 = __hip_atomic_fetch_add(lcnt + e1, 1u, __ATOMIC_RELAXED, __HIP_MEMORY_SCOPE_WORKGROUP);
                unsigned* tok = WSP(unsigned, SM_TOK) + (size_t)(r0 + i) * 8;
                tok[0] = e0; tok[1] = p0; tok[2] = e1; tok[3] = p1; tok[4] = __float_as_uint(gval * wa); tok[5] = __float_as_uint(gval * wb);
            }
        }
    };
    for (int g = gw; g < NREAL / 4; g += NGW) body(IntC<4>{}, 4 * g);
    if (gw >= NGW - 16) body(IntC<1>{}, META_ROW0 + (NGW - 1 - gw));
    __syncthreads();
    if (F.tid < 32 && !F.dry) lcnt[32 + F.tid] = atomicAdd(cnt + F.tid, lcnt[F.tid]);
    __syncthreads();
    if (!F.dry) { for (int g = gw; g < NREAL / 4; g += NGW) { const int r0 = 4 * g;
            if (lane < 4) { unsigned* tok = WSP(unsigned, SM_TOK) + (size_t)(r0 + lane) * 8; tok[1] += lcnt[32 + tok[0]]; tok[3] += lcnt[32 + tok[2]]; } }
        if (gw >= NGW - 16 && lane == 0) { unsigned* tok = WSP(unsigned, SM_TOK) + (size_t)(META_ROW0 + (NGW - 1 - gw)) * 8; tok[1] += lcnt[32 + tok[0]]; tok[3] += lcnt[32 + tok[2]]; } }
}

__device__ __forceinline__ int moe_tables(Frame& F, int l) {
    LAS int* offs = (LAS int*)(F.lds + LDS_TAB); LAS unsigned char* tab = (LAS unsigned char*)(F.lds + LDS_TAB + 384); LAS int* cn = (LAS int*)(F.lds + LDS_TAB + 192);
    const unsigned* cnt = WSP(unsigned, WS_CTL) + CW_CNT + l * 64;
    __syncthreads();
    if (F.tid < 32) cn[F.tid] = (int)__hip_atomic_load(cnt + F.tid, __ATOMIC_RELAXED, __HIP_MEMORY_SCOPE_AGENT);
    __syncthreads();
    if (F.tid == 0) { int acc = 0;
#pragma unroll 1
        for (int e = 0; e < 32; ++e) { offs[e] = acc; acc += ((cn[e] + 255) >> 8) << 8; }
        offs[32] = acc; }
    __syncthreads();
    if (F.tid < 160) { const int row = F.tid << 8; int e = 0;
#pragma unroll 1
        for (int k = 1; k < 32; ++k) if (offs[k] <= row) e = k;
        tab[F.tid] = (unsigned char)e; }
    __syncthreads();
    return offs[32] >> 8;
}

__device__ __forceinline__ void phase_gather(Frame& F, int l) {
    (void)moe_tables(F, l);
    const LAS int* offs = (const LAS int*)(F.lds + LDS_TAB); const LAS int* cn = (const LAS int*)(F.lds + LDS_TAB + 192);
    const int gw = F.bid * NWAVES + F.wave, NGW = F.G * NWAVES, lane = F.lane;
    const bf16_t* U = WSP(bf16_t, WS_U); bf16_t* XG = WSP(bf16_t, WS_XG); float* wrow = WSP(float, SM_WROW);
    auto two = [&](const int r, const int r2, const bool has2) {
        unsigned* tok = WSP(unsigned, SM_TOK) + (size_t)r * 8; unsigned* tok2 = WSP(unsigned, SM_TOK) + (size_t)r2 * 8;
        const u32x4 ta = *(const u32x4*)tok, tb = *(const u32x4*)tok2; const u32x2 wa = *(const u32x2*)(tok + 4), wb = *(const u32x2*)(tok2 + 4);
        const unsigned g0 = (unsigned)offs[ta.x] + ta.y, g1 = (unsigned)offs[ta.z] + ta.w, h0 = (unsigned)offs[tb.x] + tb.y, h1 = (unsigned)offs[tb.z] + tb.w;
        const u32x4* src = (const u32x4*)(U + (size_t)r * D); const u32x4* src2 = (const u32x4*)(U + (size_t)r2 * D);
        const u32x4 a = src[lane], b = src[lane + 64], c = src2[lane], d = src2[lane + 64];
        if (lane == 0) { tok[6] = g0; tok[7] = g1; wrow[g0] = __uint_as_float(wa.x); wrow[g1] = __uint_as_float(wa.y); }
        u32x4* d0 = (u32x4*)(XG + (size_t)g0 * D); u32x4* d1 = (u32x4*)(XG + (size_t)g1 * D);
        d0[lane] = a; d0[lane + 64] = b; d1[lane] = a; d1[lane + 64] = b;
        if (has2) { if (lane == 0) { tok2[6] = h0; tok2[7] = h1; wrow[h0] = __uint_as_float(wb.x); wrow[h1] = __uint_as_float(wb.y); }
            u32x4* e0 = (u32x4*)(XG + (size_t)h0 * D); u32x4* e1 = (u32x4*)(XG + (size_t)h1 * D);
            e0[lane] = c; e0[lane + 64] = d; e1[lane] = c; e1[lane + 64] = d; } };
    for (int idx = gw; idx < NREAL; idx += 2 * NGW) { const int idx2 = idx + NGW; const bool has2 = idx2 < NREAL; two(idx, has2 ? idx2 : idx, has2); }
    if (gw >= NGW - 16) { const int r = META_ROW0 + (NGW - 1 - gw); two(r, r, false); }
    u32x4 zz = {0u, 0u, 0u, 0u}; asm volatile("" : "+v"(zz));
    for (int i = gw; i < 32 * 256; i += NGW) { const int e = i >> 8, j = i & 255; const int row = offs[e] + cn[e] + j;
        if (row < offs[e + 1]) { u32x4* d = (u32x4*)(XG + (size_t)row * D); d[lane] = zz; d[lane + 64] = zz; if (lane == 0) wrow[row] = 0.f; } }
}

__device__ __forceinline__ void phase_final(Frame& F) {
    const int gw = F.bid * NWAVES + F.wave, NGW = F.G * NWAVES, lane = F.lane;
    float wv[16]; load_row16(INP(I_NORM_FINAL), lane, wv);
    for (int r = gw; r < NREAL; r += 2 * NGW) {
        const int r2 = r + NGW;
        float x[16], y[16]; fetch_h_row(F, 2, r, x); fetch_h_row(F, 2, r2, y);
        float ss = 0.f, s2 = 0.f;
#pragma unroll
        for (int j = 0; j < 16; ++j) { ss += x[j] * x[j]; s2 += y[j] * y[j]; }
        const float rstd = rsqrtf(wave_sum(ss) * (1.0f / D) + 1e-6f), rstd2 = rsqrtf(wave_sum(s2) * (1.0f / D) + 1e-6f);
#pragma unroll
        for (int j = 0; j < 16; ++j) { x[j] = x[j] * rstd * wv[j]; y[j] = y[j] * rstd2 * wv[j]; }
        store_row16(OUTP + (size_t)r * D, lane, x); store_row16(OUTP + (size_t)r2 * D, lane, y);
    }
}
constexpr int PH_PER_LAYER = 14, N_PHASES = 2 + 2 * PH_PER_LAYER;
#ifndef DBG_STOP
#define DBG_STOP 0
#endif
#ifndef DBG_SRC
#define DBG_SRC WS_P
#define DBG_LD LDP
#endif
#ifndef DBG_TA
#define DBG_TA -1
#endif
#ifndef DBG_TQ
#define DBG_TQ 16.0f
#endif
#ifndef DBG_TB
#define DBG_TB -1
#endif
#ifndef DUP_MASK
#define DUP_MASK 0u
#endif
#define DUPN(j) (((DUP_MASK >> (j)) & 1u) ? 2 : 1)
#ifndef MK_ONE_LAUNCH
#define MK_ONE_LAUNCH 1
#endif

template <unsigned PHMASK_T>
__global__ void __launch_bounds__(NTHREADS, 2) hybrid_fwd(Params p) {
    extern __shared__ __attribute__((aligned(16))) unsigned char lds_raw[];
    Frame F;
    F.lds = (LAS unsigned char*)lds_raw; F.tid = threadIdx.x; F.lane = F.tid & 63; F.wave = __builtin_amdgcn_readfirstlane(F.tid >> 6); F.G = gridDim.x; F.bid = blockIdx.x; F.dry = 0;
    F.out = (GAS float*)p.out; F.ws = (GAS unsigned char*)p.ws; F.inp = (const float* const __attribute__((address_space(4)))*)__builtin_amdgcn_kernarg_segment_ptr();
    volatile LAS unsigned* MISC = (volatile LAS unsigned*)(F.lds + LDS_MISC);
    if (F.tid < 128) MISC[F.tid] = 0u;
    if (F.bid >= 48 && F.tid == 0) (void)xb_add(WSP(unsigned, WS_CTL) + 8192 + 64 + xb_xcc_id(), 1u);
    __syncthreads();
#if MK_ONE_LAUNCH
    constexpr int lo = 0, hi = N_PHASES;
#else
    const int lo = p.ph_lo, hi = p.ph_hi;
#endif
    if (hi - lo > 1) (void)xcd_barrier_post(WSP(unsigned, WS_CTL) + CW_BAR, MISC + 8);
#define GRID_BARRIER() xcd_barrier(WSP(unsigned, WS_CTL) + CW_BAR, xb_xcc_id(), (volatile LAS unsigned*)(F.lds + LDS_MISC) + 8, F.tid, (unsigned)F.G)
#define EN(j) ((PHMASK_T >> (j)) & 1u)
#define IN(k) (lo <= (k) && (k) < hi)
    if (DBG_TA >= 0 && F.tid == 0) { MISC[16] = (unsigned)__builtin_amdgcn_s_memrealtime(); MISC[17] = 0u; }
#define SEAM(k) do { if (IN(k) && IN((k) + 1)) GRID_BARRIER(); PHASE_FENCE(F); \
    if (DBG_TA >= 0 && F.tid == 0) { const unsigned t_now = (unsigned)__builtin_amdgcn_s_memrealtime(); const int kk = (k) == 0 ? 15 : (((k) - 1) % PH_PER_LAYER); const int kind = (kk >= 6 && kk <= 8) ? 6 : kk; \
        if (kind == DBG_TA) MISC[17] += t_now - MISC[16]; MISC[16] = t_now; } } while (0)
    PHASE_FENCE(F);
    if (EN(15) && IN(0)) phase_pre(F);
    SEAM(0);
    { constexpr int l = 0;
        const int pb = 1 + PH_PER_LAYER * l;
        for (int rep = 0; rep < (l == 0 ? DUPN(0) : 1); ++rep) { if (rep) { GRID_BARRIER(); PHASE_FENCE(F); } if (EN(0) && IN(pb + 0)) phase_norm1(F, l); }
        PROF_MARK(F, 42);
        SEAM(pb + 0);
        for (int rep = 0; rep < DUPN(1); ++rep) { if (rep) { GRID_BARRIER(); PHASE_FENCE(F); }
        if (EN(1) && IN(pb + 1)) {
            pg8::Gemm g{WSP(bf16_t, WS_U), WSP(bf16_t, WS_WMIX), MROWS, LDP, D}; pg8::StaticOrder S; S.init(MROWS, LDP, F.G, F.bid);
            pg8::EpiInProj E{WSP(bf16_t, WS_P), WSP(bf16_t, SM_HALO)};
            pg8::gemm_phase(F.lds, F.tid, g, S, E);
        } }
        SEAM(pb + 1);
        PHASE_FENCE(F);
        if (EN(3) && IN(pb + 3)) phase_scan(F, l);
        SEAM(pb + 3);
        for (int rep = 0; rep < DUPN(4); ++rep) { if (rep) { GRID_BARRIER(); PHASE_FENCE(F); F.dry = 1; asm volatile("" : "+s"(F.dry)); } if (EN(4) && IN(pb + 4)) phase_hnorm(F, l); F.dry = 0; }
        SEAM(pb + 4);
        for (int rep = 0; rep < DUPN(5); ++rep) { if (rep) { GRID_BARRIER(); PHASE_FENCE(F); }
        if (EN(5) && IN(pb + 5)) {
            pg8::Gemm g{WSP(bf16_t, WS_U), WSP(bf16_t, WS_WGATE), NREAL, 3072, D}; pg8::StaticOrder S; S.init(NREAL, 3072, F.G, F.bid);
            pg8::EpiSigmoid E{WSP(bf16_t, WS_GT), 3072};
            pg8::gemm_phase(F.lds, F.tid, g, S, E);
            meta_gemm<0>(F, WSP(bf16_t, WS_U) + (size_t)META_ROW0 * D, WSP(bf16_t, WS_WGATE), 3072, D, 0);
        } }
        SEAM(pb + 5);
        if (EN(6) && IN(pb + 6)) {
            pg8::Gemm g{WSP(bf16_t, WS_O), WSP(bf16_t, WS_WBT), NREAL, D, 512}; pg8::BranchOrder S; S.init(NREAL, D, F.G, F.bid, (size_t)MROWS * 512 * 2, (size_t)1024 * 512 * 2);
            pg8::EpiBranch E{WSP(bf16_t, WS_MERGED), WSP(bf16_t, WS_GT)};
            pg8::gemm_phase(F.lds, F.tid, g, S, E);
            for (int n = 0; n < 3; ++n) meta_gemm<1>(F, WSP(bf16_t, WS_O) + (size_t)n * MROWS * 512 + (size_t)META_ROW0 * 512, WSP(bf16_t, WS_WBT) + (size_t)n * 1024 * 512, D, 512, n);
        }
        SEAM(pb + 8);
        if (EN(9) && IN(pb + 9)) {
            pg8::Gemm g{WSP(bf16_t, WS_MERGED), WSP(bf16_t, WS_WOT), NREAL, D, D}; pg8::StaticOrder S; S.init(NREAL, D, F.G, F.bid);
            pg8::EpiResidual E{OUTP, WSP(float, WS_HMETA)};
            pg8::gemm_phase(F.lds, F.tid, g, S, E);
            meta_gemm<2>(F, WSP(bf16_t, WS_MERGED) + (size_t)META_ROW0 * D, WSP(bf16_t, WS_WOT), D, D, 0);
        }
        SEAM(pb + 9);
        for (int rep = 0; rep < DUPN(10); ++rep) { if (rep) { GRID_BARRIER(); PHASE_FENCE(F); F.dry = 1; asm volatile("" : "+s"(F.dry)); } if (EN(10) && IN(pb + 10)) phase_norm2(F, l); F.dry = 0; }
        PROF_MARK(F, 45);
        SEAM(pb + 10);
        for (int rep = 0; rep < DUPN(11); ++rep) { if (rep) { GRID_BARRIER(); PHASE_FENCE(F); } if (EN(11) && IN(pb + 11)) phase_gather(F, l); }
        SEAM(pb + 11);
        for (int rep = 0; rep < DUPN(12); ++rep) { if (rep) { GRID_BARRIER(); PHASE_FENCE(F); }
        if (EN(12) && IN(pb + 12)) {
            const int ntiles = moe_tables(F, l);
            pg8::Gemm g{WSP(bf16_t, WS_XG), WSP(bf16_t, WS_W1T), XG_ROWS, 512, D};
            pg8::MoeOrder S{F.G, F.bid, 2, ntiles, (const LAS unsigned char*)(F.lds + LDS_TAB + 384), (size_t)512 * 1024 * 2};
            pg8::EpiMoeUp E{WSP(bf16_t, WS_HG)};
            pg8::gemm_phase(F.lds, F.tid, g, S, E);
        } }
        SEAM(pb + 12);
        for (int rep = 0; rep < DUPN(13); ++rep) { if (rep) { GRID_BARRIER(); PHASE_FENCE(F); }
        if (EN(13) && IN(pb + 13)) {
            const int ntiles = moe_tables(F, l);
            pg8::Gemm g{WSP(bf16_t, WS_HG), WSP(bf16_t, WS_W2T), XG_ROWS, D, 256};
            pg8::MoeOrder S{F.G, F.bid, 4, ntiles, (const LAS unsigned char*)(F.lds + LDS_TAB + 384), (size_t)1024 * 256 * 2};
            pg8::EpiMoeDown E{WSP(bf16_t, WS_Y2), WSP(float, SM_WROW)};
            pg8::gemm_phase(F.lds, F.tid, g, S, E);
        } }
        SEAM(pb + 13);
    }
    { constexpr int l = 1;
        const int pb = 1 + PH_PER_LAYER * l;
        for (int rep = 0; rep < (l == 0 ? DUPN(0) : 1); ++rep) { if (rep) { GRID_BARRIER(); PHASE_FENCE(F); } if (EN(0) && IN(pb + 0)) phase_norm1(F, l); }
        PROF_MARK(F, 42);
        SEAM(pb + 0);
        for (int rep = 0; rep < DUPN(1); ++rep) { if (rep) { GRID_BARRIER(); PHASE_FENCE(F); }
        if (EN(1) && IN(pb + 1)) {
            pg8::Gemm g{WSP(bf16_t, WS_U), WSP(bf16_t, WS_WMIX), MROWS, LDP, D}; pg8::StaticOrder S; S.init(MROWS, LDP, F.G, F.bid);
            pg8::EpiInProj E{WSP(bf16_t, WS_P), WSP(bf16_t, SM_HALO)};
            pg8::gemm_phase(F.lds, F.tid, g, S, E);
        } }
        SEAM(pb + 1);
        PHASE_FENCE(F);
        if (EN(3) && IN(pb + 3)) phase_scan(F, l);
        SEAM(pb + 3);
        for (int rep = 0; rep < DUPN(4); ++rep) { if (rep) { GRID_BARRIER(); PHASE_FENCE(F); F.dry = 1; asm volatile("" : "+s"(F.dry)); } if (EN(4) && IN(pb + 4)) phase_hnorm(F, l); F.dry = 0; }
        SEAM(pb + 4);
        for (int rep = 0; rep < DUPN(5); ++rep) { if (rep) { GRID_BARRIER(); PHASE_FENCE(F); }
        if (EN(5) && IN(pb + 5)) {
            pg8::Gemm g{WSP(bf16_t, WS_U), WSP(bf16_t, WS_WGATE), NREAL, 3072, D}; pg8::StaticOrder S; S.init(NREAL, 3072, F.G, F.bid);
            pg8::EpiSigmoid E{WSP(bf16_t, WS_GT), 3072};
            pg8::gemm_phase(F.lds, F.tid, g, S, E);
            meta_gemm<0>(F, WSP(bf16_t, WS_U) + (size_t)META_ROW0 * D, WSP(bf16_t, WS_WGATE), 3072, D, 0);
        } }
        SEAM(pb + 5);
        if (EN(6) && IN(pb + 6)) {
            pg8::Gemm g{WSP(bf16_t, WS_O), WSP(bf16_t, WS_WBT), NREAL, D, 512}; pg8::BranchOrder S; S.init(NREAL, D, F.G, F.bid, (size_t)MROWS * 512 * 2, (size_t)1024 * 512 * 2);
            pg8::EpiBranch E{WSP(bf16_t, WS_MERGED), WSP(bf16_t, WS_GT)};
            pg8::gemm_phase(F.lds, F.tid, g, S, E);
            for (int n = 0; n < 3; ++n) meta_gemm<1>(F, WSP(bf16_t, WS_O) + (size_t)n * MROWS * 512 + (size_t)META_ROW0 * 512, WSP(bf16_t, WS_WBT) + (size_t)n * 1024 * 512, D, 512, n);
        }
        SEAM(pb + 8);
        if (EN(9) && IN(pb + 9)) {
            pg8::Gemm g{WSP(bf16_t, WS_MERGED), WSP(bf16_t, WS_WOT), NREAL, D, D}; pg8::StaticOrder S; S.init(NREAL, D, F.G, F.bid);
            pg8::EpiResidual E{OUTP, WSP(float, WS_HMETA)};
            pg8::gemm_phase(F.lds, F.tid, g, S, E);
            meta_gemm<2>(F, WSP(bf16_t, WS_MERGED) + (size_t)META_ROW0 * D, WSP(bf16_t, WS_WOT), D, D, 0);
        }
        SEAM(pb + 9);
        for (int rep = 0; rep < DUPN(10); ++rep) { if (rep) { GRID_BARRIER(); PHASE_FENCE(F); F.dry = 1; asm volatile("" : "+s"(F.dry)); } if (EN(10) && IN(pb + 10)) phase_norm2(F, l); F.dry = 0; }
        PROF_MARK(F, 45);
        SEAM(pb + 10);
        for (int rep = 0; rep < DUPN(11); ++rep) { if (rep) { GRID_BARRIER(); PHASE_FENCE(F); } if (EN(11) && IN(pb + 11)) phase_gather(F, l); }
        SEAM(pb + 11);
        for (int rep = 0; rep < DUPN(12); ++rep) { if (rep) { GRID_BARRIER(); PHASE_FENCE(F); }
        if (EN(12) && IN(pb + 12)) {
            const int ntiles = moe_tables(F, l);
            pg8::Gemm g{WSP(bf16_t, WS_XG), WSP(bf16_t, WS_W1T), XG_ROWS, 512, D};
            pg8::MoeOrder S{F.G, F.bid, 2, ntiles, (const LAS unsigned char*)(F.lds + LDS_TAB + 384), (size_t)512 * 1024 * 2};
            pg8::EpiMoeUp E{WSP(bf16_t, WS_HG)};
            pg8::gemm_phase(F.lds, F.tid, g, S, E);
        } }
        SEAM(pb + 12);
        for (int rep = 0; rep < DUPN(13); ++rep) { if (rep) { GRID_BARRIER(); PHASE_FENCE(F); }
        if (EN(13) && IN(pb + 13)) {
            const int ntiles = moe_tables(F, l);
            pg8::Gemm g{WSP(bf16_t, WS_HG), WSP(bf16_t, WS_W2T), XG_ROWS, D, 256};
            pg8::MoeOrder S{F.G, F.bid, 4, ntiles, (const LAS unsigned char*)(F.lds + LDS_TAB + 384), (size_t)1024 * 256 * 2};
            pg8::EpiMoeDown E{WSP(bf16_t, WS_Y2), WSP(float, SM_WROW)};
            pg8::gemm_phase(F.lds, F.tid, g, S, E);
        } }
        SEAM(pb + 13);
    }
#if DBG_STOP > 0
    if (EN(14) && IN(N_PHASES - 1)) { const int gt = F.bid * NTHREADS + F.tid, NT = F.G * NTHREADS;
#ifdef DBG_LIN
        { const bf16_t* s1 = WSP(bf16_t, DBG_SRC); const bf16_t* s2 = WSP(bf16_t, DBG_SRC2);
          for (size_t i = gt; i < (size_t)NREAL * D; i += NT) F.out[i] = i < (size_t)DBG_N1 ? bf2f(s1[i]) : (i < (size_t)DBG_N1 + DBG_N2 ? bf2f(s2[i - DBG_N1]) : 0.f); }
#else
        if (DBG_LD > 0) { const bf16_t* src = WSP(bf16_t, DBG_SRC); for (size_t i = gt; i < (size_t)NREAL * D; i += NT) { const size_t r = i >> 10, c = i & 1023; F.out[i] = bf2f(src[r * DBG_LD + (c * DBG_LD) / 1024]); } }
#endif
    }
#else
#ifdef DBG_XBAR
    for (int i = 0; i < DBG_XBAR; ++i) { GRID_BARRIER(); PHASE_FENCE(F); }
#endif
    if (EN(14) && IN(N_PHASES - 1)) phase_final(F);
    PROF_SPIN(F);
    if (DBG_TA >= 0) { float* tw = WSP(float, WS_CTL) + 2048; if (F.bid == 0 && F.tid == 0) { tw[0] = (float)MISC[17] * 0.01f; }
        GRID_BARRIER(); PHASE_FENCE(F);
        const float v = floorf(WSP(float, WS_CTL)[2048] * (1.0f / DBG_TQ)) * 0.25f;
        const int gt = F.bid * NTHREADS + F.tid, NT = F.G * NTHREADS;
        for (size_t i = gt; i < (size_t)NREAL * D; i += NT) F.out[i] = v; }
#endif
#undef IN
#undef SEAM
}

#if MK_ONE_LAUNCH
#ifndef KM_ONE
#define KM_ONE 0xffffffffu
#endif
constexpr unsigned KMASK[1] = {KM_ONE};
#else
constexpr unsigned KMASK[3] = {0x0C19u, 0xC004u, 0x3262u};
#endif
template <unsigned M> static bool setup_kernel(int& per_cu) {
    if (hipFuncSetAttribute((const void*)hybrid_fwd<M>, hipFuncAttributeMaxDynamicSharedMemorySize, LDS_BYTES) != hipSuccess) return false;
    if (hipOccupancyMaxActiveBlocksPerMultiprocessor(&per_cu, (const void*)hybrid_fwd<M>, NTHREADS, LDS_BYTES) != hipSuccess) per_cu = 0;
    (void)hipGetLastError();
    return true;
}
static int phase_kind(int k) { if (k == 0) return 15; if (k == N_PHASES - 1) return 14; const int j = (k - 1) % PH_PER_LAYER; return (j >= 6 && j <= 8) ? 6 : j; }
extern "C" void kernel_launch(void* const* d_in, const int* in_sizes, int n_in, void* d_out, int out_size, void* d_ws, size_t ws_size, hipStream_t stream) {
    static int grid = 0;
    if (grid == 0) {
        if (n_in != 24 || in_sizes[0] != NREAL * D || out_size != NREAL * D || ws_size < WS_END) {
            fprintf(stderr, "kernel_launch: unexpected problem (n_in %d, in0 %d, out %d, ws %zu < %zu); nothing launched\n", n_in, n_in > 0 ? in_sizes[0] : -1, out_size, ws_size, (size_t)WS_END); grid = -1; return; }
        int dev = 0, cus = 0, per_cu = 0; bool ok = true;
        if (hipGetDevice(&dev) != hipSuccess || hipDeviceGetAttribute(&cus, hipDeviceAttributeMultiprocessorCount, dev) != hipSuccess) { grid = -1; return; }
#if MK_ONE_LAUNCH
        ok = setup_kernel<KMASK[0]>(per_cu);
#else
        ok = setup_kernel<KMASK[0]>(per_cu) && setup_kernel<KMASK[1]>(per_cu) && setup_kernel<KMASK[2]>(per_cu);
#endif
        if (!ok) { fprintf(stderr, "kernel_launch: hipFuncSetAttribute failed\n"); grid = -1; return; }
        if (per_cu < 1) fprintf(stderr, "kernel_launch: occupancy query says %d\n", per_cu);
        if (cus != 256) { fprintf(stderr, "kernel_launch: the work split of the scan phase is written for 256 CUs (found %d); nothing launched\n", cus); grid = -1; return; }
        grid = cus;
    }
    if (grid < 0) return;
    if (hipMemsetAsync((char*)d_ws + WS_CTL, 0, CTL_BYTES, stream) != hipSuccess) return;
    Params p{};
    for (int i = 0; i < 24; ++i) p.in[i] = (const float*)d_in[i];
    p.out = (float*)d_out; p.ws = (unsigned char*)d_ws;
#if MK_ONE_LAUNCH
    p.ph_lo = 0; p.ph_hi = N_PHASES;
    hipLaunchKernelGGL(hybrid_fwd<KMASK[0]>, dim3(grid), dim3(NTHREADS), LDS_BYTES, stream, p);
#else
    for (int k = 0; k < N_PHASES; ++k) { if (DBG_STOP > 0 && k >= DBG_STOP && k != N_PHASES - 1) continue; p.ph_lo = k; p.ph_hi = k + 1; const unsigned bit = 1u << phase_kind(k);
        if (KMASK[0] & bit) hipLaunchKernelGGL(hybrid_fwd<KMASK[0]>, dim3(grid), dim3(NTHREADS), LDS_BYTES, stream, p);
        else if (KMASK[1] & bit) hipLaunchKernelGGL(hybrid_fwd<KMASK[1]>, dim3(grid), dim3(NTHREADS), LDS_BYTES, stream, p);
        else hipLaunchKernelGGL(hybrid_fwd<KMASK[2]>, dim3(grid), dim3(NTHREADS), LDS_BYTES, stream, p); }
#endif
}
```
